# Optimizing an MI355X kernel written in HIP

```python
import math
import jax, jax.numpy as jnp
from jax import lax
import numpy as np

D_MODEL = 1024
BATCH = 16
SEQ = 4096
DEPTH = 1

ATT_HEADS = 16
ATT_KV_HEADS = 2
ATT_HEAD_DIM = 64
WINDOW = 128
ATT_BLOCK = 128
ROPE_THETA = 10000.0
ML_HEADS = 4
ML_DQK = 128
ML_DV = 256
ML_CHUNK = 64
CONV_WIDTH = 4
MEM_LEN = 256
X_HEADS = 4
X_HEAD_DIM = D_MODEL // X_HEADS
N_GROUPS = 8
EXPERTS_PER_GROUP = 8
N_EXPERTS = N_GROUPS * EXPERTS_PER_GROUP
TOP_K = 2
D_EXPERT = 256
MOE_BLOCK = 128
ALPHA = (2 * DEPTH) ** 0.25
BETA = (8 * DEPTH) ** -0.25
LN_EPS = 1e-5
RMS_EPS = 1e-6

ATT_Q_W = ATT_HEADS * ATT_HEAD_DIM
ATT_KV_W = ATT_KV_HEADS * ATT_HEAD_DIM
ML_QK_W = ML_HEADS * ML_DQK
ML_V_W = ML_HEADS * ML_DV
IN_WIDTHS = (ATT_Q_W, ATT_KV_W, ATT_KV_W, ML_QK_W, ML_QK_W, ML_V_W, ML_V_W, ML_HEADS, ML_HEADS, D_MODEL, D_MODEL)
IN_WIDTH = ATT_Q_W + 2 * ATT_KV_W + 2 * ML_QK_W + 2 * ML_V_W + 2 * ML_HEADS + 2 * D_MODEL

kernel_name = 'hybrid_swa_mlstm_hmoe_deepnorm'


def _split_columns(t, widths):
    parts, start = [], 0
    for w in widths:
        parts.append(t[..., start:start + w])
        start += w
    return parts


def layer_norm(x, g, b):
    xf = x.astype(jnp.float32)
    mu = jnp.mean(xf, -1, keepdims=True)
    var = jnp.mean(jnp.square(xf - mu), -1, keepdims=True)
    return ((xf - mu) * lax.rsqrt(var + LN_EPS) * g.astype(jnp.float32) + b.astype(jnp.float32)).astype(x.dtype)


def rope(x, positions):
    half = x.shape[-1] // 2
    inv = ROPE_THETA ** (-jnp.arange(half, dtype=jnp.float32) / half)
    ang = positions.astype(jnp.float32)[..., None] * inv
    cos = jnp.cos(ang)[:, :, None, :]
    sin = jnp.sin(ang)[:, :, None, :]
    xf = x.astype(jnp.float32)
    x1, x2 = xf[..., :half], xf[..., half:]
    return jnp.concatenate([x1 * cos - x2 * sin, x2 * cos + x1 * sin], -1).astype(x.dtype)


def sliding_window_attention(q, k, v, sinks):
    B, S, Hq, Dh = q.shape
    Hkv = k.shape[2]
    G = Hq // Hkv
    nb = S // ATT_BLOCK
    qb = q.reshape(B, nb, ATT_BLOCK, Hkv, G, Dh)

    def with_prev(t):
        tb = t.reshape(B, nb, ATT_BLOCK, Hkv, Dh)
        prev = jnp.pad(tb[:, :-1], ((0, 0), (1, 0), (0, 0), (0, 0), (0, 0)))
        return jnp.concatenate([prev, tb], axis=2)

    kb, vb = with_prev(k), with_prev(v)
    scores = jnp.einsum('bnqhgd,bnkhd->bnhgqk', qb, kb, preferred_element_type=jnp.float32) * (Dh ** -0.5)
    blk = jnp.arange(nb)[:, None, None]
    qpos = blk * ATT_BLOCK + jnp.arange(ATT_BLOCK)[None, :, None]
    kpos = (blk - 1) * ATT_BLOCK + jnp.arange(2 * ATT_BLOCK)[None, None, :]
    diff = qpos - kpos
    valid = (diff >= 0) & (diff < WINDOW) & (kpos >= 0)
    scores = jnp.where(valid[None, :, None, None], scores, -jnp.inf)
    sink = sinks.astype(jnp.float32).reshape(1, 1, Hkv, G, 1)
    m = jnp.maximum(jnp.max(scores, -1), sink)
    e = jnp.exp(scores - m[..., None])
    den = jnp.sum(e, -1) + jnp.exp(sink - m)
    probs = e / den[..., None]
    out = jnp.einsum('bnhgqk,bnkhd->bnqhgd', probs.astype(v.dtype), vb)
    return out.reshape(B, S, Hq * Dh)


def causal_depthwise_conv(x, w, b):
    out = lax.conv_general_dilated(x, w[:, None, :].astype(x.dtype), window_strides=(1,),
                                   padding=[(CONV_WIDTH - 1, 0)],
                                   dimension_numbers=('NWC', 'WIO', 'NWC'),
                                   feature_group_count=x.shape[-1])
    return out + b.astype(x.dtype)


def mlstm_chunkwise(q, k, v, log_i, log_f):
    B, H, S, dqk = q.shape
    dv = v.shape[-1]
    L = ML_CHUNK
    nc = S // L

    def to_chunks(t):
        return jnp.moveaxis(t.reshape((B, H, nc, L) + t.shape[3:]), 2, 0)

    xs = (to_chunks(q), to_chunks(k), to_chunks(v), to_chunks(log_i), to_chunks(log_f))
    causal = jnp.tril(jnp.ones((L, L), dtype=bool))

    def step(carry, inp):
        C, n, m = carry
        qx, kx, vx, ix, fx = inp
        b = jnp.cumsum(fx, axis=-1)
        d = jnp.where(causal, b[..., :, None] - b[..., None, :] + ix[..., None, :], -jnp.inf)
        inter = b + m[..., None]
        m_t = jnp.maximum(inter, jnp.max(d, -1))
        w_intra = jnp.exp(d - m_t[..., None])
        w_inter = jnp.exp(inter - m_t)
        s = jnp.einsum('bhtd,bhsd->bhts', qx, kx) * w_intra
        num = w_inter[..., None] * jnp.einsum('bhtd,bhde->bhte', qx, C) + jnp.einsum('bhts,bhse->bhte', s, vx)
        den = w_inter * jnp.einsum('bhtd,bhd->bht', qx, n) + jnp.sum(s, -1)
        h = num / jnp.maximum(jnp.abs(den), jnp.exp(-m_t))[..., None]
        b_end = b[..., -1]
        d_end = b_end[..., None] - b + ix
        m_new = jnp.maximum(b_end + m, jnp.max(d_end, -1))
        w_state = jnp.exp(b_end + m - m_new)
        w_k = jnp.exp(d_end - m_new[..., None])
        C_new = w_state[..., None, None] * C + jnp.einsum('bhs,bhsd,bhse->bhde', w_k, kx, vx)
        n_new = w_state[..., None] * n + jnp.einsum('bhs,bhsd->bhd', w_k, kx)
        return (C_new, n_new, m_new), h

    init = (jnp.zeros((B, H, dqk, dv), jnp.float32), jnp.zeros((B, H, dqk), jnp.float32), jnp.zeros((B, H), jnp.float32))
    _, h = lax.scan(step, init, xs)
    return jnp.moveaxis(h, 0, 2).reshape(B, H, S, dv).transpose(0, 2, 1, 3)


def hybrid_mixer(x, positions, w_in, attn_sinks, conv_w, conv_b, b_igate, b_fgate, ml_norm_g,
                 w_att_branch, w_ml_branch, w_mix_out):
    B, S, _ = x.shape
    f32 = jnp.float32
    proj = x @ w_in
    aq, ak, av, mq, mk, mv, mo, mi, mf, ga, gm = _split_columns(proj, IN_WIDTHS)
    aq = rope(aq.reshape(B, S, ATT_HEADS, ATT_HEAD_DIM), positions)
    ak = rope(ak.reshape(B, S, ATT_KV_HEADS, ATT_HEAD_DIM), positions)
    av = av.reshape(B, S, ATT_KV_HEADS, ATT_HEAD_DIM)
    a_out = sliding_window_attention(aq, ak, av, attn_sinks) @ w_att_branch
    qk_conv = jax.nn.silu(causal_depthwise_conv(jnp.concatenate([mq, mk], -1), conv_w, conv_b))
    mq, mk = qk_conv[..., :ML_QK_W], qk_conv[..., ML_QK_W:]

    def heads_first(t, d):
        return t.reshape(B, S, ML_HEADS, d).transpose(0, 2, 1, 3).astype(f32)

    q = heads_first(mq, ML_DQK)
    k = heads_first(mk, ML_DQK) * (ML_DQK ** -0.5)
    v = heads_first(mv, ML_DV)
    log_i = (mi.astype(f32) + b_igate.astype(f32)).transpose(0, 2, 1)
    log_f = jax.nn.log_sigmoid(mf.astype(f32) + b_fgate.astype(f32)).transpose(0, 2, 1)
    hm = mlstm_chunkwise(q, k, v, log_i, log_f)
    hm = hm * lax.rsqrt(jnp.mean(hm * hm, -1, keepdims=True) + RMS_EPS)
    hm = hm.reshape(B, S, ML_V_W) * ml_norm_g.astype(f32)
    hm = (hm * jax.nn.sigmoid(mo.astype(f32))).astype(x.dtype)
    m_out = hm @ w_ml_branch
    y = jax.nn.sigmoid(ga) * a_out + jax.nn.sigmoid(gm) * m_out
    return y @ w_mix_out


def memory_cross_attention(x, mem, w_xq, w_xkv, w_xo):
    B, S, _ = x.shape
    M = mem.shape[1]
    q = (x @ w_xq).reshape(B, S, X_HEADS, X_HEAD_DIM)
    kv = mem @ w_xkv
    k = kv[..., :D_MODEL].reshape(B, M, X_HEADS, X_HEAD_DIM)
    v = kv[..., D_MODEL:].reshape(B, M, X_HEADS, X_HEAD_DIM)
    s = jnp.einsum('bshd,bmhd->bhsm', q, k, preferred_element_type=jnp.float32) * (X_HEAD_DIM ** -0.5)
    p = jax.nn.softmax(s, axis=-1)
    o = jnp.einsum('bhsm,bmhd->bshd', p.astype(v.dtype), v).reshape(B, S, D_MODEL)
    return o @ w_xo


def hierarchical_moe(x, w_router_group, b_router_group, w_router_expert, b_router_expert, w_gate, w_up, w_down):
    B, S, D = x.shape
    N = B * S
    xf = x.reshape(N, D)
    g_logits = (xf @ w_router_group).astype(jnp.float32) + b_router_group.astype(jnp.float32)
    g_prob = jax.nn.softmax(g_logits, axis=-1)
    g_sel = jnp.argmax(g_logits, axis=-1)
    p_group = jnp.take_along_axis(g_prob, g_sel[:, None], axis=-1)
    e_logits = ((xf @ w_router_expert).astype(jnp.float32) + b_router_expert.astype(jnp.float32)).reshape(N, N_GROUPS, EXPERTS_PER_GROUP)
    e_in_group = jnp.take_along_axis(e_logits, g_sel[:, None, None], axis=1)[:, 0]
    top_val, top_idx = lax.top_k(e_in_group, TOP_K)
    weights = p_group * jax.nn.softmax(top_val, axis=-1)
    expert_id = g_sel[:, None] * EXPERTS_PER_GROUP + top_idx
    A = N * TOP_K
    flat_e = expert_id.reshape(A)
    flat_tok = jnp.arange(A, dtype=jnp.int32) // TOP_K
    flat_w = weights.reshape(A)
    order = jnp.argsort(flat_e)
    se, stok, sw = flat_e[order], flat_tok[order], flat_w[order]
    counts = jnp.zeros((N_EXPERTS,), jnp.int32).at[flat_e].add(1)
    padded = ((counts + MOE_BLOCK - 1) // MOE_BLOCK) * MOE_BLOCK
    pad_end = jnp.cumsum(padded)
    pad_start = pad_end - padded
    cnt_start = jnp.cumsum(counts) - counts
    dest = pad_start[se] + (jnp.arange(A, dtype=jnp.int32) - cnt_start[se])
    n_blocks = -(-A // MOE_BLOCK) + N_EXPERTS
    R = n_blocks * MOE_BLOCK
    row_tok = jnp.zeros((R,), jnp.int32).at[dest].set(stok)
    row_w = jnp.zeros((R,), jnp.float32).at[dest].set(sw)
    block_start = jnp.arange(n_blocks, dtype=jnp.int32) * MOE_BLOCK
    block_expert = jnp.minimum(jnp.searchsorted(pad_end, block_start, side='right'), N_EXPERTS - 1)

    def expert_block(args):
        toks, e = args
        xb = xf[toks]
        hb = jax.nn.silu(xb @ w_gate[e]) * (xb @ w_up[e])
        return hb @ w_down[e]

    y_rows = lax.map(expert_block, (row_tok.reshape(n_blocks, MOE_BLOCK), block_expert))
    y_rows = y_rows.reshape(R, D) * row_w[:, None].astype(x.dtype)
    y = jax.ops.segment_sum(y_rows, row_tok, num_segments=N)
    return y.reshape(B, S, D)


def setup_inputs(seed: int = 0) -> dict:
    key = jax.random.key(seed)
    ks = jax.random.split(key, 32)
    nrm = jax.random.normal
    f32 = jnp.float32
    inv = D_MODEL ** -0.5
    positions = jnp.broadcast_to(jnp.arange(SEQ, dtype=jnp.int32)[None, :], (BATCH, SEQ))
    return {
        'x': nrm(ks[0], (BATCH, SEQ, D_MODEL), f32),
        'mem': nrm(ks[1], (BATCH, MEM_LEN, D_MODEL), f32),
        'positions': positions,
        'w_in': nrm(ks[2], (DEPTH, D_MODEL, IN_WIDTH), f32) * inv,
        'attn_sinks': nrm(ks[3], (DEPTH, ATT_HEADS), f32) * 0.5,
        'conv_w': nrm(ks[4], (DEPTH, CONV_WIDTH, 2 * ML_QK_W), f32) * (CONV_WIDTH ** -0.5),
        'conv_b': nrm(ks[5], (DEPTH, 2 * ML_QK_W), f32) * 0.02,
        'b_igate': nrm(ks[6], (DEPTH, ML_HEADS), f32) * 0.1,
        'b_fgate': jnp.linspace(3.0, 6.0, ML_HEADS, dtype=f32)[None, :] + nrm(ks[7], (DEPTH, ML_HEADS), f32) * 0.1,
        'ml_norm_g': 1.0 + nrm(ks[8], (DEPTH, ML_V_W), f32) * 0.02,
        'w_att_branch': nrm(ks[9], (DEPTH, ATT_Q_W, D_MODEL), f32) * (ATT_Q_W ** -0.5),
        'w_ml_branch': nrm(ks[10], (DEPTH, ML_V_W, D_MODEL), f32) * (ML_V_W ** -0.5),
        'w_mix_out': nrm(ks[11], (DEPTH, D_MODEL, D_MODEL), f32) * inv * BETA,
        'ln1_g': 1.0 + nrm(ks[12], (DEPTH, D_MODEL), f32) * 0.02,
        'ln1_b': nrm(ks[13], (DEPTH, D_MODEL), f32) * 0.02,
        'w_xq': nrm(ks[14], (DEPTH, D_MODEL, D_MODEL), f32) * inv,
        'w_xkv': nrm(ks[15], (DEPTH, D_MODEL, 2 * D_MODEL), f32) * inv,
        'w_xo': nrm(ks[16], (DEPTH, D_MODEL, D_MODEL), f32) * inv * BETA,
        'ln2_g': 1.0 + nrm(ks[17], (DEPTH, D_MODEL), f32) * 0.02,
        'ln2_b': nrm(ks[18], (DEPTH, D_MODEL), f32) * 0.02,
        'w_router_group': nrm(ks[19], (DEPTH, D_MODEL, N_GROUPS), f32) * inv,
        'b_router_group': nrm(ks[20], (DEPTH, N_GROUPS), f32) * 0.01,
        'w_router_expert': nrm(ks[21], (DEPTH, D_MODEL, N_EXPERTS), f32) * inv,
        'b_router_expert': nrm(ks[22], (DEPTH, N_EXPERTS), f32) * 0.01,
        'w_gate': nrm(ks[23], (DEPTH, N_EXPERTS, D_MODEL, D_EXPERT), f32) * inv,
        'w_up': nrm(ks[24], (DEPTH, N_EXPERTS, D_MODEL, D_EXPERT), f32) * inv,
        'w_down': nrm(ks[25], (DEPTH, N_EXPERTS, D_EXPERT, D_MODEL), f32) * (D_EXPERT ** -0.5) * BETA,
        'ln3_g': 1.0 + nrm(ks[26], (DEPTH, D_MODEL), f32) * 0.02,
        'ln3_b': nrm(ks[27], (DEPTH, D_MODEL), f32) * 0.02,
    }


def reference(x, mem, positions, w_in, attn_sinks, conv_w, conv_b, b_igate, b_fgate, ml_norm_g,
              w_att_branch, w_ml_branch, w_mix_out, ln1_g, ln1_b, w_xq, w_xkv, w_xo, ln2_g, ln2_b,
              w_router_group, b_router_group, w_router_expert, b_router_expert, w_gate, w_up, w_down,
              ln3_g, ln3_b):
    h = x
    for l in range(DEPTH):
        mix = hybrid_mixer(h, positions, w_in[l], attn_sinks[l], conv_w[l], conv_b[l], b_igate[l], b_fgate[l],
                           ml_norm_g[l], w_att_branch[l], w_ml_branch[l], w_mix_out[l])
        h = layer_norm(ALPHA * h + mix, ln1_g[l], ln1_b[l])
        xa = memory_cross_attention(h, mem, w_xq[l], w_xkv[l], w_xo[l])
        h = layer_norm(ALPHA * h + xa, ln2_g[l], ln2_b[l])
        ff = hierarchical_moe(h, w_router_group[l], b_router_group[l], w_router_expert[l], b_router_expert[l],
                              w_gate[l], w_up[l], w_down[l])
        h = layer_norm(ALPHA * h + ff, ln3_g[l], ln3_b[l])
    return h
```

```cpp
#include <hip/hip_runtime.h>
#include <hip/hip_cooperative_groups.h>
#include <cstdio>
#include <cstdint>
namespace cg = cooperative_groups;

typedef unsigned short bf16_t;
typedef short bf16x8 __attribute__((ext_vector_type(8)));
typedef float f32x4 __attribute__((ext_vector_type(4)));
#define LDS_AS __attribute__((address_space(3)))
#define GLB_AS __attribute__((address_space(1)))

constexpr int T_ = 65536;
constexpr int NTHR = 512;
constexpr size_t MiB = 1ull << 20;
constexpr float ALPHA = 1.189207115002721f;
constexpr size_t OFF_R0 = 0;
constexpr size_t OFF_R1 = 128 * MiB;
constexpr size_t OFF_AK = 256 * MiB;
constexpr size_t OFF_AV = 272 * MiB;
constexpr size_t OFF_MQK = 288 * MiB;
constexpr size_t OFF_MV = 416 * MiB;
constexpr size_t OFF_MO = 544 * MiB;
constexpr size_t OFF_GG = 672 * MiB;
constexpr size_t OFF_WGU = 256 * MiB;
constexpr size_t OFF_WD = 320 * MiB;
constexpr size_t OFF_XQ = 352 * MiB;
constexpr size_t OFF_O = 480 * MiB;
constexpr size_t OFF_Z2 = 608 * MiB;
constexpr size_t OFF_YB = 352 * MiB;
constexpr size_t OFF_MISC = 928 * MiB;
constexpr size_t OFF_WIN = OFF_MISC;
constexpr size_t OFF_WATT = OFF_MISC + 13 * MiB;
constexpr size_t OFF_WML = OFF_MISC + 15 * MiB;
constexpr size_t OFF_WMIX = OFF_MISC + 17 * MiB;
constexpr size_t OFF_WXQ = OFF_MISC + 19 * MiB;
constexpr size_t OFF_WXO = OFF_MISC + 21 * MiB;
constexpr size_t OFF_WXKV = OFF_MISC + 23 * MiB;
constexpr size_t OFF_MEMB = OFF_MISC + 27 * MiB;
constexpr size_t OFF_KVB = OFF_MISC + 35 * MiB;
constexpr size_t OFF_GATES = OFF_MISC + 51 * MiB;
constexpr size_t OFF_CS = OFF_MISC + 53 * MiB;
constexpr size_t OFF_TOKE = OFF_MISC + 69 * MiB;
constexpr size_t OFF_TOKW = OFF_MISC + 70 * MiB;
constexpr size_t OFF_SLOTTOK = OFF_MISC + 71 * MiB;
constexpr size_t OFF_SLOTW = OFF_MISC + 72 * MiB;
constexpr size_t OFF_HIST = OFF_MISC + 73 * MiB;
constexpr size_t WS_NEED = 1024 * MiB;
constexpr int LDS_GEMM = 98304;
constexpr int LDS_BYTES = LDS_GEMM + 1024;

struct Params {
    const float *x, *mem; const int* pos;
    const float *w_in, *sinks, *conv_w, *conv_b, *b_ig, *b_fg, *ml_g, *w_att, *w_ml, *w_mix, *ln1g, *ln1b;
    const float *w_xq, *w_xkv, *w_xo, *ln2g, *ln2b, *w_rg, *b_rg, *w_re, *b_re, *w_gate, *w_up, *w_down, *ln3g, *ln3b;
    float* out; char* ws;
};

__device__ const double INV_FREQ[32] = {1.0, 0.7498942093324559, 0.5623413251903491, 0.4216965034285822, 0.31622776601683794, 0.23713737056616552, 0.1778279410038923, 0.1333521432163324, 0.1, 0.07498942093324558, 0.05623413251903491, 0.042169650342858224, 0.03162277660168379, 0.023713737056616554, 0.01778279410038923, 0.01333521432163324, 0.01, 0.007498942093324558, 0.005623413251903491, 0.004216965034285823, 0.0031622776601683794, 0.0023713737056616554, 0.0017782794100389228, 0.001333521432163324, 0.001, 0.0007498942093324559, 0.0005623413251903491, 0.00042169650342858224, 0.00031622776601683794, 0.00023713737056616554, 0.00017782794100389227, 0.0001333521432163324};

__device__ __forceinline__ unsigned pk_bf16(float lo, float hi) { unsigned r; asm("v_cvt_pk_bf16_f32 %0, %1, %2" : "=v"(r) : "v"(lo), "v"(hi)); return r; }
__device__ __forceinline__ float bf_lo(unsigned u) { return __uint_as_float(u << 16); }
__device__ __forceinline__ float bf_hi(unsigned u) { return __uint_as_float(u & 0xffff0000u); }
__device__ __forceinline__ float bf2f(bf16_t h) { return __uint_as_float(((unsigned)h) << 16); }
__device__ __forceinline__ float wsum(float v) {
#pragma unroll
    for (int o = 32; o; o >>= 1) v += __shfl_xor(v, o);
    return v;
}
__device__ __forceinline__ float wmaxf(float v) {
#pragma unroll
    for (int o = 32; o; o >>= 1) v = fmaxf(v, __shfl_xor(v, o));
    return v;
}
__device__ __forceinline__ float sigmoidf_(float x) { return 1.0f / (1.0f + __expf(-x)); }
__device__ __forceinline__ void glds16(const bf16_t* g, char* l) {
    __builtin_amdgcn_global_load_lds((const GLB_AS void*)g, (LDS_AS void*)l, 16, 0, 0);
}

struct GemmSrc { const bf16_t* a[4]; const bf16_t* b[2]; };

__device__ __forceinline__ void stage_tile(const GemmSrc& s, int koff, char* buf, int tid) {
#pragma unroll
    for (int i = 0; i < 4; ++i) glds16(s.a[i] + koff, buf + (i * 512 + tid) * 16);
#pragma unroll
    for (int i = 0; i < 2; ++i) glds16(s.b[i] + koff, buf + 32768 + (i * 512 + tid) * 16);
}

__device__ __forceinline__ void gemm_loop(f32x4 (&acc)[4][4], const GemmSrc& s, int nk, char* smem, int tid) {
    const int lane = tid & 63, wid = tid >> 6, wr = wid >> 1, wc = wid & 1, fr = lane & 15, fq = lane >> 4;
    const int swz = (fr >> 1) & 7;
    const int aoff = (wr * 64 + fr) * 128;
    const int boff = 32768 + (wc * 64 + fr) * 128;
    stage_tile(s, 0, smem, tid);
    for (int t = 0; t < nk; ++t) {
        asm volatile("s_waitcnt vmcnt(0)" ::: "memory");
        __syncthreads();
        char* cur = smem + (t & 1) * 49152;
        if (t + 1 < nk) stage_tile(s, (t + 1) * 64, smem + ((t + 1) & 1) * 49152, tid);
#pragma unroll
        for (int ks = 0; ks < 2; ++ks) {
            const int ch = ((ks * 4 + fq) ^ swz) * 16;
            bf16x8 xa[4], wb[4];
#pragma unroll
            for (int m = 0; m < 4; ++m) xa[m] = *(const bf16x8*)(cur + aoff + m * 2048 + ch);
#pragma unroll
            for (int n = 0; n < 4; ++n) wb[n] = *(const bf16x8*)(cur + boff + n * 2048 + ch);
#pragma unroll
            for (int m = 0; m < 4; ++m)
#pragma unroll
                for (int n = 0; n < 4; ++n) acc[m][n] = __builtin_amdgcn_mfma_f32_16x16x32_bf16(wb[n], xa[m], acc[m][n], 0, 0, 0);
        }
    }
    __syncthreads();
}

__device__ __forceinline__ void zero_acc(f32x4 (&acc)[4][4]) {
#pragma unroll
    for (int m = 0; m < 4; ++m)
#pragma unroll
        for (int n = 0; n < 4; ++n) acc[m][n] = (f32x4){0.f, 0.f, 0.f, 0.f};
}

__device__ __forceinline__ void make_src(GemmSrc& s, const bf16_t* A, size_t lda, int rowA0, const bf16_t* Bt, size_t ldb, int rowB0, int tid) {
    const int r = tid >> 3, lc = (tid & 7) ^ ((r >> 1) & 7);
#pragma unroll
    for (int i = 0; i < 4; ++i) s.a[i] = A + (size_t)(rowA0 + i * 64 + r) * lda + lc * 8;
#pragma unroll
    for (int i = 0; i < 2; ++i) s.b[i] = Bt + (size_t)(rowB0 + i * 64 + r) * ldb + lc * 8;
}

__device__ __forceinline__ void store_bf16x4(bf16_t* p, f32x4 v) {
    uint2 w; w.x = pk_bf16(v[0], v[1]); w.y = pk_bf16(v[2], v[3]); *(uint2*)p = w;
}

__device__ __forceinline__ void tr_tile(const float* src, size_t ld_src, int k0, int c0, bf16_t* dst, size_t ld_dst, int r0, float* tile, int tid) {
    {
        const int r = tid >> 3, c4 = (tid & 7) * 4;
        const float4 v = *(const float4*)(src + (size_t)(k0 + r) * ld_src + c0 + c4);
        float* tp = tile + r * 33 + c4; tp[0] = v.x; tp[1] = v.y; tp[2] = v.z; tp[3] = v.w;
    }
    __syncthreads();
    {
        const int c = tid >> 4, rc = (tid & 15) * 4;
        const float a0 = tile[(rc + 0) * 33 + c], a1 = tile[(rc + 1) * 33 + c], a2 = tile[(rc + 2) * 33 + c], a3 = tile[(rc + 3) * 33 + c];
        uint2 w; w.x = pk_bf16(a0, a1); w.y = pk_bf16(a2, a3);
        *(uint2*)(dst + (size_t)(r0 + c) * ld_dst + k0 + rc) = w;
    }
    __syncthreads();
}

__device__ void phase0(const Params& p, char* smem) {
    const int tid = threadIdx.x, lane = tid & 63, wid = tid >> 6;
    const int gw = blockIdx.x * 8 + wid, nw = gridDim.x * 8;
    char* ws = p.ws;
    bf16_t* xb = (bf16_t*)(ws + OFF_R0);
    float* gates = (float*)(ws + OFF_GATES);
    for (int row = gw; row < T_; row += nw) {
        const float4* xr = (const float4*)(p.x + (size_t)row * 1024);
        float g0 = 0, g1 = 0, g2 = 0, g3 = 0, g4 = 0, g5 = 0, g6 = 0, g7 = 0;
#pragma unroll
        for (int i = 0; i < 4; ++i) {
            const float4 v = xr[i * 64 + lane];
            uint2 w; w.x = pk_bf16(v.x, v.y); w.y = pk_bf16(v.z, v.w);
            *(uint2*)(xb + (size_t)row * 1024 + i * 256 + lane * 4) = w;
            const float vv[4] = {v.x, v.y, v.z, v.w};
#pragma unroll
            for (int jj = 0; jj < 4; ++jj) {
                const int k = i * 256 + lane * 4 + jj;
                const float4* wp = (const float4*)(p.w_in + (size_t)k * 6408 + 4352);
                const float4 w0 = wp[0], w1 = wp[1];
                g0 += vv[jj] * w0.x; g1 += vv[jj] * w0.y; g2 += vv[jj] * w0.z; g3 += vv[jj] * w0.w;
                g4 += vv[jj] * w1.x; g5 += vv[jj] * w1.y; g6 += vv[jj] * w1.z; g7 += vv[jj] * w1.w;
            }
        }
        g0 = wsum(g0); g1 = wsum(g1); g2 = wsum(g2); g3 = wsum(g3); g4 = wsum(g4); g5 = wsum(g5); g6 = wsum(g6); g7 = wsum(g7);
        if (lane == 0) {
            float4* gp = (float4*)(gates + (size_t)row * 8);
            gp[0] = make_float4(g0, g1, g2, g3); gp[1] = make_float4(g4, g5, g6, g7);
        }
    }
    {
        float2* cs = (float2*)(ws + OFF_CS);
        const int gt = blockIdx.x * NTHR + tid, nt = gridDim.x * NTHR;
        for (int idx = gt; idx < T_ * 32; idx += nt) {
            const int tok = idx >> 5, i = idx & 31;
            const double ang = (double)p.pos[tok] * INV_FREQ[i];
            const double turns = ang * 0.15915494309189535;
            const float f = (float)(turns - rint(turns));
            cs[idx] = make_float2(__builtin_amdgcn_cosf(f), __builtin_amdgcn_sinf(f));
        }
        bf16_t* memb = (bf16_t*)(ws + OFF_MEMB);
        for (int idx = gt; idx < 4096 * 1024 / 4; idx += nt) {
            const float4 v = ((const float4*)p.mem)[idx];
            uint2 w; w.x = pk_bf16(v.x, v.y); w.y = pk_bf16(v.z, v.w);
            ((uint2*)memb)[idx] = w;
        }
    }
    {
        float* tile = (float*)smem;
        const int NT_WIN = 16 * 200, NT_SQ = 16 * 32, NT_XKV = 16 * 64;
        const int total = NT_WIN + 5 * NT_SQ + NT_XKV;
        for (int t = blockIdx.x; t < total; t += gridDim.x) {
            if (t < NT_WIN) {
                const int kt = t & 15, nt_ = t >> 4;
                const int n0 = nt_ * 32, c0 = n0 < 4352 ? n0 : n0 + 8;
                tr_tile(p.w_in, 6408, kt * 64, c0, (bf16_t*)(ws + OFF_WIN), 1024, n0, tile, tid);
            } else if (t < NT_WIN + 5 * NT_SQ) {
                const int u = t - NT_WIN, which = u / NT_SQ, v = u % NT_SQ, kt = v & 15, nt_ = v >> 4;
                const float* src = which == 0 ? p.w_att : which == 1 ? p.w_ml : which == 2 ? p.w_mix : which == 3 ? p.w_xq : p.w_xo;
                bf16_t* dst = (bf16_t*)(ws + OFF_WATT + (size_t)which * 2 * MiB);
                tr_tile(src, 1024, kt * 64, nt_ * 32, dst, 1024, nt_ * 32, tile, tid);
            } else {
                const int v = t - NT_WIN - 5 * NT_SQ, kt = v & 15, nt_ = v >> 4;
                tr_tile(p.w_xkv, 2048, kt * 64, nt_ * 32, (bf16_t*)(ws + OFF_WXKV), 1024, nt_ * 32, tile, tid);
            }
        }
    }
}

__device__ void moe_weight_prep(const Params& p, char* smem) {
    const int tid = threadIdx.x;
    float* tile = (float*)smem;
    char* ws = p.ws;
    const int per_e = 384, total = 64 * per_e;
    for (int t = blockIdx.x; t < total; t += gridDim.x) {
        const int e = t / per_e, u = t % per_e;
        if (u < 256) {
            const int isup = u >> 7, v = u & 127, kt = v & 15, j = v >> 4;
            const float* src = (isup ? p.w_up : p.w_gate) + (size_t)e * 1024 * 256;
            tr_tile(src, 256, kt * 64, j * 32, (bf16_t*)(ws + OFF_WGU) + (size_t)e * 512 * 1024, 1024, j * 64 + isup * 32, tile, tid);
        } else {
            const int v = u - 256, kt = v & 3, nt_ = v >> 2;
            tr_tile(p.w_down + (size_t)e * 256 * 1024, 1024, kt * 64, nt_ * 32, (bf16_t*)(ws + OFF_WD) + (size_t)e * 1024 * 256, 256, nt_ * 32, tile, tid);
        }
    }
}

__device__ void phase1(const Params& p, char* smem) {
    const int tid = threadIdx.x, lane = tid & 63, wid = tid >> 6, wr = wid >> 1, wc = wid & 1, fr = lane & 15, fq = lane >> 4;
    char* ws = p.ws;
    const int NMAIN = 256 * 50, NKV = 16 * 16;
    for (int t = blockIdx.x; t < NMAIN + NKV; t += gridDim.x) {
        GemmSrc s; int rt, ct; const bool main_ = t < NMAIN;
        if (main_) { rt = t / 50; ct = t % 50; make_src(s, (const bf16_t*)(ws + OFF_R0), 1024, rt * 256, (const bf16_t*)(ws + OFF_WIN), 1024, ct * 128, tid); }
        else { const int u = t - NMAIN; rt = u >> 4; ct = u & 15; make_src(s, (const bf16_t*)(ws + OFF_MEMB), 1024, rt * 256, (const bf16_t*)(ws + OFF_WXKV), 1024, ct * 128, tid); }
        f32x4 acc[4][4]; zero_acc(acc);
        gemm_loop(acc, s, 16, smem, tid);
        const int row0 = rt * 256 + wr * 64 + fr;
        const int c0w = ct * 128 + wc * 64;
        if (main_ && c0w < 1152) {
            bf16_t* dst; int ld, cb; float sc;
            if (c0w < 1024) { dst = (bf16_t*)(ws + OFF_R1); ld = 1024; cb = c0w; sc = 0.125f; }
            else { dst = (bf16_t*)(ws + OFF_AK); ld = 128; cb = c0w - 1024; sc = 1.0f; }
            const float* cs = (const float*)(ws + OFF_CS);
#pragma unroll
            for (int m = 0; m < 4; ++m) {
                const int tok = row0 + m * 16;
#pragma unroll
                for (int n = 0; n < 2; ++n) {
                    const int d0 = n * 16 + fq * 4;
                    const float4* cp = (const float4*)(cs + (size_t)tok * 64 + d0 * 2);
                    const float4 c01 = cp[0], c23 = cp[1];
                    const f32x4 x1 = acc[m][n], x2 = acc[m][n + 2];
                    f32x4 o1, o2;
                    o1[0] = (x1[0] * c01.x - x2[0] * c01.y) * sc; o2[0] = (x2[0] * c01.x + x1[0] * c01.y) * sc;
                    o1[1] = (x1[1] * c01.z - x2[1] * c01.w) * sc; o2[1] = (x2[1] * c01.z + x1[1] * c01.w) * sc;
                    o1[2] = (x1[2] * c23.x - x2[2] * c23.y) * sc; o2[2] = (x2[2] * c23.x + x1[2] * c23.y) * sc;
                    o1[3] = (x1[3] * c23.z - x2[3] * c23.w) * sc; o2[3] = (x2[3] * c23.z + x1[3] * c23.w) * sc;
                    bf16_t* rp = dst + (size_t)tok * ld + cb + d0;
                    store_bf16x4(rp, o1); store_bf16x4(rp + 32, o2);
                }
            }
        } else {
            bf16_t* dst; int ld, cb; bool sig = false;
            if (!main_) { dst = (bf16_t*)(ws + OFF_KVB); ld = 2048; cb = c0w; }
            else if (c0w < 1280) { dst = (bf16_t*)(ws + OFF_AV); ld = 128; cb = c0w - 1152; }
            else if (c0w < 2304) { dst = (bf16_t*)(ws + OFF_MQK); ld = 1024; cb = c0w - 1280; }
            else if (c0w < 3328) { dst = (bf16_t*)(ws + OFF_MV); ld = 1024; cb = c0w - 2304; }
            else if (c0w < 4352) { dst = (bf16_t*)(ws + OFF_MO); ld = 1024; cb = c0w - 3328; sig = true; }
            else { dst = (bf16_t*)(ws + OFF_GG); ld = 2048; cb = c0w - 4352; sig = true; }
#pragma unroll
            for (int m = 0; m < 4; ++m) {
                bf16_t* rp = dst + (size_t)(row0 + m * 16) * ld + cb + fq * 4;
#pragma unroll
                for (int n = 0; n < 4; ++n) {
                    f32x4 v = acc[m][n];
                    if (sig) { v[0] = sigmoidf_(v[0]); v[1] = sigmoidf_(v[1]); v[2] = sigmoidf_(v[2]); v[3] = sigmoidf_(v[3]); }
                    store_bf16x4(rp + n * 16, v);
                }
            }
        }
    }
}

__device__ void mlstm_item(const Params& p, char* smem, int item, float* hm_out_f32_unused) {
    (void)hm_out_f32_unused;
    const int tid = threadIdx.x, lane = tid & 63;
    const int b = item >> 2, h = item & 3;
    char* ws = p.ws;
    const bf16_t* mqk = (const bf16_t*)(ws + OFF_MQK);
    const bf16_t* mv = (const bf16_t*)(ws + OFF_MV);
    const bf16_t* mo = (const bf16_t*)(ws + OFF_MO);
    const float* gates = (const float*)(ws + OFF_GATES);
    bf16_t* hm = (bf16_t*)p.out;
    float* qs = (float*)smem;
    float* ks = qs + 16 * 128;
    float* hpart = ks + 16 * 128;
    float* fl = hpart + 2 * 16 * 256;
    float* eil = fl + 16;
    float* denl = eil + 16;
    float* ssq = denl + 16;
    const int e = tid & 255, dh = tid >> 8;
    float C[64];
#pragma unroll
    for (int d = 0; d < 64; ++d) C[d] = 0.f;
    float nreg = 0.f;
    const int cc = tid & 255, tg = tid >> 8;
    const int ccol = cc < 128 ? (h * 128 + cc) : (512 + h * 128 + (cc - 128));
    const float cw0 = p.conv_w[0 * 1024 + ccol], cw1 = p.conv_w[1 * 1024 + ccol], cw2 = p.conv_w[2 * 1024 + ccol], cw3 = p.conv_w[3 * 1024 + ccol];
    const float cbias = p.conv_b[ccol];
    const float big = p.b_ig[h], bfg = p.b_fg[h];
    const float gnorm = p.ml_g[h * 256 + e];
    const size_t tokb = (size_t)b * 4096;
    for (int t0 = 0; t0 < 4096; t0 += 16) {
        {
            const int ts = t0 + tg * 8;
            float r[11];
#pragma unroll
            for (int i = 0; i < 11; ++i) { const int tt = ts - 3 + i; r[i] = tt >= 0 ? bf2f(mqk[(tokb + tt) * 1024 + ccol]) : 0.f; }
#pragma unroll
            for (int i = 0; i < 8; ++i) {
                float v = cw0 * r[i] + cw1 * r[i + 1] + cw2 * r[i + 2] + cw3 * r[i + 3] + cbias;
                v = v * sigmoidf_(v);
                if (cc < 128) qs[(tg * 8 + i) * 128 + cc] = v; else ks[(tg * 8 + i) * 128 + (cc - 128)] = v * 0.08838834764831845f;
            }
        }
        if (tid < 16) {
            const size_t tok = tokb + t0 + tid;
            const float mi = gates[tok * 8 + h] + big, mf = gates[tok * 8 + 4 + h] + bfg;
            fl[tid] = sigmoidf_(mf); eil[tid] = __expf(mi); denl[tid] = 0.f; ssq[tid] = 0.f;
        }
        float vv[16];
#pragma unroll
        for (int tt = 0; tt < 16; ++tt) vv[tt] = bf2f(mv[(tokb + t0 + tt) * 1024 + h * 256 + e]);
        __syncthreads();
#pragma unroll 1
        for (int tt = 0; tt < 16; ++tt) {
            const float f = fl[tt], ei = eil[tt], eiv = ei * vv[tt];
            const float4* kp = (const float4*)(ks + tt * 128 + dh * 64);
            const float4* qp = (const float4*)(qs + tt * 128 + dh * 64);
            float hp = 0.f;
#pragma unroll
            for (int d4 = 0; d4 < 16; ++d4) {
                const float4 kk = kp[d4], qq = qp[d4];
                C[d4 * 4 + 0] = f * C[d4 * 4 + 0] + eiv * kk.x; hp += qq.x * C[d4 * 4 + 0];
                C[d4 * 4 + 1] = f * C[d4 * 4 + 1] + eiv * kk.y; hp += qq.y * C[d4 * 4 + 1];
                C[d4 * 4 + 2] = f * C[d4 * 4 + 2] + eiv * kk.z; hp += qq.z * C[d4 * 4 + 2];
                C[d4 * 4 + 3] = f * C[d4 * 4 + 3] + eiv * kk.w; hp += qq.w * C[d4 * 4 + 3];
            }
            hpart[(dh * 16 + tt) * 256 + e] = hp;
            if (tid < 128) {
                nreg = f * nreg + ei * ks[tt * 128 + tid];
                const float part = wsum(qs[tt * 128 + tid] * nreg);
                if (lane == 0) atomicAdd(&denl[tt], part);
            }
        }
        __syncthreads();
        float hv[8];
#pragma unroll
        for (int i = 0; i < 8; ++i) {
            const int tt = dh * 8 + i;
            const float num = hpart[tt * 256 + e] + hpart[(16 + tt) * 256 + e];
            const float den = denl[tt];
            hv[i] = num / fmaxf(fabsf(den), 1.0f);
            const float sq = wsum(hv[i] * hv[i]);
            if (lane == 0) atomicAdd(&ssq[tt], sq);
        }
        __syncthreads();
#pragma unroll
        for (int i = 0; i < 8; ++i) {
            const int tt = dh * 8 + i;
            const size_t tok = tokb + t0 + tt;
            const float rstd = rsqrtf(ssq[tt] * (1.0f / 256.0f) + 1e-6f);
            const float og = bf2f(mo[tok * 1024 + h * 256 + e]);
            const float o = hv[i] * rstd * gnorm * og;
            hm[tok * 1024 + h * 256 + e] = (bf16_t)(pk_bf16(o, o) & 0xffffu);
        }
        __syncthreads();
    }
}

__device__ void swa_items(const Params& p, int gw, int nw) {
    const int lane = threadIdx.x & 63;
    char* ws = p.ws;
    const bf16_t* aq = (const bf16_t*)(ws + OFF_R1);
    const bf16_t* ak = (const bf16_t*)(ws + OFF_AK);
    const bf16_t* av = (const bf16_t*)(ws + OFF_AV);
    bf16_t* ao = (bf16_t*)(ws + OFF_R0);
    for (int item = gw; item < T_ * 16; item += nw) {
        const int tok = item >> 4, hq = item & 15, kvh = hq >> 3;
        const int s = tok & 4095;
        const float q = bf2f(aq[(size_t)tok * 1024 + hq * 64 + lane]);
        float sc0 = -INFINITY, sc1 = -INFINITY;
        const bool v0 = (s - lane) >= 0, v1 = (s - 64 - lane) >= 0;
        const uint4* k0p = (const uint4*)(ak + (size_t)(tok - (v0 ? lane : 0)) * 128 + kvh * 64);
        const uint4* k1p = (const uint4*)(ak + (size_t)(tok - (v1 ? 64 + lane : 0)) * 128 + kvh * 64);
        float a0 = 0.f, a1 = 0.f;
#pragma unroll
        for (int c = 0; c < 8; ++c) {
            const uint4 ka = k0p[c], kb = k1p[c];
            const unsigned kaw[4] = {ka.x, ka.y, ka.z, ka.w}, kbw[4] = {kb.x, kb.y, kb.z, kb.w};
#pragma unroll
            for (int w = 0; w < 4; ++w) {
                const float q0 = __shfl(q, c * 8 + w * 2), q1 = __shfl(q, c * 8 + w * 2 + 1);
                a0 += q0 * bf_lo(kaw[w]) + q1 * bf_hi(kaw[w]);
                a1 += q0 * bf_lo(kbw[w]) + q1 * bf_hi(kbw[w]);
            }
        }
        if (v0) sc0 = a0;
        if (v1) sc1 = a1;
        const float sink = p.sinks[hq];
        const float m = fmaxf(wmaxf(fmaxf(sc0, sc1)), sink);
        const float e0 = v0 ? __expf(sc0 - m) : 0.f, e1 = v1 ? __expf(sc1 - m) : 0.f;
        const float den = wsum(e0 + e1) + __expf(sink - m);
        const float inv = 1.0f / den;
        const float p0 = e0 * inv, p1 = e1 * inv;
        float o = 0.f;
        const int nkeys = s + 1 < 128 ? s + 1 : 128;
        for (int j = 0; j < nkeys; ++j) {
            const float pj = j < 64 ? __shfl(p0, j) : __shfl(p1, j - 64);
            o += pj * bf2f(av[(size_t)(tok - j) * 128 + kvh * 64 + lane]);
        }
        ao[(size_t)tok * 1024 + hq * 64 + lane] = (bf16_t)(pk_bf16(o, o) & 0xffffu);
    }
}

__device__ void phase2(const Params& p, char* smem) {
    const int wid = threadIdx.x >> 6;
    const int G = gridDim.x;
    if (G > 64) {
        if (blockIdx.x < 64) mlstm_item(p, smem, blockIdx.x, nullptr);
        else swa_items(p, (blockIdx.x - 64) * 8 + wid, (G - 64) * 8);
    } else {
        for (int it = blockIdx.x; it < 64; it += G) mlstm_item(p, smem, it, nullptr);
        swa_items(p, blockIdx.x * 8 + wid, G * 8);
    }
}

__device__ void phase3(const Params& p, char* smem) {
    const int tid = threadIdx.x, lane = tid & 63, wid = tid >> 6, wr = wid >> 1, wc = wid & 1, fr = lane & 15, fq = lane >> 4;
    char* ws = p.ws;
    const bf16_t* gg = (const bf16_t*)(ws + OFF_GG);
    bf16_t* y = (bf16_t*)(ws + OFF_R1);
    for (int t = blockIdx.x; t < 256 * 8; t += gridDim.x) {
        const int rt = t >> 3, ct = t & 7;
        GemmSrc s;
        f32x4 acca[4][4], accm[4][4]; zero_acc(acca); zero_acc(accm);
        make_src(s, (const bf16_t*)(ws + OFF_R0), 1024, rt * 256, (const bf16_t*)(ws + OFF_WATT), 1024, ct * 128, tid);
        gemm_loop(acca, s, 16, smem, tid);
        make_src(s, (const bf16_t*)p.out, 1024, rt * 256, (const bf16_t*)(ws + OFF_WML), 1024, ct * 128, tid);
        gemm_loop(accm, s, 16, smem, tid);
        const int row0 = rt * 256 + wr * 64 + fr, col0 = ct * 128 + wc * 64 + fq * 4;
#pragma unroll
        for (int m = 0; m < 4; ++m) {
            const size_t tok = row0 + m * 16;
#pragma unroll
            for (int n = 0; n < 4; ++n) {
                const int col = col0 + n * 16;
                const uint2 ga = *(const uint2*)(gg + tok * 2048 + col), gm = *(const uint2*)(gg + tok * 2048 + 1024 + col);
                f32x4 v;
                v[0] = bf_lo(ga.x) * acca[m][n][0] + bf_lo(gm.x) * accm[m][n][0];
                v[1] = bf_hi(ga.x) * acca[m][n][1] + bf_hi(gm.x) * accm[m][n][1];
                v[2] = bf_lo(ga.y) * acca[m][n][2] + bf_lo(gm.y) * accm[m][n][2];
                v[3] = bf_hi(ga.y) * acca[m][n][3] + bf_hi(gm.y) * accm[m][n][3];
                store_bf16x4(y + tok * 1024 + col, v);
            }
        }
    }
}

__device__ void phase_gemm_resid(const Params& p, char* smem, const bf16_t* A, const bf16_t* Bt, const float* resid, float* outz) {
    const int tid = threadIdx.x, lane = tid & 63, wid = tid >> 6, wr = wid >> 1, wc = wid & 1, fr = lane & 15, fq = lane >> 4;
    for (int t = blockIdx.x; t < 256 * 8; t += gridDim.x) {
        const int rt = t >> 3, ct = t & 7;
        GemmSrc s; f32x4 acc[4][4]; zero_acc(acc);
        make_src(s, A, 1024, rt * 256, Bt, 1024, ct * 128, tid);
        gemm_loop(acc, s, 16, smem, tid);
        const int row0 = rt * 256 + wr * 64 + fr, col0 = ct * 128 + wc * 64 + fq * 4;
#pragma unroll
        for (int m = 0; m < 4; ++m) {
            const size_t tok = row0 + m * 16;
#pragma unroll
            for (int n = 0; n < 4; ++n) {
                const int col = col0 + n * 16;
                const float4 r = *(const float4*)(resid + tok * 1024 + col);
                float4 o; o.x = ALPHA * r.x + acc[m][n][0]; o.y = ALPHA * r.y + acc[m][n][1]; o.z = ALPHA * r.z + acc[m][n][2]; o.w = ALPHA * r.w + acc[m][n][3];
                *(float4*)(outz + tok * 1024 + col) = o;
            }
        }
    }
}

__device__ void phase_gemm_bf16(const Params& p, char* smem, const bf16_t* A, const bf16_t* Bt, bf16_t* outb, float scale) {
    const int tid = threadIdx.x, lane = tid & 63, wid = tid >> 6, wr = wid >> 1, wc = wid & 1, fr = lane & 15, fq = lane >> 4;
    for (int t = blockIdx.x; t < 256 * 8; t += gridDim.x) {
        const int rt = t >> 3, ct = t & 7;
        GemmSrc s; f32x4 acc[4][4]; zero_acc(acc);
        make_src(s, A, 1024, rt * 256, Bt, 1024, ct * 128, tid);
        gemm_loop(acc, s, 16, smem, tid);
        const int row0 = rt * 256 + wr * 64 + fr, col0 = ct * 128 + wc * 64 + fq * 4;
#pragma unroll
        for (int m = 0; m < 4; ++m) {
            const size_t tok = row0 + m * 16;
#pragma unroll
            for (int n = 0; n < 4; ++n) store_bf16x4(outb + tok * 1024 + col0 + n * 16, acc[m][n] * scale);
        }
    }
}

__device__ __forceinline__ void ln_row(float4 (&v)[4], const float* g, const float* bta, int lane) {
    float s = 0.f;
#pragma unroll
    for (int i = 0; i < 4; ++i) s += (v[i].x + v[i].y) + (v[i].z + v[i].w);
    const float mu = wsum(s) * (1.0f / 1024.0f);
    float q = 0.f;
#pragma unroll
    for (int i = 0; i < 4; ++i) { const float a = v[i].x - mu, b = v[i].y - mu, c = v[i].z - mu, d = v[i].w - mu; q += (a * a + b * b) + (c * c + d * d); }
    const float rstd = rsqrtf(wsum(q) * (1.0f / 1024.0f) + 1e-5f);
#pragma unroll
    for (int i = 0; i < 4; ++i) {
        const float4 gg = *(const float4*)(g + i * 256 + lane * 4), bb = *(const float4*)(bta + i * 256 + lane * 4);
        v[i].x = (v[i].x - mu) * rstd * gg.x + bb.x; v[i].y = (v[i].y - mu) * rstd * gg.y + bb.y;
        v[i].z = (v[i].z - mu) * rstd * gg.z + bb.z; v[i].w = (v[i].w - mu) * rstd * gg.w + bb.w;
    }
}

__device__ void phase_ln1(const Params& p) {
    const int lane = threadIdx.x & 63, wid = threadIdx.x >> 6;
    float* z = p.out; bf16_t* hb = (bf16_t*)(p.ws + OFF_R0);
    for (int row = blockIdx.x * 8 + wid; row < T_; row += gridDim.x * 8) {
        float4 v[4];
#pragma unroll
        for (int i = 0; i < 4; ++i) v[i] = *(const float4*)(z + (size_t)row * 1024 + i * 256 + lane * 4);
        ln_row(v, p.ln1g, p.ln1b, lane);
#pragma unroll
        for (int i = 0; i < 4; ++i) {
            *(float4*)(z + (size_t)row * 1024 + i * 256 + lane * 4) = v[i];
            uint2 w; w.x = pk_bf16(v[i].x, v[i].y); w.y = pk_bf16(v[i].z, v[i].w);
            *(uint2*)(hb + (size_t)row * 1024 + i * 256 + lane * 4) = w;
        }
    }
}

__device__ void phase6(const Params& p, char* smem) {
    const int lane = threadIdx.x & 63, wid = threadIdx.x >> 6;
    char* ws = p.ws;
    const bf16_t* xq = (const bf16_t*)(ws + OFF_XQ);
    const bf16_t* kvb = (const bf16_t*)(ws + OFF_KVB);
    bf16_t* o = (bf16_t*)(ws + OFF_O);
    float* qs = (float*)smem + wid * 512;
    float* ps = qs + 256;
    for (int item = blockIdx.x * 8 + wid; item < T_ * 4; item += gridDim.x * 8) {
        const int tok = item >> 2, h = item & 3, b = tok >> 12;
        {
            const uint2 qv = *(const uint2*)(xq + (size_t)tok * 1024 + h * 256 + lane * 4);
            *(float4*)(qs + lane * 4) = make_float4(bf_lo(qv.x), bf_hi(qv.x), bf_lo(qv.y), bf_hi(qv.y));
        }
        __builtin_amdgcn_wave_barrier();
        float sc[4];
#pragma unroll
        for (int i = 0; i < 4; ++i) {
            const int j = i * 64 + lane;
            const uint4* kp = (const uint4*)(kvb + (size_t)(b * 256 + j) * 2048 + h * 256);
            float a = 0.f;
#pragma unroll 4
            for (int c = 0; c < 32; ++c) {
                const uint4 kk = kp[c];
                const float4 q0 = *(const float4*)(qs + c * 8), q1 = *(const float4*)(qs + c * 8 + 4);
                a += q0.x * bf_lo(kk.x) + q0.y * bf_hi(kk.x) + q0.z * bf_lo(kk.y) + q0.w * bf_hi(kk.y)
                   + q1.x * bf_lo(kk.z) + q1.y * bf_hi(kk.z) + q1.z * bf_lo(kk.w) + q1.w * bf_hi(kk.w);
            }
            sc[i] = a;
        }
        const float m = wmaxf(fmaxf(fmaxf(sc[0], sc[1]), fmaxf(sc[2], sc[3])));
        float es = 0.f;
#pragma unroll
        for (int i = 0; i < 4; ++i) { sc[i] = __expf(sc[i] - m); es += sc[i]; }
        const float inv = 1.0f / wsum(es);
#pragma unroll
        for (int i = 0; i < 4; ++i) ps[i * 64 + lane] = sc[i] * inv;
        __builtin_amdgcn_wave_barrier();
        float o0 = 0.f, o1 = 0.f, o2 = 0.f, o3 = 0.f;
        const bf16_t* vp = kvb + (size_t)(b * 256) * 2048 + 1024 + h * 256 + lane * 4;
#pragma unroll 4
        for (int j = 0; j < 256; ++j) {
            const float pj = ps[j];
            const uint2 vv = *(const uint2*)(vp + (size_t)j * 2048);
            o0 += pj * bf_lo(vv.x); o1 += pj * bf_hi(vv.x); o2 += pj * bf_lo(vv.y); o3 += pj * bf_hi(vv.y);
        }
        uint2 w; w.x = pk_bf16(o0, o1); w.y = pk_bf16(o2, o3);
        *(uint2*)(o + (size_t)tok * 1024 + h * 256 + lane * 4) = w;
        __builtin_amdgcn_wave_barrier();
    }
}

__device__ void phase_ln2_router(const Params& p, char* smem) {
    const int tid = threadIdx.x, lane = tid & 63, wid = tid >> 6;
    char* ws = p.ws;
    float* z = (float*)(ws + OFF_Z2); bf16_t* hb = (bf16_t*)(ws + OFF_R0);
    int2* toke = (int2*)(ws + OFF_TOKE); float2* tokw = (float2*)(ws + OFF_TOKW);
    int* histg = (int*)(ws + OFF_HIST);
    int* hist = (int*)smem;
    for (int c = blockIdx.x; c < 256; c += gridDim.x) {
        if (tid < 64) hist[tid] = 0;
        __syncthreads();
        for (int rr = 0; rr < 32; ++rr) {
            const int row = c * 256 + wid * 32 + rr;
            float4 v[4];
#pragma unroll
            for (int i = 0; i < 4; ++i) v[i] = *(const float4*)(z + (size_t)row * 1024 + i * 256 + lane * 4);
            ln_row(v, p.ln2g, p.ln2b, lane);
#pragma unroll
            for (int i = 0; i < 4; ++i) {
                *(float4*)(z + (size_t)row * 1024 + i * 256 + lane * 4) = v[i];
                uint2 w; w.x = pk_bf16(v[i].x, v[i].y); w.y = pk_bf16(v[i].z, v[i].w);
                *(uint2*)(hb + (size_t)row * 1024 + i * 256 + lane * 4) = w;
            }
            float g[8];
#pragma unroll
            for (int k = 0; k < 8; ++k) g[k] = 0.f;
#pragma unroll
            for (int i = 0; i < 4; ++i) {
                const float vv[4] = {v[i].x, v[i].y, v[i].z, v[i].w};
#pragma unroll
                for (int jj = 0; jj < 4; ++jj) {
                    const float4* wp = (const float4*)(p.w_rg + (size_t)(i * 256 + lane * 4 + jj) * 8);
                    const float4 w0 = wp[0], w1 = wp[1];
                    g[0] += vv[jj] * w0.x; g[1] += vv[jj] * w0.y; g[2] += vv[jj] * w0.z; g[3] += vv[jj] * w0.w;
                    g[4] += vv[jj] * w1.x; g[5] += vv[jj] * w1.y; g[6] += vv[jj] * w1.z; g[7] += vv[jj] * w1.w;
                }
            }
            float gmax = -INFINITY; int gsel = 0;
#pragma unroll
            for (int k = 0; k < 8; ++k) { g[k] = wsum(g[k]) + p.b_rg[k]; if (g[k] > gmax) { gmax = g[k]; gsel = k; } }
            float gs = 0.f;
#pragma unroll
            for (int k = 0; k < 8; ++k) gs += __expf(g[k] - gmax);
            const float pgroup = 1.0f / gs;
            gsel = __builtin_amdgcn_readfirstlane(gsel);
            float ex[8];
#pragma unroll
            for (int k = 0; k < 8; ++k) ex[k] = 0.f;
#pragma unroll
            for (int i = 0; i < 4; ++i) {
                const float vv[4] = {v[i].x, v[i].y, v[i].z, v[i].w};
#pragma unroll
                for (int jj = 0; jj < 4; ++jj) {
                    const float4* wp = (const float4*)(p.w_re + (size_t)(i * 256 + lane * 4 + jj) * 64 + gsel * 8);
                    const float4 w0 = wp[0], w1 = wp[1];
                    ex[0] += vv[jj] * w0.x; ex[1] += vv[jj] * w0.y; ex[2] += vv[jj] * w0.z; ex[3] += vv[jj] * w0.w;
                    ex[4] += vv[jj] * w1.x; ex[5] += vv[jj] * w1.y; ex[6] += vv[jj] * w1.z; ex[7] += vv[jj] * w1.w;
                }
            }
            float v0 = -INFINITY, v1 = -INFINITY; int i0 = 0, i1 = 0;
#pragma unroll
            for (int k = 0; k < 8; ++k) {
                const float lv = wsum(ex[k]) + p.b_re[gsel * 8 + k];
                if (lv > v0) { v1 = v0; i1 = i0; v0 = lv; i0 = k; }
                else if (lv > v1) { v1 = lv; i1 = k; }
            }
            const float e1 = __expf(v1 - v0), den = 1.0f + e1;
            const float w0 = pgroup / den, w1 = pgroup * e1 / den;
            if (lane == 0) {
                const int ea = gsel * 8 + i0, eb = gsel * 8 + i1;
                toke[row] = make_int2(ea, eb); tokw[row] = make_float2(w0, w1);
                atomicAdd(&hist[ea], 1); atomicAdd(&hist[eb], 1);
            }
        }
        __syncthreads();
        if (tid < 64) histg[c * 64 + tid] = hist[tid];
        __syncthreads();
    }
}

__device__ void compute_segments(const int* histg, int* seg, int tid) {
    if (tid < 64) {
        int s = 0;
        for (int c = 0; c < 256; ++c) s += histg[c * 64 + tid];
        seg[tid] = s;
    }
    __syncthreads();
    if (tid == 0) {
        int acc = 0;
        for (int e = 0; e < 64; ++e) { seg[64 + e] = acc; acc += (seg[e] + 255) >> 8; }
        seg[128] = acc;
    }
    __syncthreads();
}

__device__ void phase8(const Params& p, char* smem) {
    const int tid = threadIdx.x;
    char* ws = p.ws;
    const int* histg = (const int*)(ws + OFF_HIST);
    const int2* toke = (const int2*)(ws + OFF_TOKE); const float2* tokw = (const float2*)(ws + OFF_TOKW);
    int* slot_tok = (int*)(ws + OFF_SLOTTOK); float* slot_w = (float*)(ws + OFF_SLOTW);
    int* seg = (int*)smem;
    int* cursor = seg + 192;
    compute_segments(histg, seg, tid);
    for (int e = blockIdx.x; e < 64; e += gridDim.x) {
        const int start = seg[64 + e] * 256 + seg[e], end = seg[64 + e + 1] * 256;
        for (int s = start + tid; s < end; s += NTHR) { slot_tok[s] = -1; slot_w[s] = 0.f; }
    }
    for (int c = blockIdx.x; c < 256; c += gridDim.x) {
        __syncthreads();
        if (tid < 64) {
            int base = 0;
            for (int cc = 0; cc < c; ++cc) base += histg[cc * 64 + tid];
            cursor[tid] = seg[64 + tid] * 256 + base;
        }
        __syncthreads();
        if (tid < 256) {
            const int tok = c * 256 + tid;
            const int2 ee = toke[tok]; const float2 ww = tokw[tok];
            const int s0 = atomicAdd(&cursor[ee.x], 1);
            const int s1 = atomicAdd(&cursor[ee.y], 1);
            slot_tok[s0] = tok * 2; slot_w[s0] = ww.x;
            slot_tok[s1] = tok * 2 + 1; slot_w[s1] = ww.y;
        }
    }
}

__device__ void phase9a(const Params& p, char* smem) {
    const int tid = threadIdx.x, lane = tid & 63, wid = tid >> 6, wr = wid >> 1, wc = wid & 1, fr = lane & 15, fq = lane >> 4;
    char* ws = p.ws;
    int* seg = (int*)(smem + LDS_GEMM);
    compute_segments((const int*)(ws + OFF_HIST), seg, tid);
    const int nrt = seg[128];
    const int* slot_tok = (const int*)(ws + OFF_SLOTTOK);
    const bf16_t* h2b = (const bf16_t*)(ws + OFF_R0);
    bf16_t* hbuf = (bf16_t*)(ws + OFF_R1);
    for (int t = blockIdx.x; t < nrt * 4; t += gridDim.x) {
        const int rtile = t >> 2, nt = t & 3;
        int e = 0;
        for (int k = 1; k < 64; ++k) if (seg[64 + k] <= rtile) e = k;
        GemmSrc s;
        {
            const int r = tid >> 3, lc = (tid & 7) ^ ((r >> 1) & 7);
#pragma unroll
            for (int i = 0; i < 4; ++i) {
                const int tk = slot_tok[rtile * 256 + i * 64 + r];
                const int tok = tk < 0 ? 0 : (tk >> 1);
                s.a[i] = h2b + (size_t)tok * 1024 + lc * 8;
            }
#pragma unroll
            for (int i = 0; i < 2; ++i) s.b[i] = (const bf16_t*)(ws + OFF_WGU) + (size_t)e * 512 * 1024 + (size_t)(nt * 128 + i * 64 + r) * 1024 + lc * 8;
        }
        f32x4 acc[4][4]; zero_acc(acc);
        gemm_loop(acc, s, 16, smem, tid);
        const int row0 = rtile * 256 + wr * 64 + fr;
        const int colb = (nt * 2 + wc) * 32 + fq * 4;
#pragma unroll
        for (int m = 0; m < 4; ++m) {
            const size_t slot = row0 + m * 16;
#pragma unroll
            for (int n = 0; n < 2; ++n) {
                const f32x4 g = acc[m][n], u = acc[m][n + 2];
                f32x4 v;
#pragma unroll
                for (int j = 0; j < 4; ++j) v[j] = g[j] * sigmoidf_(g[j]) * u[j];
                store_bf16x4(hbuf + slot * 256 + colb + n * 16, v);
            }
        }
    }
}

__device__ void phase9b(const Params& p, char* smem) {
    const int tid = threadIdx.x, lane = tid & 63, wid = tid >> 6, wr = wid >> 1, wc = wid & 1, fr = lane & 15, fq = lane >> 4;
    char* ws = p.ws;
    int* seg = (int*)(smem + LDS_GEMM);
    compute_segments((const int*)(ws + OFF_HIST), seg, tid);
    const int nrt = seg[128];
    const int* slot_tok = (const int*)(ws + OFF_SLOTTOK); const float* slot_w = (const float*)(ws + OFF_SLOTW);
    const bf16_t* hbuf = (const bf16_t*)(ws + OFF_R1);
    bf16_t* yb = (bf16_t*)(ws + OFF_YB);
    for (int t = blockIdx.x; t < nrt * 8; t += gridDim.x) {
        const int rtile = t >> 3, nt = t & 7;
        int e = 0;
        for (int k = 1; k < 64; ++k) if (seg[64 + k] <= rtile) e = k;
        GemmSrc s;
        make_src(s, hbuf, 256, rtile * 256, (const bf16_t*)(ws + OFF_WD) + (size_t)e * 1024 * 256, 256, nt * 128, tid);
        f32x4 acc[4][4]; zero_acc(acc);
        gemm_loop(acc, s, 4, smem, tid);
        const int row0 = rtile * 256 + wr * 64 + fr, col0 = nt * 128 + wc * 64 + fq * 4;
#pragma unroll
        for (int m = 0; m < 4; ++m) {
            const int slot = row0 + m * 16;
            const int tk = slot_tok[slot]; const float w = slot_w[slot];
            if (tk >= 0) {
#pragma unroll
                for (int n = 0; n < 4; ++n) store_bf16x4(yb + (size_t)tk * 1024 + col0 + n * 16, acc[m][n] * w);
            }
        }
    }
}

__device__ void phase10(const Params& p) {
    const int lane = threadIdx.x & 63, wid = threadIdx.x >> 6;
    const float* h2 = (const float*)(p.ws + OFF_Z2); const bf16_t* yb = (const bf16_t*)(p.ws + OFF_YB);
    for (int row = blockIdx.x * 8 + wid; row < T_; row += gridDim.x * 8) {
        float4 v[4];
#pragma unroll
        for (int i = 0; i < 4; ++i) {
            const float4 hh = *(const float4*)(h2 + (size_t)row * 1024 + i * 256 + lane * 4);
            const uint2 a = *(const uint2*)(yb + (size_t)(row * 2) * 1024 + i * 256 + lane * 4), b = *(const uint2*)(yb + (size_t)(row * 2 + 1) * 1024 + i * 256 + lane * 4);
            v[i].x = ALPHA * hh.x + bf_lo(a.x) + bf_lo(b.x); v[i].y = ALPHA * hh.y + bf_hi(a.x) + bf_hi(b.x);
            v[i].z = ALPHA * hh.z + bf_lo(a.y) + bf_lo(b.y); v[i].w = ALPHA * hh.w + bf_hi(a.y) + bf_hi(b.y);
        }
        ln_row(v, p.ln3g, p.ln3b, lane);
#pragma unroll
        for (int i = 0; i < 4; ++i) *(float4*)(p.out + (size_t)row * 1024 + i * 256 + lane * 4) = v[i];
    }
}

__global__ void __launch_bounds__(NTHR) mega(Params p) {
    extern __shared__ __attribute__((aligned(16))) char smem[];
    cg::grid_group grid = cg::this_grid();
    char* ws = p.ws;
    phase0(p, smem);
    grid.sync();
    phase1(p, smem);
    grid.sync();
    phase2(p, smem);
    grid.sync();
    phase3(p, smem);
    grid.sync();
    phase_gemm_resid(p, smem, (const bf16_t*)(ws + OFF_R1), (const bf16_t*)(ws + OFF_WMIX), p.x, p.out);
    grid.sync();
    phase_ln1(p);
    moe_weight_prep(p, smem);
    grid.sync();
    phase_gemm_bf16(p, smem, (const bf16_t*)(ws + OFF_R0), (const bf16_t*)(ws + OFF_WXQ), (bf16_t*)(ws + OFF_XQ), 0.0625f);
    grid.sync();
    phase6(p, smem);
    grid.sync();
    phase_gemm_resid(p, smem, (const bf16_t*)(ws + OFF_O), (const bf16_t*)(ws + OFF_WXO), p.out, (float*)(ws + OFF_Z2));
    grid.sync();
    phase_ln2_router(p, smem);
    grid.sync();
    phase8(p, smem);
    grid.sync();
    phase9a(p, smem);
    grid.sync();
    phase9b(p, smem);
    grid.sync();
    phase10(p);
}

extern "C" void kernel_launch(void* const* d_in, const int* in_sizes, int n_in, void* d_out, int out_size,
                              void* d_ws, size_t ws_size, hipStream_t stream) {
    static int grid_blocks = 0;
    if (!grid_blocks) {
        int dev = 0, cus = 0, per_cu = 0;
        (void)hipGetDevice(&dev);
        (void)hipDeviceGetAttribute(&cus, hipDeviceAttributeMultiprocessorCount, dev);
        (void)hipFuncSetAttribute((const void*)mega, hipFuncAttributeMaxDynamicSharedMemorySize, LDS_BYTES);
        (void)hipOccupancyMaxActiveBlocksPerMultiprocessor(&per_cu, mega, NTHR, LDS_BYTES);
        if (per_cu > 1) per_cu = 1;
        grid_blocks = cus * per_cu;
        if (ws_size < WS_NEED) fprintf(stderr, "workspace too small: %zu\n", ws_size);
    }
    Params p{};
    const float* const* f = (const float* const*)d_in;
    p.x = f[0]; p.mem = f[1]; p.pos = (const int*)d_in[2];
    p.w_in = f[3]; p.sinks = f[4]; p.conv_w = f[5]; p.conv_b = f[6]; p.b_ig = f[7]; p.b_fg = f[8]; p.ml_g = f[9];
    p.w_att = f[10]; p.w_ml = f[11]; p.w_mix = f[12]; p.ln1g = f[13]; p.ln1b = f[14];
    p.w_xq = f[15]; p.w_xkv = f[16]; p.w_xo = f[17]; p.ln2g = f[18]; p.ln2b = f[19];
    p.w_rg = f[20]; p.b_rg = f[21]; p.w_re = f[22]; p.b_re = f[23]; p.w_gate = f[24]; p.w_up = f[25]; p.w_down = f[26];
    p.ln3g = f[27]; p.ln3b = f[28];
    p.out = (float*)d_out; p.ws = (char*)d_ws;
    void* args[] = {&p};
    hipError_t e = hipLaunchCooperativeKernel((void*)mega, dim3(grid_blocks), dim3(NTHR), args, LDS_BYTES, stream);
    if (e != hipSuccess) fprintf(stderr, "cooperative launch failed: %s (grid %d)\n", hipGetErrorString(e), grid_blocks);
}
```

```cpp
#include <hip/hip_runtime.h>
#include <hip/hip_cooperative_groups.h>
#include <cstdio>
#include <cstdint>
namespace cg = cooperative_groups;

typedef unsigned short bf16_t;
typedef short bf16x8 __attribute__((ext_vector_type(8)));
typedef float f32x4 __attribute__((ext_vector_type(4)));
#define LDS_AS __attribute__((address_space(3)))
#define GLB_AS __attribute__((address_space(1)))

constexpr int T_ = 65536;
constexpr int NTHR = 512;
constexpr size_t MiB = 1ull << 20;
constexpr float ALPHA = 1.189207115002721f;
constexpr size_t OFF_R0 = 0;
constexpr size_t OFF_R1 = 128 * MiB;
constexpr size_t OFF_AK = 256 * MiB;
constexpr size_t OFF_AV = 272 * MiB;
constexpr size_t OFF_MQK = 288 * MiB;
constexpr size_t OFF_MV = 416 * MiB;
constexpr size_t OFF_MO = 544 * MiB;
constexpr size_t OFF_GG = 672 * MiB;
constexpr size_t OFF_WGU = 256 * MiB;
constexpr size_t OFF_WD = 320 * MiB;
constexpr size_t OFF_XQ = 352 * MiB;
constexpr size_t OFF_O = 480 * MiB;
constexpr size_t OFF_Z2 = 608 * MiB;
constexpr size_t OFF_YB = 352 * MiB;
constexpr size_t OFF_MISC = 928 * MiB;
constexpr size_t OFF_WIN = OFF_MISC;
constexpr size_t OFF_WATT = OFF_MISC + 13 * MiB;
constexpr size_t OFF_WML = OFF_MISC + 15 * MiB;
constexpr size_t OFF_WMIX = OFF_MISC + 17 * MiB;
constexpr size_t OFF_WXQ = OFF_MISC + 19 * MiB;
constexpr size_t OFF_WXO = OFF_MISC + 21 * MiB;
constexpr size_t OFF_WXKV = OFF_MISC + 23 * MiB;
constexpr size_t OFF_MEMB = OFF_MISC + 27 * MiB;
constexpr size_t OFF_KMAT = OFF_MISC + 35 * MiB;
constexpr size_t OFF_VT = OFF_MISC + 43 * MiB;
constexpr size_t OFF_GATES = OFF_MISC + 51 * MiB;
constexpr size_t OFF_CS = OFF_MISC + 53 * MiB;
constexpr size_t OFF_TOKE = OFF_MISC + 69 * MiB;
constexpr size_t OFF_TOKW = OFF_MISC + 70 * MiB;
constexpr size_t OFF_SLOTTOK = OFF_MISC + 71 * MiB;
constexpr size_t OFF_SLOTW = OFF_MISC + 72 * MiB;
constexpr size_t OFF_HIST = OFF_MISC + 73 * MiB;
constexpr size_t WS_NEED = 1024 * MiB;
constexpr int LDS_GEMM = 131072;
constexpr int LDS_BYTES = LDS_GEMM + 1024;

struct Params {
    const float *x, *mem; const int* pos;
    const float *w_in, *sinks, *conv_w, *conv_b, *b_ig, *b_fg, *ml_g, *w_att, *w_ml, *w_mix, *ln1g, *ln1b;
    const float *w_xq, *w_xkv, *w_xo, *ln2g, *ln2b, *w_rg, *b_rg, *w_re, *b_re, *w_gate, *w_up, *w_down, *ln3g, *ln3b;
    float* out; char* ws;
};

__device__ const double INV_FREQ[32] = {1.0, 0.7498942093324559, 0.5623413251903491, 0.4216965034285822, 0.31622776601683794, 0.23713737056616552, 0.1778279410038923, 0.1333521432163324, 0.1, 0.07498942093324558, 0.05623413251903491, 0.042169650342858224, 0.03162277660168379, 0.023713737056616554, 0.01778279410038923, 0.01333521432163324, 0.01, 0.007498942093324558, 0.005623413251903491, 0.004216965034285823, 0.0031622776601683794, 0.0023713737056616554, 0.0017782794100389228, 0.001333521432163324, 0.001, 0.0007498942093324559, 0.0005623413251903491, 0.00042169650342858224, 0.00031622776601683794, 0.00023713737056616554, 0.00017782794100389227, 0.0001333521432163324};

__device__ __forceinline__ unsigned pk_bf16(float lo, float hi) { unsigned r; asm("v_cvt_pk_bf16_f32 %0, %1, %2" : "=v"(r) : "v"(lo), "v"(hi)); return r; }
__device__ __forceinline__ float bf_lo(unsigned u) { return __uint_as_float(u << 16); }
__device__ __forceinline__ float bf_hi(unsigned u) { return __uint_as_float(u & 0xffff0000u); }
__device__ __forceinline__ float bf2f(bf16_t h) { return __uint_as_float(((unsigned)h) << 16); }
__device__ __forceinline__ float wsum(float v) {
#pragma unroll
    for (int o = 32; o; o >>= 1) v += __shfl_xor(v, o);
    return v;
}
__device__ __forceinline__ float wmaxf(float v) {
#pragma unroll
    for (int o = 32; o; o >>= 1) v = fmaxf(v, __shfl_xor(v, o));
    return v;
}
__device__ __forceinline__ float sigmoidf_(float x) { return 1.0f / (1.0f + __expf(-x)); }
__device__ __forceinline__ void glds16(const bf16_t* g, char* l) {
    __builtin_amdgcn_global_load_lds((const GLB_AS void*)g, (LDS_AS void*)l, 16, 0, 0);
}

struct GemmSrc { const bf16_t* a[4]; const bf16_t* b[2]; };

__device__ __forceinline__ void stage_tile(const GemmSrc& s, int koff, char* buf, int tid) {
#pragma unroll
    for (int i = 0; i < 4; ++i) glds16(s.a[i] + koff, buf + (i * 512 + tid) * 16);
#pragma unroll
    for (int i = 0; i < 2; ++i) glds16(s.b[i] + koff, buf + 32768 + (i * 512 + tid) * 16);
}

__device__ __forceinline__ void gemm_loop(f32x4 (&acc)[4][4], const GemmSrc& s, int nk, char* smem, int tid) {
    const int lane = tid & 63, wid = tid >> 6, wr = wid >> 1, wc = wid & 1, fr = lane & 15, fq = lane >> 4;
    const int swz = (fr >> 1) & 7;
    const int aoff = (wr * 64 + fr) * 128;
    const int boff = 32768 + (wc * 64 + fr) * 128;
    stage_tile(s, 0, smem, tid);
    for (int t = 0; t < nk; ++t) {
        asm volatile("s_waitcnt vmcnt(0)" ::: "memory");
        __syncthreads();
        char* cur = smem + (t & 1) * 49152;
        if (t + 1 < nk) stage_tile(s, (t + 1) * 64, smem + ((t + 1) & 1) * 49152, tid);
#pragma unroll
        for (int ks = 0; ks < 2; ++ks) {
            const int ch = ((ks * 4 + fq) ^ swz) * 16;
            bf16x8 xa[4], wb[4];
#pragma unroll
            for (int m = 0; m < 4; ++m) xa[m] = *(const bf16x8*)(cur + aoff + m * 2048 + ch);
#pragma unroll
            for (int n = 0; n < 4; ++n) wb[n] = *(const bf16x8*)(cur + boff + n * 2048 + ch);
#pragma unroll
            for (int m = 0; m < 4; ++m)
#pragma unroll
                for (int n = 0; n < 4; ++n) acc[m][n] = __builtin_amdgcn_mfma_f32_16x16x32_bf16(wb[n], xa[m], acc[m][n], 0, 0, 0);
        }
    }
    __syncthreads();
}

__device__ __forceinline__ void zero_acc(f32x4 (&acc)[4][4]) {
#pragma unroll
    for (int m = 0; m < 4; ++m)
#pragma unroll
        for (int n = 0; n < 4; ++n) acc[m][n] = (f32x4){0.f, 0.f, 0.f, 0.f};
}

__device__ __forceinline__ void make_src(GemmSrc& s, const bf16_t* A, size_t lda, int rowA0, const bf16_t* Bt, size_t ldb, int rowB0, int tid) {
    const int r = tid >> 3, lc = (tid & 7) ^ ((r >> 1) & 7);
#pragma unroll
    for (int i = 0; i < 4; ++i) s.a[i] = A + (size_t)(rowA0 + i * 64 + r) * lda + lc * 8;
#pragma unroll
    for (int i = 0; i < 2; ++i) s.b[i] = Bt + (size_t)(rowB0 + i * 64 + r) * ldb + lc * 8;
}

__device__ __forceinline__ void store_bf16x4(bf16_t* p, f32x4 v) {
    uint2 w; w.x = pk_bf16(v[0], v[1]); w.y = pk_bf16(v[2], v[3]); *(uint2*)p = w;
}

__device__ __forceinline__ void tr_tile(const float* src, size_t ld_src, int k0, int c0, bf16_t* dst, size_t ld_dst, int r0, float* tile, int tid) {
    {
        const int r = tid >> 3, c4 = (tid & 7) * 4;
        const float4 v = *(const float4*)(src + (size_t)(k0 + r) * ld_src + c0 + c4);
        float* tp = tile + r * 33 + c4; tp[0] = v.x; tp[1] = v.y; tp[2] = v.z; tp[3] = v.w;
    }
    __syncthreads();
    {
        const int c = tid >> 4, rc = (tid & 15) * 4;
        const float a0 = tile[(rc + 0) * 33 + c], a1 = tile[(rc + 1) * 33 + c], a2 = tile[(rc + 2) * 33 + c], a3 = tile[(rc + 3) * 33 + c];
        uint2 w; w.x = pk_bf16(a0, a1); w.y = pk_bf16(a2, a3);
        *(uint2*)(dst + (size_t)(r0 + c) * ld_dst + k0 + rc) = w;
    }
    __syncthreads();
}

__device__ void phase0(const Params& p, char* smem) {
    const int tid = threadIdx.x, lane = tid & 63, wid = tid >> 6;
    const int gw = blockIdx.x * 8 + wid, nw = gridDim.x * 8;
    char* ws = p.ws;
    bf16_t* xb = (bf16_t*)(ws + OFF_R0);
    float* gates = (float*)(ws + OFF_GATES);
    for (int row = gw; row < T_; row += nw) {
        const float4* xr = (const float4*)(p.x + (size_t)row * 1024);
        float g0 = 0, g1 = 0, g2 = 0, g3 = 0, g4 = 0, g5 = 0, g6 = 0, g7 = 0;
#pragma unroll
        for (int i = 0; i < 4; ++i) {
            const float4 v = xr[i * 64 + lane];
            uint2 w; w.x = pk_bf16(v.x, v.y); w.y = pk_bf16(v.z, v.w);
            *(uint2*)(xb + (size_t)row * 1024 + i * 256 + lane * 4) = w;
            const float vv[4] = {v.x, v.y, v.z, v.w};
#pragma unroll
            for (int jj = 0; jj < 4; ++jj) {
                const int k = i * 256 + lane * 4 + jj;
                const float4* wp = (const float4*)(p.w_in + (size_t)k * 6408 + 4352);
                const float4 w0 = wp[0], w1 = wp[1];
                g0 += vv[jj] * w0.x; g1 += vv[jj] * w0.y; g2 += vv[jj] * w0.z; g3 += vv[jj] * w0.w;
                g4 += vv[jj] * w1.x; g5 += vv[jj] * w1.y; g6 += vv[jj] * w1.z; g7 += vv[jj] * w1.w;
            }
        }
        g0 = wsum(g0); g1 = wsum(g1); g2 = wsum(g2); g3 = wsum(g3); g4 = wsum(g4); g5 = wsum(g5); g6 = wsum(g6); g7 = wsum(g7);
        if (lane == 0) {
            float4* gp = (float4*)(gates + (size_t)row * 8);
            gp[0] = make_float4(g0, g1, g2, g3); gp[1] = make_float4(g4, g5, g6, g7);
        }
    }
    {
        float2* cs = (float2*)(ws + OFF_CS);
        const int gt = blockIdx.x * NTHR + tid, nt = gridDim.x * NTHR;
        for (int idx = gt; idx < T_ * 32; idx += nt) {
            const int tok = idx >> 5, i = idx & 31;
            const double ang = (double)p.pos[tok] * INV_FREQ[i];
            const double turns = ang * 0.15915494309189535;
            const float f = (float)(turns - rint(turns));
            cs[idx] = make_float2(__builtin_amdgcn_cosf(f), __builtin_amdgcn_sinf(f));
        }
        bf16_t* memb = (bf16_t*)(ws + OFF_MEMB);
        for (int idx = gt; idx < 4096 * 1024 / 4; idx += nt) {
            const float4 v = ((const float4*)p.mem)[idx];
            uint2 w; w.x = pk_bf16(v.x, v.y); w.y = pk_bf16(v.z, v.w);
            ((uint2*)memb)[idx] = w;
        }
    }
    {
        float* tile = (float*)smem;
        const int NT_WIN = 16 * 200, NT_SQ = 16 * 32, NT_XKV = 16 * 64;
        const int total = NT_WIN + 5 * NT_SQ + NT_XKV;
        for (int t = blockIdx.x; t < total; t += gridDim.x) {
            if (t < NT_WIN) {
                const int kt = t & 15, nt_ = t >> 4;
                const int n0 = nt_ * 32, c0 = n0 < 4352 ? n0 : n0 + 8;
                tr_tile(p.w_in, 6408, kt * 64, c0, (bf16_t*)(ws + OFF_WIN), 1024, n0, tile, tid);
            } else if (t < NT_WIN + 5 * NT_SQ) {
                const int u = t - NT_WIN, which = u / NT_SQ, v = u % NT_SQ, kt = v & 15, nt_ = v >> 4;
                const float* src = which == 0 ? p.w_att : which == 1 ? p.w_ml : which == 2 ? p.w_mix : which == 3 ? p.w_xq : p.w_xo;
                bf16_t* dst = (bf16_t*)(ws + OFF_WATT + (size_t)which * 2 * MiB);
                tr_tile(src, 1024, kt * 64, nt_ * 32, dst, 1024, nt_ * 32, tile, tid);
            } else {
                const int v = t - NT_WIN - 5 * NT_SQ, kt = v & 15, nt_ = v >> 4;
                tr_tile(p.w_xkv, 2048, kt * 64, nt_ * 32, (bf16_t*)(ws + OFF_WXKV), 1024, nt_ * 32, tile, tid);
            }
        }
    }
}

__device__ void moe_weight_prep(const Params& p, char* smem) {
    const int tid = threadIdx.x;
    float* tile = (float*)smem;
    char* ws = p.ws;
    const int per_e = 384, total = 64 * per_e;
    for (int t = blockIdx.x; t < total; t += gridDim.x) {
        const int e = t / per_e, u = t % per_e;
        if (u < 256) {
            const int isup = u >> 7, v = u & 127, kt = v & 15, j = v >> 4;
            const float* src = (isup ? p.w_up : p.w_gate) + (size_t)e * 1024 * 256;
            tr_tile(src, 256, kt * 64, j * 32, (bf16_t*)(ws + OFF_WGU) + (size_t)e * 512 * 1024, 1024, j * 64 + isup * 32, tile, tid);
        } else {
            const int v = u - 256, kt = v & 3, nt_ = v >> 2;
            tr_tile(p.w_down + (size_t)e * 256 * 1024, 1024, kt * 64, nt_ * 32, (bf16_t*)(ws + OFF_WD) + (size_t)e * 1024 * 256, 256, nt_ * 32, tile, tid);
        }
    }
}

__device__ void phase1(const Params& p, char* smem) {
    const int tid = threadIdx.x, lane = tid & 63, wid = tid >> 6, wr = wid >> 1, wc = wid & 1, fr = lane & 15, fq = lane >> 4;
    char* ws = p.ws;
    const int NMAIN = 256 * 50, NKV = 256;
    for (int t = blockIdx.x; t < NMAIN + NKV; t += gridDim.x) {
        GemmSrc s; int rt, ct; const bool main_ = t < NMAIN; const bool isvt = t >= NMAIN + 128;
        if (main_) { rt = t / 50; ct = t % 50; make_src(s, (const bf16_t*)(ws + OFF_R0), 1024, rt * 256, (const bf16_t*)(ws + OFF_WIN), 1024, ct * 128, tid); }
        else if (!isvt) { const int u = t - NMAIN; rt = u >> 3; ct = u & 7; make_src(s, (const bf16_t*)(ws + OFF_MEMB), 1024, rt * 256, (const bf16_t*)(ws + OFF_WXKV), 1024, ct * 128, tid); }
        else { const int u = t - NMAIN - 128; rt = u >> 5; ct = u & 31; make_src(s, (const bf16_t*)(ws + OFF_WXKV) + (size_t)1024 * 1024, 1024, rt * 256, (const bf16_t*)(ws + OFF_MEMB), 1024, ct * 128, tid); }
        f32x4 acc[4][4]; zero_acc(acc);
        gemm_loop(acc, s, 16, smem, tid);
        const int row0 = rt * 256 + wr * 64 + fr;
        const int c0w = ct * 128 + wc * 64;
        if (main_ && c0w < 1152) {
            bf16_t* dst; int ld, cb; float sc;
            if (c0w < 1024) { dst = (bf16_t*)(ws + OFF_R1); ld = 1024; cb = c0w; sc = 0.125f; }
            else { dst = (bf16_t*)(ws + OFF_AK); ld = 128; cb = c0w - 1024; sc = 1.0f; }
            const float* cs = (const float*)(ws + OFF_CS);
#pragma unroll
            for (int m = 0; m < 4; ++m) {
                const int tok = row0 + m * 16;
#pragma unroll
                for (int n = 0; n < 2; ++n) {
                    const int d0 = n * 16 + fq * 4;
                    const float4* cp = (const float4*)(cs + (size_t)tok * 64 + d0 * 2);
                    const float4 c01 = cp[0], c23 = cp[1];
                    const f32x4 x1 = acc[m][n], x2 = acc[m][n + 2];
                    f32x4 o1, o2;
                    o1[0] = (x1[0] * c01.x - x2[0] * c01.y) * sc; o2[0] = (x2[0] * c01.x + x1[0] * c01.y) * sc;
                    o1[1] = (x1[1] * c01.z - x2[1] * c01.w) * sc; o2[1] = (x2[1] * c01.z + x1[1] * c01.w) * sc;
                    o1[2] = (x1[2] * c23.x - x2[2] * c23.y) * sc; o2[2] = (x2[2] * c23.x + x1[2] * c23.y) * sc;
                    o1[3] = (x1[3] * c23.z - x2[3] * c23.w) * sc; o2[3] = (x2[3] * c23.z + x1[3] * c23.w) * sc;
                    bf16_t* rp = dst + (size_t)tok * ld + cb + d0;
                    store_bf16x4(rp, o1); store_bf16x4(rp + 32, o2);
                }
            }
        } else {
            bf16_t* dst; int ld, cb; bool sig = false;
            if (!main_) { if (isvt) { dst = (bf16_t*)(ws + OFF_VT); ld = 4096; cb = c0w; } else { dst = (bf16_t*)(ws + OFF_KMAT); ld = 1024; cb = c0w; } }
            else if (c0w < 1280) { dst = (bf16_t*)(ws + OFF_AV); ld = 128; cb = c0w - 1152; }
            else if (c0w < 2304) { dst = (bf16_t*)(ws + OFF_MQK); ld = 1024; cb = c0w - 1280; }
            else if (c0w < 3328) { dst = (bf16_t*)(ws + OFF_MV); ld = 1024; cb = c0w - 2304; }
            else if (c0w < 4352) { dst = (bf16_t*)(ws + OFF_MO); ld = 1024; cb = c0w - 3328; sig = true; }
            else { dst = (bf16_t*)(ws + OFF_GG); ld = 2048; cb = c0w - 4352; sig = true; }
#pragma unroll
            for (int m = 0; m < 4; ++m) {
                bf16_t* rp = dst + (size_t)(row0 + m * 16) * ld + cb + fq * 4;
#pragma unroll
                for (int n = 0; n < 4; ++n) {
                    f32x4 v = acc[m][n];
                    if (sig) { v[0] = sigmoidf_(v[0]); v[1] = sigmoidf_(v[1]); v[2] = sigmoidf_(v[2]); v[3] = sigmoidf_(v[3]); }
                    store_bf16x4(rp + n * 16, v);
                }
            }
        }
    }
}

__device__ void mlstm_item(const Params& p, char* smem, int item, float* hm_out_f32_unused) {
    (void)hm_out_f32_unused;
    const int tid = threadIdx.x, lane = tid & 63;
    const int b = item >> 2, h = item & 3;
    char* ws = p.ws;
    const bf16_t* mqk = (const bf16_t*)(ws + OFF_MQK);
    const bf16_t* mv = (const bf16_t*)(ws + OFF_MV);
    const bf16_t* mo = (const bf16_t*)(ws + OFF_MO);
    const float* gates = (const float*)(ws + OFF_GATES);
    bf16_t* hm = (bf16_t*)p.out;
    float* qs = (float*)smem;
    float* ks = qs + 16 * 128;
    float* hpart = ks + 16 * 128;
    float* fl = hpart + 2 * 16 * 256;
    float* eil = fl + 16;
    float* denl = eil + 16;
    float* ssq = denl + 16;
    const int e = tid & 255, dh = tid >> 8;
    float C[64];
#pragma unroll
    for (int d = 0; d < 64; ++d) C[d] = 0.f;
    float nreg = 0.f;
    const int cc = tid & 255, tg = tid >> 8;
    const int ccol = cc < 128 ? (h * 128 + cc) : (512 + h * 128 + (cc - 128));
    const float cw0 = p.conv_w[0 * 1024 + ccol], cw1 = p.conv_w[1 * 1024 + ccol], cw2 = p.conv_w[2 * 1024 + ccol], cw3 = p.conv_w[3 * 1024 + ccol];
    const float cbias = p.conv_b[ccol];
    const float big = p.b_ig[h], bfg = p.b_fg[h];
    const float gnorm = p.ml_g[h * 256 + e];
    const size_t tokb = (size_t)b * 4096;
    for (int t0 = 0; t0 < 4096; t0 += 16) {
        {
            const int ts = t0 + tg * 8;
            float r[11];
#pragma unroll
            for (int i = 0; i < 11; ++i) { const int tt = ts - 3 + i; r[i] = tt >= 0 ? bf2f(mqk[(tokb + tt) * 1024 + ccol]) : 0.f; }
#pragma unroll
            for (int i = 0; i < 8; ++i) {
                float v = cw0 * r[i] + cw1 * r[i + 1] + cw2 * r[i + 2] + cw3 * r[i + 3] + cbias;
                v = v * sigmoidf_(v);
                if (cc < 128) qs[(tg * 8 + i) * 128 + cc] = v; else ks[(tg * 8 + i) * 128 + (cc - 128)] = v * 0.08838834764831845f;
            }
        }
        if (tid < 16) {
            const size_t tok = tokb + t0 + tid;
            const float mi = gates[tok * 8 + h] + big, mf = gates[tok * 8 + 4 + h] + bfg;
            fl[tid] = sigmoidf_(mf); eil[tid] = __expf(mi); denl[tid] = 0.f; ssq[tid] = 0.f;
        }
        float vv[16];
#pragma unroll
        for (int tt = 0; tt < 16; ++tt) vv[tt] = bf2f(mv[(tokb + t0 + tt) * 1024 + h * 256 + e]);
        __syncthreads();
#pragma unroll 1
        for (int tt = 0; tt < 16; ++tt) {
            const float f = fl[tt], ei = eil[tt], eiv = ei * vv[tt];
            const float4* kp = (const float4*)(ks + tt * 128 + dh * 64);
            const float4* qp = (const float4*)(qs + tt * 128 + dh * 64);
            float hp = 0.f;
#pragma unroll
            for (int d4 = 0; d4 < 16; ++d4) {
                const float4 kk = kp[d4], qq = qp[d4];
                C[d4 * 4 + 0] = f * C[d4 * 4 + 0] + eiv * kk.x; hp += qq.x * C[d4 * 4 + 0];
                C[d4 * 4 + 1] = f * C[d4 * 4 + 1] + eiv * kk.y; hp += qq.y * C[d4 * 4 + 1];
                C[d4 * 4 + 2] = f * C[d4 * 4 + 2] + eiv * kk.z; hp += qq.z * C[d4 * 4 + 2];
                C[d4 * 4 + 3] = f * C[d4 * 4 + 3] + eiv * kk.w; hp += qq.w * C[d4 * 4 + 3];
            }
            hpart[(dh * 16 + tt) * 256 + e] = hp;
            if (tid < 128) {
                nreg = f * nreg + ei * ks[tt * 128 + tid];
                const float part = wsum(qs[tt * 128 + tid] * nreg);
                if (lane == 0) atomicAdd(&denl[tt], part);
            }
        }
        __syncthreads();
        float hv[8];
#pragma unroll
        for (int i = 0; i < 8; ++i) {
            const int tt = dh * 8 + i;
            const float num = hpart[tt * 256 + e] + hpart[(16 + tt) * 256 + e];
            const float den = denl[tt];
            hv[i] = num / fmaxf(fabsf(den), 1.0f);
            const float sq = wsum(hv[i] * hv[i]);
            if (lane == 0) atomicAdd(&ssq[tt], sq);
        }
        __syncthreads();
#pragma unroll
        for (int i = 0; i < 8; ++i) {
            const int tt = dh * 8 + i;
            const size_t tok = tokb + t0 + tt;
            const float rstd = rsqrtf(ssq[tt] * (1.0f / 256.0f) + 1e-6f);
            const float og = bf2f(mo[tok * 1024 + h * 256 + e]);
            const float o = hv[i] * rstd * gnorm * og;
            hm[tok * 1024 + h * 256 + e] = (bf16_t)(pk_bf16(o, o) & 0xffffu);
        }
        __syncthreads();
    }
}

__device__ void swa_items(const Params& p, int gw, int nw) {
    const int lane = threadIdx.x & 63;
    char* ws = p.ws;
    const bf16_t* aq = (const bf16_t*)(ws + OFF_R1);
    const bf16_t* ak = (const bf16_t*)(ws + OFF_AK);
    const bf16_t* av = (const bf16_t*)(ws + OFF_AV);
    bf16_t* ao = (bf16_t*)(ws + OFF_R0);
    for (int item = gw; item < T_ * 16; item += nw) {
        const int tok = item >> 4, hq = item & 15, kvh = hq >> 3;
        const int s = tok & 4095;
        const float q = bf2f(aq[(size_t)tok * 1024 + hq * 64 + lane]);
        float sc0 = -INFINITY, sc1 = -INFINITY;
        const bool v0 = (s - lane) >= 0, v1 = (s - 64 - lane) >= 0;
        const uint4* k0p = (const uint4*)(ak + (size_t)(tok - (v0 ? lane : 0)) * 128 + kvh * 64);
        const uint4* k1p = (const uint4*)(ak + (size_t)(tok - (v1 ? 64 + lane : 0)) * 128 + kvh * 64);
        float a0 = 0.f, a1 = 0.f;
#pragma unroll
        for (int c = 0; c < 8; ++c) {
            const uint4 ka = k0p[c], kb = k1p[c];
            const unsigned kaw[4] = {ka.x, ka.y, ka.z, ka.w}, kbw[4] = {kb.x, kb.y, kb.z, kb.w};
#pragma unroll
            for (int w = 0; w < 4; ++w) {
                const float q0 = __shfl(q, c * 8 + w * 2), q1 = __shfl(q, c * 8 + w * 2 + 1);
                a0 += q0 * bf_lo(kaw[w]) + q1 * bf_hi(kaw[w]);
                a1 += q0 * bf_lo(kbw[w]) + q1 * bf_hi(kbw[w]);
            }
        }
        if (v0) sc0 = a0;
        if (v1) sc1 = a1;
        const float sink = p.sinks[hq];
        const float m = fmaxf(wmaxf(fmaxf(sc0, sc1)), sink);
        const float e0 = v0 ? __expf(sc0 - m) : 0.f, e1 = v1 ? __expf(sc1 - m) : 0.f;
        const float den = wsum(e0 + e1) + __expf(sink - m);
        const float inv = 1.0f / den;
        const float p0 = e0 * inv, p1 = e1 * inv;
        float o = 0.f;
        const int nkeys = s + 1 < 128 ? s + 1 : 128;
        for (int j = 0; j < nkeys; ++j) {
            const float pj = j < 64 ? __shfl(p0, j) : __shfl(p1, j - 64);
            o += pj * bf2f(av[(size_t)(tok - j) * 128 + kvh * 64 + lane]);
        }
        ao[(size_t)tok * 1024 + hq * 64 + lane] = (bf16_t)(pk_bf16(o, o) & 0xffffu);
    }
}

__device__ void phase2(const Params& p, char* smem) {
    const int wid = threadIdx.x >> 6;
    const int G = gridDim.x;
    if (G > 64) {
        if (blockIdx.x < 64) mlstm_item(p, smem, blockIdx.x, nullptr);
        else swa_items(p, (blockIdx.x - 64) * 8 + wid, (G - 64) * 8);
    } else {
        for (int it = blockIdx.x; it < 64; it += G) mlstm_item(p, smem, it, nullptr);
        swa_items(p, blockIdx.x * 8 + wid, G * 8);
    }
}

__device__ void phase3(const Params& p, char* smem) {
    const int tid = threadIdx.x, lane = tid & 63, wid = tid >> 6, wr = wid >> 1, wc = wid & 1, fr = lane & 15, fq = lane >> 4;
    char* ws = p.ws;
    const bf16_t* gg = (const bf16_t*)(ws + OFF_GG);
    bf16_t* y = (bf16_t*)(ws + OFF_R1);
    for (int t = blockIdx.x; t < 256 * 8; t += gridDim.x) {
        const int rt = t >> 3, ct = t & 7;
        GemmSrc s;
        f32x4 acca[4][4], accm[4][4]; zero_acc(acca); zero_acc(accm);
        make_src(s, (const bf16_t*)(ws + OFF_R0), 1024, rt * 256, (const bf16_t*)(ws + OFF_WATT), 1024, ct * 128, tid);
        gemm_loop(acca, s, 16, smem, tid);
        make_src(s, (const bf16_t*)p.out, 1024, rt * 256, (const bf16_t*)(ws + OFF_WML), 1024, ct * 128, tid);
        gemm_loop(accm, s, 16, smem, tid);
        const int row0 = rt * 256 + wr * 64 + fr, col0 = ct * 128 + wc * 64 + fq * 4;
#pragma unroll
        for (int m = 0; m < 4; ++m) {
            const size_t tok = row0 + m * 16;
#pragma unroll
            for (int n = 0; n < 4; ++n) {
                const int col = col0 + n * 16;
                const uint2 ga = *(const uint2*)(gg + tok * 2048 + col), gm = *(const uint2*)(gg + tok * 2048 + 1024 + col);
                f32x4 v;
                v[0] = bf_lo(ga.x) * acca[m][n][0] + bf_lo(gm.x) * accm[m][n][0];
                v[1] = bf_hi(ga.x) * acca[m][n][1] + bf_hi(gm.x) * accm[m][n][1];
                v[2] = bf_lo(ga.y) * acca[m][n][2] + bf_lo(gm.y) * accm[m][n][2];
                v[3] = bf_hi(ga.y) * acca[m][n][3] + bf_hi(gm.y) * accm[m][n][3];
                store_bf16x4(y + tok * 1024 + col, v);
            }
        }
    }
}

__device__ void phase_gemm_resid(const Params& p, char* smem, const bf16_t* A, const bf16_t* Bt, const float* resid, float* outz) {
    const int tid = threadIdx.x, lane = tid & 63, wid = tid >> 6, wr = wid >> 1, wc = wid & 1, fr = lane & 15, fq = lane >> 4;
    for (int t = blockIdx.x; t < 256 * 8; t += gridDim.x) {
        const int rt = t >> 3, ct = t & 7;
        GemmSrc s; f32x4 acc[4][4]; zero_acc(acc);
        make_src(s, A, 1024, rt * 256, Bt, 1024, ct * 128, tid);
        gemm_loop(acc, s, 16, smem, tid);
        const int row0 = rt * 256 + wr * 64 + fr, col0 = ct * 128 + wc * 64 + fq * 4;
#pragma unroll
        for (int m = 0; m < 4; ++m) {
            const size_t tok = row0 + m * 16;
#pragma unroll
            for (int n = 0; n < 4; ++n) {
                const int col = col0 + n * 16;
                const float4 r = *(const float4*)(resid + tok * 1024 + col);
                float4 o; o.x = ALPHA * r.x + acc[m][n][0]; o.y = ALPHA * r.y + acc[m][n][1]; o.z = ALPHA * r.z + acc[m][n][2]; o.w = ALPHA * r.w + acc[m][n][3];
                *(float4*)(outz + tok * 1024 + col) = o;
            }
        }
    }
}

__device__ void phase_gemm_bf16(const Params& p, char* smem, const bf16_t* A, const bf16_t* Bt, bf16_t* outb, float scale) {
    const int tid = threadIdx.x, lane = tid & 63, wid = tid >> 6, wr = wid >> 1, wc = wid & 1, fr = lane & 15, fq = lane >> 4;
    for (int t = blockIdx.x; t < 256 * 8; t += gridDim.x) {
        const int rt = t >> 3, ct = t & 7;
        GemmSrc s; f32x4 acc[4][4]; zero_acc(acc);
        make_src(s, A, 1024, rt * 256, Bt, 1024, ct * 128, tid);
        gemm_loop(acc, s, 16, smem, tid);
        const int row0 = rt * 256 + wr * 64 + fr, col0 = ct * 128 + wc * 64 + fq * 4;
#pragma unroll
        for (int m = 0; m < 4; ++m) {
            const size_t tok = row0 + m * 16;
#pragma unroll
            for (int n = 0; n < 4; ++n) store_bf16x4(outb + tok * 1024 + col0 + n * 16, acc[m][n] * scale);
        }
    }
}

__device__ __forceinline__ void ln_row(float4 (&v)[4], const float* g, const float* bta, int lane) {
    float s = 0.f;
#pragma unroll
    for (int i = 0; i < 4; ++i) s += (v[i].x + v[i].y) + (v[i].z + v[i].w);
    const float mu = wsum(s) * (1.0f / 1024.0f);
    float q = 0.f;
#pragma unroll
    for (int i = 0; i < 4; ++i) { const float a = v[i].x - mu, b = v[i].y - mu, c = v[i].z - mu, d = v[i].w - mu; q += (a * a + b * b) + (c * c + d * d); }
    const float rstd = rsqrtf(wsum(q) * (1.0f / 1024.0f) + 1e-5f);
#pragma unroll
    for (int i = 0; i < 4; ++i) {
        const float4 gg = *(const float4*)(g + i * 256 + lane * 4), bb = *(const float4*)(bta + i * 256 + lane * 4);
        v[i].x = (v[i].x - mu) * rstd * gg.x + bb.x; v[i].y = (v[i].y - mu) * rstd * gg.y + bb.y;
        v[i].z = (v[i].z - mu) * rstd * gg.z + bb.z; v[i].w = (v[i].w - mu) * rstd * gg.w + bb.w;
    }
}

__device__ void phase_ln1(const Params& p) {
    const int lane = threadIdx.x & 63, wid = threadIdx.x >> 6;
    float* z = p.out; bf16_t* hb = (bf16_t*)(p.ws + OFF_R0);
    for (int row = blockIdx.x * 8 + wid; row < T_; row += gridDim.x * 8) {
        float4 v[4];
#pragma unroll
        for (int i = 0; i < 4; ++i) v[i] = *(const float4*)(z + (size_t)row * 1024 + i * 256 + lane * 4);
        ln_row(v, p.ln1g, p.ln1b, lane);
#pragma unroll
        for (int i = 0; i < 4; ++i) {
            *(float4*)(z + (size_t)row * 1024 + i * 256 + lane * 4) = v[i];
            uint2 w; w.x = pk_bf16(v[i].x, v[i].y); w.y = pk_bf16(v[i].z, v[i].w);
            *(uint2*)(hb + (size_t)row * 1024 + i * 256 + lane * 4) = w;
        }
    }
}

__device__ __forceinline__ void xa_stage_k(const bf16_t* kmat, int b, int h, int kh, char* buf, int tid) {
    const int rl = tid >> 5, pc = tid & 31, lc = pc ^ (rl & 15);
    const bf16_t* src = kmat + (size_t)(b * 256 + kh * 128 + rl) * 1024 + h * 256 + lc * 8;
#pragma unroll
    for (int i = 0; i < 8; ++i) glds16(src + (size_t)i * 16 * 1024, buf + (i * 512 + tid) * 16);
}
__device__ __forceinline__ void xa_stage_v(const bf16_t* vT, int b, int h, int vh, char* buf, int tid) {
    const int rl = tid >> 4, pc = tid & 15, lc = pc ^ (rl & 15);
    const bf16_t* src = vT + (size_t)(h * 256 + rl) * 4096 + b * 256 + vh * 128 + lc * 8;
#pragma unroll
    for (int i = 0; i < 8; ++i) glds16(src + (size_t)i * 32 * 4096, buf + (i * 512 + tid) * 16);
}

template <int KH>
__device__ __forceinline__ void xa_scores(f32x4 (&acc)[16][2], const char* buf, const bf16_t* q0p, const bf16_t* q1p, int fr, int fq) {
#pragma unroll 2
    for (int ks = 0; ks < 8; ++ks) {
        const bf16x8 q0 = *(const bf16x8*)(q0p + ks * 32), q1 = *(const bf16x8*)(q1p + ks * 32);
        const int ch = ((ks * 4 + fq) ^ fr) * 16;
#pragma unroll
        for (int mt = 0; mt < 8; ++mt) {
            const bf16x8 kf = *(const bf16x8*)(buf + (mt * 16 + fr) * 512 + ch);
            acc[KH * 8 + mt][0] = __builtin_amdgcn_mfma_f32_16x16x32_bf16(kf, q0, acc[KH * 8 + mt][0], 0, 0, 0);
            acc[KH * 8 + mt][1] = __builtin_amdgcn_mfma_f32_16x16x32_bf16(kf, q1, acc[KH * 8 + mt][1], 0, 0, 0);
        }
    }
}

typedef unsigned u32x2 __attribute__((ext_vector_type(2)));
typedef unsigned u32x4 __attribute__((ext_vector_type(4)));

template <int VH, int DH>
__device__ __forceinline__ void xa_pv(f32x4 (&o)[8][2], const u32x4 (&pf)[2][8], const char* buf, int fr, int fq) {
#pragma unroll
    for (int ks = 0; ks < 4; ++ks) {
        const int ca = ((ks * 4 + (fq >> 1)) ^ fr) * 16 + (fq & 1) * 8, cb = ((ks * 4 + 2 + (fq >> 1)) ^ fr) * 16 + (fq & 1) * 8;
        const bf16x8 p0 = __builtin_bit_cast(bf16x8, pf[0][VH * 4 + ks]), p1 = __builtin_bit_cast(bf16x8, pf[1][VH * 4 + ks]);
#pragma unroll
        for (int dt = 0; dt < 8; ++dt) {
            const char* rowp = buf + ((DH * 8 + dt) * 16 + fr) * 256;
            const u32x2 va = *(const u32x2*)(rowp + ca), vb = *(const u32x2*)(rowp + cb);
            u32x4 vv; vv[0] = va[0]; vv[1] = va[1]; vv[2] = vb[0]; vv[3] = vb[1];
            const bf16x8 vf = __builtin_bit_cast(bf16x8, vv);
            o[dt][0] = __builtin_amdgcn_mfma_f32_16x16x32_bf16(vf, p0, o[dt][0], 0, 0, 0);
            o[dt][1] = __builtin_amdgcn_mfma_f32_16x16x32_bf16(vf, p1, o[dt][1], 0, 0, 0);
        }
    }
}

__device__ void phase6(const Params& p, char* smem) {
    const int tid = threadIdx.x, lane = tid & 63, wid = tid >> 6, fr = lane & 15, fq = lane >> 4;
    char* ws = p.ws;
    const bf16_t* xq = (const bf16_t*)(ws + OFF_XQ);
    const bf16_t* kmat = (const bf16_t*)(ws + OFF_KMAT);
    const bf16_t* vT = (const bf16_t*)(ws + OFF_VT);
    bf16_t* og = (bf16_t*)(ws + OFF_O);
    char* bufA = smem; char* bufB = smem + 65536;
    const int G = gridDim.x;
    for (int idx = blockIdx.x; idx < 1024; idx += G) {
        int pair, qt;
        if (G == 256) { const int i = idx >> 8, blk = idx & 255, xcd = blk & 7, jj = blk >> 3; pair = (i * 8 + xcd) * 2 + (jj >> 4); qt = jj & 15; }
        else { pair = idx >> 4; qt = idx & 15; }
        const int b = pair >> 2, h = pair & 3;
        const int tok0 = b * 4096 + qt * 256 + wid * 32;
        xa_stage_k(kmat, b, h, 0, bufA, tid);
        xa_stage_k(kmat, b, h, 1, bufB, tid);
        const bf16_t* q0p = xq + (size_t)(tok0 + fr) * 1024 + h * 256 + fq * 8;
        const bf16_t* q1p = q0p + (size_t)16 * 1024;
        f32x4 acc[16][2];
#pragma unroll
        for (int mt = 0; mt < 16; ++mt) { acc[mt][0] = (f32x4){0.f, 0.f, 0.f, 0.f}; acc[mt][1] = (f32x4){0.f, 0.f, 0.f, 0.f}; }
        asm volatile("s_waitcnt vmcnt(0)" ::: "memory");
        __syncthreads();
        xa_scores<0>(acc, bufA, q0p, q1p, fr, fq);
        xa_scores<1>(acc, bufB, q0p, q1p, fr, fq);
        __syncthreads();
        xa_stage_v(vT, b, h, 0, bufA, tid);
        xa_stage_v(vT, b, h, 1, bufB, tid);
        u32x4 pf[2][8]; float linv[2];
#pragma unroll
        for (int nt = 0; nt < 2; ++nt) {
            float m = -INFINITY;
#pragma unroll
            for (int mt = 0; mt < 16; ++mt) m = fmaxf(m, fmaxf(fmaxf(acc[mt][nt][0], acc[mt][nt][1]), fmaxf(acc[mt][nt][2], acc[mt][nt][3])));
            m = fmaxf(m, __shfl_xor(m, 16)); m = fmaxf(m, __shfl_xor(m, 32));
            float l = 0.f;
#pragma unroll
            for (int s2 = 0; s2 < 8; ++s2) {
                float e[8];
#pragma unroll
                for (int j = 0; j < 4; ++j) { e[j] = __expf(acc[2 * s2][nt][j] - m); e[4 + j] = __expf(acc[2 * s2 + 1][nt][j] - m); }
                l += ((e[0] + e[1]) + (e[2] + e[3])) + ((e[4] + e[5]) + (e[6] + e[7]));
                u32x4 w; w[0] = pk_bf16(e[0], e[1]); w[1] = pk_bf16(e[2], e[3]); w[2] = pk_bf16(e[4], e[5]); w[3] = pk_bf16(e[6], e[7]);
                pf[nt][s2] = w;
            }
            l += __shfl_xor(l, 16); l += __shfl_xor(l, 32);
            linv[nt] = 1.0f / l;
        }
        asm volatile("s_waitcnt vmcnt(0)" ::: "memory");
        __syncthreads();
        {
            f32x4 o[8][2];
#pragma unroll
            for (int dt = 0; dt < 8; ++dt) { o[dt][0] = (f32x4){0.f, 0.f, 0.f, 0.f}; o[dt][1] = (f32x4){0.f, 0.f, 0.f, 0.f}; }
            xa_pv<0, 0>(o, pf, bufA, fr, fq);
            xa_pv<1, 0>(o, pf, bufB, fr, fq);
#pragma unroll
            for (int nt = 0; nt < 2; ++nt) {
                bf16_t* rp = og + (size_t)(tok0 + nt * 16 + fr) * 1024 + h * 256 + fq * 4;
#pragma unroll
                for (int dt = 0; dt < 8; ++dt) store_bf16x4(rp + dt * 16, o[dt][nt] * linv[nt]);
            }
        }
        {
            f32x4 o[8][2];
#pragma unroll
            for (int dt = 0; dt < 8; ++dt) { o[dt][0] = (f32x4){0.f, 0.f, 0.f, 0.f}; o[dt][1] = (f32x4){0.f, 0.f, 0.f, 0.f}; }
            xa_pv<0, 1>(o, pf, bufA, fr, fq);
            xa_pv<1, 1>(o, pf, bufB, fr, fq);
#pragma unroll
            for (int nt = 0; nt < 2; ++nt) {
                bf16_t* rp = og + (size_t)(tok0 + nt * 16 + fr) * 1024 + h * 256 + 128 + fq * 4;
#pragma unroll
                for (int dt = 0; dt < 8; ++dt) store_bf16x4(rp + dt * 16, o[dt][nt] * linv[nt]);
            }
        }
        __syncthreads();
    }
}

__device__ void phase_ln2_router(const Params& p, char* smem) {
    const int tid = threadIdx.x, lane = tid & 63, wid = tid >> 6;
    char* ws = p.ws;
    float* z = (float*)(ws + OFF_Z2); bf16_t* hb = (bf16_t*)(ws + OFF_R0);
    int2* toke = (int2*)(ws + OFF_TOKE); float2* tokw = (float2*)(ws + OFF_TOKW);
    int* histg = (int*)(ws + OFF_HIST);
    int* hist = (int*)smem;
    for (int c = blockIdx.x; c < 256; c += gridDim.x) {
        if (tid < 64) hist[tid] = 0;
        __syncthreads();
        for (int rr = 0; rr < 32; ++rr) {
            const int row = c * 256 + wid * 32 + rr;
            float4 v[4];
#pragma unroll
            for (int i = 0; i < 4; ++i) v[i] = *(const float4*)(z + (size_t)row * 1024 + i * 256 + lane * 4);
            ln_row(v, p.ln2g, p.ln2b, lane);
#pragma unroll
            for (int i = 0; i < 4; ++i) {
                *(float4*)(z + (size_t)row * 1024 + i * 256 + lane * 4) = v[i];
                uint2 w; w.x = pk_bf16(v[i].x, v[i].y); w.y = pk_bf16(v[i].z, v[i].w);
                *(uint2*)(hb + (size_t)row * 1024 + i * 256 + lane * 4) = w;
            }
            float g[8];
#pragma unroll
            for (int k = 0; k < 8; ++k) g[k] = 0.f;
#pragma unroll
            for (int i = 0; i < 4; ++i) {
                const float vv[4] = {v[i].x, v[i].y, v[i].z, v[i].w};
#pragma unroll
                for (int jj = 0; jj < 4; ++jj) {
                    const float4* wp = (const float4*)(p.w_rg + (size_t)(i * 256 + lane * 4 + jj) * 8);
                    const float4 w0 = wp[0], w1 = wp[1];
                    g[0] += vv[jj] * w0.x; g[1] += vv[jj] * w0.y; g[2] += vv[jj] * w0.z; g[3] += vv[jj] * w0.w;
                    g[4] += vv[jj] * w1.x; g[5] += vv[jj] * w1.y; g[6] += vv[jj] * w1.z; g[7] += vv[jj] * w1.w;
                }
            }
            float gmax = -INFINITY; int gsel = 0;
#pragma unroll
            for (int k = 0; k < 8; ++k) { g[k] = wsum(g[k]) + p.b_rg[k]; if (g[k] > gmax) { gmax = g[k]; gsel = k; } }
            float gs = 0.f;
#pragma unroll
            for (int k = 0; k < 8; ++k) gs += __expf(g[k] - gmax);
            const float pgroup = 1.0f / gs;
            gsel = __builtin_amdgcn_readfirstlane(gsel);
            float ex[8];
#pragma unroll
            for (int k = 0; k < 8; ++k) ex[k] = 0.f;
#pragma unroll
            for (int i = 0; i < 4; ++i) {
                const float vv[4] = {v[i].x, v[i].y, v[i].z, v[i].w};
#pragma unroll
                for (int jj = 0; jj < 4; ++jj) {
                    const float4* wp = (const float4*)(p.w_re + (size_t)(i * 256 + lane * 4 + jj) * 64 + gsel * 8);
                    const float4 w0 = wp[0], w1 = wp[1];
                    ex[0] += vv[jj] * w0.x; ex[1] += vv[jj] * w0.y; ex[2] += vv[jj] * w0.z; ex[3] += vv[jj] * w0.w;
                    ex[4] += vv[jj] * w1.x; ex[5] += vv[jj] * w1.y; ex[6] += vv[jj] * w1.z; ex[7] += vv[jj] * w1.w;
                }
            }
            float v0 = -INFINITY, v1 = -INFINITY; int i0 = 0, i1 = 0;
#pragma unroll
            for (int k = 0; k < 8; ++k) {
                const float lv = wsum(ex[k]) + p.b_re[gsel * 8 + k];
                if (lv > v0) { v1 = v0; i1 = i0; v0 = lv; i0 = k; }
                else if (lv > v1) { v1 = lv; i1 = k; }
            }
            const float e1 = __expf(v1 - v0), den = 1.0f + e1;
            const float w0 = pgroup / den, w1 = pgroup * e1 / den;
            if (lane == 0) {
                const int ea = gsel * 8 + i0, eb = gsel * 8 + i1;
                toke[row] = make_int2(ea, eb); tokw[row] = make_float2(w0, w1);
                atomicAdd(&hist[ea], 1); atomicAdd(&hist[eb], 1);
            }
        }
        __syncthreads();
        if (tid < 64) histg[c * 64 + tid] = hist[tid];
        __syncthreads();
    }
}

__device__ void compute_segments(const int* histg, int* seg, int tid) {
    if (tid < 64) {
        int s = 0;
        for (int c = 0; c < 256; ++c) s += histg[c * 64 + tid];
        seg[tid] = s;
    }
    __syncthreads();
    if (tid == 0) {
        int acc = 0;
        for (int e = 0; e < 64; ++e) { seg[64 + e] = acc; acc += (seg[e] + 255) >> 8; }
        seg[128] = acc;
    }
    __syncthreads();
}

__device__ void phase8(const Params& p, char* smem) {
    const int tid = threadIdx.x;
    char* ws = p.ws;
    const int* histg = (const int*)(ws + OFF_HIST);
    const int2* toke = (const int2*)(ws + OFF_TOKE); const float2* tokw = (const float2*)(ws + OFF_TOKW);
    int* slot_tok = (int*)(ws + OFF_SLOTTOK); float* slot_w = (float*)(ws + OFF_SLOTW);
    int* seg = (int*)smem;
    int* cursor = seg + 192;
    compute_segments(histg, seg, tid);
    for (int e = blockIdx.x; e < 64; e += gridDim.x) {
        const int start = seg[64 + e] * 256 + seg[e], end = seg[64 + e + 1] * 256;
        for (int s = start + tid; s < end; s += NTHR) { slot_tok[s] = -1; slot_w[s] = 0.f; }
    }
    for (int c = blockIdx.x; c < 256; c += gridDim.x) {
        __syncthreads();
        if (tid < 64) {
            int base = 0;
            for (int cc = 0; cc < c; ++cc) base += histg[cc * 64 + tid];
            cursor[tid] = seg[64 + tid] * 256 + base;
        }
        __syncthreads();
        if (tid < 256) {
            const int tok = c * 256 + tid;
            const int2 ee = toke[tok]; const float2 ww = tokw[tok];
            const int s0 = atomicAdd(&cursor[ee.x], 1);
            const int s1 = atomicAdd(&cursor[ee.y], 1);
            slot_tok[s0] = tok * 2; slot_w[s0] = ww.x;
            slot_tok[s1] = tok * 2 + 1; slot_w[s1] = ww.y;
        }
    }
}

__device__ void phase9a(const Params& p, char* smem) {
    const int tid = threadIdx.x, lane = tid & 63, wid = tid >> 6, wr = wid >> 1, wc = wid & 1, fr = lane & 15, fq = lane >> 4;
    char* ws = p.ws;
    int* seg = (int*)(smem + LDS_GEMM);
    compute_segments((const int*)(ws + OFF_HIST), seg, tid);
    const int nrt = seg[128];
    const int* slot_tok = (const int*)(ws + OFF_SLOTTOK);
    const bf16_t* h2b = (const bf16_t*)(ws + OFF_R0);
    bf16_t* hbuf = (bf16_t*)(ws + OFF_R1);
    for (int t = blockIdx.x; t < nrt * 4; t += gridDim.x) {
        const int rtile = t >> 2, nt = t & 3;
        int e = 0;
        for (int k = 1; k < 64; ++k) if (seg[64 + k] <= rtile) e = k;
        GemmSrc s;
        {
            const int r = tid >> 3, lc = (tid & 7) ^ ((r >> 1) & 7);
#pragma unroll
            for (int i = 0; i < 4; ++i) {
                const int tk = slot_tok[rtile * 256 + i * 64 + r];
                const int tok = tk < 0 ? 0 : (tk >> 1);
                s.a[i] = h2b + (size_t)tok * 1024 + lc * 8;
            }
#pragma unroll
            for (int i = 0; i < 2; ++i) s.b[i] = (const bf16_t*)(ws + OFF_WGU) + (size_t)e * 512 * 1024 + (size_t)(nt * 128 + i * 64 + r) * 1024 + lc * 8;
        }
        f32x4 acc[4][4]; zero_acc(acc);
        gemm_loop(acc, s, 16, smem, tid);
        const int row0 = rtile * 256 + wr * 64 + fr;
        const int colb = (nt * 2 + wc) * 32 + fq * 4;
#pragma unroll
        for (int m = 0; m < 4; ++m) {
            const size_t slot = row0 + m * 16;
#pragma unroll
            for (int n = 0; n < 2; ++n) {
                const f32x4 g = acc[m][n], u = acc[m][n + 2];
                f32x4 v;
#pragma unroll
                for (int j = 0; j < 4; ++j) v[j] = g[j] * sigmoidf_(g[j]) * u[j];
                store_bf16x4(hbuf + slot * 256 + colb + n * 16, v);
            }
        }
    }
}

__device__ void phase9b(const Params& p, char* smem) {
    const int tid = threadIdx.x, lane = tid & 63, wid = tid >> 6, wr = wid >> 1, wc = wid & 1, fr = lane & 15, fq = lane >> 4;
    char* ws = p.ws;
    int* seg = (int*)(smem + LDS_GEMM);
    compute_segments((const int*)(ws + OFF_HIST), seg, tid);
    const int nrt = seg[128];
    const int* slot_tok = (const int*)(ws + OFF_SLOTTOK); const float* slot_w = (const float*)(ws + OFF_SLOTW);
    const bf16_t* hbuf = (const bf16_t*)(ws + OFF_R1);
    bf16_t* yb = (bf16_t*)(ws + OFF_YB);
    for (int t = blockIdx.x; t < nrt * 8; t += gridDim.x) {
        const int rtile = t >> 3, nt = t & 7;
        int e = 0;
        for (int k = 1; k < 64; ++k) if (seg[64 + k] <= rtile) e = k;
        GemmSrc s;
        make_src(s, hbuf, 256, rtile * 256, (const bf16_t*)(ws + OFF_WD) + (size_t)e * 1024 * 256, 256, nt * 128, tid);
        f32x4 acc[4][4]; zero_acc(acc);
        gemm_loop(acc, s, 4, smem, tid);
        const int row0 = rtile * 256 + wr * 64 + fr, col0 = nt * 128 + wc * 64 + fq * 4;
#pragma unroll
        for (int m = 0; m < 4; ++m) {
            const int slot = row0 + m * 16;
            const int tk = slot_tok[slot]; const float w = slot_w[slot];
            if (tk >= 0) {
#pragma unroll
                for (int n = 0; n < 4; ++n) store_bf16x4(yb + (size_t)tk * 1024 + col0 + n * 16, acc[m][n] * w);
            }
        }
    }
}

__device__ void phase10(const Params& p) {
    const int lane = threadIdx.x & 63, wid = threadIdx.x >> 6;
    const float* h2 = (const float*)(p.ws + OFF_Z2); const bf16_t* yb = (const bf16_t*)(p.ws + OFF_YB);
    for (int row = blockIdx.x * 8 + wid; row < T_; row += gridDim.x * 8) {
        float4 v[4];
#pragma unroll
        for (int i = 0; i < 4; ++i) {
            const float4 hh = *(const float4*)(h2 + (size_t)row * 1024 + i * 256 + lane * 4);
            const uint2 a = *(const uint2*)(yb + (size_t)(row * 2) * 1024 + i * 256 + lane * 4), b = *(const uint2*)(yb + (size_t)(row * 2 + 1) * 1024 + i * 256 + lane * 4);
            v[i].x = ALPHA * hh.x + bf_lo(a.x) + bf_lo(b.x); v[i].y = ALPHA * hh.y + bf_hi(a.x) + bf_hi(b.x);
            v[i].z = ALPHA * hh.z + bf_lo(a.y) + bf_lo(b.y); v[i].w = ALPHA * hh.w + bf_hi(a.y) + bf_hi(b.y);
        }
        ln_row(v, p.ln3g, p.ln3b, lane);
#pragma unroll
        for (int i = 0; i < 4; ++i) *(float4*)(p.out + (size_t)row * 1024 + i * 256 + lane * 4) = v[i];
    }
}

__global__ void __launch_bounds__(NTHR) mega(Params p) {
    extern __shared__ __attribute__((aligned(16))) char smem[];
    cg::grid_group grid = cg::this_grid();
    char* ws = p.ws;
    phase0(p, smem);
    grid.sync();
    phase1(p, smem);
    grid.sync();
    phase2(p, smem);
    grid.sync();
    phase3(p, smem);
    grid.sync();
    phase_gemm_resid(p, smem, (const bf16_t*)(ws + OFF_R1), (const bf16_t*)(ws + OFF_WMIX), p.x, p.out);
    grid.sync();
    phase_ln1(p);
    moe_weight_prep(p, smem);
    grid.sync();
    phase_gemm_bf16(p, smem, (const bf16_t*)(ws + OFF_R0), (const bf16_t*)(ws + OFF_WXQ), (bf16_t*)(ws + OFF_XQ), 0.0625f);
    grid.sync();
    phase6(p, smem);
    grid.sync();
    phase_gemm_resid(p, smem, (const bf16_t*)(ws + OFF_O), (const bf16_t*)(ws + OFF_WXO), p.out, (float*)(ws + OFF_Z2));
    grid.sync();
    phase_ln2_router(p, smem);
    grid.sync();
    phase8(p, smem);
    grid.sync();
    phase9a(p, smem);
    grid.sync();
    phase9b(p, smem);
    grid.sync();
    phase10(p);
}

extern "C" void kernel_launch(void* const* d_in, const int* in_sizes, int n_in, void* d_out, int out_size,
                              void* d_ws, size_t ws_size, hipStream_t stream) {
    static int grid_blocks = 0;
    if (!grid_blocks) {
        int dev = 0, cus = 0, per_cu = 0;
        (void)hipGetDevice(&dev);
        (void)hipDeviceGetAttribute(&cus, hipDeviceAttributeMultiprocessorCount, dev);
        (void)hipFuncSetAttribute((const void*)mega, hipFuncAttributeMaxDynamicSharedMemorySize, LDS_BYTES);
        (void)hipOccupancyMaxActiveBlocksPerMultiprocessor(&per_cu, mega, NTHR, LDS_BYTES);
        if (per_cu > 1) per_cu = 1;
        grid_blocks = cus * per_cu;
        if (ws_size < WS_NEED) fprintf(stderr, "workspace too small: %zu\n", ws_size);
    }
    Params p{};
    const float* const* f = (const float* const*)d_in;
    p.x = f[0]; p.mem = f[1]; p.pos = (const int*)d_in[2];
    p.w_in = f[3]; p.sinks = f[4]; p.conv_w = f[5]; p.conv_b = f[6]; p.b_ig = f[7]; p.b_fg = f[8]; p.ml_g = f[9];
    p.w_att = f[10]; p.w_ml = f[11]; p.w_mix = f[12]; p.ln1g = f[13]; p.ln1b = f[14];
    p.w_xq = f[15]; p.w_xkv = f[16]; p.w_xo = f[17]; p.ln2g = f[18]; p.ln2b = f[19];
    p.w_rg = f[20]; p.b_rg = f[21]; p.w_re = f[22]; p.b_re = f[23]; p.w_gate = f[24]; p.w_up = f[25]; p.w_down = f[26];
    p.ln3g = f[27]; p.ln3b = f[28];
    p.out = (float*)d_out; p.ws = (char*)d_ws;
    void* args[] = {&p};
    hipError_t e = hipLaunchCooperativeKernel((void*)mega, dim3(grid_blocks), dim3(NTHR), args, LDS_BYTES, stream);
    if (e != hipSuccess) fprintf(stderr, "cooperative launch failed: %s (grid %d)\n", hipGetErrorString(e), grid_blocks);
}
```

```cpp
#include <hip/hip_runtime.h>
#include <hip/hip_cooperative_groups.h>
#include <cstdio>
#include <cstdint>
namespace cg = cooperative_groups;

typedef unsigned short bf16_t;
typedef short bf16x8 __attribute__((ext_vector_type(8)));
typedef float f32x4 __attribute__((ext_vector_type(4)));
typedef unsigned u32x2 __attribute__((ext_vector_type(2)));
typedef unsigned u32x4 __attribute__((ext_vector_type(4)));
#define LDS_AS __attribute__((address_space(3)))
#define GLB_AS __attribute__((address_space(1)))

constexpr int T_ = 65536;
constexpr int NTHR = 512;
constexpr size_t MiB = 1ull << 20;
constexpr float ALPHA = 1.189207115002721f;
constexpr size_t OFF_R0 = 0;
constexpr size_t OFF_R1 = 128 * MiB;
constexpr size_t OFF_AK = 256 * MiB;
constexpr size_t OFF_AV = 272 * MiB;
constexpr size_t OFF_MQK = 288 * MiB;
constexpr size_t OFF_MV = 416 * MiB;
constexpr size_t OFF_MO = 544 * MiB;
constexpr size_t OFF_GG = 672 * MiB;
constexpr size_t OFF_WGU = 256 * MiB;
constexpr size_t OFF_WD = 320 * MiB;
constexpr size_t OFF_XQ = 352 * MiB;
constexpr size_t OFF_O = 480 * MiB;
constexpr size_t OFF_Z2 = 608 * MiB;
constexpr size_t OFF_YB = 352 * MiB;
constexpr size_t OFF_MISC = 928 * MiB;
constexpr size_t OFF_WIN = OFF_MISC;
constexpr size_t OFF_WATT = OFF_MISC + 13 * MiB;
constexpr size_t OFF_WML = OFF_MISC + 15 * MiB;
constexpr size_t OFF_WMIX = OFF_MISC + 17 * MiB;
constexpr size_t OFF_WXQ = OFF_MISC + 19 * MiB;
constexpr size_t OFF_WXO = OFF_MISC + 21 * MiB;
constexpr size_t OFF_WXKV = OFF_MISC + 23 * MiB;
constexpr size_t OFF_MEMB = OFF_MISC + 27 * MiB;
constexpr size_t OFF_KMAT = OFF_MISC + 35 * MiB;
constexpr size_t OFF_VT = OFF_MISC + 43 * MiB;
constexpr size_t OFF_GATES = OFF_MISC + 51 * MiB;
constexpr size_t OFF_CS = OFF_MISC + 53 * MiB;
constexpr size_t OFF_TOKE = OFF_MISC + 69 * MiB;
constexpr size_t OFF_TOKW = OFF_MISC + 70 * MiB;
constexpr size_t OFF_SLOTTOK = OFF_MISC + 71 * MiB;
constexpr size_t OFF_SLOTW = OFF_MISC + 72 * MiB;
constexpr size_t OFF_HIST = OFF_MISC + 73 * MiB;
constexpr size_t WS_NEED = 1024 * MiB;
constexpr int LDS_GEMM = 131072;
constexpr int LDS_BYTES = LDS_GEMM + 1024;

struct Params {
    const float *x, *mem; const int* pos;
    const float *w_in, *sinks, *conv_w, *conv_b, *b_ig, *b_fg, *ml_g, *w_att, *w_ml, *w_mix, *ln1g, *ln1b;
    const float *w_xq, *w_xkv, *w_xo, *ln2g, *ln2b, *w_rg, *b_rg, *w_re, *b_re, *w_gate, *w_up, *w_down, *ln3g, *ln3b;
    float* out; char* ws;
};

__device__ const double INV_FREQ[32] = {1.0, 0.7498942093324559, 0.5623413251903491, 0.4216965034285822, 0.31622776601683794, 0.23713737056616552, 0.1778279410038923, 0.1333521432163324, 0.1, 0.07498942093324558, 0.05623413251903491, 0.042169650342858224, 0.03162277660168379, 0.023713737056616554, 0.01778279410038923, 0.01333521432163324, 0.01, 0.007498942093324558, 0.005623413251903491, 0.004216965034285823, 0.0031622776601683794, 0.0023713737056616554, 0.0017782794100389228, 0.001333521432163324, 0.001, 0.0007498942093324559, 0.0005623413251903491, 0.00042169650342858224, 0.00031622776601683794, 0.00023713737056616554, 0.00017782794100389227, 0.0001333521432163324};

__device__ __forceinline__ unsigned pk_bf16(float lo, float hi) { unsigned r; asm("v_cvt_pk_bf16_f32 %0, %1, %2" : "=v"(r) : "v"(lo), "v"(hi)); return r; }
__device__ __forceinline__ float bf_lo(unsigned u) { return __uint_as_float(u << 16); }
__device__ __forceinline__ float bf_hi(unsigned u) { return __uint_as_float(u & 0xffff0000u); }
__device__ __forceinline__ float bf2f(bf16_t h) { return __uint_as_float(((unsigned)h) << 16); }
__device__ __forceinline__ float wsum(float v) {
#pragma unroll
    for (int o = 32; o; o >>= 1) v += __shfl_xor(v, o);
    return v;
}
__device__ __forceinline__ float wmaxf(float v) {
#pragma unroll
    for (int o = 32; o; o >>= 1) v = fmaxf(v, __shfl_xor(v, o));
    return v;
}
__device__ __forceinline__ float sigmoidf_(float x) { return 1.0f / (1.0f + __expf(-x)); }
__device__ __forceinline__ void glds16(const bf16_t* g, char* l) {
    __builtin_amdgcn_global_load_lds((const GLB_AS void*)g, (LDS_AS void*)l, 16, 0, 0);
}

struct GemmSrc { const bf16_t* a[4]; const bf16_t* b[2]; };

__device__ __forceinline__ void stage_tile(const GemmSrc& s, int koff, char* buf, int tid) {
#pragma unroll
    for (int i = 0; i < 4; ++i) glds16(s.a[i] + koff, buf + (i * 512 + tid) * 16);
#pragma unroll
    for (int i = 0; i < 2; ++i) glds16(s.b[i] + koff, buf + 32768 + (i * 512 + tid) * 16);
}

__device__ __forceinline__ void gemm_loop(f32x4 (&acc)[4][4], const GemmSrc& s, int nk, char* smem, int tid) {
    const int lane = tid & 63, wid = tid >> 6, wr = wid >> 1, wc = wid & 1, fr = lane & 15, fq = lane >> 4;
    const int swz = (fr >> 1) & 7;
    const int aoff = (wr * 64 + fr) * 128;
    const int boff = 32768 + (wc * 64 + fr) * 128;
    stage_tile(s, 0, smem, tid);
    for (int t = 0; t < nk; ++t) {
        asm volatile("s_waitcnt vmcnt(0)" ::: "memory");
        __syncthreads();
        char* cur = smem + (t & 1) * 49152;
        if (t + 1 < nk) stage_tile(s, (t + 1) * 64, smem + ((t + 1) & 1) * 49152, tid);
#pragma unroll
        for (int ks = 0; ks < 2; ++ks) {
            const int ch = ((ks * 4 + fq) ^ swz) * 16;
            bf16x8 xa[4], wb[4];
#pragma unroll
            for (int m = 0; m < 4; ++m) xa[m] = *(const bf16x8*)(cur + aoff + m * 2048 + ch);
#pragma unroll
            for (int n = 0; n < 4; ++n) wb[n] = *(const bf16x8*)(cur + boff + n * 2048 + ch);
#pragma unroll
            for (int m = 0; m < 4; ++m)
#pragma unroll
                for (int n = 0; n < 4; ++n) acc[m][n] = __builtin_amdgcn_mfma_f32_16x16x32_bf16(wb[n], xa[m], acc[m][n], 0, 0, 0);
        }
    }
    __syncthreads();
}

__device__ __forceinline__ void zero_acc(f32x4 (&acc)[4][4]) {
#pragma unroll
    for (int m = 0; m < 4; ++m)
#pragma unroll
        for (int n = 0; n < 4; ++n) acc[m][n] = (f32x4){0.f, 0.f, 0.f, 0.f};
}

__device__ __forceinline__ void make_src(GemmSrc& s, const bf16_t* A, size_t lda, int rowA0, const bf16_t* Bt, size_t ldb, int rowB0, int tid) {
    const int r = tid >> 3, lc = (tid & 7) ^ ((r >> 1) & 7);
#pragma unroll
    for (int i = 0; i < 4; ++i) s.a[i] = A + (size_t)(rowA0 + i * 64 + r) * lda + lc * 8;
#pragma unroll
    for (int i = 0; i < 2; ++i) s.b[i] = Bt + (size_t)(rowB0 + i * 64 + r) * ldb + lc * 8;
}

__device__ __forceinline__ void store_bf16x4(bf16_t* p, f32x4 v) {
    uint2 w; w.x = pk_bf16(v[0], v[1]); w.y = pk_bf16(v[2], v[3]); *(uint2*)p = w;
}

__device__ __forceinline__ void tr_tile(const float* src, size_t ld_src, int k0, int c0, bf16_t* dst, size_t ld_dst, int r0, float* tile, int tid) {
    {
        const int r = tid >> 3, c4 = (tid & 7) * 4;
        const float4 v = *(const float4*)(src + (size_t)(k0 + r) * ld_src + c0 + c4);
        float* tp = tile + r * 33 + c4; tp[0] = v.x; tp[1] = v.y; tp[2] = v.z; tp[3] = v.w;
    }
    __syncthreads();
    {
        const int c = tid >> 4, rc = (tid & 15) * 4;
        const float a0 = tile[(rc + 0) * 33 + c], a1 = tile[(rc + 1) * 33 + c], a2 = tile[(rc + 2) * 33 + c], a3 = tile[(rc + 3) * 33 + c];
        uint2 w; w.x = pk_bf16(a0, a1); w.y = pk_bf16(a2, a3);
        *(uint2*)(dst + (size_t)(r0 + c) * ld_dst + k0 + rc) = w;
    }
    __syncthreads();
}

__device__ void phase0(const Params& p, char* smem) {
    const int tid = threadIdx.x, lane = tid & 63, wid = tid >> 6;
    const int gw = blockIdx.x * 8 + wid, nw = gridDim.x * 8;
    char* ws = p.ws;
    bf16_t* xb = (bf16_t*)(ws + OFF_R0);
    float* gates = (float*)(ws + OFF_GATES);
    for (int row = gw; row < T_; row += nw) {
        const float4* xr = (const float4*)(p.x + (size_t)row * 1024);
        float g0 = 0, g1 = 0, g2 = 0, g3 = 0, g4 = 0, g5 = 0, g6 = 0, g7 = 0;
#pragma unroll
        for (int i = 0; i < 4; ++i) {
            const float4 v = xr[i * 64 + lane];
            uint2 w; w.x = pk_bf16(v.x, v.y); w.y = pk_bf16(v.z, v.w);
            *(uint2*)(xb + (size_t)row * 1024 + i * 256 + lane * 4) = w;
            const float vv[4] = {v.x, v.y, v.z, v.w};
#pragma unroll
            for (int jj = 0; jj < 4; ++jj) {
                const int k = i * 256 + lane * 4 + jj;
                const float4* wp = (const float4*)(p.w_in + (size_t)k * 6408 + 4352);
                const float4 w0 = wp[0], w1 = wp[1];
                g0 += vv[jj] * w0.x; g1 += vv[jj] * w0.y; g2 += vv[jj] * w0.z; g3 += vv[jj] * w0.w;
                g4 += vv[jj] * w1.x; g5 += vv[jj] * w1.y; g6 += vv[jj] * w1.z; g7 += vv[jj] * w1.w;
            }
        }
        g0 = wsum(g0); g1 = wsum(g1); g2 = wsum(g2); g3 = wsum(g3); g4 = wsum(g4); g5 = wsum(g5); g6 = wsum(g6); g7 = wsum(g7);
        if (lane == 0) {
            float4* gp = (float4*)(gates + (size_t)row * 8);
            gp[0] = make_float4(g0, g1, g2, g3); gp[1] = make_float4(g4, g5, g6, g7);
        }
    }
    {
        float2* cs = (float2*)(ws + OFF_CS);
        const int gt = blockIdx.x * NTHR + tid, nt = gridDim.x * NTHR;
        for (int idx = gt; idx < T_ * 32; idx += nt) {
            const int tok = idx >> 5, i = idx & 31;
            const double ang = (double)p.pos[tok] * INV_FREQ[i];
            const double turns = ang * 0.15915494309189535;
            const float f = (float)(turns - rint(turns));
            cs[idx] = make_float2(__builtin_amdgcn_cosf(f), __builtin_amdgcn_sinf(f));
        }
        bf16_t* memb = (bf16_t*)(ws + OFF_MEMB);
        for (int idx = gt; idx < 4096 * 1024 / 4; idx += nt) {
            const float4 v = ((const float4*)p.mem)[idx];
            uint2 w; w.x = pk_bf16(v.x, v.y); w.y = pk_bf16(v.z, v.w);
            ((uint2*)memb)[idx] = w;
        }
    }
    {
        float* tile = (float*)smem;
        const int NT_WIN = 16 * 200, NT_SQ = 16 * 32, NT_XKV = 16 * 64;
        const int total = NT_WIN + 5 * NT_SQ + NT_XKV;
        for (int t = blockIdx.x; t < total; t += gridDim.x) {
            if (t < NT_WIN) {
                const int kt = t & 15, nt_ = t >> 4;
                const int n0 = nt_ * 32, c0 = n0 < 4352 ? n0 : n0 + 8;
                tr_tile(p.w_in, 6408, kt * 64, c0, (bf16_t*)(ws + OFF_WIN), 1024, n0, tile, tid);
            } else if (t < NT_WIN + 5 * NT_SQ) {
                const int u = t - NT_WIN, which = u / NT_SQ, v = u % NT_SQ, kt = v & 15, nt_ = v >> 4;
                const float* src = which == 0 ? p.w_att : which == 1 ? p.w_ml : which == 2 ? p.w_mix : which == 3 ? p.w_xq : p.w_xo;
                bf16_t* dst = (bf16_t*)(ws + OFF_WATT + (size_t)which * 2 * MiB);
                tr_tile(src, 1024, kt * 64, nt_ * 32, dst, 1024, nt_ * 32, tile, tid);
            } else {
                const int v = t - NT_WIN - 5 * NT_SQ, kt = v & 15, nt_ = v >> 4;
                tr_tile(p.w_xkv, 2048, kt * 64, nt_ * 32, (bf16_t*)(ws + OFF_WXKV), 1024, nt_ * 32, tile, tid);
            }
        }
    }
}

__device__ void moe_weight_prep(const Params& p, char* smem) {
    const int tid = threadIdx.x;
    float* tile = (float*)smem;
    char* ws = p.ws;
    const int per_e = 384, total = 64 * per_e;
    for (int t = blockIdx.x; t < total; t += gridDim.x) {
        const int e = t / per_e, u = t % per_e;
        if (u < 256) {
            const int isup = u >> 7, v = u & 127, kt = v & 15, j = v >> 4;
            const float* src = (isup ? p.w_up : p.w_gate) + (size_t)e * 1024 * 256;
            tr_tile(src, 256, kt * 64, j * 32, (bf16_t*)(ws + OFF_WGU) + (size_t)e * 512 * 1024, 1024, j * 64 + isup * 32, tile, tid);
        } else {
            const int v = u - 256, kt = v & 3, nt_ = v >> 2;
            tr_tile(p.w_down + (size_t)e * 256 * 1024, 1024, kt * 64, nt_ * 32, (bf16_t*)(ws + OFF_WD) + (size_t)e * 1024 * 256, 256, nt_ * 32, tile, tid);
        }
    }
}

__device__ void phase1(const Params& p, char* smem) {
    const int tid = threadIdx.x, lane = tid & 63, wid = tid >> 6, wr = wid >> 1, wc = wid & 1, fr = lane & 15, fq = lane >> 4;
    char* ws = p.ws;
    const int NMAIN = 256 * 50, NKV = 256;
    for (int t = blockIdx.x; t < NMAIN + NKV; t += gridDim.x) {
        GemmSrc s; int rt, ct; const bool main_ = t < NMAIN; const bool isvt = t >= NMAIN + 128;
        if (main_) { rt = t / 50; ct = t % 50; make_src(s, (const bf16_t*)(ws + OFF_R0), 1024, rt * 256, (const bf16_t*)(ws + OFF_WIN), 1024, ct * 128, tid); }
        else if (!isvt) { const int u = t - NMAIN; rt = u >> 3; ct = u & 7; make_src(s, (const bf16_t*)(ws + OFF_MEMB), 1024, rt * 256, (const bf16_t*)(ws + OFF_WXKV), 1024, ct * 128, tid); }
        else { const int u = t - NMAIN - 128; rt = u >> 5; ct = u & 31; make_src(s, (const bf16_t*)(ws + OFF_WXKV) + (size_t)1024 * 1024, 1024, rt * 256, (const bf16_t*)(ws + OFF_MEMB), 1024, ct * 128, tid); }
        f32x4 acc[4][4]; zero_acc(acc);
        gemm_loop(acc, s, 16, smem, tid);
        const int row0 = rt * 256 + wr * 64 + fr;
        const int c0w = ct * 128 + wc * 64;
        if (main_ && c0w < 1152) {
            bf16_t* dst; int ld, cb; float sc;
            if (c0w < 1024) { dst = (bf16_t*)(ws + OFF_R1); ld = 1024; cb = c0w; sc = 0.125f; }
            else { dst = (bf16_t*)(ws + OFF_AK); ld = 128; cb = c0w - 1024; sc = 1.0f; }
            const float* cs = (const float*)(ws + OFF_CS);
#pragma unroll
            for (int m = 0; m < 4; ++m) {
                const int tok = row0 + m * 16;
#pragma unroll
                for (int n = 0; n < 2; ++n) {
                    const int d0 = n * 16 + fq * 4;
                    const float4* cp = (const float4*)(cs + (size_t)tok * 64 + d0 * 2);
                    const float4 c01 = cp[0], c23 = cp[1];
                    const f32x4 x1 = acc[m][n], x2 = acc[m][n + 2];
                    f32x4 o1, o2;
                    o1[0] = (x1[0] * c01.x - x2[0] * c01.y) * sc; o2[0] = (x2[0] * c01.x + x1[0] * c01.y) * sc;
                    o1[1] = (x1[1] * c01.z - x2[1] * c01.w) * sc; o2[1] = (x2[1] * c01.z + x1[1] * c01.w) * sc;
                    o1[2] = (x1[2] * c23.x - x2[2] * c23.y) * sc; o2[2] = (x2[2] * c23.x + x1[2] * c23.y) * sc;
                    o1[3] = (x1[3] * c23.z - x2[3] * c23.w) * sc; o2[3] = (x2[3] * c23.z + x1[3] * c23.w) * sc;
                    bf16_t* rp = dst + (size_t)tok * ld + cb + d0;
                    store_bf16x4(rp, o1); store_bf16x4(rp + 32, o2);
                }
            }
        } else {
            bf16_t* dst; int ld, cb; bool sig = false;
            if (!main_) { if (isvt) { dst = (bf16_t*)(ws + OFF_VT); ld = 4096; cb = c0w; } else { dst = (bf16_t*)(ws + OFF_KMAT); ld = 1024; cb = c0w; } }
            else if (c0w < 1280) { dst = nullptr; ld = 0; cb = c0w - 1152; }
            else if (c0w < 2304) { dst = (bf16_t*)(ws + OFF_MQK); ld = 1024; cb = c0w - 1280; }
            else if (c0w < 3328) { dst = (bf16_t*)(ws + OFF_MV); ld = 1024; cb = c0w - 2304; }
            else if (c0w < 4352) { dst = (bf16_t*)(ws + OFF_MO); ld = 1024; cb = c0w - 3328; sig = true; }
            else { dst = (bf16_t*)(ws + OFF_GG); ld = 2048; cb = c0w - 4352; sig = true; }
            if (dst == nullptr) {
                bf16_t* avT = (bf16_t*)(ws + OFF_AV);
#pragma unroll
                for (int m = 0; m < 4; ++m)
#pragma unroll
                    for (int n = 0; n < 4; ++n)
#pragma unroll
                        for (int j = 0; j < 4; ++j)
                            avT[(size_t)(cb + n * 16 + fq * 4 + j) * T_ + row0 + m * 16] = (bf16_t)(pk_bf16(acc[m][n][j], acc[m][n][j]) & 0xffffu);
            } else {
#pragma unroll
            for (int m = 0; m < 4; ++m) {
                bf16_t* rp = dst + (size_t)(row0 + m * 16) * ld + cb + fq * 4;
#pragma unroll
                for (int n = 0; n < 4; ++n) {
                    f32x4 v = acc[m][n];
                    if (sig) { v[0] = sigmoidf_(v[0]); v[1] = sigmoidf_(v[1]); v[2] = sigmoidf_(v[2]); v[3] = sigmoidf_(v[3]); }
                    store_bf16x4(rp + n * 16, v);
                }
            }
            }
        }
    }
}

__device__ void mlstm_item(const Params& p, char* smem, int item, float* hm_out_f32_unused) {
    (void)hm_out_f32_unused;
    const int tid = threadIdx.x, lane = tid & 63;
    const int b = item >> 2, h = item & 3;
    char* ws = p.ws;
    const bf16_t* mqk = (const bf16_t*)(ws + OFF_MQK);
    const bf16_t* mv = (const bf16_t*)(ws + OFF_MV);
    const bf16_t* mo = (const bf16_t*)(ws + OFF_MO);
    const float* gates = (const float*)(ws + OFF_GATES);
    bf16_t* hm = (bf16_t*)p.out;
    float* qs = (float*)smem;
    float* ks = qs + 16 * 128;
    float* hpart = ks + 16 * 128;
    float* fl = hpart + 2 * 16 * 256;
    float* eil = fl + 16;
    float* denl = eil + 16;
    float* ssq = denl + 16;
    const int e = tid & 255, dh = tid >> 8;
    float C[64];
#pragma unroll
    for (int d = 0; d < 64; ++d) C[d] = 0.f;
    float nreg = 0.f;
    const int cc = tid & 255, tg = tid >> 8;
    const int ccol = cc < 128 ? (h * 128 + cc) : (512 + h * 128 + (cc - 128));
    const float cw0 = p.conv_w[0 * 1024 + ccol], cw1 = p.conv_w[1 * 1024 + ccol], cw2 = p.conv_w[2 * 1024 + ccol], cw3 = p.conv_w[3 * 1024 + ccol];
    const float cbias = p.conv_b[ccol];
    const float big = p.b_ig[h], bfg = p.b_fg[h];
    const float gnorm = p.ml_g[h * 256 + e];
    const size_t tokb = (size_t)b * 4096;
    for (int t0 = 0; t0 < 4096; t0 += 16) {
        {
            const int ts = t0 + tg * 8;
            float r[11];
#pragma unroll
            for (int i = 0; i < 11; ++i) { const int tt = ts - 3 + i; r[i] = tt >= 0 ? bf2f(mqk[(tokb + tt) * 1024 + ccol]) : 0.f; }
#pragma unroll
            for (int i = 0; i < 8; ++i) {
                float v = cw0 * r[i] + cw1 * r[i + 1] + cw2 * r[i + 2] + cw3 * r[i + 3] + cbias;
                v = v * sigmoidf_(v);
                if (cc < 128) qs[(tg * 8 + i) * 128 + cc] = v; else ks[(tg * 8 + i) * 128 + (cc - 128)] = v * 0.08838834764831845f;
            }
        }
        if (tid < 16) {
            const size_t tok = tokb + t0 + tid;
            const float mi = gates[tok * 8 + h] + big, mf = gates[tok * 8 + 4 + h] + bfg;
            fl[tid] = sigmoidf_(mf); eil[tid] = __expf(mi); denl[tid] = 0.f; ssq[tid] = 0.f;
        }
        float vv[16];
#pragma unroll
        for (int tt = 0; tt < 16; ++tt) vv[tt] = bf2f(mv[(tokb + t0 + tt) * 1024 + h * 256 + e]);
        __syncthreads();
#pragma unroll 1
        for (int tt = 0; tt < 16; ++tt) {
            const float f = fl[tt], ei = eil[tt], eiv = ei * vv[tt];
            const float4* kp = (const float4*)(ks + tt * 128 + dh * 64);
            const float4* qp = (const float4*)(qs + tt * 128 + dh * 64);
            float hp = 0.f;
#pragma unroll
            for (int d4 = 0; d4 < 16; ++d4) {
                const float4 kk = kp[d4], qq = qp[d4];
                C[d4 * 4 + 0] = f * C[d4 * 4 + 0] + eiv * kk.x; hp += qq.x * C[d4 * 4 + 0];
                C[d4 * 4 + 1] = f * C[d4 * 4 + 1] + eiv * kk.y; hp += qq.y * C[d4 * 4 + 1];
                C[d4 * 4 + 2] = f * C[d4 * 4 + 2] + eiv * kk.z; hp += qq.z * C[d4 * 4 + 2];
                C[d4 * 4 + 3] = f * C[d4 * 4 + 3] + eiv * kk.w; hp += qq.w * C[d4 * 4 + 3];
            }
            hpart[(dh * 16 + tt) * 256 + e] = hp;
            if (tid < 128) {
                nreg = f * nreg + ei * ks[tt * 128 + tid];
                const float part = wsum(qs[tt * 128 + tid] * nreg);
                if (lane == 0) atomicAdd(&denl[tt], part);
            }
        }
        __syncthreads();
        float hv[8];
#pragma unroll
        for (int i = 0; i < 8; ++i) {
            const int tt = dh * 8 + i;
            const float num = hpart[tt * 256 + e] + hpart[(16 + tt) * 256 + e];
            const float den = denl[tt];
            hv[i] = num / fmaxf(fabsf(den), 1.0f);
            const float sq = wsum(hv[i] * hv[i]);
            if (lane == 0) atomicAdd(&ssq[tt], sq);
        }
        __syncthreads();
#pragma unroll
        for (int i = 0; i < 8; ++i) {
            const int tt = dh * 8 + i;
            const size_t tok = tokb + t0 + tt;
            const float rstd = rsqrtf(ssq[tt] * (1.0f / 256.0f) + 1e-6f);
            const float og = bf2f(mo[tok * 1024 + h * 256 + e]);
            const float o = hv[i] * rstd * gnorm * og;
            hm[tok * 1024 + h * 256 + e] = (bf16_t)(pk_bf16(o, o) & 0xffffu);
        }
        __syncthreads();
    }
}

__device__ void swa_items(const Params& p, char* smem, int first, int stride) {
    const int tid = threadIdx.x, lane = tid & 63, wid = tid >> 6, fr = lane & 15, fq = lane >> 4;
    char* ws = p.ws;
    const bf16_t* aq = (const bf16_t*)(ws + OFF_R1);
    const bf16_t* ak = (const bf16_t*)(ws + OFF_AK);
    const bf16_t* avT = (const bf16_t*)(ws + OFF_AV);
    bf16_t* ao = (bf16_t*)(ws + OFF_R0);
    char* kbuf = smem; char* vbuf = smem + 32768;
    for (int item = first; item < 1024; item += stride) {
        const int kvh = item & 1, n = (item >> 1) & 31, b = item >> 6;
        const int hq = kvh * 8 + wid;
        const long tokbase = (long)b * 4096 + n * 128 - 128;
        {
            const int rk = tid >> 3, pck = tid & 7, lck = pck ^ ((rk >> 1) & 7);
            const bf16_t* srck = ak + (tokbase + rk) * 128 + kvh * 64 + lck * 8;
#pragma unroll
            for (int i = 0; i < 4; ++i) glds16(srck + (long)i * 64 * 128, kbuf + (i * 512 + tid) * 16);
            const int rv = tid >> 5, pcv = tid & 31, lcv = pcv ^ (rv & 15);
            const bf16_t* srcv = avT + (long)(kvh * 64 + rv) * T_ + tokbase + lcv * 8;
#pragma unroll
            for (int i = 0; i < 4; ++i) glds16(srcv + (long)i * 16 * T_, vbuf + (i * 512 + tid) * 16);
        }
        const float sink = p.sinks[hq];
        asm volatile("s_waitcnt vmcnt(0)" ::: "memory");
        __syncthreads();
        const int kswz = (fr >> 1) & 7;
#pragma unroll 1
        for (int u = 0; u < 4; ++u) {
            const long tq = (long)b * 4096 + n * 128 + u * 32 + fr;
            const bf16_t* qp = aq + tq * 1024 + hq * 64 + fq * 8;
            const bf16x8 q00 = *(const bf16x8*)(qp), q01 = *(const bf16x8*)(qp + 32);
            const bf16x8 q10 = *(const bf16x8*)(qp + 16 * 1024), q11 = *(const bf16x8*)(qp + 16 * 1024 + 32);
            f32x4 sc[10][2];
#pragma unroll
            for (int r = 0; r < 10; ++r) {
                sc[r][0] = (f32x4){0.f, 0.f, 0.f, 0.f}; sc[r][1] = (f32x4){0.f, 0.f, 0.f, 0.f};
                if (!(n == 0 && (2 * u + r) < 8)) {
                    const char* rowp = kbuf + ((2 * u + r) * 16 + fr) * 128;
                    const bf16x8 k0 = *(const bf16x8*)(rowp + ((fq ^ kswz) * 16)), k1 = *(const bf16x8*)(rowp + (((4 + fq) ^ kswz) * 16));
                    sc[r][0] = __builtin_amdgcn_mfma_f32_16x16x32_bf16(k0, q00, sc[r][0], 0, 0, 0);
                    sc[r][0] = __builtin_amdgcn_mfma_f32_16x16x32_bf16(k1, q01, sc[r][0], 0, 0, 0);
                    sc[r][1] = __builtin_amdgcn_mfma_f32_16x16x32_bf16(k0, q10, sc[r][1], 0, 0, 0);
                    sc[r][1] = __builtin_amdgcn_mfma_f32_16x16x32_bf16(k1, q11, sc[r][1], 0, 0, 0);
                }
            }
            u32x4 pf[2][5]; float linv[2];
#pragma unroll
            for (int nt = 0; nt < 2; ++nt) {
                float m = sink;
#pragma unroll
                for (int r = 0; r < 10; ++r) {
                    const bool tile_ok = !(n == 0 && (2 * u + r) < 8);
#pragma unroll
                    for (int j = 0; j < 4; ++j) {
                        const int delta = (r - nt) * 16 + fq * 4 + j - fr;
                        const bool ok = tile_ok && delta >= 1 && delta <= 128;
                        sc[r][nt][j] = ok ? sc[r][nt][j] : -INFINITY;
                        m = fmaxf(m, sc[r][nt][j]);
                    }
                }
                m = fmaxf(m, __shfl_xor(m, 16)); m = fmaxf(m, __shfl_xor(m, 32));
                float l = 0.f;
#pragma unroll
                for (int s2 = 0; s2 < 5; ++s2) {
                    float e[8];
#pragma unroll
                    for (int j = 0; j < 4; ++j) { e[j] = __expf(sc[2 * s2][nt][j] - m); e[4 + j] = __expf(sc[2 * s2 + 1][nt][j] - m); }
                    l += ((e[0] + e[1]) + (e[2] + e[3])) + ((e[4] + e[5]) + (e[6] + e[7]));
                    u32x4 w; w[0] = pk_bf16(e[0], e[1]); w[1] = pk_bf16(e[2], e[3]); w[2] = pk_bf16(e[4], e[5]); w[3] = pk_bf16(e[6], e[7]);
                    pf[nt][s2] = w;
                }
                l += __shfl_xor(l, 16); l += __shfl_xor(l, 32);
                linv[nt] = 1.0f / (l + __expf(sink - m));
            }
            f32x4 o[4][2];
#pragma unroll
            for (int dt = 0; dt < 4; ++dt) { o[dt][0] = (f32x4){0.f, 0.f, 0.f, 0.f}; o[dt][1] = (f32x4){0.f, 0.f, 0.f, 0.f}; }
#pragma unroll
            for (int s2 = 0; s2 < 5; ++s2) {
                if (!(n == 0 && (2 * u + 2 * s2) < 8)) {
                    const int ca = ((((2 * u + 2 * s2) * 2 + (fq >> 1)) ^ fr) * 16) + (fq & 1) * 8;
                    const int cb = ((((2 * u + 2 * s2 + 1) * 2 + (fq >> 1)) ^ fr) * 16) + (fq & 1) * 8;
                    const bf16x8 p0 = __builtin_bit_cast(bf16x8, pf[0][s2]), p1 = __builtin_bit_cast(bf16x8, pf[1][s2]);
#pragma unroll
                    for (int dt = 0; dt < 4; ++dt) {
                        const char* rowp = vbuf + (dt * 16 + fr) * 512;
                        const u32x2 va = *(const u32x2*)(rowp + ca), vb = *(const u32x2*)(rowp + cb);
                        u32x4 vv; vv[0] = va[0]; vv[1] = va[1]; vv[2] = vb[0]; vv[3] = vb[1];
                        const bf16x8 vf = __builtin_bit_cast(bf16x8, vv);
                        o[dt][0] = __builtin_amdgcn_mfma_f32_16x16x32_bf16(vf, p0, o[dt][0], 0, 0, 0);
                        o[dt][1] = __builtin_amdgcn_mfma_f32_16x16x32_bf16(vf, p1, o[dt][1], 0, 0, 0);
                    }
                }
            }
#pragma unroll
            for (int nt = 0; nt < 2; ++nt) {
                bf16_t* rp = ao + (size_t)(tq + nt * 16) * 1024 + hq * 64 + fq * 4;
#pragma unroll
                for (int dt = 0; dt < 4; ++dt) store_bf16x4(rp + dt * 16, o[dt][nt] * linv[nt]);
            }
        }
        __syncthreads();
    }
}

__device__ void phase2(const Params& p, char* smem) {
    const int G = gridDim.x;
    if (G > 64) {
        if (blockIdx.x < 64) mlstm_item(p, smem, blockIdx.x, nullptr);
        else swa_items(p, smem, blockIdx.x - 64, G - 64);
    } else {
        for (int it = blockIdx.x; it < 64; it += G) mlstm_item(p, smem, it, nullptr);
        swa_items(p, smem, blockIdx.x, G);
    }
}

__device__ void phase3(const Params& p, char* smem) {
    const int tid = threadIdx.x, lane = tid & 63, wid = tid >> 6, wr = wid >> 1, wc = wid & 1, fr = lane & 15, fq = lane >> 4;
    char* ws = p.ws;
    const bf16_t* gg = (const bf16_t*)(ws + OFF_GG);
    bf16_t* y = (bf16_t*)(ws + OFF_R1);
    for (int t = blockIdx.x; t < 256 * 8; t += gridDim.x) {
        const int rt = t >> 3, ct = t & 7;
        GemmSrc s;
        f32x4 acca[4][4], accm[4][4]; zero_acc(acca); zero_acc(accm);
        make_src(s, (const bf16_t*)(ws + OFF_R0), 1024, rt * 256, (const bf16_t*)(ws + OFF_WATT), 1024, ct * 128, tid);
        gemm_loop(acca, s, 16, smem, tid);
        make_src(s, (const bf16_t*)p.out, 1024, rt * 256, (const bf16_t*)(ws + OFF_WML), 1024, ct * 128, tid);
        gemm_loop(accm, s, 16, smem, tid);
        const int row0 = rt * 256 + wr * 64 + fr, col0 = ct * 128 + wc * 64 + fq * 4;
#pragma unroll
        for (int m = 0; m < 4; ++m) {
            const size_t tok = row0 + m * 16;
#pragma unroll
            for (int n = 0; n < 4; ++n) {
                const int col = col0 + n * 16;
                const uint2 ga = *(const uint2*)(gg + tok * 2048 + col), gm = *(const uint2*)(gg + tok * 2048 + 1024 + col);
                f32x4 v;
                v[0] = bf_lo(ga.x) * acca[m][n][0] + bf_lo(gm.x) * accm[m][n][0];
                v[1] = bf_hi(ga.x) * acca[m][n][1] + bf_hi(gm.x) * accm[m][n][1];
                v[2] = bf_lo(ga.y) * acca[m][n][2] + bf_lo(gm.y) * accm[m][n][2];
                v[3] = bf_hi(ga.y) * acca[m][n][3] + bf_hi(gm.y) * accm[m][n][3];
                store_bf16x4(y + tok * 1024 + col, v);
            }
        }
    }
}

__device__ void phase_gemm_resid(const Params& p, char* smem, const bf16_t* A, const bf16_t* Bt, const float* resid, float* outz) {
    const int tid = threadIdx.x, lane = tid & 63, wid = tid >> 6, wr = wid >> 1, wc = wid & 1, fr = lane & 15, fq = lane >> 4;
    for (int t = blockIdx.x; t < 256 * 8; t += gridDim.x) {
        const int rt = t >> 3, ct = t & 7;
        GemmSrc s; f32x4 acc[4][4]; zero_acc(acc);
        make_src(s, A, 1024, rt * 256, Bt, 1024, ct * 128, tid);
        gemm_loop(acc, s, 16, smem, tid);
        const int row0 = rt * 256 + wr * 64 + fr, col0 = ct * 128 + wc * 64 + fq * 4;
#pragma unroll
        for (int m = 0; m < 4; ++m) {
            const size_t tok = row0 + m * 16;
#pragma unroll
            for (int n = 0; n < 4; ++n) {
                const int col = col0 + n * 16;
                const float4 r = *(const float4*)(resid + tok * 1024 + col);
                float4 o; o.x = ALPHA * r.x + acc[m][n][0]; o.y = ALPHA * r.y + acc[m][n][1]; o.z = ALPHA * r.z + acc[m][n][2]; o.w = ALPHA * r.w + acc[m][n][3];
                *(float4*)(outz + tok * 1024 + col) = o;
            }
        }
    }
}

__device__ void phase_gemm_bf16(const Params& p, char* smem, const bf16_t* A, const bf16_t* Bt, bf16_t* outb, float scale) {
    const int tid = threadIdx.x, lane = tid & 63, wid = tid >> 6, wr = wid >> 1, wc = wid & 1, fr = lane & 15, fq = lane >> 4;
    for (int t = blockIdx.x; t < 256 * 8; t += gridDim.x) {
        const int rt = t >> 3, ct = t & 7;
        GemmSrc s; f32x4 acc[4][4]; zero_acc(acc);
        make_src(s, A, 1024, rt * 256, Bt, 1024, ct * 128, tid);
        gemm_loop(acc, s, 16, smem, tid);
        const int row0 = rt * 256 + wr * 64 + fr, col0 = ct * 128 + wc * 64 + fq * 4;
#pragma unroll
        for (int m = 0; m < 4; ++m) {
            const size_t tok = row0 + m * 16;
#pragma unroll
            for (int n = 0; n < 4; ++n) store_bf16x4(outb + tok * 1024 + col0 + n * 16, acc[m][n] * scale);
        }
    }
}

__device__ __forceinline__ void ln_row(float4 (&v)[4], const float* g, const float* bta, int lane) {
    float s = 0.f;
#pragma unroll
    for (int i = 0; i < 4; ++i) s += (v[i].x + v[i].y) + (v[i].z + v[i].w);
    const float mu = wsum(s) * (1.0f / 1024.0f);
    float q = 0.f;
#pragma unroll
    for (int i = 0; i < 4; ++i) { const float a = v[i].x - mu, b = v[i].y - mu, c = v[i].z - mu, d = v[i].w - mu; q += (a * a + b * b) + (c * c + d * d); }
    const float rstd = rsqrtf(wsum(q) * (1.0f / 1024.0f) + 1e-5f);
#pragma unroll
    for (int i = 0; i < 4; ++i) {
        const float4 gg = *(const float4*)(g + i * 256 + lane * 4), bb = *(const float4*)(bta + i * 256 + lane * 4);
        v[i].x = (v[i].x - mu) * rstd * gg.x + bb.x; v[i].y = (v[i].y - mu) * rstd * gg.y + bb.y;
        v[i].z = (v[i].z - mu) * rstd * gg.z + bb.z; v[i].w = (v[i].w - mu) * rstd * gg.w + bb.w;
    }
}

__device__ void phase_ln1(const Params& p) {
    const int lane = threadIdx.x & 63, wid = threadIdx.x >> 6;
    float* z = p.out; bf16_t* hb = (bf16_t*)(p.ws + OFF_R0);
    for (int row = blockIdx.x * 8 + wid; row < T_; row += gridDim.x * 8) {
        float4 v[4];
#pragma unroll
        for (int i = 0; i < 4; ++i) v[i] = *(const float4*)(z + (size_t)row * 1024 + i * 256 + lane * 4);
        ln_row(v, p.ln1g, p.ln1b, lane);
#pragma unroll
        for (int i = 0; i < 4; ++i) {
            *(float4*)(z + (size_t)row * 1024 + i * 256 + lane * 4) = v[i];
            uint2 w; w.x = pk_bf16(v[i].x, v[i].y); w.y = pk_bf16(v[i].z, v[i].w);
            *(uint2*)(hb + (size_t)row * 1024 + i * 256 + lane * 4) = w;
        }
    }
}

__device__ __forceinline__ void xa_stage_k(const bf16_t* kmat, int b, int h, int kh, char* buf, int tid) {
    const int rl = tid >> 5, pc = tid & 31, lc = pc ^ (rl & 15);
    const bf16_t* src = kmat + (size_t)(b * 256 + kh * 128 + rl) * 1024 + h * 256 + lc * 8;
#pragma unroll
    for (int i = 0; i < 8; ++i) glds16(src + (size_t)i * 16 * 1024, buf + (i * 512 + tid) * 16);
}
__device__ __forceinline__ void xa_stage_v(const bf16_t* vT, int b, int h, int vh, char* buf, int tid) {
    const int rl = tid >> 4, pc = tid & 15, lc = pc ^ (rl & 15);
    const bf16_t* src = vT + (size_t)(h * 256 + rl) * 4096 + b * 256 + vh * 128 + lc * 8;
#pragma unroll
    for (int i = 0; i < 8; ++i) glds16(src + (size_t)i * 32 * 4096, buf + (i * 512 + tid) * 16);
}

template <int KH>
__device__ __forceinline__ void xa_scores(f32x4 (&acc)[16][2], const char* buf, const bf16_t* q0p, const bf16_t* q1p, int fr, int fq) {
#pragma unroll 2
    for (int ks = 0; ks < 8; ++ks) {
        const bf16x8 q0 = *(const bf16x8*)(q0p + ks * 32), q1 = *(const bf16x8*)(q1p + ks * 32);
        const int ch = ((ks * 4 + fq) ^ fr) * 16;
#pragma unroll
        for (int mt = 0; mt < 8; ++mt) {
            const bf16x8 kf = *(const bf16x8*)(buf + (mt * 16 + fr) * 512 + ch);
            acc[KH * 8 + mt][0] = __builtin_amdgcn_mfma_f32_16x16x32_bf16(kf, q0, acc[KH * 8 + mt][0], 0, 0, 0);
            acc[KH * 8 + mt][1] = __builtin_amdgcn_mfma_f32_16x16x32_bf16(kf, q1, acc[KH * 8 + mt][1], 0, 0, 0);
        }
    }
}


template <int VH, int DH>
__device__ __forceinline__ void xa_pv(f32x4 (&o)[8][2], const u32x4 (&pf)[2][8], const char* buf, int fr, int fq) {
#pragma unroll
    for (int ks = 0; ks < 4; ++ks) {
        const int ca = ((ks * 4 + (fq >> 1)) ^ fr) * 16 + (fq & 1) * 8, cb = ((ks * 4 + 2 + (fq >> 1)) ^ fr) * 16 + (fq & 1) * 8;
        const bf16x8 p0 = __builtin_bit_cast(bf16x8, pf[0][VH * 4 + ks]), p1 = __builtin_bit_cast(bf16x8, pf[1][VH * 4 + ks]);
#pragma unroll
        for (int dt = 0; dt < 8; ++dt) {
            const char* rowp = buf + ((DH * 8 + dt) * 16 + fr) * 256;
            const u32x2 va = *(const u32x2*)(rowp + ca), vb = *(const u32x2*)(rowp + cb);
            u32x4 vv; vv[0] = va[0]; vv[1] = va[1]; vv[2] = vb[0]; vv[3] = vb[1];
            const bf16x8 vf = __builtin_bit_cast(bf16x8, vv);
            o[dt][0] = __builtin_amdgcn_mfma_f32_16x16x32_bf16(vf, p0, o[dt][0], 0, 0, 0);
            o[dt][1] = __builtin_amdgcn_mfma_f32_16x16x32_bf16(vf, p1, o[dt][1], 0, 0, 0);
        }
    }
}

__device__ void phase6(const Params& p, char* smem) {
    const int tid = threadIdx.x, lane = tid & 63, wid = tid >> 6, fr = lane & 15, fq = lane >> 4;
    char* ws = p.ws;
    const bf16_t* xq = (const bf16_t*)(ws + OFF_XQ);
    const bf16_t* kmat = (const bf16_t*)(ws + OFF_KMAT);
    const bf16_t* vT = (const bf16_t*)(ws + OFF_VT);
    bf16_t* og = (bf16_t*)(ws + OFF_O);
    char* bufA = smem; char* bufB = smem + 65536;
    const int G = gridDim.x;
    for (int idx = blockIdx.x; idx < 1024; idx += G) {
        int pair, qt;
        if (G == 256) { const int i = idx >> 8, blk = idx & 255, xcd = blk & 7, jj = blk >> 3; pair = (i * 8 + xcd) * 2 + (jj >> 4); qt = jj & 15; }
        else { pair = idx >> 4; qt = idx & 15; }
        const int b = pair >> 2, h = pair & 3;
        const int tok0 = b * 4096 + qt * 256 + wid * 32;
        xa_stage_k(kmat, b, h, 0, bufA, tid);
        xa_stage_k(kmat, b, h, 1, bufB, tid);
        const bf16_t* q0p = xq + (size_t)(tok0 + fr) * 1024 + h * 256 + fq * 8;
        const bf16_t* q1p = q0p + (size_t)16 * 1024;
        f32x4 acc[16][2];
#pragma unroll
        for (int mt = 0; mt < 16; ++mt) { acc[mt][0] = (f32x4){0.f, 0.f, 0.f, 0.f}; acc[mt][1] = (f32x4){0.f, 0.f, 0.f, 0.f}; }
        asm volatile("s_waitcnt vmcnt(0)" ::: "memory");
        __syncthreads();
        xa_scores<0>(acc, bufA, q0p, q1p, fr, fq);
        xa_scores<1>(acc, bufB, q0p, q1p, fr, fq);
        __syncthreads();
        xa_stage_v(vT, b, h, 0, bufA, tid);
        xa_stage_v(vT, b, h, 1, bufB, tid);
        u32x4 pf[2][8]; float linv[2];
#pragma unroll
        for (int nt = 0; nt < 2; ++nt) {
            float m = -INFINITY;
#pragma unroll
            for (int mt = 0; mt < 16; ++mt) m = fmaxf(m, fmaxf(fmaxf(acc[mt][nt][0], acc[mt][nt][1]), fmaxf(acc[mt][nt][2], acc[mt][nt][3])));
            m = fmaxf(m, __shfl_xor(m, 16)); m = fmaxf(m, __shfl_xor(m, 32));
            float l = 0.f;
#pragma unroll
            for (int s2 = 0; s2 < 8; ++s2) {
                float e[8];
#pragma unroll
                for (int j = 0; j < 4; ++j) { e[j] = __expf(acc[2 * s2][nt][j] - m); e[4 + j] = __expf(acc[2 * s2 + 1][nt][j] - m); }
                l += ((e[0] + e[1]) + (e[2] + e[3])) + ((e[4] + e[5]) + (e[6] + e[7]));
                u32x4 w; w[0] = pk_bf16(e[0], e[1]); w[1] = pk_bf16(e[2], e[3]); w[2] = pk_bf16(e[4], e[5]); w[3] = pk_bf16(e[6], e[7]);
                pf[nt][s2] = w;
            }
            l += __shfl_xor(l, 16); l += __shfl_xor(l, 32);
            linv[nt] = 1.0f / l;
        }
        asm volatile("s_waitcnt vmcnt(0)" ::: "memory");
        __syncthreads();
        {
            f32x4 o[8][2];
#pragma unroll
            for (int dt = 0; dt < 8; ++dt) { o[dt][0] = (f32x4){0.f, 0.f, 0.f, 0.f}; o[dt][1] = (f32x4){0.f, 0.f, 0.f, 0.f}; }
            xa_pv<0, 0>(o, pf, bufA, fr, fq);
            xa_pv<1, 0>(o, pf, bufB, fr, fq);
#pragma unroll
            for (int nt = 0; nt < 2; ++nt) {
                bf16_t* rp = og + (size_t)(tok0 + nt * 16 + fr) * 1024 + h * 256 + fq * 4;
#pragma unroll
                for (int dt = 0; dt < 8; ++dt) store_bf16x4(rp + dt * 16, o[dt][nt] * linv[nt]);
            }
        }
        {
            f32x4 o[8][2];
#pragma unroll
            for (int dt = 0; dt < 8; ++dt) { o[dt][0] = (f32x4){0.f, 0.f, 0.f, 0.f}; o[dt][1] = (f32x4){0.f, 0.f, 0.f, 0.f}; }
            xa_pv<0, 1>(o, pf, bufA, fr, fq);
            xa_pv<1, 1>(o, pf, bufB, fr, fq);
#pragma unroll
            for (int nt = 0; nt < 2; ++nt) {
                bf16_t* rp = og + (size_t)(tok0 + nt * 16 + fr) * 1024 + h * 256 + 128 + fq * 4;
#pragma unroll
                for (int dt = 0; dt < 8; ++dt) store_bf16x4(rp + dt * 16, o[dt][nt] * linv[nt]);
            }
        }
        __syncthreads();
    }
}

__device__ void phase_ln2_router(const Params& p, char* smem) {
    const int tid = threadIdx.x, lane = tid & 63, wid = tid >> 6;
    char* ws = p.ws;
    float* z = (float*)(ws + OFF_Z2); bf16_t* hb = (bf16_t*)(ws + OFF_R0);
    int2* toke = (int2*)(ws + OFF_TOKE); float2* tokw = (float2*)(ws + OFF_TOKW);
    int* histg = (int*)(ws + OFF_HIST);
    int* hist = (int*)smem;
    for (int c = blockIdx.x; c < 256; c += gridDim.x) {
        if (tid < 64) hist[tid] = 0;
        __syncthreads();
        for (int rr = 0; rr < 32; ++rr) {
            const int row = c * 256 + wid * 32 + rr;
            float4 v[4];
#pragma unroll
            for (int i = 0; i < 4; ++i) v[i] = *(const float4*)(z + (size_t)row * 1024 + i * 256 + lane * 4);
            ln_row(v, p.ln2g, p.ln2b, lane);
#pragma unroll
            for (int i = 0; i < 4; ++i) {
                *(float4*)(z + (size_t)row * 1024 + i * 256 + lane * 4) = v[i];
                uint2 w; w.x = pk_bf16(v[i].x, v[i].y); w.y = pk_bf16(v[i].z, v[i].w);
                *(uint2*)(hb + (size_t)row * 1024 + i * 256 + lane * 4) = w;
            }
            float g[8];
#pragma unroll
            for (int k = 0; k < 8; ++k) g[k] = 0.f;
#pragma unroll
            for (int i = 0; i < 4; ++i) {
                const float vv[4] = {v[i].x, v[i].y, v[i].z, v[i].w};
#pragma unroll
                for (int jj = 0; jj < 4; ++jj) {
                    const float4* wp = (const float4*)(p.w_rg + (size_t)(i * 256 + lane * 4 + jj) * 8);
                    const float4 w0 = wp[0], w1 = wp[1];
                    g[0] += vv[jj] * w0.x; g[1] += vv[jj] * w0.y; g[2] += vv[jj] * w0.z; g[3] += vv[jj] * w0.w;
                    g[4] += vv[jj] * w1.x; g[5] += vv[jj] * w1.y; g[6] += vv[jj] * w1.z; g[7] += vv[jj] * w1.w;
                }
            }
            float gmax = -INFINITY; int gsel = 0;
#pragma unroll
            for (int k = 0; k < 8; ++k) { g[k] = wsum(g[k]) + p.b_rg[k]; if (g[k] > gmax) { gmax = g[k]; gsel = k; } }
            float gs = 0.f;
#pragma unroll
            for (int k = 0; k < 8; ++k) gs += __expf(g[k] - gmax);
            const float pgroup = 1.0f / gs;
            gsel = __builtin_amdgcn_readfirstlane(gsel);
            float ex[8];
#pragma unroll
            for (int k = 0; k < 8; ++k) ex[k] = 0.f;
#pragma unroll
            for (int i = 0; i < 4; ++i) {
                const float vv[4] = {v[i].x, v[i].y, v[i].z, v[i].w};
#pragma unroll
                for (int jj = 0; jj < 4; ++jj) {
                    const float4* wp = (const float4*)(p.w_re + (size_t)(i * 256 + lane * 4 + jj) * 64 + gsel * 8);
                    const float4 w0 = wp[0], w1 = wp[1];
                    ex[0] += vv[jj] * w0.x; ex[1] += vv[jj] * w0.y; ex[2] += vv[jj] * w0.z; ex[3] += vv[jj] * w0.w;
                    ex[4] += vv[jj] * w1.x; ex[5] += vv[jj] * w1.y; ex[6] += vv[jj] * w1.z; ex[7] += vv[jj] * w1.w;
                }
            }
            float v0 = -INFINITY, v1 = -INFINITY; int i0 = 0, i1 = 0;
#pragma unroll
            for (int k = 0; k < 8; ++k) {
                const float lv = wsum(ex[k]) + p.b_re[gsel * 8 + k];
                if (lv > v0) { v1 = v0; i1 = i0; v0 = lv; i0 = k; }
                else if (lv > v1) { v1 = lv; i1 = k; }
            }
            const float e1 = __expf(v1 - v0), den = 1.0f + e1;
            const float w0 = pgroup / den, w1 = pgroup * e1 / den;
            if (lane == 0) {
                const int ea = gsel * 8 + i0, eb = gsel * 8 + i1;
                toke[row] = make_int2(ea, eb); tokw[row] = make_float2(w0, w1);
                atomicAdd(&hist[ea], 1); atomicAdd(&hist[eb], 1);
            }
        }
        __syncthreads();
        if (tid < 64) histg[c * 64 + tid] = hist[tid];
        __syncthreads();
    }
}

__device__ void compute_segments(const int* histg, int* seg, int tid) {
    if (tid < 64) {
        int s = 0;
        for (int c = 0; c < 256; ++c) s += histg[c * 64 + tid];
        seg[tid] = s;
    }
    __syncthreads();
    if (tid == 0) {
        int acc = 0;
        for (int e = 0; e < 64; ++e) { seg[64 + e] = acc; acc += (seg[e] + 255) >> 8; }
        seg[128] = acc;
    }
    __syncthreads();
}

__device__ void phase8(const Params& p, char* smem) {
    const int tid = threadIdx.x;
    char* ws = p.ws;
    const int* histg = (const int*)(ws + OFF_HIST);
    const int2* toke = (const int2*)(ws + OFF_TOKE); const float2* tokw = (const float2*)(ws + OFF_TOKW);
    int* slot_tok = (int*)(ws + OFF_SLOTTOK); float* slot_w = (float*)(ws + OFF_SLOTW);
    int* seg = (int*)smem;
    int* cursor = seg + 192;
    compute_segments(histg, seg, tid);
    for (int e = blockIdx.x; e < 64; e += gridDim.x) {
        const int start = seg[64 + e] * 256 + seg[e], end = seg[64 + e + 1] * 256;
        for (int s = start + tid; s < end; s += NTHR) { slot_tok[s] = -1; slot_w[s] = 0.f; }
    }
    for (int c = blockIdx.x; c < 256; c += gridDim.x) {
        __syncthreads();
        if (tid < 64) {
            int base = 0;
            for (int cc = 0; cc < c; ++cc) base += histg[cc * 64 + tid];
            cursor[tid] = seg[64 + tid] * 256 + base;
        }
        __syncthreads();
        if (tid < 256) {
            const int tok = c * 256 + tid;
            const int2 ee = toke[tok]; const float2 ww = tokw[tok];
            const int s0 = atomicAdd(&cursor[ee.x], 1);
            const int s1 = atomicAdd(&cursor[ee.y], 1);
            slot_tok[s0] = tok * 2; slot_w[s0] = ww.x;
            slot_tok[s1] = tok * 2 + 1; slot_w[s1] = ww.y;
        }
    }
}

__device__ void phase9a(const Params& p, char* smem) {
    const int tid = threadIdx.x, lane = tid & 63, wid = tid >> 6, wr = wid >> 1, wc = wid & 1, fr = lane & 15, fq = lane >> 4;
    char* ws = p.ws;
    int* seg = (int*)(smem + LDS_GEMM);
    compute_segments((const int*)(ws + OFF_HIST), seg, tid);
    const int nrt = seg[128];
    const int* slot_tok = (const int*)(ws + OFF_SLOTTOK);
    const bf16_t* h2b = (const bf16_t*)(ws + OFF_R0);
    bf16_t* hbuf = (bf16_t*)(ws + OFF_R1);
    for (int t = blockIdx.x; t < nrt * 4; t += gridDim.x) {
        const int rtile = t >> 2, nt = t & 3;
        int e = 0;
        for (int k = 1; k < 64; ++k) if (seg[64 + k] <= rtile) e = k;
        GemmSrc s;
        {
            const int r = tid >> 3, lc = (tid & 7) ^ ((r >> 1) & 7);
#pragma unroll
            for (int i = 0; i < 4; ++i) {
                const int tk = slot_tok[rtile * 256 + i * 64 + r];
                const int tok = tk < 0 ? 0 : (tk >> 1);
                s.a[i] = h2b + (size_t)tok * 1024 + lc * 8;
            }
#pragma unroll
            for (int i = 0; i < 2; ++i) s.b[i] = (const bf16_t*)(ws + OFF_WGU) + (size_t)e * 512 * 1024 + (size_t)(nt * 128 + i * 64 + r) * 1024 + lc * 8;
        }
        f32x4 acc[4][4]; zero_acc(acc);
        gemm_loop(acc, s, 16, smem, tid);
        const int row0 = rtile * 256 + wr * 64 + fr;
        const int colb = (nt * 2 + wc) * 32 + fq * 4;
#pragma unroll
        for (int m = 0; m < 4; ++m) {
            const size_t slot = row0 + m * 16;
#pragma unroll
            for (int n = 0; n < 2; ++n) {
                const f32x4 g = acc[m][n], u = acc[m][n + 2];
                f32x4 v;
#pragma unroll
                for (int j = 0; j < 4; ++j) v[j] = g[j] * sigmoidf_(g[j]) * u[j];
                store_bf16x4(hbuf + slot * 256 + colb + n * 16, v);
            }
        }
    }
}

__device__ void phase9b(const Params& p, char* smem) {
    const int tid = threadIdx.x, lane = tid & 63, wid = tid >> 6, wr = wid >> 1, wc = wid & 1, fr = lane & 15, fq = lane >> 4;
    char* ws = p.ws;
    int* seg = (int*)(smem + LDS_GEMM);
    compute_segments((const int*)(ws + OFF_HIST), seg, tid);
    const int nrt = seg[128];
    const int* slot_tok = (const int*)(ws + OFF_SLOTTOK); const float* slot_w = (const float*)(ws + OFF_SLOTW);
    const bf16_t* hbuf = (const bf16_t*)(ws + OFF_R1);
    bf16_t* yb = (bf16_t*)(ws + OFF_YB);
    for (int t = blockIdx.x; t < nrt * 8; t += gridDim.x) {
        const int rtile = t >> 3, nt = t & 7;
        int e = 0;
        for (int k = 1; k < 64; ++k) if (seg[64 + k] <= rtile) e = k;
        GemmSrc s;
        make_src(s, hbuf, 256, rtile * 256, (const bf16_t*)(ws + OFF_WD) + (size_t)e * 1024 * 256, 256, nt * 128, tid);
        f32x4 acc[4][4]; zero_acc(acc);
        gemm_loop(acc, s, 4, smem, tid);
        const int row0 = rtile * 256 + wr * 64 + fr, col0 = nt * 128 + wc * 64 + fq * 4;
#pragma unroll
        for (int m = 0; m < 4; ++m) {
            const int slot = row0 + m * 16;
            const int tk = slot_tok[slot]; const float w = slot_w[slot];
            if (tk >= 0) {
#pragma unroll
                for (int n = 0; n < 4; ++n) store_bf16x4(yb + (size_t)tk * 1024 + col0 + n * 16, acc[m][n] * w);
            }
        }
    }
}

__device__ void phase10(const Params& p) {
    const int lane = threadIdx.x & 63, wid = threadIdx.x >> 6;
    const float* h2 = (const float*)(p.ws + OFF_Z2); const bf16_t* yb = (const bf16_t*)(p.ws + OFF_YB);
    for (int row = blockIdx.x * 8 + wid; row < T_; row += gridDim.x * 8) {
        float4 v[4];
#pragma unroll
        for (int i = 0; i < 4; ++i) {
            const float4 hh = *(const float4*)(h2 + (size_t)row * 1024 + i * 256 + lane * 4);
            const uint2 a = *(const uint2*)(yb + (size_t)(row * 2) * 1024 + i * 256 + lane * 4), b = *(const uint2*)(yb + (size_t)(row * 2 + 1) * 1024 + i * 256 + lane * 4);
            v[i].x = ALPHA * hh.x + bf_lo(a.x) + bf_lo(b.x); v[i].y = ALPHA * hh.y + bf_hi(a.x) + bf_hi(b.x);
            v[i].z = ALPHA * hh.z + bf_lo(a.y) + bf_lo(b.y); v[i].w = ALPHA * hh.w + bf_hi(a.y) + bf_hi(b.y);
        }
        ln_row(v, p.ln3g, p.ln3b, lane);
#pragma unroll
        for (int i = 0; i < 4; ++i) *(float4*)(p.out + (size_t)row * 1024 + i * 256 + lane * 4) = v[i];
    }
}

__global__ void __launch_bounds__(NTHR) mega(Params p) {
    extern __shared__ __attribute__((aligned(16))) char smem[];
    cg::grid_group grid = cg::this_grid();
    char* ws = p.ws;
    phase0(p, smem);
    grid.sync();
    phase1(p, smem);
    grid.sync();
    phase2(p, smem);
    grid.sync();
    phase3(p, smem);
    grid.sync();
    phase_gemm_resid(p, smem, (const bf16_t*)(ws + OFF_R1), (const bf16_t*)(ws + OFF_WMIX), p.x, p.out);
    grid.sync();
    phase_ln1(p);
    moe_weight_prep(p, smem);
    grid.sync();
    phase_gemm_bf16(p, smem, (const bf16_t*)(ws + OFF_R0), (const bf16_t*)(ws + OFF_WXQ), (bf16_t*)(ws + OFF_XQ), 0.0625f);
    grid.sync();
    phase6(p, smem);
    grid.sync();
    phase_gemm_resid(p, smem, (const bf16_t*)(ws + OFF_O), (const bf16_t*)(ws + OFF_WXO), p.out, (float*)(ws + OFF_Z2));
    grid.sync();
    phase_ln2_router(p, smem);
    grid.sync();
    phase8(p, smem);
    grid.sync();
    phase9a(p, smem);
    grid.sync();
    phase9b(p, smem);
    grid.sync();
    phase10(p);
}

extern "C" void kernel_launch(void* const* d_in, const int* in_sizes, int n_in, void* d_out, int out_size,
                              void* d_ws, size_t ws_size, hipStream_t stream) {
    static int grid_blocks = 0;
    if (!grid_blocks) {
        int dev = 0, cus = 0, per_cu = 0;
        (void)hipGetDevice(&dev);
        (void)hipDeviceGetAttribute(&cus, hipDeviceAttributeMultiprocessorCount, dev);
        (void)hipFuncSetAttribute((const void*)mega, hipFuncAttributeMaxDynamicSharedMemorySize, LDS_BYTES);
        (void)hipOccupancyMaxActiveBlocksPerMultiprocessor(&per_cu, mega, NTHR, LDS_BYTES);
        if (per_cu > 1) per_cu = 1;
        grid_blocks = cus * per_cu;
        if (ws_size < WS_NEED) fprintf(stderr, "workspace too small: %zu\n", ws_size);
    }
    Params p{};
    const float* const* f = (const float* const*)d_in;
    p.x = f[0]; p.mem = f[1]; p.pos = (const int*)d_in[2];
    p.w_in = f[3]; p.sinks = f[4]; p.conv_w = f[5]; p.conv_b = f[6]; p.b_ig = f[7]; p.b_fg = f[8]; p.ml_g = f[9];
    p.w_att = f[10]; p.w_ml = f[11]; p.w_mix = f[12]; p.ln1g = f[13]; p.ln1b = f[14];
    p.w_xq = f[15]; p.w_xkv = f[16]; p.w_xo = f[17]; p.ln2g = f[18]; p.ln2b = f[19];
    p.w_rg = f[20]; p.b_rg = f[21]; p.w_re = f[22]; p.b_re = f[23]; p.w_gate = f[24]; p.w_up = f[25]; p.w_down = f[26];
    p.ln3g = f[27]; p.ln3b = f[28];
    p.out = (float*)d_out; p.ws = (char*)d_ws;
    void* args[] = {&p};
    hipError_t e = hipLaunchCooperativeKernel((void*)mega, dim3(grid_blocks), dim3(NTHR), args, LDS_BYTES, stream);
    if (e != hipSuccess) fprintf(stderr, "cooperative launch failed: %s (grid %d)\n", hipGetErrorString(e), grid_blocks);
}
```

```cpp
#include <hip/hip_runtime.h>
#include <hip/hip_cooperative_groups.h>
#include <cstdio>
#include <cstdint>
namespace cg = cooperative_groups;

typedef unsigned short bf16_t;
typedef short bf16x8 __attribute__((ext_vector_type(8)));
typedef float f32x4 __attribute__((ext_vector_type(4)));
typedef unsigned u32x2 __attribute__((ext_vector_type(2)));
typedef unsigned u32x4 __attribute__((ext_vector_type(4)));
#define LDS_AS __attribute__((address_space(3)))
#define GLB_AS __attribute__((address_space(1)))

constexpr int T_ = 65536;
constexpr int NTHR = 512;
constexpr size_t MiB = 1ull << 20;
constexpr float ALPHA = 1.189207115002721f;
constexpr size_t OFF_R0 = 0;
constexpr size_t OFF_R1 = 128 * MiB;
constexpr size_t OFF_AK = 256 * MiB;
constexpr size_t OFF_AV = 272 * MiB;
constexpr size_t OFF_MQK = 288 * MiB;
constexpr size_t OFF_MV = 416 * MiB;
constexpr size_t OFF_MO = 544 * MiB;
constexpr size_t OFF_GG = 672 * MiB;
constexpr size_t OFF_WGU = 256 * MiB;
constexpr size_t OFF_WD = 320 * MiB;
constexpr size_t OFF_XQ = 352 * MiB;
constexpr size_t OFF_O = 480 * MiB;
constexpr size_t OFF_Z2 = 608 * MiB;
constexpr size_t OFF_YB = 352 * MiB;
constexpr size_t OFF_MISC = 928 * MiB;
constexpr size_t OFF_WIN = OFF_MISC;
constexpr size_t OFF_WATT = OFF_MISC + 13 * MiB;
constexpr size_t OFF_WML = OFF_MISC + 15 * MiB;
constexpr size_t OFF_WMIX = OFF_MISC + 17 * MiB;
constexpr size_t OFF_WXQ = OFF_MISC + 19 * MiB;
constexpr size_t OFF_WXO = OFF_MISC + 21 * MiB;
constexpr size_t OFF_WXKV = OFF_MISC + 23 * MiB;
constexpr size_t OFF_MEMB = OFF_MISC + 27 * MiB;
constexpr size_t OFF_KMAT = OFF_MISC + 35 * MiB;
constexpr size_t OFF_VT = OFF_MISC + 43 * MiB;
constexpr size_t OFF_GATES = OFF_MISC + 51 * MiB;
constexpr size_t OFF_CS = OFF_MISC + 53 * MiB;
constexpr size_t OFF_TOKE = OFF_MISC + 69 * MiB;
constexpr size_t OFF_TOKW = OFF_MISC + 70 * MiB;
constexpr size_t OFF_SLOTTOK = OFF_MISC + 71 * MiB;
constexpr size_t OFF_SLOTW = OFF_MISC + 72 * MiB;
constexpr size_t OFF_HIST = OFF_MISC + 73 * MiB;
constexpr size_t WS_NEED = 1024 * MiB;
constexpr int LDS_GEMM = 131072;
constexpr int LDS_BYTES = 150528;

struct Params {
    const float *x, *mem; const int* pos;
    const float *w_in, *sinks, *conv_w, *conv_b, *b_ig, *b_fg, *ml_g, *w_att, *w_ml, *w_mix, *ln1g, *ln1b;
    const float *w_xq, *w_xkv, *w_xo, *ln2g, *ln2b, *w_rg, *b_rg, *w_re, *b_re, *w_gate, *w_up, *w_down, *ln3g, *ln3b;
    float* out; char* ws;
};

__device__ const double INV_FREQ[32] = {1.0, 0.7498942093324559, 0.5623413251903491, 0.4216965034285822, 0.31622776601683794, 0.23713737056616552, 0.1778279410038923, 0.1333521432163324, 0.1, 0.07498942093324558, 0.05623413251903491, 0.042169650342858224, 0.03162277660168379, 0.023713737056616554, 0.01778279410038923, 0.01333521432163324, 0.01, 0.007498942093324558, 0.005623413251903491, 0.004216965034285823, 0.0031622776601683794, 0.0023713737056616554, 0.0017782794100389228, 0.001333521432163324, 0.001, 0.0007498942093324559, 0.0005623413251903491, 0.00042169650342858224, 0.00031622776601683794, 0.00023713737056616554, 0.00017782794100389227, 0.0001333521432163324};

__device__ __forceinline__ int opaque_tid() { int t = threadIdx.x; asm volatile("" : "+v"(t)); return t; }
__device__ __forceinline__ unsigned pk_bf16(float lo, float hi) { unsigned r; asm("v_cvt_pk_bf16_f32 %0, %1, %2" : "=v"(r) : "v"(lo), "v"(hi)); return r; }
__device__ __forceinline__ float bf_lo(unsigned u) { return __uint_as_float(u << 16); }
__device__ __forceinline__ float bf_hi(unsigned u) { return __uint_as_float(u & 0xffff0000u); }
__device__ __forceinline__ float bf2f(bf16_t h) { return __uint_as_float(((unsigned)h) << 16); }
__device__ __forceinline__ float wsum(float v) {
#pragma unroll
    for (int o = 32; o; o >>= 1) v += __shfl_xor(v, o);
    return v;
}
__device__ __forceinline__ float wmaxf(float v) {
#pragma unroll
    for (int o = 32; o; o >>= 1) v = fmaxf(v, __shfl_xor(v, o));
    return v;
}
__device__ __forceinline__ float sigmoidf_(float x) { return 1.0f / (1.0f + __expf(-x)); }
__device__ __forceinline__ void glds16(const bf16_t* g, char* l) {
    __builtin_amdgcn_global_load_lds((const GLB_AS void*)g, (LDS_AS void*)l, 16, 0, 0);
}

struct GemmSrc { const bf16_t* a[4]; const bf16_t* b[2]; };

__device__ __forceinline__ void stage_tile(const GemmSrc& s, int koff, char* buf, int tid) {
#pragma unroll
    for (int i = 0; i < 4; ++i) glds16(s.a[i] + koff, buf + (i * 512 + tid) * 16);
#pragma unroll
    for (int i = 0; i < 2; ++i) glds16(s.b[i] + koff, buf + 32768 + (i * 512 + tid) * 16);
}

__device__ __forceinline__ void gemm_loop(f32x4 (&acc)[4][4], const GemmSrc& s, int nk, char* smem, int tid) {
    const int lane = tid & 63, wid = tid >> 6, wr = wid >> 1, wc = wid & 1, fr = lane & 15, fq = lane >> 4;
    const int swz = (fr >> 1) & 7;
    const int aoff = (wr * 64 + fr) * 128;
    const int boff = 32768 + (wc * 64 + fr) * 128;
    stage_tile(s, 0, smem, tid);
    for (int t = 0; t < nk; ++t) {
        asm volatile("s_waitcnt vmcnt(0)" ::: "memory");
        __syncthreads();
        char* cur = smem + (t & 1) * 49152;
        if (t + 1 < nk) stage_tile(s, (t + 1) * 64, smem + ((t + 1) & 1) * 49152, tid);
#pragma unroll
        for (int ks = 0; ks < 2; ++ks) {
            const int ch = ((ks * 4 + fq) ^ swz) * 16;
            bf16x8 xa[4], wb[4];
#pragma unroll
            for (int m = 0; m < 4; ++m) xa[m] = *(const bf16x8*)(cur + aoff + m * 2048 + ch);
#pragma unroll
            for (int n = 0; n < 4; ++n) wb[n] = *(const bf16x8*)(cur + boff + n * 2048 + ch);
#pragma unroll
            for (int m = 0; m < 4; ++m)
#pragma unroll
                for (int n = 0; n < 4; ++n) acc[m][n] = __builtin_amdgcn_mfma_f32_16x16x32_bf16(wb[n], xa[m], acc[m][n], 0, 0, 0);
        }
    }
    __syncthreads();
}

__device__ __forceinline__ void zero_acc(f32x4 (&acc)[4][4]) {
#pragma unroll
    for (int m = 0; m < 4; ++m)
#pragma unroll
        for (int n = 0; n < 4; ++n) acc[m][n] = (f32x4){0.f, 0.f, 0.f, 0.f};
}

__device__ __forceinline__ void make_src(GemmSrc& s, const bf16_t* A, size_t lda, int rowA0, const bf16_t* Bt, size_t ldb, int rowB0, int tid) {
    const int r = tid >> 3, lc = (tid & 7) ^ ((r >> 1) & 7);
#pragma unroll
    for (int i = 0; i < 4; ++i) s.a[i] = A + (size_t)(rowA0 + i * 64 + r) * lda + lc * 8;
#pragma unroll
    for (int i = 0; i < 2; ++i) s.b[i] = Bt + (size_t)(rowB0 + i * 64 + r) * ldb + lc * 8;
}

__device__ __forceinline__ void store_bf16x4(bf16_t* p, f32x4 v) {
    uint2 w; w.x = pk_bf16(v[0], v[1]); w.y = pk_bf16(v[2], v[3]); *(uint2*)p = w;
}

__device__ __forceinline__ void tr_tile(const float* src, size_t ld_src, int k0, int c0, bf16_t* dst, size_t ld_dst, int r0, float* tile, int tid) {
    {
        const int r = tid >> 3, c4 = (tid & 7) * 4;
        const float4 v = *(const float4*)(src + (size_t)(k0 + r) * ld_src + c0 + c4);
        float* tp = tile + r * 33 + c4; tp[0] = v.x; tp[1] = v.y; tp[2] = v.z; tp[3] = v.w;
    }
    __syncthreads();
    {
        const int c = tid >> 4, rc = (tid & 15) * 4;
        const float a0 = tile[(rc + 0) * 33 + c], a1 = tile[(rc + 1) * 33 + c], a2 = tile[(rc + 2) * 33 + c], a3 = tile[(rc + 3) * 33 + c];
        uint2 w; w.x = pk_bf16(a0, a1); w.y = pk_bf16(a2, a3);
        *(uint2*)(dst + (size_t)(r0 + c) * ld_dst + k0 + rc) = w;
    }
    __syncthreads();
}

__device__ void phase0(const Params& p, char* smem) {
    const int tid = opaque_tid(), lane = tid & 63, wid = tid >> 6;
    const int gw = blockIdx.x * 8 + wid, nw = gridDim.x * 8;
    char* ws = p.ws;
    bf16_t* xb = (bf16_t*)(ws + OFF_R0);
    float* gates = (float*)(ws + OFF_GATES);
    for (int row = gw; row < T_; row += nw) {
        const float4* xr = (const float4*)(p.x + (size_t)row * 1024);
        float g0 = 0, g1 = 0, g2 = 0, g3 = 0, g4 = 0, g5 = 0, g6 = 0, g7 = 0;
#pragma unroll
        for (int i = 0; i < 4; ++i) {
            const float4 v = xr[i * 64 + lane];
            uint2 w; w.x = pk_bf16(v.x, v.y); w.y = pk_bf16(v.z, v.w);
            *(uint2*)(xb + (size_t)row * 1024 + i * 256 + lane * 4) = w;
            const float vv[4] = {v.x, v.y, v.z, v.w};
#pragma unroll
            for (int jj = 0; jj < 4; ++jj) {
                const int k = i * 256 + lane * 4 + jj;
                const float4* wp = (const float4*)(p.w_in + (size_t)k * 6408 + 4352);
                const float4 w0 = wp[0], w1 = wp[1];
                g0 += vv[jj] * w0.x; g1 += vv[jj] * w0.y; g2 += vv[jj] * w0.z; g3 += vv[jj] * w0.w;
                g4 += vv[jj] * w1.x; g5 += vv[jj] * w1.y; g6 += vv[jj] * w1.z; g7 += vv[jj] * w1.w;
            }
        }
        g0 = wsum(g0); g1 = wsum(g1); g2 = wsum(g2); g3 = wsum(g3); g4 = wsum(g4); g5 = wsum(g5); g6 = wsum(g6); g7 = wsum(g7);
        if (lane == 0) {
            float4* gp = (float4*)(gates + (size_t)row * 8);
            gp[0] = make_float4(g0, g1, g2, g3); gp[1] = make_float4(g4, g5, g6, g7);
        }
    }
    {
        float2* cs = (float2*)(ws + OFF_CS);
        const int gt = blockIdx.x * NTHR + tid, nt = gridDim.x * NTHR;
        for (int idx = gt; idx < T_ * 32; idx += nt) {
            const int tok = idx >> 5, i = idx & 31;
            const double ang = (double)p.pos[tok] * INV_FREQ[i];
            const double turns = ang * 0.15915494309189535;
            const float f = (float)(turns - rint(turns));
            cs[idx] = make_float2(__builtin_amdgcn_cosf(f), __builtin_amdgcn_sinf(f));
        }
        bf16_t* memb = (bf16_t*)(ws + OFF_MEMB);
        for (int idx = gt; idx < 4096 * 1024 / 4; idx += nt) {
            const float4 v = ((const float4*)p.mem)[idx];
            uint2 w; w.x = pk_bf16(v.x, v.y); w.y = pk_bf16(v.z, v.w);
            ((uint2*)memb)[idx] = w;
        }
    }
    {
        float* tile = (float*)smem;
        const int NT_WIN = 16 * 200, NT_SQ = 16 * 32, NT_XKV = 16 * 64;
        const int total = NT_WIN + 5 * NT_SQ + NT_XKV;
        for (int t = blockIdx.x; t < total; t += gridDim.x) {
            if (t < NT_WIN) {
                const int kt = t & 15, nt_ = t >> 4;
                const int n0 = nt_ * 32, c0 = n0 < 4352 ? n0 : n0 + 8;
                tr_tile(p.w_in, 6408, kt * 64, c0, (bf16_t*)(ws + OFF_WIN), 1024, n0, tile, tid);
            } else if (t < NT_WIN + 5 * NT_SQ) {
                const int u = t - NT_WIN, which = u / NT_SQ, v = u % NT_SQ, kt = v & 15, nt_ = v >> 4;
                const float* src = which == 0 ? p.w_att : which == 1 ? p.w_ml : which == 2 ? p.w_mix : which == 3 ? p.w_xq : p.w_xo;
                bf16_t* dst = (bf16_t*)(ws + OFF_WATT + (size_t)which * 2 * MiB);
                tr_tile(src, 1024, kt * 64, nt_ * 32, dst, 1024, nt_ * 32, tile, tid);
            } else {
                const int v = t - NT_WIN - 5 * NT_SQ, kt = v & 15, nt_ = v >> 4;
                tr_tile(p.w_xkv, 2048, kt * 64, nt_ * 32, (bf16_t*)(ws + OFF_WXKV), 1024, nt_ * 32, tile, tid);
            }
        }
    }
}

__device__ void moe_weight_prep(const Params& p, char* smem) {
    const int tid = opaque_tid();
    float* tile = (float*)smem;
    char* ws = p.ws;
    const int per_e = 384, total = 64 * per_e;
    for (int t = blockIdx.x; t < total; t += gridDim.x) {
        const int e = t / per_e, u = t % per_e;
        if (u < 256) {
            const int isup = u >> 7, v = u & 127, kt = v & 15, j = v >> 4;
            const float* src = (isup ? p.w_up : p.w_gate) + (size_t)e * 1024 * 256;
            tr_tile(src, 256, kt * 64, j * 32, (bf16_t*)(ws + OFF_WGU) + (size_t)e * 512 * 1024, 1024, j * 64 + isup * 32, tile, tid);
        } else {
            const int v = u - 256, kt = v & 3, nt_ = v >> 2;
            tr_tile(p.w_down + (size_t)e * 256 * 1024, 1024, kt * 64, nt_ * 32, (bf16_t*)(ws + OFF_WD) + (size_t)e * 1024 * 256, 256, nt_ * 32, tile, tid);
        }
    }
}

__device__ void phase1(const Params& p, char* smem) {
    const int tid = opaque_tid(), lane = tid & 63, wid = tid >> 6, wr = wid >> 1, wc = wid & 1, fr = lane & 15, fq = lane >> 4;
    char* ws = p.ws;
    const int NMAIN = 256 * 50, NKV = 256;
    for (int t = blockIdx.x; t < NMAIN + NKV; t += gridDim.x) {
        GemmSrc s; int rt, ct; const bool main_ = t < NMAIN; const bool isvt = t >= NMAIN + 128;
        if (main_) { rt = t / 50; ct = t % 50; make_src(s, (const bf16_t*)(ws + OFF_R0), 1024, rt * 256, (const bf16_t*)(ws + OFF_WIN), 1024, ct * 128, tid); }
        else if (!isvt) { const int u = t - NMAIN; rt = u >> 3; ct = u & 7; make_src(s, (const bf16_t*)(ws + OFF_MEMB), 1024, rt * 256, (const bf16_t*)(ws + OFF_WXKV), 1024, ct * 128, tid); }
        else { const int u = t - NMAIN - 128; rt = u >> 5; ct = u & 31; make_src(s, (const bf16_t*)(ws + OFF_WXKV) + (size_t)1024 * 1024, 1024, rt * 256, (const bf16_t*)(ws + OFF_MEMB), 1024, ct * 128, tid); }
        f32x4 acc[4][4]; zero_acc(acc);
        gemm_loop(acc, s, 16, smem, tid);
        const int row0 = rt * 256 + wr * 64 + fr;
        const int c0w = ct * 128 + wc * 64;
        if (main_ && c0w < 1152) {
            bf16_t* dst; int ld, cb; float sc;
            if (c0w < 1024) { dst = (bf16_t*)(ws + OFF_R1); ld = 1024; cb = c0w; sc = 0.125f; }
            else { dst = (bf16_t*)(ws + OFF_AK); ld = 128; cb = c0w - 1024; sc = 1.0f; }
            const float* cs = (const float*)(ws + OFF_CS);
#pragma unroll
            for (int m = 0; m < 4; ++m) {
                const int tok = row0 + m * 16;
#pragma unroll
                for (int n = 0; n < 2; ++n) {
                    const int d0 = n * 16 + fq * 4;
                    const float4* cp = (const float4*)(cs + (size_t)tok * 64 + d0 * 2);
                    const float4 c01 = cp[0], c23 = cp[1];
                    const f32x4 x1 = acc[m][n], x2 = acc[m][n + 2];
                    f32x4 o1, o2;
                    o1[0] = (x1[0] * c01.x - x2[0] * c01.y) * sc; o2[0] = (x2[0] * c01.x + x1[0] * c01.y) * sc;
                    o1[1] = (x1[1] * c01.z - x2[1] * c01.w) * sc; o2[1] = (x2[1] * c01.z + x1[1] * c01.w) * sc;
                    o1[2] = (x1[2] * c23.x - x2[2] * c23.y) * sc; o2[2] = (x2[2] * c23.x + x1[2] * c23.y) * sc;
                    o1[3] = (x1[3] * c23.z - x2[3] * c23.w) * sc; o2[3] = (x2[3] * c23.z + x1[3] * c23.w) * sc;
                    bf16_t* rp = dst + (size_t)tok * ld + cb + d0;
                    store_bf16x4(rp, o1); store_bf16x4(rp + 32, o2);
                }
            }
        } else {
            bf16_t* dst; int ld, cb; bool sig = false;
            if (!main_) { if (isvt) { dst = (bf16_t*)(ws + OFF_VT); ld = 4096; cb = c0w; } else { dst = (bf16_t*)(ws + OFF_KMAT); ld = 1024; cb = c0w; } }
            else if (c0w < 1280) { dst = nullptr; ld = 0; cb = c0w - 1152; }
            else if (c0w < 2304) { dst = (bf16_t*)(ws + OFF_MQK); ld = 1024; cb = c0w - 1280; }
            else if (c0w < 3328) { dst = (bf16_t*)(ws + OFF_MV); ld = 1024; cb = c0w - 2304; }
            else if (c0w < 4352) { dst = (bf16_t*)(ws + OFF_MO); ld = 1024; cb = c0w - 3328; sig = true; }
            else { dst = (bf16_t*)(ws + OFF_GG); ld = 2048; cb = c0w - 4352; sig = true; }
            if (dst == nullptr) {
                bf16_t* avT = (bf16_t*)(ws + OFF_AV);
#pragma unroll
                for (int m = 0; m < 4; ++m)
#pragma unroll
                    for (int n = 0; n < 4; ++n)
#pragma unroll
                        for (int j = 0; j < 4; ++j)
                            avT[(size_t)(cb + n * 16 + fq * 4 + j) * T_ + row0 + m * 16] = (bf16_t)(pk_bf16(acc[m][n][j], acc[m][n][j]) & 0xffffu);
            } else {
#pragma unroll
            for (int m = 0; m < 4; ++m) {
                bf16_t* rp = dst + (size_t)(row0 + m * 16) * ld + cb + fq * 4;
#pragma unroll
                for (int n = 0; n < 4; ++n) {
                    f32x4 v = acc[m][n];
                    if (sig) { v[0] = sigmoidf_(v[0]); v[1] = sigmoidf_(v[1]); v[2] = sigmoidf_(v[2]); v[3] = sigmoidf_(v[3]); }
                    store_bf16x4(rp + n * 16, v);
                }
            }
            }
        }
    }
}

constexpr int ML_RAW = 0;
constexpr int ML_V0 = 34816;
constexpr int ML_Q = ML_V0 + 65536;
constexpr int ML_K = ML_Q + 16384;
constexpr int ML_SW = ML_K + 20480;
constexpr int ML_F = ML_SW + 8192;
constexpr int ML_END = ML_F + 4096;
typedef short v4i16_t __attribute__((ext_vector_type(4)));
__device__ __forceinline__ int offQK(int row, int ch) { return row * 256 + ((ch ^ (((row & 3) << 2) | ((row >> 2) & 3))) << 4); }
__device__ __forceinline__ int offV(int row, int ch) { return row * 512 + ((ch ^ (((row & 3) | (((row >> 3) & 1) << 2)) << 1)) << 4); }
__device__ __forceinline__ int offSw(int row, int ch) { return row * 128 + ((ch ^ ((row >> 1) & 7)) << 4); }
__device__ __forceinline__ bf16x8 tr_read2(const char* p0, const char* p1) {
    const v4i16_t a = __builtin_amdgcn_ds_read_tr16_b64_v4i16((LDS_AS v4i16_t*)p0);
    const v4i16_t b = __builtin_amdgcn_ds_read_tr16_b64_v4i16((LDS_AS v4i16_t*)p1);
    return __builtin_shufflevector(a, b, 0, 1, 2, 3, 4, 5, 6, 7);
}

__device__ void mlstm_item(const Params& p, char* smem, int item) {
    const int tid = opaque_tid(), lane = tid & 63, wid = tid >> 6, fr0 = lane & 15, fq0 = lane >> 4;
    const int b = item >> 2, h = item & 3;
    char* ws = p.ws;
    const bf16_t* mqk = (const bf16_t*)(ws + OFF_MQK);
    const bf16_t* mv = (const bf16_t*)(ws + OFF_MV);
    const bf16_t* mo = (const bf16_t*)(ws + OFF_MO);
    const float* gates = (const float*)(ws + OFF_GATES);
    bf16_t* hm = (bf16_t*)p.out;
    float* fl = (float*)(smem + ML_F);
    float* den = fl; float* ssq = fl + 64; float* nsum = fl + 192; float* eb = fl + 448; float* ek = fl + 576; float* gg = fl + 704;
    const long tokb = (long)b * 4096;
    f32x4 C[8][2];
#pragma unroll
    for (int dt = 0; dt < 8; ++dt) { C[dt][0] = (f32x4){0.f, 0.f, 0.f, 0.f}; C[dt][1] = (f32x4){0.f, 0.f, 0.f, 0.f}; }
    float nreg = 0.f;
    const int cp0 = tid & 127, tg = tid >> 7; const int cp = cp0;
    const bool isk = cp >= 64;
    const int dch = isk ? 2 * (cp - 64) : 2 * cp;
    const int ccol = isk ? (512 + h * 128 + dch) : (h * 128 + dch);
    float cw0[4], cw1[4];
#pragma unroll
    for (int j = 0; j < 4; ++j) { cw0[j] = p.conv_w[j * 1024 + ccol]; cw1[j] = p.conv_w[j * 1024 + ccol + 1]; }
    const float cb0 = p.conv_b[ccol], cb1 = p.conv_b[ccol + 1];
    const float big = p.b_ig[h], bfg = p.b_fg[h];
    const float gn0 = p.ml_g[h * 256 + wid * 32 + fr0], gn1 = p.ml_g[h * 256 + wid * 32 + 16 + fr0];
    const int vrl = tid >> 5, vpc = tid & 31, vlc = vpc ^ ((((vrl & 3) | (((vrl >> 3) & 1) << 2))) << 1);
    const bf16_t* vsrc = mv + (tokb + vrl) * 1024 + h * 256 + vlc * 8;
    __syncthreads();
    {
        unsigned* kz = (unsigned*)(smem + ML_K + 64 * 256);
        kz[tid] = 0u; kz[tid + 512] = 0u;
        if (tid < 256) nsum[tid] = 0.f;
#pragma unroll
        for (int i = 0; i < 5; ++i) {
            const int j = i * 512 + tid;
            if (j < 2176) {
                const int row = j >> 5, pc = j & 31;
                const bf16_t* src = mqk + (tokb - 3 + row) * 1024 + (pc < 16 ? h * 128 + pc * 8 : 512 + h * 128 + (pc - 16) * 8);
                glds16(src, smem + ML_RAW + j * 16);
            }
        }
#pragma unroll
        for (int i = 0; i < 4; ++i) glds16(vsrc + (long)i * 16 * 1024, smem + ML_V0 + (i * 512 + tid) * 16);
    }
    float gi = 0.f, gf = 0.f;
    if (wid == 7) {
        const float mi0 = gates[(tokb + lane) * 8 + h], mf0 = gates[(tokb + lane) * 8 + 4 + h];
        gi = gates[(tokb + 64 + lane) * 8 + h]; gf = gates[(tokb + 64 + lane) * 8 + 4 + h];
        const float x = mf0 + bfg;
        float bs = fminf(x, 0.f) - log1pf(__expf(-fabsf(x)));
#pragma unroll
        for (int o = 1; o < 64; o <<= 1) { const float y = __shfl_up(bs, o); if (lane >= o) bs += y; }
        eb[lane] = __expf(bs); ek[lane] = __expf(mi0 + big - bs);
        if (lane == 63) gg[0] = __expf(bs);
    }
    asm volatile("s_waitcnt vmcnt(0)" ::: "memory");
    __syncthreads();
#pragma unroll 1
    for (int c = 0; c < 64; ++c) {
        const int par = c & 1;
        const long tok0 = tokb + c * 64;
        int fr = fr0, fq = fq0, cpv = cp0;
        asm volatile("" : "+v"(fr), "+v"(fq), "+v"(cpv));
        if (tid < 64) { den[tid] = 0.f; ssq[par * 64 + tid] = 0.f; }
        {
            const int tt0 = tg * 16;
            const char* rp = smem + ML_RAW + tt0 * 512 + cpv * 4;
            unsigned w0 = *(const unsigned*)(rp), w1 = *(const unsigned*)(rp + 512), w2 = *(const unsigned*)(rp + 1024);
            if (c == 0 && tg == 0) { w0 = 0u; w1 = 0u; w2 = 0u; }
            float cs0 = 0.f, cs1 = 0.f;
            const float* scp = (isk ? ek : eb) + par * 64 + tt0;
            const int dchv = isk ? 2 * (cpv - 64) : 2 * cpv;
            char* dstb = smem + (isk ? ML_K : ML_Q) + (dchv & 7) * 2;
            const float kmul = isk ? 0.08838834764831845f : 1.0f;
#pragma unroll 4
            for (int tt = 0; tt < 16; ++tt) {
                const unsigned w3 = *(const unsigned*)(rp + (tt + 3) * 512);
                float v0 = cb0 + cw0[0] * bf_lo(w0) + cw0[1] * bf_lo(w1) + cw0[2] * bf_lo(w2) + cw0[3] * bf_lo(w3);
                float v1 = cb1 + cw1[0] * bf_hi(w0) + cw1[1] * bf_hi(w1) + cw1[2] * bf_hi(w2) + cw1[3] * bf_hi(w3);
                w0 = w1; w1 = w2; w2 = w3;
                v0 = v0 * sigmoidf_(v0); v1 = v1 * sigmoidf_(v1);
                const float sc = scp[tt] * kmul;
                const float a0 = v0 * sc, a1 = v1 * sc;
                *(unsigned*)(dstb + offQK(tt0 + tt, dchv >> 3)) = pk_bf16(a0, a1);
                cs0 += a0; cs1 += a1;
            }
            if (isk) { atomicAdd(&nsum[par * 128 + dch], cs0); atomicAdd(&nsum[par * 128 + dch + 1], cs1); }
        }
        __syncthreads();
        if (wid == 7 && c + 1 < 64) {
            const float x = gf + bfg;
            float bs = fminf(x, 0.f) - log1pf(__expf(-fabsf(x)));
#pragma unroll
            for (int o = 1; o < 64; o <<= 1) { const float y = __shfl_up(bs, o); if (lane >= o) bs += y; }
            eb[(par ^ 1) * 64 + lane] = __expf(bs); ek[(par ^ 1) * 64 + lane] = __expf(gi + big - bs);
            if (lane == 63) gg[par ^ 1] = __expf(bs);
            if (c + 2 < 64) { gi = gates[(tok0 + 128 + lane) * 8 + h]; gf = gates[(tok0 + 128 + lane) * 8 + 4 + h]; }
        }
        {
            const int tt = wid >> 1;
            bf16x8 qf[4];
#pragma unroll
            for (int ks = 0; ks < 4; ++ks) qf[ks] = *(const bf16x8*)(smem + ML_Q + offQK(tt * 16 + fr, 4 * ks + fq));
#pragma unroll
            for (int x = 0; x < 2; ++x) {
                const int st = (wid & 1) * 2 + x;
                f32x4 a = (f32x4){0.f, 0.f, 0.f, 0.f};
#pragma unroll
                for (int ks = 0; ks < 4; ++ks) {
                    const bf16x8 kf = *(const bf16x8*)(smem + ML_K + offQK(st * 16 + fr, 4 * ks + fq));
                    a = __builtin_amdgcn_mfma_f32_16x16x32_bf16(kf, qf[ks], a, 0, 0, 0);
                }
#pragma unroll
                for (int j = 0; j < 4; ++j) a[j] = (st * 16 + fq * 4 + j) <= (tt * 16 + fr) ? a[j] : 0.f;
                float rs = (a[0] + a[1]) + (a[2] + a[3]);
                rs += __shfl_xor(rs, 16); rs += __shfl_xor(rs, 32);
                if (fq == 0) atomicAdd(&den[tt * 16 + fr], rs);
                uint2 w; w.x = pk_bf16(a[0], a[1]); w.y = pk_bf16(a[2], a[3]);
                *(uint2*)(smem + ML_SW + offSw(tt * 16 + fr, st * 2 + (fq >> 1)) + (fq & 1) * 8) = w;
            }
            if (wid < 4) {
                f32x4 a = (f32x4){0.f, 0.f, 0.f, 0.f};
#pragma unroll
                for (int ks = 0; ks < 4; ++ks) {
                    const bf16x8 kf = *(const bf16x8*)(smem + ML_K + offQK(64 + fr, 4 * ks + fq));
                    const bf16x8 qa = *(const bf16x8*)(smem + ML_Q + offQK(wid * 16 + fr, 4 * ks + fq));
                    a = __builtin_amdgcn_mfma_f32_16x16x32_bf16(kf, qa, a, 0, 0, 0);
                }
                if (fq == 0) atomicAdd(&den[wid * 16 + fr], a[0]);
            }
        }
        f32x4 Y[4][2];
#pragma unroll
        for (int tt = 0; tt < 4; ++tt) { Y[tt][0] = (f32x4){0.f, 0.f, 0.f, 0.f}; Y[tt][1] = (f32x4){0.f, 0.f, 0.f, 0.f}; }
#pragma unroll
        for (int ks = 0; ks < 4; ++ks) {
            u32x4 c0, c1;
            c0[0] = pk_bf16(C[2 * ks][0][0], C[2 * ks][0][1]); c0[1] = pk_bf16(C[2 * ks][0][2], C[2 * ks][0][3]);
            c0[2] = pk_bf16(C[2 * ks + 1][0][0], C[2 * ks + 1][0][1]); c0[3] = pk_bf16(C[2 * ks + 1][0][2], C[2 * ks + 1][0][3]);
            c1[0] = pk_bf16(C[2 * ks][1][0], C[2 * ks][1][1]); c1[1] = pk_bf16(C[2 * ks][1][2], C[2 * ks][1][3]);
            c1[2] = pk_bf16(C[2 * ks + 1][1][0], C[2 * ks + 1][1][1]); c1[3] = pk_bf16(C[2 * ks + 1][1][2], C[2 * ks + 1][1][3]);
            const bf16x8 cf0 = __builtin_bit_cast(bf16x8, c0), cf1 = __builtin_bit_cast(bf16x8, c1);
#pragma unroll
            for (int tt = 0; tt < 4; ++tt) {
                const int row = tt * 16 + fr;
                const u32x2 lo = *(const u32x2*)(smem + ML_Q + offQK(row, 4 * ks + (fq >> 1)) + (fq & 1) * 8);
                const u32x2 hi = *(const u32x2*)(smem + ML_Q + offQK(row, 4 * ks + 2 + (fq >> 1)) + (fq & 1) * 8);
                u32x4 av; av[0] = lo[0]; av[1] = lo[1]; av[2] = hi[0]; av[3] = hi[1];
                const bf16x8 af = __builtin_bit_cast(bf16x8, av);
                Y[tt][0] = __builtin_amdgcn_mfma_f32_16x16x32_bf16(af, cf0, Y[tt][0], 0, 0, 0);
                Y[tt][1] = __builtin_amdgcn_mfma_f32_16x16x32_bf16(af, cf1, Y[tt][1], 0, 0, 0);
            }
        }
        __syncthreads();
        if (c + 1 < 64) {
#pragma unroll
            for (int i = 0; i < 5; ++i) {
                const int j = i * 512 + tid;
                if (j < 2176) {
                    const int row = j >> 5, pc = j & 31;
                    const bf16_t* src = mqk + (tok0 + 64 - 3 + row) * 1024 + (pc < 16 ? h * 128 + pc * 8 : 512 + h * 128 + (pc - 16) * 8);
                    glds16(src, smem + ML_RAW + j * 16);
                }
            }
#pragma unroll
            for (int i = 0; i < 4; ++i) glds16(vsrc + (long)(c + 1) * 64 * 1024 + (long)i * 16 * 1024, smem + ML_V0 + (par ^ 1) * 32768 + (i * 512 + tid) * 16);
        }
        unsigned mop[4][4];
#pragma unroll
        for (int tt = 0; tt < 4; ++tt)
#pragma unroll
            for (int j = 0; j < 4; ++j) {
                const bf16_t* mp = mo + (tok0 + tt * 16 + fq * 4 + j) * 1024 + h * 256 + wid * 32 + fr;
                mop[tt][j] = (unsigned)mp[0] | ((unsigned)mp[16] << 16);
            }
        const char* vb = smem + ML_V0 + par * 32768;
        bf16x8 vf[2][2];
#pragma unroll
        for (int ks = 0; ks < 2; ++ks)
#pragma unroll
            for (int et = 0; et < 2; ++et) {
                const int cidx = 2 * wid + et, ch = 2 * cidx + ((fr & 3) >> 1);
                const int r0 = 32 * ks + 8 * fq + (fr >> 2);
                vf[ks][et] = tr_read2(vb + offV(r0, ch) + 8 * (fr & 1), vb + offV(r0 + 4, ch) + 8 * (fr & 1));
            }
#pragma unroll
        for (int ks = 0; ks < 2; ++ks)
#pragma unroll
            for (int tt = 0; tt < 4; ++tt) {
                const bf16x8 sf = *(const bf16x8*)(smem + ML_SW + offSw(tt * 16 + fr, 4 * ks + fq));
                Y[tt][0] = __builtin_amdgcn_mfma_f32_16x16x32_bf16(sf, vf[ks][0], Y[tt][0], 0, 0, 0);
                Y[tt][1] = __builtin_amdgcn_mfma_f32_16x16x32_bf16(sf, vf[ks][1], Y[tt][1], 0, 0, 0);
            }
#pragma unroll
        for (int tt = 0; tt < 4; ++tt) {
            const float4 dv = *(const float4*)(den + tt * 16 + fq * 4);
            const float dd[4] = {dv.x, dv.y, dv.z, dv.w};
#pragma unroll
            for (int j = 0; j < 4; ++j) {
                const float inv = 1.0f / fmaxf(fabsf(dd[j]), 1.0f);
                Y[tt][0][j] *= inv; Y[tt][1][j] *= inv;
                float sq = Y[tt][0][j] * Y[tt][0][j] + Y[tt][1][j] * Y[tt][1][j];
                sq += __shfl_xor(sq, 1); sq += __shfl_xor(sq, 2); sq += __shfl_xor(sq, 4); sq += __shfl_xor(sq, 8);
                if (fr == 0) atomicAdd(&ssq[par * 64 + tt * 16 + fq * 4 + j], sq);
            }
        }
#pragma unroll
        for (int dt = 0; dt < 8; ++dt)
#pragma unroll
            for (int ks = 0; ks < 2; ++ks) {
                const int ch = 2 * dt + ((fr & 3) >> 1);
                const int r0 = 32 * ks + 8 * fq + (fr >> 2);
                const bf16x8 kf = tr_read2(smem + ML_K + offQK(r0, ch) + 8 * (fr & 1), smem + ML_K + offQK(r0 + 4, ch) + 8 * (fr & 1));
                C[dt][0] = __builtin_amdgcn_mfma_f32_16x16x32_bf16(kf, vf[ks][0], C[dt][0], 0, 0, 0);
                C[dt][1] = __builtin_amdgcn_mfma_f32_16x16x32_bf16(kf, vf[ks][1], C[dt][1], 0, 0, 0);
                if (ks == 1 && (dt & 1)) __builtin_amdgcn_sched_barrier(0);
            }
        const float g = gg[par];
#pragma unroll
        for (int dt = 0; dt < 8; ++dt) { C[dt][0] *= g; C[dt][1] *= g; }
        asm volatile("s_waitcnt vmcnt(0)" ::: "memory");
        __syncthreads();
#pragma unroll
        for (int tt = 0; tt < 4; ++tt) {
            const float4 sv = *(const float4*)(ssq + par * 64 + tt * 16 + fq * 4);
            const float ss[4] = {sv.x, sv.y, sv.z, sv.w};
#pragma unroll
            for (int j = 0; j < 4; ++j) {
                const float rstd = rsqrtf(ss[j] * (1.0f / 256.0f) + 1e-6f);
                bf16_t* hp = hm + (tok0 + tt * 16 + fq * 4 + j) * 1024 + h * 256 + wid * 32 + fr;
                const float o0 = Y[tt][0][j] * rstd * gn0 * bf_lo(mop[tt][j]);
                const float o1 = Y[tt][1][j] * rstd * gn1 * bf_hi(mop[tt][j]);
                hp[0] = (bf16_t)(pk_bf16(o0, o0) & 0xffffu); hp[16] = (bf16_t)(pk_bf16(o1, o1) & 0xffffu);
            }
        }
        if (tid < 128) {
            nreg = g * (nreg + nsum[par * 128 + tid]);
            nsum[par * 128 + tid] = 0.f;
            *(bf16_t*)(smem + ML_K + offQK(64, tid >> 3) + (tid & 7) * 2) = (bf16_t)(pk_bf16(nreg, nreg) & 0xffffu);
        }
    }
    __syncthreads();
}

__device__ void swa_items(const Params& p, char* smem, int first, int stride) {
    const int tid = opaque_tid(), lane = tid & 63, wid = tid >> 6, fr = lane & 15, fq = lane >> 4;
    char* ws = p.ws;
    const bf16_t* aq = (const bf16_t*)(ws + OFF_R1);
    const bf16_t* ak = (const bf16_t*)(ws + OFF_AK);
    const bf16_t* avT = (const bf16_t*)(ws + OFF_AV);
    bf16_t* ao = (bf16_t*)(ws + OFF_R0);
    char* kbuf = smem; char* vbuf = smem + 32768;
    for (int item = first; item < 1024; item += stride) {
        const int kvh = item & 1, n = (item >> 1) & 31, b = item >> 6;
        const int hq = kvh * 8 + wid;
        const long tokbase = (long)b * 4096 + n * 128 - 128;
        {
            const int rk = tid >> 3, pck = tid & 7, lck = pck ^ ((rk >> 1) & 7);
            const bf16_t* srck = ak + (tokbase + rk) * 128 + kvh * 64 + lck * 8;
#pragma unroll
            for (int i = 0; i < 4; ++i) glds16(srck + (long)i * 64 * 128, kbuf + (i * 512 + tid) * 16);
            const int rv = tid >> 5, pcv = tid & 31, lcv = pcv ^ (rv & 15);
            const bf16_t* srcv = avT + (long)(kvh * 64 + rv) * T_ + tokbase + lcv * 8;
#pragma unroll
            for (int i = 0; i < 4; ++i) glds16(srcv + (long)i * 16 * T_, vbuf + (i * 512 + tid) * 16);
        }
        const float sink = p.sinks[hq];
        asm volatile("s_waitcnt vmcnt(0)" ::: "memory");
        __syncthreads();
        const int kswz = (fr >> 1) & 7;
#pragma unroll 1
        for (int u = 0; u < 4; ++u) {
            const long tq = (long)b * 4096 + n * 128 + u * 32 + fr;
            const bf16_t* qp = aq + tq * 1024 + hq * 64 + fq * 8;
            const bf16x8 q00 = *(const bf16x8*)(qp), q01 = *(const bf16x8*)(qp + 32);
            const bf16x8 q10 = *(const bf16x8*)(qp + 16 * 1024), q11 = *(const bf16x8*)(qp + 16 * 1024 + 32);
            f32x4 sc[10][2];
#pragma unroll
            for (int r = 0; r < 10; ++r) {
                sc[r][0] = (f32x4){0.f, 0.f, 0.f, 0.f}; sc[r][1] = (f32x4){0.f, 0.f, 0.f, 0.f};
                if (!(n == 0 && (2 * u + r) < 8)) {
                    const char* rowp = kbuf + ((2 * u + r) * 16 + fr) * 128;
                    const bf16x8 k0 = *(const bf16x8*)(rowp + ((fq ^ kswz) * 16)), k1 = *(const bf16x8*)(rowp + (((4 + fq) ^ kswz) * 16));
                    sc[r][0] = __builtin_amdgcn_mfma_f32_16x16x32_bf16(k0, q00, sc[r][0], 0, 0, 0);
                    sc[r][0] = __builtin_amdgcn_mfma_f32_16x16x32_bf16(k1, q01, sc[r][0], 0, 0, 0);
                    sc[r][1] = __builtin_amdgcn_mfma_f32_16x16x32_bf16(k0, q10, sc[r][1], 0, 0, 0);
                    sc[r][1] = __builtin_amdgcn_mfma_f32_16x16x32_bf16(k1, q11, sc[r][1], 0, 0, 0);
                }
            }
            u32x4 pf[2][5]; float linv[2];
#pragma unroll
            for (int nt = 0; nt < 2; ++nt) {
                float m = sink;
#pragma unroll
                for (int r = 0; r < 10; ++r) {
                    const bool tile_ok = !(n == 0 && (2 * u + r) < 8);
#pragma unroll
                    for (int j = 0; j < 4; ++j) {
                        const int delta = (r - nt) * 16 + fq * 4 + j - fr;
                        const bool ok = tile_ok && delta >= 1 && delta <= 128;
                        sc[r][nt][j] = ok ? sc[r][nt][j] : -INFINITY;
                        m = fmaxf(m, sc[r][nt][j]);
                    }
                }
                m = fmaxf(m, __shfl_xor(m, 16)); m = fmaxf(m, __shfl_xor(m, 32));
                float l = 0.f;
#pragma unroll
                for (int s2 = 0; s2 < 5; ++s2) {
                    float e[8];
#pragma unroll
                    for (int j = 0; j < 4; ++j) { e[j] = __expf(sc[2 * s2][nt][j] - m); e[4 + j] = __expf(sc[2 * s2 + 1][nt][j] - m); }
                    l += ((e[0] + e[1]) + (e[2] + e[3])) + ((e[4] + e[5]) + (e[6] + e[7]));
                    u32x4 w; w[0] = pk_bf16(e[0], e[1]); w[1] = pk_bf16(e[2], e[3]); w[2] = pk_bf16(e[4], e[5]); w[3] = pk_bf16(e[6], e[7]);
                    pf[nt][s2] = w;
                }
                l += __shfl_xor(l, 16); l += __shfl_xor(l, 32);
                linv[nt] = 1.0f / (l + __expf(sink - m));
            }
            f32x4 o[4][2];
#pragma unroll
            for (int dt = 0; dt < 4; ++dt) { o[dt][0] = (f32x4){0.f, 0.f, 0.f, 0.f}; o[dt][1] = (f32x4){0.f, 0.f, 0.f, 0.f}; }
#pragma unroll
            for (int s2 = 0; s2 < 5; ++s2) {
                if (!(n == 0 && (2 * u + 2 * s2) < 8)) {
                    const int ca = ((((2 * u + 2 * s2) * 2 + (fq >> 1)) ^ fr) * 16) + (fq & 1) * 8;
                    const int cb = ((((2 * u + 2 * s2 + 1) * 2 + (fq >> 1)) ^ fr) * 16) + (fq & 1) * 8;
                    const bf16x8 p0 = __builtin_bit_cast(bf16x8, pf[0][s2]), p1 = __builtin_bit_cast(bf16x8, pf[1][s2]);
#pragma unroll
                    for (int dt = 0; dt < 4; ++dt) {
                        const char* rowp = vbuf + (dt * 16 + fr) * 512;
                        const u32x2 va = *(const u32x2*)(rowp + ca), vb = *(const u32x2*)(rowp + cb);
                        u32x4 vv; vv[0] = va[0]; vv[1] = va[1]; vv[2] = vb[0]; vv[3] = vb[1];
                        const bf16x8 vf = __builtin_bit_cast(bf16x8, vv);
                        o[dt][0] = __builtin_amdgcn_mfma_f32_16x16x32_bf16(vf, p0, o[dt][0], 0, 0, 0);
                        o[dt][1] = __builtin_amdgcn_mfma_f32_16x16x32_bf16(vf, p1, o[dt][1], 0, 0, 0);
                    }
                }
            }
#pragma unroll
            for (int nt = 0; nt < 2; ++nt) {
                bf16_t* rp = ao + (size_t)(tq + nt * 16) * 1024 + hq * 64 + fq * 4;
#pragma unroll
                for (int dt = 0; dt < 4; ++dt) store_bf16x4(rp + dt * 16, o[dt][nt] * linv[nt]);
            }
        }
        __syncthreads();
    }
}

__device__ void phase2(const Params& p, char* smem) {
    const int G = gridDim.x;
    if (G > 64) {
        if (blockIdx.x < 64) mlstm_item(p, smem, blockIdx.x);
        else swa_items(p, smem, blockIdx.x - 64, G - 64);
    } else {
        for (int it = blockIdx.x; it < 64; it += G) mlstm_item(p, smem, it);
        swa_items(p, smem, blockIdx.x, G);
    }
}

__device__ void phase3(const Params& p, char* smem) {
    const int tid = opaque_tid(), lane = tid & 63, wid = tid >> 6, wr = wid >> 1, wc = wid & 1, fr = lane & 15, fq = lane >> 4;
    char* ws = p.ws;
    const bf16_t* gg = (const bf16_t*)(ws + OFF_GG);
    bf16_t* y = (bf16_t*)(ws + OFF_R1);
    for (int t = blockIdx.x; t < 256 * 8; t += gridDim.x) {
        const int rt = t >> 3, ct = t & 7;
        GemmSrc s;
        f32x4 acca[4][4], accm[4][4]; zero_acc(acca); zero_acc(accm);
        make_src(s, (const bf16_t*)(ws + OFF_R0), 1024, rt * 256, (const bf16_t*)(ws + OFF_WATT), 1024, ct * 128, tid);
        gemm_loop(acca, s, 16, smem, tid);
        make_src(s, (const bf16_t*)p.out, 1024, rt * 256, (const bf16_t*)(ws + OFF_WML), 1024, ct * 128, tid);
        gemm_loop(accm, s, 16, smem, tid);
        const int row0 = rt * 256 + wr * 64 + fr, col0 = ct * 128 + wc * 64 + fq * 4;
#pragma unroll
        for (int m = 0; m < 4; ++m) {
            const size_t tok = row0 + m * 16;
#pragma unroll
            for (int n = 0; n < 4; ++n) {
                const int col = col0 + n * 16;
                const uint2 ga = *(const uint2*)(gg + tok * 2048 + col), gm = *(const uint2*)(gg + tok * 2048 + 1024 + col);
                f32x4 v;
                v[0] = bf_lo(ga.x) * acca[m][n][0] + bf_lo(gm.x) * accm[m][n][0];
                v[1] = bf_hi(ga.x) * acca[m][n][1] + bf_hi(gm.x) * accm[m][n][1];
                v[2] = bf_lo(ga.y) * acca[m][n][2] + bf_lo(gm.y) * accm[m][n][2];
                v[3] = bf_hi(ga.y) * acca[m][n][3] + bf_hi(gm.y) * accm[m][n][3];
                store_bf16x4(y + tok * 1024 + col, v);
            }
        }
    }
}

__device__ void phase_gemm_resid(const Params& p, char* smem, const bf16_t* A, const bf16_t* Bt, const float* resid, float* outz) {
    const int tid = opaque_tid(), lane = tid & 63, wid = tid >> 6, wr = wid >> 1, wc = wid & 1, fr = lane & 15, fq = lane >> 4;
    for (int t = blockIdx.x; t < 256 * 8; t += gridDim.x) {
        const int rt = t >> 3, ct = t & 7;
        GemmSrc s; f32x4 acc[4][4]; zero_acc(acc);
        make_src(s, A, 1024, rt * 256, Bt, 1024, ct * 128, tid);
        gemm_loop(acc, s, 16, smem, tid);
        const int row0 = rt * 256 + wr * 64 + fr, col0 = ct * 128 + wc * 64 + fq * 4;
#pragma unroll
        for (int m = 0; m < 4; ++m) {
            const size_t tok = row0 + m * 16;
#pragma unroll
            for (int n = 0; n < 4; ++n) {
                const int col = col0 + n * 16;
                const float4 r = *(const float4*)(resid + tok * 1024 + col);
                float4 o; o.x = ALPHA * r.x + acc[m][n][0]; o.y = ALPHA * r.y + acc[m][n][1]; o.z = ALPHA * r.z + acc[m][n][2]; o.w = ALPHA * r.w + acc[m][n][3];
                *(float4*)(outz + tok * 1024 + col) = o;
            }
        }
    }
}

__device__ void phase_gemm_bf16(const Params& p, char* smem, const bf16_t* A, const bf16_t* Bt, bf16_t* outb, float scale) {
    const int tid = opaque_tid(), lane = tid & 63, wid = tid >> 6, wr = wid >> 1, wc = wid & 1, fr = lane & 15, fq = lane >> 4;
    for (int t = blockIdx.x; t < 256 * 8; t += gridDim.x) {
        const int rt = t >> 3, ct = t & 7;
        GemmSrc s; f32x4 acc[4][4]; zero_acc(acc);
        make_src(s, A, 1024, rt * 256, Bt, 1024, ct * 128, tid);
        gemm_loop(acc, s, 16, smem, tid);
        const int row0 = rt * 256 + wr * 64 + fr, col0 = ct * 128 + wc * 64 + fq * 4;
#pragma unroll
        for (int m = 0; m < 4; ++m) {
            const size_t tok = row0 + m * 16;
#pragma unroll
            for (int n = 0; n < 4; ++n) store_bf16x4(outb + tok * 1024 + col0 + n * 16, acc[m][n] * scale);
        }
    }
}

__device__ __forceinline__ void ln_row(float4 (&v)[4], const float* g, const float* bta, int lane) {
    float s = 0.f;
#pragma unroll
    for (int i = 0; i < 4; ++i) s += (v[i].x + v[i].y) + (v[i].z + v[i].w);
    const float mu = wsum(s) * (1.0f / 1024.0f);
    float q = 0.f;
#pragma unroll
    for (int i = 0; i < 4; ++i) { const float a = v[i].x - mu, b = v[i].y - mu, c = v[i].z - mu, d = v[i].w - mu; q += (a * a + b * b) + (c * c + d * d); }
    const float rstd = rsqrtf(wsum(q) * (1.0f / 1024.0f) + 1e-5f);
#pragma unroll
    for (int i = 0; i < 4; ++i) {
        const float4 gg = *(const float4*)(g + i * 256 + lane * 4), bb = *(const float4*)(bta + i * 256 + lane * 4);
        v[i].x = (v[i].x - mu) * rstd * gg.x + bb.x; v[i].y = (v[i].y - mu) * rstd * gg.y + bb.y;
        v[i].z = (v[i].z - mu) * rstd * gg.z + bb.z; v[i].w = (v[i].w - mu) * rstd * gg.w + bb.w;
    }
}

__device__ void phase_ln1(const Params& p) {
    const int tid_ = opaque_tid(); const int lane = tid_ & 63, wid = tid_ >> 6;
    float* z = p.out; bf16_t* hb = (bf16_t*)(p.ws + OFF_R0);
    for (int row = blockIdx.x * 8 + wid; row < T_; row += gridDim.x * 8) {
        float4 v[4];
#pragma unroll
        for (int i = 0; i < 4; ++i) v[i] = *(const float4*)(z + (size_t)row * 1024 + i * 256 + lane * 4);
        ln_row(v, p.ln1g, p.ln1b, lane);
#pragma unroll
        for (int i = 0; i < 4; ++i) {
            *(float4*)(z + (size_t)row * 1024 + i * 256 + lane * 4) = v[i];
            uint2 w; w.x = pk_bf16(v[i].x, v[i].y); w.y = pk_bf16(v[i].z, v[i].w);
            *(uint2*)(hb + (size_t)row * 1024 + i * 256 + lane * 4) = w;
        }
    }
}

__device__ __forceinline__ void xa_stage_k(const bf16_t* kmat, int b, int h, int kh, char* buf, int tid) {
    const int rl = tid >> 5, pc = tid & 31, lc = pc ^ (rl & 15);
    const bf16_t* src = kmat + (size_t)(b * 256 + kh * 128 + rl) * 1024 + h * 256 + lc * 8;
#pragma unroll
    for (int i = 0; i < 8; ++i) glds16(src + (size_t)i * 16 * 1024, buf + (i * 512 + tid) * 16);
}
__device__ __forceinline__ void xa_stage_v(const bf16_t* vT, int b, int h, int vh, char* buf, int tid) {
    const int rl = tid >> 4, pc = tid & 15, lc = pc ^ (rl & 15);
    const bf16_t* src = vT + (size_t)(h * 256 + rl) * 4096 + b * 256 + vh * 128 + lc * 8;
#pragma unroll
    for (int i = 0; i < 8; ++i) glds16(src + (size_t)i * 32 * 4096, buf + (i * 512 + tid) * 16);
}

template <int KH>
__device__ __forceinline__ void xa_scores(f32x4 (&acc)[16][2], const char* buf, const bf16_t* q0p, const bf16_t* q1p, int fr, int fq) {
#pragma unroll 2
    for (int ks = 0; ks < 8; ++ks) {
        const bf16x8 q0 = *(const bf16x8*)(q0p + ks * 32), q1 = *(const bf16x8*)(q1p + ks * 32);
        const int ch = ((ks * 4 + fq) ^ fr) * 16;
#pragma unroll
        for (int mt = 0; mt < 8; ++mt) {
            const bf16x8 kf = *(const bf16x8*)(buf + (mt * 16 + fr) * 512 + ch);
            acc[KH * 8 + mt][0] = __builtin_amdgcn_mfma_f32_16x16x32_bf16(kf, q0, acc[KH * 8 + mt][0], 0, 0, 0);
            acc[KH * 8 + mt][1] = __builtin_amdgcn_mfma_f32_16x16x32_bf16(kf, q1, acc[KH * 8 + mt][1], 0, 0, 0);
        }
    }
}


template <int VH, int DH>
__device__ __forceinline__ void xa_pv(f32x4 (&o)[8][2], const u32x4 (&pf)[2][8], const char* buf, int fr, int fq) {
#pragma unroll
    for (int ks = 0; ks < 4; ++ks) {
        const int ca = ((ks * 4 + (fq >> 1)) ^ fr) * 16 + (fq & 1) * 8, cb = ((ks * 4 + 2 + (fq >> 1)) ^ fr) * 16 + (fq & 1) * 8;
        const bf16x8 p0 = __builtin_bit_cast(bf16x8, pf[0][VH * 4 + ks]), p1 = __builtin_bit_cast(bf16x8, pf[1][VH * 4 + ks]);
#pragma unroll
        for (int dt = 0; dt < 8; ++dt) {
            const char* rowp = buf + ((DH * 8 + dt) * 16 + fr) * 256;
            const u32x2 va = *(const u32x2*)(rowp + ca), vb = *(const u32x2*)(rowp + cb);
            u32x4 vv; vv[0] = va[0]; vv[1] = va[1]; vv[2] = vb[0]; vv[3] = vb[1];
            const bf16x8 vf = __builtin_bit_cast(bf16x8, vv);
            o[dt][0] = __builtin_amdgcn_mfma_f32_16x16x32_bf16(vf, p0, o[dt][0], 0, 0, 0);
            o[dt][1] = __builtin_amdgcn_mfma_f32_16x16x32_bf16(vf, p1, o[dt][1], 0, 0, 0);
        }
    }
}

__device__ void phase6(const Params& p, char* smem) {
    const int tid = opaque_tid(), lane = tid & 63, wid = tid >> 6, fr = lane & 15, fq = lane >> 4;
    char* ws = p.ws;
    const bf16_t* xq = (const bf16_t*)(ws + OFF_XQ);
    const bf16_t* kmat = (const bf16_t*)(ws + OFF_KMAT);
    const bf16_t* vT = (const bf16_t*)(ws + OFF_VT);
    bf16_t* og = (bf16_t*)(ws + OFF_O);
    char* bufA = smem; char* bufB = smem + 65536;
    const int G = gridDim.x;
    for (int idx = blockIdx.x; idx < 1024; idx += G) {
        int pair, qt;
        if (G == 256) { const int i = idx >> 8, blk = idx & 255, xcd = blk & 7, jj = blk >> 3; pair = (i * 8 + xcd) * 2 + (jj >> 4); qt = jj & 15; }
        else { pair = idx >> 4; qt = idx & 15; }
        const int b = pair >> 2, h = pair & 3;
        const int tok0 = b * 4096 + qt * 256 + wid * 32;
        xa_stage_k(kmat, b, h, 0, bufA, tid);
        xa_stage_k(kmat, b, h, 1, bufB, tid);
        const bf16_t* q0p = xq + (size_t)(tok0 + fr) * 1024 + h * 256 + fq * 8;
        const bf16_t* q1p = q0p + (size_t)16 * 1024;
        f32x4 acc[16][2];
#pragma unroll
        for (int mt = 0; mt < 16; ++mt) { acc[mt][0] = (f32x4){0.f, 0.f, 0.f, 0.f}; acc[mt][1] = (f32x4){0.f, 0.f, 0.f, 0.f}; }
        asm volatile("s_waitcnt vmcnt(0)" ::: "memory");
        __syncthreads();
        xa_scores<0>(acc, bufA, q0p, q1p, fr, fq);
        xa_scores<1>(acc, bufB, q0p, q1p, fr, fq);
        __syncthreads();
        xa_stage_v(vT, b, h, 0, bufA, tid);
        xa_stage_v(vT, b, h, 1, bufB, tid);
        u32x4 pf[2][8]; float linv[2];
#pragma unroll
        for (int nt = 0; nt < 2; ++nt) {
            float m = -INFINITY;
#pragma unroll
            for (int mt = 0; mt < 16; ++mt) m = fmaxf(m, fmaxf(fmaxf(acc[mt][nt][0], acc[mt][nt][1]), fmaxf(acc[mt][nt][2], acc[mt][nt][3])));
            m = fmaxf(m, __shfl_xor(m, 16)); m = fmaxf(m, __shfl_xor(m, 32));
            float l = 0.f;
#pragma unroll
            for (int s2 = 0; s2 < 8; ++s2) {
                float e[8];
#pragma unroll
                for (int j = 0; j < 4; ++j) { e[j] = __expf(acc[2 * s2][nt][j] - m); e[4 + j] = __expf(acc[2 * s2 + 1][nt][j] - m); }
                l += ((e[0] + e[1]) + (e[2] + e[3])) + ((e[4] + e[5]) + (e[6] + e[7]));
                u32x4 w; w[0] = pk_bf16(e[0], e[1]); w[1] = pk_bf16(e[2], e[3]); w[2] = pk_bf16(e[4], e[5]); w[3] = pk_bf16(e[6], e[7]);
                pf[nt][s2] = w;
            }
            l += __shfl_xor(l, 16); l += __shfl_xor(l, 32);
            linv[nt] = 1.0f / l;
        }
        asm volatile("s_waitcnt vmcnt(0)" ::: "memory");
        __syncthreads();
        {
            f32x4 o[8][2];
#pragma unroll
            for (int dt = 0; dt < 8; ++dt) { o[dt][0] = (f32x4){0.f, 0.f, 0.f, 0.f}; o[dt][1] = (f32x4){0.f, 0.f, 0.f, 0.f}; }
            xa_pv<0, 0>(o, pf, bufA, fr, fq);
            xa_pv<1, 0>(o, pf, bufB, fr, fq);
#pragma unroll
            for (int nt = 0; nt < 2; ++nt) {
                bf16_t* rp = og + (size_t)(tok0 + nt * 16 + fr) * 1024 + h * 256 + fq * 4;
#pragma unroll
                for (int dt = 0; dt < 8; ++dt) store_bf16x4(rp + dt * 16, o[dt][nt] * linv[nt]);
            }
        }
        {
            f32x4 o[8][2];
#pragma unroll
            for (int dt = 0; dt < 8; ++dt) { o[dt][0] = (f32x4){0.f, 0.f, 0.f, 0.f}; o[dt][1] = (f32x4){0.f, 0.f, 0.f, 0.f}; }
            xa_pv<0, 1>(o, pf, bufA, fr, fq);
            xa_pv<1, 1>(o, pf, bufB, fr, fq);
#pragma unroll
            for (int nt = 0; nt < 2; ++nt) {
                bf16_t* rp = og + (size_t)(tok0 + nt * 16 + fr) * 1024 + h * 256 + 128 + fq * 4;
#pragma unroll
                for (int dt = 0; dt < 8; ++dt) store_bf16x4(rp + dt * 16, o[dt][nt] * linv[nt]);
            }
        }
        __syncthreads();
    }
}

__device__ void phase_ln2_router(const Params& p, char* smem) {
    const int tid = opaque_tid(), lane = tid & 63, wid = tid >> 6;
    char* ws = p.ws;
    float* z = (float*)(ws + OFF_Z2); bf16_t* hb = (bf16_t*)(ws + OFF_R0);
    int2* toke = (int2*)(ws + OFF_TOKE); float2* tokw = (float2*)(ws + OFF_TOKW);
    int* histg = (int*)(ws + OFF_HIST);
    int* hist = (int*)smem;
    for (int c = blockIdx.x; c < 256; c += gridDim.x) {
        if (tid < 64) hist[tid] = 0;
        __syncthreads();
        for (int rr = 0; rr < 32; ++rr) {
            const int row = c * 256 + wid * 32 + rr;
            float4 v[4];
#pragma unroll
            for (int i = 0; i < 4; ++i) v[i] = *(const float4*)(z + (size_t)row * 1024 + i * 256 + lane * 4);
            ln_row(v, p.ln2g, p.ln2b, lane);
#pragma unroll
            for (int i = 0; i < 4; ++i) {
                *(float4*)(z + (size_t)row * 1024 + i * 256 + lane * 4) = v[i];
                uint2 w; w.x = pk_bf16(v[i].x, v[i].y); w.y = pk_bf16(v[i].z, v[i].w);
                *(uint2*)(hb + (size_t)row * 1024 + i * 256 + lane * 4) = w;
            }
            float g[8];
#pragma unroll
            for (int k = 0; k < 8; ++k) g[k] = 0.f;
#pragma unroll
            for (int i = 0; i < 4; ++i) {
                const float vv[4] = {v[i].x, v[i].y, v[i].z, v[i].w};
#pragma unroll
                for (int jj = 0; jj < 4; ++jj) {
                    const float4* wp = (const float4*)(p.w_rg + (size_t)(i * 256 + lane * 4 + jj) * 8);
                    const float4 w0 = wp[0], w1 = wp[1];
                    g[0] += vv[jj] * w0.x; g[1] += vv[jj] * w0.y; g[2] += vv[jj] * w0.z; g[3] += vv[jj] * w0.w;
                    g[4] += vv[jj] * w1.x; g[5] += vv[jj] * w1.y; g[6] += vv[jj] * w1.z; g[7] += vv[jj] * w1.w;
                }
            }
            float gmax = -INFINITY; int gsel = 0;
#pragma unroll
            for (int k = 0; k < 8; ++k) { g[k] = wsum(g[k]) + p.b_rg[k]; if (g[k] > gmax) { gmax = g[k]; gsel = k; } }
            float gs = 0.f;
#pragma unroll
            for (int k = 0; k < 8; ++k) gs += __expf(g[k] - gmax);
            const float pgroup = 1.0f / gs;
            gsel = __builtin_amdgcn_readfirstlane(gsel);
            float ex[8];
#pragma unroll
            for (int k = 0; k < 8; ++k) ex[k] = 0.f;
#pragma unroll
            for (int i = 0; i < 4; ++i) {
                const float vv[4] = {v[i].x, v[i].y, v[i].z, v[i].w};
#pragma unroll
                for (int jj = 0; jj < 4; ++jj) {
                    const float4* wp = (const float4*)(p.w_re + (size_t)(i * 256 + lane * 4 + jj) * 64 + gsel * 8);
                    const float4 w0 = wp[0], w1 = wp[1];
                    ex[0] += vv[jj] * w0.x; ex[1] += vv[jj] * w0.y; ex[2] += vv[jj] * w0.z; ex[3] += vv[jj] * w0.w;
                    ex[4] += vv[jj] * w1.x; ex[5] += vv[jj] * w1.y; ex[6] += vv[jj] * w1.z; ex[7] += vv[jj] * w1.w;
                }
            }
            float v0 = -INFINITY, v1 = -INFINITY; int i0 = 0, i1 = 0;
#pragma unroll
            for (int k = 0; k < 8; ++k) {
                const float lv = wsum(ex[k]) + p.b_re[gsel * 8 + k];
                if (lv > v0) { v1 = v0; i1 = i0; v0 = lv; i0 = k; }
                else if (lv > v1) { v1 = lv; i1 = k; }
            }
            const float e1 = __expf(v1 - v0), den = 1.0f + e1;
            const float w0 = pgroup / den, w1 = pgroup * e1 / den;
            if (lane == 0) {
                const int ea = gsel * 8 + i0, eb = gsel * 8 + i1;
                toke[row] = make_int2(ea, eb); tokw[row] = make_float2(w0, w1);
                atomicAdd(&hist[ea], 1); atomicAdd(&hist[eb], 1);
            }
        }
        __syncthreads();
        if (tid < 64) histg[c * 64 + tid] = hist[tid];
        __syncthreads();
    }
}

__device__ void compute_segments(const int* histg, int* seg, int tid) {
    if (tid < 64) {
        int s = 0;
        for (int c = 0; c < 256; ++c) s += histg[c * 64 + tid];
        seg[tid] = s;
    }
    __syncthreads();
    if (tid == 0) {
        int acc = 0;
        for (int e = 0; e < 64; ++e) { seg[64 + e] = acc; acc += (seg[e] + 255) >> 8; }
        seg[128] = acc;
    }
    __syncthreads();
}

__device__ void phase8(const Params& p, char* smem) {
    const int tid = opaque_tid();
    char* ws = p.ws;
    const int* histg = (const int*)(ws + OFF_HIST);
    const int2* toke = (const int2*)(ws + OFF_TOKE); const float2* tokw = (const float2*)(ws + OFF_TOKW);
    int* slot_tok = (int*)(ws + OFF_SLOTTOK); float* slot_w = (float*)(ws + OFF_SLOTW);
    int* seg = (int*)smem;
    int* cursor = seg + 192;
    compute_segments(histg, seg, tid);
    for (int e = blockIdx.x; e < 64; e += gridDim.x) {
        const int start = seg[64 + e] * 256 + seg[e], end = seg[64 + e + 1] * 256;
        for (int s = start + tid; s < end; s += NTHR) { slot_tok[s] = -1; slot_w[s] = 0.f; }
    }
    for (int c = blockIdx.x; c < 256; c += gridDim.x) {
        __syncthreads();
        if (tid < 64) {
            int base = 0;
            for (int cc = 0; cc < c; ++cc) base += histg[cc * 64 + tid];
            cursor[tid] = seg[64 + tid] * 256 + base;
        }
        __syncthreads();
        if (tid < 256) {
            const int tok = c * 256 + tid;
            const int2 ee = toke[tok]; const float2 ww = tokw[tok];
            const int s0 = atomicAdd(&cursor[ee.x], 1);
            const int s1 = atomicAdd(&cursor[ee.y], 1);
            slot_tok[s0] = tok * 2; slot_w[s0] = ww.x;
            slot_tok[s1] = tok * 2 + 1; slot_w[s1] = ww.y;
        }
    }
}

__device__ void phase9a(const Params& p, char* smem) {
    const int tid = opaque_tid(), lane = tid & 63, wid = tid >> 6, wr = wid >> 1, wc = wid & 1, fr = lane & 15, fq = lane >> 4;
    char* ws = p.ws;
    int* seg = (int*)(smem + LDS_GEMM);
    compute_segments((const int*)(ws + OFF_HIST), seg, tid);
    const int nrt = seg[128];
    const int* slot_tok = (const int*)(ws + OFF_SLOTTOK);
    const bf16_t* h2b = (const bf16_t*)(ws + OFF_R0);
    bf16_t* hbuf = (bf16_t*)(ws + OFF_R1);
    for (int t = blockIdx.x; t < nrt * 4; t += gridDim.x) {
        const int rtile = t >> 2, nt = t & 3;
        int e = 0;
        for (int k = 1; k < 64; ++k) if (seg[64 + k] <= rtile) e = k;
        GemmSrc s;
        {
            const int r = tid >> 3, lc = (tid & 7) ^ ((r >> 1) & 7);
#pragma unroll
            for (int i = 0; i < 4; ++i) {
                const int tk = slot_tok[rtile * 256 + i * 64 + r];
                const int tok = tk < 0 ? 0 : (tk >> 1);
                s.a[i] = h2b + (size_t)tok * 1024 + lc * 8;
            }
#pragma unroll
            for (int i = 0; i < 2; ++i) s.b[i] = (const bf16_t*)(ws + OFF_WGU) + (size_t)e * 512 * 1024 + (size_t)(nt * 128 + i * 64 + r) * 1024 + lc * 8;
        }
        f32x4 acc[4][4]; zero_acc(acc);
        gemm_loop(acc, s, 16, smem, tid);
        const int row0 = rtile * 256 + wr * 64 + fr;
        const int colb = (nt * 2 + wc) * 32 + fq * 4;
#pragma unroll
        for (int m = 0; m < 4; ++m) {
            const size_t slot = row0 + m * 16;
#pragma unroll
            for (int n = 0; n < 2; ++n) {
                const f32x4 g = acc[m][n], u = acc[m][n + 2];
                f32x4 v;
#pragma unroll
                for (int j = 0; j < 4; ++j) v[j] = g[j] * sigmoidf_(g[j]) * u[j];
                store_bf16x4(hbuf + slot * 256 + colb + n * 16, v);
            }
        }
    }
}

__device__ void phase9b(const Params& p, char* smem) {
    const int tid = opaque_tid(), lane = tid & 63, wid = tid >> 6, wr = wid >> 1, wc = wid & 1, fr = lane & 15, fq = lane >> 4;
    char* ws = p.ws;
    int* seg = (int*)(smem + LDS_GEMM);
    compute_segments((const int*)(ws + OFF_HIST), seg, tid);
    const int nrt = seg[128];
    const int* slot_tok = (const int*)(ws + OFF_SLOTTOK); const float* slot_w = (const float*)(ws + OFF_SLOTW);
    const bf16_t* hbuf = (const bf16_t*)(ws + OFF_R1);
    bf16_t* yb = (bf16_t*)(ws + OFF_YB);
    for (int t = blockIdx.x; t < nrt * 8; t += gridDim.x) {
        const int rtile = t >> 3, nt = t & 7;
        int e = 0;
        for (int k = 1; k < 64; ++k) if (seg[64 + k] <= rtile) e = k;
        GemmSrc s;
        make_src(s, hbuf, 256, rtile * 256, (const bf16_t*)(ws + OFF_WD) + (size_t)e * 1024 * 256, 256, nt * 128, tid);
        f32x4 acc[4][4]; zero_acc(acc);
        gemm_loop(acc, s, 4, smem, tid);
        const int row0 = rtile * 256 + wr * 64 + fr, col0 = nt * 128 + wc * 64 + fq * 4;
#pragma unroll
        for (int m = 0; m < 4; ++m) {
            const int slot = row0 + m * 16;
            const int tk = slot_tok[slot]; const float w = slot_w[slot];
            if (tk >= 0) {
#pragma unroll
                for (int n = 0; n < 4; ++n) store_bf16x4(yb + (size_t)tk * 1024 + col0 + n * 16, acc[m][n] * w);
            }
        }
    }
}

__device__ void phase10(const Params& p) {
    const int tid_ = opaque_tid(); const int lane = tid_ & 63, wid = tid_ >> 6;
    const float* h2 = (const float*)(p.ws + OFF_Z2); const bf16_t* yb = (const bf16_t*)(p.ws + OFF_YB);
    for (int row = blockIdx.x * 8 + wid; row < T_; row += gridDim.x * 8) {
        float4 v[4];
#pragma unroll
        for (int i = 0; i < 4; ++i) {
            const float4 hh = *(const float4*)(h2 + (size_t)row * 1024 + i * 256 + lane * 4);
            const uint2 a = *(const uint2*)(yb + (size_t)(row * 2) * 1024 + i * 256 + lane * 4), b = *(const uint2*)(yb + (size_t)(row * 2 + 1) * 1024 + i * 256 + lane * 4);
            v[i].x = ALPHA * hh.x + bf_lo(a.x) + bf_lo(b.x); v[i].y = ALPHA * hh.y + bf_hi(a.x) + bf_hi(b.x);
            v[i].z = ALPHA * hh.z + bf_lo(a.y) + bf_lo(b.y); v[i].w = ALPHA * hh.w + bf_hi(a.y) + bf_hi(b.y);
        }
        ln_row(v, p.ln3g, p.ln3b, lane);
#pragma unroll
        for (int i = 0; i < 4; ++i) *(float4*)(p.out + (size_t)row * 1024 + i * 256 + lane * 4) = v[i];
    }
}

__global__ void __launch_bounds__(NTHR) mega(Params p) {
    extern __shared__ __attribute__((aligned(16))) char smem[];
    cg::grid_group grid = cg::this_grid();
    char* ws = p.ws;
    phase0(p, smem);
    grid.sync();
    phase1(p, smem);
    grid.sync();
    phase2(p, smem);
    grid.sync();
    phase3(p, smem);
    grid.sync();
    phase_gemm_resid(p, smem, (const bf16_t*)(ws + OFF_R1), (const bf16_t*)(ws + OFF_WMIX), p.x, p.out);
    grid.sync();
    phase_ln1(p);
    moe_weight_prep(p, smem);
    grid.sync();
    phase_gemm_bf16(p, smem, (const bf16_t*)(ws + OFF_R0), (const bf16_t*)(ws + OFF_WXQ), (bf16_t*)(ws + OFF_XQ), 0.0625f);
    grid.sync();
    phase6(p, smem);
    grid.sync();
    phase_gemm_resid(p, smem, (const bf16_t*)(ws + OFF_O), (const bf16_t*)(ws + OFF_WXO), p.out, (float*)(ws + OFF_Z2));
    grid.sync();
    phase_ln2_router(p, smem);
    grid.sync();
    phase8(p, smem);
    grid.sync();
    phase9a(p, smem);
    grid.sync();
    phase9b(p, smem);
    grid.sync();
    phase10(p);
}

extern "C" void kernel_launch(void* const* d_in, const int* in_sizes, int n_in, void* d_out, int out_size,
                              void* d_ws, size_t ws_size, hipStream_t stream) {
    static int grid_blocks = 0;
    if (!grid_blocks) {
        int dev = 0, cus = 0, per_cu = 0;
        (void)hipGetDevice(&dev);
        (void)hipDeviceGetAttribute(&cus, hipDeviceAttributeMultiprocessorCount, dev);
        (void)hipFuncSetAttribute((const void*)mega, hipFuncAttributeMaxDynamicSharedMemorySize, LDS_BYTES);
        (void)hipOccupancyMaxActiveBlocksPerMultiprocessor(&per_cu, mega, NTHR, LDS_BYTES);
        if (per_cu > 1) per_cu = 1;
        grid_blocks = cus * per_cu;
        if (ws_size < WS_NEED) fprintf(stderr, "workspace too small: %zu\n", ws_size);
    }
    Params p{};
    const float* const* f = (const float* const*)d_in;
    p.x = f[0]; p.mem = f[1]; p.pos = (const int*)d_in[2];
    p.w_in = f[3]; p.sinks = f[4]; p.conv_w = f[5]; p.conv_b = f[6]; p.b_ig = f[7]; p.b_fg = f[8]; p.ml_g = f[9];
    p.w_att = f[10]; p.w_ml = f[11]; p.w_mix = f[12]; p.ln1g = f[13]; p.ln1b = f[14];
    p.w_xq = f[15]; p.w_xkv = f[16]; p.w_xo = f[17]; p.ln2g = f[18]; p.ln2b = f[19];
    p.w_rg = f[20]; p.b_rg = f[21]; p.w_re = f[22]; p.b_re = f[23]; p.w_gate = f[24]; p.w_up = f[25]; p.w_down = f[26];
    p.ln3g = f[27]; p.ln3b = f[28];
    p.out = (float*)d_out; p.ws = (char*)d_ws;
    void* args[] = {&p};
    hipError_t e = hipLaunchCooperativeKernel((void*)mega, dim3(grid_blocks), dim3(NTHR), args, LDS_BYTES, stream);
    if (e != hipSuccess) fprintf(stderr, "cooperative launch failed: %s (grid %d)\n", hipGetErrorString(e), grid_blocks);
}
```

```cpp
#include <hip/hip_runtime.h>
#include <hip/hip_cooperative_groups.h>
#include <cstdio>
#include <cstdint>
namespace cg = cooperative_groups;

typedef unsigned short bf16_t;
typedef short bf16x8 __attribute__((ext_vector_type(8)));
typedef float f32x4 __attribute__((ext_vector_type(4)));
typedef unsigned u32x2 __attribute__((ext_vector_type(2)));
typedef unsigned u32x4 __attribute__((ext_vector_type(4)));
#define LDS_AS __attribute__((address_space(3)))
#define GLB_AS __attribute__((address_space(1)))

constexpr int T_ = 65536;
constexpr int NTHR = 512;
constexpr size_t MiB = 1ull << 20;
constexpr float ALPHA = 1.189207115002721f;
constexpr size_t OFF_R0 = 0;
constexpr size_t OFF_R1 = 128 * MiB;
constexpr size_t OFF_AK = 256 * MiB;
constexpr size_t OFF_AV = 272 * MiB;
constexpr size_t OFF_MQK = 288 * MiB;
constexpr size_t OFF_MV = 416 * MiB;
constexpr size_t OFF_MO = 544 * MiB;
constexpr size_t OFF_GG = 672 * MiB;
constexpr size_t OFF_WGU = 256 * MiB;
constexpr size_t OFF_WD = 320 * MiB;
constexpr size_t OFF_XQ = 352 * MiB;
constexpr size_t OFF_O = 480 * MiB;
constexpr size_t OFF_Z2 = 608 * MiB;
constexpr size_t OFF_YB = 352 * MiB;
constexpr size_t OFF_MISC = 928 * MiB;
constexpr size_t OFF_WIN = OFF_MISC;
constexpr size_t OFF_WATT = OFF_MISC + 13 * MiB;
constexpr size_t OFF_WML = OFF_MISC + 15 * MiB;
constexpr size_t OFF_WMIX = OFF_MISC + 17 * MiB;
constexpr size_t OFF_WXQ = OFF_MISC + 19 * MiB;
constexpr size_t OFF_WXO = OFF_MISC + 21 * MiB;
constexpr size_t OFF_WXKV = OFF_MISC + 23 * MiB;
constexpr size_t OFF_MEMB = OFF_MISC + 27 * MiB;
constexpr size_t OFF_KMAT = OFF_MISC + 35 * MiB;
constexpr size_t OFF_VT = OFF_MISC + 43 * MiB;
constexpr size_t OFF_GATES = OFF_MISC + 51 * MiB;
constexpr size_t OFF_CS = OFF_MISC + 53 * MiB;
constexpr size_t OFF_TOKE = OFF_MISC + 69 * MiB;
constexpr size_t OFF_TOKW = OFF_MISC + 70 * MiB;
constexpr size_t OFF_SLOTTOK = OFF_MISC + 71 * MiB;
constexpr size_t OFF_SLOTW = OFF_MISC + 72 * MiB;
constexpr size_t OFF_HIST = OFF_MISC + 73 * MiB;
constexpr size_t WS_NEED = 1024 * MiB;
constexpr int LDS_GEMM = 147456;
constexpr int LDS_BYTES = 150528;

struct Params {
    const float *x, *mem; const int* pos;
    const float *w_in, *sinks, *conv_w, *conv_b, *b_ig, *b_fg, *ml_g, *w_att, *w_ml, *w_mix, *ln1g, *ln1b;
    const float *w_xq, *w_xkv, *w_xo, *ln2g, *ln2b, *w_rg, *b_rg, *w_re, *b_re, *w_gate, *w_up, *w_down, *ln3g, *ln3b;
    float* out; char* ws;
};

__device__ const double INV_FREQ[32] = {1.0, 0.7498942093324559, 0.5623413251903491, 0.4216965034285822, 0.31622776601683794, 0.23713737056616552, 0.1778279410038923, 0.1333521432163324, 0.1, 0.07498942093324558, 0.05623413251903491, 0.042169650342858224, 0.03162277660168379, 0.023713737056616554, 0.01778279410038923, 0.01333521432163324, 0.01, 0.007498942093324558, 0.005623413251903491, 0.004216965034285823, 0.0031622776601683794, 0.0023713737056616554, 0.0017782794100389228, 0.001333521432163324, 0.001, 0.0007498942093324559, 0.0005623413251903491, 0.00042169650342858224, 0.00031622776601683794, 0.00023713737056616554, 0.00017782794100389227, 0.0001333521432163324};

__device__ __forceinline__ int opaque_tid() { int t = threadIdx.x; asm volatile("" : "+v"(t)); return t; }
__device__ __forceinline__ unsigned pk_bf16(float lo, float hi) { unsigned r; asm("v_cvt_pk_bf16_f32 %0, %1, %2" : "=v"(r) : "v"(lo), "v"(hi)); return r; }
__device__ __forceinline__ float bf_lo(unsigned u) { return __uint_as_float(u << 16); }
__device__ __forceinline__ float bf_hi(unsigned u) { return __uint_as_float(u & 0xffff0000u); }
__device__ __forceinline__ float bf2f(bf16_t h) { return __uint_as_float(((unsigned)h) << 16); }
__device__ __forceinline__ float wsum(float v) {
#pragma unroll
    for (int o = 32; o; o >>= 1) v += __shfl_xor(v, o);
    return v;
}
__device__ __forceinline__ float wmaxf(float v) {
#pragma unroll
    for (int o = 32; o; o >>= 1) v = fmaxf(v, __shfl_xor(v, o));
    return v;
}
__device__ __forceinline__ float sigmoidf_(float x) { return 1.0f / (1.0f + __expf(-x)); }
__device__ __forceinline__ void glds16(const bf16_t* g, char* l) {
    __builtin_amdgcn_global_load_lds((const GLB_AS void*)g, (LDS_AS void*)l, 16, 0, 0);
}

struct GemmSrc { const bf16_t* a[4]; const bf16_t* b[2]; };

__device__ __forceinline__ void stage_tile(const GemmSrc& s, int koff, char* buf, int tid) {
#pragma unroll
    for (int i = 0; i < 4; ++i) glds16(s.a[i] + koff, buf + (i * 512 + tid) * 16);
#pragma unroll
    for (int i = 0; i < 2; ++i) glds16(s.b[i] + koff, buf + 32768 + (i * 512 + tid) * 16);
}

constexpr int GEMM_STAGE = 49152;
__device__ __forceinline__ void gemm_loop(f32x4 (&acc)[4][4], const GemmSrc& s, int nk, char* smem, int tid) {
    const int lane = tid & 63, wid = tid >> 6, wr = wid >> 1, wc = wid & 1, fr = lane & 15, fq = lane >> 4;
    const int swz = (fr >> 1) & 7;
    const int aoff = (wr * 64 + fr) * 128;
    const int boff = 32768 + (wc * 64 + fr) * 128;
    stage_tile(s, 0, smem, tid);
    if (nk > 1) stage_tile(s, 64, smem + GEMM_STAGE, tid);
    int cur = 0, nxt = 2;
#pragma unroll 1
    for (int t = 0; t < nk; ++t) {
        if (t + 1 < nk) asm volatile("s_waitcnt vmcnt(6)" ::: "memory"); else asm volatile("s_waitcnt vmcnt(0)" ::: "memory");
        __builtin_amdgcn_s_barrier();
        if (t + 2 < nk) stage_tile(s, (t + 2) * 64, smem + nxt * GEMM_STAGE, tid);
        const char* cb = smem + cur * GEMM_STAGE;
#pragma unroll
        for (int ks = 0; ks < 2; ++ks) {
            const int ch = ((ks * 4 + fq) ^ swz) * 16;
            bf16x8 xa[4], wb[4];
#pragma unroll
            for (int m = 0; m < 4; ++m) xa[m] = *(const bf16x8*)(cb + aoff + m * 2048 + ch);
#pragma unroll
            for (int n = 0; n < 4; ++n) wb[n] = *(const bf16x8*)(cb + boff + n * 2048 + ch);
#pragma unroll
            for (int m = 0; m < 4; ++m)
#pragma unroll
                for (int n = 0; n < 4; ++n) acc[m][n] = __builtin_amdgcn_mfma_f32_16x16x32_bf16(wb[n], xa[m], acc[m][n], 0, 0, 0);
        }
        cur = cur == 2 ? 0 : cur + 1; nxt = nxt == 2 ? 0 : nxt + 1;
    }
    __syncthreads();
}

__device__ __forceinline__ void zero_acc(f32x4 (&acc)[4][4]) {
#pragma unroll
    for (int m = 0; m < 4; ++m)
#pragma unroll
        for (int n = 0; n < 4; ++n) acc[m][n] = (f32x4){0.f, 0.f, 0.f, 0.f};
}

__device__ __forceinline__ void make_src(GemmSrc& s, const bf16_t* A, size_t lda, int rowA0, const bf16_t* Bt, size_t ldb, int rowB0, int tid) {
    const int r = tid >> 3, lc = (tid & 7) ^ ((r >> 1) & 7);
#pragma unroll
    for (int i = 0; i < 4; ++i) s.a[i] = A + (size_t)(rowA0 + i * 64 + r) * lda + lc * 8;
#pragma unroll
    for (int i = 0; i < 2; ++i) s.b[i] = Bt + (size_t)(rowB0 + i * 64 + r) * ldb + lc * 8;
}

__device__ __forceinline__ void store_bf16x4(bf16_t* p, f32x4 v) {
    uint2 w; w.x = pk_bf16(v[0], v[1]); w.y = pk_bf16(v[2], v[3]); *(uint2*)p = w;
}

__device__ __forceinline__ void tr_tile(const float* src, size_t ld_src, int k0, int c0, bf16_t* dst, size_t ld_dst, int r0, float* tile, int tid) {
    {
        const int r = tid >> 3, c4 = (tid & 7) * 4;
        const float4 v = *(const float4*)(src + (size_t)(k0 + r) * ld_src + c0 + c4);
        float* tp = tile + r * 33 + c4; tp[0] = v.x; tp[1] = v.y; tp[2] = v.z; tp[3] = v.w;
    }
    __syncthreads();
    {
        const int c = tid >> 4, rc = (tid & 15) * 4;
        const float a0 = tile[(rc + 0) * 33 + c], a1 = tile[(rc + 1) * 33 + c], a2 = tile[(rc + 2) * 33 + c], a3 = tile[(rc + 3) * 33 + c];
        uint2 w; w.x = pk_bf16(a0, a1); w.y = pk_bf16(a2, a3);
        *(uint2*)(dst + (size_t)(r0 + c) * ld_dst + k0 + rc) = w;
    }
    __syncthreads();
}

__device__ void phase0(const Params& p, char* smem) {
    const int tid = opaque_tid(), lane = tid & 63, wid = tid >> 6;
    const int gw = blockIdx.x * 8 + wid, nw = gridDim.x * 8;
    char* ws = p.ws;
    bf16_t* xb = (bf16_t*)(ws + OFF_R0);
    for (int row = gw; row < T_; row += nw) {
        const float4* xr = (const float4*)(p.x + (size_t)row * 1024);
#pragma unroll
        for (int i = 0; i < 4; ++i) {
            const float4 v = xr[i * 64 + lane];
            uint2 w; w.x = pk_bf16(v.x, v.y); w.y = pk_bf16(v.z, v.w);
            *(uint2*)(xb + (size_t)row * 1024 + i * 256 + lane * 4) = w;
        }
    }
    {
        float2* cs = (float2*)(ws + OFF_CS);
        const int gt = blockIdx.x * NTHR + tid, nt = gridDim.x * NTHR;
        for (int idx = gt; idx < T_ * 32; idx += nt) {
            const int tok = idx >> 5, i = idx & 31;
            const double ang = (double)p.pos[tok] * INV_FREQ[i];
            const double turns = ang * 0.15915494309189535;
            const float f = (float)(turns - rint(turns));
            cs[idx] = make_float2(__builtin_amdgcn_cosf(f), __builtin_amdgcn_sinf(f));
        }
        bf16_t* memb = (bf16_t*)(ws + OFF_MEMB);
        for (int idx = gt; idx < 4096 * 1024 / 4; idx += nt) {
            const float4 v = ((const float4*)p.mem)[idx];
            uint2 w; w.x = pk_bf16(v.x, v.y); w.y = pk_bf16(v.z, v.w);
            ((uint2*)memb)[idx] = w;
        }
    }
    {
        float* tile = (float*)smem;
        const int NT_WIN = 16 * 201, NT_SQ = 16 * 32, NT_XKV = 16 * 64;
        const int total = NT_WIN + 5 * NT_SQ + NT_XKV;
        for (int t = blockIdx.x; t < total; t += gridDim.x) {
            if (t < NT_WIN) {
                const int kt = t & 15, nt_ = t >> 4;
                const int n0 = nt_ * 32, c0 = n0 < 4352 ? n0 : (n0 < 6400 ? n0 + 8 : 4352);
                tr_tile(p.w_in, 6408, kt * 64, c0, (bf16_t*)(ws + OFF_WIN), 1024, n0, tile, tid);
            } else if (t < NT_WIN + 5 * NT_SQ) {
                const int u = t - NT_WIN, which = u / NT_SQ, v = u % NT_SQ, kt = v & 15, nt_ = v >> 4;
                const float* src = which == 0 ? p.w_att : which == 1 ? p.w_ml : which == 2 ? p.w_mix : which == 3 ? p.w_xq : p.w_xo;
                bf16_t* dst = (bf16_t*)(ws + OFF_WATT + (size_t)which * 2 * MiB);
                tr_tile(src, 1024, kt * 64, nt_ * 32, dst, 1024, nt_ * 32, tile, tid);
            } else {
                const int v = t - NT_WIN - 5 * NT_SQ, kt = v & 15, nt_ = v >> 4;
                tr_tile(p.w_xkv, 2048, kt * 64, nt_ * 32, (bf16_t*)(ws + OFF_WXKV), 1024, nt_ * 32, tile, tid);
            }
        }
    }
}

__device__ void moe_weight_prep(const Params& p, char* smem) {
    const int tid = opaque_tid();
    float* tile = (float*)smem;
    char* ws = p.ws;
    const int per_e = 384, total = 64 * per_e;
    for (int t = blockIdx.x; t < total; t += gridDim.x) {
        const int e = t / per_e, u = t % per_e;
        if (u < 256) {
            const int isup = u >> 7, v = u & 127, kt = v & 15, j = v >> 4;
            const float* src = (isup ? p.w_up : p.w_gate) + (size_t)e * 1024 * 256;
            tr_tile(src, 256, kt * 64, j * 32, (bf16_t*)(ws + OFF_WGU) + (size_t)e * 512 * 1024, 1024, j * 64 + isup * 32, tile, tid);
        } else {
            const int v = u - 256, kt = v & 3, nt_ = v >> 2;
            tr_tile(p.w_down + (size_t)e * 256 * 1024, 1024, kt * 64, nt_ * 32, (bf16_t*)(ws + OFF_WD) + (size_t)e * 1024 * 256, 256, nt_ * 32, tile, tid);
        }
    }
}

__device__ void phase1(const Params& p, char* smem) {
    const int tid = opaque_tid(), lane = tid & 63, wid = tid >> 6, wr = wid >> 1, wc = wid & 1, fr = lane & 15, fq = lane >> 4;
    char* ws = p.ws;
    const int NMAIN = 256 * 51, NKV = 256;
    for (int t = blockIdx.x; t < NMAIN + NKV; t += gridDim.x) {
        GemmSrc s; int rt, ct; const bool main_ = t < NMAIN; const bool isvt = t >= NMAIN + 128;
        if (main_) { rt = t / 51; ct = t % 51; make_src(s, (const bf16_t*)(ws + OFF_R0), 1024, rt * 256, (const bf16_t*)(ws + OFF_WIN), 1024, ct * 128, tid); }
        else if (!isvt) { const int u = t - NMAIN; rt = u >> 3; ct = u & 7; make_src(s, (const bf16_t*)(ws + OFF_MEMB), 1024, rt * 256, (const bf16_t*)(ws + OFF_WXKV), 1024, ct * 128, tid); }
        else { const int u = t - NMAIN - 128; rt = u >> 5; ct = u & 31; make_src(s, (const bf16_t*)(ws + OFF_WXKV) + (size_t)1024 * 1024, 1024, rt * 256, (const bf16_t*)(ws + OFF_MEMB), 1024, ct * 128, tid); }
        f32x4 acc[4][4]; zero_acc(acc);
        gemm_loop(acc, s, 16, smem, tid);
        const int row0 = rt * 256 + wr * 64 + fr;
        const int c0w = ct * 128 + wc * 64;
        if (main_ && ct == 50) {
            if (wc == 0 && fq < 2) {
                float* gates = (float*)(ws + OFF_GATES);
#pragma unroll
                for (int m = 0; m < 4; ++m) {
                    const f32x4 v = acc[m][0];
                    *(float4*)(gates + (size_t)(row0 + m * 16) * 8 + fq * 4) = make_float4(v[0], v[1], v[2], v[3]);
                }
            }
        } else if (main_ && c0w < 1152) {
            bf16_t* dst; int ld, cb; float sc;
            if (c0w < 1024) { dst = (bf16_t*)(ws + OFF_R1); ld = 1024; cb = c0w; sc = 0.125f; }
            else { dst = (bf16_t*)(ws + OFF_AK); ld = 128; cb = c0w - 1024; sc = 1.0f; }
            const float* cs = (const float*)(ws + OFF_CS);
#pragma unroll
            for (int m = 0; m < 4; ++m) {
                const int tok = row0 + m * 16;
#pragma unroll
                for (int n = 0; n < 2; ++n) {
                    const int d0 = n * 16 + fq * 4;
                    const float4* cp = (const float4*)(cs + (size_t)tok * 64 + d0 * 2);
                    const float4 c01 = cp[0], c23 = cp[1];
                    const f32x4 x1 = acc[m][n], x2 = acc[m][n + 2];
                    f32x4 o1, o2;
                    o1[0] = (x1[0] * c01.x - x2[0] * c01.y) * sc; o2[0] = (x2[0] * c01.x + x1[0] * c01.y) * sc;
                    o1[1] = (x1[1] * c01.z - x2[1] * c01.w) * sc; o2[1] = (x2[1] * c01.z + x1[1] * c01.w) * sc;
                    o1[2] = (x1[2] * c23.x - x2[2] * c23.y) * sc; o2[2] = (x2[2] * c23.x + x1[2] * c23.y) * sc;
                    o1[3] = (x1[3] * c23.z - x2[3] * c23.w) * sc; o2[3] = (x2[3] * c23.z + x1[3] * c23.w) * sc;
                    bf16_t* rp = dst + (size_t)tok * ld + cb + d0;
                    store_bf16x4(rp, o1); store_bf16x4(rp + 32, o2);
                }
            }
        } else {
            bf16_t* dst; int ld, cb; bool sig = false;
            if (!main_) { if (isvt) { dst = (bf16_t*)(ws + OFF_VT); ld = 4096; cb = c0w; } else { dst = (bf16_t*)(ws + OFF_KMAT); ld = 1024; cb = c0w; } }
            else if (c0w < 1280) { dst = nullptr; ld = 0; cb = c0w - 1152; }
            else if (c0w < 2304) { dst = (bf16_t*)(ws + OFF_MQK); ld = 1024; cb = c0w - 1280; }
            else if (c0w < 3328) { dst = (bf16_t*)(ws + OFF_MV); ld = 1024; cb = c0w - 2304; }
            else if (c0w < 4352) { dst = (bf16_t*)(ws + OFF_MO); ld = 1024; cb = c0w - 3328; sig = true; }
            else { dst = (bf16_t*)(ws + OFF_GG); ld = 2048; cb = c0w - 4352; sig = true; }
            if (dst == nullptr) {
                bf16_t* avT = (bf16_t*)(ws + OFF_AV);
#pragma unroll
                for (int m = 0; m < 4; ++m)
#pragma unroll
                    for (int n = 0; n < 4; ++n)
#pragma unroll
                        for (int j = 0; j < 4; ++j)
                            avT[(size_t)(cb + n * 16 + fq * 4 + j) * T_ + row0 + m * 16] = (bf16_t)(pk_bf16(acc[m][n][j], acc[m][n][j]) & 0xffffu);
            } else {
#pragma unroll
            for (int m = 0; m < 4; ++m) {
                bf16_t* rp = dst + (size_t)(row0 + m * 16) * ld + cb + fq * 4;
#pragma unroll
                for (int n = 0; n < 4; ++n) {
                    f32x4 v = acc[m][n];
                    if (sig) { v[0] = sigmoidf_(v[0]); v[1] = sigmoidf_(v[1]); v[2] = sigmoidf_(v[2]); v[3] = sigmoidf_(v[3]); }
                    store_bf16x4(rp + n * 16, v);
                }
            }
            }
        }
    }
}

constexpr int ML_RAW = 0;
constexpr int ML_V0 = 34816;
constexpr int ML_Q = ML_V0 + 65536;
constexpr int ML_K = ML_Q + 16384;
constexpr int ML_SW = ML_K + 20480;
constexpr int ML_F = ML_SW + 8192;
constexpr int ML_END = ML_F + 4096;
typedef short v4i16_t __attribute__((ext_vector_type(4)));
__device__ __forceinline__ int offQK(int row, int ch) { return row * 256 + ((ch ^ (((row & 3) << 2) | ((row >> 2) & 3))) << 4); }
__device__ __forceinline__ int offV(int row, int ch) { return row * 512 + ((ch ^ (((row & 3) | (((row >> 3) & 1) << 2)) << 1)) << 4); }
__device__ __forceinline__ int offSw(int row, int ch) { return row * 128 + ((ch ^ ((row >> 1) & 7)) << 4); }
__device__ __forceinline__ bf16x8 tr_read2(const char* p0, const char* p1) {
    const v4i16_t a = __builtin_amdgcn_ds_read_tr16_b64_v4i16((LDS_AS v4i16_t*)p0);
    const v4i16_t b = __builtin_amdgcn_ds_read_tr16_b64_v4i16((LDS_AS v4i16_t*)p1);
    return __builtin_shufflevector(a, b, 0, 1, 2, 3, 4, 5, 6, 7);
}

__device__ void mlstm_item(const Params& p, char* smem, int item) {
    const int tid = opaque_tid(), lane = tid & 63, wid = tid >> 6, fr0 = lane & 15, fq0 = lane >> 4;
    const int b = item >> 2, h = item & 3;
    char* ws = p.ws;
    const bf16_t* mqk = (const bf16_t*)(ws + OFF_MQK);
    const bf16_t* mv = (const bf16_t*)(ws + OFF_MV);
    const bf16_t* mo = (const bf16_t*)(ws + OFF_MO);
    const float* gates = (const float*)(ws + OFF_GATES);
    bf16_t* hm = (bf16_t*)p.out;
    float* fl = (float*)(smem + ML_F);
    float* den = fl; float* ssq = fl + 64; float* nsum = fl + 192; float* eb = fl + 448; float* ek = fl + 576; float* gg = fl + 704;
    const long tokb = (long)b * 4096;
    f32x4 C[8][2];
#pragma unroll
    for (int dt = 0; dt < 8; ++dt) { C[dt][0] = (f32x4){0.f, 0.f, 0.f, 0.f}; C[dt][1] = (f32x4){0.f, 0.f, 0.f, 0.f}; }
    float nreg = 0.f;
    const int cp0 = tid & 127, tg = tid >> 7; const int cp = cp0;
    const bool isk = cp >= 64;
    const int dch = isk ? 2 * (cp - 64) : 2 * cp;
    const int ccol = isk ? (512 + h * 128 + dch) : (h * 128 + dch);
    float cw0[4], cw1[4];
#pragma unroll
    for (int j = 0; j < 4; ++j) { cw0[j] = p.conv_w[j * 1024 + ccol]; cw1[j] = p.conv_w[j * 1024 + ccol + 1]; }
    const float cb0 = p.conv_b[ccol], cb1 = p.conv_b[ccol + 1];
    const float big = p.b_ig[h], bfg = p.b_fg[h];
    const float gn0 = p.ml_g[h * 256 + wid * 32 + fr0], gn1 = p.ml_g[h * 256 + wid * 32 + 16 + fr0];
    const int vrl = tid >> 5, vpc = tid & 31, vlc = vpc ^ ((((vrl & 3) | (((vrl >> 3) & 1) << 2))) << 1);
    const bf16_t* vsrc = mv + (tokb + vrl) * 1024 + h * 256 + vlc * 8;
    __syncthreads();
    {
        unsigned* kz = (unsigned*)(smem + ML_K + 64 * 256);
        kz[tid] = 0u; kz[tid + 512] = 0u;
        if (tid < 256) nsum[tid] = 0.f;
#pragma unroll
        for (int i = 0; i < 5; ++i) {
            const int j = i * 512 + tid;
            if (j < 2176) {
                const int row = j >> 5, pc = j & 31;
                const bf16_t* src = mqk + (tokb - 3 + row) * 1024 + (pc < 16 ? h * 128 + pc * 8 : 512 + h * 128 + (pc - 16) * 8);
                glds16(src, smem + ML_RAW + j * 16);
            }
        }
#pragma unroll
        for (int i = 0; i < 4; ++i) glds16(vsrc + (long)i * 16 * 1024, smem + ML_V0 + (i * 512 + tid) * 16);
    }
    float gi = 0.f, gf = 0.f;
    if (wid == 7) {
        const float mi0 = gates[(tokb + lane) * 8 + h], mf0 = gates[(tokb + lane) * 8 + 4 + h];
        gi = gates[(tokb + 64 + lane) * 8 + h]; gf = gates[(tokb + 64 + lane) * 8 + 4 + h];
        const float x = mf0 + bfg;
        float bs = fminf(x, 0.f) - log1pf(__expf(-fabsf(x)));
#pragma unroll
        for (int o = 1; o < 64; o <<= 1) { const float y = __shfl_up(bs, o); if (lane >= o) bs += y; }
        eb[lane] = __expf(bs); ek[lane] = __expf(mi0 + big - bs);
        if (lane == 63) gg[0] = __expf(bs);
    }
    asm volatile("s_waitcnt vmcnt(0)" ::: "memory");
    __syncthreads();
#pragma unroll 1
    for (int c = 0; c < 64; ++c) {
        const int par = c & 1;
        const long tok0 = tokb + c * 64;
        int fr = fr0, fq = fq0, cpv = cp0;
        asm volatile("" : "+v"(fr), "+v"(fq), "+v"(cpv));
        if (tid < 64) { den[tid] = 0.f; ssq[par * 64 + tid] = 0.f; }
        {
            const int tt0 = tg * 16;
            const char* rp = smem + ML_RAW + tt0 * 512 + cpv * 4;
            unsigned w0 = *(const unsigned*)(rp), w1 = *(const unsigned*)(rp + 512), w2 = *(const unsigned*)(rp + 1024);
            if (c == 0 && tg == 0) { w0 = 0u; w1 = 0u; w2 = 0u; }
            float cs0 = 0.f, cs1 = 0.f;
            const float* scp = (isk ? ek : eb) + par * 64 + tt0;
            const int dchv = isk ? 2 * (cpv - 64) : 2 * cpv;
            char* dstb = smem + (isk ? ML_K : ML_Q) + (dchv & 7) * 2;
            const float kmul = isk ? 0.08838834764831845f : 1.0f;
#pragma unroll 4
            for (int tt = 0; tt < 16; ++tt) {
                const unsigned w3 = *(const unsigned*)(rp + (tt + 3) * 512);
                float v0 = cb0 + cw0[0] * bf_lo(w0) + cw0[1] * bf_lo(w1) + cw0[2] * bf_lo(w2) + cw0[3] * bf_lo(w3);
                float v1 = cb1 + cw1[0] * bf_hi(w0) + cw1[1] * bf_hi(w1) + cw1[2] * bf_hi(w2) + cw1[3] * bf_hi(w3);
                w0 = w1; w1 = w2; w2 = w3;
                v0 = v0 * sigmoidf_(v0); v1 = v1 * sigmoidf_(v1);
                const float sc = scp[tt] * kmul;
                const float a0 = v0 * sc, a1 = v1 * sc;
                *(unsigned*)(dstb + offQK(tt0 + tt, dchv >> 3)) = pk_bf16(a0, a1);
                cs0 += a0; cs1 += a1;
            }
            if (isk) { atomicAdd(&nsum[par * 128 + dch], cs0); atomicAdd(&nsum[par * 128 + dch + 1], cs1); }
        }
        __syncthreads();
        if (wid == 7 && c + 1 < 64) {
            const float x = gf + bfg;
            float bs = fminf(x, 0.f) - log1pf(__expf(-fabsf(x)));
#pragma unroll
            for (int o = 1; o < 64; o <<= 1) { const float y = __shfl_up(bs, o); if (lane >= o) bs += y; }
            eb[(par ^ 1) * 64 + lane] = __expf(bs); ek[(par ^ 1) * 64 + lane] = __expf(gi + big - bs);
            if (lane == 63) gg[par ^ 1] = __expf(bs);
            if (c + 2 < 64) { gi = gates[(tok0 + 128 + lane) * 8 + h]; gf = gates[(tok0 + 128 + lane) * 8 + 4 + h]; }
        }
        {
            const int tt = wid >> 1;
            bf16x8 qf[4];
#pragma unroll
            for (int ks = 0; ks < 4; ++ks) qf[ks] = *(const bf16x8*)(smem + ML_Q + offQK(tt * 16 + fr, 4 * ks + fq));
#pragma unroll
            for (int x = 0; x < 2; ++x) {
                const int st = (wid & 1) * 2 + x;
                f32x4 a = (f32x4){0.f, 0.f, 0.f, 0.f};
#pragma unroll
                for (int ks = 0; ks < 4; ++ks) {
                    const bf16x8 kf = *(const bf16x8*)(smem + ML_K + offQK(st * 16 + fr, 4 * ks + fq));
                    a = __builtin_amdgcn_mfma_f32_16x16x32_bf16(kf, qf[ks], a, 0, 0, 0);
                }
#pragma unroll
                for (int j = 0; j < 4; ++j) a[j] = (st * 16 + fq * 4 + j) <= (tt * 16 + fr) ? a[j] : 0.f;
                float rs = (a[0] + a[1]) + (a[2] + a[3]);
                rs += __shfl_xor(rs, 16); rs += __shfl_xor(rs, 32);
                if (fq == 0) atomicAdd(&den[tt * 16 + fr], rs);
                uint2 w; w.x = pk_bf16(a[0], a[1]); w.y = pk_bf16(a[2], a[3]);
                *(uint2*)(smem + ML_SW + offSw(tt * 16 + fr, st * 2 + (fq >> 1)) + (fq & 1) * 8) = w;
            }
            if (wid < 4) {
                f32x4 a = (f32x4){0.f, 0.f, 0.f, 0.f};
#pragma unroll
                for (int ks = 0; ks < 4; ++ks) {
                    const bf16x8 kf = *(const bf16x8*)(smem + ML_K + offQK(64 + fr, 4 * ks + fq));
                    const bf16x8 qa = *(const bf16x8*)(smem + ML_Q + offQK(wid * 16 + fr, 4 * ks + fq));
                    a = __builtin_amdgcn_mfma_f32_16x16x32_bf16(kf, qa, a, 0, 0, 0);
                }
                if (fq == 0) atomicAdd(&den[wid * 16 + fr], a[0]);
            }
        }
        f32x4 Y[4][2];
#pragma unroll
        for (int tt = 0; tt < 4; ++tt) { Y[tt][0] = (f32x4){0.f, 0.f, 0.f, 0.f}; Y[tt][1] = (f32x4){0.f, 0.f, 0.f, 0.f}; }
#pragma unroll
        for (int ks = 0; ks < 4; ++ks) {
            u32x4 c0, c1;
            c0[0] = pk_bf16(C[2 * ks][0][0], C[2 * ks][0][1]); c0[1] = pk_bf16(C[2 * ks][0][2], C[2 * ks][0][3]);
            c0[2] = pk_bf16(C[2 * ks + 1][0][0], C[2 * ks + 1][0][1]); c0[3] = pk_bf16(C[2 * ks + 1][0][2], C[2 * ks + 1][0][3]);
            c1[0] = pk_bf16(C[2 * ks][1][0], C[2 * ks][1][1]); c1[1] = pk_bf16(C[2 * ks][1][2], C[2 * ks][1][3]);
            c1[2] = pk_bf16(C[2 * ks + 1][1][0], C[2 * ks + 1][1][1]); c1[3] = pk_bf16(C[2 * ks + 1][1][2], C[2 * ks + 1][1][3]);
            const bf16x8 cf0 = __builtin_bit_cast(bf16x8, c0), cf1 = __builtin_bit_cast(bf16x8, c1);
#pragma unroll
            for (int tt = 0; tt < 4; ++tt) {
                const int row = tt * 16 + fr;
                const u32x2 lo = *(const u32x2*)(smem + ML_Q + offQK(row, 4 * ks + (fq >> 1)) + (fq & 1) * 8);
                const u32x2 hi = *(const u32x2*)(smem + ML_Q + offQK(row, 4 * ks + 2 + (fq >> 1)) + (fq & 1) * 8);
                u32x4 av; av[0] = lo[0]; av[1] = lo[1]; av[2] = hi[0]; av[3] = hi[1];
                const bf16x8 af = __builtin_bit_cast(bf16x8, av);
                Y[tt][0] = __builtin_amdgcn_mfma_f32_16x16x32_bf16(af, cf0, Y[tt][0], 0, 0, 0);
                Y[tt][1] = __builtin_amdgcn_mfma_f32_16x16x32_bf16(af, cf1, Y[tt][1], 0, 0, 0);
            }
        }
        __syncthreads();
        if (c + 1 < 64) {
#pragma unroll
            for (int i = 0; i < 5; ++i) {
                const int j = i * 512 + tid;
                if (j < 2176) {
                    const int row = j >> 5, pc = j & 31;
                    const bf16_t* src = mqk + (tok0 + 64 - 3 + row) * 1024 + (pc < 16 ? h * 128 + pc * 8 : 512 + h * 128 + (pc - 16) * 8);
                    glds16(src, smem + ML_RAW + j * 16);
                }
            }
#pragma unroll
            for (int i = 0; i < 4; ++i) glds16(vsrc + (long)(c + 1) * 64 * 1024 + (long)i * 16 * 1024, smem + ML_V0 + (par ^ 1) * 32768 + (i * 512 + tid) * 16);
        }
        unsigned mop[4][4];
#pragma unroll
        for (int tt = 0; tt < 4; ++tt)
#pragma unroll
            for (int j = 0; j < 4; ++j) {
                const bf16_t* mp = mo + (tok0 + tt * 16 + fq * 4 + j) * 1024 + h * 256 + wid * 32 + fr;
                mop[tt][j] = (unsigned)mp[0] | ((unsigned)mp[16] << 16);
            }
        const char* vb = smem + ML_V0 + par * 32768;
        bf16x8 vf[2][2];
#pragma unroll
        for (int ks = 0; ks < 2; ++ks)
#pragma unroll
            for (int et = 0; et < 2; ++et) {
                const int cidx = 2 * wid + et, ch = 2 * cidx + ((fr & 3) >> 1);
                const int r0 = 32 * ks + 8 * fq + (fr >> 2);
                vf[ks][et] = tr_read2(vb + offV(r0, ch) + 8 * (fr & 1), vb + offV(r0 + 4, ch) + 8 * (fr & 1));
            }
#pragma unroll
        for (int ks = 0; ks < 2; ++ks)
#pragma unroll
            for (int tt = 0; tt < 4; ++tt) {
                const bf16x8 sf = *(const bf16x8*)(smem + ML_SW + offSw(tt * 16 + fr, 4 * ks + fq));
                Y[tt][0] = __builtin_amdgcn_mfma_f32_16x16x32_bf16(sf, vf[ks][0], Y[tt][0], 0, 0, 0);
                Y[tt][1] = __builtin_amdgcn_mfma_f32_16x16x32_bf16(sf, vf[ks][1], Y[tt][1], 0, 0, 0);
            }
#pragma unroll
        for (int tt = 0; tt < 4; ++tt) {
            const float4 dv = *(const float4*)(den + tt * 16 + fq * 4);
            const float dd[4] = {dv.x, dv.y, dv.z, dv.w};
#pragma unroll
            for (int j = 0; j < 4; ++j) {
                const float inv = 1.0f / fmaxf(fabsf(dd[j]), 1.0f);
                Y[tt][0][j] *= inv; Y[tt][1][j] *= inv;
                float sq = Y[tt][0][j] * Y[tt][0][j] + Y[tt][1][j] * Y[tt][1][j];
                sq += __shfl_xor(sq, 1); sq += __shfl_xor(sq, 2); sq += __shfl_xor(sq, 4); sq += __shfl_xor(sq, 8);
                if (fr == 0) atomicAdd(&ssq[par * 64 + tt * 16 + fq * 4 + j], sq);
            }
        }
#pragma unroll
        for (int dt = 0; dt < 8; ++dt)
#pragma unroll
            for (int ks = 0; ks < 2; ++ks) {
                const int ch = 2 * dt + ((fr & 3) >> 1);
                const int r0 = 32 * ks + 8 * fq + (fr >> 2);
                const bf16x8 kf = tr_read2(smem + ML_K + offQK(r0, ch) + 8 * (fr & 1), smem + ML_K + offQK(r0 + 4, ch) + 8 * (fr & 1));
                C[dt][0] = __builtin_amdgcn_mfma_f32_16x16x32_bf16(kf, vf[ks][0], C[dt][0], 0, 0, 0);
                C[dt][1] = __builtin_amdgcn_mfma_f32_16x16x32_bf16(kf, vf[ks][1], C[dt][1], 0, 0, 0);
                if (ks == 1 && (dt & 1)) __builtin_amdgcn_sched_barrier(0);
            }
        const float g = gg[par];
#pragma unroll
        for (int dt = 0; dt < 8; ++dt) { C[dt][0] *= g; C[dt][1] *= g; }
        asm volatile("s_waitcnt vmcnt(0)" ::: "memory");
        __syncthreads();
#pragma unroll
        for (int tt = 0; tt < 4; ++tt) {
            const float4 sv = *(const float4*)(ssq + par * 64 + tt * 16 + fq * 4);
            const float ss[4] = {sv.x, sv.y, sv.z, sv.w};
#pragma unroll
            for (int j = 0; j < 4; ++j) {
                const float rstd = rsqrtf(ss[j] * (1.0f / 256.0f) + 1e-6f);
                bf16_t* hp = hm + (tok0 + tt * 16 + fq * 4 + j) * 1024 + h * 256 + wid * 32 + fr;
                const float o0 = Y[tt][0][j] * rstd * gn0 * bf_lo(mop[tt][j]);
                const float o1 = Y[tt][1][j] * rstd * gn1 * bf_hi(mop[tt][j]);
                hp[0] = (bf16_t)(pk_bf16(o0, o0) & 0xffffu); hp[16] = (bf16_t)(pk_bf16(o1, o1) & 0xffffu);
            }
        }
        if (tid < 128) {
            nreg = g * (nreg + nsum[par * 128 + tid]);
            nsum[par * 128 + tid] = 0.f;
            *(bf16_t*)(smem + ML_K + offQK(64, tid >> 3) + (tid & 7) * 2) = (bf16_t)(pk_bf16(nreg, nreg) & 0xffffu);
        }
    }
    __syncthreads();
}

__device__ void swa_items(const Params& p, char* smem, int first, int stride) {
    const int tid = opaque_tid(), lane = tid & 63, wid = tid >> 6, fr = lane & 15, fq = lane >> 4;
    char* ws = p.ws;
    const bf16_t* aq = (const bf16_t*)(ws + OFF_R1);
    const bf16_t* ak = (const bf16_t*)(ws + OFF_AK);
    const bf16_t* avT = (const bf16_t*)(ws + OFF_AV);
    bf16_t* ao = (bf16_t*)(ws + OFF_R0);
    char* kbuf = smem; char* vbuf = smem + 32768;
    for (int item = first; item < 1024; item += stride) {
        const int kvh = item & 1, n = (item >> 1) & 31, b = item >> 6;
        const int hq = kvh * 8 + wid;
        const long tokbase = (long)b * 4096 + n * 128 - 128;
        {
            const int rk = tid >> 3, pck = tid & 7, lck = pck ^ ((rk >> 1) & 7);
            const bf16_t* srck = ak + (tokbase + rk) * 128 + kvh * 64 + lck * 8;
#pragma unroll
            for (int i = 0; i < 4; ++i) glds16(srck + (long)i * 64 * 128, kbuf + (i * 512 + tid) * 16);
            const int rv = tid >> 5, pcv = tid & 31, lcv = pcv ^ (rv & 15);
            const bf16_t* srcv = avT + (long)(kvh * 64 + rv) * T_ + tokbase + lcv * 8;
#pragma unroll
            for (int i = 0; i < 4; ++i) glds16(srcv + (long)i * 16 * T_, vbuf + (i * 512 + tid) * 16);
        }
        const float sink = p.sinks[hq];
        asm volatile("s_waitcnt vmcnt(0)" ::: "memory");
        __syncthreads();
        const int kswz = (fr >> 1) & 7;
#pragma unroll 1
        for (int u = 0; u < 4; ++u) {
            const long tq = (long)b * 4096 + n * 128 + u * 32 + fr;
            const bf16_t* qp = aq + tq * 1024 + hq * 64 + fq * 8;
            const bf16x8 q00 = *(const bf16x8*)(qp), q01 = *(const bf16x8*)(qp + 32);
            const bf16x8 q10 = *(const bf16x8*)(qp + 16 * 1024), q11 = *(const bf16x8*)(qp + 16 * 1024 + 32);
            f32x4 sc[10][2];
#pragma unroll
            for (int r = 0; r < 10; ++r) {
                sc[r][0] = (f32x4){0.f, 0.f, 0.f, 0.f}; sc[r][1] = (f32x4){0.f, 0.f, 0.f, 0.f};
                if (!(n == 0 && (2 * u + r) < 8)) {
                    const char* rowp = kbuf + ((2 * u + r) * 16 + fr) * 128;
                    const bf16x8 k0 = *(const bf16x8*)(rowp + ((fq ^ kswz) * 16)), k1 = *(const bf16x8*)(rowp + (((4 + fq) ^ kswz) * 16));
                    sc[r][0] = __builtin_amdgcn_mfma_f32_16x16x32_bf16(k0, q00, sc[r][0], 0, 0, 0);
                    sc[r][0] = __builtin_amdgcn_mfma_f32_16x16x32_bf16(k1, q01, sc[r][0], 0, 0, 0);
                    sc[r][1] = __builtin_amdgcn_mfma_f32_16x16x32_bf16(k0, q10, sc[r][1], 0, 0, 0);
                    sc[r][1] = __builtin_amdgcn_mfma_f32_16x16x32_bf16(k1, q11, sc[r][1], 0, 0, 0);
                }
            }
            u32x4 pf[2][5]; float linv[2];
#pragma unroll
            for (int nt = 0; nt < 2; ++nt) {
                float m = sink;
#pragma unroll
                for (int r = 0; r < 10; ++r) {
                    const bool tile_ok = !(n == 0 && (2 * u + r) < 8);
#pragma unroll
                    for (int j = 0; j < 4; ++j) {
                        const int delta = (r - nt) * 16 + fq * 4 + j - fr;
                        const bool ok = tile_ok && delta >= 1 && delta <= 128;
                        sc[r][nt][j] = ok ? sc[r][nt][j] : -INFINITY;
                        m = fmaxf(m, sc[r][nt][j]);
                    }
                }
                m = fmaxf(m, __shfl_xor(m, 16)); m = fmaxf(m, __shfl_xor(m, 32));
                float l = 0.f;
#pragma unroll
                for (int s2 = 0; s2 < 5; ++s2) {
                    float e[8];
#pragma unroll
                    for (int j = 0; j < 4; ++j) { e[j] = __expf(sc[2 * s2][nt][j] - m); e[4 + j] = __expf(sc[2 * s2 + 1][nt][j] - m); }
                    l += ((e[0] + e[1]) + (e[2] + e[3])) + ((e[4] + e[5]) + (e[6] + e[7]));
                    u32x4 w; w[0] = pk_bf16(e[0], e[1]); w[1] = pk_bf16(e[2], e[3]); w[2] = pk_bf16(e[4], e[5]); w[3] = pk_bf16(e[6], e[7]);
                    pf[nt][s2] = w;
                }
                l += __shfl_xor(l, 16); l += __shfl_xor(l, 32);
                linv[nt] = 1.0f / (l + __expf(sink - m));
            }
            f32x4 o[4][2];
#pragma unroll
            for (int dt = 0; dt < 4; ++dt) { o[dt][0] = (f32x4){0.f, 0.f, 0.f, 0.f}; o[dt][1] = (f32x4){0.f, 0.f, 0.f, 0.f}; }
#pragma unroll
            for (int s2 = 0; s2 < 5; ++s2) {
                if (!(n == 0 && (2 * u + 2 * s2) < 8)) {
                    const int ca = ((((2 * u + 2 * s2) * 2 + (fq >> 1)) ^ fr) * 16) + (fq & 1) * 8;
                    const int cb = ((((2 * u + 2 * s2 + 1) * 2 + (fq >> 1)) ^ fr) * 16) + (fq & 1) * 8;
                    const bf16x8 p0 = __builtin_bit_cast(bf16x8, pf[0][s2]), p1 = __builtin_bit_cast(bf16x8, pf[1][s2]);
#pragma unroll
                    for (int dt = 0; dt < 4; ++dt) {
                        const char* rowp = vbuf + (dt * 16 + fr) * 512;
                        const u32x2 va = *(const u32x2*)(rowp + ca), vb = *(const u32x2*)(rowp + cb);
                        u32x4 vv; vv[0] = va[0]; vv[1] = va[1]; vv[2] = vb[0]; vv[3] = vb[1];
                        const bf16x8 vf = __builtin_bit_cast(bf16x8, vv);
                        o[dt][0] = __builtin_amdgcn_mfma_f32_16x16x32_bf16(vf, p0, o[dt][0], 0, 0, 0);
                        o[dt][1] = __builtin_amdgcn_mfma_f32_16x16x32_bf16(vf, p1, o[dt][1], 0, 0, 0);
                    }
                }
            }
#pragma unroll
            for (int nt = 0; nt < 2; ++nt) {
                bf16_t* rp = ao + (size_t)(tq + nt * 16) * 1024 + hq * 64 + fq * 4;
#pragma unroll
                for (int dt = 0; dt < 4; ++dt) store_bf16x4(rp + dt * 16, o[dt][nt] * linv[nt]);
            }
        }
        __syncthreads();
    }
}

__device__ void phase2(const Params& p, char* smem, int which = 3) {
    const int G = gridDim.x;
    if (G > 64) {
        if (blockIdx.x < 64) { if (which & 1) mlstm_item(p, smem, blockIdx.x); }
        else { if (which & 2) swa_items(p, smem, blockIdx.x - 64, G - 64); }
    } else {
        for (int it = blockIdx.x; it < 64; it += G) mlstm_item(p, smem, it);
        swa_items(p, smem, blockIdx.x, G);
    }
}

__device__ void phase3(const Params& p, char* smem) {
    const int tid = opaque_tid(), lane = tid & 63, wid = tid >> 6, wr = wid >> 1, wc = wid & 1, fr = lane & 15, fq = lane >> 4;
    char* ws = p.ws;
    const bf16_t* gg = (const bf16_t*)(ws + OFF_GG);
    bf16_t* y = (bf16_t*)(ws + OFF_R1);
    for (int t = blockIdx.x; t < 256 * 8; t += gridDim.x) {
        const int rt = t >> 3, ct = t & 7;
        GemmSrc s;
        f32x4 acca[4][4], accm[4][4]; zero_acc(acca); zero_acc(accm);
        make_src(s, (const bf16_t*)(ws + OFF_R0), 1024, rt * 256, (const bf16_t*)(ws + OFF_WATT), 1024, ct * 128, tid);
        gemm_loop(acca, s, 16, smem, tid);
        make_src(s, (const bf16_t*)p.out, 1024, rt * 256, (const bf16_t*)(ws + OFF_WML), 1024, ct * 128, tid);
        gemm_loop(accm, s, 16, smem, tid);
        const int row0 = rt * 256 + wr * 64 + fr, col0 = ct * 128 + wc * 64 + fq * 4;
#pragma unroll
        for (int m = 0; m < 4; ++m) {
            const size_t tok = row0 + m * 16;
#pragma unroll
            for (int n = 0; n < 4; ++n) {
                const int col = col0 + n * 16;
                const uint2 ga = *(const uint2*)(gg + tok * 2048 + col), gm = *(const uint2*)(gg + tok * 2048 + 1024 + col);
                f32x4 v;
                v[0] = bf_lo(ga.x) * acca[m][n][0] + bf_lo(gm.x) * accm[m][n][0];
                v[1] = bf_hi(ga.x) * acca[m][n][1] + bf_hi(gm.x) * accm[m][n][1];
                v[2] = bf_lo(ga.y) * acca[m][n][2] + bf_lo(gm.y) * accm[m][n][2];
                v[3] = bf_hi(ga.y) * acca[m][n][3] + bf_hi(gm.y) * accm[m][n][3];
                store_bf16x4(y + tok * 1024 + col, v);
            }
        }
    }
}

__device__ void phase_gemm_resid(const Params& p, char* smem, const bf16_t* A, const bf16_t* Bt, const float* resid, float* outz) {
    const int tid = opaque_tid(), lane = tid & 63, wid = tid >> 6, wr = wid >> 1, wc = wid & 1, fr = lane & 15, fq = lane >> 4;
    for (int t = blockIdx.x; t < 256 * 8; t += gridDim.x) {
        const int rt = t >> 3, ct = t & 7;
        GemmSrc s; f32x4 acc[4][4]; zero_acc(acc);
        make_src(s, A, 1024, rt * 256, Bt, 1024, ct * 128, tid);
        gemm_loop(acc, s, 16, smem, tid);
        const int row0 = rt * 256 + wr * 64 + fr, col0 = ct * 128 + wc * 64 + fq * 4;
#pragma unroll
        for (int m = 0; m < 4; ++m) {
            const size_t tok = row0 + m * 16;
#pragma unroll
            for (int n = 0; n < 4; ++n) {
                const int col = col0 + n * 16;
                const float4 r = *(const float4*)(resid + tok * 1024 + col);
                float4 o; o.x = ALPHA * r.x + acc[m][n][0]; o.y = ALPHA * r.y + acc[m][n][1]; o.z = ALPHA * r.z + acc[m][n][2]; o.w = ALPHA * r.w + acc[m][n][3];
                *(float4*)(outz + tok * 1024 + col) = o;
            }
        }
    }
}

__device__ void phase_gemm_bf16(const Params& p, char* smem, const bf16_t* A, const bf16_t* Bt, bf16_t* outb, float scale) {
    const int tid = opaque_tid(), lane = tid & 63, wid = tid >> 6, wr = wid >> 1, wc = wid & 1, fr = lane & 15, fq = lane >> 4;
    for (int t = blockIdx.x; t < 256 * 8; t += gridDim.x) {
        const int rt = t >> 3, ct = t & 7;
        GemmSrc s; f32x4 acc[4][4]; zero_acc(acc);
        make_src(s, A, 1024, rt * 256, Bt, 1024, ct * 128, tid);
        gemm_loop(acc, s, 16, smem, tid);
        const int row0 = rt * 256 + wr * 64 + fr, col0 = ct * 128 + wc * 64 + fq * 4;
#pragma unroll
        for (int m = 0; m < 4; ++m) {
            const size_t tok = row0 + m * 16;
#pragma unroll
            for (int n = 0; n < 4; ++n) store_bf16x4(outb + tok * 1024 + col0 + n * 16, acc[m][n] * scale);
        }
    }
}

__device__ __forceinline__ void ln_row(float4 (&v)[4], const float* g, const float* bta, int lane) {
    float s = 0.f;
#pragma unroll
    for (int i = 0; i < 4; ++i) s += (v[i].x + v[i].y) + (v[i].z + v[i].w);
    const float mu = wsum(s) * (1.0f / 1024.0f);
    float q = 0.f;
#pragma unroll
    for (int i = 0; i < 4; ++i) { const float a = v[i].x - mu, b = v[i].y - mu, c = v[i].z - mu, d = v[i].w - mu; q += (a * a + b * b) + (c * c + d * d); }
    const float rstd = rsqrtf(wsum(q) * (1.0f / 1024.0f) + 1e-5f);
#pragma unroll
    for (int i = 0; i < 4; ++i) {
        const float4 gg = *(const float4*)(g + i * 256 + lane * 4), bb = *(const float4*)(bta + i * 256 + lane * 4);
        v[i].x = (v[i].x - mu) * rstd * gg.x + bb.x; v[i].y = (v[i].y - mu) * rstd * gg.y + bb.y;
        v[i].z = (v[i].z - mu) * rstd * gg.z + bb.z; v[i].w = (v[i].w - mu) * rstd * gg.w + bb.w;
    }
}

__device__ void phase_ln1(const Params& p) {
    const int tid_ = opaque_tid(); const int lane = tid_ & 63, wid = tid_ >> 6;
    float* z = p.out; bf16_t* hb = (bf16_t*)(p.ws + OFF_R0);
    for (int row = blockIdx.x * 8 + wid; row < T_; row += gridDim.x * 8) {
        float4 v[4];
#pragma unroll
        for (int i = 0; i < 4; ++i) v[i] = *(const float4*)(z + (size_t)row * 1024 + i * 256 + lane * 4);
        ln_row(v, p.ln1g, p.ln1b, lane);
#pragma unroll
        for (int i = 0; i < 4; ++i) {
            *(float4*)(z + (size_t)row * 1024 + i * 256 + lane * 4) = v[i];
            uint2 w; w.x = pk_bf16(v[i].x, v[i].y); w.y = pk_bf16(v[i].z, v[i].w);
            *(uint2*)(hb + (size_t)row * 1024 + i * 256 + lane * 4) = w;
        }
    }
}

__device__ __forceinline__ void xa_stage_k(const bf16_t* kmat, int b, int h, int kh, char* buf, int tid) {
    const int rl = tid >> 5, pc = tid & 31, lc = pc ^ (rl & 15);
    const bf16_t* src = kmat + (size_t)(b * 256 + kh * 128 + rl) * 1024 + h * 256 + lc * 8;
#pragma unroll
    for (int i = 0; i < 8; ++i) glds16(src + (size_t)i * 16 * 1024, buf + (i * 512 + tid) * 16);
}
__device__ __forceinline__ void xa_stage_v(const bf16_t* vT, int b, int h, int vh, char* buf, int tid) {
    const int rl = tid >> 4, pc = tid & 15, lc = pc ^ (rl & 15);
    const bf16_t* src = vT + (size_t)(h * 256 + rl) * 4096 + b * 256 + vh * 128 + lc * 8;
#pragma unroll
    for (int i = 0; i < 8; ++i) glds16(src + (size_t)i * 32 * 4096, buf + (i * 512 + tid) * 16);
}

template <int KH>
__device__ __forceinline__ void xa_scores(f32x4 (&acc)[16][2], const char* buf, const bf16_t* q0p, const bf16_t* q1p, int fr, int fq) {
#pragma unroll 2
    for (int ks = 0; ks < 8; ++ks) {
        const bf16x8 q0 = *(const bf16x8*)(q0p + ks * 32), q1 = *(const bf16x8*)(q1p + ks * 32);
        const int ch = ((ks * 4 + fq) ^ fr) * 16;
#pragma unroll
        for (int mt = 0; mt < 8; ++mt) {
            const bf16x8 kf = *(const bf16x8*)(buf + (mt * 16 + fr) * 512 + ch);
            acc[KH * 8 + mt][0] = __builtin_amdgcn_mfma_f32_16x16x32_bf16(kf, q0, acc[KH * 8 + mt][0], 0, 0, 0);
            acc[KH * 8 + mt][1] = __builtin_amdgcn_mfma_f32_16x16x32_bf16(kf, q1, acc[KH * 8 + mt][1], 0, 0, 0);
        }
    }
}


template <int VH, int DH>
__device__ __forceinline__ void xa_pv(f32x4 (&o)[8][2], const u32x4 (&pf)[2][8], const char* buf, int fr, int fq) {
#pragma unroll
    for (int ks = 0; ks < 4; ++ks) {
        const int ca = ((ks * 4 + (fq >> 1)) ^ fr) * 16 + (fq & 1) * 8, cb = ((ks * 4 + 2 + (fq >> 1)) ^ fr) * 16 + (fq & 1) * 8;
        const bf16x8 p0 = __builtin_bit_cast(bf16x8, pf[0][VH * 4 + ks]), p1 = __builtin_bit_cast(bf16x8, pf[1][VH * 4 + ks]);
#pragma unroll
        for (int dt = 0; dt < 8; ++dt) {
            const char* rowp = buf + ((DH * 8 + dt) * 16 + fr) * 256;
            const u32x2 va = *(const u32x2*)(rowp + ca), vb = *(const u32x2*)(rowp + cb);
            u32x4 vv; vv[0] = va[0]; vv[1] = va[1]; vv[2] = vb[0]; vv[3] = vb[1];
            const bf16x8 vf = __builtin_bit_cast(bf16x8, vv);
            o[dt][0] = __builtin_amdgcn_mfma_f32_16x16x32_bf16(vf, p0, o[dt][0], 0, 0, 0);
            o[dt][1] = __builtin_amdgcn_mfma_f32_16x16x32_bf16(vf, p1, o[dt][1], 0, 0, 0);
        }
    }
}

__device__ void phase6(const Params& p, char* smem) {
    const int tid = opaque_tid(), lane = tid & 63, wid = tid >> 6, fr = lane & 15, fq = lane >> 4;
    char* ws = p.ws;
    const bf16_t* xq = (const bf16_t*)(ws + OFF_XQ);
    const bf16_t* kmat = (const bf16_t*)(ws + OFF_KMAT);
    const bf16_t* vT = (const bf16_t*)(ws + OFF_VT);
    bf16_t* og = (bf16_t*)(ws + OFF_O);
    char* bufA = smem; char* bufB = smem + 65536;
    const int G = gridDim.x;
    for (int idx = blockIdx.x; idx < 1024; idx += G) {
        int pair, qt;
        if (G == 256) { const int i = idx >> 8, blk = idx & 255, xcd = blk & 7, jj = blk >> 3; pair = (i * 8 + xcd) * 2 + (jj >> 4); qt = jj & 15; }
        else { pair = idx >> 4; qt = idx & 15; }
        const int b = pair >> 2, h = pair & 3;
        const int tok0 = b * 4096 + qt * 256 + wid * 32;
        xa_stage_k(kmat, b, h, 0, bufA, tid);
        xa_stage_k(kmat, b, h, 1, bufB, tid);
        const bf16_t* q0p = xq + (size_t)(tok0 + fr) * 1024 + h * 256 + fq * 8;
        const bf16_t* q1p = q0p + (size_t)16 * 1024;
        f32x4 acc[16][2];
#pragma unroll
        for (int mt = 0; mt < 16; ++mt) { acc[mt][0] = (f32x4){0.f, 0.f, 0.f, 0.f}; acc[mt][1] = (f32x4){0.f, 0.f, 0.f, 0.f}; }
        asm volatile("s_waitcnt vmcnt(0)" ::: "memory");
        __syncthreads();
        xa_scores<0>(acc, bufA, q0p, q1p, fr, fq);
        xa_scores<1>(acc, bufB, q0p, q1p, fr, fq);
        __syncthreads();
        xa_stage_v(vT, b, h, 0, bufA, tid);
        xa_stage_v(vT, b, h, 1, bufB, tid);
        u32x4 pf[2][8]; float linv[2];
#pragma unroll
        for (int nt = 0; nt < 2; ++nt) {
            float m = -INFINITY;
#pragma unroll
            for (int mt = 0; mt < 16; ++mt) m = fmaxf(m, fmaxf(fmaxf(acc[mt][nt][0], acc[mt][nt][1]), fmaxf(acc[mt][nt][2], acc[mt][nt][3])));
            m = fmaxf(m, __shfl_xor(m, 16)); m = fmaxf(m, __shfl_xor(m, 32));
            float l = 0.f;
#pragma unroll
            for (int s2 = 0; s2 < 8; ++s2) {
                float e[8];
#pragma unroll
                for (int j = 0; j < 4; ++j) { e[j] = __expf(acc[2 * s2][nt][j] - m); e[4 + j] = __expf(acc[2 * s2 + 1][nt][j] - m); }
                l += ((e[0] + e[1]) + (e[2] + e[3])) + ((e[4] + e[5]) + (e[6] + e[7]));
                u32x4 w; w[0] = pk_bf16(e[0], e[1]); w[1] = pk_bf16(e[2], e[3]); w[2] = pk_bf16(e[4], e[5]); w[3] = pk_bf16(e[6], e[7]);
                pf[nt][s2] = w;
            }
            l += __shfl_xor(l, 16); l += __shfl_xor(l, 32);
            linv[nt] = 1.0f / l;
        }
        asm volatile("s_waitcnt vmcnt(0)" ::: "memory");
        __syncthreads();
        {
            f32x4 o[8][2];
#pragma unroll
            for (int dt = 0; dt < 8; ++dt) { o[dt][0] = (f32x4){0.f, 0.f, 0.f, 0.f}; o[dt][1] = (f32x4){0.f, 0.f, 0.f, 0.f}; }
            xa_pv<0, 0>(o, pf, bufA, fr, fq);
            xa_pv<1, 0>(o, pf, bufB, fr, fq);
#pragma unroll
            for (int nt = 0; nt < 2; ++nt) {
                bf16_t* rp = og + (size_t)(tok0 + nt * 16 + fr) * 1024 + h * 256 + fq * 4;
#pragma unroll
                for (int dt = 0; dt < 8; ++dt) store_bf16x4(rp + dt * 16, o[dt][nt] * linv[nt]);
            }
        }
        {
            f32x4 o[8][2];
#pragma unroll
            for (int dt = 0; dt < 8; ++dt) { o[dt][0] = (f32x4){0.f, 0.f, 0.f, 0.f}; o[dt][1] = (f32x4){0.f, 0.f, 0.f, 0.f}; }
            xa_pv<0, 1>(o, pf, bufA, fr, fq);
            xa_pv<1, 1>(o, pf, bufB, fr, fq);
#pragma unroll
            for (int nt = 0; nt < 2; ++nt) {
                bf16_t* rp = og + (size_t)(tok0 + nt * 16 + fr) * 1024 + h * 256 + 128 + fq * 4;
#pragma unroll
                for (int dt = 0; dt < 8; ++dt) store_bf16x4(rp + dt * 16, o[dt][nt] * linv[nt]);
            }
        }
        __syncthreads();
    }
}

__device__ void phase_ln2_router(const Params& p, char* smem) {
    const int tid = opaque_tid(), lane = tid & 63, wid = tid >> 6;
    char* ws = p.ws;
    float* z = (float*)(ws + OFF_Z2); bf16_t* hb = (bf16_t*)(ws + OFF_R0);
    int2* toke = (int2*)(ws + OFF_TOKE); float2* tokw = (float2*)(ws + OFF_TOKW);
    int* histg = (int*)(ws + OFF_HIST);
    int* hist = (int*)smem;
    for (int c = blockIdx.x; c < 256; c += gridDim.x) {
        if (tid < 64) hist[tid] = 0;
        __syncthreads();
        for (int rr = 0; rr < 32; ++rr) {
            const int row = c * 256 + wid * 32 + rr;
            float4 v[4];
#pragma unroll
            for (int i = 0; i < 4; ++i) v[i] = *(const float4*)(z + (size_t)row * 1024 + i * 256 + lane * 4);
            ln_row(v, p.ln2g, p.ln2b, lane);
#pragma unroll
            for (int i = 0; i < 4; ++i) {
                *(float4*)(z + (size_t)row * 1024 + i * 256 + lane * 4) = v[i];
                uint2 w; w.x = pk_bf16(v[i].x, v[i].y); w.y = pk_bf16(v[i].z, v[i].w);
                *(uint2*)(hb + (size_t)row * 1024 + i * 256 + lane * 4) = w;
            }
            float g[8];
#pragma unroll
            for (int k = 0; k < 8; ++k) g[k] = 0.f;
#pragma unroll
            for (int i = 0; i < 4; ++i) {
                const float vv[4] = {v[i].x, v[i].y, v[i].z, v[i].w};
#pragma unroll
                for (int jj = 0; jj < 4; ++jj) {
                    const float4* wp = (const float4*)(p.w_rg + (size_t)(i * 256 + lane * 4 + jj) * 8);
                    const float4 w0 = wp[0], w1 = wp[1];
                    g[0] += vv[jj] * w0.x; g[1] += vv[jj] * w0.y; g[2] += vv[jj] * w0.z; g[3] += vv[jj] * w0.w;
                    g[4] += vv[jj] * w1.x; g[5] += vv[jj] * w1.y; g[6] += vv[jj] * w1.z; g[7] += vv[jj] * w1.w;
                }
            }
            float gmax = -INFINITY; int gsel = 0;
#pragma unroll
            for (int k = 0; k < 8; ++k) { g[k] = wsum(g[k]) + p.b_rg[k]; if (g[k] > gmax) { gmax = g[k]; gsel = k; } }
            float gs = 0.f;
#pragma unroll
            for (int k = 0; k < 8; ++k) gs += __expf(g[k] - gmax);
            const float pgroup = 1.0f / gs;
            gsel = __builtin_amdgcn_readfirstlane(gsel);
            float ex[8];
#pragma unroll
            for (int k = 0; k < 8; ++k) ex[k] = 0.f;
#pragma unroll
            for (int i = 0; i < 4; ++i) {
                const float vv[4] = {v[i].x, v[i].y, v[i].z, v[i].w};
#pragma unroll
                for (int jj = 0; jj < 4; ++jj) {
                    const float4* wp = (const float4*)(p.w_re + (size_t)(i * 256 + lane * 4 + jj) * 64 + gsel * 8);
                    const float4 w0 = wp[0], w1 = wp[1];
                    ex[0] += vv[jj] * w0.x; ex[1] += vv[jj] * w0.y; ex[2] += vv[jj] * w0.z; ex[3] += vv[jj] * w0.w;
                    ex[4] += vv[jj] * w1.x; ex[5] += vv[jj] * w1.y; ex[6] += vv[jj] * w1.z; ex[7] += vv[jj] * w1.w;
                }
            }
            float v0 = -INFINITY, v1 = -INFINITY; int i0 = 0, i1 = 0;
#pragma unroll
            for (int k = 0; k < 8; ++k) {
                const float lv = wsum(ex[k]) + p.b_re[gsel * 8 + k];
                if (lv > v0) { v1 = v0; i1 = i0; v0 = lv; i0 = k; }
                else if (lv > v1) { v1 = lv; i1 = k; }
            }
            const float e1 = __expf(v1 - v0), den = 1.0f + e1;
            const float w0 = pgroup / den, w1 = pgroup * e1 / den;
            if (lane == 0) {
                const int ea = gsel * 8 + i0, eb = gsel * 8 + i1;
                toke[row] = make_int2(ea, eb); tokw[row] = make_float2(w0, w1);
                atomicAdd(&hist[ea], 1); atomicAdd(&hist[eb], 1);
            }
        }
        __syncthreads();
        if (tid < 64) histg[c * 64 + tid] = hist[tid];
        __syncthreads();
    }
}

__device__ void compute_segments(const int* histg, int* seg, int tid) {
    if (tid < 64) {
        int s = 0;
        for (int c = 0; c < 256; ++c) s += histg[c * 64 + tid];
        seg[tid] = s;
    }
    __syncthreads();
    if (tid == 0) {
        int acc = 0;
        for (int e = 0; e < 64; ++e) { seg[64 + e] = acc; acc += (seg[e] + 255) >> 8; }
        seg[128] = acc;
    }
    __syncthreads();
}

__device__ void phase8(const Params& p, char* smem) {
    const int tid = opaque_tid();
    char* ws = p.ws;
    const int* histg = (const int*)(ws + OFF_HIST);
    const int2* toke = (const int2*)(ws + OFF_TOKE); const float2* tokw = (const float2*)(ws + OFF_TOKW);
    int* slot_tok = (int*)(ws + OFF_SLOTTOK); float* slot_w = (float*)(ws + OFF_SLOTW);
    int* seg = (int*)smem;
    int* cursor = seg + 192;
    compute_segments(histg, seg, tid);
    for (int e = blockIdx.x; e < 64; e += gridDim.x) {
        const int start = seg[64 + e] * 256 + seg[e], end = seg[64 + e + 1] * 256;
        for (int s = start + tid; s < end; s += NTHR) { slot_tok[s] = -1; slot_w[s] = 0.f; }
    }
    for (int c = blockIdx.x; c < 256; c += gridDim.x) {
        __syncthreads();
        if (tid < 64) {
            int base = 0;
            for (int cc = 0; cc < c; ++cc) base += histg[cc * 64 + tid];
            cursor[tid] = seg[64 + tid] * 256 + base;
        }
        __syncthreads();
        if (tid < 256) {
            const int tok = c * 256 + tid;
            const int2 ee = toke[tok]; const float2 ww = tokw[tok];
            const int s0 = atomicAdd(&cursor[ee.x], 1);
            const int s1 = atomicAdd(&cursor[ee.y], 1);
            slot_tok[s0] = tok * 2; slot_w[s0] = ww.x;
            slot_tok[s1] = tok * 2 + 1; slot_w[s1] = ww.y;
        }
    }
}

__device__ void phase9a(const Params& p, char* smem) {
    const int tid = opaque_tid(), lane = tid & 63, wid = tid >> 6, wr = wid >> 1, wc = wid & 1, fr = lane & 15, fq = lane >> 4;
    char* ws = p.ws;
    int* seg = (int*)(smem + LDS_GEMM);
    compute_segments((const int*)(ws + OFF_HIST), seg, tid);
    const int nrt = seg[128];
    const int* slot_tok = (const int*)(ws + OFF_SLOTTOK);
    const bf16_t* h2b = (const bf16_t*)(ws + OFF_R0);
    bf16_t* hbuf = (bf16_t*)(ws + OFF_R1);
    for (int t = blockIdx.x; t < nrt * 4; t += gridDim.x) {
        const int rtile = t >> 2, nt = t & 3;
        int e = 0;
        for (int k = 1; k < 64; ++k) if (seg[64 + k] <= rtile) e = k;
        GemmSrc s;
        {
            const int r = tid >> 3, lc = (tid & 7) ^ ((r >> 1) & 7);
#pragma unroll
            for (int i = 0; i < 4; ++i) {
                const int tk = slot_tok[rtile * 256 + i * 64 + r];
                const int tok = tk < 0 ? 0 : (tk >> 1);
                s.a[i] = h2b + (size_t)tok * 1024 + lc * 8;
            }
#pragma unroll
            for (int i = 0; i < 2; ++i) s.b[i] = (const bf16_t*)(ws + OFF_WGU) + (size_t)e * 512 * 1024 + (size_t)(nt * 128 + i * 64 + r) * 1024 + lc * 8;
        }
        f32x4 acc[4][4]; zero_acc(acc);
        gemm_loop(acc, s, 16, smem, tid);
        const int row0 = rtile * 256 + wr * 64 + fr;
        const int colb = (nt * 2 + wc) * 32 + fq * 4;
#pragma unroll
        for (int m = 0; m < 4; ++m) {
            const size_t slot = row0 + m * 16;
#pragma unroll
            for (int n = 0; n < 2; ++n) {
                const f32x4 g = acc[m][n], u = acc[m][n + 2];
                f32x4 v;
#pragma unroll
                for (int j = 0; j < 4; ++j) v[j] = g[j] * sigmoidf_(g[j]) * u[j];
                store_bf16x4(hbuf + slot * 256 + colb + n * 16, v);
            }
        }
    }
}

__device__ void phase9b(const Params& p, char* smem) {
    const int tid = opaque_tid(), lane = tid & 63, wid = tid >> 6, wr = wid >> 1, wc = wid & 1, fr = lane & 15, fq = lane >> 4;
    char* ws = p.ws;
    int* seg = (int*)(smem + LDS_GEMM);
    compute_segments((const int*)(ws + OFF_HIST), seg, tid);
    const int nrt = seg[128];
    const int* slot_tok = (const int*)(ws + OFF_SLOTTOK); const float* slot_w = (const float*)(ws + OFF_SLOTW);
    const bf16_t* hbuf = (const bf16_t*)(ws + OFF_R1);
    bf16_t* yb = (bf16_t*)(ws + OFF_YB);
    for (int t = blockIdx.x; t < nrt * 8; t += gridDim.x) {
        const int rtile = t >> 3, nt = t & 7;
        int e = 0;
        for (int k = 1; k < 64; ++k) if (seg[64 + k] <= rtile) e = k;
        GemmSrc s;
        make_src(s, hbuf, 256, rtile * 256, (const bf16_t*)(ws + OFF_WD) + (size_t)e * 1024 * 256, 256, nt * 128, tid);
        f32x4 acc[4][4]; zero_acc(acc);
        gemm_loop(acc, s, 4, smem, tid);
        const int row0 = rtile * 256 + wr * 64 + fr, col0 = nt * 128 + wc * 64 + fq * 4;
#pragma unroll
        for (int m = 0; m < 4; ++m) {
            const int slot = row0 + m * 16;
            const int tk = slot_tok[slot]; const float w = slot_w[slot];
            if (tk >= 0) {
#pragma unroll
                for (int n = 0; n < 4; ++n) store_bf16x4(yb + (size_t)tk * 1024 + col0 + n * 16, acc[m][n] * w);
            }
        }
    }
}

__device__ void phase10(const Params& p) {
    const int tid_ = opaque_tid(); const int lane = tid_ & 63, wid = tid_ >> 6;
    const float* h2 = (const float*)(p.ws + OFF_Z2); const bf16_t* yb = (const bf16_t*)(p.ws + OFF_YB);
    for (int row = blockIdx.x * 8 + wid; row < T_; row += gridDim.x * 8) {
        float4 v[4];
#pragma unroll
        for (int i = 0; i < 4; ++i) {
            const float4 hh = *(const float4*)(h2 + (size_t)row * 1024 + i * 256 + lane * 4);
            const uint2 a = *(const uint2*)(yb + (size_t)(row * 2) * 1024 + i * 256 + lane * 4), b = *(const uint2*)(yb + (size_t)(row * 2 + 1) * 1024 + i * 256 + lane * 4);
            v[i].x = ALPHA * hh.x + bf_lo(a.x) + bf_lo(b.x); v[i].y = ALPHA * hh.y + bf_hi(a.x) + bf_hi(b.x);
            v[i].z = ALPHA * hh.z + bf_lo(a.y) + bf_lo(b.y); v[i].w = ALPHA * hh.w + bf_hi(a.y) + bf_hi(b.y);
        }
        ln_row(v, p.ln3g, p.ln3b, lane);
#pragma unroll
        for (int i = 0; i < 4; ++i) *(float4*)(p.out + (size_t)row * 1024 + i * 256 + lane * 4) = v[i];
    }
}

#ifndef DUP
#define DUP (-1)
#endif
#define RUN(id, call) do { call; if (DUP == (id)) { grid.sync(); call; } } while (0)
__global__ void __launch_bounds__(NTHR) mega(Params p) {
    extern __shared__ __attribute__((aligned(16))) char smem[];
    cg::grid_group grid = cg::this_grid();
    char* ws = p.ws;
    RUN(0, phase0(p, smem));
    grid.sync();
    RUN(1, phase1(p, smem));
    grid.sync();
    RUN(2, phase2(p, smem));
    if (DUP == 20) { grid.sync(); phase2(p, smem, 1); }
    if (DUP == 21) { grid.sync(); phase2(p, smem, 2); }
    grid.sync();
    RUN(3, phase3(p, smem));
    grid.sync();
    RUN(4, phase_gemm_resid(p, smem, (const bf16_t*)(ws + OFF_R1), (const bf16_t*)(ws + OFF_WMIX), p.x, p.out));
    grid.sync();
    phase_ln1(p);
    RUN(5, moe_weight_prep(p, smem));
    grid.sync();
    RUN(6, phase_gemm_bf16(p, smem, (const bf16_t*)(ws + OFF_R0), (const bf16_t*)(ws + OFF_WXQ), (bf16_t*)(ws + OFF_XQ), 0.0625f));
    grid.sync();
    RUN(7, phase6(p, smem));
    grid.sync();
    RUN(8, phase_gemm_resid(p, smem, (const bf16_t*)(ws + OFF_O), (const bf16_t*)(ws + OFF_WXO), p.out, (float*)(ws + OFF_Z2)));
    grid.sync();
    phase_ln2_router(p, smem);
    grid.sync();
    RUN(9, phase8(p, smem));
    grid.sync();
    RUN(10, phase9a(p, smem));
    grid.sync();
    RUN(11, phase9b(p, smem));
    grid.sync();
    phase10(p);
}

extern "C" void kernel_launch(void* const* d_in, const int* in_sizes, int n_in, void* d_out, int out_size,
                              void* d_ws, size_t ws_size, hipStream_t stream) {
    static int grid_blocks = 0;
    if (!grid_blocks) {
        int dev = 0, cus = 0, per_cu = 0;
        (void)hipGetDevice(&dev);
        (void)hipDeviceGetAttribute(&cus, hipDeviceAttributeMultiprocessorCount, dev);
        (void)hipFuncSetAttribute((const void*)mega, hipFuncAttributeMaxDynamicSharedMemorySize, LDS_BYTES);
        (void)hipOccupancyMaxActiveBlocksPerMultiprocessor(&per_cu, mega, NTHR, LDS_BYTES);
        if (per_cu > 1) per_cu = 1;
        grid_blocks = cus * per_cu;
        if (ws_size < WS_NEED) fprintf(stderr, "workspace too small: %zu\n", ws_size);
    }
    Params p{};
    const float* const* f = (const float* const*)d_in;
    p.x = f[0]; p.mem = f[1]; p.pos = (const int*)d_in[2];
    p.w_in = f[3]; p.sinks = f[4]; p.conv_w = f[5]; p.conv_b = f[6]; p.b_ig = f[7]; p.b_fg = f[8]; p.ml_g = f[9];
    p.w_att = f[10]; p.w_ml = f[11]; p.w_mix = f[12]; p.ln1g = f[13]; p.ln1b = f[14];
    p.w_xq = f[15]; p.w_xkv = f[16]; p.w_xo = f[17]; p.ln2g = f[18]; p.ln2b = f[19];
    p.w_rg = f[20]; p.b_rg = f[21]; p.w_re = f[22]; p.b_re = f[23]; p.w_gate = f[24]; p.w_up = f[25]; p.w_down = f[26];
    p.ln3g = f[27]; p.ln3b = f[28];
    p.out = (float*)d_out; p.ws = (char*)d_ws;
    void* args[] = {&p};
    hipError_t e = hipLaunchCooperativeKernel((void*)mega, dim3(grid_blocks), dim3(NTHR), args, LDS_BYTES, stream);
    if (e != hipSuccess) fprintf(stderr, "cooperative launch failed: %s (grid %d)\n", hipGetErrorString(e), grid_blocks);
}
```

```cpp
#include <hip/hip_runtime.h>
#include <hip/hip_cooperative_groups.h>
#include <cstdio>
#include <cstdint>
namespace cg = cooperative_groups;

typedef unsigned short bf16_t;
typedef short bf16x8 __attribute__((ext_vector_type(8)));
typedef float f32x4 __attribute__((ext_vector_type(4)));
typedef unsigned u32x2 __attribute__((ext_vector_type(2)));
typedef unsigned u32x4 __attribute__((ext_vector_type(4)));
#define LDS_AS __attribute__((address_space(3)))
#define GLB_AS __attribute__((address_space(1)))

constexpr int T_ = 65536;
constexpr int NTHR = 512;
constexpr size_t MiB = 1ull << 20;
constexpr float ALPHA = 1.189207115002721f;
constexpr size_t OFF_R0 = 0;
constexpr size_t OFF_R1 = 128 * MiB;
constexpr size_t OFF_AK = 256 * MiB;
constexpr size_t OFF_AV = 272 * MiB;
constexpr size_t OFF_MQK = 288 * MiB;
constexpr size_t OFF_MV = 416 * MiB;
constexpr size_t OFF_MO = 544 * MiB;
constexpr size_t OFF_GG = 672 * MiB;
constexpr size_t OFF_WGU = 256 * MiB;
constexpr size_t OFF_WD = 320 * MiB;
constexpr size_t OFF_XQ = 352 * MiB;
constexpr size_t OFF_O = 480 * MiB;
constexpr size_t OFF_Z2 = 608 * MiB;
constexpr size_t OFF_YB = 352 * MiB;
constexpr size_t OFF_MISC = 928 * MiB;
constexpr size_t OFF_WIN = OFF_MISC;
constexpr size_t OFF_WATT = OFF_MISC + 13 * MiB;
constexpr size_t OFF_WML = OFF_MISC + 15 * MiB;
constexpr size_t OFF_WMIX = OFF_MISC + 17 * MiB;
constexpr size_t OFF_WXQ = OFF_MISC + 19 * MiB;
constexpr size_t OFF_WXO = OFF_MISC + 21 * MiB;
constexpr size_t OFF_WXKV = OFF_MISC + 23 * MiB;
constexpr size_t OFF_MEMB = OFF_MISC + 27 * MiB;
constexpr size_t OFF_KMAT = OFF_MISC + 35 * MiB;
constexpr size_t OFF_VT = OFF_MISC + 43 * MiB;
constexpr size_t OFF_GATES = OFF_MISC + 51 * MiB;
constexpr size_t OFF_CS = OFF_MISC + 53 * MiB;
constexpr size_t OFF_TOKE = OFF_MISC + 69 * MiB;
constexpr size_t OFF_TOKW = OFF_MISC + 70 * MiB;
constexpr size_t OFF_SLOTTOK = OFF_MISC + 71 * MiB;
constexpr size_t OFF_SLOTW = OFF_MISC + 72 * MiB;
constexpr size_t OFF_HIST = OFF_MISC + 73 * MiB;
constexpr size_t WS_NEED = 1024 * MiB;
constexpr int LDS_GEMM = 147456;
constexpr int LDS_BYTES = 150528;

struct Params {
    const float *x, *mem; const int* pos;
    const float *w_in, *sinks, *conv_w, *conv_b, *b_ig, *b_fg, *ml_g, *w_att, *w_ml, *w_mix, *ln1g, *ln1b;
    const float *w_xq, *w_xkv, *w_xo, *ln2g, *ln2b, *w_rg, *b_rg, *w_re, *b_re, *w_gate, *w_up, *w_down, *ln3g, *ln3b;
    float* out; char* ws;
};

__device__ const double INV_FREQ[32] = {1.0, 0.7498942093324559, 0.5623413251903491, 0.4216965034285822, 0.31622776601683794, 0.23713737056616552, 0.1778279410038923, 0.1333521432163324, 0.1, 0.07498942093324558, 0.05623413251903491, 0.042169650342858224, 0.03162277660168379, 0.023713737056616554, 0.01778279410038923, 0.01333521432163324, 0.01, 0.007498942093324558, 0.005623413251903491, 0.004216965034285823, 0.0031622776601683794, 0.0023713737056616554, 0.0017782794100389228, 0.001333521432163324, 0.001, 0.0007498942093324559, 0.0005623413251903491, 0.00042169650342858224, 0.00031622776601683794, 0.00023713737056616554, 0.00017782794100389227, 0.0001333521432163324};

__device__ __forceinline__ int opaque_tid() { int t = threadIdx.x; asm volatile("" : "+v"(t)); return t; }
__device__ __forceinline__ unsigned pk_bf16(float lo, float hi) { unsigned r; asm("v_cvt_pk_bf16_f32 %0, %1, %2" : "=v"(r) : "v"(lo), "v"(hi)); return r; }
__device__ __forceinline__ float bf_lo(unsigned u) { return __uint_as_float(u << 16); }
__device__ __forceinline__ float bf_hi(unsigned u) { return __uint_as_float(u & 0xffff0000u); }
__device__ __forceinline__ float bf2f(bf16_t h) { return __uint_as_float(((unsigned)h) << 16); }
__device__ __forceinline__ float wsum(float v) {
#pragma unroll
    for (int o = 32; o; o >>= 1) v += __shfl_xor(v, o);
    return v;
}
__device__ __forceinline__ float wmaxf(float v) {
#pragma unroll
    for (int o = 32; o; o >>= 1) v = fmaxf(v, __shfl_xor(v, o));
    return v;
}
__device__ __forceinline__ float sigmoidf_(float x) { return 1.0f / (1.0f + __expf(-x)); }
__device__ __forceinline__ void glds16(const bf16_t* g, char* l) {
    __builtin_amdgcn_global_load_lds((const GLB_AS void*)g, (LDS_AS void*)l, 16, 0, 0);
}

__device__ __forceinline__ bool xcd_item(int i, int n, int& item) {
    const int G = gridDim.x;
    if ((G & 7) == 0) {
        const int x = blockIdx.x & 7, j = blockIdx.x >> 3, nj = G >> 3;
        const int per = (n + 7) >> 3;
        const int u = i * nj + j;
        if (u >= per) return false;
        item = x * per + u;
        return item < n;
    }
    item = blockIdx.x + i * G;
    return item < n;
}

struct GemmSrc { const bf16_t* a[4]; const bf16_t* b[2]; };

__device__ __forceinline__ void stage_tile(const GemmSrc& s, int koff, char* buf, int tid) {
#pragma unroll
    for (int i = 0; i < 4; ++i) glds16(s.a[i] + koff, buf + (i * 512 + tid) * 16);
#pragma unroll
    for (int i = 0; i < 2; ++i) glds16(s.b[i] + koff, buf + 32768 + (i * 512 + tid) * 16);
}

constexpr int GEMM_STAGE = 49152;
__device__ __forceinline__ void gemm_loop(f32x4 (&acc)[4][4], const GemmSrc& s, int nk, char* smem, int tid) {
    const int lane = tid & 63, wid = tid >> 6, wr = wid >> 1, wc = wid & 1, fr = lane & 15, fq = lane >> 4;
    const int swz = (fr >> 1) & 7;
    const int aoff = (wr * 64 + fr) * 128;
    const int boff = 32768 + (wc * 64 + fr) * 128;
    stage_tile(s, 0, smem, tid);
    if (nk > 1) stage_tile(s, 64, smem + GEMM_STAGE, tid);
    int cur = 0, nxt = 2;
#pragma unroll 1
    for (int t = 0; t < nk; ++t) {
        if (t + 1 < nk) asm volatile("s_waitcnt vmcnt(6)" ::: "memory"); else asm volatile("s_waitcnt vmcnt(0)" ::: "memory");
        __builtin_amdgcn_s_barrier();
        if (t + 2 < nk) stage_tile(s, (t + 2) * 64, smem + nxt * GEMM_STAGE, tid);
        const char* cb = smem + cur * GEMM_STAGE;
#pragma unroll
        for (int ks = 0; ks < 2; ++ks) {
            const int ch = ((ks * 4 + fq) ^ swz) * 16;
            bf16x8 xa[4], wb[4];
#pragma unroll
            for (int m = 0; m < 4; ++m) xa[m] = *(const bf16x8*)(cb + aoff + m * 2048 + ch);
#pragma unroll
            for (int n = 0; n < 4; ++n) wb[n] = *(const bf16x8*)(cb + boff + n * 2048 + ch);
#pragma unroll
            for (int m = 0; m < 4; ++m)
#pragma unroll
                for (int n = 0; n < 4; ++n) acc[m][n] = __builtin_amdgcn_mfma_f32_16x16x32_bf16(wb[n], xa[m], acc[m][n], 0, 0, 0);
        }
        cur = cur == 2 ? 0 : cur + 1; nxt = nxt == 2 ? 0 : nxt + 1;
    }
    __syncthreads();
}

__device__ __forceinline__ void zero_acc(f32x4 (&acc)[4][4]) {
#pragma unroll
    for (int m = 0; m < 4; ++m)
#pragma unroll
        for (int n = 0; n < 4; ++n) acc[m][n] = (f32x4){0.f, 0.f, 0.f, 0.f};
}

__device__ __forceinline__ void make_src(GemmSrc& s, const bf16_t* A, size_t lda, int rowA0, const bf16_t* Bt, size_t ldb, int rowB0, int tid) {
    const int r = tid >> 3, lc = (tid & 7) ^ ((r >> 1) & 7);
#pragma unroll
    for (int i = 0; i < 4; ++i) s.a[i] = A + (size_t)(rowA0 + i * 64 + r) * lda + lc * 8;
#pragma unroll
    for (int i = 0; i < 2; ++i) s.b[i] = Bt + (size_t)(rowB0 + i * 64 + r) * ldb + lc * 8;
}

__device__ __forceinline__ void store_bf16x4(bf16_t* p, f32x4 v) {
    uint2 w; w.x = pk_bf16(v[0], v[1]); w.y = pk_bf16(v[2], v[3]); *(uint2*)p = w;
}

namespace pg8 {
constexpr int BM = 256, BK = 64, HALF = 128, HTB = HALF * BK * 2;
__device__ __forceinline__ int lds_byte(int r, int c) { const int st = (r >> 4) * 2 + (c >> 5), rr = r & 15, cc = c & 31, ob = rr * 64 + cc * 2; return st * 1024 + (ob ^ (((ob >> 9) & 1) << 5)); }
__device__ __forceinline__ void stage_rc(int b, int& R, int& C) { const int st = b / 1024, sb = b % 1024, swz = sb ^ (((sb >> 9) & 1) << 5); R = (st >> 1) * 16 + swz / 64; C = (st & 1) * 32 + (swz % 64) / 2; }
struct Unit { int pm, pn, aux; const char* A; const char* Bt; };

template <class Epi, class Sched>
__device__ __forceinline__ void gemm_phase(LDS_AS unsigned char* lds, const int K, const Sched& S, const Epi& E) {
    const int tid = opaque_tid(), wid = __builtin_amdgcn_readfirstlane(tid >> 6), lane = tid & 63, wr = wid >> 2, wc = wid & 3, fr = lane & 15, fq = lane >> 4;
    const int nt = K / BK;
    unsigned voff[2];
#pragma unroll
    for (int i = 0; i < 2; ++i) { int R, C; stage_rc(tid * 16 + i * 8192, R, C); voff[i] = (unsigned)(R * K + C) * 2u; }
    const size_t kstep = (size_t)(BK * 2);
    const size_t hstep = (size_t)HALF * K * 2;
    const size_t tstep = 2 * hstep;
    const unsigned ldsw = (unsigned)wid * 1024u;
    const int aoff = lds_byte(wr * 64 + fr, fq * 8), boff = lds_byte(wc * 32 + fr, fq * 8);
#define PG8_SA(b, h) (((b) * 2 + (h)) * HTB)
#define PG8_SB(b, h) ((4 + (b) * 2 + (h)) * HTB)
#define PG8_STAGE(bufoff, gbase) do { _Pragma("unroll") for (int _i = 0; _i < 2; ++_i) \
        __builtin_amdgcn_global_load_lds((const GLB_AS void*)((const char*)(gbase) + voff[_i]), (LDS_AS void*)(lds + (bufoff) + ldsw + _i * 8192), 16, 0, 0); } while (0)
#define PG8_LDA(dst, b, h) do { _Pragma("unroll") for (int m = 0; m < 4; ++m) _Pragma("unroll") for (int k = 0; k < 2; ++k) dst[m][k] = *(const LDS_AS bf16x8*)(lds + PG8_SA(b, h) + aoff + m * 2048 + k * 1024); } while (0)
#define PG8_LDB(dst, b, h) do { _Pragma("unroll") for (int n = 0; n < 2; ++n) _Pragma("unroll") for (int k = 0; k < 2; ++k) dst[n][k] = *(const LDS_AS bf16x8*)(lds + PG8_SB(b, h) + boff + n * 2048 + k * 1024); } while (0)
#define PG8_MMA(ai, bj, At, Bt) do { __builtin_amdgcn_s_setprio(1); _Pragma("unroll") for (int m = 0; m < 4; ++m) _Pragma("unroll") for (int n = 0; n < 2; ++n) _Pragma("unroll") for (int k = 0; k < 2; ++k) \
        acc[ai][bj][m][n] = __builtin_amdgcn_mfma_f32_16x16x32_bf16(Bt[n][k], At[m][k], acc[ai][bj][m][n], 0, 0, 0); __builtin_amdgcn_s_setprio(0); } while (0)
#define PG8_WAIT_V(n) asm volatile("s_waitcnt vmcnt(" #n ")" ::: "memory")
#define PG8_WAIT_L(n) asm volatile("s_waitcnt lgkmcnt(" #n ")" ::: "memory")
#define PG8_BAR __builtin_amdgcn_s_barrier()
#define PG8_SCHED __builtin_amdgcn_sched_barrier(0)
    Unit cur, nxt; int ui = 0;
    if (!S.next(0, cur)) return;
    f32x4 acc[2][2][4][2];
#pragma unroll
    for (int a = 0; a < 2; ++a)
#pragma unroll
        for (int b = 0; b < 2; ++b)
#pragma unroll
            for (int m = 0; m < 4; ++m)
#pragma unroll
                for (int n = 0; n < 2; ++n) acc[a][b][m][n] = (f32x4){0.f, 0.f, 0.f, 0.f};
    bf16x8 At[4][2], B0[2][2], B1[2][2];
    const char* cA = cur.A + (size_t)cur.pm * tstep; const char* cB = cur.Bt + (size_t)cur.pn * tstep;
    PG8_STAGE(PG8_SB(0, 0), cB); PG8_STAGE(PG8_SB(0, 1), cB + hstep); PG8_STAGE(PG8_SA(0, 0), cA); PG8_STAGE(PG8_SA(0, 1), cA + hstep);
    if (wr == 1) PG8_BAR;
    PG8_WAIT_V(2); PG8_BAR;
    PG8_STAGE(PG8_SB(1, 0), cB + kstep); PG8_STAGE(PG8_SA(1, 0), cA + kstep); PG8_STAGE(PG8_SB(1, 1), cB + hstep + kstep);
    PG8_WAIT_V(6); PG8_BAR;
    for (;;) {
        const bool has_next = S.next(ui + 1, nxt);
        const char* nA = has_next ? nxt.A + (size_t)nxt.pm * tstep : cA; const char* nB = has_next ? nxt.Bt + (size_t)nxt.pn * tstep : cB;
        for (int t = 0; t < nt; t += 2) {
            const bool last = (t == nt - 2);
            const char* a1 = cA + (size_t)(t + 1) * kstep;
            const char* a2 = last ? nA : cA + (size_t)(t + 2) * kstep; const char* b2 = last ? nB : cB + (size_t)(t + 2) * kstep;
            const char* a3 = a2 + kstep; const char* b3 = b2 + kstep;
            PG8_LDB(B0, 0, 0); PG8_LDB(B1, 0, 1); PG8_SCHED; PG8_LDA(At, 0, 0); PG8_STAGE(PG8_SA(1, 1), a1 + hstep);
            PG8_WAIT_V(8); PG8_WAIT_L(0); PG8_BAR; PG8_MMA(0, 0, At, B0); PG8_MMA(0, 1, At, B1); PG8_BAR; PG8_SCHED;
            PG8_LDA(At, 0, 1); PG8_STAGE(PG8_SB(0, 0), b2); PG8_STAGE(PG8_SB(0, 1), b2 + hstep); PG8_STAGE(PG8_SA(0, 0), a2);
            PG8_WAIT_V(8); PG8_WAIT_L(0); PG8_BAR; PG8_MMA(1, 0, At, B0); PG8_MMA(1, 1, At, B1); PG8_BAR; PG8_SCHED;
            PG8_LDB(B0, 1, 0); PG8_LDB(B1, 1, 1); PG8_SCHED; PG8_LDA(At, 1, 0); PG8_STAGE(PG8_SA(0, 1), a2 + hstep);
            PG8_WAIT_V(8); PG8_WAIT_L(0); PG8_BAR; PG8_MMA(0, 0, At, B0); PG8_MMA(0, 1, At, B1); PG8_BAR; PG8_SCHED;
            PG8_LDA(At, 1, 1); PG8_STAGE(PG8_SB(1, 0), b3); PG8_STAGE(PG8_SB(1, 1), b3 + hstep); PG8_STAGE(PG8_SA(1, 0), a3);
            PG8_WAIT_V(8); PG8_WAIT_L(0); PG8_BAR; PG8_MMA(1, 0, At, B0); PG8_MMA(1, 1, At, B1); PG8_BAR; PG8_SCHED;
        }
        if (wr == 0) PG8_BAR;
        E(acc, cur, wr, wc, fr, fq);
        if (!has_next) break;
#pragma unroll
        for (int a = 0; a < 2; ++a)
#pragma unroll
            for (int b = 0; b < 2; ++b)
#pragma unroll
                for (int m = 0; m < 4; ++m)
#pragma unroll
                    for (int n = 0; n < 2; ++n) acc[a][b][m][n] = (f32x4){0.f, 0.f, 0.f, 0.f};
        cur = nxt; cA = nA; cB = nB; ++ui;
        if (wr == 1) PG8_BAR;
    }
    PG8_WAIT_V(0);
    PG8_BAR;
#undef PG8_SA
#undef PG8_SB
#undef PG8_STAGE
#undef PG8_LDA
#undef PG8_LDB
#undef PG8_MMA
#undef PG8_WAIT_V
#undef PG8_WAIT_L
#undef PG8_BAR
#undef PG8_SCHED
}
}

__device__ __forceinline__ void tr_tile2(const float* srca, int c0a, const float* srcb, int c0b, size_t ld_src, int k0, bf16_t* dst, size_t ld_dst, int r0, float* tile, int tid) {
    {
        const int r = tid >> 3, c4 = (tid & 7) * 4;
        const float* sp = c4 < 16 ? srca + (size_t)(k0 + r) * ld_src + c0a + c4 : srcb + (size_t)(k0 + r) * ld_src + c0b + (c4 - 16);
        const float4 v = *(const float4*)sp;
        float* tp = tile + r * 33 + c4; tp[0] = v.x; tp[1] = v.y; tp[2] = v.z; tp[3] = v.w;
    }
    __syncthreads();
    {
        const int c = tid >> 4, rc = (tid & 15) * 4;
        const float a0 = tile[(rc + 0) * 33 + c], a1 = tile[(rc + 1) * 33 + c], a2 = tile[(rc + 2) * 33 + c], a3 = tile[(rc + 3) * 33 + c];
        uint2 w; w.x = pk_bf16(a0, a1); w.y = pk_bf16(a2, a3);
        *(uint2*)(dst + (size_t)(r0 + c) * ld_dst + k0 + rc) = w;
    }
    __syncthreads();
}
__device__ __forceinline__ void tr_tile(const float* src, size_t ld_src, int k0, int c0, bf16_t* dst, size_t ld_dst, int r0, float* tile, int tid) {
    tr_tile2(src, c0, src, c0 + 16, ld_src, k0, dst, ld_dst, r0, tile, tid);
}

__device__ void phase0(const Params& p, char* smem) {
    const int tid = opaque_tid(), lane = tid & 63, wid = tid >> 6;
    const int gw = blockIdx.x * 8 + wid, nw = gridDim.x * 8;
    char* ws = p.ws;
    bf16_t* xb = (bf16_t*)(ws + OFF_R0);
    for (int row = gw; row < T_; row += nw) {
        const float4* xr = (const float4*)(p.x + (size_t)row * 1024);
#pragma unroll
        for (int i = 0; i < 4; ++i) {
            const float4 v = xr[i * 64 + lane];
            uint2 w; w.x = pk_bf16(v.x, v.y); w.y = pk_bf16(v.z, v.w);
            *(uint2*)(xb + (size_t)row * 1024 + i * 256 + lane * 4) = w;
        }
    }
    {
        float2* cs = (float2*)(ws + OFF_CS);
        const int gt = blockIdx.x * NTHR + tid, nt = gridDim.x * NTHR;
        for (int idx = gt; idx < T_ * 32; idx += nt) {
            const int tok = idx >> 5, i = idx & 31;
            const double ang = (double)p.pos[tok] * INV_FREQ[i];
            const double turns = ang * 0.15915494309189535;
            const float f = (float)(turns - rint(turns));
            cs[idx] = make_float2(__builtin_amdgcn_cosf(f), __builtin_amdgcn_sinf(f));
        }
        bf16_t* memb = (bf16_t*)(ws + OFF_MEMB);
        for (int idx = gt; idx < 4096 * 1024 / 4; idx += nt) {
            const float4 v = ((const float4*)p.mem)[idx];
            uint2 w; w.x = pk_bf16(v.x, v.y); w.y = pk_bf16(v.z, v.w);
            ((uint2*)memb)[idx] = w;
        }
    }
    {
        float* tile = (float*)smem;
        const int NT_WIN = 16 * 201, NT_SQ = 16 * 32, NT_XKV = 16 * 64;
        const int total = NT_WIN + 5 * NT_SQ + NT_XKV;
        for (int t = blockIdx.x; t < total; t += gridDim.x) {
            if (t < NT_WIN) {
                const int kt = t & 15, nt_ = t >> 4;
                const int n0 = nt_ * 32;
                if (n0 < 1152) {
                    const int hd = n0 >> 6, half = (n0 >> 5) & 1;
                    tr_tile2(p.w_in, hd * 64 + half * 16, p.w_in, hd * 64 + half * 16 + 32, 6408, kt * 64, (bf16_t*)(ws + OFF_WIN), 1024, n0, tile, tid);
                } else {
                    const int c0 = n0 < 4352 ? n0 : (n0 < 6400 ? n0 + 8 : 4352);
                    tr_tile(p.w_in, 6408, kt * 64, c0, (bf16_t*)(ws + OFF_WIN), 1024, n0, tile, tid);
                }
            } else if (t < NT_WIN + 5 * NT_SQ) {
                const int u = t - NT_WIN, which = u / NT_SQ, v = u % NT_SQ, kt = v & 15, nt_ = v >> 4;
                const float* src = which == 0 ? p.w_att : which == 1 ? p.w_ml : which == 2 ? p.w_mix : which == 3 ? p.w_xq : p.w_xo;
                bf16_t* dst = (bf16_t*)(ws + OFF_WATT + (size_t)which * 2 * MiB);
                tr_tile(src, 1024, kt * 64, nt_ * 32, dst, 1024, nt_ * 32, tile, tid);
            } else {
                const int v = t - NT_WIN - 5 * NT_SQ, kt = v & 15, nt_ = v >> 4;
                tr_tile(p.w_xkv, 2048, kt * 64, nt_ * 32, (bf16_t*)(ws + OFF_WXKV), 1024, nt_ * 32, tile, tid);
            }
        }
    }
}

__device__ void moe_weight_prep(const Params& p, char* smem) {
    const int tid = opaque_tid();
    float* tile = (float*)smem;
    char* ws = p.ws;
    const int per_e = 384, total = 64 * per_e;
    for (int t = blockIdx.x; t < total; t += gridDim.x) {
        const int e = t / per_e, u = t % per_e;
        if (u < 256) {
            const int isup = u >> 7, v = u & 127, kt = v & 15, j = v >> 4;
            const float* src = (isup ? p.w_up : p.w_gate) + (size_t)e * 1024 * 256;
            tr_tile(src, 256, kt * 64, j * 32, (bf16_t*)(ws + OFF_WGU) + (size_t)e * 512 * 1024, 1024, j * 64 + isup * 32, tile, tid);
        } else {
            const int v = u - 256, kt = v & 3, nt_ = v >> 2;
            tr_tile(p.w_down + (size_t)e * 256 * 1024, 1024, kt * 64, nt_ * 32, (bf16_t*)(ws + OFF_WD) + (size_t)e * 1024 * 256, 256, nt_ * 32, tile, tid);
        }
    }
}

struct SchedP1 {
    int G, c; const char *xb, *win, *memb, *wxkv;
    __device__ __forceinline__ bool next(int i, pg8::Unit& u) const {
        int nmain, uidx;
        if (G == 256) { nmain = 26; const int x = c & 7, j = c >> 3; uidx = i * 32 + j; if (i < 26) { const int g = uidx / 104, v = uidx % 104; u.pm = 32 * x + 4 * g + (v & 3); u.pn = v >> 2; } }
        else { nmain = c < 6656 ? (6656 - 1 - c) / G + 1 : 0; uidx = i * G + c; if (i < nmain) { u.pm = uidx / 26; u.pn = uidx % 26; } }
        if (i < nmain) { u.aux = 0; u.A = xb; u.Bt = win; return true; }
        const int kv = c + (i - nmain) * G;
        if (kv >= 128) return false;
        if (kv < 64) { u.aux = 1; u.pm = kv >> 2; u.pn = kv & 3; u.A = memb; u.Bt = wxkv; }
        else { const int k2 = kv - 64; u.aux = 2; u.pm = k2 >> 4; u.pn = k2 & 15; u.A = wxkv + (size_t)1024 * 1024 * 2; u.Bt = memb; }
        return true;
    }
};

struct EpiP1 {
    char* ws;
    __device__ __forceinline__ void operator()(const f32x4 (&acc)[2][2][4][2], const pg8::Unit& u, int wr, int wc, int fr, int fq) const {
        const int row0 = u.pm * 256 + wr * 64 + fr;
#pragma unroll
        for (int bj = 0; bj < 2; ++bj) {
            const int c32 = u.pn * 256 + bj * 128 + wc * 32;
            if (u.aux == 0 && c32 < 1152) {
                bf16_t* dst; int ld, cb; float sc;
                const int half = (c32 >> 5) & 1;
                if (c32 < 1024) { dst = (bf16_t*)(ws + OFF_R1); ld = 1024; cb = (c32 >> 6) * 64; sc = 0.125f; }
                else { dst = (bf16_t*)(ws + OFF_AK); ld = 128; cb = ((c32 - 1024) >> 6) * 64; sc = 1.0f; }
                const float* cs = (const float*)(ws + OFF_CS);
                const int d1 = half * 16 + fq * 4;
#pragma unroll
                for (int ai = 0; ai < 2; ++ai)
#pragma unroll
                    for (int m = 0; m < 4; ++m) {
                        const int tok = row0 + ai * 128 + m * 16;
                        const float4* cp = (const float4*)(cs + (size_t)tok * 64 + d1 * 2);
                        const float4 c01 = cp[0], c23 = cp[1];
                        const f32x4 x1 = acc[ai][bj][m][0], x2 = acc[ai][bj][m][1];
                        f32x4 o1, o2;
                        o1[0] = (x1[0] * c01.x - x2[0] * c01.y) * sc; o2[0] = (x2[0] * c01.x + x1[0] * c01.y) * sc;
                        o1[1] = (x1[1] * c01.z - x2[1] * c01.w) * sc; o2[1] = (x2[1] * c01.z + x1[1] * c01.w) * sc;
                        o1[2] = (x1[2] * c23.x - x2[2] * c23.y) * sc; o2[2] = (x2[2] * c23.x + x1[2] * c23.y) * sc;
                        o1[3] = (x1[3] * c23.z - x2[3] * c23.w) * sc; o2[3] = (x2[3] * c23.z + x1[3] * c23.w) * sc;
                        bf16_t* rp = dst + (size_t)tok * ld + cb + d1;
                        store_bf16x4(rp, o1); store_bf16x4(rp + 32, o2);
                    }
            } else if (u.aux == 0 && c32 >= 1152 && c32 < 1280) {
                bf16_t* avT = (bf16_t*)(ws + OFF_AV);
                const int cb = c32 - 1152 + fq * 4;
#pragma unroll
                for (int ai = 0; ai < 2; ++ai)
#pragma unroll
                    for (int m = 0; m < 4; ++m)
#pragma unroll
                        for (int n = 0; n < 2; ++n)
#pragma unroll
                            for (int j = 0; j < 4; ++j)
                                avT[(size_t)(cb + n * 16 + j) * T_ + row0 + ai * 128 + m * 16] = (bf16_t)(pk_bf16(acc[ai][bj][m][n][j], acc[ai][bj][m][n][j]) & 0xffffu);
            } else if (u.aux == 0 && c32 >= 6400) {
                if (c32 == 6400 && fq < 2) {
                    float* gates = (float*)(ws + OFF_GATES);
#pragma unroll
                    for (int ai = 0; ai < 2; ++ai)
#pragma unroll
                        for (int m = 0; m < 4; ++m) {
                            const f32x4 v = acc[ai][bj][m][0];
                            *(float4*)(gates + (size_t)(row0 + ai * 128 + m * 16) * 8 + fq * 4) = make_float4(v[0], v[1], v[2], v[3]);
                        }
                }
            } else {
                bf16_t* dst; int ld, cb; bool sig = false;
                if (u.aux == 1) { dst = (bf16_t*)(ws + OFF_KMAT); ld = 1024; cb = c32; }
                else if (u.aux == 2) { dst = (bf16_t*)(ws + OFF_VT); ld = 4096; cb = c32; }
                else if (c32 < 2304) { dst = (bf16_t*)(ws + OFF_MQK); ld = 1024; cb = c32 - 1280; }
                else if (c32 < 3328) { dst = (bf16_t*)(ws + OFF_MV); ld = 1024; cb = c32 - 2304; }
                else if (c32 < 4352) { dst = (bf16_t*)(ws + OFF_MO); ld = 1024; cb = c32 - 3328; sig = true; }
                else { dst = (bf16_t*)(ws + OFF_GG); ld = 2048; cb = c32 - 4352; sig = true; }
#pragma unroll
                for (int ai = 0; ai < 2; ++ai)
#pragma unroll
                    for (int m = 0; m < 4; ++m) {
                        bf16_t* rp = dst + (size_t)(row0 + ai * 128 + m * 16) * ld + cb + fq * 4;
#pragma unroll
                        for (int n = 0; n < 2; ++n) {
                            f32x4 v = acc[ai][bj][m][n];
                            if (sig) { v[0] = sigmoidf_(v[0]); v[1] = sigmoidf_(v[1]); v[2] = sigmoidf_(v[2]); v[3] = sigmoidf_(v[3]); }
                            store_bf16x4(rp + n * 16, v);
                        }
                    }
            }
        }
    }
};

__device__ void phase1(const Params& p, char* smem) {
    char* ws = p.ws;
    SchedP1 S{(int)gridDim.x, (int)blockIdx.x, ws + OFF_R0, ws + OFF_WIN, ws + OFF_MEMB, ws + OFF_WXKV};
    EpiP1 E{ws};
    pg8::gemm_phase<EpiP1, SchedP1>((LDS_AS unsigned char*)smem, 1024, S, E);
}

template <int NPASS>
struct SchedN1024 {
    int G, c; const char* A0; const char* B0; const char* A1; const char* B1;
    __device__ __forceinline__ bool next(int i, pg8::Unit& u) const {
        const int ti = i / NPASS, pass = i % NPASS;
        int uidx;
        if (G == 256) { if (ti >= 4) return false; const int x = c & 7, j = c >> 3; uidx = ti * 32 + j; u.pm = 32 * x + (uidx >> 2); u.pn = uidx & 3; }
        else { uidx = ti * G + c; if (uidx >= 1024) return false; u.pm = uidx >> 2; u.pn = uidx & 3; }
        u.aux = pass; u.A = pass ? A1 : A0; u.Bt = pass ? B1 : B0;
        return true;
    }
};

constexpr int ML_RAW = 0;
constexpr int ML_V0 = 34816;
constexpr int ML_Q = ML_V0 + 65536;
constexpr int ML_K = ML_Q + 16384;
constexpr int ML_SW = ML_K + 20480;
constexpr int ML_F = ML_SW + 8192;
constexpr int ML_END = ML_F + 4096;
typedef short v4i16_t __attribute__((ext_vector_type(4)));
__device__ __forceinline__ int offQK(int row, int ch) { return row * 256 + ((ch ^ (((row & 3) << 2) | ((row >> 2) & 3))) << 4); }
__device__ __forceinline__ int offV(int row, int ch) { return row * 512 + ((ch ^ (((row & 3) | (((row >> 3) & 1) << 2)) << 1)) << 4); }
__device__ __forceinline__ int offSw(int row, int ch) { return row * 128 + ((ch ^ ((row >> 1) & 7)) << 4); }
__device__ __forceinline__ bf16x8 tr_read2(const char* p0, const char* p1) {
    const v4i16_t a = __builtin_amdgcn_ds_read_tr16_b64_v4i16((LDS_AS v4i16_t*)p0);
    const v4i16_t b = __builtin_amdgcn_ds_read_tr16_b64_v4i16((LDS_AS v4i16_t*)p1);
    return __builtin_shufflevector(a, b, 0, 1, 2, 3, 4, 5, 6, 7);
}

__device__ void mlstm_item(const Params& p, char* smem, int item) {
    const int tid = opaque_tid(), lane = tid & 63, wid = tid >> 6, fr0 = lane & 15, fq0 = lane >> 4;
    const int b = item >> 2, h = item & 3;
    char* ws = p.ws;
    const bf16_t* mqk = (const bf16_t*)(ws + OFF_MQK);
    const bf16_t* mv = (const bf16_t*)(ws + OFF_MV);
    const bf16_t* mo = (const bf16_t*)(ws + OFF_MO);
    const float* gates = (const float*)(ws + OFF_GATES);
    bf16_t* hm = (bf16_t*)p.out;
    float* fl = (float*)(smem + ML_F);
    float* den = fl; float* ssq = fl + 64; float* nsum = fl + 192; float* eb = fl + 448; float* ek = fl + 576; float* gg = fl + 704;
    const long tokb = (long)b * 4096;
    f32x4 C[8][2];
#pragma unroll
    for (int dt = 0; dt < 8; ++dt) { C[dt][0] = (f32x4){0.f, 0.f, 0.f, 0.f}; C[dt][1] = (f32x4){0.f, 0.f, 0.f, 0.f}; }
    float nreg = 0.f;
    const int cp0 = tid & 127, tg = tid >> 7; const int cp = cp0;
    const bool isk = cp >= 64;
    const int dch = isk ? 2 * (cp - 64) : 2 * cp;
    const int ccol = isk ? (512 + h * 128 + dch) : (h * 128 + dch);
    float cw0[4], cw1[4];
#pragma unroll
    for (int j = 0; j < 4; ++j) { cw0[j] = p.conv_w[j * 1024 + ccol]; cw1[j] = p.conv_w[j * 1024 + ccol + 1]; }
    const float cb0 = p.conv_b[ccol], cb1 = p.conv_b[ccol + 1];
    const float big = p.b_ig[h], bfg = p.b_fg[h];
    const float gn0 = p.ml_g[h * 256 + wid * 32 + fr0], gn1 = p.ml_g[h * 256 + wid * 32 + 16 + fr0];
    const int vrl = tid >> 5, vpc = tid & 31, vlc = vpc ^ ((((vrl & 3) | (((vrl >> 3) & 1) << 2))) << 1);
    const bf16_t* vsrc = mv + (tokb + vrl) * 1024 + h * 256 + vlc * 8;
    __syncthreads();
    {
        unsigned* kz = (unsigned*)(smem + ML_K + 64 * 256);
        kz[tid] = 0u; kz[tid + 512] = 0u;
        if (tid < 256) nsum[tid] = 0.f;
#pragma unroll
        for (int i = 0; i < 5; ++i) {
            const int j = i * 512 + tid;
            if (j < 2176) {
                const int row = j >> 5, pc = j & 31;
                const bf16_t* src = mqk + (tokb - 3 + row) * 1024 + (pc < 16 ? h * 128 + pc * 8 : 512 + h * 128 + (pc - 16) * 8);
                glds16(src, smem + ML_RAW + j * 16);
            }
        }
#pragma unroll
        for (int i = 0; i < 4; ++i) glds16(vsrc + (long)i * 16 * 1024, smem + ML_V0 + (i * 512 + tid) * 16);
    }
    float gi = 0.f, gf = 0.f;
    if (wid == 7) {
        const float mi0 = gates[(tokb + lane) * 8 + h], mf0 = gates[(tokb + lane) * 8 + 4 + h];
        gi = gates[(tokb + 64 + lane) * 8 + h]; gf = gates[(tokb + 64 + lane) * 8 + 4 + h];
        const float x = mf0 + bfg;
        float bs = fminf(x, 0.f) - log1pf(__expf(-fabsf(x)));
#pragma unroll
        for (int o = 1; o < 64; o <<= 1) { const float y = __shfl_up(bs, o); if (lane >= o) bs += y; }
        eb[lane] = __expf(bs); ek[lane] = __expf(mi0 + big - bs);
        if (lane == 63) gg[0] = __expf(bs);
    }
    asm volatile("s_waitcnt vmcnt(0)" ::: "memory");
    __syncthreads();
#pragma unroll 1
    for (int c = 0; c < 64; ++c) {
        const int par = c & 1;
        const long tok0 = tokb + c * 64;
        int fr = fr0, fq = fq0, cpv = cp0;
        asm volatile("" : "+v"(fr), "+v"(fq), "+v"(cpv));
        if (tid < 64) { den[tid] = 0.f; ssq[par * 64 + tid] = 0.f; }
        {
            const int tt0 = tg * 16;
            const char* rp = smem + ML_RAW + tt0 * 512 + cpv * 4;
            unsigned w0 = *(const unsigned*)(rp), w1 = *(const unsigned*)(rp + 512), w2 = *(const unsigned*)(rp + 1024);
            if (c == 0 && tg == 0) { w0 = 0u; w1 = 0u; w2 = 0u; }
            float cs0 = 0.f, cs1 = 0.f;
            const float* scp = (isk ? ek : eb) + par * 64 + tt0;
            const int dchv = isk ? 2 * (cpv - 64) : 2 * cpv;
            char* dstb = smem + (isk ? ML_K : ML_Q) + (dchv & 7) * 2;
            const float kmul = isk ? 0.08838834764831845f : 1.0f;
#pragma unroll 4
            for (int tt = 0; tt < 16; ++tt) {
                const unsigned w3 = *(const unsigned*)(rp + (tt + 3) * 512);
                float v0 = cb0 + cw0[0] * bf_lo(w0) + cw0[1] * bf_lo(w1) + cw0[2] * bf_lo(w2) + cw0[3] * bf_lo(w3);
                float v1 = cb1 + cw1[0] * bf_hi(w0) + cw1[1] * bf_hi(w1) + cw1[2] * bf_hi(w2) + cw1[3] * bf_hi(w3);
                w0 = w1; w1 = w2; w2 = w3;
                v0 = v0 * sigmoidf_(v0); v1 = v1 * sigmoidf_(v1);
                const float sc = scp[tt] * kmul;
                const float a0 = v0 * sc, a1 = v1 * sc;
                *(unsigned*)(dstb + offQK(tt0 + tt, dchv >> 3)) = pk_bf16(a0, a1);
                cs0 += a0; cs1 += a1;
            }
            if (isk) { atomicAdd(&nsum[par * 128 + dch], cs0); atomicAdd(&nsum[par * 128 + dch + 1], cs1); }
        }
        __syncthreads();
        if (wid == 7 && c + 1 < 64) {
            const float x = gf + bfg;
            float bs = fminf(x, 0.f) - log1pf(__expf(-fabsf(x)));
#pragma unroll
            for (int o = 1; o < 64; o <<= 1) { const float y = __shfl_up(bs, o); if (lane >= o) bs += y; }
            eb[(par ^ 1) * 64 + lane] = __expf(bs); ek[(par ^ 1) * 64 + lane] = __expf(gi + big - bs);
            if (lane == 63) gg[par ^ 1] = __expf(bs);
            if (c + 2 < 64) { gi = gates[(tok0 + 128 + lane) * 8 + h]; gf = gates[(tok0 + 128 + lane) * 8 + 4 + h]; }
        }
        {
            const int tt = wid >> 1;
            bf16x8 qf[4];
#pragma unroll
            for (int ks = 0; ks < 4; ++ks) qf[ks] = *(const bf16x8*)(smem + ML_Q + offQK(tt * 16 + fr, 4 * ks + fq));
#pragma unroll
            for (int x = 0; x < 2; ++x) {
                const int st = (wid & 1) * 2 + x;
                f32x4 a = (f32x4){0.f, 0.f, 0.f, 0.f};
#pragma unroll
                for (int ks = 0; ks < 4; ++ks) {
                    const bf16x8 kf = *(const bf16x8*)(smem + ML_K + offQK(st * 16 + fr, 4 * ks + fq));
                    a = __builtin_amdgcn_mfma_f32_16x16x32_bf16(kf, qf[ks], a, 0, 0, 0);
                }
#pragma unroll
                for (int j = 0; j < 4; ++j) a[j] = (st * 16 + fq * 4 + j) <= (tt * 16 + fr) ? a[j] : 0.f;
                float rs = (a[0] + a[1]) + (a[2] + a[3]);
                rs += __shfl_xor(rs, 16); rs += __shfl_xor(rs, 32);
                if (fq == 0) atomicAdd(&den[tt * 16 + fr], rs);
                uint2 w; w.x = pk_bf16(a[0], a[1]); w.y = pk_bf16(a[2], a[3]);
                *(uint2*)(smem + ML_SW + offSw(tt * 16 + fr, st * 2 + (fq >> 1)) + (fq & 1) * 8) = w;
            }
            if (wid < 4) {
                f32x4 a = (f32x4){0.f, 0.f, 0.f, 0.f};
#pragma unroll
                for (int ks = 0; ks < 4; ++ks) {
                    const bf16x8 kf = *(const bf16x8*)(smem + ML_K + offQK(64 + fr, 4 * ks + fq));
                    const bf16x8 qa = *(const bf16x8*)(smem + ML_Q + offQK(wid * 16 + fr, 4 * ks + fq));
                    a = __builtin_amdgcn_mfma_f32_16x16x32_bf16(kf, qa, a, 0, 0, 0);
                }
                if (fq == 0) atomicAdd(&den[wid * 16 + fr], a[0]);
            }
        }
        f32x4 Y[4][2];
#pragma unroll
        for (int tt = 0; tt < 4; ++tt) { Y[tt][0] = (f32x4){0.f, 0.f, 0.f, 0.f}; Y[tt][1] = (f32x4){0.f, 0.f, 0.f, 0.f}; }
#pragma unroll
        for (int ks = 0; ks < 4; ++ks) {
            u32x4 c0, c1;
            c0[0] = pk_bf16(C[2 * ks][0][0], C[2 * ks][0][1]); c0[1] = pk_bf16(C[2 * ks][0][2], C[2 * ks][0][3]);
            c0[2] = pk_bf16(C[2 * ks + 1][0][0], C[2 * ks + 1][0][1]); c0[3] = pk_bf16(C[2 * ks + 1][0][2], C[2 * ks + 1][0][3]);
            c1[0] = pk_bf16(C[2 * ks][1][0], C[2 * ks][1][1]); c1[1] = pk_bf16(C[2 * ks][1][2], C[2 * ks][1][3]);
            c1[2] = pk_bf16(C[2 * ks + 1][1][0], C[2 * ks + 1][1][1]); c1[3] = pk_bf16(C[2 * ks + 1][1][2], C[2 * ks + 1][1][3]);
            const bf16x8 cf0 = __builtin_bit_cast(bf16x8, c0), cf1 = __builtin_bit_cast(bf16x8, c1);
#pragma unroll
            for (int tt = 0; tt < 4; ++tt) {
                const int row = tt * 16 + fr;
                const u32x2 lo = *(const u32x2*)(smem + ML_Q + offQK(row, 4 * ks + (fq >> 1)) + (fq & 1) * 8);
                const u32x2 hi = *(const u32x2*)(smem + ML_Q + offQK(row, 4 * ks + 2 + (fq >> 1)) + (fq & 1) * 8);
                u32x4 av; av[0] = lo[0]; av[1] = lo[1]; av[2] = hi[0]; av[3] = hi[1];
                const bf16x8 af = __builtin_bit_cast(bf16x8, av);
                Y[tt][0] = __builtin_amdgcn_mfma_f32_16x16x32_bf16(af, cf0, Y[tt][0], 0, 0, 0);
                Y[tt][1] = __builtin_amdgcn_mfma_f32_16x16x32_bf16(af, cf1, Y[tt][1], 0, 0, 0);
            }
        }
        __syncthreads();
        if (c + 1 < 64) {
#pragma unroll
            for (int i = 0; i < 5; ++i) {
                const int j = i * 512 + tid;
                if (j < 2176) {
                    const int row = j >> 5, pc = j & 31;
                    const bf16_t* src = mqk + (tok0 + 64 - 3 + row) * 1024 + (pc < 16 ? h * 128 + pc * 8 : 512 + h * 128 + (pc - 16) * 8);
                    glds16(src, smem + ML_RAW + j * 16);
                }
            }
#pragma unroll
            for (int i = 0; i < 4; ++i) glds16(vsrc + (long)(c + 1) * 64 * 1024 + (long)i * 16 * 1024, smem + ML_V0 + (par ^ 1) * 32768 + (i * 512 + tid) * 16);
        }
        unsigned mop[4][4];
#pragma unroll
        for (int tt = 0; tt < 4; ++tt)
#pragma unroll
            for (int j = 0; j < 4; ++j) {
                const bf16_t* mp = mo + (tok0 + tt * 16 + fq * 4 + j) * 1024 + h * 256 + wid * 32 + fr;
                mop[tt][j] = (unsigned)mp[0] | ((unsigned)mp[16] << 16);
            }
        const char* vb = smem + ML_V0 + par * 32768;
        bf16x8 vf[2][2];
#pragma unroll
        for (int ks = 0; ks < 2; ++ks)
#pragma unroll
            for (int et = 0; et < 2; ++et) {
                const int cidx = 2 * wid + et, ch = 2 * cidx + ((fr & 3) >> 1);
                const int r0 = 32 * ks + 8 * fq + (fr >> 2);
                vf[ks][et] = tr_read2(vb + offV(r0, ch) + 8 * (fr & 1), vb + offV(r0 + 4, ch) + 8 * (fr & 1));
            }
#pragma unroll
        for (int ks = 0; ks < 2; ++ks)
#pragma unroll
            for (int tt = 0; tt < 4; ++tt) {
                const bf16x8 sf = *(const bf16x8*)(smem + ML_SW + offSw(tt * 16 + fr, 4 * ks + fq));
                Y[tt][0] = __builtin_amdgcn_mfma_f32_16x16x32_bf16(sf, vf[ks][0], Y[tt][0], 0, 0, 0);
                Y[tt][1] = __builtin_amdgcn_mfma_f32_16x16x32_bf16(sf, vf[ks][1], Y[tt][1], 0, 0, 0);
            }
#pragma unroll
        for (int tt = 0; tt < 4; ++tt) {
            const float4 dv = *(const float4*)(den + tt * 16 + fq * 4);
            const float dd[4] = {dv.x, dv.y, dv.z, dv.w};
#pragma unroll
            for (int j = 0; j < 4; ++j) {
                const float inv = 1.0f / fmaxf(fabsf(dd[j]), 1.0f);
                Y[tt][0][j] *= inv; Y[tt][1][j] *= inv;
                float sq = Y[tt][0][j] * Y[tt][0][j] + Y[tt][1][j] * Y[tt][1][j];
                sq += __shfl_xor(sq, 1); sq += __shfl_xor(sq, 2); sq += __shfl_xor(sq, 4); sq += __shfl_xor(sq, 8);
                if (fr == 0) atomicAdd(&ssq[par * 64 + tt * 16 + fq * 4 + j], sq);
            }
        }
#pragma unroll
        for (int dt = 0; dt < 8; ++dt)
#pragma unroll
            for (int ks = 0; ks < 2; ++ks) {
                const int ch = 2 * dt + ((fr & 3) >> 1);
                const int r0 = 32 * ks + 8 * fq + (fr >> 2);
                const bf16x8 kf = tr_read2(smem + ML_K + offQK(r0, ch) + 8 * (fr & 1), smem + ML_K + offQK(r0 + 4, ch) + 8 * (fr & 1));
                C[dt][0] = __builtin_amdgcn_mfma_f32_16x16x32_bf16(kf, vf[ks][0], C[dt][0], 0, 0, 0);
                C[dt][1] = __builtin_amdgcn_mfma_f32_16x16x32_bf16(kf, vf[ks][1], C[dt][1], 0, 0, 0);
                if (ks == 1 && (dt & 1)) __builtin_amdgcn_sched_barrier(0);
            }
        const float g = gg[par];
#pragma unroll
        for (int dt = 0; dt < 8; ++dt) { C[dt][0] *= g; C[dt][1] *= g; }
        asm volatile("s_waitcnt vmcnt(0)" ::: "memory");
        __syncthreads();
#pragma unroll
        for (int tt = 0; tt < 4; ++tt) {
            const float4 sv = *(const float4*)(ssq + par * 64 + tt * 16 + fq * 4);
            const float ss[4] = {sv.x, sv.y, sv.z, sv.w};
#pragma unroll
            for (int j = 0; j < 4; ++j) {
                const float rstd = rsqrtf(ss[j] * (1.0f / 256.0f) + 1e-6f);
                bf16_t* hp = hm + (tok0 + tt * 16 + fq * 4 + j) * 1024 + h * 256 + wid * 32 + fr;
                const float o0 = Y[tt][0][j] * rstd * gn0 * bf_lo(mop[tt][j]);
                const float o1 = Y[tt][1][j] * rstd * gn1 * bf_hi(mop[tt][j]);
                hp[0] = (bf16_t)(pk_bf16(o0, o0) & 0xffffu); hp[16] = (bf16_t)(pk_bf16(o1, o1) & 0xffffu);
            }
        }
        if (tid < 128) {
            nreg = g * (nreg + nsum[par * 128 + tid]);
            nsum[par * 128 + tid] = 0.f;
            *(bf16_t*)(smem + ML_K + offQK(64, tid >> 3) + (tid & 7) * 2) = (bf16_t)(pk_bf16(nreg, nreg) & 0xffffu);
        }
    }
    __syncthreads();
}

__device__ void swa_items(const Params& p, char* smem, int first, int stride) {
    const int tid = opaque_tid(), lane = tid & 63, wid = tid >> 6, fr = lane & 15, fq = lane >> 4;
    char* ws = p.ws;
    const bf16_t* aq = (const bf16_t*)(ws + OFF_R1);
    const bf16_t* ak = (const bf16_t*)(ws + OFF_AK);
    const bf16_t* avT = (const bf16_t*)(ws + OFF_AV);
    bf16_t* ao = (bf16_t*)(ws + OFF_R0);
    char* kbuf = smem; char* vbuf = smem + 32768;
    for (int item = first; item < 1024; item += stride) {
        const int kvh = item & 1, n = (item >> 1) & 31, b = item >> 6;
        const int hq = kvh * 8 + wid;
        const long tokbase = (long)b * 4096 + n * 128 - 128;
        {
            const int rk = tid >> 3, pck = tid & 7, lck = pck ^ ((rk >> 1) & 7);
            const bf16_t* srck = ak + (tokbase + rk) * 128 + kvh * 64 + lck * 8;
#pragma unroll
            for (int i = 0; i < 4; ++i) glds16(srck + (long)i * 64 * 128, kbuf + (i * 512 + tid) * 16);
            const int rv = tid >> 5, pcv = tid & 31, lcv = pcv ^ (rv & 15);
            const bf16_t* srcv = avT + (long)(kvh * 64 + rv) * T_ + tokbase + lcv * 8;
#pragma unroll
            for (int i = 0; i < 4; ++i) glds16(srcv + (long)i * 16 * T_, vbuf + (i * 512 + tid) * 16);
        }
        const float sink = p.sinks[hq];
        asm volatile("s_waitcnt vmcnt(0)" ::: "memory");
        __syncthreads();
        const int kswz = (fr >> 1) & 7;
#pragma unroll 1
        for (int u = 0; u < 4; ++u) {
            const long tq = (long)b * 4096 + n * 128 + u * 32 + fr;
            const bf16_t* qp = aq + tq * 1024 + hq * 64 + fq * 8;
            const bf16x8 q00 = *(const bf16x8*)(qp), q01 = *(const bf16x8*)(qp + 32);
            const bf16x8 q10 = *(const bf16x8*)(qp + 16 * 1024), q11 = *(const bf16x8*)(qp + 16 * 1024 + 32);
            f32x4 sc[10][2];
#pragma unroll
            for (int r = 0; r < 10; ++r) {
                sc[r][0] = (f32x4){0.f, 0.f, 0.f, 0.f}; sc[r][1] = (f32x4){0.f, 0.f, 0.f, 0.f};
                if (!(n == 0 && (2 * u + r) < 8)) {
                    const char* rowp = kbuf + ((2 * u + r) * 16 + fr) * 128;
                    const bf16x8 k0 = *(const bf16x8*)(rowp + ((fq ^ kswz) * 16)), k1 = *(const bf16x8*)(rowp + (((4 + fq) ^ kswz) * 16));
                    sc[r][0] = __builtin_amdgcn_mfma_f32_16x16x32_bf16(k0, q00, sc[r][0], 0, 0, 0);
                    sc[r][0] = __builtin_amdgcn_mfma_f32_16x16x32_bf16(k1, q01, sc[r][0], 0, 0, 0);
                    sc[r][1] = __builtin_amdgcn_mfma_f32_16x16x32_bf16(k0, q10, sc[r][1], 0, 0, 0);
                    sc[r][1] = __builtin_amdgcn_mfma_f32_16x16x32_bf16(k1, q11, sc[r][1], 0, 0, 0);
                }
            }
            u32x4 pf[2][5]; float linv[2];
#pragma unroll
            for (int nt = 0; nt < 2; ++nt) {
                float m = sink;
#pragma unroll
                for (int r = 0; r < 10; ++r) {
                    const bool tile_ok = !(n == 0 && (2 * u + r) < 8);
#pragma unroll
                    for (int j = 0; j < 4; ++j) {
                        const int delta = (r - nt) * 16 + fq * 4 + j - fr;
                        const bool ok = tile_ok && delta >= 1 && delta <= 128;
                        sc[r][nt][j] = ok ? sc[r][nt][j] : -INFINITY;
                        m = fmaxf(m, sc[r][nt][j]);
                    }
                }
                m = fmaxf(m, __shfl_xor(m, 16)); m = fmaxf(m, __shfl_xor(m, 32));
                float l = 0.f;
#pragma unroll
                for (int s2 = 0; s2 < 5; ++s2) {
                    float e[8];
#pragma unroll
                    for (int j = 0; j < 4; ++j) { e[j] = __expf(sc[2 * s2][nt][j] - m); e[4 + j] = __expf(sc[2 * s2 + 1][nt][j] - m); }
                    l += ((e[0] + e[1]) + (e[2] + e[3])) + ((e[4] + e[5]) + (e[6] + e[7]));
                    u32x4 w; w[0] = pk_bf16(e[0], e[1]); w[1] = pk_bf16(e[2], e[3]); w[2] = pk_bf16(e[4], e[5]); w[3] = pk_bf16(e[6], e[7]);
                    pf[nt][s2] = w;
                }
                l += __shfl_xor(l, 16); l += __shfl_xor(l, 32);
                linv[nt] = 1.0f / (l + __expf(sink - m));
            }
            f32x4 o[4][2];
#pragma unroll
            for (int dt = 0; dt < 4; ++dt) { o[dt][0] = (f32x4){0.f, 0.f, 0.f, 0.f}; o[dt][1] = (f32x4){0.f, 0.f, 0.f, 0.f}; }
#pragma unroll
            for (int s2 = 0; s2 < 5; ++s2) {
                if (!(n == 0 && (2 * u + 2 * s2) < 8)) {
                    const int ca = ((((2 * u + 2 * s2) * 2 + (fq >> 1)) ^ fr) * 16) + (fq & 1) * 8;
                    const int cb = ((((2 * u + 2 * s2 + 1) * 2 + (fq >> 1)) ^ fr) * 16) + (fq & 1) * 8;
                    const bf16x8 p0 = __builtin_bit_cast(bf16x8, pf[0][s2]), p1 = __builtin_bit_cast(bf16x8, pf[1][s2]);
#pragma unroll
                    for (int dt = 0; dt < 4; ++dt) {
                        const char* rowp = vbuf + (dt * 16 + fr) * 512;
                        const u32x2 va = *(const u32x2*)(rowp + ca), vb = *(const u32x2*)(rowp + cb);
                        u32x4 vv; vv[0] = va[0]; vv[1] = va[1]; vv[2] = vb[0]; vv[3] = vb[1];
                        const bf16x8 vf = __builtin_bit_cast(bf16x8, vv);
                        o[dt][0] = __builtin_amdgcn_mfma_f32_16x16x32_bf16(vf, p0, o[dt][0], 0, 0, 0);
                        o[dt][1] = __builtin_amdgcn_mfma_f32_16x16x32_bf16(vf, p1, o[dt][1], 0, 0, 0);
                    }
                }
            }
#pragma unroll
            for (int nt = 0; nt < 2; ++nt) {
                bf16_t* rp = ao + (size_t)(tq + nt * 16) * 1024 + hq * 64 + fq * 4;
#pragma unroll
                for (int dt = 0; dt < 4; ++dt) store_bf16x4(rp + dt * 16, o[dt][nt] * linv[nt]);
            }
        }
        __syncthreads();
    }
}

__device__ void phase2(const Params& p, char* smem, int which = 3) {
    const int G = gridDim.x;
    if (G > 64) {
        if (blockIdx.x < 64) { if (which & 1) mlstm_item(p, smem, blockIdx.x); }
        else { if (which & 2) swa_items(p, smem, blockIdx.x - 64, G - 64); }
    } else {
        for (int it = blockIdx.x; it < 64; it += G) mlstm_item(p, smem, it);
        swa_items(p, smem, blockIdx.x, G);
    }
}

struct EpiP3 {
    const bf16_t* gg; bf16_t* y;
    __device__ __forceinline__ void operator()(const f32x4 (&acc)[2][2][4][2], const pg8::Unit& u, int wr, int wc, int fr, int fq) const {
        const int row0 = u.pm * 256 + wr * 64 + fr, col0 = u.pn * 256 + wc * 32 + fq * 4;
#pragma unroll
        for (int ai = 0; ai < 2; ++ai)
#pragma unroll
            for (int m = 0; m < 4; ++m) {
                const size_t tok = row0 + ai * 128 + m * 16;
#pragma unroll
                for (int bj = 0; bj < 2; ++bj)
#pragma unroll
                    for (int n = 0; n < 2; ++n) {
                        const int col = col0 + bj * 128 + n * 16;
                        const uint2 g = *(const uint2*)(gg + tok * 2048 + (u.aux ? 1024 : 0) + col);
                        f32x4 v;
                        v[0] = bf_lo(g.x) * acc[ai][bj][m][n][0]; v[1] = bf_hi(g.x) * acc[ai][bj][m][n][1];
                        v[2] = bf_lo(g.y) * acc[ai][bj][m][n][2]; v[3] = bf_hi(g.y) * acc[ai][bj][m][n][3];
                        if (u.aux) { const uint2 prev = *(const uint2*)(y + tok * 1024 + col); v[0] += bf_lo(prev.x); v[1] += bf_hi(prev.x); v[2] += bf_lo(prev.y); v[3] += bf_hi(prev.y); }
                        store_bf16x4(y + tok * 1024 + col, v);
                    }
                __builtin_amdgcn_sched_barrier(0);
            }
    }
};
__device__ void phase3(const Params& p, char* smem) {
    char* ws = p.ws;
    SchedN1024<2> S{(int)gridDim.x, (int)blockIdx.x, ws + OFF_R0, ws + OFF_WATT, (const char*)p.out, ws + OFF_WML};
    EpiP3 E{(const bf16_t*)(ws + OFF_GG), (bf16_t*)(ws + OFF_R1)};
    pg8::gemm_phase<EpiP3, SchedN1024<2>>((LDS_AS unsigned char*)smem, 1024, S, E);
}

struct EpiResid {
    const float* resid; float* outz;
    __device__ __forceinline__ void operator()(const f32x4 (&acc)[2][2][4][2], const pg8::Unit& u, int wr, int wc, int fr, int fq) const {
        const int row0 = u.pm * 256 + wr * 64 + fr, col0 = u.pn * 256 + wc * 32 + fq * 4;
#pragma unroll
        for (int ai = 0; ai < 2; ++ai)
#pragma unroll
            for (int m = 0; m < 4; ++m) {
                const size_t tok = row0 + ai * 128 + m * 16;
#pragma unroll
                for (int bj = 0; bj < 2; ++bj)
#pragma unroll
                    for (int n = 0; n < 2; ++n) {
                        const int col = col0 + bj * 128 + n * 16;
                        const float4 r = *(const float4*)(resid + tok * 1024 + col);
                        float4 o; o.x = ALPHA * r.x + acc[ai][bj][m][n][0]; o.y = ALPHA * r.y + acc[ai][bj][m][n][1]; o.z = ALPHA * r.z + acc[ai][bj][m][n][2]; o.w = ALPHA * r.w + acc[ai][bj][m][n][3];
                        *(float4*)(outz + tok * 1024 + col) = o;
                    }
                __builtin_amdgcn_sched_barrier(0);
            }
    }
};
__device__ __forceinline__ void phase_gemm_resid(const Params& p, char* smem, const bf16_t* A, const bf16_t* Bt, const float* resid, float* outz) {
    SchedN1024<1> S{(int)gridDim.x, (int)blockIdx.x, (const char*)A, (const char*)Bt, (const char*)A, (const char*)Bt};
    EpiResid E{resid, outz};
    pg8::gemm_phase<EpiResid, SchedN1024<1>>((LDS_AS unsigned char*)smem, 1024, S, E);
}

struct EpiBf16 {
    bf16_t* outb; float scale;
    __device__ __forceinline__ void operator()(const f32x4 (&acc)[2][2][4][2], const pg8::Unit& u, int wr, int wc, int fr, int fq) const {
        const int row0 = u.pm * 256 + wr * 64 + fr, col0 = u.pn * 256 + wc * 32 + fq * 4;
#pragma unroll
        for (int ai = 0; ai < 2; ++ai)
#pragma unroll
            for (int m = 0; m < 4; ++m) {
                const size_t tok = row0 + ai * 128 + m * 16;
#pragma unroll
                for (int bj = 0; bj < 2; ++bj)
#pragma unroll
                    for (int n = 0; n < 2; ++n) store_bf16x4(outb + tok * 1024 + col0 + bj * 128 + n * 16, acc[ai][bj][m][n] * scale);
            }
    }
};
__device__ __forceinline__ void phase_gemm_bf16(const Params& p, char* smem, const bf16_t* A, const bf16_t* Bt, bf16_t* outb, float scale) {
    SchedN1024<1> S{(int)gridDim.x, (int)blockIdx.x, (const char*)A, (const char*)Bt, (const char*)A, (const char*)Bt};
    EpiBf16 E{outb, scale};
    pg8::gemm_phase<EpiBf16, SchedN1024<1>>((LDS_AS unsigned char*)smem, 1024, S, E);
}

__device__ __forceinline__ void ln_row(float4 (&v)[4], const float* g, const float* bta, int lane) {
    float s = 0.f;
#pragma unroll
    for (int i = 0; i < 4; ++i) s += (v[i].x + v[i].y) + (v[i].z + v[i].w);
    const float mu = wsum(s) * (1.0f / 1024.0f);
    float q = 0.f;
#pragma unroll
    for (int i = 0; i < 4; ++i) { const float a = v[i].x - mu, b = v[i].y - mu, c = v[i].z - mu, d = v[i].w - mu; q += (a * a + b * b) + (c * c + d * d); }
    const float rstd = rsqrtf(wsum(q) * (1.0f / 1024.0f) + 1e-5f);
#pragma unroll
    for (int i = 0; i < 4; ++i) {
        const float4 gg = *(const float4*)(g + i * 256 + lane * 4), bb = *(const float4*)(bta + i * 256 + lane * 4);
        v[i].x = (v[i].x - mu) * rstd * gg.x + bb.x; v[i].y = (v[i].y - mu) * rstd * gg.y + bb.y;
        v[i].z = (v[i].z - mu) * rstd * gg.z + bb.z; v[i].w = (v[i].w - mu) * rstd * gg.w + bb.w;
    }
}

__device__ void phase_ln1(const Params& p) {
    const int tid_ = opaque_tid(); const int lane = tid_ & 63, wid = tid_ >> 6;
    float* z = p.out; bf16_t* hb = (bf16_t*)(p.ws + OFF_R0);
    for (int row = blockIdx.x * 8 + wid; row < T_; row += gridDim.x * 8) {
        float4 v[4];
#pragma unroll
        for (int i = 0; i < 4; ++i) v[i] = *(const float4*)(z + (size_t)row * 1024 + i * 256 + lane * 4);
        ln_row(v, p.ln1g, p.ln1b, lane);
#pragma unroll
        for (int i = 0; i < 4; ++i) {
            *(float4*)(z + (size_t)row * 1024 + i * 256 + lane * 4) = v[i];
            uint2 w; w.x = pk_bf16(v[i].x, v[i].y); w.y = pk_bf16(v[i].z, v[i].w);
            *(uint2*)(hb + (size_t)row * 1024 + i * 256 + lane * 4) = w;
        }
    }
}

__device__ __forceinline__ void xa_stage_k(const bf16_t* kmat, int b, int h, int kh, char* buf, int tid) {
    const int rl = tid >> 5, pc = tid & 31, lc = pc ^ (rl & 15);
    const bf16_t* src = kmat + (size_t)(b * 256 + kh * 128 + rl) * 1024 + h * 256 + lc * 8;
#pragma unroll
    for (int i = 0; i < 8; ++i) glds16(src + (size_t)i * 16 * 1024, buf + (i * 512 + tid) * 16);
}
__device__ __forceinline__ void xa_stage_v(const bf16_t* vT, int b, int h, int vh, char* buf, int tid) {
    const int rl = tid >> 4, pc = tid & 15, lc = pc ^ (rl & 15);
    const bf16_t* src = vT + (size_t)(h * 256 + rl) * 4096 + b * 256 + vh * 128 + lc * 8;
#pragma unroll
    for (int i = 0; i < 8; ++i) glds16(src + (size_t)i * 32 * 4096, buf + (i * 512 + tid) * 16);
}

template <int KH>
__device__ __forceinline__ void xa_scores(f32x4 (&acc)[16][2], const char* buf, const bf16_t* q0p, const bf16_t* q1p, int fr, int fq) {
#pragma unroll 2
    for (int ks = 0; ks < 8; ++ks) {
        const bf16x8 q0 = *(const bf16x8*)(q0p + ks * 32), q1 = *(const bf16x8*)(q1p + ks * 32);
        const int ch = ((ks * 4 + fq) ^ fr) * 16;
#pragma unroll
        for (int mt = 0; mt < 8; ++mt) {
            const bf16x8 kf = *(const bf16x8*)(buf + (mt * 16 + fr) * 512 + ch);
            acc[KH * 8 + mt][0] = __builtin_amdgcn_mfma_f32_16x16x32_bf16(kf, q0, acc[KH * 8 + mt][0], 0, 0, 0);
            acc[KH * 8 + mt][1] = __builtin_amdgcn_mfma_f32_16x16x32_bf16(kf, q1, acc[KH * 8 + mt][1], 0, 0, 0);
        }
    }
}


template <int VH, int DH>
__device__ __forceinline__ void xa_pv(f32x4 (&o)[8][2], const u32x4 (&pf)[2][8], const char* buf, int fr, int fq) {
#pragma unroll
    for (int ks = 0; ks < 4; ++ks) {
        const int ca = ((ks * 4 + (fq >> 1)) ^ fr) * 16 + (fq & 1) * 8, cb = ((ks * 4 + 2 + (fq >> 1)) ^ fr) * 16 + (fq & 1) * 8;
        const bf16x8 p0 = __builtin_bit_cast(bf16x8, pf[0][VH * 4 + ks]), p1 = __builtin_bit_cast(bf16x8, pf[1][VH * 4 + ks]);
#pragma unroll
        for (int dt = 0; dt < 8; ++dt) {
            const char* rowp = buf + ((DH * 8 + dt) * 16 + fr) * 256;
            const u32x2 va = *(const u32x2*)(rowp + ca), vb = *(const u32x2*)(rowp + cb);
            u32x4 vv; vv[0] = va[0]; vv[1] = va[1]; vv[2] = vb[0]; vv[3] = vb[1];
            const bf16x8 vf = __builtin_bit_cast(bf16x8, vv);
            o[dt][0] = __builtin_amdgcn_mfma_f32_16x16x32_bf16(vf, p0, o[dt][0], 0, 0, 0);
            o[dt][1] = __builtin_amdgcn_mfma_f32_16x16x32_bf16(vf, p1, o[dt][1], 0, 0, 0);
        }
    }
}

__device__ void phase6(const Params& p, char* smem) {
    const int tid = opaque_tid(), lane = tid & 63, wid = tid >> 6, fr = lane & 15, fq = lane >> 4;
    char* ws = p.ws;
    const bf16_t* xq = (const bf16_t*)(ws + OFF_XQ);
    const bf16_t* kmat = (const bf16_t*)(ws + OFF_KMAT);
    const bf16_t* vT = (const bf16_t*)(ws + OFF_VT);
    bf16_t* og = (bf16_t*)(ws + OFF_O);
    char* bufA = smem; char* bufB = smem + 65536;
    const int G = gridDim.x;
    for (int idx = blockIdx.x; idx < 1024; idx += G) {
        int pair, qt;
        if (G == 256) { const int i = idx >> 8, blk = idx & 255, xcd = blk & 7, jj = blk >> 3; pair = (i * 8 + xcd) * 2 + (jj >> 4); qt = jj & 15; }
        else { pair = idx >> 4; qt = idx & 15; }
        const int b = pair >> 2, h = pair & 3;
        const int tok0 = b * 4096 + qt * 256 + wid * 32;
        xa_stage_k(kmat, b, h, 0, bufA, tid);
        xa_stage_k(kmat, b, h, 1, bufB, tid);
        const bf16_t* q0p = xq + (size_t)(tok0 + fr) * 1024 + h * 256 + fq * 8;
        const bf16_t* q1p = q0p + (size_t)16 * 1024;
        f32x4 acc[16][2];
#pragma unroll
        for (int mt = 0; mt < 16; ++mt) { acc[mt][0] = (f32x4){0.f, 0.f, 0.f, 0.f}; acc[mt][1] = (f32x4){0.f, 0.f, 0.f, 0.f}; }
        asm volatile("s_waitcnt vmcnt(0)" ::: "memory");
        __syncthreads();
        xa_scores<0>(acc, bufA, q0p, q1p, fr, fq);
        xa_scores<1>(acc, bufB, q0p, q1p, fr, fq);
        __syncthreads();
        xa_stage_v(vT, b, h, 0, bufA, tid);
        xa_stage_v(vT, b, h, 1, bufB, tid);
        u32x4 pf[2][8]; float linv[2];
#pragma unroll
        for (int nt = 0; nt < 2; ++nt) {
            float m = -INFINITY;
#pragma unroll
            for (int mt = 0; mt < 16; ++mt) m = fmaxf(m, fmaxf(fmaxf(acc[mt][nt][0], acc[mt][nt][1]), fmaxf(acc[mt][nt][2], acc[mt][nt][3])));
            m = fmaxf(m, __shfl_xor(m, 16)); m = fmaxf(m, __shfl_xor(m, 32));
            float l = 0.f;
#pragma unroll
            for (int s2 = 0; s2 < 8; ++s2) {
                float e[8];
#pragma unroll
                for (int j = 0; j < 4; ++j) { e[j] = __expf(acc[2 * s2][nt][j] - m); e[4 + j] = __expf(acc[2 * s2 + 1][nt][j] - m); }
                l += ((e[0] + e[1]) + (e[2] + e[3])) + ((e[4] + e[5]) + (e[6] + e[7]));
                u32x4 w; w[0] = pk_bf16(e[0], e[1]); w[1] = pk_bf16(e[2], e[3]); w[2] = pk_bf16(e[4], e[5]); w[3] = pk_bf16(e[6], e[7]);
                pf[nt][s2] = w;
            }
            l += __shfl_xor(l, 16); l += __shfl_xor(l, 32);
            linv[nt] = 1.0f / l;
        }
        asm volatile("s_waitcnt vmcnt(0)" ::: "memory");
        __syncthreads();
        {
            f32x4 o[8][2];
#pragma unroll
            for (int dt = 0; dt < 8; ++dt) { o[dt][0] = (f32x4){0.f, 0.f, 0.f, 0.f}; o[dt][1] = (f32x4){0.f, 0.f, 0.f, 0.f}; }
            xa_pv<0, 0>(o, pf, bufA, fr, fq);
            xa_pv<1, 0>(o, pf, bufB, fr, fq);
#pragma unroll
            for (int nt = 0; nt < 2; ++nt) {
                bf16_t* rp = og + (size_t)(tok0 + nt * 16 + fr) * 1024 + h * 256 + fq * 4;
#pragma unroll
                for (int dt = 0; dt < 8; ++dt) store_bf16x4(rp + dt * 16, o[dt][nt] * linv[nt]);
            }
        }
        {
            f32x4 o[8][2];
#pragma unroll
            for (int dt = 0; dt < 8; ++dt) { o[dt][0] = (f32x4){0.f, 0.f, 0.f, 0.f}; o[dt][1] = (f32x4){0.f, 0.f, 0.f, 0.f}; }
            xa_pv<0, 1>(o, pf, bufA, fr, fq);
            xa_pv<1, 1>(o, pf, bufB, fr, fq);
#pragma unroll
            for (int nt = 0; nt < 2; ++nt) {
                bf16_t* rp = og + (size_t)(tok0 + nt * 16 + fr) * 1024 + h * 256 + 128 + fq * 4;
#pragma unroll
                for (int dt = 0; dt < 8; ++dt) store_bf16x4(rp + dt * 16, o[dt][nt] * linv[nt]);
            }
        }
        __syncthreads();
    }
}

__device__ void phase_ln2_router(const Params& p, char* smem) {
    const int tid = opaque_tid(), lane = tid & 63, wid = tid >> 6;
    char* ws = p.ws;
    float* z = (float*)(ws + OFF_Z2); bf16_t* hb = (bf16_t*)(ws + OFF_R0);
    int2* toke = (int2*)(ws + OFF_TOKE); float2* tokw = (float2*)(ws + OFF_TOKW);
    int* histg = (int*)(ws + OFF_HIST);
    int* hist = (int*)smem;
    for (int c = blockIdx.x; c < 256; c += gridDim.x) {
        if (tid < 64) hist[tid] = 0;
        __syncthreads();
        for (int rr = 0; rr < 32; ++rr) {
            const int row = c * 256 + wid * 32 + rr;
            float4 v[4];
#pragma unroll
            for (int i = 0; i < 4; ++i) v[i] = *(const float4*)(z + (size_t)row * 1024 + i * 256 + lane * 4);
            ln_row(v, p.ln2g, p.ln2b, lane);
#pragma unroll
            for (int i = 0; i < 4; ++i) {
                *(float4*)(z + (size_t)row * 1024 + i * 256 + lane * 4) = v[i];
                uint2 w; w.x = pk_bf16(v[i].x, v[i].y); w.y = pk_bf16(v[i].z, v[i].w);
                *(uint2*)(hb + (size_t)row * 1024 + i * 256 + lane * 4) = w;
            }
            float g[8];
#pragma unroll
            for (int k = 0; k < 8; ++k) g[k] = 0.f;
#pragma unroll
            for (int i = 0; i < 4; ++i) {
                const float vv[4] = {v[i].x, v[i].y, v[i].z, v[i].w};
#pragma unroll
                for (int jj = 0; jj < 4; ++jj) {
                    const float4* wp = (const float4*)(p.w_rg + (size_t)(i * 256 + lane * 4 + jj) * 8);
                    const float4 w0 = wp[0], w1 = wp[1];
                    g[0] += vv[jj] * w0.x; g[1] += vv[jj] * w0.y; g[2] += vv[jj] * w0.z; g[3] += vv[jj] * w0.w;
                    g[4] += vv[jj] * w1.x; g[5] += vv[jj] * w1.y; g[6] += vv[jj] * w1.z; g[7] += vv[jj] * w1.w;
                }
            }
            float gmax = -INFINITY; int gsel = 0;
#pragma unroll
            for (int k = 0; k < 8; ++k) { g[k] = wsum(g[k]) + p.b_rg[k]; if (g[k] > gmax) { gmax = g[k]; gsel = k; } }
            float gs = 0.f;
#pragma unroll
            for (int k = 0; k < 8; ++k) gs += __expf(g[k] - gmax);
            const float pgroup = 1.0f / gs;
            gsel = __builtin_amdgcn_readfirstlane(gsel);
            float ex[8];
#pragma unroll
            for (int k = 0; k < 8; ++k) ex[k] = 0.f;
#pragma unroll
            for (int i = 0; i < 4; ++i) {
                const float vv[4] = {v[i].x, v[i].y, v[i].z, v[i].w};
#pragma unroll
                for (int jj = 0; jj < 4; ++jj) {
                    const float4* wp = (const float4*)(p.w_re + (size_t)(i * 256 + lane * 4 + jj) * 64 + gsel * 8);
                    const float4 w0 = wp[0], w1 = wp[1];
                    ex[0] += vv[jj] * w0.x; ex[1] += vv[jj] * w0.y; ex[2] += vv[jj] * w0.z; ex[3] += vv[jj] * w0.w;
                    ex[4] += vv[jj] * w1.x; ex[5] += vv[jj] * w1.y; ex[6] += vv[jj] * w1.z; ex[7] += vv[jj] * w1.w;
                }
            }
            float v0 = -INFINITY, v1 = -INFINITY; int i0 = 0, i1 = 0;
#pragma unroll
            for (int k = 0; k < 8; ++k) {
                const float lv = wsum(ex[k]) + p.b_re[gsel * 8 + k];
                if (lv > v0) { v1 = v0; i1 = i0; v0 = lv; i0 = k; }
                else if (lv > v1) { v1 = lv; i1 = k; }
            }
            const float e1 = __expf(v1 - v0), den = 1.0f + e1;
            const float w0 = pgroup / den, w1 = pgroup * e1 / den;
            if (lane == 0) {
                const int ea = gsel * 8 + i0, eb = gsel * 8 + i1;
                toke[row] = make_int2(ea, eb); tokw[row] = make_float2(w0, w1);
                atomicAdd(&hist[ea], 1); atomicAdd(&hist[eb], 1);
            }
        }
        __syncthreads();
        if (tid < 64) histg[c * 64 + tid] = hist[tid];
        __syncthreads();
    }
}

__device__ void compute_segments(const int* histg, int* seg, int tid) {
    if (tid < 64) {
        int s = 0;
        for (int c = 0; c < 256; ++c) s += histg[c * 64 + tid];
        seg[tid] = s;
    }
    __syncthreads();
    if (tid == 0) {
        int acc = 0;
        for (int e = 0; e < 64; ++e) { seg[64 + e] = acc; acc += (seg[e] + 255) >> 8; }
        seg[128] = acc;
    }
    __syncthreads();
}

__device__ void phase8(const Params& p, char* smem) {
    const int tid = opaque_tid();
    char* ws = p.ws;
    const int* histg = (const int*)(ws + OFF_HIST);
    const int2* toke = (const int2*)(ws + OFF_TOKE); const float2* tokw = (const float2*)(ws + OFF_TOKW);
    int* slot_tok = (int*)(ws + OFF_SLOTTOK); float* slot_w = (float*)(ws + OFF_SLOTW);
    int* seg = (int*)smem;
    int* cursor = seg + 192;
    compute_segments(histg, seg, tid);
    for (int e = blockIdx.x; e < 64; e += gridDim.x) {
        const int start = seg[64 + e] * 256 + seg[e], end = seg[64 + e + 1] * 256;
        for (int s = start + tid; s < end; s += NTHR) { slot_tok[s] = -1; slot_w[s] = 0.f; }
    }
    for (int c = blockIdx.x; c < 256; c += gridDim.x) {
        __syncthreads();
        if (tid < 64) {
            int base = 0;
            for (int cc = 0; cc < c; ++cc) base += histg[cc * 64 + tid];
            cursor[tid] = seg[64 + tid] * 256 + base;
        }
        __syncthreads();
        if (tid < 256) {
            const int tok = c * 256 + tid;
            const int2 ee = toke[tok]; const float2 ww = tokw[tok];
            const int s0 = atomicAdd(&cursor[ee.x], 1);
            const int s1 = atomicAdd(&cursor[ee.y], 1);
            slot_tok[s0] = tok * 2; slot_w[s0] = ww.x;
            slot_tok[s1] = tok * 2 + 1; slot_w[s1] = ww.y;
        }
    }
}

__device__ void phase9a(const Params& p, char* smem) {
    const int tid = opaque_tid(), lane = tid & 63, wid = tid >> 6, wr = wid >> 1, wc = wid & 1, fr = lane & 15, fq = lane >> 4;
    char* ws = p.ws;
    int* seg = (int*)(smem + LDS_GEMM);
    compute_segments((const int*)(ws + OFF_HIST), seg, tid);
    const int nrt = seg[128];
    const int* slot_tok = (const int*)(ws + OFF_SLOTTOK);
    const bf16_t* h2b = (const bf16_t*)(ws + OFF_R0);
    bf16_t* hbuf = (bf16_t*)(ws + OFF_R1);
    for (int it = 0;; ++it) {
        int t;
        if (!xcd_item(it, nrt * 4, t)) break;
        const int rtile = t >> 2, nt = t & 3;
        int e = 0;
        for (int k = 1; k < 64; ++k) if (seg[64 + k] <= rtile) e = k;
        GemmSrc s;
        {
            const int r = tid >> 3, lc = (tid & 7) ^ ((r >> 1) & 7);
#pragma unroll
            for (int i = 0; i < 4; ++i) {
                const int tk = slot_tok[rtile * 256 + i * 64 + r];
                const int tok = tk < 0 ? 0 : (tk >> 1);
                s.a[i] = h2b + (size_t)tok * 1024 + lc * 8;
            }
#pragma unroll
            for (int i = 0; i < 2; ++i) s.b[i] = (const bf16_t*)(ws + OFF_WGU) + (size_t)e * 512 * 1024 + (size_t)(nt * 128 + i * 64 + r) * 1024 + lc * 8;
        }
        f32x4 acc[4][4]; zero_acc(acc);
        gemm_loop(acc, s, 16, smem, tid);
        const int row0 = rtile * 256 + wr * 64 + fr;
        const int colb = (nt * 2 + wc) * 32 + fq * 4;
#pragma unroll
        for (int m = 0; m < 4; ++m) {
            const size_t slot = row0 + m * 16;
#pragma unroll
            for (int n = 0; n < 2; ++n) {
                const f32x4 g = acc[m][n], u = acc[m][n + 2];
                f32x4 v;
#pragma unroll
                for (int j = 0; j < 4; ++j) v[j] = g[j] * sigmoidf_(g[j]) * u[j];
                store_bf16x4(hbuf + slot * 256 + colb + n * 16, v);
            }
        }
    }
}

struct Sched9b {
    int G, c, nrt; const int* seg; const char* hbuf; const char* wd;
    __device__ __forceinline__ bool next(int i, pg8::Unit& u) const {
        int rtile, pn;
        if ((G & 7) == 0) { const int x = c & 7, j = c >> 3, nj = G >> 3, per = (nrt + 7) >> 3; const int uidx = i * nj + j; if (uidx >= per * 4) return false; rtile = x * per + (uidx >> 2); pn = uidx & 3; if (rtile >= nrt) return false; }
        else { const int uidx = i * G + c; if (uidx >= nrt * 4) return false; rtile = uidx >> 2; pn = uidx & 3; }
        int e = 0;
        for (int k = 1; k < 64; ++k) if (seg[64 + k] <= rtile) e = k;
        u.pm = rtile; u.pn = pn; u.aux = e; u.A = hbuf; u.Bt = wd + (size_t)e * 1024 * 256 * 2;
        return true;
    }
};
struct Epi9b {
    const int* slot_tok; const float* slot_w; bf16_t* yb;
    __device__ __forceinline__ void operator()(const f32x4 (&acc)[2][2][4][2], const pg8::Unit& u, int wr, int wc, int fr, int fq) const {
        const int row0 = u.pm * 256 + wr * 64 + fr, col0 = u.pn * 256 + wc * 32 + fq * 4;
#pragma unroll
        for (int ai = 0; ai < 2; ++ai)
#pragma unroll
            for (int m = 0; m < 4; ++m) {
                const int slot = row0 + ai * 128 + m * 16;
                const int tk = slot_tok[slot]; const float w = slot_w[slot];
                if (tk >= 0) {
#pragma unroll
                    for (int bj = 0; bj < 2; ++bj)
#pragma unroll
                        for (int n = 0; n < 2; ++n) store_bf16x4(yb + (size_t)tk * 1024 + col0 + bj * 128 + n * 16, acc[ai][bj][m][n] * w);
                }
            }
    }
};
__device__ void phase9b(const Params& p, char* smem) {
    const int tid = opaque_tid();
    char* ws = p.ws;
    int* seg = (int*)(smem + LDS_GEMM);
    compute_segments((const int*)(ws + OFF_HIST), seg, tid);
    Sched9b S{(int)gridDim.x, (int)blockIdx.x, seg[128], seg, ws + OFF_R1, ws + OFF_WD};
    Epi9b E{(const int*)(ws + OFF_SLOTTOK), (const float*)(ws + OFF_SLOTW), (bf16_t*)(ws + OFF_YB)};
    pg8::gemm_phase<Epi9b, Sched9b>((LDS_AS unsigned char*)smem, 256, S, E);
}

__device__ void phase10(const Params& p) {
    const int tid_ = opaque_tid(); const int lane = tid_ & 63, wid = tid_ >> 6;
    const float* h2 = (const float*)(p.ws + OFF_Z2); const bf16_t* yb = (const bf16_t*)(p.ws + OFF_YB);
    for (int row = blockIdx.x * 8 + wid; row < T_; row += gridDim.x * 8) {
        float4 v[4];
#pragma unroll
        for (int i = 0; i < 4; ++i) {
            const float4 hh = *(const float4*)(h2 + (size_t)row * 1024 + i * 256 + lane * 4);
            const uint2 a = *(const uint2*)(yb + (size_t)(row * 2) * 1024 + i * 256 + lane * 4), b = *(const uint2*)(yb + (size_t)(row * 2 + 1) * 1024 + i * 256 + lane * 4);
            v[i].x = ALPHA * hh.x + bf_lo(a.x) + bf_lo(b.x); v[i].y = ALPHA * hh.y + bf_hi(a.x) + bf_hi(b.x);
            v[i].z = ALPHA * hh.z + bf_lo(a.y) + bf_lo(b.y); v[i].w = ALPHA * hh.w + bf_hi(a.y) + bf_hi(b.y);
        }
        ln_row(v, p.ln3g, p.ln3b, lane);
#pragma unroll
        for (int i = 0; i < 4; ++i) *(float4*)(p.out + (size_t)row * 1024 + i * 256 + lane * 4) = v[i];
    }
}

#ifndef DUP
#define DUP (-1)
#endif
#define RUN(id, call) do { call; if (DUP == (id)) { grid.sync(); call; } } while (0)
__global__ void __launch_bounds__(NTHR) mega(Params p) {
    extern __shared__ __attribute__((aligned(16))) char smem[];
    cg::grid_group grid = cg::this_grid();
    char* ws = p.ws;
    RUN(0, phase0(p, smem));
    grid.sync();
    RUN(1, phase1(p, smem));
    grid.sync();
    RUN(2, phase2(p, smem));
    if (DUP == 20) { grid.sync(); phase2(p, smem, 1); }
    if (DUP == 21) { grid.sync(); phase2(p, smem, 2); }
    grid.sync();
    RUN(3, phase3(p, smem));
    grid.sync();
    RUN(4, phase_gemm_resid(p, smem, (const bf16_t*)(ws + OFF_R1), (const bf16_t*)(ws + OFF_WMIX), p.x, p.out));
    grid.sync();
    phase_ln1(p);
    RUN(5, moe_weight_prep(p, smem));
    grid.sync();
    RUN(6, phase_gemm_bf16(p, smem, (const bf16_t*)(ws + OFF_R0), (const bf16_t*)(ws + OFF_WXQ), (bf16_t*)(ws + OFF_XQ), 0.0625f));
    grid.sync();
    RUN(7, phase6(p, smem));
    grid.sync();
    RUN(8, phase_gemm_resid(p, smem, (const bf16_t*)(ws + OFF_O), (const bf16_t*)(ws + OFF_WXO), p.out, (float*)(ws + OFF_Z2)));
    grid.sync();
    phase_ln2_router(p, smem);
    grid.sync();
    RUN(9, phase8(p, smem));
    grid.sync();
    RUN(10, phase9a(p, smem));
    grid.sync();
    RUN(11, phase9b(p, smem));
    grid.sync();
    phase10(p);
}

extern "C" void kernel_launch(void* const* d_in, const int* in_sizes, int n_in, void* d_out, int out_size,
                              void* d_ws, size_t ws_size, hipStream_t stream) {
    static int grid_blocks = 0;
    if (!grid_blocks) {
        int dev = 0, cus = 0, per_cu = 0;
        (void)hipGetDevice(&dev);
        (void)hipDeviceGetAttribute(&cus, hipDeviceAttributeMultiprocessorCount, dev);
        (void)hipFuncSetAttribute((const void*)mega, hipFuncAttributeMaxDynamicSharedMemorySize, LDS_BYTES);
        (void)hipOccupancyMaxActiveBlocksPerMultiprocessor(&per_cu, mega, NTHR, LDS_BYTES);
        if (per_cu > 1) per_cu = 1;
        grid_blocks = cus * per_cu;
        if (ws_size < WS_NEED) fprintf(stderr, "workspace too small: %zu\n", ws_size);
    }
    Params p{};
    const float* const* f = (const float* const*)d_in;
    p.x = f[0]; p.mem = f[1]; p.pos = (const int*)d_in[2];
    p.w_in = f[3]; p.sinks = f[4]; p.conv_w = f[5]; p.conv_b = f[6]; p.b_ig = f[7]; p.b_fg = f[8]; p.ml_g = f[9];
    p.w_att = f[10]; p.w_ml = f[11]; p.w_mix = f[12]; p.ln1g = f[13]; p.ln1b = f[14];
    p.w_xq = f[15]; p.w_xkv = f[16]; p.w_xo = f[17]; p.ln2g = f[18]; p.ln2b = f[19];
    p.w_rg = f[20]; p.b_rg = f[21]; p.w_re = f[22]; p.b_re = f[23]; p.w_gate = f[24]; p.w_up = f[25]; p.w_down = f[26];
    p.ln3g = f[27]; p.ln3b = f[28];
    p.out = (float*)d_out; p.ws = (char*)d_ws;
    void* args[] = {&p};
    hipError_t e = hipLaunchCooperativeKernel((void*)mega, dim3(grid_blocks), dim3(NTHR), args, LDS_BYTES, stream);
    if (e != hipSuccess) fprintf(stderr, "cooperative launch failed: %s (grid %d)\n", hipGetErrorString(e), grid_blocks);
}
```

```cpp
#include <hip/hip_runtime.h>
#include <hip/hip_cooperative_groups.h>
#include <cstdio>
#include <cstdint>
namespace cg = cooperative_groups;

typedef unsigned short bf16_t;
typedef short bf16x8 __attribute__((ext_vector_type(8)));
typedef float f32x4 __attribute__((ext_vector_type(4)));
typedef unsigned u32x2 __attribute__((ext_vector_type(2)));
typedef unsigned u32x4 __attribute__((ext_vector_type(4)));
#define LDS_AS __attribute__((address_space(3)))
#define GLB_AS __attribute__((address_space(1)))

constexpr int T_ = 65536;
constexpr int NTHR = 512;
constexpr size_t MiB = 1ull << 20;
constexpr float ALPHA = 1.189207115002721f;
constexpr size_t OFF_R0 = 0;
constexpr size_t OFF_R1 = 128 * MiB;
constexpr size_t OFF_AK = 256 * MiB;
constexpr size_t OFF_AV = 272 * MiB;
constexpr size_t OFF_MQK = 288 * MiB;
constexpr size_t OFF_MV = 416 * MiB;
constexpr size_t OFF_MO = 544 * MiB;
constexpr size_t OFF_GG = 672 * MiB;
constexpr size_t OFF_WGU = 256 * MiB;
constexpr size_t OFF_WD = 320 * MiB;
constexpr size_t OFF_XQ = 352 * MiB;
constexpr size_t OFF_O = 480 * MiB;
constexpr size_t OFF_Z2 = 608 * MiB;
constexpr size_t OFF_YB = 352 * MiB;
constexpr size_t OFF_MISC = 928 * MiB;
constexpr size_t OFF_WIN = OFF_MISC;
constexpr size_t OFF_WATT = OFF_MISC + 13 * MiB;
constexpr size_t OFF_WML = OFF_MISC + 15 * MiB;
constexpr size_t OFF_WMIX = OFF_MISC + 17 * MiB;
constexpr size_t OFF_WXQ = OFF_MISC + 19 * MiB;
constexpr size_t OFF_WXO = OFF_MISC + 21 * MiB;
constexpr size_t OFF_WXKV = OFF_MISC + 23 * MiB;
constexpr size_t OFF_MEMB = OFF_MISC + 27 * MiB;
constexpr size_t OFF_KMAT = OFF_MISC + 35 * MiB;
constexpr size_t OFF_VT = OFF_MISC + 43 * MiB;
constexpr size_t OFF_GATES = OFF_MISC + 51 * MiB;
constexpr size_t OFF_CS = OFF_MISC + 53 * MiB;
constexpr size_t OFF_TOKE = OFF_MISC + 69 * MiB;
constexpr size_t OFF_TOKW = OFF_MISC + 70 * MiB;
constexpr size_t OFF_SLOTTOK = OFF_MISC + 71 * MiB;
constexpr size_t OFF_SLOTW = OFF_MISC + 72 * MiB;
constexpr size_t OFF_HIST = OFF_MISC + 73 * MiB;
constexpr size_t OFF_BAR = OFF_MISC + 74 * MiB;
constexpr size_t WS_NEED = 1024 * MiB;
constexpr int LDS_GEMM = 147456;
constexpr int LDS_XB = 150016;
constexpr int LDS_BYTES = 150528;

struct Params {
    const float *x, *mem; const int* pos;
    const float *w_in, *sinks, *conv_w, *conv_b, *b_ig, *b_fg, *ml_g, *w_att, *w_ml, *w_mix, *ln1g, *ln1b;
    const float *w_xq, *w_xkv, *w_xo, *ln2g, *ln2b, *w_rg, *b_rg, *w_re, *b_re, *w_gate, *w_up, *w_down, *ln3g, *ln3b;
    float* out; char* ws;
};

__device__ const double INV_FREQ[32] = {1.0, 0.7498942093324559, 0.5623413251903491, 0.4216965034285822, 0.31622776601683794, 0.23713737056616552, 0.1778279410038923, 0.1333521432163324, 0.1, 0.07498942093324558, 0.05623413251903491, 0.042169650342858224, 0.03162277660168379, 0.023713737056616554, 0.01778279410038923, 0.01333521432163324, 0.01, 0.007498942093324558, 0.005623413251903491, 0.004216965034285823, 0.0031622776601683794, 0.0023713737056616554, 0.0017782794100389228, 0.001333521432163324, 0.001, 0.0007498942093324559, 0.0005623413251903491, 0.00042169650342858224, 0.00031622776601683794, 0.00023713737056616554, 0.00017782794100389227, 0.0001333521432163324};

__device__ __forceinline__ int opaque_tid() { int t = threadIdx.x; asm volatile("" : "+v"(t)); return t; }
__device__ __forceinline__ unsigned pk_bf16(float lo, float hi) { unsigned r; asm("v_cvt_pk_bf16_f32 %0, %1, %2" : "=v"(r) : "v"(lo), "v"(hi)); return r; }
__device__ __forceinline__ float bf_lo(unsigned u) { return __uint_as_float(u << 16); }
__device__ __forceinline__ float bf_hi(unsigned u) { return __uint_as_float(u & 0xffff0000u); }
__device__ __forceinline__ float bf2f(bf16_t h) { return __uint_as_float(((unsigned)h) << 16); }
__device__ __forceinline__ float wsum(float v) {
#pragma unroll
    for (int o = 32; o; o >>= 1) v += __shfl_xor(v, o);
    return v;
}
__device__ __forceinline__ float wmaxf(float v) {
#pragma unroll
    for (int o = 32; o; o >>= 1) v = fmaxf(v, __shfl_xor(v, o));
    return v;
}
__device__ __forceinline__ float sigmoidf_(float x) { return 1.0f / (1.0f + __expf(-x)); }
__device__ __forceinline__ void glds16(const bf16_t* g, char* l) {
    __builtin_amdgcn_global_load_lds((const GLB_AS void*)g, (LDS_AS void*)l, 16, 0, 0);
}

__device__ __forceinline__ bool xcd_item(int i, int n, int& item) {
    const int G = gridDim.x;
    if ((G & 7) == 0) {
        const int x = blockIdx.x & 7, j = blockIdx.x >> 3, nj = G >> 3;
        const int per = (n + 7) >> 3;
        const int u = i * nj + j;
        if (u >= per) return false;
        item = x * per + u;
        return item < n;
    }
    item = blockIdx.x + i * G;
    return item < n;
}

struct GemmSrc { const bf16_t* a[4]; const bf16_t* b[2]; };

__device__ __forceinline__ void stage_tile(const GemmSrc& s, int koff, char* buf, int tid) {
#pragma unroll
    for (int i = 0; i < 4; ++i) glds16(s.a[i] + koff, buf + (i * 512 + tid) * 16);
#pragma unroll
    for (int i = 0; i < 2; ++i) glds16(s.b[i] + koff, buf + 32768 + (i * 512 + tid) * 16);
}

constexpr int GEMM_STAGE = 49152;
__device__ __forceinline__ void gemm_loop(f32x4 (&acc)[4][4], const GemmSrc& s, int nk, char* smem, int tid) {
    const int lane = tid & 63, wid = tid >> 6, wr = wid >> 1, wc = wid & 1, fr = lane & 15, fq = lane >> 4;
    const int swz = (fr >> 1) & 7;
    const int aoff = (wr * 64 + fr) * 128;
    const int boff = 32768 + (wc * 64 + fr) * 128;
    stage_tile(s, 0, smem, tid);
    if (nk > 1) stage_tile(s, 64, smem + GEMM_STAGE, tid);
    int cur = 0, nxt = 2;
#pragma unroll 1
    for (int t = 0; t < nk; ++t) {
        if (t + 1 < nk) asm volatile("s_waitcnt vmcnt(6)" ::: "memory"); else asm volatile("s_waitcnt vmcnt(0)" ::: "memory");
        __builtin_amdgcn_s_barrier();
        if (t + 2 < nk) stage_tile(s, (t + 2) * 64, smem + nxt * GEMM_STAGE, tid);
        const char* cb = smem + cur * GEMM_STAGE;
#pragma unroll
        for (int ks = 0; ks < 2; ++ks) {
            const int ch = ((ks * 4 + fq) ^ swz) * 16;
            bf16x8 xa[4], wb[4];
#pragma unroll
            for (int m = 0; m < 4; ++m) xa[m] = *(const bf16x8*)(cb + aoff + m * 2048 + ch);
#pragma unroll
            for (int n = 0; n < 4; ++n) wb[n] = *(const bf16x8*)(cb + boff + n * 2048 + ch);
#pragma unroll
            for (int m = 0; m < 4; ++m)
#pragma unroll
                for (int n = 0; n < 4; ++n) acc[m][n] = __builtin_amdgcn_mfma_f32_16x16x32_bf16(wb[n], xa[m], acc[m][n], 0, 0, 0);
        }
        cur = cur == 2 ? 0 : cur + 1; nxt = nxt == 2 ? 0 : nxt + 1;
    }
    __syncthreads();
}

__device__ __forceinline__ void zero_acc(f32x4 (&acc)[4][4]) {
#pragma unroll
    for (int m = 0; m < 4; ++m)
#pragma unroll
        for (int n = 0; n < 4; ++n) acc[m][n] = (f32x4){0.f, 0.f, 0.f, 0.f};
}

__device__ __forceinline__ void make_src(GemmSrc& s, const bf16_t* A, size_t lda, int rowA0, const bf16_t* Bt, size_t ldb, int rowB0, int tid) {
    const int r = tid >> 3, lc = (tid & 7) ^ ((r >> 1) & 7);
#pragma unroll
    for (int i = 0; i < 4; ++i) s.a[i] = A + (size_t)(rowA0 + i * 64 + r) * lda + lc * 8;
#pragma unroll
    for (int i = 0; i < 2; ++i) s.b[i] = Bt + (size_t)(rowB0 + i * 64 + r) * ldb + lc * 8;
}

__device__ __forceinline__ void store_bf16x8(bf16_t* p, f32x4 a, f32x4 b) {
    u32x4 w; w[0] = pk_bf16(a[0], a[1]); w[1] = pk_bf16(a[2], a[3]); w[2] = pk_bf16(b[0], b[1]); w[3] = pk_bf16(b[2], b[3]); *(u32x4*)p = w;
}
__device__ __forceinline__ void store_bf16x4(bf16_t* p, f32x4 v) {
    uint2 w; w.x = pk_bf16(v[0], v[1]); w.y = pk_bf16(v[2], v[3]); *(uint2*)p = w;
}

namespace pg8 {
constexpr int BM = 256, BK = 64, HALF = 128, HTB = HALF * BK * 2;
__device__ __forceinline__ int lds_byte(int r, int c) { const int st = (r >> 4) * 2 + (c >> 5), rr = r & 15, cc = c & 31, ob = rr * 64 + cc * 2; return st * 1024 + (ob ^ (((ob >> 9) & 1) << 5)); }
__device__ __forceinline__ void stage_rc(int b, int& R, int& C) { const int st = b / 1024, sb = b % 1024, swz = sb ^ (((sb >> 9) & 1) << 5); R = (st >> 1) * 16 + swz / 64; C = (st & 1) * 32 + (swz % 64) / 2; }
struct Unit { int pm, pn, aux; const char* A; const char* Bt; };

template <class Epi, class Sched>
__device__ __forceinline__ void gemm_phase(LDS_AS unsigned char* lds, const int K, const Sched& S, const Epi& E) {
    const int tid = opaque_tid(), wid = __builtin_amdgcn_readfirstlane(tid >> 6), lane = tid & 63, wr = wid >> 2, wc = wid & 3, fr = lane & 15, fq = lane >> 4;
    const int nt = K / BK;
    unsigned voff[2];
#pragma unroll
    for (int i = 0; i < 2; ++i) { int R, C; stage_rc(tid * 16 + i * 8192, R, C); voff[i] = (unsigned)(R * K + C) * 2u; }
    const size_t kstep = (size_t)(BK * 2);
    const size_t hstep = (size_t)HALF * K * 2;
    const size_t tstep = 2 * hstep;
    const unsigned ldsw = (unsigned)wid * 1024u;
    const int aoff = lds_byte(wr * 64 + fr, fq * 8), boff = lds_byte(wc * 32 + fr, fq * 8);
#define PG8_SA(b, h) (((b) * 2 + (h)) * HTB)
#define PG8_SB(b, h) ((4 + (b) * 2 + (h)) * HTB)
#define PG8_STAGE(bufoff, gbase) do { _Pragma("unroll") for (int _i = 0; _i < 2; ++_i) \
        __builtin_amdgcn_global_load_lds((const GLB_AS void*)((const char*)(gbase) + voff[_i]), (LDS_AS void*)(lds + (bufoff) + ldsw + _i * 8192), 16, 0, 0); } while (0)
#define PG8_LDA(dst, b, h) do { _Pragma("unroll") for (int m = 0; m < 4; ++m) _Pragma("unroll") for (int k = 0; k < 2; ++k) dst[m][k] = *(const LDS_AS bf16x8*)(lds + PG8_SA(b, h) + aoff + m * 2048 + k * 1024); } while (0)
#define PG8_LDB(dst, b, h) do { _Pragma("unroll") for (int n = 0; n < 2; ++n) _Pragma("unroll") for (int k = 0; k < 2; ++k) dst[n][k] = *(const LDS_AS bf16x8*)(lds + PG8_SB(b, h) + boff + n * 2048 + k * 1024); } while (0)
#define PG8_MMA(ai, bj, At, Bt) do { __builtin_amdgcn_s_setprio(1); _Pragma("unroll") for (int m = 0; m < 4; ++m) _Pragma("unroll") for (int n = 0; n < 2; ++n) _Pragma("unroll") for (int k = 0; k < 2; ++k) \
        acc[ai][bj][m][n] = __builtin_amdgcn_mfma_f32_16x16x32_bf16(Bt[n][k], At[m][k], acc[ai][bj][m][n], 0, 0, 0); __builtin_amdgcn_s_setprio(0); } while (0)
#define PG8_WAIT_V(n) asm volatile("s_waitcnt vmcnt(" #n ")" ::: "memory")
#define PG8_WAIT_L(n) asm volatile("s_waitcnt lgkmcnt(" #n ")" ::: "memory")
#define PG8_BAR __builtin_amdgcn_s_barrier()
#define PG8_SCHED __builtin_amdgcn_sched_barrier(0)
    Unit cur, nxt; int ui = 0;
    if (!S.next(0, cur)) return;
    f32x4 acc[2][2][4][2];
#pragma unroll
    for (int a = 0; a < 2; ++a)
#pragma unroll
        for (int b = 0; b < 2; ++b)
#pragma unroll
            for (int m = 0; m < 4; ++m)
#pragma unroll
                for (int n = 0; n < 2; ++n) acc[a][b][m][n] = (f32x4){0.f, 0.f, 0.f, 0.f};
    bf16x8 At[4][2], B0[2][2], B1[2][2];
    const char* cA = cur.A + (size_t)cur.pm * tstep; const char* cB = cur.Bt + (size_t)cur.pn * tstep;
    PG8_STAGE(PG8_SB(0, 0), cB); PG8_STAGE(PG8_SB(0, 1), cB + hstep); PG8_STAGE(PG8_SA(0, 0), cA); PG8_STAGE(PG8_SA(0, 1), cA + hstep);
    if (wr == 1) PG8_BAR;
    PG8_WAIT_V(2); PG8_BAR;
    PG8_STAGE(PG8_SB(1, 0), cB + kstep); PG8_STAGE(PG8_SA(1, 0), cA + kstep); PG8_STAGE(PG8_SB(1, 1), cB + hstep + kstep);
    PG8_WAIT_V(6); PG8_BAR;
    for (;;) {
        const bool has_next = S.next(ui + 1, nxt);
        const char* nA = has_next ? nxt.A + (size_t)nxt.pm * tstep : cA; const char* nB = has_next ? nxt.Bt + (size_t)nxt.pn * tstep : cB;
        for (int t = 0; t < nt; t += 2) {
            const bool last = (t == nt - 2);
            const char* a1 = cA + (size_t)(t + 1) * kstep;
            const char* a2 = last ? nA : cA + (size_t)(t + 2) * kstep; const char* b2 = last ? nB : cB + (size_t)(t + 2) * kstep;
            const char* a3 = a2 + kstep; const char* b3 = b2 + kstep;
            PG8_LDB(B0, 0, 0); PG8_LDB(B1, 0, 1); PG8_SCHED; PG8_LDA(At, 0, 0); PG8_STAGE(PG8_SA(1, 1), a1 + hstep);
            PG8_WAIT_V(8); PG8_WAIT_L(0); PG8_BAR; PG8_MMA(0, 0, At, B0); PG8_MMA(0, 1, At, B1); PG8_BAR; PG8_SCHED;
            PG8_LDA(At, 0, 1); PG8_STAGE(PG8_SB(0, 0), b2); PG8_STAGE(PG8_SB(0, 1), b2 + hstep); PG8_STAGE(PG8_SA(0, 0), a2);
            PG8_WAIT_V(8); PG8_WAIT_L(0); PG8_BAR; PG8_MMA(1, 0, At, B0); PG8_MMA(1, 1, At, B1); PG8_BAR; PG8_SCHED;
            PG8_LDB(B0, 1, 0); PG8_LDB(B1, 1, 1); PG8_SCHED; PG8_LDA(At, 1, 0); PG8_STAGE(PG8_SA(0, 1), a2 + hstep);
            PG8_WAIT_V(8); PG8_WAIT_L(0); PG8_BAR; PG8_MMA(0, 0, At, B0); PG8_MMA(0, 1, At, B1); PG8_BAR; PG8_SCHED;
            PG8_LDA(At, 1, 1); PG8_STAGE(PG8_SB(1, 0), b3); PG8_STAGE(PG8_SB(1, 1), b3 + hstep); PG8_STAGE(PG8_SA(1, 0), a3);
            PG8_WAIT_V(8); PG8_WAIT_L(0); PG8_BAR; PG8_MMA(1, 0, At, B0); PG8_MMA(1, 1, At, B1); PG8_BAR; PG8_SCHED;
        }
        if (wr == 0) PG8_BAR;
        E(acc, cur, wr, wc, fr, fq);
        if (!has_next) break;
#pragma unroll
        for (int a = 0; a < 2; ++a)
#pragma unroll
            for (int b = 0; b < 2; ++b)
#pragma unroll
                for (int m = 0; m < 4; ++m)
#pragma unroll
                    for (int n = 0; n < 2; ++n) acc[a][b][m][n] = (f32x4){0.f, 0.f, 0.f, 0.f};
        cur = nxt; cA = nA; cB = nB; ++ui;
        if (wr == 1) PG8_BAR;
    }
    PG8_WAIT_V(0);
    PG8_BAR;
#undef PG8_SA
#undef PG8_SB
#undef PG8_STAGE
#undef PG8_LDA
#undef PG8_LDB
#undef PG8_MMA
#undef PG8_WAIT_V
#undef PG8_WAIT_L
#undef PG8_BAR
#undef PG8_SCHED
}
}

__device__ __forceinline__ int perm32(int rho) { const int n = rho >> 4, i = rho & 15; return 8 * (i >> 2) + 4 * n + (i & 3); }
template <bool PERM>
__device__ __forceinline__ void tr_tile_t(const float* src, size_t ld_src, int k0, int c0, bf16_t* dst, size_t ld_dst, int r0, float* tile, int tid) {
    {
        const int r = tid >> 3, c4 = (tid & 7) * 4;
        const float4 v = *(const float4*)(src + (size_t)(k0 + r) * ld_src + c0 + c4);
        float* tp = tile + r * 33 + c4; tp[0] = v.x; tp[1] = v.y; tp[2] = v.z; tp[3] = v.w;
    }
    __syncthreads();
    {
        const int c = tid >> 4, rc = (tid & 15) * 4, sc = PERM ? perm32(c) : c;
        const float a0 = tile[(rc + 0) * 33 + sc], a1 = tile[(rc + 1) * 33 + sc], a2 = tile[(rc + 2) * 33 + sc], a3 = tile[(rc + 3) * 33 + sc];
        uint2 w; w.x = pk_bf16(a0, a1); w.y = pk_bf16(a2, a3);
        *(uint2*)(dst + (size_t)(r0 + c) * ld_dst + k0 + rc) = w;
    }
    __syncthreads();
}
__device__ __forceinline__ void tr_tile2(const float* srca, int c0a, const float* srcb, int c0b, size_t ld_src, int k0, bf16_t* dst, size_t ld_dst, int r0, float* tile, int tid) {
    {
        const int r = tid >> 3, c4 = (tid & 7) * 4;
        const float* sp = c4 < 16 ? srca + (size_t)(k0 + r) * ld_src + c0a + c4 : srcb + (size_t)(k0 + r) * ld_src + c0b + (c4 - 16);
        const float4 v = *(const float4*)sp;
        float* tp = tile + r * 33 + c4; tp[0] = v.x; tp[1] = v.y; tp[2] = v.z; tp[3] = v.w;
    }
    __syncthreads();
    {
        const int c = tid >> 4, rc = (tid & 15) * 4;
        const float a0 = tile[(rc + 0) * 33 + c], a1 = tile[(rc + 1) * 33 + c], a2 = tile[(rc + 2) * 33 + c], a3 = tile[(rc + 3) * 33 + c];
        uint2 w; w.x = pk_bf16(a0, a1); w.y = pk_bf16(a2, a3);
        *(uint2*)(dst + (size_t)(r0 + c) * ld_dst + k0 + rc) = w;
    }
    __syncthreads();
}

__device__ __forceinline__ void phase0(const Params& p, char* smem) {
    const int tid = opaque_tid(), lane = tid & 63, wid = tid >> 6;
    const int gw = blockIdx.x * 8 + wid, nw = gridDim.x * 8;
    char* ws = p.ws;
    bf16_t* xb = (bf16_t*)(ws + OFF_R0);
    for (int row = gw; row < T_; row += nw) {
        const float4* xr = (const float4*)(p.x + (size_t)row * 1024);
#pragma unroll
        for (int i = 0; i < 4; ++i) {
            const float4 v = xr[i * 64 + lane];
            uint2 w; w.x = pk_bf16(v.x, v.y); w.y = pk_bf16(v.z, v.w);
            *(uint2*)(xb + (size_t)row * 1024 + i * 256 + lane * 4) = w;
        }
    }
    {
        float2* cs = (float2*)(ws + OFF_CS);
        const int gt = blockIdx.x * NTHR + tid, nt = gridDim.x * NTHR;
        for (int idx = gt; idx < T_ * 32; idx += nt) {
            const int tok = idx >> 5, i = idx & 31;
            const double ang = (double)p.pos[tok] * INV_FREQ[i];
            const double turns = ang * 0.15915494309189535;
            const float f = (float)(turns - rint(turns));
            cs[idx] = make_float2(__builtin_amdgcn_cosf(f), __builtin_amdgcn_sinf(f));
        }
        bf16_t* memb = (bf16_t*)(ws + OFF_MEMB);
        for (int idx = gt; idx < 4096 * 1024 / 4; idx += nt) {
            const float4 v = ((const float4*)p.mem)[idx];
            uint2 w; w.x = pk_bf16(v.x, v.y); w.y = pk_bf16(v.z, v.w);
            ((uint2*)memb)[idx] = w;
        }
    }
    {
        float* tile = (float*)smem;
        const int NT_WIN = 16 * 201, NT_SQ = 16 * 32, NT_XKV = 16 * 64;
        const int total = NT_WIN + 5 * NT_SQ + NT_XKV;
        for (int t = blockIdx.x; t < total; t += gridDim.x) {
            if (t < NT_WIN) {
                const int kt = t & 15, nt_ = t >> 4;
                const int n0 = nt_ * 32;
                int c0;
                if (n0 < 1280) { const int pn = n0 >> 8, bj = (n0 >> 7) & 1, wc = (n0 >> 5) & 3; c0 = (4 * pn + wc) * 64 + 32 * bj; }
                else c0 = n0 < 4352 ? n0 : (n0 < 6400 ? n0 + 8 : 4352);
                tr_tile_t<true>(p.w_in, 6408, kt * 64, c0, (bf16_t*)(ws + OFF_WIN), 1024, n0, tile, tid);
            } else if (t < NT_WIN + 5 * NT_SQ) {
                const int u = t - NT_WIN, which = u / NT_SQ, v = u % NT_SQ, kt = v & 15, nt_ = v >> 4;
                const float* src = which == 0 ? p.w_att : which == 1 ? p.w_ml : which == 2 ? p.w_mix : which == 3 ? p.w_xq : p.w_xo;
                bf16_t* dst = (bf16_t*)(ws + OFF_WATT + (size_t)which * 2 * MiB);
                tr_tile_t<true>(src, 1024, kt * 64, nt_ * 32, dst, 1024, nt_ * 32, tile, tid);
            } else {
                const int v = t - NT_WIN - 5 * NT_SQ, kt = v & 15, nt_ = v >> 4;
                if (nt_ < 32) tr_tile_t<true>(p.w_xkv, 2048, kt * 64, nt_ * 32, (bf16_t*)(ws + OFF_WXKV), 1024, nt_ * 32, tile, tid);
                else tr_tile_t<false>(p.w_xkv, 2048, kt * 64, nt_ * 32, (bf16_t*)(ws + OFF_WXKV), 1024, nt_ * 32, tile, tid);
            }
        }
    }
}

__device__ __forceinline__ void moe_weight_prep(const Params& p, char* smem) {
    const int tid = opaque_tid();
    float* tile = (float*)smem;
    char* ws = p.ws;
    const int per_e = 384, total = 64 * per_e;
    for (int t = blockIdx.x; t < total; t += gridDim.x) {
        const int e = t / per_e, u = t % per_e;
        if (u < 256) {
            const int isup = u >> 7, v = u & 127, kt = v & 15, j = v >> 4;
            const float* src = (isup ? p.w_up : p.w_gate) + (size_t)e * 1024 * 256;
            tr_tile_t<false>(src, 256, kt * 64, j * 32, (bf16_t*)(ws + OFF_WGU) + (size_t)e * 512 * 1024, 1024, j * 64 + isup * 32, tile, tid);
        } else {
            const int v = u - 256, kt = v & 3, nt_ = v >> 2;
            tr_tile_t<true>(p.w_down + (size_t)e * 256 * 1024, 1024, kt * 64, nt_ * 32, (bf16_t*)(ws + OFF_WD) + (size_t)e * 1024 * 256, 256, nt_ * 32, tile, tid);
        }
    }
}

struct SchedP1 {
    int G, c; const char *xb, *win, *memb, *wxkv;
    __device__ __forceinline__ bool next(int i, pg8::Unit& u) const {
        int nmain, uidx;
        if (G == 256) { nmain = 26; const int x = c & 7, j = c >> 3; uidx = i * 32 + j; if (i < 26) { const int g = uidx / 104, v = uidx % 104; u.pm = 32 * x + 4 * g + (v & 3); u.pn = v >> 2; } }
        else { nmain = c < 6656 ? (6656 - 1 - c) / G + 1 : 0; uidx = i * G + c; if (i < nmain) { u.pm = uidx / 26; u.pn = uidx % 26; } }
        if (i < nmain) { u.aux = 0; u.A = xb; u.Bt = win; return true; }
        const int kv = c + (i - nmain) * G;
        if (kv >= 128) return false;
        if (kv < 64) { u.aux = 1; u.pm = kv >> 2; u.pn = kv & 3; u.A = memb; u.Bt = wxkv; }
        else { const int k2 = kv - 64; u.aux = 2; u.pm = k2 >> 4; u.pn = k2 & 15; u.A = wxkv + (size_t)1024 * 1024 * 2; u.Bt = memb; }
        return true;
    }
};

struct EpiP1 {
    char* ws; int skip;
    __device__ __forceinline__ void operator()(const f32x4 (&acc)[2][2][4][2], const pg8::Unit& u, int wr, int wc, int fr, int fq) const {
        if (skip) {
#pragma unroll
            for (int a = 0; a < 2; ++a)
#pragma unroll
                for (int b = 0; b < 2; ++b)
#pragma unroll
                    for (int m = 0; m < 4; ++m) { asm volatile("" :: "v"(acc[a][b][m][0]), "v"(acc[a][b][m][1])); }
            return;
        }
        const int row0 = u.pm * 256 + wr * 64 + fr;
        if (u.aux == 0 && u.pn < 5) {
            const int hidx = 4 * u.pn + wc;
            if (hidx < 18) {
                bf16_t* dst; int ld, cb; float sc;
                if (hidx < 16) { dst = (bf16_t*)(ws + OFF_R1); ld = 1024; cb = hidx * 64; sc = 0.125f; }
                else { dst = (bf16_t*)(ws + OFF_AK); ld = 128; cb = (hidx - 16) * 64; sc = 1.0f; }
                const float* cs = (const float*)(ws + OFF_CS);
                const int d1 = 8 * fq;
#pragma unroll
                for (int ai = 0; ai < 2; ++ai)
#pragma unroll
                    for (int m = 0; m < 4; ++m) {
                        const int tok = row0 + ai * 128 + m * 16;
                        const float4* cp = (const float4*)(cs + (size_t)tok * 64 + d1 * 2);
                        const float4 c0 = cp[0], c1 = cp[1], c2 = cp[2], c3 = cp[3];
                        const f32x4 x1a = acc[ai][0][m][0], x1b = acc[ai][0][m][1], x2a = acc[ai][1][m][0], x2b = acc[ai][1][m][1];
                        f32x4 o1a, o1b, o2a, o2b;
                        o1a[0] = (x1a[0] * c0.x - x2a[0] * c0.y) * sc; o2a[0] = (x2a[0] * c0.x + x1a[0] * c0.y) * sc;
                        o1a[1] = (x1a[1] * c0.z - x2a[1] * c0.w) * sc; o2a[1] = (x2a[1] * c0.z + x1a[1] * c0.w) * sc;
                        o1a[2] = (x1a[2] * c1.x - x2a[2] * c1.y) * sc; o2a[2] = (x2a[2] * c1.x + x1a[2] * c1.y) * sc;
                        o1a[3] = (x1a[3] * c1.z - x2a[3] * c1.w) * sc; o2a[3] = (x2a[3] * c1.z + x1a[3] * c1.w) * sc;
                        o1b[0] = (x1b[0] * c2.x - x2b[0] * c2.y) * sc; o2b[0] = (x2b[0] * c2.x + x1b[0] * c2.y) * sc;
                        o1b[1] = (x1b[1] * c2.z - x2b[1] * c2.w) * sc; o2b[1] = (x2b[1] * c2.z + x1b[1] * c2.w) * sc;
                        o1b[2] = (x1b[2] * c3.x - x2b[2] * c3.y) * sc; o2b[2] = (x2b[2] * c3.x + x1b[2] * c3.y) * sc;
                        o1b[3] = (x1b[3] * c3.z - x2b[3] * c3.w) * sc; o2b[3] = (x2b[3] * c3.z + x1b[3] * c3.w) * sc;
                        bf16_t* rp = dst + (size_t)tok * ld + cb + d1;
                        store_bf16x8(rp, o1a, o1b); store_bf16x8(rp + 32, o2a, o2b);
                    }
            } else {
                bf16_t* avT = (bf16_t*)(ws + OFF_AV);
#pragma unroll
                for (int bj = 0; bj < 2; ++bj)
#pragma unroll
                    for (int ai = 0; ai < 2; ++ai)
#pragma unroll
                        for (int m = 0; m < 4; ++m)
#pragma unroll
                            for (int n = 0; n < 2; ++n)
#pragma unroll
                                for (int j = 0; j < 4; ++j)
                                    avT[(size_t)((hidx - 18) * 64 + 32 * bj + 8 * fq + 4 * n + j) * T_ + row0 + ai * 128 + m * 16] = (bf16_t)(pk_bf16(acc[ai][bj][m][n][j], acc[ai][bj][m][n][j]) & 0xffffu);
            }
            return;
        }
#pragma unroll
        for (int bj = 0; bj < 2; ++bj) {
            const int c32 = u.pn * 256 + bj * 128 + wc * 32;
            if (u.aux == 0 && c32 >= 6400) {
                if (c32 == 6400 && fq == 0) {
                    float* gates = (float*)(ws + OFF_GATES);
#pragma unroll
                    for (int ai = 0; ai < 2; ++ai)
#pragma unroll
                        for (int m = 0; m < 4; ++m) {
                            const f32x4 v0 = acc[ai][bj][m][0], v1 = acc[ai][bj][m][1];
                            float4* gp = (float4*)(gates + (size_t)(row0 + ai * 128 + m * 16) * 8);
                            gp[0] = make_float4(v0[0], v0[1], v0[2], v0[3]); gp[1] = make_float4(v1[0], v1[1], v1[2], v1[3]);
                        }
                }
            } else if (u.aux == 2) {
                bf16_t* dst = (bf16_t*)(ws + OFF_VT);
#pragma unroll
                for (int ai = 0; ai < 2; ++ai)
#pragma unroll
                    for (int m = 0; m < 4; ++m) {
                        bf16_t* rp = dst + (size_t)(row0 + ai * 128 + m * 16) * 4096 + c32 + fq * 4;
                        store_bf16x4(rp, acc[ai][bj][m][0]); store_bf16x4(rp + 16, acc[ai][bj][m][1]);
                    }
            } else {
                bf16_t* dst; int ld, cb; bool sig = false;
                if (u.aux == 1) { dst = (bf16_t*)(ws + OFF_KMAT); ld = 1024; cb = c32; }
                else if (c32 < 2304) { dst = (bf16_t*)(ws + OFF_MQK); ld = 1024; cb = c32 - 1280; }
                else if (c32 < 3328) { dst = (bf16_t*)(ws + OFF_MV); ld = 1024; cb = c32 - 2304; }
                else if (c32 < 4352) { dst = (bf16_t*)(ws + OFF_MO); ld = 1024; cb = c32 - 3328; sig = true; }
                else { dst = (bf16_t*)(ws + OFF_GG); ld = 2048; cb = c32 - 4352; sig = true; }
#pragma unroll
                for (int ai = 0; ai < 2; ++ai)
#pragma unroll
                    for (int m = 0; m < 4; ++m) {
                        f32x4 v0 = acc[ai][bj][m][0], v1 = acc[ai][bj][m][1];
                        if (sig) {
                            v0[0] = sigmoidf_(v0[0]); v0[1] = sigmoidf_(v0[1]); v0[2] = sigmoidf_(v0[2]); v0[3] = sigmoidf_(v0[3]);
                            v1[0] = sigmoidf_(v1[0]); v1[1] = sigmoidf_(v1[1]); v1[2] = sigmoidf_(v1[2]); v1[3] = sigmoidf_(v1[3]);
                        }
                        store_bf16x8(dst + (size_t)(row0 + ai * 128 + m * 16) * ld + cb + fq * 8, v0, v1);
                    }
            }
        }
    }
};

__device__ __forceinline__ void phase1(const Params& p, char* smem, int skip_epi = 0) {
    char* ws = p.ws;
    SchedP1 S{(int)gridDim.x, (int)blockIdx.x, ws + OFF_R0, ws + OFF_WIN, ws + OFF_MEMB, ws + OFF_WXKV};
    EpiP1 E{ws, skip_epi};
    pg8::gemm_phase<EpiP1, SchedP1>((LDS_AS unsigned char*)smem, 1024, S, E);
}

template <int NPASS>
struct SchedN1024 {
    int G, c; const char* A0; const char* B0; const char* A1; const char* B1;
    __device__ __forceinline__ bool next(int i, pg8::Unit& u) const {
        const int ti = i / NPASS, pass = i % NPASS;
        int uidx;
        if (G == 256) { if (ti >= 4) return false; const int x = c & 7, j = c >> 3; uidx = ti * 32 + j; u.pm = 32 * x + (uidx >> 2); u.pn = uidx & 3; }
        else { uidx = ti * G + c; if (uidx >= 1024) return false; u.pm = uidx >> 2; u.pn = uidx & 3; }
        u.aux = pass; u.A = pass ? A1 : A0; u.Bt = pass ? B1 : B0;
        return true;
    }
};

constexpr int ML_RAW = 0;
constexpr int ML_V0 = 34816;
constexpr int ML_Q = ML_V0 + 65536;
constexpr int ML_K = ML_Q + 16384;
constexpr int ML_SW = ML_K + 20480;
constexpr int ML_F = ML_SW + 8192;
constexpr int ML_END = ML_F + 4096;
typedef short v4i16_t __attribute__((ext_vector_type(4)));
__device__ __forceinline__ int offQK(int row, int ch) { return row * 256 + ((ch ^ (((row & 3) << 2) | ((row >> 2) & 3))) << 4); }
__device__ __forceinline__ int offV(int row, int ch) { return row * 512 + ((ch ^ (((row & 3) | (((row >> 3) & 1) << 2)) << 1)) << 4); }
__device__ __forceinline__ int offSw(int row, int ch) { return row * 128 + ((ch ^ ((row >> 1) & 7)) << 4); }
__device__ __forceinline__ bf16x8 tr_read2(const char* p0, const char* p1) {
    const v4i16_t a = __builtin_amdgcn_ds_read_tr16_b64_v4i16((LDS_AS v4i16_t*)p0);
    const v4i16_t b = __builtin_amdgcn_ds_read_tr16_b64_v4i16((LDS_AS v4i16_t*)p1);
    return __builtin_shufflevector(a, b, 0, 1, 2, 3, 4, 5, 6, 7);
}

__device__ __forceinline__ void mlstm_item(const Params& p, char* smem, int item) {
    const int tid = opaque_tid(), lane = tid & 63, wid = tid >> 6, fr0 = lane & 15, fq0 = lane >> 4;
    const int b = item >> 2, h = item & 3;
    char* ws = p.ws;
    const bf16_t* mqk = (const bf16_t*)(ws + OFF_MQK);
    const bf16_t* mv = (const bf16_t*)(ws + OFF_MV);
    const bf16_t* mo = (const bf16_t*)(ws + OFF_MO);
    const float* gates = (const float*)(ws + OFF_GATES);
    bf16_t* hm = (bf16_t*)p.out;
    float* fl = (float*)(smem + ML_F);
    float* den = fl; float* ssq = fl + 64; float* nsum = fl + 192; float* eb = fl + 448; float* ek = fl + 576; float* gg = fl + 704;
    const long tokb = (long)b * 4096;
    f32x4 C[8][2];
#pragma unroll
    for (int dt = 0; dt < 8; ++dt) { C[dt][0] = (f32x4){0.f, 0.f, 0.f, 0.f}; C[dt][1] = (f32x4){0.f, 0.f, 0.f, 0.f}; }
    float nreg = 0.f;
    const int cp0 = tid & 127, tg = tid >> 7; const int cp = cp0;
    const bool isk = cp >= 64;
    const int dch = isk ? 2 * (cp - 64) : 2 * cp;
    const int ccol = isk ? (512 + h * 128 + dch) : (h * 128 + dch);
    float cw0[4], cw1[4];
#pragma unroll
    for (int j = 0; j < 4; ++j) { cw0[j] = p.conv_w[j * 1024 + ccol]; cw1[j] = p.conv_w[j * 1024 + ccol + 1]; }
    const float cb0 = p.conv_b[ccol], cb1 = p.conv_b[ccol + 1];
    const float big = p.b_ig[h], bfg = p.b_fg[h];
    const float gn0 = p.ml_g[h * 256 + wid * 32 + fr0], gn1 = p.ml_g[h * 256 + wid * 32 + 16 + fr0];
    const int vrl = tid >> 5, vpc = tid & 31, vlc = vpc ^ ((((vrl & 3) | (((vrl >> 3) & 1) << 2))) << 1);
    const bf16_t* vsrc = mv + (tokb + vrl) * 1024 + h * 256 + vlc * 8;
    __syncthreads();
    {
        unsigned* kz = (unsigned*)(smem + ML_K + 64 * 256);
        kz[tid] = 0u; kz[tid + 512] = 0u;
        if (tid < 256) nsum[tid] = 0.f;
#pragma unroll
        for (int i = 0; i < 5; ++i) {
            const int j = i * 512 + tid;
            if (j < 2176) {
                const int row = j >> 5, pc = j & 31;
                const bf16_t* src = mqk + (tokb - 3 + row) * 1024 + (pc < 16 ? h * 128 + pc * 8 : 512 + h * 128 + (pc - 16) * 8);
                glds16(src, smem + ML_RAW + j * 16);
            }
        }
#pragma unroll
        for (int i = 0; i < 4; ++i) glds16(vsrc + (long)i * 16 * 1024, smem + ML_V0 + (i * 512 + tid) * 16);
    }
    float gi = 0.f, gf = 0.f;
    if (wid == 7) {
        const float mi0 = gates[(tokb + lane) * 8 + h], mf0 = gates[(tokb + lane) * 8 + 4 + h];
        gi = gates[(tokb + 64 + lane) * 8 + h]; gf = gates[(tokb + 64 + lane) * 8 + 4 + h];
        const float x = mf0 + bfg;
        float bs = fminf(x, 0.f) - log1pf(__expf(-fabsf(x)));
#pragma unroll
        for (int o = 1; o < 64; o <<= 1) { const float y = __shfl_up(bs, o); if (lane >= o) bs += y; }
        eb[lane] = __expf(bs); ek[lane] = __expf(mi0 + big - bs);
        if (lane == 63) gg[0] = __expf(bs);
    }
    asm volatile("s_waitcnt vmcnt(0)" ::: "memory");
    __syncthreads();
#pragma unroll 1
    for (int c = 0; c < 64; ++c) {
        const int par = c & 1;
        const long tok0 = tokb + c * 64;
        int fr = fr0, fq = fq0, cpv = cp0;
        asm volatile("" : "+v"(fr), "+v"(fq), "+v"(cpv));
        if (tid < 64) { den[tid] = 0.f; ssq[par * 64 + tid] = 0.f; }
        {
            const int tt0 = tg * 16;
            const char* rp = smem + ML_RAW + tt0 * 512 + cpv * 4;
            unsigned w0 = *(const unsigned*)(rp), w1 = *(const unsigned*)(rp + 512), w2 = *(const unsigned*)(rp + 1024);
            if (c == 0 && tg == 0) { w0 = 0u; w1 = 0u; w2 = 0u; }
            float cs0 = 0.f, cs1 = 0.f;
            const float* scp = (isk ? ek : eb) + par * 64 + tt0;
            const int dchv = isk ? 2 * (cpv - 64) : 2 * cpv;
            char* dstb = smem + (isk ? ML_K : ML_Q) + (dchv & 7) * 2;
            const float kmul = isk ? 0.08838834764831845f : 1.0f;
#pragma unroll 4
            for (int tt = 0; tt < 16; ++tt) {
                const unsigned w3 = *(const unsigned*)(rp + (tt + 3) * 512);
                float v0 = cb0 + cw0[0] * bf_lo(w0) + cw0[1] * bf_lo(w1) + cw0[2] * bf_lo(w2) + cw0[3] * bf_lo(w3);
                float v1 = cb1 + cw1[0] * bf_hi(w0) + cw1[1] * bf_hi(w1) + cw1[2] * bf_hi(w2) + cw1[3] * bf_hi(w3);
                w0 = w1; w1 = w2; w2 = w3;
                v0 = v0 * sigmoidf_(v0); v1 = v1 * sigmoidf_(v1);
                const float sc = scp[tt] * kmul;
                const float a0 = v0 * sc, a1 = v1 * sc;
                *(unsigned*)(dstb + offQK(tt0 + tt, dchv >> 3)) = pk_bf16(a0, a1);
                cs0 += a0; cs1 += a1;
            }
            if (isk) { atomicAdd(&nsum[par * 128 + dch], cs0); atomicAdd(&nsum[par * 128 + dch + 1], cs1); }
        }
        __syncthreads();
        if (wid == 7 && c + 1 < 64) {
            const float x = gf + bfg;
            float bs = fminf(x, 0.f) - log1pf(__expf(-fabsf(x)));
#pragma unroll
            for (int o = 1; o < 64; o <<= 1) { const float y = __shfl_up(bs, o); if (lane >= o) bs += y; }
            eb[(par ^ 1) * 64 + lane] = __expf(bs); ek[(par ^ 1) * 64 + lane] = __expf(gi + big - bs);
            if (lane == 63) gg[par ^ 1] = __expf(bs);
            if (c + 2 < 64) { gi = gates[(tok0 + 128 + lane) * 8 + h]; gf = gates[(tok0 + 128 + lane) * 8 + 4 + h]; }
        }
        {
            const int tt = wid >> 1;
            bf16x8 qf[4];
#pragma unroll
            for (int ks = 0; ks < 4; ++ks) qf[ks] = *(const bf16x8*)(smem + ML_Q + offQK(tt * 16 + fr, 4 * ks + fq));
#pragma unroll
            for (int x = 0; x < 2; ++x) {
                const int st = (wid & 1) * 2 + x;
                f32x4 a = (f32x4){0.f, 0.f, 0.f, 0.f};
#pragma unroll
                for (int ks = 0; ks < 4; ++ks) {
                    const bf16x8 kf = *(const bf16x8*)(smem + ML_K + offQK(st * 16 + fr, 4 * ks + fq));
                    a = __builtin_amdgcn_mfma_f32_16x16x32_bf16(kf, qf[ks], a, 0, 0, 0);
                }
#pragma unroll
                for (int j = 0; j < 4; ++j) a[j] = (st * 16 + fq * 4 + j) <= (tt * 16 + fr) ? a[j] : 0.f;
                float rs = (a[0] + a[1]) + (a[2] + a[3]);
                rs += __shfl_xor(rs, 16); rs += __shfl_xor(rs, 32);
                if (fq == 0) atomicAdd(&den[tt * 16 + fr], rs);
                uint2 w; w.x = pk_bf16(a[0], a[1]); w.y = pk_bf16(a[2], a[3]);
                *(uint2*)(smem + ML_SW + offSw(tt * 16 + fr, st * 2 + (fq >> 1)) + (fq & 1) * 8) = w;
            }
            if (wid < 4) {
                f32x4 a = (f32x4){0.f, 0.f, 0.f, 0.f};
#pragma unroll
                for (int ks = 0; ks < 4; ++ks) {
                    const bf16x8 kf = *(const bf16x8*)(smem + ML_K + offQK(64 + fr, 4 * ks + fq));
                    const bf16x8 qa = *(const bf16x8*)(smem + ML_Q + offQK(wid * 16 + fr, 4 * ks + fq));
                    a = __builtin_amdgcn_mfma_f32_16x16x32_bf16(kf, qa, a, 0, 0, 0);
                }
                if (fq == 0) atomicAdd(&den[wid * 16 + fr], a[0]);
            }
        }
        f32x4 Y[4][2];
#pragma unroll
        for (int tt = 0; tt < 4; ++tt) { Y[tt][0] = (f32x4){0.f, 0.f, 0.f, 0.f}; Y[tt][1] = (f32x4){0.f, 0.f, 0.f, 0.f}; }
#pragma unroll
        for (int ks = 0; ks < 4; ++ks) {
            u32x4 c0, c1;
            c0[0] = pk_bf16(C[2 * ks][0][0], C[2 * ks][0][1]); c0[1] = pk_bf16(C[2 * ks][0][2], C[2 * ks][0][3]);
            c0[2] = pk_bf16(C[2 * ks + 1][0][0], C[2 * ks + 1][0][1]); c0[3] = pk_bf16(C[2 * ks + 1][0][2], C[2 * ks + 1][0][3]);
            c1[0] = pk_bf16(C[2 * ks][1][0], C[2 * ks][1][1]); c1[1] = pk_bf16(C[2 * ks][1][2], C[2 * ks][1][3]);
            c1[2] = pk_bf16(C[2 * ks + 1][1][0], C[2 * ks + 1][1][1]); c1[3] = pk_bf16(C[2 * ks + 1][1][2], C[2 * ks + 1][1][3]);
            const bf16x8 cf0 = __builtin_bit_cast(bf16x8, c0), cf1 = __builtin_bit_cast(bf16x8, c1);
#pragma unroll
            for (int tt = 0; tt < 4; ++tt) {
                const int row = tt * 16 + fr;
                const u32x2 lo = *(const u32x2*)(smem + ML_Q + offQK(row, 4 * ks + (fq >> 1)) + (fq & 1) * 8);
                const u32x2 hi = *(const u32x2*)(smem + ML_Q + offQK(row, 4 * ks + 2 + (fq >> 1)) + (fq & 1) * 8);
                u32x4 av; av[0] = lo[0]; av[1] = lo[1]; av[2] = hi[0]; av[3] = hi[1];
                const bf16x8 af = __builtin_bit_cast(bf16x8, av);
                Y[tt][0] = __builtin_amdgcn_mfma_f32_16x16x32_bf16(af, cf0, Y[tt][0], 0, 0, 0);
                Y[tt][1] = __builtin_amdgcn_mfma_f32_16x16x32_bf16(af, cf1, Y[tt][1], 0, 0, 0);
            }
        }
        __syncthreads();
        if (c + 1 < 64) {
#pragma unroll
            for (int i = 0; i < 5; ++i) {
                const int j = i * 512 + tid;
                if (j < 2176) {
                    const int row = j >> 5, pc = j & 31;
                    const bf16_t* src = mqk + (tok0 + 64 - 3 + row) * 1024 + (pc < 16 ? h * 128 + pc * 8 : 512 + h * 128 + (pc - 16) * 8);
                    glds16(src, smem + ML_RAW + j * 16);
                }
            }
#pragma unroll
            for (int i = 0; i < 4; ++i) glds16(vsrc + (long)(c + 1) * 64 * 1024 + (long)i * 16 * 1024, smem + ML_V0 + (par ^ 1) * 32768 + (i * 512 + tid) * 16);
        }
        unsigned mop[4][4];
#pragma unroll
        for (int tt = 0; tt < 4; ++tt)
#pragma unroll
            for (int j = 0; j < 4; ++j) {
                const bf16_t* mp = mo + (tok0 + tt * 16 + fq * 4 + j) * 1024 + h * 256 + wid * 32 + fr;
                mop[tt][j] = (unsigned)mp[0] | ((unsigned)mp[16] << 16);
            }
        const char* vb = smem + ML_V0 + par * 32768;
        bf16x8 vf[2][2];
#pragma unroll
        for (int ks = 0; ks < 2; ++ks)
#pragma unroll
            for (int et = 0; et < 2; ++et) {
                const int cidx = 2 * wid + et, ch = 2 * cidx + ((fr & 3) >> 1);
                const int r0 = 32 * ks + 8 * fq + (fr >> 2);
                vf[ks][et] = tr_read2(vb + offV(r0, ch) + 8 * (fr & 1), vb + offV(r0 + 4, ch) + 8 * (fr & 1));
            }
#pragma unroll
        for (int ks = 0; ks < 2; ++ks)
#pragma unroll
            for (int tt = 0; tt < 4; ++tt) {
                const bf16x8 sf = *(const bf16x8*)(smem + ML_SW + offSw(tt * 16 + fr, 4 * ks + fq));
                Y[tt][0] = __builtin_amdgcn_mfma_f32_16x16x32_bf16(sf, vf[ks][0], Y[tt][0], 0, 0, 0);
                Y[tt][1] = __builtin_amdgcn_mfma_f32_16x16x32_bf16(sf, vf[ks][1], Y[tt][1], 0, 0, 0);
            }
#pragma unroll
        for (int tt = 0; tt < 4; ++tt) {
            const float4 dv = *(const float4*)(den + tt * 16 + fq * 4);
            const float dd[4] = {dv.x, dv.y, dv.z, dv.w};
#pragma unroll
            for (int j = 0; j < 4; ++j) {
                const float inv = 1.0f / fmaxf(fabsf(dd[j]), 1.0f);
                Y[tt][0][j] *= inv; Y[tt][1][j] *= inv;
                float sq = Y[tt][0][j] * Y[tt][0][j] + Y[tt][1][j] * Y[tt][1][j];
                sq += __shfl_xor(sq, 1); sq += __shfl_xor(sq, 2); sq += __shfl_xor(sq, 4); sq += __shfl_xor(sq, 8);
                if (fr == 0) atomicAdd(&ssq[par * 64 + tt * 16 + fq * 4 + j], sq);
            }
        }
#pragma unroll
        for (int dt = 0; dt < 8; ++dt)
#pragma unroll
            for (int ks = 0; ks < 2; ++ks) {
                const int ch = 2 * dt + ((fr & 3) >> 1);
                const int r0 = 32 * ks + 8 * fq + (fr >> 2);
                const bf16x8 kf = tr_read2(smem + ML_K + offQK(r0, ch) + 8 * (fr & 1), smem + ML_K + offQK(r0 + 4, ch) + 8 * (fr & 1));
                C[dt][0] = __builtin_amdgcn_mfma_f32_16x16x32_bf16(kf, vf[ks][0], C[dt][0], 0, 0, 0);
                C[dt][1] = __builtin_amdgcn_mfma_f32_16x16x32_bf16(kf, vf[ks][1], C[dt][1], 0, 0, 0);
                if (ks == 1 && (dt & 1)) __builtin_amdgcn_sched_barrier(0);
            }
        const float g = gg[par];
#pragma unroll
        for (int dt = 0; dt < 8; ++dt) { C[dt][0] *= g; C[dt][1] *= g; }
        asm volatile("s_waitcnt vmcnt(0)" ::: "memory");
        __syncthreads();
#pragma unroll
        for (int tt = 0; tt < 4; ++tt) {
            const float4 sv = *(const float4*)(ssq + par * 64 + tt * 16 + fq * 4);
            const float ss[4] = {sv.x, sv.y, sv.z, sv.w};
#pragma unroll
            for (int j = 0; j < 4; ++j) {
                const float rstd = rsqrtf(ss[j] * (1.0f / 256.0f) + 1e-6f);
                bf16_t* hp = hm + (tok0 + tt * 16 + fq * 4 + j) * 1024 + h * 256 + wid * 32 + fr;
                const float o0 = Y[tt][0][j] * rstd * gn0 * bf_lo(mop[tt][j]);
                const float o1 = Y[tt][1][j] * rstd * gn1 * bf_hi(mop[tt][j]);
                hp[0] = (bf16_t)(pk_bf16(o0, o0) & 0xffffu); hp[16] = (bf16_t)(pk_bf16(o1, o1) & 0xffffu);
            }
        }
        if (tid < 128) {
            nreg = g * (nreg + nsum[par * 128 + tid]);
            nsum[par * 128 + tid] = 0.f;
            *(bf16_t*)(smem + ML_K + offQK(64, tid >> 3) + (tid & 7) * 2) = (bf16_t)(pk_bf16(nreg, nreg) & 0xffffu);
        }
    }
    __syncthreads();
}

__device__ __forceinline__ void swa_items(const Params& p, char* smem, int first, int stride) {
    const int tid = opaque_tid(), lane = tid & 63, wid = tid >> 6, fr = lane & 15, fq = lane >> 4;
    char* ws = p.ws;
    const bf16_t* aq = (const bf16_t*)(ws + OFF_R1);
    const bf16_t* ak = (const bf16_t*)(ws + OFF_AK);
    const bf16_t* avT = (const bf16_t*)(ws + OFF_AV);
    bf16_t* ao = (bf16_t*)(ws + OFF_R0);
    char* kbuf = smem; char* vbuf = smem + 32768;
    for (int item = first; item < 1024; item += stride) {
        const int kvh = item & 1, n = (item >> 1) & 31, b = item >> 6;
        const int hq = kvh * 8 + wid;
        const long tokbase = (long)b * 4096 + n * 128 - 128;
        {
            const int rk = tid >> 3, pck = tid & 7, lck = pck ^ ((rk >> 1) & 7);
            const bf16_t* srck = ak + (tokbase + rk) * 128 + kvh * 64 + lck * 8;
#pragma unroll
            for (int i = 0; i < 4; ++i) glds16(srck + (long)i * 64 * 128, kbuf + (i * 512 + tid) * 16);
            const int rv = tid >> 5, pcv = tid & 31, lcv = pcv ^ (rv & 15);
            const bf16_t* srcv = avT + (long)(kvh * 64 + rv) * T_ + tokbase + lcv * 8;
#pragma unroll
            for (int i = 0; i < 4; ++i) glds16(srcv + (long)i * 16 * T_, vbuf + (i * 512 + tid) * 16);
        }
        const float sink = p.sinks[hq];
        asm volatile("s_waitcnt vmcnt(0)" ::: "memory");
        __syncthreads();
        const int kswz = (fr >> 1) & 7;
#pragma unroll 1
        for (int u = 0; u < 4; ++u) {
            const long tq = (long)b * 4096 + n * 128 + u * 32 + fr;
            const bf16_t* qp = aq + tq * 1024 + hq * 64 + fq * 8;
            const bf16x8 q00 = *(const bf16x8*)(qp), q01 = *(const bf16x8*)(qp + 32);
            const bf16x8 q10 = *(const bf16x8*)(qp + 16 * 1024), q11 = *(const bf16x8*)(qp + 16 * 1024 + 32);
            f32x4 sc[10][2];
#pragma unroll
            for (int r = 0; r < 10; ++r) {
                sc[r][0] = (f32x4){0.f, 0.f, 0.f, 0.f}; sc[r][1] = (f32x4){0.f, 0.f, 0.f, 0.f};
                if (!(n == 0 && (2 * u + r) < 8)) {
                    const char* rowp = kbuf + ((2 * u + r) * 16 + fr) * 128;
                    const bf16x8 k0 = *(const bf16x8*)(rowp + ((fq ^ kswz) * 16)), k1 = *(const bf16x8*)(rowp + (((4 + fq) ^ kswz) * 16));
                    sc[r][0] = __builtin_amdgcn_mfma_f32_16x16x32_bf16(k0, q00, sc[r][0], 0, 0, 0);
                    sc[r][0] = __builtin_amdgcn_mfma_f32_16x16x32_bf16(k1, q01, sc[r][0], 0, 0, 0);
                    sc[r][1] = __builtin_amdgcn_mfma_f32_16x16x32_bf16(k0, q10, sc[r][1], 0, 0, 0);
                    sc[r][1] = __builtin_amdgcn_mfma_f32_16x16x32_bf16(k1, q11, sc[r][1], 0, 0, 0);
                }
            }
            u32x4 pf[2][5]; float linv[2];
#pragma unroll
            for (int nt = 0; nt < 2; ++nt) {
                float m = sink;
#pragma unroll
                for (int r = 0; r < 10; ++r) {
                    const bool tile_ok = !(n == 0 && (2 * u + r) < 8);
#pragma unroll
                    for (int j = 0; j < 4; ++j) {
                        const int delta = (r - nt) * 16 + fq * 4 + j - fr;
                        const bool ok = tile_ok && delta >= 1 && delta <= 128;
                        sc[r][nt][j] = ok ? sc[r][nt][j] : -INFINITY;
                        m = fmaxf(m, sc[r][nt][j]);
                    }
                }
                m = fmaxf(m, __shfl_xor(m, 16)); m = fmaxf(m, __shfl_xor(m, 32));
                float l = 0.f;
#pragma unroll
                for (int s2 = 0; s2 < 5; ++s2) {
                    float e[8];
#pragma unroll
                    for (int j = 0; j < 4; ++j) { e[j] = __expf(sc[2 * s2][nt][j] - m); e[4 + j] = __expf(sc[2 * s2 + 1][nt][j] - m); }
                    l += ((e[0] + e[1]) + (e[2] + e[3])) + ((e[4] + e[5]) + (e[6] + e[7]));
                    u32x4 w; w[0] = pk_bf16(e[0], e[1]); w[1] = pk_bf16(e[2], e[3]); w[2] = pk_bf16(e[4], e[5]); w[3] = pk_bf16(e[6], e[7]);
                    pf[nt][s2] = w;
                }
                l += __shfl_xor(l, 16); l += __shfl_xor(l, 32);
                linv[nt] = 1.0f / (l + __expf(sink - m));
            }
            f32x4 o[4][2];
#pragma unroll
            for (int dt = 0; dt < 4; ++dt) { o[dt][0] = (f32x4){0.f, 0.f, 0.f, 0.f}; o[dt][1] = (f32x4){0.f, 0.f, 0.f, 0.f}; }
#pragma unroll
            for (int s2 = 0; s2 < 5; ++s2) {
                if (!(n == 0 && (2 * u + 2 * s2) < 8)) {
                    const int ca = ((((2 * u + 2 * s2) * 2 + (fq >> 1)) ^ fr) * 16) + (fq & 1) * 8;
                    const int cb = ((((2 * u + 2 * s2 + 1) * 2 + (fq >> 1)) ^ fr) * 16) + (fq & 1) * 8;
                    const bf16x8 p0 = __builtin_bit_cast(bf16x8, pf[0][s2]), p1 = __builtin_bit_cast(bf16x8, pf[1][s2]);
#pragma unroll
                    for (int dt = 0; dt < 4; ++dt) {
                        const char* rowp = vbuf + (dt * 16 + fr) * 512;
                        const u32x2 va = *(const u32x2*)(rowp + ca), vb = *(const u32x2*)(rowp + cb);
                        u32x4 vv; vv[0] = va[0]; vv[1] = va[1]; vv[2] = vb[0]; vv[3] = vb[1];
                        const bf16x8 vf = __builtin_bit_cast(bf16x8, vv);
                        o[dt][0] = __builtin_amdgcn_mfma_f32_16x16x32_bf16(vf, p0, o[dt][0], 0, 0, 0);
                        o[dt][1] = __builtin_amdgcn_mfma_f32_16x16x32_bf16(vf, p1, o[dt][1], 0, 0, 0);
                    }
                }
            }
#pragma unroll
            for (int nt = 0; nt < 2; ++nt) {
                bf16_t* rp = ao + (size_t)(tq + nt * 16) * 1024 + hq * 64 + fq * 4;
#pragma unroll
                for (int dt = 0; dt < 4; ++dt) store_bf16x4(rp + dt * 16, o[dt][nt] * linv[nt]);
            }
        }
        __syncthreads();
    }
}

__device__ __forceinline__ void phase2(const Params& p, char* smem, int which = 3) {
    const int G = gridDim.x;
    if (G > 64) {
        if (blockIdx.x < 64) { if (which & 1) mlstm_item(p, smem, blockIdx.x); }
        else { if (which & 2) swa_items(p, smem, blockIdx.x - 64, G - 64); }
    } else {
        for (int it = blockIdx.x; it < 64; it += G) mlstm_item(p, smem, it);
        swa_items(p, smem, blockIdx.x, G);
    }
}

struct EpiP3 {
    const bf16_t* gg; bf16_t* y;
    __device__ __forceinline__ void operator()(const f32x4 (&acc)[2][2][4][2], const pg8::Unit& u, int wr, int wc, int fr, int fq) const {
        const int row0 = u.pm * 256 + wr * 64 + fr, col0 = u.pn * 256 + wc * 32 + fq * 8;
#pragma unroll
        for (int ai = 0; ai < 2; ++ai)
#pragma unroll
            for (int m = 0; m < 4; ++m) {
                const size_t tok = row0 + ai * 128 + m * 16;
#pragma unroll
                for (int bj = 0; bj < 2; ++bj) {
                    const int col = col0 + bj * 128;
                    const u32x4 g = *(const u32x4*)(gg + tok * 2048 + (u.aux ? 1024 : 0) + col);
                    f32x4 v0, v1;
                    v0[0] = bf_lo(g[0]) * acc[ai][bj][m][0][0]; v0[1] = bf_hi(g[0]) * acc[ai][bj][m][0][1];
                    v0[2] = bf_lo(g[1]) * acc[ai][bj][m][0][2]; v0[3] = bf_hi(g[1]) * acc[ai][bj][m][0][3];
                    v1[0] = bf_lo(g[2]) * acc[ai][bj][m][1][0]; v1[1] = bf_hi(g[2]) * acc[ai][bj][m][1][1];
                    v1[2] = bf_lo(g[3]) * acc[ai][bj][m][1][2]; v1[3] = bf_hi(g[3]) * acc[ai][bj][m][1][3];
                    if (u.aux) {
                        const u32x4 pv = *(const u32x4*)(y + tok * 1024 + col);
                        v0[0] += bf_lo(pv[0]); v0[1] += bf_hi(pv[0]); v0[2] += bf_lo(pv[1]); v0[3] += bf_hi(pv[1]);
                        v1[0] += bf_lo(pv[2]); v1[1] += bf_hi(pv[2]); v1[2] += bf_lo(pv[3]); v1[3] += bf_hi(pv[3]);
                    }
                    store_bf16x8(y + tok * 1024 + col, v0, v1);
                }
                if (m & 1) __builtin_amdgcn_sched_barrier(0);
            }
    }
};
__device__ __forceinline__ void phase3(const Params& p, char* smem) {
    char* ws = p.ws;
    SchedN1024<2> S{(int)gridDim.x, (int)blockIdx.x, ws + OFF_R0, ws + OFF_WATT, (const char*)p.out, ws + OFF_WML};
    EpiP3 E{(const bf16_t*)(ws + OFF_GG), (bf16_t*)(ws + OFF_R1)};
    pg8::gemm_phase<EpiP3, SchedN1024<2>>((LDS_AS unsigned char*)smem, 1024, S, E);
}

struct EpiBf16 {
    bf16_t* outb; float scale;
    __device__ __forceinline__ void operator()(const f32x4 (&acc)[2][2][4][2], const pg8::Unit& u, int wr, int wc, int fr, int fq) const {
        const int row0 = u.pm * 256 + wr * 64 + fr, col0 = u.pn * 256 + wc * 32 + fq * 8;
#pragma unroll
        for (int ai = 0; ai < 2; ++ai)
#pragma unroll
            for (int m = 0; m < 4; ++m) {
                const size_t tok = row0 + ai * 128 + m * 16;
#pragma unroll
                for (int bj = 0; bj < 2; ++bj) store_bf16x8(outb + tok * 1024 + col0 + bj * 128, acc[ai][bj][m][0] * scale, acc[ai][bj][m][1] * scale);
            }
    }
};
__device__ __forceinline__ void phase_gemm_bf16(const Params& p, char* smem, const bf16_t* A, const bf16_t* Bt, bf16_t* outb, float scale) {
    SchedN1024<1> S{(int)gridDim.x, (int)blockIdx.x, (const char*)A, (const char*)Bt, (const char*)A, (const char*)Bt};
    EpiBf16 E{outb, scale};
    pg8::gemm_phase<EpiBf16, SchedN1024<1>>((LDS_AS unsigned char*)smem, 1024, S, E);
}

__device__ __forceinline__ void ln_row(float4 (&v)[4], const float* g, const float* bta, int lane) {
    float s = 0.f;
#pragma unroll
    for (int i = 0; i < 4; ++i) s += (v[i].x + v[i].y) + (v[i].z + v[i].w);
    const float mu = wsum(s) * (1.0f / 1024.0f);
    float q = 0.f;
#pragma unroll
    for (int i = 0; i < 4; ++i) { const float a = v[i].x - mu, b = v[i].y - mu, c = v[i].z - mu, d = v[i].w - mu; q += (a * a + b * b) + (c * c + d * d); }
    const float rstd = rsqrtf(wsum(q) * (1.0f / 1024.0f) + 1e-5f);
#pragma unroll
    for (int i = 0; i < 4; ++i) {
        const float4 gg = *(const float4*)(g + i * 256 + lane * 4), bb = *(const float4*)(bta + i * 256 + lane * 4);
        v[i].x = (v[i].x - mu) * rstd * gg.x + bb.x; v[i].y = (v[i].y - mu) * rstd * gg.y + bb.y;
        v[i].z = (v[i].z - mu) * rstd * gg.z + bb.z; v[i].w = (v[i].w - mu) * rstd * gg.w + bb.w;
    }
}

__device__ __forceinline__ void phase_ln1(const Params& p) {
    const int tid_ = opaque_tid(); const int lane = tid_ & 63, wid = tid_ >> 6;
    float* z = p.out; bf16_t* hb = (bf16_t*)(p.ws + OFF_R0);
    for (int row = blockIdx.x * 8 + wid; row < T_; row += gridDim.x * 8) {
        float4 v[4];
#pragma unroll
        for (int i = 0; i < 4; ++i) {
            const float4 xx = *(const float4*)(p.x + (size_t)row * 1024 + i * 256 + lane * 4);
            const uint2 mm = *(const uint2*)(hb + (size_t)row * 1024 + i * 256 + lane * 4);
            v[i].x = ALPHA * xx.x + bf_lo(mm.x); v[i].y = ALPHA * xx.y + bf_hi(mm.x); v[i].z = ALPHA * xx.z + bf_lo(mm.y); v[i].w = ALPHA * xx.w + bf_hi(mm.y);
        }
        ln_row(v, p.ln1g, p.ln1b, lane);
#pragma unroll
        for (int i = 0; i < 4; ++i) {
            *(float4*)(z + (size_t)row * 1024 + i * 256 + lane * 4) = v[i];
            uint2 w; w.x = pk_bf16(v[i].x, v[i].y); w.y = pk_bf16(v[i].z, v[i].w);
            *(uint2*)(hb + (size_t)row * 1024 + i * 256 + lane * 4) = w;
        }
    }
}

__device__ __forceinline__ void xa_stage_k(const bf16_t* kmat, int b, int h, int kh, char* buf, int tid) {
    const int rl = tid >> 5, pc = tid & 31, lc = pc ^ (rl & 15);
    const bf16_t* src = kmat + (size_t)(b * 256 + kh * 128 + rl) * 1024 + h * 256 + lc * 8;
#pragma unroll
    for (int i = 0; i < 8; ++i) glds16(src + (size_t)i * 16 * 1024, buf + (i * 512 + tid) * 16);
}
__device__ __forceinline__ void xa_stage_v(const bf16_t* vT, int b, int h, int vh, char* buf, int tid) {
    const int rl = tid >> 4, pc = tid & 15, lc = pc ^ (rl & 15);
    const bf16_t* src = vT + (size_t)(h * 256 + rl) * 4096 + b * 256 + vh * 128 + lc * 8;
#pragma unroll
    for (int i = 0; i < 8; ++i) glds16(src + (size_t)i * 32 * 4096, buf + (i * 512 + tid) * 16);
}

template <int KH>
__device__ __forceinline__ void xa_scores(f32x4 (&acc)[16][2], const char* buf, const bf16_t* q0p, const bf16_t* q1p, int fr, int fq) {
#pragma unroll 2
    for (int ks = 0; ks < 8; ++ks) {
        const bf16x8 q0 = *(const bf16x8*)(q0p + ks * 32), q1 = *(const bf16x8*)(q1p + ks * 32);
        const int ch = ((ks * 4 + fq) ^ fr) * 16;
#pragma unroll
        for (int mt = 0; mt < 8; ++mt) {
            const bf16x8 kf = *(const bf16x8*)(buf + (mt * 16 + fr) * 512 + ch);
            acc[KH * 8 + mt][0] = __builtin_amdgcn_mfma_f32_16x16x32_bf16(kf, q0, acc[KH * 8 + mt][0], 0, 0, 0);
            acc[KH * 8 + mt][1] = __builtin_amdgcn_mfma_f32_16x16x32_bf16(kf, q1, acc[KH * 8 + mt][1], 0, 0, 0);
        }
    }
}


template <int VH, int DH>
__device__ __forceinline__ void xa_pv(f32x4 (&o)[8][2], const u32x4 (&pf)[2][8], const char* buf, int fr, int fq) {
#pragma unroll
    for (int ks = 0; ks < 4; ++ks) {
        const int ca = ((ks * 4 + (fq >> 1)) ^ fr) * 16 + (fq & 1) * 8, cb = ((ks * 4 + 2 + (fq >> 1)) ^ fr) * 16 + (fq & 1) * 8;
        const bf16x8 p0 = __builtin_bit_cast(bf16x8, pf[0][VH * 4 + ks]), p1 = __builtin_bit_cast(bf16x8, pf[1][VH * 4 + ks]);
#pragma unroll
        for (int dt = 0; dt < 8; ++dt) {
            const char* rowp = buf + ((DH * 8 + dt) * 16 + fr) * 256;
            const u32x2 va = *(const u32x2*)(rowp + ca), vb = *(const u32x2*)(rowp + cb);
            u32x4 vv; vv[0] = va[0]; vv[1] = va[1]; vv[2] = vb[0]; vv[3] = vb[1];
            const bf16x8 vf = __builtin_bit_cast(bf16x8, vv);
            o[dt][0] = __builtin_amdgcn_mfma_f32_16x16x32_bf16(vf, p0, o[dt][0], 0, 0, 0);
            o[dt][1] = __builtin_amdgcn_mfma_f32_16x16x32_bf16(vf, p1, o[dt][1], 0, 0, 0);
        }
    }
}

__device__ __forceinline__ void phase6(const Params& p, char* smem) {
    const int tid = opaque_tid(), lane = tid & 63, wid = tid >> 6, fr = lane & 15, fq = lane >> 4;
    char* ws = p.ws;
    const bf16_t* xq = (const bf16_t*)(ws + OFF_XQ);
    const bf16_t* kmat = (const bf16_t*)(ws + OFF_KMAT);
    const bf16_t* vT = (const bf16_t*)(ws + OFF_VT);
    bf16_t* og = (bf16_t*)(ws + OFF_O);
    char* bufA = smem; char* bufB = smem + 65536;
    const int G = gridDim.x;
    for (int idx = blockIdx.x; idx < 1024; idx += G) {
        int pair, qt;
        if (G == 256) { const int i = idx >> 8, blk = idx & 255, xcd = blk & 7, jj = blk >> 3; pair = (i * 8 + xcd) * 2 + (jj >> 4); qt = jj & 15; }
        else { pair = idx >> 4; qt = idx & 15; }
        const int b = pair >> 2, h = pair & 3;
        const int tok0 = b * 4096 + qt * 256 + wid * 32;
        xa_stage_k(kmat, b, h, 0, bufA, tid);
        xa_stage_k(kmat, b, h, 1, bufB, tid);
        const bf16_t* q0p = xq + (size_t)(tok0 + fr) * 1024 + h * 256 + fq * 8;
        const bf16_t* q1p = q0p + (size_t)16 * 1024;
        f32x4 acc[16][2];
#pragma unroll
        for (int mt = 0; mt < 16; ++mt) { acc[mt][0] = (f32x4){0.f, 0.f, 0.f, 0.f}; acc[mt][1] = (f32x4){0.f, 0.f, 0.f, 0.f}; }
        asm volatile("s_waitcnt vmcnt(0)" ::: "memory");
        __syncthreads();
        xa_scores<0>(acc, bufA, q0p, q1p, fr, fq);
        xa_scores<1>(acc, bufB, q0p, q1p, fr, fq);
        __syncthreads();
        xa_stage_v(vT, b, h, 0, bufA, tid);
        xa_stage_v(vT, b, h, 1, bufB, tid);
        u32x4 pf[2][8]; float linv[2];
#pragma unroll
        for (int nt = 0; nt < 2; ++nt) {
            float m = -INFINITY;
#pragma unroll
            for (int mt = 0; mt < 16; ++mt) m = fmaxf(m, fmaxf(fmaxf(acc[mt][nt][0], acc[mt][nt][1]), fmaxf(acc[mt][nt][2], acc[mt][nt][3])));
            m = fmaxf(m, __shfl_xor(m, 16)); m = fmaxf(m, __shfl_xor(m, 32));
            float l = 0.f;
#pragma unroll
            for (int s2 = 0; s2 < 8; ++s2) {
                float e[8];
#pragma unroll
                for (int j = 0; j < 4; ++j) { e[j] = __expf(acc[2 * s2][nt][j] - m); e[4 + j] = __expf(acc[2 * s2 + 1][nt][j] - m); }
                l += ((e[0] + e[1]) + (e[2] + e[3])) + ((e[4] + e[5]) + (e[6] + e[7]));
                u32x4 w; w[0] = pk_bf16(e[0], e[1]); w[1] = pk_bf16(e[2], e[3]); w[2] = pk_bf16(e[4], e[5]); w[3] = pk_bf16(e[6], e[7]);
                pf[nt][s2] = w;
            }
            l += __shfl_xor(l, 16); l += __shfl_xor(l, 32);
            linv[nt] = 1.0f / l;
        }
        asm volatile("s_waitcnt vmcnt(0)" ::: "memory");
        __syncthreads();
        {
            f32x4 o[8][2];
#pragma unroll
            for (int dt = 0; dt < 8; ++dt) { o[dt][0] = (f32x4){0.f, 0.f, 0.f, 0.f}; o[dt][1] = (f32x4){0.f, 0.f, 0.f, 0.f}; }
            xa_pv<0, 0>(o, pf, bufA, fr, fq);
            xa_pv<1, 0>(o, pf, bufB, fr, fq);
#pragma unroll
            for (int nt = 0; nt < 2; ++nt) {
                bf16_t* rp = og + (size_t)(tok0 + nt * 16 + fr) * 1024 + h * 256 + fq * 4;
#pragma unroll
                for (int dt = 0; dt < 8; ++dt) store_bf16x4(rp + dt * 16, o[dt][nt] * linv[nt]);
            }
        }
        {
            f32x4 o[8][2];
#pragma unroll
            for (int dt = 0; dt < 8; ++dt) { o[dt][0] = (f32x4){0.f, 0.f, 0.f, 0.f}; o[dt][1] = (f32x4){0.f, 0.f, 0.f, 0.f}; }
            xa_pv<0, 1>(o, pf, bufA, fr, fq);
            xa_pv<1, 1>(o, pf, bufB, fr, fq);
#pragma unroll
            for (int nt = 0; nt < 2; ++nt) {
                bf16_t* rp = og + (size_t)(tok0 + nt * 16 + fr) * 1024 + h * 256 + 128 + fq * 4;
#pragma unroll
                for (int dt = 0; dt < 8; ++dt) store_bf16x4(rp + dt * 16, o[dt][nt] * linv[nt]);
            }
        }
        __syncthreads();
    }
}

__device__ __forceinline__ void phase_ln2_router(const Params& p, char* smem) {
    const int tid = opaque_tid(), lane = tid & 63, wid = tid >> 6;
    char* ws = p.ws;
    float* z = (float*)(ws + OFF_Z2); bf16_t* hb = (bf16_t*)(ws + OFF_R0); const bf16_t* xa = (const bf16_t*)(ws + OFF_XQ);
    int2* toke = (int2*)(ws + OFF_TOKE); float2* tokw = (float2*)(ws + OFF_TOKW);
    int* histg = (int*)(ws + OFF_HIST);
    int* hist = (int*)smem;
    for (int c = blockIdx.x; c < 256; c += gridDim.x) {
        if (tid < 64) hist[tid] = 0;
        __syncthreads();
        for (int rr = 0; rr < 32; ++rr) {
            const int row = c * 256 + wid * 32 + rr;
            float4 v[4];
#pragma unroll
            for (int i = 0; i < 4; ++i) {
                const float4 hh = *(const float4*)(p.out + (size_t)row * 1024 + i * 256 + lane * 4);
                const uint2 mm = *(const uint2*)(xa + (size_t)row * 1024 + i * 256 + lane * 4);
                v[i].x = ALPHA * hh.x + bf_lo(mm.x); v[i].y = ALPHA * hh.y + bf_hi(mm.x); v[i].z = ALPHA * hh.z + bf_lo(mm.y); v[i].w = ALPHA * hh.w + bf_hi(mm.y);
            }
            ln_row(v, p.ln2g, p.ln2b, lane);
#pragma unroll
            for (int i = 0; i < 4; ++i) {
                *(float4*)(z + (size_t)row * 1024 + i * 256 + lane * 4) = v[i];
                uint2 w; w.x = pk_bf16(v[i].x, v[i].y); w.y = pk_bf16(v[i].z, v[i].w);
                *(uint2*)(hb + (size_t)row * 1024 + i * 256 + lane * 4) = w;
            }
            float g[8];
#pragma unroll
            for (int k = 0; k < 8; ++k) g[k] = 0.f;
#pragma unroll
            for (int i = 0; i < 4; ++i) {
                const float vv[4] = {v[i].x, v[i].y, v[i].z, v[i].w};
#pragma unroll
                for (int jj = 0; jj < 4; ++jj) {
                    const float4* wp = (const float4*)(p.w_rg + (size_t)(i * 256 + lane * 4 + jj) * 8);
                    const float4 w0 = wp[0], w1 = wp[1];
                    g[0] += vv[jj] * w0.x; g[1] += vv[jj] * w0.y; g[2] += vv[jj] * w0.z; g[3] += vv[jj] * w0.w;
                    g[4] += vv[jj] * w1.x; g[5] += vv[jj] * w1.y; g[6] += vv[jj] * w1.z; g[7] += vv[jj] * w1.w;
                }
            }
            float gmax = -INFINITY; int gsel = 0;
#pragma unroll
            for (int k = 0; k < 8; ++k) { g[k] = wsum(g[k]) + p.b_rg[k]; if (g[k] > gmax) { gmax = g[k]; gsel = k; } }
            float gs = 0.f;
#pragma unroll
            for (int k = 0; k < 8; ++k) gs += __expf(g[k] - gmax);
            const float pgroup = 1.0f / gs;
            gsel = __builtin_amdgcn_readfirstlane(gsel);
            float ex[8];
#pragma unroll
            for (int k = 0; k < 8; ++k) ex[k] = 0.f;
#pragma unroll
            for (int i = 0; i < 4; ++i) {
                const float vv[4] = {v[i].x, v[i].y, v[i].z, v[i].w};
#pragma unroll
                for (int jj = 0; jj < 4; ++jj) {
                    const float4* wp = (const float4*)(p.w_re + (size_t)(i * 256 + lane * 4 + jj) * 64 + gsel * 8);
                    const float4 w0 = wp[0], w1 = wp[1];
                    ex[0] += vv[jj] * w0.x; ex[1] += vv[jj] * w0.y; ex[2] += vv[jj] * w0.z; ex[3] += vv[jj] * w0.w;
                    ex[4] += vv[jj] * w1.x; ex[5] += vv[jj] * w1.y; ex[6] += vv[jj] * w1.z; ex[7] += vv[jj] * w1.w;
                }
            }
            float v0 = -INFINITY, v1 = -INFINITY; int i0 = 0, i1 = 0;
#pragma unroll
            for (int k = 0; k < 8; ++k) {
                const float lv = wsum(ex[k]) + p.b_re[gsel * 8 + k];
                if (lv > v0) { v1 = v0; i1 = i0; v0 = lv; i0 = k; }
                else if (lv > v1) { v1 = lv; i1 = k; }
            }
            const float e1 = __expf(v1 - v0), den = 1.0f + e1;
            const float w0 = pgroup / den, w1 = pgroup * e1 / den;
            if (lane == 0) {
                const int ea = gsel * 8 + i0, eb = gsel * 8 + i1;
                toke[row] = make_int2(ea, eb); tokw[row] = make_float2(w0, w1);
                atomicAdd(&hist[ea], 1); atomicAdd(&hist[eb], 1);
            }
        }
        __syncthreads();
        if (tid < 64) histg[c * 64 + tid] = hist[tid];
        __syncthreads();
    }
}

__device__ __forceinline__ void compute_segments(const int* histg, int* seg, int tid) {
    if (tid < 64) {
        int s = 0;
        for (int c = 0; c < 256; ++c) s += histg[c * 64 + tid];
        seg[tid] = s;
    }
    __syncthreads();
    if (tid == 0) {
        int acc = 0;
        for (int e = 0; e < 64; ++e) { seg[64 + e] = acc; acc += (seg[e] + 255) >> 8; }
        seg[128] = acc;
    }
    __syncthreads();
}

__device__ __forceinline__ void phase8(const Params& p, char* smem) {
    const int tid = opaque_tid();
    char* ws = p.ws;
    const int* histg = (const int*)(ws + OFF_HIST);
    const int2* toke = (const int2*)(ws + OFF_TOKE); const float2* tokw = (const float2*)(ws + OFF_TOKW);
    int* slot_tok = (int*)(ws + OFF_SLOTTOK); float* slot_w = (float*)(ws + OFF_SLOTW);
    int* seg = (int*)smem;
    int* cursor = seg + 192;
    compute_segments(histg, seg, tid);
    for (int e = blockIdx.x; e < 64; e += gridDim.x) {
        const int start = seg[64 + e] * 256 + seg[e], end = seg[64 + e + 1] * 256;
        for (int s = start + tid; s < end; s += NTHR) { slot_tok[s] = -1; slot_w[s] = 0.f; }
    }
    for (int c = blockIdx.x; c < 256; c += gridDim.x) {
        __syncthreads();
        if (tid < 64) {
            int base = 0;
            for (int cc = 0; cc < c; ++cc) base += histg[cc * 64 + tid];
            cursor[tid] = seg[64 + tid] * 256 + base;
        }
        __syncthreads();
        if (tid < 256) {
            const int tok = c * 256 + tid;
            const int2 ee = toke[tok]; const float2 ww = tokw[tok];
            const int s0 = atomicAdd(&cursor[ee.x], 1);
            const int s1 = atomicAdd(&cursor[ee.y], 1);
            slot_tok[s0] = tok * 2; slot_w[s0] = ww.x;
            slot_tok[s1] = tok * 2 + 1; slot_w[s1] = ww.y;
        }
    }
}

__device__ __forceinline__ void phase9a(const Params& p, char* smem) {
    const int tid = opaque_tid(), lane = tid & 63, wid = tid >> 6, wr = wid >> 1, wc = wid & 1, fr = lane & 15, fq = lane >> 4;
    char* ws = p.ws;
    int* seg = (int*)(smem + LDS_GEMM);
    compute_segments((const int*)(ws + OFF_HIST), seg, tid);
    const int nrt = seg[128];
    const int* slot_tok = (const int*)(ws + OFF_SLOTTOK);
    const bf16_t* h2b = (const bf16_t*)(ws + OFF_R0);
    bf16_t* hbuf = (bf16_t*)(ws + OFF_R1);
    for (int it = 0;; ++it) {
        int t;
        if (!xcd_item(it, nrt * 4, t)) break;
        const int rtile = t >> 2, nt = t & 3;
        int e = 0;
        for (int k = 1; k < 64; ++k) if (seg[64 + k] <= rtile) e = k;
        GemmSrc s;
        {
            const int r = tid >> 3, lc = (tid & 7) ^ ((r >> 1) & 7);
#pragma unroll
            for (int i = 0; i < 4; ++i) {
                const int tk = slot_tok[rtile * 256 + i * 64 + r];
                const int tok = tk < 0 ? 0 : (tk >> 1);
                s.a[i] = h2b + (size_t)tok * 1024 + lc * 8;
            }
#pragma unroll
            for (int i = 0; i < 2; ++i) s.b[i] = (const bf16_t*)(ws + OFF_WGU) + (size_t)e * 512 * 1024 + (size_t)(nt * 128 + i * 64 + r) * 1024 + lc * 8;
        }
        f32x4 acc[4][4]; zero_acc(acc);
        gemm_loop(acc, s, 16, smem, tid);
        const int row0 = rtile * 256 + wr * 64 + fr;
        const int colb = (nt * 2 + wc) * 32 + fq * 4;
#pragma unroll
        for (int m = 0; m < 4; ++m) {
            const size_t slot = row0 + m * 16;
#pragma unroll
            for (int n = 0; n < 2; ++n) {
                const f32x4 g = acc[m][n], u = acc[m][n + 2];
                f32x4 v;
#pragma unroll
                for (int j = 0; j < 4; ++j) v[j] = g[j] * sigmoidf_(g[j]) * u[j];
                store_bf16x4(hbuf + slot * 256 + colb + n * 16, v);
            }
        }
    }
}

struct Sched9b {
    int G, c, nrt; const int* seg; const char* hbuf; const char* wd;
    __device__ __forceinline__ bool next(int i, pg8::Unit& u) const {
        int rtile, pn;
        if ((G & 7) == 0) { const int x = c & 7, j = c >> 3, nj = G >> 3, per = (nrt + 7) >> 3; const int uidx = i * nj + j; if (uidx >= per * 4) return false; rtile = x * per + (uidx >> 2); pn = uidx & 3; if (rtile >= nrt) return false; }
        else { const int uidx = i * G + c; if (uidx >= nrt * 4) return false; rtile = uidx >> 2; pn = uidx & 3; }
        int e = 0;
        for (int k = 1; k < 64; ++k) if (seg[64 + k] <= rtile) e = k;
        u.pm = rtile; u.pn = pn; u.aux = e; u.A = hbuf; u.Bt = wd + (size_t)e * 1024 * 256 * 2;
        return true;
    }
};
struct Epi9b {
    const int* slot_tok; const float* slot_w; bf16_t* yb;
    __device__ __forceinline__ void operator()(const f32x4 (&acc)[2][2][4][2], const pg8::Unit& u, int wr, int wc, int fr, int fq) const {
        const int row0 = u.pm * 256 + wr * 64 + fr, col0 = u.pn * 256 + wc * 32 + fq * 8;
#pragma unroll
        for (int ai = 0; ai < 2; ++ai)
#pragma unroll
            for (int m = 0; m < 4; ++m) {
                const int slot = row0 + ai * 128 + m * 16;
                const int tk = slot_tok[slot]; const float w = slot_w[slot];
                if (tk >= 0) {
#pragma unroll
                    for (int bj = 0; bj < 2; ++bj) store_bf16x8(yb + (size_t)tk * 1024 + col0 + bj * 128, acc[ai][bj][m][0] * w, acc[ai][bj][m][1] * w);
                }
            }
    }
};
__device__ __forceinline__ void phase9b(const Params& p, char* smem) {
    const int tid = opaque_tid();
    char* ws = p.ws;
    int* seg = (int*)(smem + LDS_GEMM);
    compute_segments((const int*)(ws + OFF_HIST), seg, tid);
    Sched9b S{(int)gridDim.x, (int)blockIdx.x, seg[128], seg, ws + OFF_R1, ws + OFF_WD};
    Epi9b E{(const int*)(ws + OFF_SLOTTOK), (const float*)(ws + OFF_SLOTW), (bf16_t*)(ws + OFF_YB)};
    pg8::gemm_phase<Epi9b, Sched9b>((LDS_AS unsigned char*)smem, 256, S, E);
}

__device__ __forceinline__ void phase10(const Params& p) {
    const int tid_ = opaque_tid(); const int lane = tid_ & 63, wid = tid_ >> 6;
    const float* h2 = (const float*)(p.ws + OFF_Z2); const bf16_t* yb = (const bf16_t*)(p.ws + OFF_YB);
    for (int row = blockIdx.x * 8 + wid; row < T_; row += gridDim.x * 8) {
        float4 v[4];
#pragma unroll
        for (int i = 0; i < 4; ++i) {
            const float4 hh = *(const float4*)(h2 + (size_t)row * 1024 + i * 256 + lane * 4);
            const uint2 a = *(const uint2*)(yb + (size_t)(row * 2) * 1024 + i * 256 + lane * 4), b = *(const uint2*)(yb + (size_t)(row * 2 + 1) * 1024 + i * 256 + lane * 4);
            v[i].x = ALPHA * hh.x + bf_lo(a.x) + bf_lo(b.x); v[i].y = ALPHA * hh.y + bf_hi(a.x) + bf_hi(b.x);
            v[i].z = ALPHA * hh.z + bf_lo(a.y) + bf_lo(b.y); v[i].w = ALPHA * hh.w + bf_hi(a.y) + bf_hi(b.y);
        }
        ln_row(v, p.ln3g, p.ln3b, lane);
#pragma unroll
        for (int i = 0; i < 4; ++i) *(float4*)(p.out + (size_t)row * 1024 + i * 256 + lane * 4) = v[i];
    }
}

#define XB_TMO      128
#define XB_XCNT(j)  (256  + 64 * (j))
#define XB_XSUB(j)  (1280 + 64 * (j))
#define XB_XGEN(j)  (2304 + 64 * (j))
#define XB_TOP      3328
#define XB_TOPGEN   3392
#define XCD_BAR_WORDS 3456
#define XB_SPIN_CAP (1u << 18)
#define LAS LDS_AS

__device__ __forceinline__ unsigned xb_ld(unsigned* p)              { return __hip_atomic_load(p, __ATOMIC_RELAXED, __HIP_MEMORY_SCOPE_AGENT); }
__device__ __forceinline__ unsigned xb_add(unsigned* p, unsigned v) { return __hip_atomic_fetch_add(p, v, __ATOMIC_RELAXED, __HIP_MEMORY_SCOPE_AGENT); }
__device__ __forceinline__ unsigned xb_xcc_id() { return (unsigned)__builtin_amdgcn_s_getreg((3 << 11) | 20) & 0xFu; }
#define XB_SPIN(cond, bar) do { unsigned _sp = 0; while (cond) { __builtin_amdgcn_s_sleep(1); \
    if ((++_sp & 255u) == 0u) { if (xb_ld(&(bar)[XB_TMO])) break; if (_sp > XB_SPIN_CAP) { atomicAdd(&(bar)[XB_TMO], 1u); break; } } } } while (0)

struct XcdBarrier {
    unsigned* bar; unsigned x;
    volatile LAS unsigned* st;
};

__device__ __forceinline__ XcdBarrier xcd_barrier_post(unsigned* bar, volatile LAS unsigned* st) {
    XcdBarrier b; b.bar = bar; b.x = xb_xcc_id(); b.st = st;
    if (threadIdx.x == 0) (void)xb_add(&bar[XB_XCNT(b.x)], 1u);
    return b;
}
__device__ __forceinline__ void xcd_barrier_complete(unsigned* bar, unsigned x, unsigned& nloc, unsigned& nx) {
    const unsigned G = gridDim.x * gridDim.y * gridDim.z;
    unsigned sum, cnt, mine, sp = 0u;
    for (;;) {
        sum = 0u; cnt = 0u; mine = 0u;
#pragma unroll
        for (unsigned j = 0; j < 16; ++j) { const unsigned c = xb_ld(&bar[XB_XCNT(j)]); sum += c; cnt += (c > 0u) ? 1u : 0u; mine = (j == x) ? c : mine; }
        if (sum == G) break;
        __builtin_amdgcn_s_sleep(1);
        if ((++sp & 255u) == 0u) { if (xb_ld(&bar[XB_TMO])) break; if (sp > XB_SPIN_CAP) { atomicAdd(&bar[XB_TMO], 1u); break; } }
    }
    nloc = mine > 0u ? mine : 1u; nx = cnt > 0u ? cnt : 1u;
}

__device__ __forceinline__ void xcd_barrier(const XcdBarrier& b) {
    asm volatile("s_waitcnt vmcnt(0)" ::: "memory");
    __syncthreads();
    if (threadIdx.x == 0) {
        unsigned* bar = b.bar;
        __builtin_amdgcn_s_waitcnt(0);
        unsigned nloc = b.st[0], nx = b.st[1];
        if (nloc == 0u) { xcd_barrier_complete(bar, b.x, nloc, nx); b.st[0] = nloc; b.st[1] = nx; }
        const unsigned old = xb_add(&bar[XB_XSUB(b.x)], 1u);
        const unsigned gen = old / nloc;
        if (old + 1u == (gen + 1u) * nloc) {
            __builtin_amdgcn_fence(__ATOMIC_RELEASE, "agent");
            asm volatile("s_waitcnt vmcnt(0)" ::: "memory");
            const unsigned og = xb_add(&bar[XB_TOP], 1u);
            const unsigned tg = og / nx;
            if (og + 1u == (tg + 1u) * nx) xb_add(&bar[XB_TOPGEN], 1u);
            else XB_SPIN(xb_ld(&bar[XB_TOPGEN]) == tg, bar);
            __builtin_amdgcn_fence(__ATOMIC_ACQUIRE, "agent");
            xb_add(&bar[XB_XGEN(b.x)], 1u);
            asm volatile("s_waitcnt vmcnt(0)" ::: "memory");
        } else {
            XB_SPIN(xb_ld(&bar[XB_XGEN(b.x)]) == gen, bar);
            __builtin_amdgcn_fence(__ATOMIC_ACQUIRE, "agent");
            asm volatile("s_waitcnt vmcnt(0)" ::: "memory");
        }
    }
    __syncthreads();
}


#ifndef DUP
#define DUP (-1)
#endif
#define RUN(id, call) do { call; if (DUP == (id)) { GRID_SYNC(); call; } } while (0)
__global__ void __launch_bounds__(NTHR) mega(Params p) {
    extern __shared__ __attribute__((aligned(16))) char smem[];
    cg::grid_group grid = cg::this_grid();
    char* ws = p.ws;
    volatile LDS_AS unsigned* xst = (volatile LDS_AS unsigned*)(LDS_AS char*)smem + (LDS_XB / 4);
    if (threadIdx.x < 4) xst[threadIdx.x] = 0u;
    __syncthreads();
    const XcdBarrier xbar = xcd_barrier_post((unsigned*)(ws + OFF_BAR), xst);
#define GRID_SYNC() xcd_barrier(xbar)
    RUN(0, phase0(p, smem));
    grid.sync();
    RUN(1, phase1(p, smem));
    if (DUP == 30) { GRID_SYNC(); phase1(p, smem, 1); }
    GRID_SYNC();
    RUN(2, phase2(p, smem));
    if (DUP == 20) { GRID_SYNC(); phase2(p, smem, 1); }
    if (DUP == 21) { GRID_SYNC(); phase2(p, smem, 2); }
    GRID_SYNC();
    RUN(3, phase3(p, smem));
    GRID_SYNC();
    RUN(4, phase_gemm_bf16(p, smem, (const bf16_t*)(ws + OFF_R1), (const bf16_t*)(ws + OFF_WMIX), (bf16_t*)(ws + OFF_R0), 1.0f));
    GRID_SYNC();
    phase_ln1(p);
    RUN(5, moe_weight_prep(p, smem));
    GRID_SYNC();
    RUN(6, phase_gemm_bf16(p, smem, (const bf16_t*)(ws + OFF_R0), (const bf16_t*)(ws + OFF_WXQ), (bf16_t*)(ws + OFF_XQ), 0.0625f));
    GRID_SYNC();
    RUN(7, phase6(p, smem));
    GRID_SYNC();
    RUN(8, phase_gemm_bf16(p, smem, (const bf16_t*)(ws + OFF_O), (const bf16_t*)(ws + OFF_WXO), (bf16_t*)(ws + OFF_XQ), 1.0f));
    GRID_SYNC();
    phase_ln2_router(p, smem);
    GRID_SYNC();
    RUN(9, phase8(p, smem));
    GRID_SYNC();
    RUN(10, phase9a(p, smem));
    GRID_SYNC();
    RUN(11, phase9b(p, smem));
    GRID_SYNC();
    phase10(p);
}

extern "C" void kernel_launch(void* const* d_in, const int* in_sizes, int n_in, void* d_out, int out_size,
                              void* d_ws, size_t ws_size, hipStream_t stream) {
    static int grid_blocks = 0;
    if (!grid_blocks) {
        int dev = 0, cus = 0, per_cu = 0;
        (void)hipGetDevice(&dev);
        (void)hipDeviceGetAttribute(&cus, hipDeviceAttributeMultiprocessorCount, dev);
        (void)hipFuncSetAttribute((const void*)mega, hipFuncAttributeMaxDynamicSharedMemorySize, LDS_BYTES);
        (void)hipOccupancyMaxActiveBlocksPerMultiprocessor(&per_cu, mega, NTHR, LDS_BYTES);
        if (per_cu > 1) per_cu = 1;
        grid_blocks = cus * per_cu;
        if (ws_size < WS_NEED) fprintf(stderr, "workspace too small: %zu\n", ws_size);
    }
    Params p{};
    const float* const* f = (const float* const*)d_in;
    p.x = f[0]; p.mem = f[1]; p.pos = (const int*)d_in[2];
    p.w_in = f[3]; p.sinks = f[4]; p.conv_w = f[5]; p.conv_b = f[6]; p.b_ig = f[7]; p.b_fg = f[8]; p.ml_g = f[9];
    p.w_att = f[10]; p.w_ml = f[11]; p.w_mix = f[12]; p.ln1g = f[13]; p.ln1b = f[14];
    p.w_xq = f[15]; p.w_xkv = f[16]; p.w_xo = f[17]; p.ln2g = f[18]; p.ln2b = f[19];
    p.w_rg = f[20]; p.b_rg = f[21]; p.w_re = f[22]; p.b_re = f[23]; p.w_gate = f[24]; p.w_up = f[25]; p.w_down = f[26];
    p.ln3g = f[27]; p.ln3b = f[28];
    p.out = (float*)d_out; p.ws = (char*)d_ws;
    (void)hipMemsetAsync((char*)d_ws + OFF_BAR, 0, XCD_BAR_WORDS * sizeof(unsigned), stream);
    void* args[] = {&p};
    hipError_t e = hipLaunchCooperativeKernel((void*)mega, dim3(grid_blocks), dim3(NTHR), args, LDS_BYTES, stream);
    if (e != hipSuccess) fprintf(stderr, "cooperative launch failed: %s (grid %d)\n", hipGetErrorString(e), grid_blocks);
}
```

```cpp
#include <hip/hip_runtime.h>
#include <hip/hip_cooperative_groups.h>
#include <cstdio>
#include <cstdint>
namespace cg = cooperative_groups;

typedef unsigned short bf16_t;
typedef short bf16x8 __attribute__((ext_vector_type(8)));
typedef float f32x4 __attribute__((ext_vector_type(4)));
typedef unsigned u32x2 __attribute__((ext_vector_type(2)));
typedef unsigned u32x4 __attribute__((ext_vector_type(4)));
#define LDS_AS __attribute__((address_space(3)))
#define GLB_AS __attribute__((address_space(1)))

constexpr int T_ = 65536;
constexpr int NTHR = 512;
constexpr size_t MiB = 1ull << 20;
constexpr float ALPHA = 1.189207115002721f;
constexpr size_t OFF_R0 = 0;
constexpr size_t OFF_R1 = 128 * MiB;
constexpr size_t OFF_AK = 256 * MiB;
constexpr size_t OFF_AV = 272 * MiB;
constexpr size_t OFF_MQK = 288 * MiB;
constexpr size_t OFF_MV = 416 * MiB;
constexpr size_t OFF_MO = 544 * MiB;
constexpr size_t OFF_GG = 672 * MiB;
constexpr size_t OFF_WGU = 256 * MiB;
constexpr size_t OFF_WD = 320 * MiB;
constexpr size_t OFF_XQ = 352 * MiB;
constexpr size_t OFF_O = 480 * MiB;
constexpr size_t OFF_Z2 = 608 * MiB;
constexpr size_t OFF_YB = 352 * MiB;
constexpr size_t OFF_MISC = 928 * MiB;
constexpr size_t OFF_WIN = OFF_MISC;
constexpr size_t OFF_MEMB = OFF_MISC + 13 * MiB;
constexpr size_t OFF_CS = OFF_MISC + 21 * MiB;
constexpr size_t OFF_WXKV = OFF_MISC + 37 * MiB;
constexpr size_t OFF_WATT = OFF_MISC + 41 * MiB;
constexpr size_t OFF_WML = OFF_MISC + 43 * MiB;
constexpr size_t OFF_WMIX = OFF_MISC + 45 * MiB;
constexpr size_t OFF_WXQ = OFF_MISC + 47 * MiB;
constexpr size_t OFF_WXO = OFF_MISC + 49 * MiB;
constexpr size_t OFF_KMAT = OFF_MISC + 51 * MiB;
constexpr size_t OFF_VT = OFF_MISC + 59 * MiB;
constexpr size_t OFF_GATES = OFF_MISC + 67 * MiB;
constexpr size_t OFF_TOKE = OFF_MISC + 69 * MiB;
constexpr size_t OFF_TOKW = OFF_MISC + 70 * MiB;
constexpr size_t OFF_SLOTTOK = OFF_MISC + 71 * MiB;
constexpr size_t OFF_SLOTW = OFF_MISC + 72 * MiB;
constexpr size_t OFF_HIST = OFF_MISC + 73 * MiB;
constexpr size_t OFF_BAR = OFF_MISC + 74 * MiB;
constexpr size_t OFF_SP = OFF_MISC;
constexpr size_t OFF_REC = OFF_MISC + 32 * MiB;
constexpr size_t OUT_QP = 128 * MiB;
constexpr size_t OUT_KP = 192 * MiB;
constexpr size_t WS_NEED = 1024 * MiB;
constexpr int LDS_GEMM = 147456;
constexpr int LDS_PARAMS = 163520;
constexpr int LDS_XB = 163776;
constexpr int LDS_BYTES = 163840;

struct Params {
    const float *x, *mem; const int* pos;
    const float *w_in, *sinks, *conv_w, *conv_b, *b_ig, *b_fg, *ml_g, *w_att, *w_ml, *w_mix, *ln1g, *ln1b;
    const float *w_xq, *w_xkv, *w_xo, *ln2g, *ln2b, *w_rg, *b_rg, *w_re, *b_re, *w_gate, *w_up, *w_down, *ln3g, *ln3b;
    float* out; char* ws;
};

__device__ const double INV_FREQ[32] = {1.0, 0.7498942093324559, 0.5623413251903491, 0.4216965034285822, 0.31622776601683794, 0.23713737056616552, 0.1778279410038923, 0.1333521432163324, 0.1, 0.07498942093324558, 0.05623413251903491, 0.042169650342858224, 0.03162277660168379, 0.023713737056616554, 0.01778279410038923, 0.01333521432163324, 0.01, 0.007498942093324558, 0.005623413251903491, 0.004216965034285823, 0.0031622776601683794, 0.0023713737056616554, 0.0017782794100389228, 0.001333521432163324, 0.001, 0.0007498942093324559, 0.0005623413251903491, 0.00042169650342858224, 0.00031622776601683794, 0.00023713737056616554, 0.00017782794100389227, 0.0001333521432163324};

template <class T> __device__ __forceinline__ T* uni(T* q) {
    const unsigned long long v = (unsigned long long)q;
    const unsigned lo = __builtin_amdgcn_readfirstlane((unsigned)v), hi = __builtin_amdgcn_readfirstlane((unsigned)(v >> 32));
    return (T*)(((unsigned long long)hi << 32) | lo);
}
__device__ __forceinline__ int opaque_tid() { int t = threadIdx.x; asm volatile("" : "+v"(t)); return t; }
__device__ __forceinline__ unsigned pk_bf16(float lo, float hi) { unsigned r; asm("v_cvt_pk_bf16_f32 %0, %1, %2" : "=v"(r) : "v"(lo), "v"(hi)); return r; }
__device__ __forceinline__ float bf_lo(unsigned u) { return __uint_as_float(u << 16); }
__device__ __forceinline__ float bf_hi(unsigned u) { return __uint_as_float(u & 0xffff0000u); }
__device__ __forceinline__ float bf2f(bf16_t h) { return __uint_as_float(((unsigned)h) << 16); }
__device__ __forceinline__ float wsum(float v) {
#pragma unroll
    for (int o = 32; o; o >>= 1) v += __shfl_xor(v, o);
    return v;
}
__device__ __forceinline__ float wmaxf(float v) {
#pragma unroll
    for (int o = 32; o; o >>= 1) v = fmaxf(v, __shfl_xor(v, o));
    return v;
}
__device__ __forceinline__ float sigmoidf_(float x) { return 1.0f / (1.0f + __expf(-x)); }
__device__ __forceinline__ void glds16(const bf16_t* g, char* l) {
    __builtin_amdgcn_global_load_lds((const GLB_AS void*)g, (LDS_AS void*)l, 16, 0, 0);
}

__device__ __forceinline__ bool xcd_item(int i, int n, int& item) {
    const int G = gridDim.x;
    if ((G & 7) == 0) {
        const int x = blockIdx.x & 7, j = blockIdx.x >> 3, nj = G >> 3;
        const int per = (n + 7) >> 3;
        const int u = i * nj + j;
        if (u >= per) return false;
        item = x * per + u;
        return item < n;
    }
    item = blockIdx.x + i * G;
    return item < n;
}

struct GemmSrc { const bf16_t* a[4]; const bf16_t* b[2]; };

__device__ __forceinline__ void stage_tile(const GemmSrc& s, int koff, char* buf, int tid) {
#pragma unroll
    for (int i = 0; i < 4; ++i) glds16(s.a[i] + koff, buf + (i * 512 + tid) * 16);
#pragma unroll
    for (int i = 0; i < 2; ++i) glds16(s.b[i] + koff, buf + 32768 + (i * 512 + tid) * 16);
}

constexpr int GEMM_STAGE = 49152;
__device__ __forceinline__ void gemm_loop(f32x4 (&acc)[4][4], const GemmSrc& s, int nk, char* smem, int tid) {
    const int lane = tid & 63, wid = tid >> 6, wr = wid >> 1, wc = wid & 1, fr = lane & 15, fq = lane >> 4;
    const int swz = (fr >> 1) & 7;
    const int aoff = (wr * 64 + fr) * 128;
    const int boff = 32768 + (wc * 64 + fr) * 128;
    stage_tile(s, 0, smem, tid);
    if (nk > 1) stage_tile(s, 64, smem + GEMM_STAGE, tid);
    int cur = 0, nxt = 2;
#pragma unroll 1
    for (int t = 0; t < nk; ++t) {
        if (t + 1 < nk) asm volatile("s_waitcnt vmcnt(6)" ::: "memory"); else asm volatile("s_waitcnt vmcnt(0)" ::: "memory");
        __builtin_amdgcn_s_barrier();
        if (t + 2 < nk) stage_tile(s, (t + 2) * 64, smem + nxt * GEMM_STAGE, tid);
        const char* cb = smem + cur * GEMM_STAGE;
#pragma unroll
        for (int ks = 0; ks < 2; ++ks) {
            const int ch = ((ks * 4 + fq) ^ swz) * 16;
            bf16x8 xa[4], wb[4];
#pragma unroll
            for (int m = 0; m < 4; ++m) xa[m] = *(const bf16x8*)(cb + aoff + m * 2048 + ch);
#pragma unroll
            for (int n = 0; n < 4; ++n) wb[n] = *(const bf16x8*)(cb + boff + n * 2048 + ch);
#pragma unroll
            for (int m = 0; m < 4; ++m)
#pragma unroll
                for (int n = 0; n < 4; ++n) acc[m][n] = __builtin_amdgcn_mfma_f32_16x16x32_bf16(wb[n], xa[m], acc[m][n], 0, 0, 0);
        }
        cur = cur == 2 ? 0 : cur + 1; nxt = nxt == 2 ? 0 : nxt + 1;
    }
    __syncthreads();
}

__device__ __forceinline__ void zero_acc(f32x4 (&acc)[4][4]) {
#pragma unroll
    for (int m = 0; m < 4; ++m)
#pragma unroll
        for (int n = 0; n < 4; ++n) acc[m][n] = (f32x4){0.f, 0.f, 0.f, 0.f};
}

__device__ __forceinline__ void make_src(GemmSrc& s, const bf16_t* A, size_t lda, int rowA0, const bf16_t* Bt, size_t ldb, int rowB0, int tid) {
    const int r = tid >> 3, lc = (tid & 7) ^ ((r >> 1) & 7);
#pragma unroll
    for (int i = 0; i < 4; ++i) s.a[i] = A + (size_t)(rowA0 + i * 64 + r) * lda + lc * 8;
#pragma unroll
    for (int i = 0; i < 2; ++i) s.b[i] = Bt + (size_t)(rowB0 + i * 64 + r) * ldb + lc * 8;
}

__device__ __forceinline__ void store_bf16x8(bf16_t* p, f32x4 a, f32x4 b) {
    u32x4 w; w[0] = pk_bf16(a[0], a[1]); w[1] = pk_bf16(a[2], a[3]); w[2] = pk_bf16(b[0], b[1]); w[3] = pk_bf16(b[2], b[3]); *(u32x4*)p = w;
}
__device__ __forceinline__ void store_bf16x4(bf16_t* p, f32x4 v) {
    uint2 w; w.x = pk_bf16(v[0], v[1]); w.y = pk_bf16(v[2], v[3]); *(uint2*)p = w;
}

namespace pg8 {
constexpr int BM = 256, BK = 64, HALF = 128, HTB = HALF * BK * 2;
__device__ __forceinline__ int lds_byte(int r, int c) { const int st = (r >> 4) * 2 + (c >> 5), rr = r & 15, cc = c & 31, ob = rr * 64 + cc * 2; return st * 1024 + (ob ^ (((ob >> 9) & 1) << 5)); }
__device__ __forceinline__ void stage_rc(int b, int& R, int& C) { const int st = b / 1024, sb = b % 1024, swz = sb ^ (((sb >> 9) & 1) << 5); R = (st >> 1) * 16 + swz / 64; C = (st & 1) * 32 + (swz % 64) / 2; }
struct Unit { int pm, pn, aux; const char* A; const char* Bt; };

template <class Epi, class Sched>
__device__ __forceinline__ void gemm_phase(LDS_AS unsigned char* lds, const int K, const Sched& S, const Epi& E) {
    const int tid = opaque_tid(), wid = __builtin_amdgcn_readfirstlane(tid >> 6), lane = tid & 63, wr = wid >> 2, wc = wid & 3, fr = lane & 15, fq = lane >> 4;
    const int nt = K / BK;
    unsigned voff[2];
#pragma unroll
    for (int i = 0; i < 2; ++i) { int R, C; stage_rc(tid * 16 + i * 8192, R, C); voff[i] = (unsigned)(R * K + C) * 2u; }
    const size_t kstep = (size_t)(BK * 2);
    const size_t hstep = (size_t)HALF * K * 2;
    const size_t tstep = 2 * hstep;
    const unsigned ldsw = (unsigned)wid * 1024u;
    const int aoff = lds_byte(wr * 64 + fr, fq * 8), boff = lds_byte(wc * 32 + fr, fq * 8);
#define PG8_SA(b, h) (((b) * 2 + (h)) * HTB)
#define PG8_SB(b, h) ((4 + (b) * 2 + (h)) * HTB)
#define PG8_STAGE(bufoff, gbase) do { _Pragma("unroll") for (int _i = 0; _i < 2; ++_i) \
        __builtin_amdgcn_global_load_lds((const GLB_AS void*)((const char*)(gbase) + voff[_i]), (LDS_AS void*)(lds + (bufoff) + ldsw + _i * 8192), 16, 0, 0); } while (0)
#define PG8_LDA(dst, b, h) do { _Pragma("unroll") for (int m = 0; m < 4; ++m) _Pragma("unroll") for (int k = 0; k < 2; ++k) dst[m][k] = *(const LDS_AS bf16x8*)(lds + PG8_SA(b, h) + aoff + m * 2048 + k * 1024); } while (0)
#define PG8_LDB(dst, b, h) do { _Pragma("unroll") for (int n = 0; n < 2; ++n) _Pragma("unroll") for (int k = 0; k < 2; ++k) dst[n][k] = *(const LDS_AS bf16x8*)(lds + PG8_SB(b, h) + boff + n * 2048 + k * 1024); } while (0)
#define PG8_MMA(ai, bj, At, Bt) do { __builtin_amdgcn_s_setprio(1); _Pragma("unroll") for (int m = 0; m < 4; ++m) _Pragma("unroll") for (int n = 0; n < 2; ++n) _Pragma("unroll") for (int k = 0; k < 2; ++k) \
        acc[ai][bj][m][n] = __builtin_amdgcn_mfma_f32_16x16x32_bf16(Bt[n][k], At[m][k], acc[ai][bj][m][n], 0, 0, 0); __builtin_amdgcn_s_setprio(0); } while (0)
#define PG8_WAIT_V(n) asm volatile("s_waitcnt vmcnt(" #n ")" ::: "memory")
#define PG8_WAIT_L(n) asm volatile("s_waitcnt lgkmcnt(" #n ")" ::: "memory")
#define PG8_BAR __builtin_amdgcn_s_barrier()
#define PG8_SCHED __builtin_amdgcn_sched_barrier(0)
    Unit cur, nxt; int ui = 0;
    if (!S.next(0, cur)) return;
    f32x4 acc[2][2][4][2];
#pragma unroll
    for (int a = 0; a < 2; ++a)
#pragma unroll
        for (int b = 0; b < 2; ++b)
#pragma unroll
            for (int m = 0; m < 4; ++m)
#pragma unroll
                for (int n = 0; n < 2; ++n) acc[a][b][m][n] = (f32x4){0.f, 0.f, 0.f, 0.f};
    bf16x8 At[4][2], B0[2][2], B1[2][2];
    const char* cA = cur.A + (size_t)cur.pm * tstep; const char* cB = cur.Bt + (size_t)cur.pn * tstep;
    PG8_STAGE(PG8_SB(0, 0), cB); PG8_STAGE(PG8_SB(0, 1), cB + hstep); PG8_STAGE(PG8_SA(0, 0), cA); PG8_STAGE(PG8_SA(0, 1), cA + hstep);
    if (wr == 1) PG8_BAR;
    PG8_WAIT_V(2); PG8_BAR;
    PG8_STAGE(PG8_SB(1, 0), cB + kstep); PG8_STAGE(PG8_SA(1, 0), cA + kstep); PG8_STAGE(PG8_SB(1, 1), cB + hstep + kstep);
    PG8_WAIT_V(6); PG8_BAR;
    for (;;) {
        const bool has_next = S.next(ui + 1, nxt);
        const char* nA = has_next ? nxt.A + (size_t)nxt.pm * tstep : cA; const char* nB = has_next ? nxt.Bt + (size_t)nxt.pn * tstep : cB;
        for (int t = 0; t < nt; t += 2) {
            const bool last = (t == nt - 2);
            const char* a1 = cA + (size_t)(t + 1) * kstep;
            const char* a2 = last ? nA : cA + (size_t)(t + 2) * kstep; const char* b2 = last ? nB : cB + (size_t)(t + 2) * kstep;
            const char* a3 = a2 + kstep; const char* b3 = b2 + kstep;
            PG8_LDB(B0, 0, 0); PG8_LDB(B1, 0, 1); PG8_SCHED; PG8_LDA(At, 0, 0); PG8_STAGE(PG8_SA(1, 1), a1 + hstep);
            PG8_WAIT_V(8); PG8_WAIT_L(0); PG8_BAR; PG8_MMA(0, 0, At, B0); PG8_MMA(0, 1, At, B1); PG8_BAR; PG8_SCHED;
            PG8_LDA(At, 0, 1); PG8_STAGE(PG8_SB(0, 0), b2); PG8_STAGE(PG8_SB(0, 1), b2 + hstep); PG8_STAGE(PG8_SA(0, 0), a2);
            PG8_WAIT_V(8); PG8_WAIT_L(0); PG8_BAR; PG8_MMA(1, 0, At, B0); PG8_MMA(1, 1, At, B1); PG8_BAR; PG8_SCHED;
            PG8_LDB(B0, 1, 0); PG8_LDB(B1, 1, 1); PG8_SCHED; PG8_LDA(At, 1, 0); PG8_STAGE(PG8_SA(0, 1), a2 + hstep);
            PG8_WAIT_V(8); PG8_WAIT_L(0); PG8_BAR; PG8_MMA(0, 0, At, B0); PG8_MMA(0, 1, At, B1); PG8_BAR; PG8_SCHED;
            PG8_LDA(At, 1, 1); PG8_STAGE(PG8_SB(1, 0), b3); PG8_STAGE(PG8_SB(1, 1), b3 + hstep); PG8_STAGE(PG8_SA(1, 0), a3);
            PG8_WAIT_V(8); PG8_WAIT_L(0); PG8_BAR; PG8_MMA(1, 0, At, B0); PG8_MMA(1, 1, At, B1); PG8_BAR; PG8_SCHED;
        }
        if (wr == 0) PG8_BAR;
        E(acc, cur, wr, wc, fr, fq);
        if (!has_next) break;
#pragma unroll
        for (int a = 0; a < 2; ++a)
#pragma unroll
            for (int b = 0; b < 2; ++b)
#pragma unroll
                for (int m = 0; m < 4; ++m)
#pragma unroll
                    for (int n = 0; n < 2; ++n) acc[a][b][m][n] = (f32x4){0.f, 0.f, 0.f, 0.f};
        cur = nxt; cA = nA; cB = nB; ++ui;
        if (wr == 1) PG8_BAR;
    }
    PG8_WAIT_V(0);
    PG8_BAR;
#undef PG8_SA
#undef PG8_SB
#undef PG8_STAGE
#undef PG8_LDA
#undef PG8_LDB
#undef PG8_MMA
#undef PG8_WAIT_V
#undef PG8_WAIT_L
#undef PG8_BAR
#undef PG8_SCHED
}
}

__device__ __forceinline__ int perm32(int rho) { const int n = rho >> 4, i = rho & 15; return 8 * (i >> 2) + 4 * n + (i & 3); }
template <bool PERM>
__device__ __forceinline__ void tr_tile_t(const float* src, size_t ld_src, int k0, int c0, bf16_t* dst, size_t ld_dst, int r0, float* tile, int tid) {
    {
        const int r = tid >> 3, c4 = (tid & 7) * 4;
        const float4 v = *(const float4*)(src + (size_t)(k0 + r) * ld_src + c0 + c4);
        float* tp = tile + r * 33 + c4; tp[0] = v.x; tp[1] = v.y; tp[2] = v.z; tp[3] = v.w;
    }
    __syncthreads();
    {
        const int c = tid >> 4, rc = (tid & 15) * 4, sc = PERM ? perm32(c) : c;
        const float a0 = tile[(rc + 0) * 33 + sc], a1 = tile[(rc + 1) * 33 + sc], a2 = tile[(rc + 2) * 33 + sc], a3 = tile[(rc + 3) * 33 + sc];
        uint2 w; w.x = pk_bf16(a0, a1); w.y = pk_bf16(a2, a3);
        *(uint2*)(dst + (size_t)(r0 + c) * ld_dst + k0 + rc) = w;
    }
    __syncthreads();
}
__device__ __forceinline__ void tr_tile2(const float* srca, int c0a, const float* srcb, int c0b, size_t ld_src, int k0, bf16_t* dst, size_t ld_dst, int r0, float* tile, int tid) {
    {
        const int r = tid >> 3, c4 = (tid & 7) * 4;
        const float* sp = c4 < 16 ? srca + (size_t)(k0 + r) * ld_src + c0a + c4 : srcb + (size_t)(k0 + r) * ld_src + c0b + (c4 - 16);
        const float4 v = *(const float4*)sp;
        float* tp = tile + r * 33 + c4; tp[0] = v.x; tp[1] = v.y; tp[2] = v.z; tp[3] = v.w;
    }
    __syncthreads();
    {
        const int c = tid >> 4, rc = (tid & 15) * 4;
        const float a0 = tile[(rc + 0) * 33 + c], a1 = tile[(rc + 1) * 33 + c], a2 = tile[(rc + 2) * 33 + c], a3 = tile[(rc + 3) * 33 + c];
        uint2 w; w.x = pk_bf16(a0, a1); w.y = pk_bf16(a2, a3);
        *(uint2*)(dst + (size_t)(r0 + c) * ld_dst + k0 + rc) = w;
    }
    __syncthreads();
}

__device__ __forceinline__ void phase0(const Params& p, char* smem) {
    const int tid = opaque_tid(), lane = tid & 63, wid = tid >> 6;
    const int gw = blockIdx.x * 8 + wid, nw = gridDim.x * 8;
    char* ws = uni(p.ws);
    bf16_t* xb = (bf16_t*)(ws + OFF_R0);
    for (int row = gw; row < T_; row += nw) {
        const float4* xr = (const float4*)(uni(p.x) + (size_t)row * 1024);
#pragma unroll
        for (int i = 0; i < 4; ++i) {
            const float4 v = xr[i * 64 + lane];
            uint2 w; w.x = pk_bf16(v.x, v.y); w.y = pk_bf16(v.z, v.w);
            *(uint2*)(xb + (size_t)row * 1024 + i * 256 + lane * 4) = w;
        }
    }
    {
        float2* cs = (float2*)(ws + OFF_CS);
        const int gt = blockIdx.x * NTHR + tid, nt = gridDim.x * NTHR;
        for (int idx = gt; idx < T_ * 32; idx += nt) {
            const int tok = idx >> 5, i = idx & 31;
            const double ang = (double)uni(p.pos)[tok] * INV_FREQ[i];
            const double turns = ang * 0.15915494309189535;
            const float f = (float)(turns - rint(turns));
            cs[idx] = make_float2(__builtin_amdgcn_cosf(f), __builtin_amdgcn_sinf(f));
        }
        bf16_t* memb = (bf16_t*)(ws + OFF_MEMB);
        for (int idx = gt; idx < 4096 * 1024 / 4; idx += nt) {
            const float4 v = ((const float4*)uni(p.mem))[idx];
            uint2 w; w.x = pk_bf16(v.x, v.y); w.y = pk_bf16(v.z, v.w);
            ((uint2*)memb)[idx] = w;
        }
    }
    {
        float* tile = (float*)smem;
        const int NT_WIN = 16 * 201, NT_SQ = 16 * 32, NT_XKV = 16 * 64;
        const int total = NT_WIN + 5 * NT_SQ + NT_XKV;
        for (int t = blockIdx.x; t < total; t += gridDim.x) {
            if (t < NT_WIN) {
                const int kt = t & 15, nt_ = t >> 4;
                const int n0 = nt_ * 32;
                int c0;
                if (n0 < 1280) { const int pn = n0 >> 8, bj = (n0 >> 7) & 1, wc = (n0 >> 5) & 3; c0 = (4 * pn + wc) * 64 + 32 * bj; }
                else c0 = n0 < 4352 ? n0 : (n0 < 6400 ? n0 + 8 : 4352);
                tr_tile_t<true>(uni(p.w_in), 6408, kt * 64, c0, (bf16_t*)(ws + OFF_WIN), 1024, n0, tile, tid);
            } else if (t < NT_WIN + 5 * NT_SQ) {
                const int u = t - NT_WIN, which = u / NT_SQ, v = u % NT_SQ, kt = v & 15, nt_ = v >> 4;
                const float* src = which == 0 ? uni(p.w_att) : which == 1 ? uni(p.w_ml) : which == 2 ? uni(p.w_mix) : which == 3 ? uni(p.w_xq) : uni(p.w_xo);
                bf16_t* dst = (bf16_t*)(ws + OFF_WATT + (size_t)which * 2 * MiB);
                tr_tile_t<true>(src, 1024, kt * 64, nt_ * 32, dst, 1024, nt_ * 32, tile, tid);
            } else {
                const int v = t - NT_WIN - 5 * NT_SQ, kt = v & 15, nt_ = v >> 4;
                if (nt_ < 32) tr_tile_t<true>(uni(p.w_xkv), 2048, kt * 64, nt_ * 32, (bf16_t*)(ws + OFF_WXKV), 1024, nt_ * 32, tile, tid);
                else tr_tile_t<false>(uni(p.w_xkv), 2048, kt * 64, nt_ * 32, (bf16_t*)(ws + OFF_WXKV), 1024, nt_ * 32, tile, tid);
            }
        }
    }
}

__device__ __forceinline__ void moe_weight_prep(const Params& p, char* smem) {
    const int tid = opaque_tid();
    float* tile = (float*)smem;
    char* ws = uni(p.ws);
    const int per_e = 384, total = 64 * per_e;
    for (int t = blockIdx.x; t < total; t += gridDim.x) {
        const int e = t / per_e, u = t % per_e;
        if (u < 256) {
            const int isup = u >> 7, v = u & 127, kt = v & 15, j = v >> 4;
            const float* src = (isup ? uni(p.w_up) : uni(p.w_gate)) + (size_t)e * 1024 * 256;
            tr_tile_t<false>(src, 256, kt * 64, j * 32, (bf16_t*)(ws + OFF_WGU) + (size_t)e * 512 * 1024, 1024, j * 64 + isup * 32, tile, tid);
        } else {
            const int v = u - 256, kt = v & 3, nt_ = v >> 2;
            tr_tile_t<true>(uni(p.w_down) + (size_t)e * 256 * 1024, 1024, kt * 64, nt_ * 32, (bf16_t*)(ws + OFF_WD) + (size_t)e * 1024 * 256, 256, nt_ * 32, tile, tid);
        }
    }
}

struct SchedP1 {
    int G, c; const char *xb, *win, *memb, *wxkv;
    __device__ __forceinline__ bool next(int i, pg8::Unit& u) const {
        int nmain, uidx;
        if (G == 256) { nmain = 26; const int x = c & 7, j = c >> 3; uidx = i * 32 + j; if (i < 26) { const int g = uidx / 104, v = uidx % 104; u.pm = 32 * x + 4 * g + (v & 3); u.pn = v >> 2; } }
        else { nmain = c < 6656 ? (6656 - 1 - c) / G + 1 : 0; uidx = i * G + c; if (i < nmain) { u.pm = uidx / 26; u.pn = uidx % 26; } }
        if (i < nmain) { u.aux = 0; u.A = xb; u.Bt = win; return true; }
        const int kv = c + (i - nmain) * G;
        if (kv >= 128) return false;
        if (kv < 64) { u.aux = 1; u.pm = kv >> 2; u.pn = kv & 3; u.A = memb; u.Bt = wxkv; }
        else { const int k2 = kv - 64; u.aux = 2; u.pm = k2 >> 4; u.pn = k2 & 15; u.A = wxkv + (size_t)1024 * 1024 * 2; u.Bt = memb; }
        return true;
    }
};

struct EpiP1 {
    char* ws; int skip;
    __device__ __forceinline__ void operator()(const f32x4 (&acc)[2][2][4][2], const pg8::Unit& u, int wr, int wc, int fr, int fq) const {
        if (skip) {
#pragma unroll
            for (int a = 0; a < 2; ++a)
#pragma unroll
                for (int b = 0; b < 2; ++b)
#pragma unroll
                    for (int m = 0; m < 4; ++m) { asm volatile("" :: "v"(acc[a][b][m][0]), "v"(acc[a][b][m][1])); }
            return;
        }
        const int row0 = u.pm * 256 + wr * 64 + fr;
        if (u.aux == 0 && u.pn < 5) {
            const int hidx = 4 * u.pn + wc;
            if (hidx < 18) {
                bf16_t* dst; int ld, cb; float sc;
                if (hidx < 16) { dst = (bf16_t*)(ws + OFF_R1); ld = 1024; cb = hidx * 64; sc = 0.125f; }
                else { dst = (bf16_t*)(ws + OFF_AK); ld = 128; cb = (hidx - 16) * 64; sc = 1.0f; }
                const float* cs = (const float*)(ws + OFF_CS);
                const int d1 = 8 * fq;
#pragma unroll
                for (int ai = 0; ai < 2; ++ai)
#pragma unroll
                    for (int m = 0; m < 4; ++m) {
                        const int tok = row0 + ai * 128 + m * 16;
                        const float4* cp = (const float4*)(cs + (size_t)tok * 64 + d1 * 2);
                        const float4 c0 = cp[0], c1 = cp[1], c2 = cp[2], c3 = cp[3];
                        const f32x4 x1a = acc[ai][0][m][0], x1b = acc[ai][0][m][1], x2a = acc[ai][1][m][0], x2b = acc[ai][1][m][1];
                        f32x4 o1a, o1b, o2a, o2b;
                        o1a[0] = (x1a[0] * c0.x - x2a[0] * c0.y) * sc; o2a[0] = (x2a[0] * c0.x + x1a[0] * c0.y) * sc;
                        o1a[1] = (x1a[1] * c0.z - x2a[1] * c0.w) * sc; o2a[1] = (x2a[1] * c0.z + x1a[1] * c0.w) * sc;
                        o1a[2] = (x1a[2] * c1.x - x2a[2] * c1.y) * sc; o2a[2] = (x2a[2] * c1.x + x1a[2] * c1.y) * sc;
                        o1a[3] = (x1a[3] * c1.z - x2a[3] * c1.w) * sc; o2a[3] = (x2a[3] * c1.z + x1a[3] * c1.w) * sc;
                        o1b[0] = (x1b[0] * c2.x - x2b[0] * c2.y) * sc; o2b[0] = (x2b[0] * c2.x + x1b[0] * c2.y) * sc;
                        o1b[1] = (x1b[1] * c2.z - x2b[1] * c2.w) * sc; o2b[1] = (x2b[1] * c2.z + x1b[1] * c2.w) * sc;
                        o1b[2] = (x1b[2] * c3.x - x2b[2] * c3.y) * sc; o2b[2] = (x2b[2] * c3.x + x1b[2] * c3.y) * sc;
                        o1b[3] = (x1b[3] * c3.z - x2b[3] * c3.w) * sc; o2b[3] = (x2b[3] * c3.z + x1b[3] * c3.w) * sc;
                        bf16_t* rp = dst + (size_t)tok * ld + cb + d1;
                        store_bf16x8(rp, o1a, o1b); store_bf16x8(rp + 32, o2a, o2b);
                    }
            } else {
                bf16_t* avT = (bf16_t*)(ws + OFF_AV);
#pragma unroll
                for (int bj = 0; bj < 2; ++bj)
#pragma unroll
                    for (int ai = 0; ai < 2; ++ai)
#pragma unroll
                        for (int m = 0; m < 4; ++m)
#pragma unroll
                            for (int n = 0; n < 2; ++n)
#pragma unroll
                                for (int j = 0; j < 4; ++j)
                                    avT[(size_t)((hidx - 18) * 64 + 32 * bj + 8 * fq + 4 * n + j) * T_ + row0 + ai * 128 + m * 16] = (bf16_t)(pk_bf16(acc[ai][bj][m][n][j], acc[ai][bj][m][n][j]) & 0xffffu);
            }
            return;
        }
#pragma unroll
        for (int bj = 0; bj < 2; ++bj) {
            const int c32 = u.pn * 256 + bj * 128 + wc * 32;
            if (u.aux == 0 && c32 >= 6400) {
                if (c32 == 6400 && fq == 0) {
                    float* gates = (float*)(ws + OFF_GATES);
#pragma unroll
                    for (int ai = 0; ai < 2; ++ai)
#pragma unroll
                        for (int m = 0; m < 4; ++m) {
                            const f32x4 v0 = acc[ai][bj][m][0], v1 = acc[ai][bj][m][1];
                            float4* gp = (float4*)(gates + (size_t)(row0 + ai * 128 + m * 16) * 8);
                            gp[0] = make_float4(v0[0], v0[1], v0[2], v0[3]); gp[1] = make_float4(v1[0], v1[1], v1[2], v1[3]);
                        }
                }
            } else if (u.aux == 2) {
                bf16_t* dst = (bf16_t*)(ws + OFF_VT);
#pragma unroll
                for (int ai = 0; ai < 2; ++ai)
#pragma unroll
                    for (int m = 0; m < 4; ++m) {
                        bf16_t* rp = dst + (size_t)(row0 + ai * 128 + m * 16) * 4096 + c32 + fq * 4;
                        store_bf16x4(rp, acc[ai][bj][m][0]); store_bf16x4(rp + 16, acc[ai][bj][m][1]);
                    }
            } else {
                bf16_t* dst; int ld, cb; bool sig = false;
                if (u.aux == 1) { dst = (bf16_t*)(ws + OFF_KMAT); ld = 1024; cb = c32; }
                else if (c32 < 2304) { dst = (bf16_t*)(ws + OFF_MQK); ld = 1024; cb = c32 - 1280; }
                else if (c32 < 3328) { dst = (bf16_t*)(ws + OFF_MV); ld = 1024; cb = c32 - 2304; }
                else if (c32 < 4352) { dst = (bf16_t*)(ws + OFF_MO); ld = 1024; cb = c32 - 3328; sig = true; }
                else { dst = (bf16_t*)(ws + OFF_GG); ld = 2048; cb = c32 - 4352; sig = true; }
#pragma unroll
                for (int ai = 0; ai < 2; ++ai)
#pragma unroll
                    for (int m = 0; m < 4; ++m) {
                        f32x4 v0 = acc[ai][bj][m][0], v1 = acc[ai][bj][m][1];
                        if (sig) {
                            v0[0] = sigmoidf_(v0[0]); v0[1] = sigmoidf_(v0[1]); v0[2] = sigmoidf_(v0[2]); v0[3] = sigmoidf_(v0[3]);
                            v1[0] = sigmoidf_(v1[0]); v1[1] = sigmoidf_(v1[1]); v1[2] = sigmoidf_(v1[2]); v1[3] = sigmoidf_(v1[3]);
                        }
                        store_bf16x8(dst + (size_t)(row0 + ai * 128 + m * 16) * ld + cb + fq * 8, v0, v1);
                    }
            }
        }
    }
};

__device__ __forceinline__ void phase1(const Params& p, char* smem, int skip_epi = 0) {
    char* ws = uni(p.ws);
    SchedP1 S{(int)gridDim.x, (int)blockIdx.x, ws + OFF_R0, ws + OFF_WIN, ws + OFF_MEMB, ws + OFF_WXKV};
    EpiP1 E{ws, skip_epi};
    pg8::gemm_phase<EpiP1, SchedP1>((LDS_AS unsigned char*)smem, 1024, S, E);
}

template <int NPASS>
struct SchedN1024 {
    int G, c; const char* A0; const char* B0; const char* A1; const char* B1;
    __device__ __forceinline__ bool next(int i, pg8::Unit& u) const {
        const int ti = i / NPASS, pass = i % NPASS;
        int uidx;
        if (G == 256) { if (ti >= 4) return false; const int x = c & 7, j = c >> 3; uidx = ti * 32 + j; u.pm = 32 * x + (uidx >> 2); u.pn = uidx & 3; }
        else { uidx = ti * G + c; if (uidx >= 1024) return false; u.pm = uidx >> 2; u.pn = uidx & 3; }
        u.aux = pass; u.A = pass ? A1 : A0; u.Bt = pass ? B1 : B0;
        return true;
    }
};

typedef short v4i16_t __attribute__((ext_vector_type(4)));
__device__ __forceinline__ int offQK(int row, int ch) { return row * 256 + ((ch ^ (((row & 3) << 2) | ((row >> 2) & 3))) << 4); }
__device__ __forceinline__ int offV(int row, int ch) { return row * 512 + ((ch ^ (((row & 3) | (((row >> 3) & 1) << 2)) << 1)) << 4); }
__device__ __forceinline__ int offSw(int row, int ch) { return row * 128 + ((ch ^ ((row >> 1) & 7)) << 4); }
__device__ __forceinline__ bf16x8 tr_read2(const char* p0, const char* p1) {
    const v4i16_t a = __builtin_amdgcn_ds_read_tr16_b64_v4i16((LDS_AS v4i16_t*)p0);
    const v4i16_t b = __builtin_amdgcn_ds_read_tr16_b64_v4i16((LDS_AS v4i16_t*)p1);
    return __builtin_shufflevector(a, b, 0, 1, 2, 3, 4, 5, 6, 7);
}
__device__ __forceinline__ float row16_sum(float v) {
    v += __builtin_bit_cast(float, __builtin_amdgcn_update_dpp(0, __builtin_bit_cast(int, v), 0xB1, 0xf, 0xf, true));
    v += __builtin_bit_cast(float, __builtin_amdgcn_update_dpp(0, __builtin_bit_cast(int, v), 0x4E, 0xf, 0xf, true));
    v += __builtin_bit_cast(float, __builtin_amdgcn_update_dpp(0, __builtin_bit_cast(int, v), 0x141, 0xf, 0xf, true));
    v += __builtin_bit_cast(float, __builtin_amdgcn_update_dpp(0, __builtin_bit_cast(int, v), 0x140, 0xf, 0xf, true));
    return v;
}

constexpr int PP_Q = 0, PP_K = 16384, PP_S = 32768, PP_REC = 40960, PP_EB = 41984, PP_EK = 42240, PP_CSP = 42496  , PP_RSP = 44544  , PP_END = 45056;
__device__ __forceinline__ void ml_prepass_item(const Params& p, char* smem, int item) {
    const int tid = opaque_tid(), lane = tid & 63, wid = tid >> 6, fr = lane & 15, fq = lane >> 4;
    const int c = item & 63, bh = item >> 6, b = bh >> 2, h = bh & 3;
    char* ws = uni(p.ws);
    const bf16_t* mqk = (const bf16_t*)(ws + OFF_MQK);
    const float* gates = (const float*)(ws + OFF_GATES);
    float* rec = (float*)(smem + PP_REC); float* eb = (float*)(smem + PP_EB); float* ek = (float*)(smem + PP_EK);
    float* csp = (float*)(smem + PP_CSP); float* rsp = (float*)(smem + PP_RSP);
    const long tok0 = (long)b * 4096 + c * 64;
    const int cp = tid & 127, tg = tid >> 7;
    const bool isk = cp >= 64;
    const int dch = isk ? 2 * (cp - 64) : 2 * cp;
    const int ccol = isk ? (512 + h * 128 + dch) : (h * 128 + dch);
    unsigned r[19];
#pragma unroll
    for (int i = 0; i < 19; ++i) {
        const int tl = tg * 16 - 3 + i;
        r[i] = (c == 0 && tl < 0) ? 0u : *(const unsigned*)(mqk + (tok0 + tl) * 1024 + ccol);
    }
    float cw0[4], cw1[4];
#pragma unroll
    for (int j = 0; j < 4; ++j) { cw0[j] = uni(p.conv_w)[j * 1024 + ccol]; cw1[j] = uni(p.conv_w)[j * 1024 + ccol + 1]; }
    const float cb0 = uni(p.conv_b)[ccol], cb1 = uni(p.conv_b)[ccol + 1];
    if (wid == 0) {
        const float mi0 = gates[(tok0 + lane) * 8 + h] + uni(p.b_ig)[h], x = gates[(tok0 + lane) * 8 + 4 + h] + uni(p.b_fg)[h];
        float bs = fminf(x, 0.f) - log1pf(__expf(-fabsf(x)));
#pragma unroll
        for (int o = 1; o < 64; o <<= 1) { const float y = __shfl_up(bs, o); if (lane >= o) bs += y; }
        eb[lane] = __expf(bs); ek[lane] = __expf(mi0 - bs);
        if (lane == 63) rec[192] = __expf(bs);
    }
    __syncthreads();
    {
        const int tt0 = tg * 16;
        float cs0 = 0.f, cs1 = 0.f;
        const float* scp = (isk ? ek : eb) + tt0;
        char* dstb = smem + (isk ? PP_K : PP_Q) + (dch & 7) * 2;
        const float kmul = isk ? 0.08838834764831845f : 1.0f;
#pragma unroll
        for (int tt = 0; tt < 16; ++tt) {
            float v0 = cb0 + cw0[0] * bf_lo(r[tt]) + cw0[1] * bf_lo(r[tt + 1]) + cw0[2] * bf_lo(r[tt + 2]) + cw0[3] * bf_lo(r[tt + 3]);
            float v1 = cb1 + cw1[0] * bf_hi(r[tt]) + cw1[1] * bf_hi(r[tt + 1]) + cw1[2] * bf_hi(r[tt + 2]) + cw1[3] * bf_hi(r[tt + 3]);
            v0 = v0 * sigmoidf_(v0); v1 = v1 * sigmoidf_(v1);
            const float sc = scp[tt] * kmul;
            const float a0 = v0 * sc, a1 = v1 * sc;
            *(unsigned*)(dstb + offQK(tt0 + tt, dch >> 3)) = pk_bf16(a0, a1);
            cs0 += a0; cs1 += a1;
        }
        if (isk) { csp[tg * 128 + dch] = cs0; csp[tg * 128 + dch + 1] = cs1; }
    }
    __syncthreads();
    {
        const int tt = wid >> 1;
        bf16x8 qf[4];
#pragma unroll
        for (int ks = 0; ks < 4; ++ks) qf[ks] = *(const bf16x8*)(smem + PP_Q + offQK(tt * 16 + fr, 4 * ks + fq));
        float rs = 0.f;
#pragma unroll
        for (int x = 0; x < 2; ++x) {
            const int st = (wid & 1) * 2 + x;
            f32x4 a = (f32x4){0.f, 0.f, 0.f, 0.f};
#pragma unroll
            for (int ks = 0; ks < 4; ++ks) {
                const bf16x8 kf = *(const bf16x8*)(smem + PP_K + offQK(st * 16 + fr, 4 * ks + fq));
                a = __builtin_amdgcn_mfma_f32_16x16x32_bf16(kf, qf[ks], a, 0, 0, 0);
            }
#pragma unroll
            for (int j = 0; j < 4; ++j) a[j] = (st * 16 + fq * 4 + j) <= (tt * 16 + fr) ? a[j] : 0.f;
            rs += (a[0] + a[1]) + (a[2] + a[3]);
            uint2 w; w.x = pk_bf16(a[0], a[1]); w.y = pk_bf16(a[2], a[3]);
            *(uint2*)(smem + PP_S + offSw(tt * 16 + fr, st * 2 + (fq >> 1)) + (fq & 1) * 8) = w;
        }
        rs += __shfl_xor(rs, 16); rs += __shfl_xor(rs, 32);
        if (fq == 0) rsp[(wid & 1) * 64 + tt * 16 + fr] = rs;
        if (tid < 128) rec[64 + tid] = (csp[tid] + csp[128 + tid]) + (csp[256 + tid] + csp[384 + tid]);
    }
    __syncthreads();
    if (tid < 64) rec[tid] = rsp[tid] + rsp[64 + tid];
    __syncthreads();
    {
        char* qp = (char*)uni(p.out) + OUT_QP + (size_t)item * 16384;
        char* kp = (char*)uni(p.out) + OUT_KP + (size_t)item * 16384;
        char* sp = ws + OFF_SP + (size_t)item * 8192;
        char* rp = ws + OFF_REC + (size_t)item * 1024;
#pragma unroll
        for (int i = 0; i < 2; ++i) {
            *(u32x4*)(qp + (i * 512 + tid) * 16) = *(const u32x4*)(smem + PP_Q + (i * 512 + tid) * 16);
            *(u32x4*)(kp + (i * 512 + tid) * 16) = *(const u32x4*)(smem + PP_K + (i * 512 + tid) * 16);
        }
        *(u32x4*)(sp + tid * 16) = *(const u32x4*)(smem + PP_S + tid * 16);
        if (tid < 64) *(u32x4*)(rp + tid * 16) = *(const u32x4*)(smem + PP_REC + tid * 16);
    }
    __syncthreads();
}

constexpr int SC_BUF = 41984;
constexpr int SC_V = 2 * SC_BUF;
constexpr int SC_PART = SC_V + 65536;
constexpr int SC_NBF = SC_PART + 2048;
constexpr int SC_END = SC_NBF + 256;
__device__ __forceinline__ void ml_scan(const Params& p, char* smem, int bh, const int mode = 0) {
    const int tid = opaque_tid(), lane = tid & 63, wid = tid >> 6, fr0 = lane & 15, fq0 = lane >> 4;
    const int b = bh >> 2, h = bh & 3;
    char* ws = uni(p.ws);
    const bf16_t* mv = (const bf16_t*)(ws + OFF_MV);
    const bf16_t* mo = (const bf16_t*)(ws + OFF_MO);
    bf16_t* hm = (bf16_t*)uni(p.out);
    const long tokb = (long)b * 4096;
    f32x4 C[8][2];
#pragma unroll
    for (int dt = 0; dt < 8; ++dt) { C[dt][0] = (f32x4){0.f, 0.f, 0.f, 0.f}; C[dt][1] = (f32x4){0.f, 0.f, 0.f, 0.f}; }
    const float gn0 = uni(p.ml_g)[h * 256 + wid * 32 + fr0], gn1 = uni(p.ml_g)[h * 256 + wid * 32 + 16 + fr0];
    const int vrl = tid >> 5, vpc = tid & 31, vlc = vpc ^ ((((vrl & 3) | (((vrl >> 3) & 1) << 2))) << 1);
    const bf16_t* vsrc = mv + (tokb + vrl) * 1024 + h * 256 + vlc * 8;
    const char* qp = (const char*)uni(p.out) + OUT_QP + (size_t)bh * 64 * 16384;
    const char* kp = (const char*)uni(p.out) + OUT_KP + (size_t)bh * 64 * 16384;
    const char* sp = ws + OFF_SP + (size_t)bh * 64 * 8192;
    const char* rp = ws + OFF_REC + (size_t)bh * 64 * 1024;
#define SC_STAGE(cc, bufoff) do { \
        _Pragma("unroll") for (int _i = 0; _i < 2; ++_i) { \
            glds16((const bf16_t*)(qp + (size_t)(cc) * 16384 + (_i * 512 + tid) * 16), smem + (bufoff) + (_i * 512 + tid) * 16); \
            glds16((const bf16_t*)(kp + (size_t)(cc) * 16384 + (_i * 512 + tid) * 16), smem + (bufoff) + 16384 + (_i * 512 + tid) * 16); } \
        glds16((const bf16_t*)(sp + (size_t)(cc) * 8192 + tid * 16), smem + (bufoff) + 32768 + tid * 16); \
        if (tid < 64) glds16((const bf16_t*)(rp + (size_t)(cc) * 1024 + tid * 16), smem + (bufoff) + 40960 + tid * 16); \
        _Pragma("unroll") for (int _i = 0; _i < 4; ++_i) glds16(vsrc + (long)(cc) * 64 * 1024 + (long)_i * 16 * 1024, smem + SC_V + ((cc) & 1) * 32768 + (_i * 512 + tid) * 16); } while (0)
    __syncthreads();
    if (tid < 128) ((bf16_t*)(smem + SC_NBF))[tid] = 0;
    float nreg = 0.f;
    SC_STAGE(0, 0);
    asm volatile("s_waitcnt vmcnt(0)" ::: "memory");
#pragma unroll 1
    for (int c = 0; c < 64; ++c) {
        const int par = c & 1;
        const long tok0 = tokb + c * 64;
        int fr = fr0, fq = fq0, tv = tid;
        asm volatile("" : "+v"(fr), "+v"(fq), "+v"(tv));
        const char* buf = smem + par * SC_BUF;
        asm volatile("s_waitcnt vmcnt(4) lgkmcnt(0)" ::: "memory");
        __builtin_amdgcn_s_barrier();
        if (c + 1 < 64 && !(mode & 1)) SC_STAGE(c + 1, (par ^ 1) * SC_BUF);
        u32x4 mop[4];
#pragma unroll
        for (int i = 0; i < 4; ++i) { if (!(mode & 8)) mop[i] = *(const u32x4*)(mo + (tok0 + i * 16 + (tv >> 5)) * 1024 + h * 256 + (tv & 31) * 8); else mop[i] = (u32x4){0x3f803f80u, 0x3f803f80u, 0x3f803f80u, 0x3f803f80u}; }
        f32x4 Y[4][2], DN[4];
#pragma unroll
        for (int tt = 0; tt < 4; ++tt) { Y[tt][0] = (f32x4){0.f, 0.f, 0.f, 0.f}; Y[tt][1] = (f32x4){0.f, 0.f, 0.f, 0.f}; DN[tt] = (f32x4){0.f, 0.f, 0.f, 0.f}; }
#pragma unroll
        for (int ks = 0; ks < 4; ++ks) {
            u32x4 c0, c1;
            c0[0] = pk_bf16(C[2 * ks][0][0], C[2 * ks][0][1]); c0[1] = pk_bf16(C[2 * ks][0][2], C[2 * ks][0][3]);
            c0[2] = pk_bf16(C[2 * ks + 1][0][0], C[2 * ks + 1][0][1]); c0[3] = pk_bf16(C[2 * ks + 1][0][2], C[2 * ks + 1][0][3]);
            c1[0] = pk_bf16(C[2 * ks][1][0], C[2 * ks][1][1]); c1[1] = pk_bf16(C[2 * ks][1][2], C[2 * ks][1][3]);
            c1[2] = pk_bf16(C[2 * ks + 1][1][0], C[2 * ks + 1][1][1]); c1[3] = pk_bf16(C[2 * ks + 1][1][2], C[2 * ks + 1][1][3]);
            const bf16x8 cf0 = __builtin_bit_cast(bf16x8, c0), cf1 = __builtin_bit_cast(bf16x8, c1);
            const u32x2 nlo = *(const u32x2*)(smem + SC_NBF + (32 * ks + 4 * fq) * 2), nhi = *(const u32x2*)(smem + SC_NBF + (32 * ks + 16 + 4 * fq) * 2);
            u32x4 nv; nv[0] = nlo[0]; nv[1] = nlo[1]; nv[2] = nhi[0]; nv[3] = nhi[1];
            const bf16x8 nb = __builtin_bit_cast(bf16x8, nv);
#pragma unroll
            for (int tt = 0; tt < 4; ++tt) {
                const int row = tt * 16 + fr;
                const u32x2 lo = *(const u32x2*)(buf + offQK(row, 4 * ks + (fq >> 1)) + (fq & 1) * 8);
                const u32x2 hi = *(const u32x2*)(buf + offQK(row, 4 * ks + 2 + (fq >> 1)) + (fq & 1) * 8);
                u32x4 av; av[0] = lo[0]; av[1] = lo[1]; av[2] = hi[0]; av[3] = hi[1];
                const bf16x8 af = __builtin_bit_cast(bf16x8, av);
                Y[tt][0] = __builtin_amdgcn_mfma_f32_16x16x32_bf16(af, cf0, Y[tt][0], 0, 0, 0);
                Y[tt][1] = __builtin_amdgcn_mfma_f32_16x16x32_bf16(af, cf1, Y[tt][1], 0, 0, 0);
                DN[tt] = __builtin_amdgcn_mfma_f32_16x16x32_bf16(af, nb, DN[tt], 0, 0, 0);
            }
        }
        const char* vb = smem + SC_V + par * 32768;
        bf16x8 vf[2][2];
#pragma unroll
        for (int ks = 0; ks < 2; ++ks)
#pragma unroll
            for (int et = 0; et < 2; ++et) {
                const int cidx = 2 * wid + et, ch = 2 * cidx + ((fr & 3) >> 1);
                const int r0 = 32 * ks + 8 * fq + (fr >> 2);
                vf[ks][et] = tr_read2(vb + offV(r0, ch) + 8 * (fr & 1), vb + offV(r0 + 4, ch) + 8 * (fr & 1));
            }
#pragma unroll
        for (int ks = 0; ks < 2; ++ks)
#pragma unroll
            for (int tt = 0; tt < 4; ++tt) {
                const bf16x8 sf = *(const bf16x8*)(buf + 32768 + offSw(tt * 16 + fr, 4 * ks + fq));
                Y[tt][0] = __builtin_amdgcn_mfma_f32_16x16x32_bf16(sf, vf[ks][0], Y[tt][0], 0, 0, 0);
                Y[tt][1] = __builtin_amdgcn_mfma_f32_16x16x32_bf16(sf, vf[ks][1], Y[tt][1], 0, 0, 0);
            }
        const float* recf = (const float*)(buf + 40960);
#pragma unroll
        for (int tt = 0; tt < 4; ++tt) {
            const float4 rsv = *(const float4*)(recf + tt * 16 + fq * 4);
            const float dd[4] = {rsv.x + DN[tt][0], rsv.y + DN[tt][1], rsv.z + DN[tt][2], rsv.w + DN[tt][3]};
            float sq[4];
#pragma unroll
            for (int j = 0; j < 4; ++j) {
                const float inv = 1.0f / fmaxf(fabsf(dd[j]), 1.0f);
                Y[tt][0][j] *= inv; Y[tt][1][j] *= inv;
                sq[j] = row16_sum(Y[tt][0][j] * Y[tt][0][j] + Y[tt][1][j] * Y[tt][1][j]);
            }
            if (fr == 0) *(float4*)(smem + SC_PART + (wid * 64 + tt * 16 + fq * 4) * 4) = make_float4(sq[0], sq[1], sq[2], sq[3]);
        }
#pragma unroll
        for (int dt = 0; dt < 8; ++dt)
#pragma unroll
            for (int ks = 0; ks < 2; ++ks) {
                const int ch = 2 * dt + ((fr & 3) >> 1);
                const int r0 = 32 * ks + 8 * fq + (fr >> 2);
                const bf16x8 kf = tr_read2(buf + 16384 + offQK(r0, ch) + 8 * (fr & 1), buf + 16384 + offQK(r0 + 4, ch) + 8 * (fr & 1));
                C[dt][0] = __builtin_amdgcn_mfma_f32_16x16x32_bf16(kf, vf[ks][0], C[dt][0], 0, 0, 0);
                C[dt][1] = __builtin_amdgcn_mfma_f32_16x16x32_bf16(kf, vf[ks][1], C[dt][1], 0, 0, 0);
                if (ks == 1 && (dt & 1)) __builtin_amdgcn_sched_barrier(0);
            }
        const float g = recf[192];
#pragma unroll
        for (int dt = 0; dt < 8; ++dt) { C[dt][0] *= g; C[dt][1] *= g; }
        const float colsum = tid < 128 ? recf[64 + (tid & 127)] : 0.f;
        asm volatile("s_waitcnt lgkmcnt(0)" ::: "memory");
        __builtin_amdgcn_s_barrier();
#pragma unroll
        for (int tt = 0; tt < 4; ++tt) {
            float4 ss = *(const float4*)(smem + SC_PART + (tt * 16 + fq * 4) * 4);
#pragma unroll
            for (int w = 1; w < 8; ++w) { const float4 x = *(const float4*)(smem + SC_PART + (w * 64 + tt * 16 + fq * 4) * 4); ss.x += x.x; ss.y += x.y; ss.z += x.z; ss.w += x.w; }
            const float sv[4] = {ss.x, ss.y, ss.z, ss.w};
#pragma unroll
            for (int j = 0; j < 4; ++j) {
                const float rstd = rsqrtf(sv[j] * (1.0f / 256.0f) + 1e-6f);
                bf16_t* tp = (bf16_t*)(smem + par * SC_BUF) + (tt * 16 + fq * 4 + j) * 256 + wid * 32 + fr;
                const float o0 = Y[tt][0][j] * rstd * gn0, o1 = Y[tt][1][j] * rstd * gn1;
                tp[0] = (bf16_t)(pk_bf16(o0, o0) & 0xffffu); tp[16] = (bf16_t)(pk_bf16(o1, o1) & 0xffffu);
            }
        }
        asm volatile("s_waitcnt lgkmcnt(0)" ::: "memory");
        __builtin_amdgcn_s_barrier();
#pragma unroll
        for (int i = 0; i < 4; ++i) {
            const int row = i * 16 + (tv >> 5), ch = tv & 31;
            const u32x4 hv = *(const u32x4*)(buf + row * 512 + ch * 16);
            u32x4 o;
#pragma unroll
            for (int k = 0; k < 4; ++k) o[k] = pk_bf16(bf_lo(hv[k]) * bf_lo(mop[i][k]), bf_hi(hv[k]) * bf_hi(mop[i][k]));
            if (!(mode & 4)) *(u32x4*)(hm + (tok0 + row) * 1024 + h * 256 + ch * 8) = o; else asm volatile("" :: "v"(o));
        }
        if (tid < 128) {
            nreg = g * (nreg + colsum);
            ((bf16_t*)(smem + SC_NBF))[tid] = (bf16_t)(pk_bf16(nreg, nreg) & 0xffffu);
        }
    }
    __syncthreads();
#undef SC_STAGE
}

__device__ __forceinline__ void swa_items(const Params& p, char* smem, int first, int stride, int hi) {
    const int tid = opaque_tid(), lane = tid & 63, wid = tid >> 6, fr = lane & 15, fq = lane >> 4;
    char* ws = uni(p.ws);
    const bf16_t* aq = (const bf16_t*)(ws + OFF_R1);
    const bf16_t* ak = (const bf16_t*)(ws + OFF_AK);
    const bf16_t* avT = (const bf16_t*)(ws + OFF_AV);
    bf16_t* ao = (bf16_t*)(ws + OFF_R0);
    char* kbuf = smem; char* vbuf = smem + 32768;
    for (int item = first; item < hi; item += stride) {
        const int kvh = item & 1, n = (item >> 1) & 31, b = item >> 6;
        const int hq = kvh * 8 + wid;
        const long tokbase = (long)b * 4096 + n * 128 - 128;
        {
            const int rk = tid >> 3, pck = tid & 7, lck = pck ^ ((rk >> 1) & 7);
            const bf16_t* srck = ak + (tokbase + rk) * 128 + kvh * 64 + lck * 8;
#pragma unroll
            for (int i = 0; i < 4; ++i) glds16(srck + (long)i * 64 * 128, kbuf + (i * 512 + tid) * 16);
            const int rv = tid >> 5, pcv = tid & 31, lcv = pcv ^ (rv & 15);
            const bf16_t* srcv = avT + (long)(kvh * 64 + rv) * T_ + tokbase + lcv * 8;
#pragma unroll
            for (int i = 0; i < 4; ++i) glds16(srcv + (long)i * 16 * T_, vbuf + (i * 512 + tid) * 16);
        }
        const float sink = uni(p.sinks)[hq];
        asm volatile("s_waitcnt vmcnt(0)" ::: "memory");
        __syncthreads();
        const int kswz = (fr >> 1) & 7;
#pragma unroll 1
        for (int u = 0; u < 4; ++u) {
            const long tq = (long)b * 4096 + n * 128 + u * 32 + fr;
            const bf16_t* qp = aq + tq * 1024 + hq * 64 + fq * 8;
            const bf16x8 q00 = *(const bf16x8*)(qp), q01 = *(const bf16x8*)(qp + 32);
            const bf16x8 q10 = *(const bf16x8*)(qp + 16 * 1024), q11 = *(const bf16x8*)(qp + 16 * 1024 + 32);
            f32x4 sc[10][2];
#pragma unroll
            for (int r = 0; r < 10; ++r) {
                sc[r][0] = (f32x4){0.f, 0.f, 0.f, 0.f}; sc[r][1] = (f32x4){0.f, 0.f, 0.f, 0.f};
                if (!(n == 0 && (2 * u + r) < 8)) {
                    const char* rowp = kbuf + ((2 * u + r) * 16 + fr) * 128;
                    const bf16x8 k0 = *(const bf16x8*)(rowp + ((fq ^ kswz) * 16)), k1 = *(const bf16x8*)(rowp + (((4 + fq) ^ kswz) * 16));
                    sc[r][0] = __builtin_amdgcn_mfma_f32_16x16x32_bf16(k0, q00, sc[r][0], 0, 0, 0);
                    sc[r][0] = __builtin_amdgcn_mfma_f32_16x16x32_bf16(k1, q01, sc[r][0], 0, 0, 0);
                    sc[r][1] = __builtin_amdgcn_mfma_f32_16x16x32_bf16(k0, q10, sc[r][1], 0, 0, 0);
                    sc[r][1] = __builtin_amdgcn_mfma_f32_16x16x32_bf16(k1, q11, sc[r][1], 0, 0, 0);
                }
            }
            u32x4 pf[2][5]; float linv[2];
#pragma unroll
            for (int nt = 0; nt < 2; ++nt) {
                float m = sink;
#pragma unroll
                for (int r = 0; r < 10; ++r) {
                    const bool tile_ok = !(n == 0 && (2 * u + r) < 8);
#pragma unroll
                    for (int j = 0; j < 4; ++j) {
                        const int delta = (r - nt) * 16 + fq * 4 + j - fr;
                        const bool ok = tile_ok && delta >= 1 && delta <= 128;
                        sc[r][nt][j] = ok ? sc[r][nt][j] : -INFINITY;
                        m = fmaxf(m, sc[r][nt][j]);
                    }
                }
                m = fmaxf(m, __shfl_xor(m, 16)); m = fmaxf(m, __shfl_xor(m, 32));
                float l = 0.f;
#pragma unroll
                for (int s2 = 0; s2 < 5; ++s2) {
                    float e[8];
#pragma unroll
                    for (int j = 0; j < 4; ++j) { e[j] = __expf(sc[2 * s2][nt][j] - m); e[4 + j] = __expf(sc[2 * s2 + 1][nt][j] - m); }
                    l += ((e[0] + e[1]) + (e[2] + e[3])) + ((e[4] + e[5]) + (e[6] + e[7]));
                    u32x4 w; w[0] = pk_bf16(e[0], e[1]); w[1] = pk_bf16(e[2], e[3]); w[2] = pk_bf16(e[4], e[5]); w[3] = pk_bf16(e[6], e[7]);
                    pf[nt][s2] = w;
                }
                l += __shfl_xor(l, 16); l += __shfl_xor(l, 32);
                linv[nt] = 1.0f / (l + __expf(sink - m));
            }
            f32x4 o[4][2];
#pragma unroll
            for (int dt = 0; dt < 4; ++dt) { o[dt][0] = (f32x4){0.f, 0.f, 0.f, 0.f}; o[dt][1] = (f32x4){0.f, 0.f, 0.f, 0.f}; }
#pragma unroll
            for (int s2 = 0; s2 < 5; ++s2) {
                if (!(n == 0 && (2 * u + 2 * s2) < 8)) {
                    const int ca = ((((2 * u + 2 * s2) * 2 + (fq >> 1)) ^ fr) * 16) + (fq & 1) * 8;
                    const int cb = ((((2 * u + 2 * s2 + 1) * 2 + (fq >> 1)) ^ fr) * 16) + (fq & 1) * 8;
                    const bf16x8 p0 = __builtin_bit_cast(bf16x8, pf[0][s2]), p1 = __builtin_bit_cast(bf16x8, pf[1][s2]);
#pragma unroll
                    for (int dt = 0; dt < 4; ++dt) {
                        const char* rowp = vbuf + (dt * 16 + fr) * 512;
                        const u32x2 va = *(const u32x2*)(rowp + ca), vb = *(const u32x2*)(rowp + cb);
                        u32x4 vv; vv[0] = va[0]; vv[1] = va[1]; vv[2] = vb[0]; vv[3] = vb[1];
                        const bf16x8 vf = __builtin_bit_cast(bf16x8, vv);
                        o[dt][0] = __builtin_amdgcn_mfma_f32_16x16x32_bf16(vf, p0, o[dt][0], 0, 0, 0);
                        o[dt][1] = __builtin_amdgcn_mfma_f32_16x16x32_bf16(vf, p1, o[dt][1], 0, 0, 0);
                    }
                }
            }
#pragma unroll
            for (int nt = 0; nt < 2; ++nt) {
                bf16_t* rp = ao + (size_t)(tq + nt * 16) * 1024 + hq * 64 + fq * 4;
#pragma unroll
                for (int dt = 0; dt < 4; ++dt) store_bf16x4(rp + dt * 16, o[dt][nt] * linv[nt]);
            }
        }
        __syncthreads();
    }
}

constexpr int SWA_A = 0;
__device__ __forceinline__ void phase2a(const Params& p, char* smem, int which = 3) {
    const int G = gridDim.x;
    if (which & 1) for (int it = blockIdx.x; it < 4096; it += G) ml_prepass_item(p, smem, it);
    if (which & 2) swa_items(p, smem, blockIdx.x, G, SWA_A);
}
__device__ __forceinline__ void phase2b(const Params& p, char* smem, int which = 3, const int mode = 0) {
    const int G = gridDim.x;
    if (G > 64) {
        if (blockIdx.x < 64) { if (which & 1) ml_scan(p, smem, blockIdx.x, mode); }
        else { if (which & 2) swa_items(p, smem, SWA_A + blockIdx.x - 64, G - 64, 1024); }
    } else {
        for (int it = blockIdx.x; it < 64; it += G) ml_scan(p, smem, it);
        swa_items(p, smem, SWA_A + blockIdx.x, G, 1024);
    }
}

struct EpiP3 {
    const bf16_t* gg; bf16_t* y;
    __device__ __forceinline__ void operator()(const f32x4 (&acc)[2][2][4][2], const pg8::Unit& u, int wr, int wc, int fr, int fq) const {
        const int row0 = u.pm * 256 + wr * 64 + fr, col0 = u.pn * 256 + wc * 32 + fq * 8;
#pragma unroll
        for (int ai = 0; ai < 2; ++ai)
#pragma unroll
            for (int m = 0; m < 4; ++m) {
                const size_t tok = row0 + ai * 128 + m * 16;
#pragma unroll
                for (int bj = 0; bj < 2; ++bj) {
                    const int col = col0 + bj * 128;
                    const u32x4 g = *(const u32x4*)(gg + tok * 2048 + (u.aux ? 1024 : 0) + col);
                    f32x4 v0, v1;
                    v0[0] = bf_lo(g[0]) * acc[ai][bj][m][0][0]; v0[1] = bf_hi(g[0]) * acc[ai][bj][m][0][1];
                    v0[2] = bf_lo(g[1]) * acc[ai][bj][m][0][2]; v0[3] = bf_hi(g[1]) * acc[ai][bj][m][0][3];
                    v1[0] = bf_lo(g[2]) * acc[ai][bj][m][1][0]; v1[1] = bf_hi(g[2]) * acc[ai][bj][m][1][1];
                    v1[2] = bf_lo(g[3]) * acc[ai][bj][m][1][2]; v1[3] = bf_hi(g[3]) * acc[ai][bj][m][1][3];
                    if (u.aux) {
                        const u32x4 pv = *(const u32x4*)(y + tok * 1024 + col);
                        v0[0] += bf_lo(pv[0]); v0[1] += bf_hi(pv[0]); v0[2] += bf_lo(pv[1]); v0[3] += bf_hi(pv[1]);
                        v1[0] += bf_lo(pv[2]); v1[1] += bf_hi(pv[2]); v1[2] += bf_lo(pv[3]); v1[3] += bf_hi(pv[3]);
                    }
                    store_bf16x8(y + tok * 1024 + col, v0, v1);
                }
                if (m & 1) __builtin_amdgcn_sched_barrier(0);
            }
    }
};
__device__ __forceinline__ void phase3(const Params& p, char* smem) {
    char* ws = uni(p.ws);
    SchedN1024<2> S{(int)gridDim.x, (int)blockIdx.x, ws + OFF_R0, ws + OFF_WATT, (const char*)uni(p.out), ws + OFF_WML};
    EpiP3 E{(const bf16_t*)(ws + OFF_GG), (bf16_t*)(ws + OFF_R1)};
    pg8::gemm_phase<EpiP3, SchedN1024<2>>((LDS_AS unsigned char*)smem, 1024, S, E);
}

struct EpiBf16 {
    bf16_t* outb; float scale;
    __device__ __forceinline__ void operator()(const f32x4 (&acc)[2][2][4][2], const pg8::Unit& u, int wr, int wc, int fr, int fq) const {
        const int row0 = u.pm * 256 + wr * 64 + fr, col0 = u.pn * 256 + wc * 32 + fq * 8;
#pragma unroll
        for (int ai = 0; ai < 2; ++ai)
#pragma unroll
            for (int m = 0; m < 4; ++m) {
                const size_t tok = row0 + ai * 128 + m * 16;
#pragma unroll
                for (int bj = 0; bj < 2; ++bj) store_bf16x8(outb + tok * 1024 + col0 + bj * 128, acc[ai][bj][m][0] * scale, acc[ai][bj][m][1] * scale);
            }
    }
};
__device__ __forceinline__ void phase_gemm_bf16(const Params& p, char* smem, const bf16_t* A, const bf16_t* Bt, bf16_t* outb, float scale) {
    SchedN1024<1> S{(int)gridDim.x, (int)blockIdx.x, (const char*)A, (const char*)Bt, (const char*)A, (const char*)Bt};
    EpiBf16 E{outb, scale};
    pg8::gemm_phase<EpiBf16, SchedN1024<1>>((LDS_AS unsigned char*)smem, 1024, S, E);
}

__device__ __forceinline__ void ln_row(float4 (&v)[4], const float* g, const float* bta, int lane) {
    float s = 0.f;
#pragma unroll
    for (int i = 0; i < 4; ++i) s += (v[i].x + v[i].y) + (v[i].z + v[i].w);
    const float mu = wsum(s) * (1.0f / 1024.0f);
    float q = 0.f;
#pragma unroll
    for (int i = 0; i < 4; ++i) { const float a = v[i].x - mu, b = v[i].y - mu, c = v[i].z - mu, d = v[i].w - mu; q += (a * a + b * b) + (c * c + d * d); }
    const float rstd = rsqrtf(wsum(q) * (1.0f / 1024.0f) + 1e-5f);
#pragma unroll
    for (int i = 0; i < 4; ++i) {
        const float4 gg = *(const float4*)(g + i * 256 + lane * 4), bb = *(const float4*)(bta + i * 256 + lane * 4);
        v[i].x = (v[i].x - mu) * rstd * gg.x + bb.x; v[i].y = (v[i].y - mu) * rstd * gg.y + bb.y;
        v[i].z = (v[i].z - mu) * rstd * gg.z + bb.z; v[i].w = (v[i].w - mu) * rstd * gg.w + bb.w;
    }
}

__device__ __forceinline__ void phase_ln1(const Params& p) {
    const int tid_ = opaque_tid(); const int lane = tid_ & 63, wid = tid_ >> 6;
    float* z = uni(p.out); bf16_t* hb = (bf16_t*)(uni(p.ws) + OFF_R0);
    for (int row = blockIdx.x * 8 + wid; row < T_; row += gridDim.x * 8) {
        float4 v[4];
#pragma unroll
        for (int i = 0; i < 4; ++i) {
            const float4 xx = *(const float4*)(uni(p.x) + (size_t)row * 1024 + i * 256 + lane * 4);
            const uint2 mm = *(const uint2*)(hb + (size_t)row * 1024 + i * 256 + lane * 4);
            v[i].x = ALPHA * xx.x + bf_lo(mm.x); v[i].y = ALPHA * xx.y + bf_hi(mm.x); v[i].z = ALPHA * xx.z + bf_lo(mm.y); v[i].w = ALPHA * xx.w + bf_hi(mm.y);
        }
        ln_row(v, uni(p.ln1g), uni(p.ln1b), lane);
#pragma unroll
        for (int i = 0; i < 4; ++i) {
            *(float4*)(z + (size_t)row * 1024 + i * 256 + lane * 4) = v[i];
            uint2 w; w.x = pk_bf16(v[i].x, v[i].y); w.y = pk_bf16(v[i].z, v[i].w);
            *(uint2*)(hb + (size_t)row * 1024 + i * 256 + lane * 4) = w;
        }
    }
}

__device__ __forceinline__ void xa_stage_k(const bf16_t* kmat, int b, int h, int kh, char* buf, int tid) {
    const int rl = tid >> 5, pc = tid & 31, lc = pc ^ (rl & 15);
    const bf16_t* src = kmat + (size_t)(b * 256 + kh * 128 + rl) * 1024 + h * 256 + lc * 8;
#pragma unroll
    for (int i = 0; i < 8; ++i) glds16(src + (size_t)i * 16 * 1024, buf + (i * 512 + tid) * 16);
}
__device__ __forceinline__ void xa_stage_v(const bf16_t* vT, int b, int h, int vh, char* buf, int tid) {
    const int rl = tid >> 4, pc = tid & 15, lc = pc ^ (rl & 15);
    const bf16_t* src = vT + (size_t)(h * 256 + rl) * 4096 + b * 256 + vh * 128 + lc * 8;
#pragma unroll
    for (int i = 0; i < 8; ++i) glds16(src + (size_t)i * 32 * 4096, buf + (i * 512 + tid) * 16);
}

template <int KH>
__device__ __forceinline__ void xa_scores(f32x4 (&acc)[16][2], const char* buf, const bf16_t* q0p, const bf16_t* q1p, int fr, int fq) {
#pragma unroll 2
    for (int ks = 0; ks < 8; ++ks) {
        const bf16x8 q0 = *(const bf16x8*)(q0p + ks * 32), q1 = *(const bf16x8*)(q1p + ks * 32);
        const int ch = ((ks * 4 + fq) ^ fr) * 16;
#pragma unroll
        for (int mt = 0; mt < 8; ++mt) {
            const bf16x8 kf = *(const bf16x8*)(buf + (mt * 16 + fr) * 512 + ch);
            acc[KH * 8 + mt][0] = __builtin_amdgcn_mfma_f32_16x16x32_bf16(kf, q0, acc[KH * 8 + mt][0], 0, 0, 0);
            acc[KH * 8 + mt][1] = __builtin_amdgcn_mfma_f32_16x16x32_bf16(kf, q1, acc[KH * 8 + mt][1], 0, 0, 0);
        }
    }
}


template <int VH, int DH>
__device__ __forceinline__ void xa_pv(f32x4 (&o)[8][2], const u32x4 (&pf)[2][8], const char* buf, int fr, int fq) {
#pragma unroll
    for (int ks = 0; ks < 4; ++ks) {
        const int ca = ((ks * 4 + (fq >> 1)) ^ fr) * 16 + (fq & 1) * 8, cb = ((ks * 4 + 2 + (fq >> 1)) ^ fr) * 16 + (fq & 1) * 8;
        const bf16x8 p0 = __builtin_bit_cast(bf16x8, pf[0][VH * 4 + ks]), p1 = __builtin_bit_cast(bf16x8, pf[1][VH * 4 + ks]);
#pragma unroll
        for (int dt = 0; dt < 8; ++dt) {
            const char* rowp = buf + ((DH * 8 + dt) * 16 + fr) * 256;
            const u32x2 va = *(const u32x2*)(rowp + ca), vb = *(const u32x2*)(rowp + cb);
            u32x4 vv; vv[0] = va[0]; vv[1] = va[1]; vv[2] = vb[0]; vv[3] = vb[1];
            const bf16x8 vf = __builtin_bit_cast(bf16x8, vv);
            o[dt][0] = __builtin_amdgcn_mfma_f32_16x16x32_bf16(vf, p0, o[dt][0], 0, 0, 0);
            o[dt][1] = __builtin_amdgcn_mfma_f32_16x16x32_bf16(vf, p1, o[dt][1], 0, 0, 0);
        }
    }
}

__device__ __forceinline__ void phase6(const Params& p, char* smem) {
    const int tid = opaque_tid(), lane = tid & 63, wid = tid >> 6, fr = lane & 15, fq = lane >> 4;
    char* ws = uni(p.ws);
    const bf16_t* xq = (const bf16_t*)(ws + OFF_XQ);
    const bf16_t* kmat = (const bf16_t*)(ws + OFF_KMAT);
    const bf16_t* vT = (const bf16_t*)(ws + OFF_VT);
    bf16_t* og = (bf16_t*)(ws + OFF_O);
    char* bufA = smem; char* bufB = smem + 65536;
    const int G = gridDim.x;
    for (int idx = blockIdx.x; idx < 1024; idx += G) {
        int pair, qt;
        if (G == 256) { const int i = idx >> 8, blk = idx & 255, xcd = blk & 7, jj = blk >> 3; pair = (i * 8 + xcd) * 2 + (jj >> 4); qt = jj & 15; }
        else { pair = idx >> 4; qt = idx & 15; }
        const int b = pair >> 2, h = pair & 3;
        const int tok0 = b * 4096 + qt * 256 + wid * 32;
        xa_stage_k(kmat, b, h, 0, bufA, tid);
        xa_stage_k(kmat, b, h, 1, bufB, tid);
        const bf16_t* q0p = xq + (size_t)(tok0 + fr) * 1024 + h * 256 + fq * 8;
        const bf16_t* q1p = q0p + (size_t)16 * 1024;
        f32x4 acc[16][2];
#pragma unroll
        for (int mt = 0; mt < 16; ++mt) { acc[mt][0] = (f32x4){0.f, 0.f, 0.f, 0.f}; acc[mt][1] = (f32x4){0.f, 0.f, 0.f, 0.f}; }
        asm volatile("s_waitcnt vmcnt(0)" ::: "memory");
        __syncthreads();
        xa_scores<0>(acc, bufA, q0p, q1p, fr, fq);
        xa_scores<1>(acc, bufB, q0p, q1p, fr, fq);
        __syncthreads();
        xa_stage_v(vT, b, h, 0, bufA, tid);
        xa_stage_v(vT, b, h, 1, bufB, tid);
        u32x4 pf[2][8]; float linv[2];
#pragma unroll
        for (int nt = 0; nt < 2; ++nt) {
            float m = -INFINITY;
#pragma unroll
            for (int mt = 0; mt < 16; ++mt) m = fmaxf(m, fmaxf(fmaxf(acc[mt][nt][0], acc[mt][nt][1]), fmaxf(acc[mt][nt][2], acc[mt][nt][3])));
            m = fmaxf(m, __shfl_xor(m, 16)); m = fmaxf(m, __shfl_xor(m, 32));
            float l = 0.f;
#pragma unroll
            for (int s2 = 0; s2 < 8; ++s2) {
                float e[8];
#pragma unroll
                for (int j = 0; j < 4; ++j) { e[j] = __expf(acc[2 * s2][nt][j] - m); e[4 + j] = __expf(acc[2 * s2 + 1][nt][j] - m); }
                l += ((e[0] + e[1]) + (e[2] + e[3])) + ((e[4] + e[5]) + (e[6] + e[7]));
                u32x4 w; w[0] = pk_bf16(e[0], e[1]); w[1] = pk_bf16(e[2], e[3]); w[2] = pk_bf16(e[4], e[5]); w[3] = pk_bf16(e[6], e[7]);
                pf[nt][s2] = w;
            }
            l += __shfl_xor(l, 16); l += __shfl_xor(l, 32);
            linv[nt] = 1.0f / l;
        }
        asm volatile("s_waitcnt vmcnt(0)" ::: "memory");
        __syncthreads();
        {
            f32x4 o[8][2];
#pragma unroll
            for (int dt = 0; dt < 8; ++dt) { o[dt][0] = (f32x4){0.f, 0.f, 0.f, 0.f}; o[dt][1] = (f32x4){0.f, 0.f, 0.f, 0.f}; }
            xa_pv<0, 0>(o, pf, bufA, fr, fq);
            xa_pv<1, 0>(o, pf, bufB, fr, fq);
#pragma unroll
            for (int nt = 0; nt < 2; ++nt) {
                bf16_t* rp = og + (size_t)(tok0 + nt * 16 + fr) * 1024 + h * 256 + fq * 4;
#pragma unroll
                for (int dt = 0; dt < 8; ++dt) store_bf16x4(rp + dt * 16, o[dt][nt] * linv[nt]);
            }
        }
        {
            f32x4 o[8][2];
#pragma unroll
            for (int dt = 0; dt < 8; ++dt) { o[dt][0] = (f32x4){0.f, 0.f, 0.f, 0.f}; o[dt][1] = (f32x4){0.f, 0.f, 0.f, 0.f}; }
            xa_pv<0, 1>(o, pf, bufA, fr, fq);
            xa_pv<1, 1>(o, pf, bufB, fr, fq);
#pragma unroll
            for (int nt = 0; nt < 2; ++nt) {
                bf16_t* rp = og + (size_t)(tok0 + nt * 16 + fr) * 1024 + h * 256 + 128 + fq * 4;
#pragma unroll
                for (int dt = 0; dt < 8; ++dt) store_bf16x4(rp + dt * 16, o[dt][nt] * linv[nt]);
            }
        }
        __syncthreads();
    }
}

__device__ __forceinline__ bool rt_better(float va, int ia, float vb, int ib) { return va > vb || (va == vb && ia < ib); }
__device__ __forceinline__ void phase_ln2_router(const Params& p, char* smem) {
    const int tid = opaque_tid(), lane = tid & 63, wid = tid >> 6;
    char* ws = uni(p.ws);
    float* z = (float*)(ws + OFF_Z2); bf16_t* hb = (bf16_t*)(ws + OFF_R0); const bf16_t* xa = (const bf16_t*)(ws + OFF_XQ);
    const float* h1 = uni(p.out);
    int2* toke = (int2*)(ws + OFF_TOKE); float2* tokw = (float2*)(ws + OFF_TOKW);
    int* histg = (int*)(ws + OFF_HIST);
    float* hs = (float*)(smem + wid * 16384);
    int* hist = (int*)(smem + 131072);
    const float* w_rg = uni(p.w_rg); const float* w_re = uni(p.w_re); const float* b_rg = uni(p.b_rg); const float* b_re = uni(p.b_re);
    const float* ln2g = uni(p.ln2g); const float* ln2b = uni(p.ln2b);
    const int j = lane & 7, r = (lane >> 3) & 3, kh = lane >> 5;
    for (int c = blockIdx.x; c < 256; c += gridDim.x) {
        if (tid < 64) hist[tid] = 0;
        __syncthreads();
#pragma unroll 1
        for (int rg = 0; rg < 8; ++rg) {
            const int rowbase = c * 256 + wid * 32 + rg * 4;
#pragma unroll 1
            for (int rr = 0; rr < 4; ++rr) {
                const int row = rowbase + rr;
                float4 v[4];
#pragma unroll
                for (int i = 0; i < 4; ++i) {
                    const float4 hh = *(const float4*)(h1 + (size_t)row * 1024 + i * 256 + lane * 4);
                    const uint2 mm = *(const uint2*)(xa + (size_t)row * 1024 + i * 256 + lane * 4);
                    v[i].x = ALPHA * hh.x + bf_lo(mm.x); v[i].y = ALPHA * hh.y + bf_hi(mm.x); v[i].z = ALPHA * hh.z + bf_lo(mm.y); v[i].w = ALPHA * hh.w + bf_hi(mm.y);
                }
                ln_row(v, ln2g, ln2b, lane);
#pragma unroll
                for (int i = 0; i < 4; ++i) {
                    *(float4*)(z + (size_t)row * 1024 + i * 256 + lane * 4) = v[i];
                    uint2 w; w.x = pk_bf16(v[i].x, v[i].y); w.y = pk_bf16(v[i].z, v[i].w);
                    *(uint2*)(hb + (size_t)row * 1024 + i * 256 + lane * 4) = w;
                    *(float4*)(hs + rr * 1024 + i * 256 + lane * 4) = v[i];
                }
            }
            __builtin_amdgcn_wave_barrier();
            asm volatile("s_waitcnt lgkmcnt(0)" ::: "memory");
            const float* hrow = hs + r * 1024 + kh * 512;
            float a = 0.f;
            {
                const float* wg = w_rg + (size_t)(kh * 512) * 8 + j;
#pragma unroll 4
                for (int s4 = 0; s4 < 128; ++s4) {
                    const float4 h4 = *(const float4*)(hrow + 4 * s4);
                    a += h4.x * wg[(4 * s4) * 8] + h4.y * wg[(4 * s4 + 1) * 8] + h4.z * wg[(4 * s4 + 2) * 8] + h4.w * wg[(4 * s4 + 3) * 8];
                }
            }
            a += __shfl_xor(a, 32);
            a += b_rg[j];
            float mv = a; int mi = j;
#pragma unroll
            for (int o = 1; o < 8; o <<= 1) { const float ov = __shfl_xor(mv, o); const int oi = __shfl_xor(mi, o); if (rt_better(ov, oi, mv, mi)) { mv = ov; mi = oi; } }
            float es = __expf(a - mv);
            es += __shfl_xor(es, 1); es += __shfl_xor(es, 2); es += __shfl_xor(es, 4);
            const float pgroup = 1.0f / es;
            const int gsel = mi;
            float e = 0.f;
            {
                const float* we = w_re + (size_t)(kh * 512) * 64 + gsel * 8 + j;
#pragma unroll 4
                for (int s4 = 0; s4 < 128; ++s4) {
                    const float4 h4 = *(const float4*)(hrow + 4 * s4);
                    e += h4.x * we[(4 * s4) * 64] + h4.y * we[(4 * s4 + 1) * 64] + h4.z * we[(4 * s4 + 2) * 64] + h4.w * we[(4 * s4 + 3) * 64];
                }
            }
            e += __shfl_xor(e, 32);
            e += b_re[gsel * 8 + j];
            float v0 = e, v1 = -INFINITY; int i0 = j, i1 = 99;
#pragma unroll
            for (int o = 1; o < 8; o <<= 1) {
                const float b0 = __shfl_xor(v0, o), b1 = __shfl_xor(v1, o); const int k0 = __shfl_xor(i0, o), k1 = __shfl_xor(i1, o);
                float n0, n1; int m0, m1;
                if (rt_better(v0, i0, b0, k0)) { n0 = v0; m0 = i0; if (rt_better(v1, i1, b0, k0)) { n1 = v1; m1 = i1; } else { n1 = b0; m1 = k0; } }
                else { n0 = b0; m0 = k0; if (rt_better(b1, k1, v0, i0)) { n1 = b1; m1 = k1; } else { n1 = v0; m1 = i0; } }
                v0 = n0; i0 = m0; v1 = n1; i1 = m1;
            }
            if (j == 0 && kh == 0) {
                const float e1 = __expf(v1 - v0), den = 1.0f + e1;
                const int ea = gsel * 8 + i0, eb2 = gsel * 8 + i1;
                toke[rowbase + r] = make_int2(ea, eb2); tokw[rowbase + r] = make_float2(pgroup / den, pgroup * e1 / den);
                atomicAdd(&hist[ea], 1); atomicAdd(&hist[eb2], 1);
            }
            __builtin_amdgcn_wave_barrier();
        }
        __syncthreads();
        if (tid < 64) histg[c * 64 + tid] = hist[tid];
        __syncthreads();
    }
}

__device__ __forceinline__ void compute_segments(const int* histg, int* seg, int tid) {
    if (tid < 64) {
        int s = 0;
        for (int c = 0; c < 256; ++c) s += histg[c * 64 + tid];
        seg[tid] = s;
    }
    __syncthreads();
    if (tid == 0) {
        int acc = 0;
        for (int e = 0; e < 64; ++e) { seg[64 + e] = acc; acc += (seg[e] + 255) >> 8; }
        seg[128] = acc;
    }
    __syncthreads();
}

__device__ __forceinline__ void phase8(const Params& p, char* smem) {
    const int tid = opaque_tid();
    char* ws = uni(p.ws);
    const int* histg = (const int*)(ws + OFF_HIST);
    const int2* toke = (const int2*)(ws + OFF_TOKE); const float2* tokw = (const float2*)(ws + OFF_TOKW);
    int* slot_tok = (int*)(ws + OFF_SLOTTOK); float* slot_w = (float*)(ws + OFF_SLOTW);
    int* seg = (int*)smem;
    int* cursor = seg + 192;
    compute_segments(histg, seg, tid);
    for (int e = blockIdx.x; e < 64; e += gridDim.x) {
        const int start = seg[64 + e] * 256 + seg[e], end = seg[64 + e + 1] * 256;
        for (int s = start + tid; s < end; s += NTHR) { slot_tok[s] = -1; slot_w[s] = 0.f; }
    }
    for (int c = blockIdx.x; c < 256; c += gridDim.x) {
        __syncthreads();
        if (tid < 64) {
            int base = 0;
            for (int cc = 0; cc < c; ++cc) base += histg[cc * 64 + tid];
            cursor[tid] = seg[64 + tid] * 256 + base;
        }
        __syncthreads();
        if (tid < 256) {
            const int tok = c * 256 + tid;
            const int2 ee = toke[tok]; const float2 ww = tokw[tok];
            const int s0 = atomicAdd(&cursor[ee.x], 1);
            const int s1 = atomicAdd(&cursor[ee.y], 1);
            slot_tok[s0] = tok * 2; slot_w[s0] = ww.x;
            slot_tok[s1] = tok * 2 + 1; slot_w[s1] = ww.y;
        }
    }
}

__device__ __forceinline__ void phase9a(const Params& p, char* smem) {
    const int tid = opaque_tid(), lane = tid & 63, wid = tid >> 6, wr = wid >> 1, wc = wid & 1, fr = lane & 15, fq = lane >> 4;
    char* ws = uni(p.ws);
    int* seg = (int*)(smem + LDS_GEMM);
    compute_segments((const int*)(ws + OFF_HIST), seg, tid);
    const int nrt = seg[128];
    const int* slot_tok = (const int*)(ws + OFF_SLOTTOK);
    const bf16_t* h2b = (const bf16_t*)(ws + OFF_R0);
    bf16_t* hbuf = (bf16_t*)(ws + OFF_R1);
    for (int it = 0;; ++it) {
        int t;
        if (!xcd_item(it, nrt * 4, t)) break;
        const int rtile = t >> 2, nt = t & 3;
        int e = 0;
        for (int k = 1; k < 64; ++k) if (seg[64 + k] <= rtile) e = k;
        GemmSrc s;
        {
            const int r = tid >> 3, lc = (tid & 7) ^ ((r >> 1) & 7);
#pragma unroll
            for (int i = 0; i < 4; ++i) {
                const int tk = slot_tok[rtile * 256 + i * 64 + r];
                const int tok = tk < 0 ? 0 : (tk >> 1);
                s.a[i] = h2b + (size_t)tok * 1024 + lc * 8;
            }
#pragma unroll
            for (int i = 0; i < 2; ++i) s.b[i] = (const bf16_t*)(ws + OFF_WGU) + (size_t)e * 512 * 1024 + (size_t)(nt * 128 + i * 64 + r) * 1024 + lc * 8;
        }
        f32x4 acc[4][4]; zero_acc(acc);
        gemm_loop(acc, s, 16, smem, tid);
        const int row0 = rtile * 256 + wr * 64 + fr;
        const int colb = (nt * 2 + wc) * 32 + fq * 4;
#pragma unroll
        for (int m = 0; m < 4; ++m) {
            const size_t slot = row0 + m * 16;
#pragma unroll
            for (int n = 0; n < 2; ++n) {
                const f32x4 g = acc[m][n], u = acc[m][n + 2];
                f32x4 v;
#pragma unroll
                for (int j = 0; j < 4; ++j) v[j] = g[j] * sigmoidf_(g[j]) * u[j];
                store_bf16x4(hbuf + slot * 256 + colb + n * 16, v);
            }
        }
    }
}

struct Sched9b {
    int G, c, nrt; const int* seg; const char* hbuf; const char* wd;
    __device__ __forceinline__ bool next(int i, pg8::Unit& u) const {
        int rtile, pn;
        if ((G & 7) == 0) { const int x = c & 7, j = c >> 3, nj = G >> 3, per = (nrt + 7) >> 3; const int uidx = i * nj + j; if (uidx >= per * 4) return false; rtile = x * per + (uidx >> 2); pn = uidx & 3; if (rtile >= nrt) return false; }
        else { const int uidx = i * G + c; if (uidx >= nrt * 4) return false; rtile = uidx >> 2; pn = uidx & 3; }
        int e = 0;
        for (int k = 1; k < 64; ++k) if (seg[64 + k] <= rtile) e = k;
        e = __builtin_amdgcn_readfirstlane(e);
        u.pm = rtile; u.pn = pn; u.aux = e; u.A = hbuf; u.Bt = wd + (size_t)e * 1024 * 256 * 2;
        return true;
    }
};
struct Epi9b {
    const int* slot_tok; const float* slot_w; bf16_t* yb;
    __device__ __forceinline__ void operator()(const f32x4 (&acc)[2][2][4][2], const pg8::Unit& u, int wr, int wc, int fr, int fq) const {
        const int row0 = u.pm * 256 + wr * 64 + fr, col0 = u.pn * 256 + wc * 32 + fq * 8;
#pragma unroll
        for (int ai = 0; ai < 2; ++ai)
#pragma unroll
            for (int m = 0; m < 4; ++m) {
                const int slot = row0 + ai * 128 + m * 16;
                const int tk = slot_tok[slot]; const float w = slot_w[slot];
                if (tk >= 0) {
#pragma unroll
                    for (int bj = 0; bj < 2; ++bj) store_bf16x8(yb + (size_t)tk * 1024 + col0 + bj * 128, acc[ai][bj][m][0] * w, acc[ai][bj][m][1] * w);
                }
            }
    }
};
__device__ __forceinline__ void phase9b(const Params& p, char* smem) {
    const int tid = opaque_tid();
    char* ws = uni(p.ws);
    int* seg = (int*)(smem + LDS_GEMM);
    compute_segments((const int*)(ws + OFF_HIST), seg, tid);
    Sched9b S{(int)gridDim.x, (int)blockIdx.x, __builtin_amdgcn_readfirstlane(seg[128]), seg, ws + OFF_R1, ws + OFF_WD};
    Epi9b E{(const int*)(ws + OFF_SLOTTOK), (const float*)(ws + OFF_SLOTW), (bf16_t*)(ws + OFF_YB)};
    pg8::gemm_phase<Epi9b, Sched9b>((LDS_AS unsigned char*)smem, 256, S, E);
}

__device__ __forceinline__ void phase10(const Params& p) {
    const int tid_ = opaque_tid(); const int lane = tid_ & 63, wid = tid_ >> 6;
    const float* h2 = (const float*)(uni(p.ws) + OFF_Z2); const bf16_t* yb = (const bf16_t*)(uni(p.ws) + OFF_YB);
    for (int row = blockIdx.x * 8 + wid; row < T_; row += gridDim.x * 8) {
        float4 v[4];
#pragma unroll
        for (int i = 0; i < 4; ++i) {
            const float4 hh = *(const float4*)(h2 + (size_t)row * 1024 + i * 256 + lane * 4);
            const uint2 a = *(const uint2*)(yb + (size_t)(row * 2) * 1024 + i * 256 + lane * 4), b = *(const uint2*)(yb + (size_t)(row * 2 + 1) * 1024 + i * 256 + lane * 4);
            v[i].x = ALPHA * hh.x + bf_lo(a.x) + bf_lo(b.x); v[i].y = ALPHA * hh.y + bf_hi(a.x) + bf_hi(b.x);
            v[i].z = ALPHA * hh.z + bf_lo(a.y) + bf_lo(b.y); v[i].w = ALPHA * hh.w + bf_hi(a.y) + bf_hi(b.y);
        }
        ln_row(v, uni(p.ln3g), uni(p.ln3b), lane);
#pragma unroll
        for (int i = 0; i < 4; ++i) *(float4*)(uni(p.out) + (size_t)row * 1024 + i * 256 + lane * 4) = v[i];
    }
}

#define XB_TMO      128
#define XB_XCNT(j)  (256  + 64 * (j))
#define XB_XSUB(j)  (1280 + 64 * (j))
#define XB_XGEN(j)  (2304 + 64 * (j))
#define XB_TOP      3328
#define XB_TOPGEN   3392
#define XCD_BAR_WORDS 3456
#define XB_SPIN_CAP (1u << 18)
#define LAS LDS_AS

__device__ __forceinline__ unsigned xb_ld(unsigned* p)              { return __hip_atomic_load(p, __ATOMIC_RELAXED, __HIP_MEMORY_SCOPE_AGENT); }
__device__ __forceinline__ unsigned xb_add(unsigned* p, unsigned v) { return __hip_atomic_fetch_add(p, v, __ATOMIC_RELAXED, __HIP_MEMORY_SCOPE_AGENT); }
__device__ __forceinline__ unsigned xb_xcc_id() { return (unsigned)__builtin_amdgcn_s_getreg((3 << 11) | 20) & 0xFu; }
#define XB_SPIN(cond, bar) do { unsigned _sp = 0; while (cond) { __builtin_amdgcn_s_sleep(1); \
    if ((++_sp & 255u) == 0u) { if (xb_ld(&(bar)[XB_TMO])) break; if (_sp > XB_SPIN_CAP) { atomicAdd(&(bar)[XB_TMO], 1u); break; } } } } while (0)

struct XcdBarrier {
    unsigned* bar; unsigned x;
    volatile LAS unsigned* st;
};

__device__ __forceinline__ XcdBarrier xcd_barrier_post(unsigned* bar, volatile LAS unsigned* st) {
    XcdBarrier b; b.bar = bar; b.x = xb_xcc_id(); b.st = st;
    if (threadIdx.x == 0) (void)xb_add(&bar[XB_XCNT(b.x)], 1u);
    return b;
}
__device__ __forceinline__ void xcd_barrier_complete(unsigned* bar, unsigned x, unsigned& nloc, unsigned& nx) {
    const unsigned G = gridDim.x * gridDim.y * gridDim.z;
    unsigned sum, cnt, mine, sp = 0u;
    for (;;) {
        sum = 0u; cnt = 0u; mine = 0u;
#pragma unroll
        for (unsigned j = 0; j < 16; ++j) { const unsigned c = xb_ld(&bar[XB_XCNT(j)]); sum += c; cnt += (c > 0u) ? 1u : 0u; mine = (j == x) ? c : mine; }
        if (sum == G) break;
        __builtin_amdgcn_s_sleep(1);
        if ((++sp & 255u) == 0u) { if (xb_ld(&bar[XB_TMO])) break; if (sp > XB_SPIN_CAP) { atomicAdd(&bar[XB_TMO], 1u); break; } }
    }
    nloc = mine > 0u ? mine : 1u; nx = cnt > 0u ? cnt : 1u;
}

__device__ __forceinline__ void xcd_barrier(const XcdBarrier& b) {
    asm volatile("s_waitcnt vmcnt(0)" ::: "memory");
    __syncthreads();
    if (threadIdx.x == 0) {
        unsigned* bar = b.bar;
        __builtin_amdgcn_s_waitcnt(0);
        unsigned nloc = b.st[0], nx = b.st[1];
        if (nloc == 0u) { xcd_barrier_complete(bar, b.x, nloc, nx); b.st[0] = nloc; b.st[1] = nx; }
        const unsigned old = xb_add(&bar[XB_XSUB(b.x)], 1u);
        const unsigned gen = old / nloc;
        if (old + 1u == (gen + 1u) * nloc) {
            __builtin_amdgcn_fence(__ATOMIC_RELEASE, "agent");
            asm volatile("s_waitcnt vmcnt(0)" ::: "memory");
            const unsigned og = xb_add(&bar[XB_TOP], 1u);
            const unsigned tg = og / nx;
            if (og + 1u == (tg + 1u) * nx) xb_add(&bar[XB_TOPGEN], 1u);
            else XB_SPIN(xb_ld(&bar[XB_TOPGEN]) == tg, bar);
            __builtin_amdgcn_fence(__ATOMIC_ACQUIRE, "agent");
            xb_add(&bar[XB_XGEN(b.x)], 1u);
            asm volatile("s_waitcnt vmcnt(0)" ::: "memory");
        } else {
            XB_SPIN(xb_ld(&bar[XB_XGEN(b.x)]) == gen, bar);
            __builtin_amdgcn_fence(__ATOMIC_ACQUIRE, "agent");
            asm volatile("s_waitcnt vmcnt(0)" ::: "memory");
        }
    }
    __syncthreads();
}


#ifndef DUP
#define DUP (-1)
#endif
#define RUN(id, call) do { call; if (DUP == (id)) { GRID_SYNC(); call; } } while (0)
__global__ void __launch_bounds__(NTHR) mega(Params pk) {
    extern __shared__ __attribute__((aligned(16))) char smem[];
    cg::grid_group grid = cg::this_grid();
    if (threadIdx.x == 0) *(Params*)(smem + LDS_PARAMS) = pk;
    __syncthreads();
    const Params& p = *(const Params*)(smem + LDS_PARAMS);
    char* ws = uni(p.ws);
    volatile LDS_AS unsigned* xst = (volatile LDS_AS unsigned*)(LDS_AS char*)smem + (LDS_XB / 4);
    if (threadIdx.x < 4) xst[threadIdx.x] = 0u;
    __syncthreads();
    (void)xcd_barrier_post((unsigned*)(ws + OFF_BAR), xst);
#define GRID_SYNC() do { XcdBarrier xb_; xb_.bar = (unsigned*)(uni(p.ws) + OFF_BAR); xb_.x = xb_xcc_id(); xb_.st = (volatile LDS_AS unsigned*)(LDS_AS char*)smem + (LDS_XB / 4); xcd_barrier(xb_); } while (0)
    RUN(0, phase0(p, smem));
    grid.sync();
    RUN(1, phase1(p, smem));
    if (DUP == 30) { GRID_SYNC(); phase1(p, smem, 1); }
    GRID_SYNC();
    RUN(2, phase2a(p, smem));
    if (DUP == 20) { GRID_SYNC(); phase2a(p, smem, 1); }
    if (DUP == 21) { GRID_SYNC(); phase2a(p, smem, 2); }
    GRID_SYNC();
    RUN(12, phase2b(p, smem));
    if (DUP == 22) { GRID_SYNC(); phase2b(p, smem, 1); }
    if (DUP == 23) { GRID_SYNC(); phase2b(p, smem, 2); }
    if (DUP == 24) { GRID_SYNC(); phase2b(p, smem, 1, 4); }
    if (DUP == 25) { GRID_SYNC(); phase2b(p, smem, 1, 5); }
    if (DUP == 26) { GRID_SYNC(); phase2b(p, smem, 1, 13); }
    GRID_SYNC();
    RUN(3, phase3(p, smem));
    GRID_SYNC();
    RUN(4, phase_gemm_bf16(p, smem, (const bf16_t*)(ws + OFF_R1), (const bf16_t*)(ws + OFF_WMIX), (bf16_t*)(ws + OFF_R0), 1.0f));
    GRID_SYNC();
    phase_ln1(p);
    RUN(5, moe_weight_prep(p, smem));
    GRID_SYNC();
    RUN(6, phase_gemm_bf16(p, smem, (const bf16_t*)(ws + OFF_R0), (const bf16_t*)(ws + OFF_WXQ), (bf16_t*)(ws + OFF_XQ), 0.0625f));
    GRID_SYNC();
    RUN(7, phase6(p, smem));
    GRID_SYNC();
    RUN(8, phase_gemm_bf16(p, smem, (const bf16_t*)(ws + OFF_O), (const bf16_t*)(ws + OFF_WXO), (bf16_t*)(ws + OFF_XQ), 1.0f));
    GRID_SYNC();
    RUN(13, phase_ln2_router(p, smem));
    GRID_SYNC();
    RUN(9, phase8(p, smem));
    GRID_SYNC();
    RUN(10, phase9a(p, smem));
    GRID_SYNC();
    RUN(11, phase9b(p, smem));
    GRID_SYNC();
    RUN(14, phase10(p));
}

extern "C" void kernel_launch(void* const* d_in, const int* in_sizes, int n_in, void* d_out, int out_size,
                              void* d_ws, size_t ws_size, hipStream_t stream) {
    static int grid_blocks = 0;
    if (!grid_blocks) {
        int dev = 0, cus = 0, per_cu = 0;
        (void)hipGetDevice(&dev);
        (void)hipDeviceGetAttribute(&cus, hipDeviceAttributeMultiprocessorCount, dev);
        (void)hipFuncSetAttribute((const void*)mega, hipFuncAttributeMaxDynamicSharedMemorySize, LDS_BYTES);
        (void)hipOccupancyMaxActiveBlocksPerMultiprocessor(&per_cu, mega, NTHR, LDS_BYTES);
        if (per_cu > 1) per_cu = 1;
        grid_blocks = cus * per_cu;
        if (ws_size < WS_NEED) fprintf(stderr, "workspace too small: %zu\n", ws_size);
    }
    Params p{};
    const float* const* f = (const float* const*)d_in;
    p.x = f[0]; p.mem = f[1]; p.pos = (const int*)d_in[2];
    p.w_in = f[3]; p.sinks = f[4]; p.conv_w = f[5]; p.conv_b = f[6]; p.b_ig = f[7]; p.b_fg = f[8]; p.ml_g = f[9];
    p.w_att = f[10]; p.w_ml = f[11]; p.w_mix = f[12]; p.ln1g = f[13]; p.ln1b = f[14];
    p.w_xq = f[15]; p.w_xkv = f[16]; p.w_xo = f[17]; p.ln2g = f[18]; p.ln2b = f[19];
    p.w_rg = f[20]; p.b_rg = f[21]; p.w_re = f[22]; p.b_re = f[23]; p.w_gate = f[24]; p.w_up = f[25]; p.w_down = f[26];
    p.ln3g = f[27]; p.ln3b = f[28];
    p.out = (float*)d_out; p.ws = (char*)d_ws;
    (void)hipMemsetAsync((char*)d_ws + OFF_BAR, 0, XCD_BAR_WORDS * sizeof(unsigned), stream);
    void* args[] = {&p};
    hipError_t e = hipLaunchCooperativeKernel((void*)mega, dim3(grid_blocks), dim3(NTHR), args, LDS_BYTES, stream);
    if (e != hipSuccess) fprintf(stderr, "cooperative launch failed: %s (grid %d)\n", hipGetErrorString(e), grid_blocks);
}
```

```cpp
#include <hip/hip_runtime.h>
#include <hip/hip_cooperative_groups.h>
#include <cstdio>
#include <cstdint>
namespace cg = cooperative_groups;

typedef unsigned short bf16_t;
typedef short bf16x8 __attribute__((ext_vector_type(8)));
typedef float f32x4 __attribute__((ext_vector_type(4)));
typedef unsigned u32x2 __attribute__((ext_vector_type(2)));
typedef unsigned u32x4 __attribute__((ext_vector_type(4)));
#define LDS_AS __attribute__((address_space(3)))
#define GLB_AS __attribute__((address_space(1)))

constexpr int T_ = 65536;
constexpr int NTHR = 512;
constexpr size_t MiB = 1ull << 20;
constexpr float ALPHA = 1.189207115002721f;
constexpr size_t OFF_R0 = 0;
constexpr size_t OFF_R1 = 128 * MiB;
constexpr size_t OFF_AK = 256 * MiB;
constexpr size_t OFF_AV = 272 * MiB;
constexpr size_t OFF_MQK = 288 * MiB;
constexpr size_t OFF_MV = 416 * MiB;
constexpr size_t OFF_MO = 544 * MiB;
constexpr size_t OFF_GG = 672 * MiB;
constexpr size_t OFF_WGU = 288 * MiB;
constexpr size_t OFF_WD = 352 * MiB;
constexpr size_t OFF_XQ = 416 * MiB;
constexpr size_t OFF_O = 544 * MiB;
constexpr size_t OFF_Z2 = 672 * MiB;
constexpr size_t OFF_YB = 416 * MiB;
constexpr size_t OFF_MISC = 928 * MiB;
constexpr size_t OFF_WIN = OFF_MISC;
constexpr size_t OFF_MEMB = OFF_MISC + 13 * MiB;
constexpr size_t OFF_CS = OFF_MISC + 21 * MiB;
constexpr size_t OFF_WXKV = OFF_MISC + 37 * MiB;
constexpr size_t OFF_WATT = OFF_MISC + 41 * MiB;
constexpr size_t OFF_WML = OFF_MISC + 43 * MiB;
constexpr size_t OFF_WMIX = OFF_MISC + 45 * MiB;
constexpr size_t OFF_WXQ = OFF_MISC + 47 * MiB;
constexpr size_t OFF_WXO = OFF_MISC + 49 * MiB;
constexpr size_t OFF_KMAT = OFF_MISC + 51 * MiB;
constexpr size_t OFF_VT = OFF_MISC + 59 * MiB;
constexpr size_t OFF_GATES = OFF_MISC + 67 * MiB;
constexpr size_t OFF_TOKE = OFF_MISC + 69 * MiB;
constexpr size_t OFF_TOKW = OFF_MISC + 70 * MiB;
constexpr size_t OFF_SLOTTOK = OFF_MISC + 71 * MiB;
constexpr size_t OFF_SLOTW = OFF_MISC + 72 * MiB;
constexpr size_t OFF_HIST = OFF_MISC + 73 * MiB;
constexpr size_t OFF_BAR = OFF_MISC + 74 * MiB;
constexpr size_t OFF_SP = OFF_MISC;
constexpr size_t OFF_REC = OFF_MISC + 32 * MiB;
constexpr size_t OUT_QP = 128 * MiB;
constexpr size_t OUT_KP = 192 * MiB;
constexpr size_t WS_NEED = 1024 * MiB;
constexpr int LDS_GEMM = 147456;
constexpr int LDS_PARAMS = 163520;
constexpr int LDS_XB = 163776;
constexpr int LDS_BYTES = 163840;

struct Params {
    const float *x, *mem; const int* pos;
    const float *w_in, *sinks, *conv_w, *conv_b, *b_ig, *b_fg, *ml_g, *w_att, *w_ml, *w_mix, *ln1g, *ln1b;
    const float *w_xq, *w_xkv, *w_xo, *ln2g, *ln2b, *w_rg, *b_rg, *w_re, *b_re, *w_gate, *w_up, *w_down, *ln3g, *ln3b;
    float* out; char* ws;
};

__device__ const double INV_FREQ[32] = {1.0, 0.7498942093324559, 0.5623413251903491, 0.4216965034285822, 0.31622776601683794, 0.23713737056616552, 0.1778279410038923, 0.1333521432163324, 0.1, 0.07498942093324558, 0.05623413251903491, 0.042169650342858224, 0.03162277660168379, 0.023713737056616554, 0.01778279410038923, 0.01333521432163324, 0.01, 0.007498942093324558, 0.005623413251903491, 0.004216965034285823, 0.0031622776601683794, 0.0023713737056616554, 0.0017782794100389228, 0.001333521432163324, 0.001, 0.0007498942093324559, 0.0005623413251903491, 0.00042169650342858224, 0.00031622776601683794, 0.00023713737056616554, 0.00017782794100389227, 0.0001333521432163324};

template <class T> __device__ __forceinline__ T* uni(T* q) {
    const unsigned long long v = (unsigned long long)q;
    const unsigned lo = __builtin_amdgcn_readfirstlane((unsigned)v), hi = __builtin_amdgcn_readfirstlane((unsigned)(v >> 32));
    return (T*)(((unsigned long long)hi << 32) | lo);
}
__device__ __forceinline__ int opaque_tid() { int t = threadIdx.x; asm volatile("" : "+v"(t)); return t; }
__device__ __forceinline__ unsigned pk_bf16(float lo, float hi) { unsigned r; asm("v_cvt_pk_bf16_f32 %0, %1, %2" : "=v"(r) : "v"(lo), "v"(hi)); return r; }
__device__ __forceinline__ float bf_lo(unsigned u) { return __uint_as_float(u << 16); }
__device__ __forceinline__ float bf_hi(unsigned u) { return __uint_as_float(u & 0xffff0000u); }
__device__ __forceinline__ float bf2f(bf16_t h) { return __uint_as_float(((unsigned)h) << 16); }
__device__ __forceinline__ float wsum(float v) {
#pragma unroll
    for (int o = 32; o; o >>= 1) v += __shfl_xor(v, o);
    return v;
}
__device__ __forceinline__ float wmaxf(float v) {
#pragma unroll
    for (int o = 32; o; o >>= 1) v = fmaxf(v, __shfl_xor(v, o));
    return v;
}
__device__ __forceinline__ float sigmoidf_(float x) { return 1.0f / (1.0f + __expf(-x)); }
__device__ __forceinline__ void glds16(const bf16_t* g, char* l) {
    __builtin_amdgcn_global_load_lds((const GLB_AS void*)g, (LDS_AS void*)l, 16, 0, 0);
}

__device__ __forceinline__ bool xcd_item(int i, int n, int& item) {
    const int G = gridDim.x;
    if ((G & 7) == 0) {
        const int x = blockIdx.x & 7, j = blockIdx.x >> 3, nj = G >> 3;
        const int per = (n + 7) >> 3;
        const int u = i * nj + j;
        if (u >= per) return false;
        item = x * per + u;
        return item < n;
    }
    item = blockIdx.x + i * G;
    return item < n;
}

struct GemmSrc { const bf16_t* a[4]; const bf16_t* b[2]; };

__device__ __forceinline__ void stage_tile(const GemmSrc& s, int koff, char* buf, int tid) {
#pragma unroll
    for (int i = 0; i < 4; ++i) glds16(s.a[i] + koff, buf + (i * 512 + tid) * 16);
#pragma unroll
    for (int i = 0; i < 2; ++i) glds16(s.b[i] + koff, buf + 32768 + (i * 512 + tid) * 16);
}

constexpr int GEMM_STAGE = 49152;
__device__ __forceinline__ void gemm_loop(f32x4 (&acc)[4][4], const GemmSrc& s, int nk, char* smem, int tid) {
    const int lane = tid & 63, wid = tid >> 6, wr = wid >> 1, wc = wid & 1, fr = lane & 15, fq = lane >> 4;
    const int swz = (fr >> 1) & 7;
    const int aoff = (wr * 64 + fr) * 128;
    const int boff = 32768 + (wc * 64 + fr) * 128;
    stage_tile(s, 0, smem, tid);
    if (nk > 1) stage_tile(s, 64, smem + GEMM_STAGE, tid);
    int cur = 0, nxt = 2;
#pragma unroll 1
    for (int t = 0; t < nk; ++t) {
        if (t + 1 < nk) asm volatile("s_waitcnt vmcnt(6)" ::: "memory"); else asm volatile("s_waitcnt vmcnt(0)" ::: "memory");
        __builtin_amdgcn_s_barrier();
        if (t + 2 < nk) stage_tile(s, (t + 2) * 64, smem + nxt * GEMM_STAGE, tid);
        const char* cb = smem + cur * GEMM_STAGE;
#pragma unroll
        for (int ks = 0; ks < 2; ++ks) {
            const int ch = ((ks * 4 + fq) ^ swz) * 16;
            bf16x8 xa[4], wb[4];
#pragma unroll
            for (int m = 0; m < 4; ++m) xa[m] = *(const bf16x8*)(cb + aoff + m * 2048 + ch);
#pragma unroll
            for (int n = 0; n < 4; ++n) wb[n] = *(const bf16x8*)(cb + boff + n * 2048 + ch);
#pragma unroll
            for (int m = 0; m < 4; ++m)
#pragma unroll
                for (int n = 0; n < 4; ++n) acc[m][n] = __builtin_amdgcn_mfma_f32_16x16x32_bf16(wb[n], xa[m], acc[m][n], 0, 0, 0);
        }
        cur = cur == 2 ? 0 : cur + 1; nxt = nxt == 2 ? 0 : nxt + 1;
    }
    __syncthreads();
}

__device__ __forceinline__ void zero_acc(f32x4 (&acc)[4][4]) {
#pragma unroll
    for (int m = 0; m < 4; ++m)
#pragma unroll
        for (int n = 0; n < 4; ++n) acc[m][n] = (f32x4){0.f, 0.f, 0.f, 0.f};
}

__device__ __forceinline__ void make_src(GemmSrc& s, const bf16_t* A, size_t lda, int rowA0, const bf16_t* Bt, size_t ldb, int rowB0, int tid) {
    const int r = tid >> 3, lc = (tid & 7) ^ ((r >> 1) & 7);
#pragma unroll
    for (int i = 0; i < 4; ++i) s.a[i] = A + (size_t)(rowA0 + i * 64 + r) * lda + lc * 8;
#pragma unroll
    for (int i = 0; i < 2; ++i) s.b[i] = Bt + (size_t)(rowB0 + i * 64 + r) * ldb + lc * 8;
}

__device__ __forceinline__ void store_bf16x8(bf16_t* p, f32x4 a, f32x4 b) {
    u32x4 w; w[0] = pk_bf16(a[0], a[1]); w[1] = pk_bf16(a[2], a[3]); w[2] = pk_bf16(b[0], b[1]); w[3] = pk_bf16(b[2], b[3]); *(u32x4*)p = w;
}
__device__ __forceinline__ void store_bf16x4(bf16_t* p, f32x4 v) {
    uint2 w; w.x = pk_bf16(v[0], v[1]); w.y = pk_bf16(v[2], v[3]); *(uint2*)p = w;
}

namespace pg8 {
constexpr int BM = 256, BK = 64, HALF = 128, HTB = HALF * BK * 2;
__device__ __forceinline__ int lds_byte(int r, int c) { const int st = (r >> 4) * 2 + (c >> 5), rr = r & 15, cc = c & 31, ob = rr * 64 + cc * 2; return st * 1024 + (ob ^ (((ob >> 9) & 1) << 5)); }
__device__ __forceinline__ void stage_rc(int b, int& R, int& C) { const int st = b / 1024, sb = b % 1024, swz = sb ^ (((sb >> 9) & 1) << 5); R = (st >> 1) * 16 + swz / 64; C = (st & 1) * 32 + (swz % 64) / 2; }
struct Unit { int pm, pn, aux; const char* A; const char* Bt; };

template <class Epi, class Sched>
__device__ __forceinline__ void gemm_phase(LDS_AS unsigned char* lds, const int K, const Sched& S, const Epi& E) {
    const int tid = opaque_tid(), wid = __builtin_amdgcn_readfirstlane(tid >> 6), lane = tid & 63, wr = wid >> 2, wc = wid & 3, fr = lane & 15, fq = lane >> 4;
    const int nt = K / BK;
    unsigned voff[2];
#pragma unroll
    for (int i = 0; i < 2; ++i) { int R, C; stage_rc(tid * 16 + i * 8192, R, C); voff[i] = (unsigned)(R * K + C) * 2u; }
    const size_t kstep = (size_t)(BK * 2);
    const size_t hstep = (size_t)HALF * K * 2;
    const size_t tstep = 2 * hstep;
    const unsigned ldsw = (unsigned)wid * 1024u;
    const int aoff = lds_byte(wr * 64 + fr, fq * 8), boff = lds_byte(wc * 32 + fr, fq * 8);
#define PG8_SA(b, h) (((b) * 2 + (h)) * HTB)
#define PG8_SB(b, h) ((4 + (b) * 2 + (h)) * HTB)
#define PG8_STAGE(bufoff, gbase) do { _Pragma("unroll") for (int _i = 0; _i < 2; ++_i) \
        __builtin_amdgcn_global_load_lds((const GLB_AS void*)((const char*)(gbase) + voff[_i]), (LDS_AS void*)(lds + (bufoff) + ldsw + _i * 8192), 16, 0, 0); } while (0)
#define PG8_LDA(dst, b, h) do { _Pragma("unroll") for (int m = 0; m < 4; ++m) _Pragma("unroll") for (int k = 0; k < 2; ++k) dst[m][k] = *(const LDS_AS bf16x8*)(lds + PG8_SA(b, h) + aoff + m * 2048 + k * 1024); } while (0)
#define PG8_LDB(dst, b, h) do { _Pragma("unroll") for (int n = 0; n < 2; ++n) _Pragma("unroll") for (int k = 0; k < 2; ++k) dst[n][k] = *(const LDS_AS bf16x8*)(lds + PG8_SB(b, h) + boff + n * 2048 + k * 1024); } while (0)
#define PG8_MMA(ai, bj, At, Bt) do { __builtin_amdgcn_s_setprio(1); _Pragma("unroll") for (int m = 0; m < 4; ++m) _Pragma("unroll") for (int n = 0; n < 2; ++n) _Pragma("unroll") for (int k = 0; k < 2; ++k) \
        acc[ai][bj][m][n] = __builtin_amdgcn_mfma_f32_16x16x32_bf16(Bt[n][k], At[m][k], acc[ai][bj][m][n], 0, 0, 0); __builtin_amdgcn_s_setprio(0); } while (0)
#define PG8_WAIT_V(n) asm volatile("s_waitcnt vmcnt(" #n ")" ::: "memory")
#define PG8_WAIT_L(n) asm volatile("s_waitcnt lgkmcnt(" #n ")" ::: "memory")
#define PG8_BAR __builtin_amdgcn_s_barrier()
#define PG8_SCHED __builtin_amdgcn_sched_barrier(0)
    Unit cur, nxt; int ui = 0;
    if (!S.next(0, cur)) return;
    f32x4 acc[2][2][4][2];
#pragma unroll
    for (int a = 0; a < 2; ++a)
#pragma unroll
        for (int b = 0; b < 2; ++b)
#pragma unroll
            for (int m = 0; m < 4; ++m)
#pragma unroll
                for (int n = 0; n < 2; ++n) acc[a][b][m][n] = (f32x4){0.f, 0.f, 0.f, 0.f};
    bf16x8 At[4][2], B0[2][2], B1[2][2];
    const char* cA = cur.A + (size_t)cur.pm * tstep; const char* cB = cur.Bt + (size_t)cur.pn * tstep;
    PG8_STAGE(PG8_SB(0, 0), cB); PG8_STAGE(PG8_SB(0, 1), cB + hstep); PG8_STAGE(PG8_SA(0, 0), cA); PG8_STAGE(PG8_SA(0, 1), cA + hstep);
    if (wr == 1) PG8_BAR;
    PG8_WAIT_V(2); PG8_BAR;
    PG8_STAGE(PG8_SB(1, 0), cB + kstep); PG8_STAGE(PG8_SA(1, 0), cA + kstep); PG8_STAGE(PG8_SB(1, 1), cB + hstep + kstep);
    PG8_WAIT_V(6); PG8_BAR;
    for (;;) {
        const bool has_next = S.next(ui + 1, nxt);
        const char* nA = has_next ? nxt.A + (size_t)nxt.pm * tstep : cA; const char* nB = has_next ? nxt.Bt + (size_t)nxt.pn * tstep : cB;
        for (int t = 0; t < nt; t += 2) {
            const bool last = (t == nt - 2);
            const char* a1 = cA + (size_t)(t + 1) * kstep;
            const char* a2 = last ? nA : cA + (size_t)(t + 2) * kstep; const char* b2 = last ? nB : cB + (size_t)(t + 2) * kstep;
            const char* a3 = a2 + kstep; const char* b3 = b2 + kstep;
            PG8_LDB(B0, 0, 0); PG8_LDB(B1, 0, 1); PG8_SCHED; PG8_LDA(At, 0, 0); PG8_STAGE(PG8_SA(1, 1), a1 + hstep);
            PG8_WAIT_V(8); PG8_WAIT_L(0); PG8_BAR; PG8_MMA(0, 0, At, B0); PG8_MMA(0, 1, At, B1); PG8_BAR; PG8_SCHED;
            PG8_LDA(At, 0, 1); PG8_STAGE(PG8_SB(0, 0), b2); PG8_STAGE(PG8_SB(0, 1), b2 + hstep); PG8_STAGE(PG8_SA(0, 0), a2);
            PG8_WAIT_V(8); PG8_WAIT_L(0); PG8_BAR; PG8_MMA(1, 0, At, B0); PG8_MMA(1, 1, At, B1); PG8_BAR; PG8_SCHED;
            PG8_LDB(B0, 1, 0); PG8_LDB(B1, 1, 1); PG8_SCHED; PG8_LDA(At, 1, 0); PG8_STAGE(PG8_SA(0, 1), a2 + hstep);
            PG8_WAIT_V(8); PG8_WAIT_L(0); PG8_BAR; PG8_MMA(0, 0, At, B0); PG8_MMA(0, 1, At, B1); PG8_BAR; PG8_SCHED;
            PG8_LDA(At, 1, 1); PG8_STAGE(PG8_SB(1, 0), b3); PG8_STAGE(PG8_SB(1, 1), b3 + hstep); PG8_STAGE(PG8_SA(1, 0), a3);
            PG8_WAIT_V(8); PG8_WAIT_L(0); PG8_BAR; PG8_MMA(1, 0, At, B0); PG8_MMA(1, 1, At, B1); PG8_BAR; PG8_SCHED;
        }
        if (wr == 0) PG8_BAR;
        E(acc, cur, wr, wc, fr, fq);
        if (!has_next) break;
#pragma unroll
        for (int a = 0; a < 2; ++a)
#pragma unroll
            for (int b = 0; b < 2; ++b)
#pragma unroll
                for (int m = 0; m < 4; ++m)
#pragma unroll
                    for (int n = 0; n < 2; ++n) acc[a][b][m][n] = (f32x4){0.f, 0.f, 0.f, 0.f};
        cur = nxt; cA = nA; cB = nB; ++ui;
        if (wr == 1) PG8_BAR;
    }
    PG8_WAIT_V(0);
    PG8_BAR;
#undef PG8_SA
#undef PG8_SB
#undef PG8_STAGE
#undef PG8_LDA
#undef PG8_LDB
#undef PG8_MMA
#undef PG8_WAIT_V
#undef PG8_WAIT_L
#undef PG8_BAR
#undef PG8_SCHED
}
}

__device__ __forceinline__ int perm32(int rho) { const int n = rho >> 4, i = rho & 15; return 8 * (i >> 2) + 4 * n + (i & 3); }
template <bool PERM>
__device__ __forceinline__ void tr_tile_t(const float* src, size_t ld_src, int k0, int c0, bf16_t* dst, size_t ld_dst, int r0, float* tile, int tid) {
    {
        const int r = tid >> 3, c4 = (tid & 7) * 4;
        const float4 v = *(const float4*)(src + (size_t)(k0 + r) * ld_src + c0 + c4);
        float* tp = tile + r * 33 + c4; tp[0] = v.x; tp[1] = v.y; tp[2] = v.z; tp[3] = v.w;
    }
    __syncthreads();
    {
        const int c = tid >> 4, rc = (tid & 15) * 4, sc = PERM ? perm32(c) : c;
        const float a0 = tile[(rc + 0) * 33 + sc], a1 = tile[(rc + 1) * 33 + sc], a2 = tile[(rc + 2) * 33 + sc], a3 = tile[(rc + 3) * 33 + sc];
        uint2 w; w.x = pk_bf16(a0, a1); w.y = pk_bf16(a2, a3);
        *(uint2*)(dst + (size_t)(r0 + c) * ld_dst + k0 + rc) = w;
    }
    __syncthreads();
}
__device__ __forceinline__ void tr_tile2(const float* srca, int c0a, const float* srcb, int c0b, size_t ld_src, int k0, bf16_t* dst, size_t ld_dst, int r0, float* tile, int tid) {
    {
        const int r = tid >> 3, c4 = (tid & 7) * 4;
        const float* sp = c4 < 16 ? srca + (size_t)(k0 + r) * ld_src + c0a + c4 : srcb + (size_t)(k0 + r) * ld_src + c0b + (c4 - 16);
        const float4 v = *(const float4*)sp;
        float* tp = tile + r * 33 + c4; tp[0] = v.x; tp[1] = v.y; tp[2] = v.z; tp[3] = v.w;
    }
    __syncthreads();
    {
        const int c = tid >> 4, rc = (tid & 15) * 4;
        const float a0 = tile[(rc + 0) * 33 + c], a1 = tile[(rc + 1) * 33 + c], a2 = tile[(rc + 2) * 33 + c], a3 = tile[(rc + 3) * 33 + c];
        uint2 w; w.x = pk_bf16(a0, a1); w.y = pk_bf16(a2, a3);
        *(uint2*)(dst + (size_t)(r0 + c) * ld_dst + k0 + rc) = w;
    }
    __syncthreads();
}

__device__ __forceinline__ void phase0(const Params& p, char* smem) {
    const int tid = opaque_tid(), lane = tid & 63, wid = tid >> 6;
    const int gw = blockIdx.x * 8 + wid, nw = gridDim.x * 8;
    char* ws = uni(p.ws);
    bf16_t* xb = (bf16_t*)(ws + OFF_R0);
    for (int row = gw; row < T_; row += nw) {
        const float4* xr = (const float4*)(uni(p.x) + (size_t)row * 1024);
#pragma unroll
        for (int i = 0; i < 4; ++i) {
            const float4 v = xr[i * 64 + lane];
            uint2 w; w.x = pk_bf16(v.x, v.y); w.y = pk_bf16(v.z, v.w);
            *(uint2*)(xb + (size_t)row * 1024 + i * 256 + lane * 4) = w;
        }
    }
    {
        float2* cs = (float2*)(ws + OFF_CS);
        const int gt = blockIdx.x * NTHR + tid, nt = gridDim.x * NTHR;
        for (int idx = gt; idx < T_ * 32; idx += nt) {
            const int tok = idx >> 5, i = idx & 31;
            const double ang = (double)uni(p.pos)[tok] * INV_FREQ[i];
            const double turns = ang * 0.15915494309189535;
            const float f = (float)(turns - rint(turns));
            cs[idx] = make_float2(__builtin_amdgcn_cosf(f), __builtin_amdgcn_sinf(f));
        }
        bf16_t* memb = (bf16_t*)(ws + OFF_MEMB);
        for (int idx = gt; idx < 4096 * 1024 / 4; idx += nt) {
            const float4 v = ((const float4*)uni(p.mem))[idx];
            uint2 w; w.x = pk_bf16(v.x, v.y); w.y = pk_bf16(v.z, v.w);
            ((uint2*)memb)[idx] = w;
        }
    }
    {
        float* tile = (float*)smem;
        const int NT_WIN = 16 * 201, NT_SQ = 16 * 32, NT_XKV = 16 * 64;
        const int total = NT_WIN + 5 * NT_SQ + NT_XKV;
        for (int t = blockIdx.x; t < total; t += gridDim.x) {
            if (t < NT_WIN) {
                const int kt = t & 15, nt_ = t >> 4;
                const int n0 = nt_ * 32;
                int c0;
                if (n0 < 1280) { const int pn = n0 >> 8, bj = (n0 >> 7) & 1, wc = (n0 >> 5) & 3; c0 = (4 * pn + wc) * 64 + 32 * bj; }
                else c0 = n0 < 4352 ? n0 : (n0 < 6400 ? n0 + 8 : 4352);
                tr_tile_t<true>(uni(p.w_in), 6408, kt * 64, c0, (bf16_t*)(ws + OFF_WIN), 1024, n0, tile, tid);
            } else if (t < NT_WIN + 5 * NT_SQ) {
                const int u = t - NT_WIN, which = u / NT_SQ, v = u % NT_SQ, kt = v & 15, nt_ = v >> 4;
                const float* src = which == 0 ? uni(p.w_att) : which == 1 ? uni(p.w_ml) : which == 2 ? uni(p.w_mix) : which == 3 ? uni(p.w_xq) : uni(p.w_xo);
                bf16_t* dst = (bf16_t*)(ws + OFF_WATT + (size_t)which * 2 * MiB);
                tr_tile_t<true>(src, 1024, kt * 64, nt_ * 32, dst, 1024, nt_ * 32, tile, tid);
            } else {
                const int v = t - NT_WIN - 5 * NT_SQ, kt = v & 15, nt_ = v >> 4;
                if (nt_ < 32) tr_tile_t<true>(uni(p.w_xkv), 2048, kt * 64, nt_ * 32, (bf16_t*)(ws + OFF_WXKV), 1024, nt_ * 32, tile, tid);
                else tr_tile_t<false>(uni(p.w_xkv), 2048, kt * 64, nt_ * 32, (bf16_t*)(ws + OFF_WXKV), 1024, nt_ * 32, tile, tid);
            }
        }
    }
}

__device__ __forceinline__ void moe_weight_prep(const Params& p, char* smem, int first, int stride) {
    const int tid = opaque_tid();
    float* tile = (float*)smem;
    char* ws = uni(p.ws);
    const int per_e = 384, total = 64 * per_e;
    __syncthreads();
    for (int t = first; t < total; t += stride) {
        const int e = t / per_e, u = t % per_e;
        if (u < 256) {
            const int isup = u >> 7, v = u & 127, kt = v & 15, j = v >> 4;
            const float* src = (isup ? uni(p.w_up) : uni(p.w_gate)) + (size_t)e * 1024 * 256;
            tr_tile_t<false>(src, 256, kt * 64, j * 32, (bf16_t*)(ws + OFF_WGU) + (size_t)e * 512 * 1024, 1024, j * 64 + isup * 32, tile, tid);
        } else {
            const int v = u - 256, kt = v & 3, nt_ = v >> 2;
            tr_tile_t<true>(uni(p.w_down) + (size_t)e * 256 * 1024, 1024, kt * 64, nt_ * 32, (bf16_t*)(ws + OFF_WD) + (size_t)e * 1024 * 256, 256, nt_ * 32, tile, tid);
        }
    }
}

struct SchedP1 {
    int G, c; const char *xb, *win, *memb, *wxkv;
    __device__ __forceinline__ bool next(int i, pg8::Unit& u) const {
        int nmain, uidx;
        if (G == 256) { nmain = 26; const int x = c & 7, j = c >> 3; uidx = i * 32 + j; if (i < 26) { const int g = uidx / 104, v = uidx % 104; u.pm = 32 * x + 4 * g + (v & 3); u.pn = v >> 2; } }
        else { nmain = c < 6656 ? (6656 - 1 - c) / G + 1 : 0; uidx = i * G + c; if (i < nmain) { u.pm = uidx / 26; u.pn = uidx % 26; } }
        if (i < nmain) { u.aux = 0; u.A = xb; u.Bt = win; return true; }
        const int kv = c + (i - nmain) * G;
        if (kv >= 128) return false;
        if (kv < 64) { u.aux = 1; u.pm = kv >> 2; u.pn = kv & 3; u.A = memb; u.Bt = wxkv; }
        else { const int k2 = kv - 64; u.aux = 2; u.pm = k2 >> 4; u.pn = k2 & 15; u.A = wxkv + (size_t)1024 * 1024 * 2; u.Bt = memb; }
        return true;
    }
};

struct EpiP1 {
    char* ws; int skip;
    __device__ __forceinline__ void operator()(const f32x4 (&acc)[2][2][4][2], const pg8::Unit& u, int wr, int wc, int fr, int fq) const {
        if (skip) {
#pragma unroll
            for (int a = 0; a < 2; ++a)
#pragma unroll
                for (int b = 0; b < 2; ++b)
#pragma unroll
                    for (int m = 0; m < 4; ++m) { asm volatile("" :: "v"(acc[a][b][m][0]), "v"(acc[a][b][m][1])); }
            return;
        }
        const int row0 = u.pm * 256 + wr * 64 + fr;
        if (u.aux == 0 && u.pn < 5) {
            const int hidx = 4 * u.pn + wc;
            if (hidx < 18) {
                bf16_t* dst; int ld, cb; float sc;
                if (hidx < 16) { dst = (bf16_t*)(ws + OFF_R1); ld = 1024; cb = hidx * 64; sc = 0.125f; }
                else { dst = (bf16_t*)(ws + OFF_AK); ld = 128; cb = (hidx - 16) * 64; sc = 1.0f; }
                const float* cs = (const float*)(ws + OFF_CS);
                const int d1 = 8 * fq;
#pragma unroll
                for (int ai = 0; ai < 2; ++ai)
#pragma unroll
                    for (int m = 0; m < 4; ++m) {
                        const int tok = row0 + ai * 128 + m * 16;
                        const float4* cp = (const float4*)(cs + (size_t)tok * 64 + d1 * 2);
                        const float4 c0 = cp[0], c1 = cp[1], c2 = cp[2], c3 = cp[3];
                        const f32x4 x1a = acc[ai][0][m][0], x1b = acc[ai][0][m][1], x2a = acc[ai][1][m][0], x2b = acc[ai][1][m][1];
                        f32x4 o1a, o1b, o2a, o2b;
                        o1a[0] = (x1a[0] * c0.x - x2a[0] * c0.y) * sc; o2a[0] = (x2a[0] * c0.x + x1a[0] * c0.y) * sc;
                        o1a[1] = (x1a[1] * c0.z - x2a[1] * c0.w) * sc; o2a[1] = (x2a[1] * c0.z + x1a[1] * c0.w) * sc;
                        o1a[2] = (x1a[2] * c1.x - x2a[2] * c1.y) * sc; o2a[2] = (x2a[2] * c1.x + x1a[2] * c1.y) * sc;
                        o1a[3] = (x1a[3] * c1.z - x2a[3] * c1.w) * sc; o2a[3] = (x2a[3] * c1.z + x1a[3] * c1.w) * sc;
                        o1b[0] = (x1b[0] * c2.x - x2b[0] * c2.y) * sc; o2b[0] = (x2b[0] * c2.x + x1b[0] * c2.y) * sc;
                        o1b[1] = (x1b[1] * c2.z - x2b[1] * c2.w) * sc; o2b[1] = (x2b[1] * c2.z + x1b[1] * c2.w) * sc;
                        o1b[2] = (x1b[2] * c3.x - x2b[2] * c3.y) * sc; o2b[2] = (x2b[2] * c3.x + x1b[2] * c3.y) * sc;
                        o1b[3] = (x1b[3] * c3.z - x2b[3] * c3.w) * sc; o2b[3] = (x2b[3] * c3.z + x1b[3] * c3.w) * sc;
                        bf16_t* rp = dst + (size_t)tok * ld + cb + d1;
                        store_bf16x8(rp, o1a, o1b); store_bf16x8(rp + 32, o2a, o2b);
                    }
            } else {
                bf16_t* avT = (bf16_t*)(ws + OFF_AV);
#pragma unroll
                for (int bj = 0; bj < 2; ++bj)
#pragma unroll
                    for (int ai = 0; ai < 2; ++ai)
#pragma unroll
                        for (int m = 0; m < 4; ++m)
#pragma unroll
                            for (int n = 0; n < 2; ++n)
#pragma unroll
                                for (int j = 0; j < 4; ++j)
                                    avT[(size_t)((hidx - 18) * 64 + 32 * bj + 8 * fq + 4 * n + j) * T_ + row0 + ai * 128 + m * 16] = (bf16_t)(pk_bf16(acc[ai][bj][m][n][j], acc[ai][bj][m][n][j]) & 0xffffu);
            }
            return;
        }
#pragma unroll
        for (int bj = 0; bj < 2; ++bj) {
            const int c32 = u.pn * 256 + bj * 128 + wc * 32;
            if (u.aux == 0 && c32 >= 6400) {
                if (c32 == 6400 && fq == 0) {
                    float* gates = (float*)(ws + OFF_GATES);
#pragma unroll
                    for (int ai = 0; ai < 2; ++ai)
#pragma unroll
                        for (int m = 0; m < 4; ++m) {
                            const f32x4 v0 = acc[ai][bj][m][0], v1 = acc[ai][bj][m][1];
                            float4* gp = (float4*)(gates + (size_t)(row0 + ai * 128 + m * 16) * 8);
                            gp[0] = make_float4(v0[0], v0[1], v0[2], v0[3]); gp[1] = make_float4(v1[0], v1[1], v1[2], v1[3]);
                        }
                }
            } else if (u.aux == 2) {
                bf16_t* dst = (bf16_t*)(ws + OFF_VT);
#pragma unroll
                for (int ai = 0; ai < 2; ++ai)
#pragma unroll
                    for (int m = 0; m < 4; ++m) {
                        bf16_t* rp = dst + (size_t)(row0 + ai * 128 + m * 16) * 4096 + c32 + fq * 4;
                        store_bf16x4(rp, acc[ai][bj][m][0]); store_bf16x4(rp + 16, acc[ai][bj][m][1]);
                    }
            } else {
                bf16_t* dst; int ld, cb; bool sig = false;
                if (u.aux == 1) { dst = (bf16_t*)(ws + OFF_KMAT); ld = 1024; cb = c32; }
                else if (c32 < 2304) { dst = (bf16_t*)(ws + OFF_MQK); ld = 1024; cb = c32 - 1280; }
                else if (c32 < 3328) { dst = (bf16_t*)(ws + OFF_MV); ld = 1024; cb = c32 - 2304; }
                else if (c32 < 4352) { dst = (bf16_t*)(ws + OFF_MO); ld = 1024; cb = c32 - 3328; sig = true; }
                else { dst = (bf16_t*)(ws + OFF_GG); ld = 2048; cb = c32 - 4352; sig = true; }
#pragma unroll
                for (int ai = 0; ai < 2; ++ai)
#pragma unroll
                    for (int m = 0; m < 4; ++m) {
                        f32x4 v0 = acc[ai][bj][m][0], v1 = acc[ai][bj][m][1];
                        if (sig) {
                            v0[0] = sigmoidf_(v0[0]); v0[1] = sigmoidf_(v0[1]); v0[2] = sigmoidf_(v0[2]); v0[3] = sigmoidf_(v0[3]);
                            v1[0] = sigmoidf_(v1[0]); v1[1] = sigmoidf_(v1[1]); v1[2] = sigmoidf_(v1[2]); v1[3] = sigmoidf_(v1[3]);
                        }
                        store_bf16x8(dst + (size_t)(row0 + ai * 128 + m * 16) * ld + cb + fq * 8, v0, v1);
                    }
            }
        }
    }
};

__device__ __forceinline__ void phase1(const Params& p, char* smem, int skip_epi = 0) {
    char* ws = uni(p.ws);
    SchedP1 S{(int)gridDim.x, (int)blockIdx.x, ws + OFF_R0, ws + OFF_WIN, ws + OFF_MEMB, ws + OFF_WXKV};
    EpiP1 E{ws, skip_epi};
    pg8::gemm_phase<EpiP1, SchedP1>((LDS_AS unsigned char*)smem, 1024, S, E);
}

template <int NPASS>
struct SchedN1024 {
    int G, c; const char* A0; const char* B0; const char* A1; const char* B1;
    __device__ __forceinline__ bool next(int i, pg8::Unit& u) const {
        const int ti = i / NPASS, pass = i % NPASS;
        int uidx;
        if (G == 256) { if (ti >= 4) return false; const int x = c & 7, j = c >> 3; uidx = ti * 32 + j; u.pm = 32 * x + (uidx >> 2); u.pn = uidx & 3; }
        else { uidx = ti * G + c; if (uidx >= 1024) return false; u.pm = uidx >> 2; u.pn = uidx & 3; }
        u.aux = pass; u.A = pass ? A1 : A0; u.Bt = pass ? B1 : B0;
        return true;
    }
};

typedef short v4i16_t __attribute__((ext_vector_type(4)));
__device__ __forceinline__ int offQK(int row, int ch) { return row * 256 + ((ch ^ (((row & 3) << 2) | ((row >> 2) & 3))) << 4); }
__device__ __forceinline__ int offV(int row, int ch) { return row * 512 + ((ch ^ (((row & 3) | (((row >> 3) & 1) << 2)) << 1)) << 4); }
__device__ __forceinline__ int offSw(int row, int ch) { return row * 128 + ((ch ^ ((row >> 1) & 7)) << 4); }
__device__ __forceinline__ bf16x8 tr_read2(const char* p0, const char* p1) {
    const v4i16_t a = __builtin_amdgcn_ds_read_tr16_b64_v4i16((LDS_AS v4i16_t*)p0);
    const v4i16_t b = __builtin_amdgcn_ds_read_tr16_b64_v4i16((LDS_AS v4i16_t*)p1);
    return __builtin_shufflevector(a, b, 0, 1, 2, 3, 4, 5, 6, 7);
}
__device__ __forceinline__ float row16_sum(float v) {
    v += __builtin_bit_cast(float, __builtin_amdgcn_update_dpp(0, __builtin_bit_cast(int, v), 0xB1, 0xf, 0xf, true));
    v += __builtin_bit_cast(float, __builtin_amdgcn_update_dpp(0, __builtin_bit_cast(int, v), 0x4E, 0xf, 0xf, true));
    v += __builtin_bit_cast(float, __builtin_amdgcn_update_dpp(0, __builtin_bit_cast(int, v), 0x141, 0xf, 0xf, true));
    v += __builtin_bit_cast(float, __builtin_amdgcn_update_dpp(0, __builtin_bit_cast(int, v), 0x140, 0xf, 0xf, true));
    return v;
}

constexpr int PP_Q = 0, PP_K = 16384, PP_S = 32768, PP_REC = 40960, PP_EB = 41984, PP_EK = 42240, PP_CSP = 42496  , PP_RSP = 44544  , PP_END = 45056;
__device__ __forceinline__ void ml_prepass_item(const Params& p, char* smem, int item) {
    const int tid = opaque_tid(), lane = tid & 63, wid = tid >> 6, fr = lane & 15, fq = lane >> 4;
    const int c = item & 63, bh = item >> 6, b = bh >> 2, h = bh & 3;
    char* ws = uni(p.ws);
    const bf16_t* mqk = (const bf16_t*)(ws + OFF_MQK);
    const float* gates = (const float*)(ws + OFF_GATES);
    float* rec = (float*)(smem + PP_REC); float* eb = (float*)(smem + PP_EB); float* ek = (float*)(smem + PP_EK);
    float* csp = (float*)(smem + PP_CSP); float* rsp = (float*)(smem + PP_RSP);
    const long tok0 = (long)b * 4096 + c * 64;
    const int cp = tid & 127, tg = tid >> 7;
    const bool isk = cp >= 64;
    const int dch = isk ? 2 * (cp - 64) : 2 * cp;
    const int ccol = isk ? (512 + h * 128 + dch) : (h * 128 + dch);
    unsigned r[19];
#pragma unroll
    for (int i = 0; i < 19; ++i) {
        const int tl = tg * 16 - 3 + i;
        r[i] = (c == 0 && tl < 0) ? 0u : *(const unsigned*)(mqk + (tok0 + tl) * 1024 + ccol);
    }
    float cw0[4], cw1[4];
#pragma unroll
    for (int j = 0; j < 4; ++j) { cw0[j] = uni(p.conv_w)[j * 1024 + ccol]; cw1[j] = uni(p.conv_w)[j * 1024 + ccol + 1]; }
    const float cb0 = uni(p.conv_b)[ccol], cb1 = uni(p.conv_b)[ccol + 1];
    if (wid == 0) {
        const float mi0 = gates[(tok0 + lane) * 8 + h] + uni(p.b_ig)[h], x = gates[(tok0 + lane) * 8 + 4 + h] + uni(p.b_fg)[h];
        float bs = fminf(x, 0.f) - log1pf(__expf(-fabsf(x)));
#pragma unroll
        for (int o = 1; o < 64; o <<= 1) { const float y = __shfl_up(bs, o); if (lane >= o) bs += y; }
        eb[lane] = __expf(bs); ek[lane] = __expf(mi0 - bs);
        if (lane == 63) rec[192] = __expf(bs);
    }
    __syncthreads();
    {
        const int tt0 = tg * 16;
        float cs0 = 0.f, cs1 = 0.f;
        const float* scp = (isk ? ek : eb) + tt0;
        char* dstb = smem + (isk ? PP_K : PP_Q) + (dch & 7) * 2;
        const float kmul = isk ? 0.08838834764831845f : 1.0f;
#pragma unroll
        for (int tt = 0; tt < 16; ++tt) {
            float v0 = cb0 + cw0[0] * bf_lo(r[tt]) + cw0[1] * bf_lo(r[tt + 1]) + cw0[2] * bf_lo(r[tt + 2]) + cw0[3] * bf_lo(r[tt + 3]);
            float v1 = cb1 + cw1[0] * bf_hi(r[tt]) + cw1[1] * bf_hi(r[tt + 1]) + cw1[2] * bf_hi(r[tt + 2]) + cw1[3] * bf_hi(r[tt + 3]);
            v0 = v0 * sigmoidf_(v0); v1 = v1 * sigmoidf_(v1);
            const float sc = scp[tt] * kmul;
            const float a0 = v0 * sc, a1 = v1 * sc;
            *(unsigned*)(dstb + offQK(tt0 + tt, dch >> 3)) = pk_bf16(a0, a1);
            cs0 += a0; cs1 += a1;
        }
        if (isk) { csp[tg * 128 + dch] = cs0; csp[tg * 128 + dch + 1] = cs1; }
    }
    __syncthreads();
    {
        const int tt = wid >> 1;
        bf16x8 qf[4];
#pragma unroll
        for (int ks = 0; ks < 4; ++ks) qf[ks] = *(const bf16x8*)(smem + PP_Q + offQK(tt * 16 + fr, 4 * ks + fq));
        float rs = 0.f;
#pragma unroll
        for (int x = 0; x < 2; ++x) {
            const int st = (wid & 1) * 2 + x;
            f32x4 a = (f32x4){0.f, 0.f, 0.f, 0.f};
#pragma unroll
            for (int ks = 0; ks < 4; ++ks) {
                const bf16x8 kf = *(const bf16x8*)(smem + PP_K + offQK(st * 16 + fr, 4 * ks + fq));
                a = __builtin_amdgcn_mfma_f32_16x16x32_bf16(kf, qf[ks], a, 0, 0, 0);
            }
#pragma unroll
            for (int j = 0; j < 4; ++j) a[j] = (st * 16 + fq * 4 + j) <= (tt * 16 + fr) ? a[j] : 0.f;
            rs += (a[0] + a[1]) + (a[2] + a[3]);
            uint2 w; w.x = pk_bf16(a[0], a[1]); w.y = pk_bf16(a[2], a[3]);
            *(uint2*)(smem + PP_S + offSw(tt * 16 + fr, st * 2 + (fq >> 1)) + (fq & 1) * 8) = w;
        }
        rs += __shfl_xor(rs, 16); rs += __shfl_xor(rs, 32);
        if (fq == 0) rsp[(wid & 1) * 64 + tt * 16 + fr] = rs;
        if (tid < 128) rec[64 + tid] = (csp[tid] + csp[128 + tid]) + (csp[256 + tid] + csp[384 + tid]);
    }
    __syncthreads();
    if (tid < 64) rec[tid] = rsp[tid] + rsp[64 + tid];
    __syncthreads();
    {
        char* qp = (char*)uni(p.out) + OUT_QP + (size_t)item * 16384;
        char* kp = (char*)uni(p.out) + OUT_KP + (size_t)item * 16384;
        char* sp = ws + OFF_SP + (size_t)item * 8192;
        char* rp = ws + OFF_REC + (size_t)item * 1024;
#pragma unroll
        for (int i = 0; i < 2; ++i) {
            *(u32x4*)(qp + (i * 512 + tid) * 16) = *(const u32x4*)(smem + PP_Q + (i * 512 + tid) * 16);
            *(u32x4*)(kp + (i * 512 + tid) * 16) = *(const u32x4*)(smem + PP_K + (i * 512 + tid) * 16);
        }
        *(u32x4*)(sp + tid * 16) = *(const u32x4*)(smem + PP_S + tid * 16);
        if (tid < 64) *(u32x4*)(rp + tid * 16) = *(const u32x4*)(smem + PP_REC + tid * 16);
    }
    __syncthreads();
}

constexpr int SC_BUF = 41984;
constexpr int SC_V = 2 * SC_BUF;
constexpr int SC_PART = SC_V + 65536;
constexpr int SC_NBF = SC_PART + 2048;
constexpr int SC_END = SC_NBF + 256;
__device__ __forceinline__ void ml_scan(const Params& p, char* smem, int bh, const int mode = 0) {
    const int tid = opaque_tid(), lane = tid & 63, wid = tid >> 6, fr0 = lane & 15, fq0 = lane >> 4;
    const int b = bh >> 2, h = bh & 3;
    char* ws = uni(p.ws);
    const bf16_t* mv = (const bf16_t*)(ws + OFF_MV);
    const bf16_t* mo = (const bf16_t*)(ws + OFF_MO);
    bf16_t* hm = (bf16_t*)uni(p.out);
    const long tokb = (long)b * 4096;
    f32x4 C[8][2];
#pragma unroll
    for (int dt = 0; dt < 8; ++dt) { C[dt][0] = (f32x4){0.f, 0.f, 0.f, 0.f}; C[dt][1] = (f32x4){0.f, 0.f, 0.f, 0.f}; }
    const float gn0 = uni(p.ml_g)[h * 256 + wid * 32 + fr0], gn1 = uni(p.ml_g)[h * 256 + wid * 32 + 16 + fr0];
    const int vrl = tid >> 5, vpc = tid & 31, vlc = vpc ^ ((((vrl & 3) | (((vrl >> 3) & 1) << 2))) << 1);
    const bf16_t* vsrc = mv + (tokb + vrl) * 1024 + h * 256 + vlc * 8;
    const char* qp = (const char*)uni(p.out) + OUT_QP + (size_t)bh * 64 * 16384;
    const char* kp = (const char*)uni(p.out) + OUT_KP + (size_t)bh * 64 * 16384;
    const char* sp = ws + OFF_SP + (size_t)bh * 64 * 8192;
    const char* rp = ws + OFF_REC + (size_t)bh * 64 * 1024;
#define SC_STAGE(cc, bufoff) do { \
        _Pragma("unroll") for (int _i = 0; _i < 2; ++_i) { \
            glds16((const bf16_t*)(qp + (size_t)(cc) * 16384 + (_i * 512 + tid) * 16), smem + (bufoff) + (_i * 512 + tid) * 16); \
            glds16((const bf16_t*)(kp + (size_t)(cc) * 16384 + (_i * 512 + tid) * 16), smem + (bufoff) + 16384 + (_i * 512 + tid) * 16); } \
        glds16((const bf16_t*)(sp + (size_t)(cc) * 8192 + tid * 16), smem + (bufoff) + 32768 + tid * 16); \
        if (tid < 64) glds16((const bf16_t*)(rp + (size_t)(cc) * 1024 + tid * 16), smem + (bufoff) + 40960 + tid * 16); \
        _Pragma("unroll") for (int _i = 0; _i < 4; ++_i) glds16(vsrc + (long)(cc) * 64 * 1024 + (long)_i * 16 * 1024, smem + SC_V + ((cc) & 1) * 32768 + (_i * 512 + tid) * 16); } while (0)
    __syncthreads();
    if (tid < 128) ((bf16_t*)(smem + SC_NBF))[tid] = 0;
    float nreg = 0.f;
    SC_STAGE(0, 0);
    asm volatile("s_waitcnt vmcnt(0)" ::: "memory");
#pragma unroll 1
    for (int c = 0; c < 64; ++c) {
        const int par = c & 1;
        const long tok0 = tokb + c * 64;
        int fr = fr0, fq = fq0, tv = tid;
        asm volatile("" : "+v"(fr), "+v"(fq), "+v"(tv));
        const char* buf = smem + par * SC_BUF;
        asm volatile("s_waitcnt vmcnt(4) lgkmcnt(0)" ::: "memory");
        __builtin_amdgcn_s_barrier();
        if (c + 1 < 64 && !(mode & 1)) SC_STAGE(c + 1, (par ^ 1) * SC_BUF);
        u32x4 mop[4];
#pragma unroll
        for (int i = 0; i < 4; ++i) { if (!(mode & 8)) mop[i] = *(const u32x4*)(mo + (tok0 + i * 16 + (tv >> 5)) * 1024 + h * 256 + (tv & 31) * 8); else mop[i] = (u32x4){0x3f803f80u, 0x3f803f80u, 0x3f803f80u, 0x3f803f80u}; }
        f32x4 Y[4][2], DN[4];
#pragma unroll
        for (int tt = 0; tt < 4; ++tt) { Y[tt][0] = (f32x4){0.f, 0.f, 0.f, 0.f}; Y[tt][1] = (f32x4){0.f, 0.f, 0.f, 0.f}; DN[tt] = (f32x4){0.f, 0.f, 0.f, 0.f}; }
#pragma unroll
        for (int ks = 0; ks < 4; ++ks) {
            u32x4 c0, c1;
            c0[0] = pk_bf16(C[2 * ks][0][0], C[2 * ks][0][1]); c0[1] = pk_bf16(C[2 * ks][0][2], C[2 * ks][0][3]);
            c0[2] = pk_bf16(C[2 * ks + 1][0][0], C[2 * ks + 1][0][1]); c0[3] = pk_bf16(C[2 * ks + 1][0][2], C[2 * ks + 1][0][3]);
            c1[0] = pk_bf16(C[2 * ks][1][0], C[2 * ks][1][1]); c1[1] = pk_bf16(C[2 * ks][1][2], C[2 * ks][1][3]);
            c1[2] = pk_bf16(C[2 * ks + 1][1][0], C[2 * ks + 1][1][1]); c1[3] = pk_bf16(C[2 * ks + 1][1][2], C[2 * ks + 1][1][3]);
            const bf16x8 cf0 = __builtin_bit_cast(bf16x8, c0), cf1 = __builtin_bit_cast(bf16x8, c1);
            const u32x2 nlo = *(const u32x2*)(smem + SC_NBF + (32 * ks + 4 * fq) * 2), nhi = *(const u32x2*)(smem + SC_NBF + (32 * ks + 16 + 4 * fq) * 2);
            u32x4 nv; nv[0] = nlo[0]; nv[1] = nlo[1]; nv[2] = nhi[0]; nv[3] = nhi[1];
            const bf16x8 nb = __builtin_bit_cast(bf16x8, nv);
#pragma unroll
            for (int tt = 0; tt < 4; ++tt) {
                const int row = tt * 16 + fr;
                const u32x2 lo = *(const u32x2*)(buf + offQK(row, 4 * ks + (fq >> 1)) + (fq & 1) * 8);
                const u32x2 hi = *(const u32x2*)(buf + offQK(row, 4 * ks + 2 + (fq >> 1)) + (fq & 1) * 8);
                u32x4 av; av[0] = lo[0]; av[1] = lo[1]; av[2] = hi[0]; av[3] = hi[1];
                const bf16x8 af = __builtin_bit_cast(bf16x8, av);
                Y[tt][0] = __builtin_amdgcn_mfma_f32_16x16x32_bf16(af, cf0, Y[tt][0], 0, 0, 0);
                Y[tt][1] = __builtin_amdgcn_mfma_f32_16x16x32_bf16(af, cf1, Y[tt][1], 0, 0, 0);
                DN[tt] = __builtin_amdgcn_mfma_f32_16x16x32_bf16(af, nb, DN[tt], 0, 0, 0);
            }
        }
        const char* vb = smem + SC_V + par * 32768;
        bf16x8 vf[2][2];
#pragma unroll
        for (int ks = 0; ks < 2; ++ks)
#pragma unroll
            for (int et = 0; et < 2; ++et) {
                const int cidx = 2 * wid + et, ch = 2 * cidx + ((fr & 3) >> 1);
                const int r0 = 32 * ks + 8 * fq + (fr >> 2);
                vf[ks][et] = tr_read2(vb + offV(r0, ch) + 8 * (fr & 1), vb + offV(r0 + 4, ch) + 8 * (fr & 1));
            }
#pragma unroll
        for (int ks = 0; ks < 2; ++ks)
#pragma unroll
            for (int tt = 0; tt < 4; ++tt) {
                const bf16x8 sf = *(const bf16x8*)(buf + 32768 + offSw(tt * 16 + fr, 4 * ks + fq));
                Y[tt][0] = __builtin_amdgcn_mfma_f32_16x16x32_bf16(sf, vf[ks][0], Y[tt][0], 0, 0, 0);
                Y[tt][1] = __builtin_amdgcn_mfma_f32_16x16x32_bf16(sf, vf[ks][1], Y[tt][1], 0, 0, 0);
            }
        const float* recf = (const float*)(buf + 40960);
#pragma unroll
        for (int tt = 0; tt < 4; ++tt) {
            const float4 rsv = *(const float4*)(recf + tt * 16 + fq * 4);
            const float dd[4] = {rsv.x + DN[tt][0], rsv.y + DN[tt][1], rsv.z + DN[tt][2], rsv.w + DN[tt][3]};
            float sq[4];
#pragma unroll
            for (int j = 0; j < 4; ++j) {
                const float inv = 1.0f / fmaxf(fabsf(dd[j]), 1.0f);
                Y[tt][0][j] *= inv; Y[tt][1][j] *= inv;
                sq[j] = row16_sum(Y[tt][0][j] * Y[tt][0][j] + Y[tt][1][j] * Y[tt][1][j]);
            }
            if (fr == 0) *(float4*)(smem + SC_PART + (wid * 64 + tt * 16 + fq * 4) * 4) = make_float4(sq[0], sq[1], sq[2], sq[3]);
        }
#pragma unroll
        for (int dt = 0; dt < 8; ++dt)
#pragma unroll
            for (int ks = 0; ks < 2; ++ks) {
                const int ch = 2 * dt + ((fr & 3) >> 1);
                const int r0 = 32 * ks + 8 * fq + (fr >> 2);
                const bf16x8 kf = tr_read2(buf + 16384 + offQK(r0, ch) + 8 * (fr & 1), buf + 16384 + offQK(r0 + 4, ch) + 8 * (fr & 1));
                C[dt][0] = __builtin_amdgcn_mfma_f32_16x16x32_bf16(kf, vf[ks][0], C[dt][0], 0, 0, 0);
                C[dt][1] = __builtin_amdgcn_mfma_f32_16x16x32_bf16(kf, vf[ks][1], C[dt][1], 0, 0, 0);
                if (ks == 1 && (dt & 1)) __builtin_amdgcn_sched_barrier(0);
            }
        const float g = recf[192];
#pragma unroll
        for (int dt = 0; dt < 8; ++dt) { C[dt][0] *= g; C[dt][1] *= g; }
        const float colsum = tid < 128 ? recf[64 + (tid & 127)] : 0.f;
        asm volatile("s_waitcnt lgkmcnt(0)" ::: "memory");
        __builtin_amdgcn_s_barrier();
#pragma unroll
        for (int tt = 0; tt < 4; ++tt) {
            float4 ss = *(const float4*)(smem + SC_PART + (tt * 16 + fq * 4) * 4);
#pragma unroll
            for (int w = 1; w < 8; ++w) { const float4 x = *(const float4*)(smem + SC_PART + (w * 64 + tt * 16 + fq * 4) * 4); ss.x += x.x; ss.y += x.y; ss.z += x.z; ss.w += x.w; }
            const float sv[4] = {ss.x, ss.y, ss.z, ss.w};
#pragma unroll
            for (int j = 0; j < 4; ++j) {
                const float rstd = rsqrtf(sv[j] * (1.0f / 256.0f) + 1e-6f);
                bf16_t* tp = (bf16_t*)(smem + par * SC_BUF) + (tt * 16 + fq * 4 + j) * 256 + wid * 32 + fr;
                const float o0 = Y[tt][0][j] * rstd * gn0, o1 = Y[tt][1][j] * rstd * gn1;
                tp[0] = (bf16_t)(pk_bf16(o0, o0) & 0xffffu); tp[16] = (bf16_t)(pk_bf16(o1, o1) & 0xffffu);
            }
        }
        asm volatile("s_waitcnt lgkmcnt(0)" ::: "memory");
        __builtin_amdgcn_s_barrier();
#pragma unroll
        for (int i = 0; i < 4; ++i) {
            const int row = i * 16 + (tv >> 5), ch = tv & 31;
            const u32x4 hv = *(const u32x4*)(buf + row * 512 + ch * 16);
            u32x4 o;
#pragma unroll
            for (int k = 0; k < 4; ++k) o[k] = pk_bf16(bf_lo(hv[k]) * bf_lo(mop[i][k]), bf_hi(hv[k]) * bf_hi(mop[i][k]));
            if (!(mode & 4)) *(u32x4*)(hm + (tok0 + row) * 1024 + h * 256 + ch * 8) = o; else asm volatile("" :: "v"(o));
        }
        if (tid < 128) {
            nreg = g * (nreg + colsum);
            ((bf16_t*)(smem + SC_NBF))[tid] = (bf16_t)(pk_bf16(nreg, nreg) & 0xffffu);
        }
    }
    __syncthreads();
#undef SC_STAGE
}

__device__ __forceinline__ void swa_items(const Params& p, char* smem, int first, int stride, int hi) {
    const int tid = opaque_tid(), lane = tid & 63, wid = tid >> 6, fr = lane & 15, fq = lane >> 4;
    char* ws = uni(p.ws);
    const bf16_t* aq = (const bf16_t*)(ws + OFF_R1);
    const bf16_t* ak = (const bf16_t*)(ws + OFF_AK);
    const bf16_t* avT = (const bf16_t*)(ws + OFF_AV);
    bf16_t* ao = (bf16_t*)(ws + OFF_R0);
    char* kbuf = smem; char* vbuf = smem + 32768;
    for (int item = first; item < hi; item += stride) {
        const int kvh = item & 1, n = (item >> 1) & 31, b = item >> 6;
        const int hq = kvh * 8 + wid;
        const long tokbase = (long)b * 4096 + n * 128 - 128;
        {
            const int rk = tid >> 3, pck = tid & 7, lck = pck ^ ((rk >> 1) & 7);
            const bf16_t* srck = ak + (tokbase + rk) * 128 + kvh * 64 + lck * 8;
#pragma unroll
            for (int i = 0; i < 4; ++i) glds16(srck + (long)i * 64 * 128, kbuf + (i * 512 + tid) * 16);
            const int rv = tid >> 5, pcv = tid & 31, lcv = pcv ^ (rv & 15);
            const bf16_t* srcv = avT + (long)(kvh * 64 + rv) * T_ + tokbase + lcv * 8;
#pragma unroll
            for (int i = 0; i < 4; ++i) glds16(srcv + (long)i * 16 * T_, vbuf + (i * 512 + tid) * 16);
        }
        const float sink = uni(p.sinks)[hq];
        asm volatile("s_waitcnt vmcnt(0)" ::: "memory");
        __syncthreads();
        const int kswz = (fr >> 1) & 7;
#pragma unroll 1
        for (int u = 0; u < 4; ++u) {
            const long tq = (long)b * 4096 + n * 128 + u * 32 + fr;
            const bf16_t* qp = aq + tq * 1024 + hq * 64 + fq * 8;
            const bf16x8 q00 = *(const bf16x8*)(qp), q01 = *(const bf16x8*)(qp + 32);
            const bf16x8 q10 = *(const bf16x8*)(qp + 16 * 1024), q11 = *(const bf16x8*)(qp + 16 * 1024 + 32);
            f32x4 sc[10][2];
#pragma unroll
            for (int r = 0; r < 10; ++r) {
                sc[r][0] = (f32x4){0.f, 0.f, 0.f, 0.f}; sc[r][1] = (f32x4){0.f, 0.f, 0.f, 0.f};
                if (!(n == 0 && (2 * u + r) < 8)) {
                    const char* rowp = kbuf + ((2 * u + r) * 16 + fr) * 128;
                    const bf16x8 k0 = *(const bf16x8*)(rowp + ((fq ^ kswz) * 16)), k1 = *(const bf16x8*)(rowp + (((4 + fq) ^ kswz) * 16));
                    sc[r][0] = __builtin_amdgcn_mfma_f32_16x16x32_bf16(k0, q00, sc[r][0], 0, 0, 0);
                    sc[r][0] = __builtin_amdgcn_mfma_f32_16x16x32_bf16(k1, q01, sc[r][0], 0, 0, 0);
                    sc[r][1] = __builtin_amdgcn_mfma_f32_16x16x32_bf16(k0, q10, sc[r][1], 0, 0, 0);
                    sc[r][1] = __builtin_amdgcn_mfma_f32_16x16x32_bf16(k1, q11, sc[r][1], 0, 0, 0);
                }
            }
            u32x4 pf[2][5]; float linv[2];
#pragma unroll
            for (int nt = 0; nt < 2; ++nt) {
                float m = sink;
#pragma unroll
                for (int r = 0; r < 10; ++r) {
                    const bool tile_ok = !(n == 0 && (2 * u + r) < 8);
#pragma unroll
                    for (int j = 0; j < 4; ++j) {
                        const int delta = (r - nt) * 16 + fq * 4 + j - fr;
                        const bool ok = tile_ok && delta >= 1 && delta <= 128;
                        sc[r][nt][j] = ok ? sc[r][nt][j] : -INFINITY;
                        m = fmaxf(m, sc[r][nt][j]);
                    }
                }
                m = fmaxf(m, __shfl_xor(m, 16)); m = fmaxf(m, __shfl_xor(m, 32));
                float l = 0.f;
#pragma unroll
                for (int s2 = 0; s2 < 5; ++s2) {
                    float e[8];
#pragma unroll
                    for (int j = 0; j < 4; ++j) { e[j] = __expf(sc[2 * s2][nt][j] - m); e[4 + j] = __expf(sc[2 * s2 + 1][nt][j] - m); }
                    l += ((e[0] + e[1]) + (e[2] + e[3])) + ((e[4] + e[5]) + (e[6] + e[7]));
                    u32x4 w; w[0] = pk_bf16(e[0], e[1]); w[1] = pk_bf16(e[2], e[3]); w[2] = pk_bf16(e[4], e[5]); w[3] = pk_bf16(e[6], e[7]);
                    pf[nt][s2] = w;
                }
                l += __shfl_xor(l, 16); l += __shfl_xor(l, 32);
                linv[nt] = 1.0f / (l + __expf(sink - m));
            }
            f32x4 o[4][2];
#pragma unroll
            for (int dt = 0; dt < 4; ++dt) { o[dt][0] = (f32x4){0.f, 0.f, 0.f, 0.f}; o[dt][1] = (f32x4){0.f, 0.f, 0.f, 0.f}; }
#pragma unroll
            for (int s2 = 0; s2 < 5; ++s2) {
                if (!(n == 0 && (2 * u + 2 * s2) < 8)) {
                    const int ca = ((((2 * u + 2 * s2) * 2 + (fq >> 1)) ^ fr) * 16) + (fq & 1) * 8;
                    const int cb = ((((2 * u + 2 * s2 + 1) * 2 + (fq >> 1)) ^ fr) * 16) + (fq & 1) * 8;
                    const bf16x8 p0 = __builtin_bit_cast(bf16x8, pf[0][s2]), p1 = __builtin_bit_cast(bf16x8, pf[1][s2]);
#pragma unroll
                    for (int dt = 0; dt < 4; ++dt) {
                        const char* rowp = vbuf + (dt * 16 + fr) * 512;
                        const u32x2 va = *(const u32x2*)(rowp + ca), vb = *(const u32x2*)(rowp + cb);
                        u32x4 vv; vv[0] = va[0]; vv[1] = va[1]; vv[2] = vb[0]; vv[3] = vb[1];
                        const bf16x8 vf = __builtin_bit_cast(bf16x8, vv);
                        o[dt][0] = __builtin_amdgcn_mfma_f32_16x16x32_bf16(vf, p0, o[dt][0], 0, 0, 0);
                        o[dt][1] = __builtin_amdgcn_mfma_f32_16x16x32_bf16(vf, p1, o[dt][1], 0, 0, 0);
                    }
                }
            }
#pragma unroll
            for (int nt = 0; nt < 2; ++nt) {
                bf16_t* rp = ao + (size_t)(tq + nt * 16) * 1024 + hq * 64 + fq * 4;
#pragma unroll
                for (int dt = 0; dt < 4; ++dt) store_bf16x4(rp + dt * 16, o[dt][nt] * linv[nt]);
            }
        }
        __syncthreads();
    }
}

constexpr int SWA_A = 0;
__device__ __forceinline__ void phase2a(const Params& p, char* smem, int which = 3) {
    const int G = gridDim.x;
    if (which & 1) for (int it = blockIdx.x; it < 4096; it += G) ml_prepass_item(p, smem, it);
    if (which & 2) swa_items(p, smem, blockIdx.x, G, SWA_A);
}
__device__ __forceinline__ void phase2b(const Params& p, char* smem, int which = 3, const int mode = 0) {
    const int G = gridDim.x;
    if (G > 64) {
        if (blockIdx.x < 64) { if (which & 1) ml_scan(p, smem, blockIdx.x, mode); }
        else { if (which & 2) { swa_items(p, smem, SWA_A + blockIdx.x - 64, G - 64, 1024); moe_weight_prep(p, smem, blockIdx.x - 64, G - 64); } }
    } else {
        for (int it = blockIdx.x; it < 64; it += G) ml_scan(p, smem, it);
        swa_items(p, smem, SWA_A + blockIdx.x, G, 1024);
        moe_weight_prep(p, smem, blockIdx.x, G);
    }
}

struct EpiP3 {
    const bf16_t* gg; bf16_t* y;
    __device__ __forceinline__ void operator()(const f32x4 (&acc)[2][2][4][2], const pg8::Unit& u, int wr, int wc, int fr, int fq) const {
        const int row0 = u.pm * 256 + wr * 64 + fr, col0 = u.pn * 256 + wc * 32 + fq * 8;
#pragma unroll
        for (int ai = 0; ai < 2; ++ai)
#pragma unroll
            for (int m = 0; m < 4; ++m) {
                const size_t tok = row0 + ai * 128 + m * 16;
#pragma unroll
                for (int bj = 0; bj < 2; ++bj) {
                    const int col = col0 + bj * 128;
                    const u32x4 g = *(const u32x4*)(gg + tok * 2048 + (u.aux ? 1024 : 0) + col);
                    f32x4 v0, v1;
                    v0[0] = bf_lo(g[0]) * acc[ai][bj][m][0][0]; v0[1] = bf_hi(g[0]) * acc[ai][bj][m][0][1];
                    v0[2] = bf_lo(g[1]) * acc[ai][bj][m][0][2]; v0[3] = bf_hi(g[1]) * acc[ai][bj][m][0][3];
                    v1[0] = bf_lo(g[2]) * acc[ai][bj][m][1][0]; v1[1] = bf_hi(g[2]) * acc[ai][bj][m][1][1];
                    v1[2] = bf_lo(g[3]) * acc[ai][bj][m][1][2]; v1[3] = bf_hi(g[3]) * acc[ai][bj][m][1][3];
                    if (u.aux) {
                        const u32x4 pv = *(const u32x4*)(y + tok * 1024 + col);
                        v0[0] += bf_lo(pv[0]); v0[1] += bf_hi(pv[0]); v0[2] += bf_lo(pv[1]); v0[3] += bf_hi(pv[1]);
                        v1[0] += bf_lo(pv[2]); v1[1] += bf_hi(pv[2]); v1[2] += bf_lo(pv[3]); v1[3] += bf_hi(pv[3]);
                    }
                    store_bf16x8(y + tok * 1024 + col, v0, v1);
                }
                if (m & 1) __builtin_amdgcn_sched_barrier(0);
            }
    }
};
__device__ __forceinline__ void phase3(const Params& p, char* smem) {
    char* ws = uni(p.ws);
    SchedN1024<2> S{(int)gridDim.x, (int)blockIdx.x, ws + OFF_R0, ws + OFF_WATT, (const char*)uni(p.out), ws + OFF_WML};
    EpiP3 E{(const bf16_t*)(ws + OFF_GG), (bf16_t*)(ws + OFF_R1)};
    pg8::gemm_phase<EpiP3, SchedN1024<2>>((LDS_AS unsigned char*)smem, 1024, S, E);
}

struct EpiBf16 {
    bf16_t* outb; float scale;
    __device__ __forceinline__ void operator()(const f32x4 (&acc)[2][2][4][2], const pg8::Unit& u, int wr, int wc, int fr, int fq) const {
        const int row0 = u.pm * 256 + wr * 64 + fr, col0 = u.pn * 256 + wc * 32 + fq * 8;
#pragma unroll
        for (int ai = 0; ai < 2; ++ai)
#pragma unroll
            for (int m = 0; m < 4; ++m) {
                const size_t tok = row0 + ai * 128 + m * 16;
#pragma unroll
                for (int bj = 0; bj < 2; ++bj) store_bf16x8(outb + tok * 1024 + col0 + bj * 128, acc[ai][bj][m][0] * scale, acc[ai][bj][m][1] * scale);
            }
    }
};
__device__ __forceinline__ void phase_gemm_bf16(const Params& p, char* smem, const bf16_t* A, const bf16_t* Bt, bf16_t* outb, float scale) {
    SchedN1024<1> S{(int)gridDim.x, (int)blockIdx.x, (const char*)A, (const char*)Bt, (const char*)A, (const char*)Bt};
    EpiBf16 E{outb, scale};
    pg8::gemm_phase<EpiBf16, SchedN1024<1>>((LDS_AS unsigned char*)smem, 1024, S, E);
}

__device__ __forceinline__ void ln_row(float4 (&v)[4], const float* g, const float* bta, int lane) {
    float s = 0.f;
#pragma unroll
    for (int i = 0; i < 4; ++i) s += (v[i].x + v[i].y) + (v[i].z + v[i].w);
    const float mu = wsum(s) * (1.0f / 1024.0f);
    float q = 0.f;
#pragma unroll
    for (int i = 0; i < 4; ++i) { const float a = v[i].x - mu, b = v[i].y - mu, c = v[i].z - mu, d = v[i].w - mu; q += (a * a + b * b) + (c * c + d * d); }
    const float rstd = rsqrtf(wsum(q) * (1.0f / 1024.0f) + 1e-5f);
#pragma unroll
    for (int i = 0; i < 4; ++i) {
        const float4 gg = *(const float4*)(g + i * 256 + lane * 4), bb = *(const float4*)(bta + i * 256 + lane * 4);
        v[i].x = (v[i].x - mu) * rstd * gg.x + bb.x; v[i].y = (v[i].y - mu) * rstd * gg.y + bb.y;
        v[i].z = (v[i].z - mu) * rstd * gg.z + bb.z; v[i].w = (v[i].w - mu) * rstd * gg.w + bb.w;
    }
}

__device__ __forceinline__ void phase_ln1(const Params& p) {
    const int tid_ = opaque_tid(); const int lane = tid_ & 63, wid = tid_ >> 6;
    float* z = uni(p.out); bf16_t* hb = (bf16_t*)(uni(p.ws) + OFF_R0);
    for (int row = blockIdx.x * 8 + wid; row < T_; row += gridDim.x * 8) {
        float4 v[4];
#pragma unroll
        for (int i = 0; i < 4; ++i) {
            const float4 xx = *(const float4*)(uni(p.x) + (size_t)row * 1024 + i * 256 + lane * 4);
            const uint2 mm = *(const uint2*)(hb + (size_t)row * 1024 + i * 256 + lane * 4);
            v[i].x = ALPHA * xx.x + bf_lo(mm.x); v[i].y = ALPHA * xx.y + bf_hi(mm.x); v[i].z = ALPHA * xx.z + bf_lo(mm.y); v[i].w = ALPHA * xx.w + bf_hi(mm.y);
        }
        ln_row(v, uni(p.ln1g), uni(p.ln1b), lane);
#pragma unroll
        for (int i = 0; i < 4; ++i) {
            *(float4*)(z + (size_t)row * 1024 + i * 256 + lane * 4) = v[i];
            uint2 w; w.x = pk_bf16(v[i].x, v[i].y); w.y = pk_bf16(v[i].z, v[i].w);
            *(uint2*)(hb + (size_t)row * 1024 + i * 256 + lane * 4) = w;
        }
    }
}

__device__ __forceinline__ void xa_stage_k(const bf16_t* kmat, int b, int h, int kh, char* buf, int tid) {
    const int rl = tid >> 5, pc = tid & 31, lc = pc ^ (rl & 15);
    const bf16_t* src = kmat + (size_t)(b * 256 + kh * 128 + rl) * 1024 + h * 256 + lc * 8;
#pragma unroll
    for (int i = 0; i < 8; ++i) glds16(src + (size_t)i * 16 * 1024, buf + (i * 512 + tid) * 16);
}
__device__ __forceinline__ void xa_stage_v(const bf16_t* vT, int b, int h, int vh, char* buf, int tid) {
    const int rl = tid >> 4, pc = tid & 15, lc = pc ^ (rl & 15);
    const bf16_t* src = vT + (size_t)(h * 256 + rl) * 4096 + b * 256 + vh * 128 + lc * 8;
#pragma unroll
    for (int i = 0; i < 8; ++i) glds16(src + (size_t)i * 32 * 4096, buf + (i * 512 + tid) * 16);
}

template <int KH>
__device__ __forceinline__ void xa_scores(f32x4 (&acc)[16][2], const char* buf, const bf16_t* q0p, const bf16_t* q1p, int fr, int fq) {
#pragma unroll 2
    for (int ks = 0; ks < 8; ++ks) {
        const bf16x8 q0 = *(const bf16x8*)(q0p + ks * 32), q1 = *(const bf16x8*)(q1p + ks * 32);
        const int ch = ((ks * 4 + fq) ^ fr) * 16;
#pragma unroll
        for (int mt = 0; mt < 8; ++mt) {
            const bf16x8 kf = *(const bf16x8*)(buf + (mt * 16 + fr) * 512 + ch);
            acc[KH * 8 + mt][0] = __builtin_amdgcn_mfma_f32_16x16x32_bf16(kf, q0, acc[KH * 8 + mt][0], 0, 0, 0);
            acc[KH * 8 + mt][1] = __builtin_amdgcn_mfma_f32_16x16x32_bf16(kf, q1, acc[KH * 8 + mt][1], 0, 0, 0);
        }
    }
}


template <int VH, int DH>
__device__ __forceinline__ void xa_pv(f32x4 (&o)[8][2], const u32x4 (&pf)[2][8], const char* buf, int fr, int fq) {
#pragma unroll
    for (int ks = 0; ks < 4; ++ks) {
        const int ca = ((ks * 4 + (fq >> 1)) ^ fr) * 16 + (fq & 1) * 8, cb = ((ks * 4 + 2 + (fq >> 1)) ^ fr) * 16 + (fq & 1) * 8;
        const bf16x8 p0 = __builtin_bit_cast(bf16x8, pf[0][VH * 4 + ks]), p1 = __builtin_bit_cast(bf16x8, pf[1][VH * 4 + ks]);
#pragma unroll
        for (int dt = 0; dt < 8; ++dt) {
            const char* rowp = buf + ((DH * 8 + dt) * 16 + fr) * 256;
            const u32x2 va = *(const u32x2*)(rowp + ca), vb = *(const u32x2*)(rowp + cb);
            u32x4 vv; vv[0] = va[0]; vv[1] = va[1]; vv[2] = vb[0]; vv[3] = vb[1];
            const bf16x8 vf = __builtin_bit_cast(bf16x8, vv);
            o[dt][0] = __builtin_amdgcn_mfma_f32_16x16x32_bf16(vf, p0, o[dt][0], 0, 0, 0);
            o[dt][1] = __builtin_amdgcn_mfma_f32_16x16x32_bf16(vf, p1, o[dt][1], 0, 0, 0);
        }
    }
}

__device__ __forceinline__ void phase6(const Params& p, char* smem) {
    const int tid = opaque_tid(), lane = tid & 63, wid = tid >> 6, fr = lane & 15, fq = lane >> 4;
    char* ws = uni(p.ws);
    const bf16_t* xq = (const bf16_t*)(ws + OFF_XQ);
    const bf16_t* kmat = (const bf16_t*)(ws + OFF_KMAT);
    const bf16_t* vT = (const bf16_t*)(ws + OFF_VT);
    bf16_t* og = (bf16_t*)(ws + OFF_O);
    char* bufA = smem; char* bufB = smem + 65536;
    const int G = gridDim.x;
    for (int idx = blockIdx.x; idx < 1024; idx += G) {
        int pair, qt;
        if (G == 256) { const int i = idx >> 8, blk = idx & 255, xcd = blk & 7, jj = blk >> 3; pair = (i * 8 + xcd) * 2 + (jj >> 4); qt = jj & 15; }
        else { pair = idx >> 4; qt = idx & 15; }
        const int b = pair >> 2, h = pair & 3;
        const int tok0 = b * 4096 + qt * 256 + wid * 32;
        xa_stage_k(kmat, b, h, 0, bufA, tid);
        xa_stage_k(kmat, b, h, 1, bufB, tid);
        const bf16_t* q0p = xq + (size_t)(tok0 + fr) * 1024 + h * 256 + fq * 8;
        const bf16_t* q1p = q0p + (size_t)16 * 1024;
        f32x4 acc[16][2];
#pragma unroll
        for (int mt = 0; mt < 16; ++mt) { acc[mt][0] = (f32x4){0.f, 0.f, 0.f, 0.f}; acc[mt][1] = (f32x4){0.f, 0.f, 0.f, 0.f}; }
        asm volatile("s_waitcnt vmcnt(0)" ::: "memory");
        __syncthreads();
        xa_scores<0>(acc, bufA, q0p, q1p, fr, fq);
        xa_scores<1>(acc, bufB, q0p, q1p, fr, fq);
        __syncthreads();
        xa_stage_v(vT, b, h, 0, bufA, tid);
        xa_stage_v(vT, b, h, 1, bufB, tid);
        u32x4 pf[2][8]; float linv[2];
#pragma unroll
        for (int nt = 0; nt < 2; ++nt) {
            float m = -INFINITY;
#pragma unroll
            for (int mt = 0; mt < 16; ++mt) m = fmaxf(m, fmaxf(fmaxf(acc[mt][nt][0], acc[mt][nt][1]), fmaxf(acc[mt][nt][2], acc[mt][nt][3])));
            m = fmaxf(m, __shfl_xor(m, 16)); m = fmaxf(m, __shfl_xor(m, 32));
            float l = 0.f;
#pragma unroll
            for (int s2 = 0; s2 < 8; ++s2) {
                float e[8];
#pragma unroll
                for (int j = 0; j < 4; ++j) { e[j] = __expf(acc[2 * s2][nt][j] - m); e[4 + j] = __expf(acc[2 * s2 + 1][nt][j] - m); }
                l += ((e[0] + e[1]) + (e[2] + e[3])) + ((e[4] + e[5]) + (e[6] + e[7]));
                u32x4 w; w[0] = pk_bf16(e[0], e[1]); w[1] = pk_bf16(e[2], e[3]); w[2] = pk_bf16(e[4], e[5]); w[3] = pk_bf16(e[6], e[7]);
                pf[nt][s2] = w;
            }
            l += __shfl_xor(l, 16); l += __shfl_xor(l, 32);
            linv[nt] = 1.0f / l;
        }
        asm volatile("s_waitcnt vmcnt(0)" ::: "memory");
        __syncthreads();
        {
            f32x4 o[8][2];
#pragma unroll
            for (int dt = 0; dt < 8; ++dt) { o[dt][0] = (f32x4){0.f, 0.f, 0.f, 0.f}; o[dt][1] = (f32x4){0.f, 0.f, 0.f, 0.f}; }
            xa_pv<0, 0>(o, pf, bufA, fr, fq);
            xa_pv<1, 0>(o, pf, bufB, fr, fq);
#pragma unroll
            for (int nt = 0; nt < 2; ++nt) {
                bf16_t* rp = og + (size_t)(tok0 + nt * 16 + fr) * 1024 + h * 256 + fq * 4;
#pragma unroll
                for (int dt = 0; dt < 8; ++dt) store_bf16x4(rp + dt * 16, o[dt][nt] * linv[nt]);
            }
        }
        {
            f32x4 o[8][2];
#pragma unroll
            for (int dt = 0; dt < 8; ++dt) { o[dt][0] = (f32x4){0.f, 0.f, 0.f, 0.f}; o[dt][1] = (f32x4){0.f, 0.f, 0.f, 0.f}; }
            xa_pv<0, 1>(o, pf, bufA, fr, fq);
            xa_pv<1, 1>(o, pf, bufB, fr, fq);
#pragma unroll
            for (int nt = 0; nt < 2; ++nt) {
                bf16_t* rp = og + (size_t)(tok0 + nt * 16 + fr) * 1024 + h * 256 + 128 + fq * 4;
#pragma unroll
                for (int dt = 0; dt < 8; ++dt) store_bf16x4(rp + dt * 16, o[dt][nt] * linv[nt]);
            }
        }
        __syncthreads();
    }
}

__device__ __forceinline__ bool rt_better(float va, int ia, float vb, int ib) { return va > vb || (va == vb && ia < ib); }
__device__ __forceinline__ void phase_ln2_router(const Params& p, char* smem, const int mode = 0) {
    const int tid = opaque_tid(), lane = tid & 63, wid = tid >> 6;
    char* ws = uni(p.ws);
    float* z = (float*)(ws + OFF_Z2); bf16_t* hb = (bf16_t*)(ws + OFF_R0); const bf16_t* xa = (const bf16_t*)(ws + OFF_XQ);
    const float* h1 = uni(p.out);
    int2* toke = (int2*)(ws + OFF_TOKE); float2* tokw = (float2*)(ws + OFF_TOKW);
    int* histg = (int*)(ws + OFF_HIST);
    float* hs = (float*)(smem + wid * 16512);
    int* hist = (int*)(smem + 132096);
    const float* w_rg = uni(p.w_rg); const float* w_re = uni(p.w_re); const float* b_rg = uni(p.b_rg); const float* b_re = uni(p.b_re);
    const float* ln2g = uni(p.ln2g); const float* ln2b = uni(p.ln2b);
    const int chalf = lane & 1, kk = (lane >> 1) & 7, r = lane >> 4;
    for (int c = blockIdx.x; c < 256; c += gridDim.x) {
        if (tid < 64) hist[tid] = 0;
        __syncthreads();
#pragma unroll 1
        for (int rg = 0; rg < 8; ++rg) {
            const int rowbase = c * 256 + wid * 32 + rg * 4;
#pragma unroll
            for (int rr = 0; rr < 4; ++rr) {
                const int row = rowbase + rr;
                float4 v[4];
#pragma unroll
                for (int i = 0; i < 4; ++i) {
                    const float4 hh = *(const float4*)(h1 + (size_t)row * 1024 + i * 256 + lane * 4);
                    const uint2 mm = *(const uint2*)(xa + (size_t)row * 1024 + i * 256 + lane * 4);
                    v[i].x = ALPHA * hh.x + bf_lo(mm.x); v[i].y = ALPHA * hh.y + bf_hi(mm.x); v[i].z = ALPHA * hh.z + bf_lo(mm.y); v[i].w = ALPHA * hh.w + bf_hi(mm.y);
                }
                ln_row(v, ln2g, ln2b, lane);
#pragma unroll
                for (int i = 0; i < 4; ++i) {
                    uint2 w; w.x = pk_bf16(v[i].x, v[i].y); w.y = pk_bf16(v[i].z, v[i].w);
                    if (!(mode & 2)) { *(float4*)(z + (size_t)row * 1024 + i * 256 + lane * 4) = v[i]; *(uint2*)(hb + (size_t)row * 1024 + i * 256 + lane * 4) = w; }
                    *(float4*)(hs + rr * 1032 + i * 256 + lane * 4) = v[i];
                }
            }
            __builtin_amdgcn_wave_barrier();
            asm volatile("s_waitcnt lgkmcnt(0)" ::: "memory");
            if (mode & 1) continue;
            float g0 = 0.f, g1 = 0.f, g2 = 0.f, g3 = 0.f;
#pragma unroll 16
            for (int s8 = 0; s8 < 128; ++s8) {
                const int k = s8 * 8 + kk;
                const float4 w = *(const float4*)(w_rg + (size_t)k * 8 + chalf * 4);
                const float hv = hs[r * 1032 + k];
                g0 += hv * w.x; g1 += hv * w.y; g2 += hv * w.z; g3 += hv * w.w;
            }
#pragma unroll
            for (int o = 2; o < 16; o <<= 1) { g0 += __shfl_xor(g0, o); g1 += __shfl_xor(g1, o); g2 += __shfl_xor(g2, o); g3 += __shfl_xor(g3, o); }
            {
                const float4 bb = *(const float4*)(b_rg + chalf * 4);
                g0 += bb.x; g1 += bb.y; g2 += bb.z; g3 += bb.w;
            }
            float mv = g0; int mi = chalf * 4;
            if (g1 > mv) { mv = g1; mi = chalf * 4 + 1; }
            if (g2 > mv) { mv = g2; mi = chalf * 4 + 2; }
            if (g3 > mv) { mv = g3; mi = chalf * 4 + 3; }
            { const float ov = __shfl_xor(mv, 1); const int oi = __shfl_xor(mi, 1); if (rt_better(ov, oi, mv, mi)) { mv = ov; mi = oi; } }
            float es = (__expf(g0 - mv) + __expf(g1 - mv)) + (__expf(g2 - mv) + __expf(g3 - mv));
            es += __shfl_xor(es, 1);
            const float pgroup = 1.0f / es;
            const int gsel = mi;
            float e0 = 0.f, e1 = 0.f, e2 = 0.f, e3 = 0.f;
            {
                const float* we = w_re + gsel * 8 + chalf * 4;
#pragma unroll 32
                for (int s8 = 0; s8 < 128; ++s8) {
                    const int k = s8 * 8 + kk;
                    const float4 w = *(const float4*)(we + (size_t)k * 64);
                    const float hv = hs[r * 1032 + k];
                    e0 += hv * w.x; e1 += hv * w.y; e2 += hv * w.z; e3 += hv * w.w;
                }
            }
#pragma unroll
            for (int o = 2; o < 16; o <<= 1) { e0 += __shfl_xor(e0, o); e1 += __shfl_xor(e1, o); e2 += __shfl_xor(e2, o); e3 += __shfl_xor(e3, o); }
            {
                const float4 bb = *(const float4*)(b_re + gsel * 8 + chalf * 4);
                e0 += bb.x; e1 += bb.y; e2 += bb.z; e3 += bb.w;
            }
            float v0 = e0, v1 = -INFINITY; int i0 = chalf * 4, i1 = 99;
            {
                const float ev[3] = {e1, e2, e3};
#pragma unroll
                for (int q = 0; q < 3; ++q) {
                    const float x = ev[q]; const int xi = chalf * 4 + q + 1;
                    if (x > v0) { v1 = v0; i1 = i0; v0 = x; i0 = xi; } else if (x > v1) { v1 = x; i1 = xi; }
                }
            }
            {
                const float b0 = __shfl_xor(v0, 1), b1 = __shfl_xor(v1, 1); const int k0 = __shfl_xor(i0, 1), k1 = __shfl_xor(i1, 1);
                float n0, n1; int m0, m1;
                if (rt_better(v0, i0, b0, k0)) { n0 = v0; m0 = i0; if (rt_better(v1, i1, b0, k0)) { n1 = v1; m1 = i1; } else { n1 = b0; m1 = k0; } }
                else { n0 = b0; m0 = k0; if (rt_better(b1, k1, v0, i0)) { n1 = b1; m1 = k1; } else { n1 = v0; m1 = i0; } }
                v0 = n0; i0 = m0; v1 = n1; i1 = m1;
            }
            if (kk == 0 && chalf == 0) {
                const float x1 = __expf(v1 - v0), den = 1.0f + x1;
                const int ea = gsel * 8 + i0, eb2 = gsel * 8 + i1;
                toke[rowbase + r] = make_int2(ea, eb2); tokw[rowbase + r] = make_float2(pgroup / den, pgroup * x1 / den);
                atomicAdd(&hist[ea], 1); atomicAdd(&hist[eb2], 1);
            }
            __builtin_amdgcn_wave_barrier();
        }
        __syncthreads();
        if (tid < 64 && !(mode & 1)) histg[c * 64 + tid] = hist[tid];
        __syncthreads();
    }
}

__device__ __forceinline__ void compute_segments(const int* histg, int* seg, int tid) {
    if (tid < 64) {
        int s = 0;
        for (int c = 0; c < 256; ++c) s += histg[c * 64 + tid];
        seg[tid] = s;
    }
    __syncthreads();
    if (tid == 0) {
        int acc = 0;
        for (int e = 0; e < 64; ++e) { seg[64 + e] = acc; acc += (seg[e] + 255) >> 8; }
        seg[128] = acc;
    }
    __syncthreads();
}

__device__ __forceinline__ void phase8(const Params& p, char* smem) {
    const int tid = opaque_tid();
    char* ws = uni(p.ws);
    const int* histg = (const int*)(ws + OFF_HIST);
    const int2* toke = (const int2*)(ws + OFF_TOKE); const float2* tokw = (const float2*)(ws + OFF_TOKW);
    int* slot_tok = (int*)(ws + OFF_SLOTTOK); float* slot_w = (float*)(ws + OFF_SLOTW);
    int* seg = (int*)smem;
    int* cursor = seg + 192;
    compute_segments(histg, seg, tid);
    for (int e = blockIdx.x; e < 64; e += gridDim.x) {
        const int start = seg[64 + e] * 256 + seg[e], end = seg[64 + e + 1] * 256;
        for (int s = start + tid; s < end; s += NTHR) { slot_tok[s] = -1; slot_w[s] = 0.f; }
    }
    for (int c = blockIdx.x; c < 256; c += gridDim.x) {
        __syncthreads();
        if (tid < 64) {
            int base = 0;
            for (int cc = 0; cc < c; ++cc) base += histg[cc * 64 + tid];
            cursor[tid] = seg[64 + tid] * 256 + base;
        }
        __syncthreads();
        if (tid < 256) {
            const int tok = c * 256 + tid;
            const int2 ee = toke[tok]; const float2 ww = tokw[tok];
            const int s0 = atomicAdd(&cursor[ee.x], 1);
            const int s1 = atomicAdd(&cursor[ee.y], 1);
            slot_tok[s0] = tok * 2; slot_w[s0] = ww.x;
            slot_tok[s1] = tok * 2 + 1; slot_w[s1] = ww.y;
        }
    }
}

__device__ __forceinline__ void phase9a(const Params& p, char* smem) {
    const int tid = opaque_tid(), lane = tid & 63, wid = tid >> 6, wr = wid >> 1, wc = wid & 1, fr = lane & 15, fq = lane >> 4;
    char* ws = uni(p.ws);
    int* seg = (int*)(smem + LDS_GEMM);
    compute_segments((const int*)(ws + OFF_HIST), seg, tid);
    const int nrt = seg[128];
    const int* slot_tok = (const int*)(ws + OFF_SLOTTOK);
    const bf16_t* h2b = (const bf16_t*)(ws + OFF_R0);
    bf16_t* hbuf = (bf16_t*)(ws + OFF_R1);
    for (int it = 0;; ++it) {
        int t;
        if (!xcd_item(it, nrt * 4, t)) break;
        const int rtile = t >> 2, nt = t & 3;
        int e = 0;
        for (int k = 1; k < 64; ++k) if (seg[64 + k] <= rtile) e = k;
        GemmSrc s;
        {
            const int r = tid >> 3, lc = (tid & 7) ^ ((r >> 1) & 7);
#pragma unroll
            for (int i = 0; i < 4; ++i) {
                const int tk = slot_tok[rtile * 256 + i * 64 + r];
                const int tok = tk < 0 ? 0 : (tk >> 1);
                s.a[i] = h2b + (size_t)tok * 1024 + lc * 8;
            }
#pragma unroll
            for (int i = 0; i < 2; ++i) s.b[i] = (const bf16_t*)(ws + OFF_WGU) + (size_t)e * 512 * 1024 + (size_t)(nt * 128 + i * 64 + r) * 1024 + lc * 8;
        }
        f32x4 acc[4][4]; zero_acc(acc);
        gemm_loop(acc, s, 16, smem, tid);
        const int row0 = rtile * 256 + wr * 64 + fr;
        const int colb = (nt * 2 + wc) * 32 + fq * 4;
#pragma unroll
        for (int m = 0; m < 4; ++m) {
            const size_t slot = row0 + m * 16;
#pragma unroll
            for (int n = 0; n < 2; ++n) {
                const f32x4 g = acc[m][n], u = acc[m][n + 2];
                f32x4 v;
#pragma unroll
                for (int j = 0; j < 4; ++j) v[j] = g[j] * sigmoidf_(g[j]) * u[j];
                store_bf16x4(hbuf + slot * 256 + colb + n * 16, v);
            }
        }
    }
}

struct Sched9b {
    int G, c, nrt; const int* seg; const char* hbuf; const char* wd;
    __device__ __forceinline__ bool next(int i, pg8::Unit& u) const {
        int rtile, pn;
        if ((G & 7) == 0) { const int x = c & 7, j = c >> 3, nj = G >> 3, per = (nrt + 7) >> 3; const int uidx = i * nj + j; if (uidx >= per * 4) return false; rtile = x * per + (uidx >> 2); pn = uidx & 3; if (rtile >= nrt) return false; }
        else { const int uidx = i * G + c; if (uidx >= nrt * 4) return false; rtile = uidx >> 2; pn = uidx & 3; }
        int e = 0;
        for (int k = 1; k < 64; ++k) if (seg[64 + k] <= rtile) e = k;
        e = __builtin_amdgcn_readfirstlane(e);
        u.pm = rtile; u.pn = pn; u.aux = e; u.A = hbuf; u.Bt = wd + (size_t)e * 1024 * 256 * 2;
        return true;
    }
};
struct Epi9b {
    const int* slot_tok; const float* slot_w; bf16_t* yb;
    __device__ __forceinline__ void operator()(const f32x4 (&acc)[2][2][4][2], const pg8::Unit& u, int wr, int wc, int fr, int fq) const {
        const int row0 = u.pm * 256 + wr * 64 + fr, col0 = u.pn * 256 + wc * 32 + fq * 8;
#pragma unroll
        for (int ai = 0; ai < 2; ++ai)
#pragma unroll
            for (int m = 0; m < 4; ++m) {
                const int slot = row0 + ai * 128 + m * 16;
                const int tk = slot_tok[slot]; const float w = slot_w[slot];
                if (tk >= 0) {
#pragma unroll
                    for (int bj = 0; bj < 2; ++bj) store_bf16x8(yb + (size_t)tk * 1024 + col0 + bj * 128, acc[ai][bj][m][0] * w, acc[ai][bj][m][1] * w);
                }
            }
    }
};
__device__ __forceinline__ void phase9b(const Params& p, char* smem) {
    const int tid = opaque_tid();
    char* ws = uni(p.ws);
    int* seg = (int*)(smem + LDS_GEMM);
    compute_segments((const int*)(ws + OFF_HIST), seg, tid);
    Sched9b S{(int)gridDim.x, (int)blockIdx.x, __builtin_amdgcn_readfirstlane(seg[128]), seg, ws + OFF_R1, ws + OFF_WD};
    Epi9b E{(const int*)(ws + OFF_SLOTTOK), (const float*)(ws + OFF_SLOTW), (bf16_t*)(ws + OFF_YB)};
    pg8::gemm_phase<Epi9b, Sched9b>((LDS_AS unsigned char*)smem, 256, S, E);
}

__device__ __forceinline__ void phase10(const Params& p) {
    const int tid_ = opaque_tid(); const int lane = tid_ & 63, wid = tid_ >> 6;
    const float* h2 = (const float*)(uni(p.ws) + OFF_Z2); const bf16_t* yb = (const bf16_t*)(uni(p.ws) + OFF_YB);
    for (int row = blockIdx.x * 8 + wid; row < T_; row += gridDim.x * 8) {
        float4 v[4];
#pragma unroll
        for (int i = 0; i < 4; ++i) {
            const float4 hh = *(const float4*)(h2 + (size_t)row * 1024 + i * 256 + lane * 4);
            const uint2 a = *(const uint2*)(yb + (size_t)(row * 2) * 1024 + i * 256 + lane * 4), b = *(const uint2*)(yb + (size_t)(row * 2 + 1) * 1024 + i * 256 + lane * 4);
            v[i].x = ALPHA * hh.x + bf_lo(a.x) + bf_lo(b.x); v[i].y = ALPHA * hh.y + bf_hi(a.x) + bf_hi(b.x);
            v[i].z = ALPHA * hh.z + bf_lo(a.y) + bf_lo(b.y); v[i].w = ALPHA * hh.w + bf_hi(a.y) + bf_hi(b.y);
        }
        ln_row(v, uni(p.ln3g), uni(p.ln3b), lane);
#pragma unroll
        for (int i = 0; i < 4; ++i) *(float4*)(uni(p.out) + (size_t)row * 1024 + i * 256 + lane * 4) = v[i];
    }
}

#define XB_TMO      128
#define XB_XCNT(j)  (256  + 64 * (j))
#define XB_XSUB(j)  (1280 + 64 * (j))
#define XB_XGEN(j)  (2304 + 64 * (j))
#define XB_TOP      3328
#define XB_TOPGEN   3392
#define XCD_BAR_WORDS 3456
#define XB_SPIN_CAP (1u << 18)
#define LAS LDS_AS

__device__ __forceinline__ unsigned xb_ld(unsigned* p)              { return __hip_atomic_load(p, __ATOMIC_RELAXED, __HIP_MEMORY_SCOPE_AGENT); }
__device__ __forceinline__ unsigned xb_add(unsigned* p, unsigned v) { return __hip_atomic_fetch_add(p, v, __ATOMIC_RELAXED, __HIP_MEMORY_SCOPE_AGENT); }
__device__ __forceinline__ unsigned xb_xcc_id() { return (unsigned)__builtin_amdgcn_s_getreg((3 << 11) | 20) & 0xFu; }
#define XB_SPIN(cond, bar) do { unsigned _sp = 0; while (cond) { __builtin_amdgcn_s_sleep(1); \
    if ((++_sp & 255u) == 0u) { if (xb_ld(&(bar)[XB_TMO])) break; if (_sp > XB_SPIN_CAP) { atomicAdd(&(bar)[XB_TMO], 1u); break; } } } } while (0)

struct XcdBarrier {
    unsigned* bar; unsigned x;
    volatile LAS unsigned* st;
};

__device__ __forceinline__ XcdBarrier xcd_barrier_post(unsigned* bar, volatile LAS unsigned* st) {
    XcdBarrier b; b.bar = bar; b.x = xb_xcc_id(); b.st = st;
    if (threadIdx.x == 0) (void)xb_add(&bar[XB_XCNT(b.x)], 1u);
    return b;
}
__device__ __forceinline__ void xcd_barrier_complete(unsigned* bar, unsigned x, unsigned& nloc, unsigned& nx) {
    const unsigned G = gridDim.x * gridDim.y * gridDim.z;
    unsigned sum, cnt, mine, sp = 0u;
    for (;;) {
        sum = 0u; cnt = 0u; mine = 0u;
#pragma unroll
        for (unsigned j = 0; j < 16; ++j) { const unsigned c = xb_ld(&bar[XB_XCNT(j)]); sum += c; cnt += (c > 0u) ? 1u : 0u; mine = (j == x) ? c : mine; }
        if (sum == G) break;
        __builtin_amdgcn_s_sleep(1);
        if ((++sp & 255u) == 0u) { if (xb_ld(&bar[XB_TMO])) break; if (sp > XB_SPIN_CAP) { atomicAdd(&bar[XB_TMO], 1u); break; } }
    }
    nloc = mine > 0u ? mine : 1u; nx = cnt > 0u ? cnt : 1u;
}

__device__ __forceinline__ void xcd_barrier(const XcdBarrier& b) {
    asm volatile("s_waitcnt vmcnt(0)" ::: "memory");
    __syncthreads();
    if (threadIdx.x == 0) {
        unsigned* bar = b.bar;
        __builtin_amdgcn_s_waitcnt(0);
        unsigned nloc = b.st[0], nx = b.st[1];
        if (nloc == 0u) { xcd_barrier_complete(bar, b.x, nloc, nx); b.st[0] = nloc; b.st[1] = nx; }
        const unsigned old = xb_add(&bar[XB_XSUB(b.x)], 1u);
        const unsigned gen = old / nloc;
        if (old + 1u == (gen + 1u) * nloc) {
            __builtin_amdgcn_fence(__ATOMIC_RELEASE, "agent");
            asm volatile("s_waitcnt vmcnt(0)" ::: "memory");
            const unsigned og = xb_add(&bar[XB_TOP], 1u);
            const unsigned tg = og / nx;
            if (og + 1u == (tg + 1u) * nx) xb_add(&bar[XB_TOPGEN], 1u);
            else XB_SPIN(xb_ld(&bar[XB_TOPGEN]) == tg, bar);
            __builtin_amdgcn_fence(__ATOMIC_ACQUIRE, "agent");
            xb_add(&bar[XB_XGEN(b.x)], 1u);
            asm volatile("s_waitcnt vmcnt(0)" ::: "memory");
        } else {
            XB_SPIN(xb_ld(&bar[XB_XGEN(b.x)]) == gen, bar);
            __builtin_amdgcn_fence(__ATOMIC_ACQUIRE, "agent");
            asm volatile("s_waitcnt vmcnt(0)" ::: "memory");
        }
    }
    __syncthreads();
}


#ifndef DUP
#define DUP (-1)
#endif
#define RUN(id, call) do { call; if (DUP == (id)) { GRID_SYNC(); call; } } while (0)
__global__ void __launch_bounds__(NTHR) mega(Params pk) {
    extern __shared__ __attribute__((aligned(16))) char smem[];
    cg::grid_group grid = cg::this_grid();
    if (threadIdx.x == 0) *(Params*)(smem + LDS_PARAMS) = pk;
    __syncthreads();
    const Params& p = *(const Params*)(smem + LDS_PARAMS);
    char* ws = uni(p.ws);
    volatile LDS_AS unsigned* xst = (volatile LDS_AS unsigned*)(LDS_AS char*)smem + (LDS_XB / 4);
    if (threadIdx.x < 4) xst[threadIdx.x] = 0u;
    __syncthreads();
    (void)xcd_barrier_post((unsigned*)(ws + OFF_BAR), xst);
#define GRID_SYNC() do { XcdBarrier xb_; xb_.bar = (unsigned*)(uni(p.ws) + OFF_BAR); xb_.x = xb_xcc_id(); xb_.st = (volatile LDS_AS unsigned*)(LDS_AS char*)smem + (LDS_XB / 4); xcd_barrier(xb_); } while (0)
    RUN(0, phase0(p, smem));
    grid.sync();
    RUN(1, phase1(p, smem));
    if (DUP == 30) { GRID_SYNC(); phase1(p, smem, 1); }
    GRID_SYNC();
    RUN(2, phase2a(p, smem));
    if (DUP == 20) { GRID_SYNC(); phase2a(p, smem, 1); }
    if (DUP == 21) { GRID_SYNC(); phase2a(p, smem, 2); }
    GRID_SYNC();
    RUN(12, phase2b(p, smem));
    if (DUP == 22) { GRID_SYNC(); phase2b(p, smem, 1); }
    if (DUP == 23) { GRID_SYNC(); phase2b(p, smem, 2); }
    if (DUP == 24) { GRID_SYNC(); phase2b(p, smem, 1, 4); }
    if (DUP == 25) { GRID_SYNC(); phase2b(p, smem, 1, 5); }
    if (DUP == 26) { GRID_SYNC(); phase2b(p, smem, 1, 13); }
    GRID_SYNC();
    RUN(3, phase3(p, smem));
    GRID_SYNC();
    RUN(4, phase_gemm_bf16(p, smem, (const bf16_t*)(ws + OFF_R1), (const bf16_t*)(ws + OFF_WMIX), (bf16_t*)(ws + OFF_R0), 1.0f));
    GRID_SYNC();
    phase_ln1(p);
    GRID_SYNC();
    RUN(6, phase_gemm_bf16(p, smem, (const bf16_t*)(ws + OFF_R0), (const bf16_t*)(ws + OFF_WXQ), (bf16_t*)(ws + OFF_XQ), 0.0625f));
    GRID_SYNC();
    RUN(7, phase6(p, smem));
    GRID_SYNC();
    RUN(8, phase_gemm_bf16(p, smem, (const bf16_t*)(ws + OFF_O), (const bf16_t*)(ws + OFF_WXO), (bf16_t*)(ws + OFF_XQ), 1.0f));
    GRID_SYNC();
    RUN(13, phase_ln2_router(p, smem));
    if (DUP == 51) { GRID_SYNC(); phase_ln2_router(p, smem, 1); }
    if (DUP == 53) { GRID_SYNC(); phase_ln2_router(p, smem, 3); }
    GRID_SYNC();
    RUN(9, phase8(p, smem));
    GRID_SYNC();
    RUN(10, phase9a(p, smem));
    GRID_SYNC();
    RUN(11, phase9b(p, smem));
    GRID_SYNC();
    RUN(14, phase10(p));
}

extern "C" void kernel_launch(void* const* d_in, const int* in_sizes, int n_in, void* d_out, int out_size,
                              void* d_ws, size_t ws_size, hipStream_t stream) {
    static int grid_blocks = 0;
    if (!grid_blocks) {
        int dev = 0, cus = 0, per_cu = 0;
        (void)hipGetDevice(&dev);
        (void)hipDeviceGetAttribute(&cus, hipDeviceAttributeMultiprocessorCount, dev);
        (void)hipFuncSetAttribute((const void*)mega, hipFuncAttributeMaxDynamicSharedMemorySize, LDS_BYTES);
        (void)hipOccupancyMaxActiveBlocksPerMultiprocessor(&per_cu, mega, NTHR, LDS_BYTES);
        if (per_cu > 1) per_cu = 1;
        grid_blocks = cus * per_cu;
        if (ws_size < WS_NEED) fprintf(stderr, "workspace too small: %zu\n", ws_size);
    }
    Params p{};
    const float* const* f = (const float* const*)d_in;
    p.x = f[0]; p.mem = f[1]; p.pos = (const int*)d_in[2];
    p.w_in = f[3]; p.sinks = f[4]; p.conv_w = f[5]; p.conv_b = f[6]; p.b_ig = f[7]; p.b_fg = f[8]; p.ml_g = f[9];
    p.w_att = f[10]; p.w_ml = f[11]; p.w_mix = f[12]; p.ln1g = f[13]; p.ln1b = f[14];
    p.w_xq = f[15]; p.w_xkv = f[16]; p.w_xo = f[17]; p.ln2g = f[18]; p.ln2b = f[19];
    p.w_rg = f[20]; p.b_rg = f[21]; p.w_re = f[22]; p.b_re = f[23]; p.w_gate = f[24]; p.w_up = f[25]; p.w_down = f[26];
    p.ln3g = f[27]; p.ln3b = f[28];
    p.out = (float*)d_out; p.ws = (char*)d_ws;
    (void)hipMemsetAsync((char*)d_ws + OFF_BAR, 0, XCD_BAR_WORDS * sizeof(unsigned), stream);
    void* args[] = {&p};
    hipError_t e = hipLaunchCooperativeKernel((void*)mega, dim3(grid_blocks), dim3(NTHR), args, LDS_BYTES, stream);
    if (e != hipSuccess) fprintf(stderr, "cooperative launch failed: %s (grid %d)\n", hipGetErrorString(e), grid_blocks);
}
```

```cpp
#include <hip/hip_runtime.h>
#include <hip/hip_cooperative_groups.h>
#include <cstdio>
#include <cstdint>
namespace cg = cooperative_groups;

typedef unsigned short bf16_t;
typedef short bf16x8 __attribute__((ext_vector_type(8)));
typedef float f32x4 __attribute__((ext_vector_type(4)));
typedef unsigned u32x2 __attribute__((ext_vector_type(2)));
typedef unsigned u32x4 __attribute__((ext_vector_type(4)));
#define LDS_AS __attribute__((address_space(3)))
#define GLB_AS __attribute__((address_space(1)))

constexpr int T_ = 65536;
constexpr int NTHR = 512;
constexpr size_t MiB = 1ull << 20;
constexpr float ALPHA = 1.189207115002721f;
constexpr size_t OFF_R0 = 0;
constexpr size_t OFF_R1 = 128 * MiB;
constexpr size_t OFF_AK = 256 * MiB;
constexpr size_t OFF_AV = 272 * MiB;
constexpr size_t OFF_MQK = 288 * MiB;
constexpr size_t OFF_MV = 416 * MiB;
constexpr size_t OFF_MO = 544 * MiB;
constexpr size_t OFF_GG = 672 * MiB;
constexpr size_t OFF_WGU = 288 * MiB;
constexpr size_t OFF_WD = 352 * MiB;
constexpr size_t OFF_XQ = 416 * MiB;
constexpr size_t OFF_O = 544 * MiB;
constexpr size_t OFF_Z2 = 672 * MiB;
constexpr size_t OFF_YB = 416 * MiB;
constexpr size_t OFF_MISC = 928 * MiB;
constexpr size_t OFF_WIN = OFF_MISC;
constexpr size_t OFF_MEMB = OFF_MISC + 13 * MiB;
constexpr size_t OFF_CS = OFF_MISC + 21 * MiB;
constexpr size_t OFF_WXKV = OFF_MISC + 37 * MiB;
constexpr size_t OFF_WATT = OFF_MISC + 41 * MiB;
constexpr size_t OFF_WML = OFF_MISC + 43 * MiB;
constexpr size_t OFF_WMIX = OFF_MISC + 45 * MiB;
constexpr size_t OFF_WXQ = OFF_MISC + 47 * MiB;
constexpr size_t OFF_WXO = OFF_MISC + 49 * MiB;
constexpr size_t OFF_KMAT = OFF_MISC + 51 * MiB;
constexpr size_t OFF_VT = OFF_MISC + 59 * MiB;
constexpr size_t OFF_GATES = OFF_MISC + 67 * MiB;
constexpr size_t OFF_TOKE = OFF_MISC + 69 * MiB;
constexpr size_t OFF_TOKW = OFF_MISC + 70 * MiB;
constexpr size_t OFF_SLOTTOK = OFF_MISC + 71 * MiB;
constexpr size_t OFF_SLOTW = OFF_MISC + 72 * MiB;
constexpr size_t OFF_HIST = OFF_MISC + 73 * MiB;
constexpr size_t OFF_BAR = OFF_MISC + 74 * MiB;
constexpr size_t OFF_SSQP = OFF_MISC + 76 * MiB;
constexpr size_t OFF_SP = OFF_MISC;
constexpr size_t OFF_REC = OFF_MISC + 32 * MiB;
constexpr size_t OUT_QP = 128 * MiB;
constexpr size_t OUT_KP = 192 * MiB;
constexpr size_t WS_NEED = 1024 * MiB;
constexpr int LDS_GEMM = 147456;
constexpr int LDS_PARAMS = 163520;
constexpr int LDS_XB = 163776;
constexpr int LDS_BYTES = 163840;

struct Params {
    const float *x, *mem; const int* pos;
    const float *w_in, *sinks, *conv_w, *conv_b, *b_ig, *b_fg, *ml_g, *w_att, *w_ml, *w_mix, *ln1g, *ln1b;
    const float *w_xq, *w_xkv, *w_xo, *ln2g, *ln2b, *w_rg, *b_rg, *w_re, *b_re, *w_gate, *w_up, *w_down, *ln3g, *ln3b;
    float* out; char* ws;
};

__device__ const double INV_FREQ[32] = {1.0, 0.7498942093324559, 0.5623413251903491, 0.4216965034285822, 0.31622776601683794, 0.23713737056616552, 0.1778279410038923, 0.1333521432163324, 0.1, 0.07498942093324558, 0.05623413251903491, 0.042169650342858224, 0.03162277660168379, 0.023713737056616554, 0.01778279410038923, 0.01333521432163324, 0.01, 0.007498942093324558, 0.005623413251903491, 0.004216965034285823, 0.0031622776601683794, 0.0023713737056616554, 0.0017782794100389228, 0.001333521432163324, 0.001, 0.0007498942093324559, 0.0005623413251903491, 0.00042169650342858224, 0.00031622776601683794, 0.00023713737056616554, 0.00017782794100389227, 0.0001333521432163324};

template <class T> __device__ __forceinline__ T* uni(T* q) {
    const unsigned long long v = (unsigned long long)q;
    const unsigned lo = __builtin_amdgcn_readfirstlane((unsigned)v), hi = __builtin_amdgcn_readfirstlane((unsigned)(v >> 32));
    return (T*)(((unsigned long long)hi << 32) | lo);
}
__device__ __forceinline__ int opaque_tid() { int t = threadIdx.x; asm volatile("" : "+v"(t)); return t; }
__device__ __forceinline__ unsigned pk_bf16(float lo, float hi) { unsigned r; asm("v_cvt_pk_bf16_f32 %0, %1, %2" : "=v"(r) : "v"(lo), "v"(hi)); return r; }
__device__ __forceinline__ float bf_lo(unsigned u) { return __uint_as_float(u << 16); }
__device__ __forceinline__ float bf_hi(unsigned u) { return __uint_as_float(u & 0xffff0000u); }
__device__ __forceinline__ float bf2f(bf16_t h) { return __uint_as_float(((unsigned)h) << 16); }
__device__ __forceinline__ float wsum(float v) {
#pragma unroll
    for (int o = 32; o; o >>= 1) v += __shfl_xor(v, o);
    return v;
}
__device__ __forceinline__ float wmaxf(float v) {
#pragma unroll
    for (int o = 32; o; o >>= 1) v = fmaxf(v, __shfl_xor(v, o));
    return v;
}
__device__ __forceinline__ float sigmoidf_(float x) { return __builtin_amdgcn_rcpf(1.0f + __builtin_amdgcn_exp2f(x * -1.4426950408889634f)); }
__device__ __forceinline__ void glds16(const bf16_t* g, char* l) {
    __builtin_amdgcn_global_load_lds((const GLB_AS void*)g, (LDS_AS void*)l, 16, 0, 0);
}

__device__ __forceinline__ bool xcd_item(int i, int n, int& item) {
    const int G = gridDim.x;
    if ((G & 7) == 0) {
        const int x = blockIdx.x & 7, j = blockIdx.x >> 3, nj = G >> 3;
        const int per = (n + 7) >> 3;
        const int u = i * nj + j;
        if (u >= per) return false;
        item = x * per + u;
        return item < n;
    }
    item = blockIdx.x + i * G;
    return item < n;
}

struct GemmSrc { const bf16_t* a[4]; const bf16_t* b[2]; };

__device__ __forceinline__ void stage_tile(const GemmSrc& s, int koff, char* buf, int tid) {
#pragma unroll
    for (int i = 0; i < 4; ++i) glds16(s.a[i] + koff, buf + (i * 512 + tid) * 16);
#pragma unroll
    for (int i = 0; i < 2; ++i) glds16(s.b[i] + koff, buf + 32768 + (i * 512 + tid) * 16);
}

constexpr int GEMM_STAGE = 49152;
__device__ __forceinline__ void gemm_loop(f32x4 (&acc)[4][4], const GemmSrc& s, int nk, char* smem, int tid) {
    const int lane = tid & 63, wid = tid >> 6, wr = wid >> 1, wc = wid & 1, fr = lane & 15, fq = lane >> 4;
    const int swz = (fr >> 1) & 7;
    const int aoff = (wr * 64 + fr) * 128;
    const int boff = 32768 + (wc * 64 + fr) * 128;
    stage_tile(s, 0, smem, tid);
    if (nk > 1) stage_tile(s, 64, smem + GEMM_STAGE, tid);
    int cur = 0, nxt = 2;
#pragma unroll 1
    for (int t = 0; t < nk; ++t) {
        if (t + 1 < nk) asm volatile("s_waitcnt vmcnt(6)" ::: "memory"); else asm volatile("s_waitcnt vmcnt(0)" ::: "memory");
        __builtin_amdgcn_s_barrier();
        if (t + 2 < nk) stage_tile(s, (t + 2) * 64, smem + nxt * GEMM_STAGE, tid);
        const char* cb = smem + cur * GEMM_STAGE;
#pragma unroll
        for (int ks = 0; ks < 2; ++ks) {
            const int ch = ((ks * 4 + fq) ^ swz) * 16;
            bf16x8 xa[4], wb[4];
#pragma unroll
            for (int m = 0; m < 4; ++m) xa[m] = *(const bf16x8*)(cb + aoff + m * 2048 + ch);
#pragma unroll
            for (int n = 0; n < 4; ++n) wb[n] = *(const bf16x8*)(cb + boff + n * 2048 + ch);
#pragma unroll
            for (int m = 0; m < 4; ++m)
#pragma unroll
                for (int n = 0; n < 4; ++n) acc[m][n] = __builtin_amdgcn_mfma_f32_16x16x32_bf16(wb[n], xa[m], acc[m][n], 0, 0, 0);
        }
        cur = cur == 2 ? 0 : cur + 1; nxt = nxt == 2 ? 0 : nxt + 1;
    }
    __syncthreads();
}

__device__ __forceinline__ void zero_acc(f32x4 (&acc)[4][4]) {
#pragma unroll
    for (int m = 0; m < 4; ++m)
#pragma unroll
        for (int n = 0; n < 4; ++n) acc[m][n] = (f32x4){0.f, 0.f, 0.f, 0.f};
}

__device__ __forceinline__ void make_src(GemmSrc& s, const bf16_t* A, size_t lda, int rowA0, const bf16_t* Bt, size_t ldb, int rowB0, int tid) {
    const int r = tid >> 3, lc = (tid & 7) ^ ((r >> 1) & 7);
#pragma unroll
    for (int i = 0; i < 4; ++i) s.a[i] = A + (size_t)(rowA0 + i * 64 + r) * lda + lc * 8;
#pragma unroll
    for (int i = 0; i < 2; ++i) s.b[i] = Bt + (size_t)(rowB0 + i * 64 + r) * ldb + lc * 8;
}

__device__ __forceinline__ void store_bf16x8(bf16_t* p, f32x4 a, f32x4 b) {
    u32x4 w; w[0] = pk_bf16(a[0], a[1]); w[1] = pk_bf16(a[2], a[3]); w[2] = pk_bf16(b[0], b[1]); w[3] = pk_bf16(b[2], b[3]); *(u32x4*)p = w;
}
__device__ __forceinline__ void store_bf16x4(bf16_t* p, f32x4 v) {
    uint2 w; w.x = pk_bf16(v[0], v[1]); w.y = pk_bf16(v[2], v[3]); *(uint2*)p = w;
}

namespace pg8 {
constexpr int BM = 256, BK = 64, HALF = 128, HTB = HALF * BK * 2;
__device__ __forceinline__ int lds_byte(int r, int c) { const int st = (r >> 4) * 2 + (c >> 5), rr = r & 15, cc = c & 31, ob = rr * 64 + cc * 2; return st * 1024 + (ob ^ (((ob >> 9) & 1) << 5)); }
__device__ __forceinline__ void stage_rc(int b, int& R, int& C) { const int st = b / 1024, sb = b % 1024, swz = sb ^ (((sb >> 9) & 1) << 5); R = (st >> 1) * 16 + swz / 64; C = (st & 1) * 32 + (swz % 64) / 2; }
struct Unit { int pm, pn, aux; const char* A; const char* Bt; };

template <class Epi, class Sched>
__device__ __forceinline__ void gemm_phase(LDS_AS unsigned char* lds, const int K, const Sched& S, const Epi& E, const int stagger_cycles = 0) {
    const int tid = opaque_tid(), wid = __builtin_amdgcn_readfirstlane(tid >> 6), lane = tid & 63, wr = wid >> 2, wc = wid & 3, fr = lane & 15, fq = lane >> 4;
    const int nt = K / BK;
    unsigned voff[2];
#pragma unroll
    for (int i = 0; i < 2; ++i) { int R, C; stage_rc(tid * 16 + i * 8192, R, C); voff[i] = (unsigned)(R * K + C) * 2u; }
    const size_t kstep = (size_t)(BK * 2);
    const size_t hstep = (size_t)HALF * K * 2;
    const size_t tstep = 2 * hstep;
    const unsigned ldsw = (unsigned)wid * 1024u;
    const int aoff = lds_byte(wr * 64 + fr, fq * 8), boff = lds_byte(wc * 32 + fr, fq * 8);
#define PG8_SA(b, h) (((b) * 2 + (h)) * HTB)
#define PG8_SB(b, h) ((4 + (b) * 2 + (h)) * HTB)
#define PG8_STAGE(bufoff, gbase) do { _Pragma("unroll") for (int _i = 0; _i < 2; ++_i) \
        __builtin_amdgcn_global_load_lds((const GLB_AS void*)((const char*)(gbase) + voff[_i]), (LDS_AS void*)(lds + (bufoff) + ldsw + _i * 8192), 16, 0, 0); } while (0)
#define PG8_LDA(dst, b, h) do { _Pragma("unroll") for (int m = 0; m < 4; ++m) _Pragma("unroll") for (int k = 0; k < 2; ++k) dst[m][k] = *(const LDS_AS bf16x8*)(lds + PG8_SA(b, h) + aoff + m * 2048 + k * 1024); } while (0)
#define PG8_LDB(dst, b, h) do { _Pragma("unroll") for (int n = 0; n < 2; ++n) _Pragma("unroll") for (int k = 0; k < 2; ++k) dst[n][k] = *(const LDS_AS bf16x8*)(lds + PG8_SB(b, h) + boff + n * 2048 + k * 1024); } while (0)
#define PG8_MMA(ai, bj, At, Bt) do { __builtin_amdgcn_s_setprio(1); _Pragma("unroll") for (int m = 0; m < 4; ++m) _Pragma("unroll") for (int n = 0; n < 2; ++n) _Pragma("unroll") for (int k = 0; k < 2; ++k) \
        acc[ai][bj][m][n] = __builtin_amdgcn_mfma_f32_16x16x32_bf16(Bt[n][k], At[m][k], acc[ai][bj][m][n], 0, 0, 0); __builtin_amdgcn_s_setprio(0); } while (0)
#define PG8_WAIT_V(n) asm volatile("s_waitcnt vmcnt(" #n ")" ::: "memory")
#define PG8_WAIT_L(n) asm volatile("s_waitcnt lgkmcnt(" #n ")" ::: "memory")
#define PG8_BAR __builtin_amdgcn_s_barrier()
#define PG8_SCHED __builtin_amdgcn_sched_barrier(0)
    Unit cur, nxt; int ui = 0;
    if (!S.next(0, cur)) return;
    if (stagger_cycles > 0) {
        const int lvl = (blockIdx.x >> 3) & 31;
        for (int q = 0; q < lvl * stagger_cycles; ++q) __builtin_amdgcn_s_sleep(15);
    }
    f32x4 acc[2][2][4][2];
#pragma unroll
    for (int a = 0; a < 2; ++a)
#pragma unroll
        for (int b = 0; b < 2; ++b)
#pragma unroll
            for (int m = 0; m < 4; ++m)
#pragma unroll
                for (int n = 0; n < 2; ++n) acc[a][b][m][n] = (f32x4){0.f, 0.f, 0.f, 0.f};
    bf16x8 At[4][2], B0[2][2], B1[2][2];
    const char* cA = cur.A + (size_t)cur.pm * tstep; const char* cB = cur.Bt + (size_t)cur.pn * tstep;
    PG8_STAGE(PG8_SB(0, 0), cB); PG8_STAGE(PG8_SB(0, 1), cB + hstep); PG8_STAGE(PG8_SA(0, 0), cA); PG8_STAGE(PG8_SA(0, 1), cA + hstep);
    if (wr == 1) PG8_BAR;
    PG8_WAIT_V(2); PG8_BAR;
    PG8_STAGE(PG8_SB(1, 0), cB + kstep); PG8_STAGE(PG8_SA(1, 0), cA + kstep); PG8_STAGE(PG8_SB(1, 1), cB + hstep + kstep);
    PG8_WAIT_V(6); PG8_BAR;
    for (;;) {
        const bool has_next = S.next(ui + 1, nxt);
        const char* nA = has_next ? nxt.A + (size_t)nxt.pm * tstep : cA; const char* nB = has_next ? nxt.Bt + (size_t)nxt.pn * tstep : cB;
        for (int t = 0; t < nt; t += 2) {
            const bool last = (t == nt - 2);
            const char* a1 = cA + (size_t)(t + 1) * kstep;
            const char* a2 = last ? nA : cA + (size_t)(t + 2) * kstep; const char* b2 = last ? nB : cB + (size_t)(t + 2) * kstep;
            const char* a3 = a2 + kstep; const char* b3 = b2 + kstep;
            PG8_LDB(B0, 0, 0); PG8_LDB(B1, 0, 1); PG8_SCHED; PG8_LDA(At, 0, 0); PG8_STAGE(PG8_SA(1, 1), a1 + hstep);
            PG8_WAIT_V(8); PG8_WAIT_L(0); PG8_BAR; PG8_MMA(0, 0, At, B0); PG8_MMA(0, 1, At, B1); PG8_BAR; PG8_SCHED;
            PG8_LDA(At, 0, 1); PG8_STAGE(PG8_SB(0, 0), b2); PG8_STAGE(PG8_SB(0, 1), b2 + hstep); PG8_STAGE(PG8_SA(0, 0), a2);
            PG8_WAIT_V(8); PG8_WAIT_L(0); PG8_BAR; PG8_MMA(1, 0, At, B0); PG8_MMA(1, 1, At, B1); PG8_BAR; PG8_SCHED;
            PG8_LDB(B0, 1, 0); PG8_LDB(B1, 1, 1); PG8_SCHED; PG8_LDA(At, 1, 0); PG8_STAGE(PG8_SA(0, 1), a2 + hstep);
            PG8_WAIT_V(8); PG8_WAIT_L(0); PG8_BAR; PG8_MMA(0, 0, At, B0); PG8_MMA(0, 1, At, B1); PG8_BAR; PG8_SCHED;
            PG8_LDA(At, 1, 1); PG8_STAGE(PG8_SB(1, 0), b3); PG8_STAGE(PG8_SB(1, 1), b3 + hstep); PG8_STAGE(PG8_SA(1, 0), a3);
            PG8_WAIT_V(8); PG8_WAIT_L(0); PG8_BAR; PG8_MMA(1, 0, At, B0); PG8_MMA(1, 1, At, B1); PG8_BAR; PG8_SCHED;
        }
        if (wr == 0) PG8_BAR;
        E(acc, cur, wr, wc, fr, fq);
        if (!has_next) break;
        if (!(cur.aux & 0x100)) {
#pragma unroll
        for (int a = 0; a < 2; ++a)
#pragma unroll
            for (int b = 0; b < 2; ++b)
#pragma unroll
                for (int m = 0; m < 4; ++m)
#pragma unroll
                    for (int n = 0; n < 2; ++n) acc[a][b][m][n] = (f32x4){0.f, 0.f, 0.f, 0.f};
        }
        cur = nxt; cA = nA; cB = nB; ++ui;
        if (wr == 1) PG8_BAR;
    }
    PG8_WAIT_V(0);
    PG8_BAR;
#undef PG8_SA
#undef PG8_SB
#undef PG8_STAGE
#undef PG8_LDA
#undef PG8_LDB
#undef PG8_MMA
#undef PG8_WAIT_V
#undef PG8_WAIT_L
#undef PG8_BAR
#undef PG8_SCHED
}
}

__device__ __forceinline__ int perm32(int rho) { const int n = rho >> 4, i = rho & 15; return 8 * (i >> 2) + 4 * n + (i & 3); }
template <bool PERM>
__device__ __forceinline__ void tr_tile_t(const float* src, size_t ld_src, int k0, int c0, bf16_t* dst, size_t ld_dst, int r0, float* tile, int tid) {
    {
        const int r = tid >> 3, c4 = (tid & 7) * 4;
        const float4 v = *(const float4*)(src + (size_t)(k0 + r) * ld_src + c0 + c4);
        float* tp = tile + r * 33 + c4; tp[0] = v.x; tp[1] = v.y; tp[2] = v.z; tp[3] = v.w;
    }
    __syncthreads();
    {
        const int c = tid >> 4, rc = (tid & 15) * 4, sc = PERM ? perm32(c) : c;
        const float a0 = tile[(rc + 0) * 33 + sc], a1 = tile[(rc + 1) * 33 + sc], a2 = tile[(rc + 2) * 33 + sc], a3 = tile[(rc + 3) * 33 + sc];
        uint2 w; w.x = pk_bf16(a0, a1); w.y = pk_bf16(a2, a3);
        *(uint2*)(dst + (size_t)(r0 + c) * ld_dst + k0 + rc) = w;
    }
    __syncthreads();
}
template <bool PERM>
__device__ __forceinline__ void tr_tile4(const float* const (&src)[4], const int (&c0)[4], size_t ld_src, int k0, bf16_t* dst, size_t ld_dst, int r0, float* tile, int tid) {
    {
        const int r = tid >> 3, c4 = (tid & 7) * 4;
        float4 v[4];
#pragma unroll
        for (int g = 0; g < 4; ++g) v[g] = *(const float4*)(src[g] + (size_t)(k0 + r) * ld_src + c0[g] + c4);
#pragma unroll
        for (int g = 0; g < 4; ++g) { float* tp = tile + r * 129 + g * 32 + c4; tp[0] = v[g].x; tp[1] = v[g].y; tp[2] = v[g].z; tp[3] = v[g].w; }
    }
    __syncthreads();
    {
        const int c = tid >> 4, rc = (tid & 15) * 4, sc = PERM ? perm32(c) : c;
#pragma unroll
        for (int g = 0; g < 4; ++g) {
            const float a0 = tile[(rc + 0) * 129 + g * 32 + sc], a1 = tile[(rc + 1) * 129 + g * 32 + sc], a2 = tile[(rc + 2) * 129 + g * 32 + sc], a3 = tile[(rc + 3) * 129 + g * 32 + sc];
            uint2 w; w.x = pk_bf16(a0, a1); w.y = pk_bf16(a2, a3);
            *(uint2*)(dst + (size_t)(r0 + g * 32 + c) * ld_dst + k0 + rc) = w;
        }
    }
    __syncthreads();
}
__device__ __forceinline__ void tr_tile2(const float* srca, int c0a, const float* srcb, int c0b, size_t ld_src, int k0, bf16_t* dst, size_t ld_dst, int r0, float* tile, int tid) {
    {
        const int r = tid >> 3, c4 = (tid & 7) * 4;
        const float* sp = c4 < 16 ? srca + (size_t)(k0 + r) * ld_src + c0a + c4 : srcb + (size_t)(k0 + r) * ld_src + c0b + (c4 - 16);
        const float4 v = *(const float4*)sp;
        float* tp = tile + r * 33 + c4; tp[0] = v.x; tp[1] = v.y; tp[2] = v.z; tp[3] = v.w;
    }
    __syncthreads();
    {
        const int c = tid >> 4, rc = (tid & 15) * 4;
        const float a0 = tile[(rc + 0) * 33 + c], a1 = tile[(rc + 1) * 33 + c], a2 = tile[(rc + 2) * 33 + c], a3 = tile[(rc + 3) * 33 + c];
        uint2 w; w.x = pk_bf16(a0, a1); w.y = pk_bf16(a2, a3);
        *(uint2*)(dst + (size_t)(r0 + c) * ld_dst + k0 + rc) = w;
    }
    __syncthreads();
}

__device__ __forceinline__ void phase0(const Params& p, char* smem, const int parts = 7) {
    const int tid = opaque_tid(), lane = tid & 63, wid = tid >> 6;
    const int gw = blockIdx.x * 8 + wid, nw = gridDim.x * 8;
    char* ws = uni(p.ws);
    bf16_t* xb = (bf16_t*)(ws + OFF_R0);
    if (parts & 1) {
        const float* xg = uni(p.x);
        for (int row = gw * 2; row < T_; row += nw * 2) {
            float4 v[8];
#pragma unroll
            for (int i = 0; i < 8; ++i) v[i] = ((const float4*)(xg + (size_t)(row + (i >> 2)) * 1024))[(i & 3) * 64 + lane];
#pragma unroll
            for (int i = 0; i < 8; ++i) {
                uint2 w; w.x = pk_bf16(v[i].x, v[i].y); w.y = pk_bf16(v[i].z, v[i].w);
                *(uint2*)(xb + (size_t)(row + (i >> 2)) * 1024 + (i & 3) * 256 + lane * 4) = w;
            }
        }
    }
    if (parts & 2) {
        float2* cs = (float2*)(ws + OFF_CS);
        const int gt = blockIdx.x * NTHR + tid, nt = gridDim.x * NTHR;
        for (int idx = gt; idx < T_ * 32; idx += nt) {
            const int tok = idx >> 5, i = idx & 31;
            const double ang = (double)uni(p.pos)[tok] * INV_FREQ[i];
            const double turns = ang * 0.15915494309189535;
            const float f = (float)(turns - rint(turns));
            cs[idx] = make_float2(__builtin_amdgcn_cosf(f), __builtin_amdgcn_sinf(f));
        }
        bf16_t* memb = (bf16_t*)(ws + OFF_MEMB);
        for (int idx = gt; idx < 4096 * 1024 / 4; idx += nt) {
            const float4 v = ((const float4*)uni(p.mem))[idx];
            uint2 w; w.x = pk_bf16(v.x, v.y); w.y = pk_bf16(v.z, v.w);
            ((uint2*)memb)[idx] = w;
        }
    }
    if (parts & 4) {
        float* tile = (float*)smem;
        const int NQ_WIN = 16 * 50, NQ_SQ = 16 * 8, NQ_XKV = 16 * 16;
        const int total = NQ_WIN + 5 * NQ_SQ + NQ_XKV + 16;
        const float* win = uni(p.w_in);
        for (int t = blockIdx.x; t < total; t += gridDim.x) {
            if (t < NQ_WIN) {
                const int kt = t & 15, qd = t >> 4;
                const float* srcs[4] = {win, win, win, win}; int c0[4];
#pragma unroll
                for (int g = 0; g < 4; ++g) {
                    const int n0 = (qd * 4 + g) * 32;
                    if (n0 < 1280) { const int pn = n0 >> 8, bj = (n0 >> 7) & 1, wc = (n0 >> 5) & 3; c0[g] = (4 * pn + wc) * 64 + 32 * bj; }
                    else c0[g] = n0 < 4352 ? n0 : n0 + 8;
                }
                tr_tile4<true>(srcs, c0, 6408, kt * 64, (bf16_t*)(ws + OFF_WIN), 1024, qd * 128, tile, tid);
            } else if (t < NQ_WIN + 5 * NQ_SQ) {
                const int u = t - NQ_WIN, which = u / NQ_SQ, v = u % NQ_SQ, kt = v & 15, qd = v >> 4;
                const float* src = which == 0 ? uni(p.w_att) : which == 1 ? uni(p.w_ml) : which == 2 ? uni(p.w_mix) : which == 3 ? uni(p.w_xq) : uni(p.w_xo);
                const float* srcs[4] = {src, src, src, src}; const int c0[4] = {qd * 128, qd * 128 + 32, qd * 128 + 64, qd * 128 + 96};
                tr_tile4<true>(srcs, c0, 1024, kt * 64, (bf16_t*)(ws + OFF_WATT + (size_t)which * 2 * MiB), 1024, qd * 128, tile, tid);
            } else if (t < NQ_WIN + 5 * NQ_SQ + NQ_XKV) {
                const int v = t - NQ_WIN - 5 * NQ_SQ, kt = v & 15, qd = v >> 4;
                const float* src = uni(p.w_xkv);
                const float* srcs[4] = {src, src, src, src}; const int c0[4] = {qd * 128, qd * 128 + 32, qd * 128 + 64, qd * 128 + 96};
                if (qd < 8) tr_tile4<true>(srcs, c0, 2048, kt * 64, (bf16_t*)(ws + OFF_WXKV), 1024, qd * 128, tile, tid);
                else tr_tile4<false>(srcs, c0, 2048, kt * 64, (bf16_t*)(ws + OFF_WXKV), 1024, qd * 128, tile, tid);
            } else {
                const int kt = t - (NQ_WIN + 5 * NQ_SQ + NQ_XKV);
                tr_tile_t<true>(win, 6408, kt * 64, 4352, (bf16_t*)(ws + OFF_WIN), 1024, 6400, tile, tid);
            }
        }
    }
}

__device__ __forceinline__ void moe_weight_prep(const Params& p, char* smem, int first, int stride) {
    const int tid = opaque_tid();
    float* tile = (float*)smem;
    char* ws = uni(p.ws);
    const int per_e = 96, total = 64 * per_e;
    __syncthreads();
    for (int t = first; t < total; t += stride) {
        const int e = t / per_e, u = t % per_e;
        if (u < 64) {
            const int kt = u & 15, qd = u >> 4;
            const float* gsrc = uni(p.w_gate) + (size_t)e * 1024 * 256; const float* usrc = uni(p.w_up) + (size_t)e * 1024 * 256;
            const float* srcs[4] = {gsrc, usrc, gsrc, usrc}; const int c0[4] = {qd * 64, qd * 64, qd * 64 + 32, qd * 64 + 32};
            tr_tile4<false>(srcs, c0, 256, kt * 64, (bf16_t*)(ws + OFF_WGU) + (size_t)e * 512 * 1024, 1024, qd * 128, tile, tid);
        } else {
            const int v = u - 64, kt = v & 3, qd = v >> 2;
            const float* dsrc = uni(p.w_down) + (size_t)e * 256 * 1024;
            const float* srcs[4] = {dsrc, dsrc, dsrc, dsrc}; const int c0[4] = {qd * 128, qd * 128 + 32, qd * 128 + 64, qd * 128 + 96};
            tr_tile4<true>(srcs, c0, 1024, kt * 64, (bf16_t*)(ws + OFF_WD) + (size_t)e * 1024 * 256, 256, qd * 128, tile, tid);
        }
    }
}

struct SchedP1 {
    int G, c; const char *xb, *win, *memb, *wxkv;
    __device__ __forceinline__ bool next(int i, pg8::Unit& u) const {
        int nmain, uidx;
        if (G == 256) { nmain = 26; const int x = c & 7, j = c >> 3; uidx = i * 32 + j; if (i < 26) { const int g = uidx / 104, v = uidx % 104; u.pm = 32 * x + 4 * g + (v & 3); u.pn = v >> 2; } }
        else { nmain = c < 6656 ? (6656 - 1 - c) / G + 1 : 0; uidx = i * G + c; if (i < nmain) { u.pm = uidx / 26; u.pn = uidx % 26; } }
        if (i < nmain) { u.aux = 0; u.A = xb; u.Bt = win; return true; }
        const int kv = c + (i - nmain) * G;
        if (kv >= 128) return false;
        if (kv < 64) { u.aux = 1; u.pm = kv >> 2; u.pn = kv & 3; u.A = memb; u.Bt = wxkv; }
        else { const int k2 = kv - 64; u.aux = 2; u.pm = k2 >> 4; u.pn = k2 & 15; u.A = wxkv + (size_t)1024 * 1024 * 2; u.Bt = memb; }
        return true;
    }
};

struct EpiP1 {
    char* ws; int skip;
    __device__ __forceinline__ void operator()(f32x4 (&acc)[2][2][4][2], const pg8::Unit& u, int wr, int wc, int fr, int fq) const {
        if (skip == 1) {
#pragma unroll
            for (int a = 0; a < 2; ++a)
#pragma unroll
                for (int b = 0; b < 2; ++b)
#pragma unroll
                    for (int m = 0; m < 4; ++m) { asm volatile("" :: "v"(acc[a][b][m][0]), "v"(acc[a][b][m][1])); }
            return;
        }
        const int row0 = u.pm * 256 + wr * 64 + fr;
        if (u.aux == 0 && u.pn < 5) {
            const int hidx = 4 * u.pn + wc;
            if (hidx < 18) {
                bf16_t* dst; int ld, cb; float sc;
                if (hidx < 16) { dst = (bf16_t*)(ws + OFF_R1); ld = 1024; cb = hidx * 64; sc = 0.125f; }
                else { dst = (bf16_t*)(ws + OFF_AK); ld = 128; cb = (hidx - 16) * 64; sc = 1.0f; }
                const float* cs = (const float*)(ws + OFF_CS);
                const int d1 = 8 * fq;
#pragma unroll
                for (int ai = 0; ai < 2; ++ai)
#pragma unroll
                    for (int m = 0; m < 4; ++m) {
                        const int tok = row0 + ai * 128 + m * 16;
                        const float4* cp = (const float4*)(cs + (size_t)tok * 64 + d1 * 2);
                        const float4 c0 = cp[0], c1 = cp[1], c2 = cp[2], c3 = cp[3];
                        const f32x4 x1a = acc[ai][0][m][0], x1b = acc[ai][0][m][1], x2a = acc[ai][1][m][0], x2b = acc[ai][1][m][1];
                        f32x4 o1a, o1b, o2a, o2b;
                        o1a[0] = (x1a[0] * c0.x - x2a[0] * c0.y) * sc; o2a[0] = (x2a[0] * c0.x + x1a[0] * c0.y) * sc;
                        o1a[1] = (x1a[1] * c0.z - x2a[1] * c0.w) * sc; o2a[1] = (x2a[1] * c0.z + x1a[1] * c0.w) * sc;
                        o1a[2] = (x1a[2] * c1.x - x2a[2] * c1.y) * sc; o2a[2] = (x2a[2] * c1.x + x1a[2] * c1.y) * sc;
                        o1a[3] = (x1a[3] * c1.z - x2a[3] * c1.w) * sc; o2a[3] = (x2a[3] * c1.z + x1a[3] * c1.w) * sc;
                        o1b[0] = (x1b[0] * c2.x - x2b[0] * c2.y) * sc; o2b[0] = (x2b[0] * c2.x + x1b[0] * c2.y) * sc;
                        o1b[1] = (x1b[1] * c2.z - x2b[1] * c2.w) * sc; o2b[1] = (x2b[1] * c2.z + x1b[1] * c2.w) * sc;
                        o1b[2] = (x1b[2] * c3.x - x2b[2] * c3.y) * sc; o2b[2] = (x2b[2] * c3.x + x1b[2] * c3.y) * sc;
                        o1b[3] = (x1b[3] * c3.z - x2b[3] * c3.w) * sc; o2b[3] = (x2b[3] * c3.z + x1b[3] * c3.w) * sc;
                        bf16_t* rp = dst + (size_t)tok * ld + cb + d1;
                        if (skip == 2) { asm volatile("" :: "v"(o1a), "v"(o1b), "v"(o2a), "v"(o2b)); } else { store_bf16x8(rp, o1a, o1b); store_bf16x8(rp + 32, o2a, o2b); }
                    }
            } else {
                bf16_t* avT = (bf16_t*)(ws + OFF_AV);
#pragma unroll
                for (int bj = 0; bj < 2; ++bj)
#pragma unroll
                    for (int ai = 0; ai < 2; ++ai)
#pragma unroll
                        for (int m = 0; m < 4; ++m)
#pragma unroll
                            for (int n = 0; n < 2; ++n)
#pragma unroll
                                for (int j = 0; j < 4; ++j)
                                    avT[(size_t)((hidx - 18) * 64 + 32 * bj + 8 * fq + 4 * n + j) * T_ + row0 + ai * 128 + m * 16] = (bf16_t)(pk_bf16(acc[ai][bj][m][n][j], acc[ai][bj][m][n][j]) & 0xffffu);
            }
            return;
        }
#pragma unroll
        for (int bj = 0; bj < 2; ++bj) {
            const int c32 = u.pn * 256 + bj * 128 + wc * 32;
            if (u.aux == 0 && c32 >= 6400) {
                if (c32 == 6400 && fq == 0) {
                    float* gates = (float*)(ws + OFF_GATES);
#pragma unroll
                    for (int ai = 0; ai < 2; ++ai)
#pragma unroll
                        for (int m = 0; m < 4; ++m) {
                            const f32x4 v0 = acc[ai][bj][m][0], v1 = acc[ai][bj][m][1];
                            float4* gp = (float4*)(gates + (size_t)(row0 + ai * 128 + m * 16) * 8);
                            gp[0] = make_float4(v0[0], v0[1], v0[2], v0[3]); gp[1] = make_float4(v1[0], v1[1], v1[2], v1[3]);
                        }
                }
            } else if (u.aux == 2) {
                bf16_t* dst = (bf16_t*)(ws + OFF_VT);
#pragma unroll
                for (int ai = 0; ai < 2; ++ai)
#pragma unroll
                    for (int m = 0; m < 4; ++m) {
                        bf16_t* rp = dst + (size_t)(row0 + ai * 128 + m * 16) * 4096 + c32 + fq * 4;
                        store_bf16x4(rp, acc[ai][bj][m][0]); store_bf16x4(rp + 16, acc[ai][bj][m][1]);
                    }
            } else {
                bf16_t* dst; int ld, cb; bool sig = false;
                if (u.aux == 1) { dst = (bf16_t*)(ws + OFF_KMAT); ld = 1024; cb = c32; }
                else if (c32 < 2304) { dst = (bf16_t*)(ws + OFF_MQK); ld = 1024; cb = c32 - 1280; }
                else if (c32 < 3328) { dst = (bf16_t*)(ws + OFF_MV); ld = 1024; cb = c32 - 2304; }
                else if (c32 < 4352) { dst = (bf16_t*)(ws + OFF_MO); ld = 1024; cb = c32 - 3328; sig = true; }
                else { dst = (bf16_t*)(ws + OFF_GG); ld = 2048; cb = c32 - 4352; sig = true; }
#pragma unroll
                for (int ai = 0; ai < 2; ++ai)
#pragma unroll
                    for (int m = 0; m < 4; ++m) {
                        f32x4 v0 = acc[ai][bj][m][0], v1 = acc[ai][bj][m][1];
                        if (sig) {
                            v0[0] = sigmoidf_(v0[0]); v0[1] = sigmoidf_(v0[1]); v0[2] = sigmoidf_(v0[2]); v0[3] = sigmoidf_(v0[3]);
                            v1[0] = sigmoidf_(v1[0]); v1[1] = sigmoidf_(v1[1]); v1[2] = sigmoidf_(v1[2]); v1[3] = sigmoidf_(v1[3]);
                        }
                        if (skip == 2) { asm volatile("" :: "v"(v0), "v"(v1)); } else store_bf16x8(dst + (size_t)(row0 + ai * 128 + m * 16) * ld + cb + fq * 8, v0, v1);
                    }
            }
        }
    }
};

__device__ __forceinline__ void phase1(const Params& p, char* smem, int skip_epi = 0) {
    char* ws = uni(p.ws);
    SchedP1 S{(int)gridDim.x, (int)blockIdx.x, ws + OFF_R0, ws + OFF_WIN, ws + OFF_MEMB, ws + OFF_WXKV};
    EpiP1 E{ws, skip_epi};
    pg8::gemm_phase<EpiP1, SchedP1>((LDS_AS unsigned char*)smem, 1024, S, E, 0);
}

template <int NPASS>
struct SchedN1024 {
    int G, c; const char* A0; const char* B0; const char* A1; const char* B1;
    __device__ __forceinline__ bool next(int i, pg8::Unit& u) const {
        const int ti = i / NPASS, pass = i % NPASS;
        int uidx;
        if (G == 256) { if (ti >= 4) return false; const int x = c & 7, j = c >> 3; uidx = ti * 32 + j; u.pm = 32 * x + (uidx >> 2); u.pn = uidx & 3; }
        else { uidx = ti * G + c; if (uidx >= 1024) return false; u.pm = uidx >> 2; u.pn = uidx & 3; }
        u.aux = pass | ((NPASS == 2 && pass == 0) ? 0x100 : 0); u.A = pass ? A1 : A0; u.Bt = pass ? B1 : B0;
        return true;
    }
};

typedef short v4i16_t __attribute__((ext_vector_type(4)));
__device__ __forceinline__ int offQK(int row, int ch) { return row * 256 + ((ch ^ (((row & 3) << 2) | ((row >> 2) & 3))) << 4); }
__device__ __forceinline__ int offV(int row, int ch) { return row * 512 + ((ch ^ (((row & 3) | (((row >> 3) & 1) << 2)) << 1)) << 4); }
__device__ __forceinline__ int offSw(int row, int ch) { return row * 128 + ((ch ^ ((row >> 1) & 7)) << 4); }
__device__ __forceinline__ bf16x8 tr_read2(const char* p0, const char* p1) {
    const v4i16_t a = __builtin_amdgcn_ds_read_tr16_b64_v4i16((LDS_AS v4i16_t*)p0);
    const v4i16_t b = __builtin_amdgcn_ds_read_tr16_b64_v4i16((LDS_AS v4i16_t*)p1);
    return __builtin_shufflevector(a, b, 0, 1, 2, 3, 4, 5, 6, 7);
}
__device__ __forceinline__ float row16_sum(float v) {
    v += __builtin_bit_cast(float, __builtin_amdgcn_update_dpp(0, __builtin_bit_cast(int, v), 0xB1, 0xf, 0xf, true));
    v += __builtin_bit_cast(float, __builtin_amdgcn_update_dpp(0, __builtin_bit_cast(int, v), 0x4E, 0xf, 0xf, true));
    v += __builtin_bit_cast(float, __builtin_amdgcn_update_dpp(0, __builtin_bit_cast(int, v), 0x141, 0xf, 0xf, true));
    v += __builtin_bit_cast(float, __builtin_amdgcn_update_dpp(0, __builtin_bit_cast(int, v), 0x140, 0xf, 0xf, true));
    return v;
}

constexpr int PP_Q = 0, PP_K = 16384, PP_S = 32768, PP_REC = 40960, PP_EB = 41984, PP_EK = 42240, PP_CSP = 42496  , PP_RSP = 44544  , PP_END = 45056;
__device__ __forceinline__ void ml_prepass_item(const Params& p, char* smem, int item) {
    const int tid = opaque_tid(), lane = tid & 63, wid = tid >> 6, fr = lane & 15, fq = lane >> 4;
    const int c = item & 63, bh = item >> 6, b = bh >> 2, h = bh & 3;
    char* ws = uni(p.ws);
    const bf16_t* mqk = (const bf16_t*)(ws + OFF_MQK);
    const float* gates = (const float*)(ws + OFF_GATES);
    float* rec = (float*)(smem + PP_REC); float* eb = (float*)(smem + PP_EB); float* ek = (float*)(smem + PP_EK);
    float* csp = (float*)(smem + PP_CSP); float* rsp = (float*)(smem + PP_RSP);
    const long tok0 = (long)b * 4096 + c * 64;
    const int cp = tid & 127, tg = tid >> 7;
    const bool isk = cp >= 64;
    const int dch = isk ? 2 * (cp - 64) : 2 * cp;
    const int ccol = isk ? (512 + h * 128 + dch) : (h * 128 + dch);
    unsigned r[19];
#pragma unroll
    for (int i = 0; i < 19; ++i) {
        const int tl = tg * 16 - 3 + i;
        r[i] = (c == 0 && tl < 0) ? 0u : *(const unsigned*)(mqk + (tok0 + tl) * 1024 + ccol);
    }
    float cw0[4], cw1[4];
#pragma unroll
    for (int j = 0; j < 4; ++j) { cw0[j] = uni(p.conv_w)[j * 1024 + ccol]; cw1[j] = uni(p.conv_w)[j * 1024 + ccol + 1]; }
    const float cb0 = uni(p.conv_b)[ccol], cb1 = uni(p.conv_b)[ccol + 1];
    if (wid == 0) {
        const float mi0 = gates[(tok0 + lane) * 8 + h] + uni(p.b_ig)[h], x = gates[(tok0 + lane) * 8 + 4 + h] + uni(p.b_fg)[h];
        float bs = fminf(x, 0.f) - log1pf(__expf(-fabsf(x)));
#pragma unroll
        for (int o = 1; o < 64; o <<= 1) { const float y = __shfl_up(bs, o); if (lane >= o) bs += y; }
        eb[lane] = __expf(bs); ek[lane] = __expf(mi0 - bs);
        if (lane == 63) rec[192] = __expf(bs);
    }
    __syncthreads();
    {
        const int tt0 = tg * 16;
        float cs0 = 0.f, cs1 = 0.f;
        const float* scp = (isk ? ek : eb) + tt0;
        char* dstb = smem + (isk ? PP_K : PP_Q) + (dch & 7) * 2;
        const float kmul = isk ? 0.08838834764831845f : 1.0f;
#pragma unroll
        for (int tt = 0; tt < 16; ++tt) {
            float v0 = cb0 + cw0[0] * bf_lo(r[tt]) + cw0[1] * bf_lo(r[tt + 1]) + cw0[2] * bf_lo(r[tt + 2]) + cw0[3] * bf_lo(r[tt + 3]);
            float v1 = cb1 + cw1[0] * bf_hi(r[tt]) + cw1[1] * bf_hi(r[tt + 1]) + cw1[2] * bf_hi(r[tt + 2]) + cw1[3] * bf_hi(r[tt + 3]);
            v0 = v0 * sigmoidf_(v0); v1 = v1 * sigmoidf_(v1);
            const float sc = scp[tt] * kmul;
            const float a0 = v0 * sc, a1 = v1 * sc;
            *(unsigned*)(dstb + offQK(tt0 + tt, dch >> 3)) = pk_bf16(a0, a1);
            cs0 += a0; cs1 += a1;
        }
        if (isk) { csp[tg * 128 + dch] = cs0; csp[tg * 128 + dch + 1] = cs1; }
    }
    __syncthreads();
    {
        const int tt = wid >> 1;
        bf16x8 qf[4];
#pragma unroll
        for (int ks = 0; ks < 4; ++ks) qf[ks] = *(const bf16x8*)(smem + PP_Q + offQK(tt * 16 + fr, 4 * ks + fq));
        float rs = 0.f;
#pragma unroll
        for (int x = 0; x < 2; ++x) {
            const int st = (wid & 1) * 2 + x;
            f32x4 a = (f32x4){0.f, 0.f, 0.f, 0.f};
#pragma unroll
            for (int ks = 0; ks < 4; ++ks) {
                const bf16x8 kf = *(const bf16x8*)(smem + PP_K + offQK(st * 16 + fr, 4 * ks + fq));
                a = __builtin_amdgcn_mfma_f32_16x16x32_bf16(kf, qf[ks], a, 0, 0, 0);
            }
#pragma unroll
            for (int j = 0; j < 4; ++j) a[j] = (st * 16 + fq * 4 + j) <= (tt * 16 + fr) ? a[j] : 0.f;
            rs += (a[0] + a[1]) + (a[2] + a[3]);
            uint2 w; w.x = pk_bf16(a[0], a[1]); w.y = pk_bf16(a[2], a[3]);
            *(uint2*)(smem + PP_S + offSw(tt * 16 + fr, st * 2 + (fq >> 1)) + (fq & 1) * 8) = w;
        }
        rs += __shfl_xor(rs, 16); rs += __shfl_xor(rs, 32);
        if (fq == 0) rsp[(wid & 1) * 64 + tt * 16 + fr] = rs;
        if (tid < 128) rec[64 + tid] = (csp[tid] + csp[128 + tid]) + (csp[256 + tid] + csp[384 + tid]);
    }
    __syncthreads();
    if (tid < 64) rec[tid] = rsp[tid] + rsp[64 + tid];
    __syncthreads();
    {
        char* qp = (char*)uni(p.out) + OUT_QP + (size_t)item * 16384;
        char* kp = (char*)uni(p.out) + OUT_KP + (size_t)item * 16384;
        char* sp = ws + OFF_SP + (size_t)item * 8192;
        char* rp = ws + OFF_REC + (size_t)item * 1024;
#pragma unroll
        for (int i = 0; i < 2; ++i) {
            *(u32x4*)(qp + (i * 512 + tid) * 16) = *(const u32x4*)(smem + PP_Q + (i * 512 + tid) * 16);
            *(u32x4*)(kp + (i * 512 + tid) * 16) = *(const u32x4*)(smem + PP_K + (i * 512 + tid) * 16);
        }
        *(u32x4*)(sp + tid * 16) = *(const u32x4*)(smem + PP_S + tid * 16);
        if (tid < 64) *(u32x4*)(rp + tid * 16) = *(const u32x4*)(smem + PP_REC + tid * 16);
    }
    __syncthreads();
}

constexpr int SC_BUF = 41984;
constexpr int SC_V = 2 * SC_BUF;
constexpr int SC_NBF = SC_V + 65536;
constexpr int SC_END = SC_NBF + 512;
__device__ __forceinline__ void ml_scan(const Params& p, char* smem, int bh, const int mode = 0) {
    const int tid = opaque_tid(), lane = tid & 63, wid = tid >> 6, fr0 = lane & 15, fq0 = lane >> 4;
    const int b = bh >> 2, h = bh & 3;
    char* ws = uni(p.ws);
    const bf16_t* mv = (const bf16_t*)(ws + OFF_MV);
    bf16_t* hm = (bf16_t*)uni(p.out);
    float* ssqp = (float*)(ws + OFF_SSQP);
    const long tokb = (long)b * 4096;
    f32x4 C[8][2];
#pragma unroll
    for (int dt = 0; dt < 8; ++dt) { C[dt][0] = (f32x4){0.f, 0.f, 0.f, 0.f}; C[dt][1] = (f32x4){0.f, 0.f, 0.f, 0.f}; }
    const int vrl = tid >> 5, vpc = tid & 31, vlc = vpc ^ ((((vrl & 3) | (((vrl >> 3) & 1) << 2))) << 1);
    const bf16_t* vsrc = mv + (tokb + vrl) * 1024 + h * 256 + vlc * 8;
    const char* qp = (const char*)uni(p.out) + OUT_QP + (size_t)bh * 64 * 16384;
    const char* kp = (const char*)uni(p.out) + OUT_KP + (size_t)bh * 64 * 16384;
    const char* sp = ws + OFF_SP + (size_t)bh * 64 * 8192;
    const char* rp = ws + OFF_REC + (size_t)bh * 64 * 1024;
#define SC_STAGE(cc, bufoff) do { \
        _Pragma("unroll") for (int _i = 0; _i < 2; ++_i) { \
            glds16((const bf16_t*)(qp + (size_t)(cc) * 16384 + (_i * 512 + tid) * 16), smem + (bufoff) + (_i * 512 + tid) * 16); \
            glds16((const bf16_t*)(kp + (size_t)(cc) * 16384 + (_i * 512 + tid) * 16), smem + (bufoff) + 16384 + (_i * 512 + tid) * 16); } \
        glds16((const bf16_t*)(sp + (size_t)(cc) * 8192 + tid * 16), smem + (bufoff) + 32768 + tid * 16); \
        if (tid < 64) glds16((const bf16_t*)(rp + (size_t)(cc) * 1024 + tid * 16), smem + (bufoff) + 40960 + tid * 16); \
        _Pragma("unroll") for (int _i = 0; _i < 4; ++_i) glds16(vsrc + (long)(cc) * 64 * 1024 + (long)_i * 16 * 1024, smem + SC_V + ((cc) & 1) * 32768 + (_i * 512 + tid) * 16); } while (0)
    __syncthreads();
    if (tid < 256) ((bf16_t*)(smem + SC_NBF))[tid] = 0;
    float nreg = 0.f;
    SC_STAGE(0, 0);
    asm volatile("s_waitcnt vmcnt(0)" ::: "memory");
#pragma unroll 1
    for (int c = 0; c < 64; ++c) {
        const int par = c & 1;
        const long tok0 = tokb + c * 64;
        int fr = fr0, fq = fq0;
        asm volatile("" : "+v"(fr), "+v"(fq));
        const char* buf = smem + par * SC_BUF;
        asm volatile("s_waitcnt vmcnt(10) lgkmcnt(0)" ::: "memory");
        __builtin_amdgcn_s_barrier();
        if (c + 1 < 64 && !(mode & 1)) SC_STAGE(c + 1, (par ^ 1) * SC_BUF);
        f32x4 Y[4][2], DN[4];
#pragma unroll
        for (int tt = 0; tt < 4; ++tt) { Y[tt][0] = (f32x4){0.f, 0.f, 0.f, 0.f}; Y[tt][1] = (f32x4){0.f, 0.f, 0.f, 0.f}; DN[tt] = (f32x4){0.f, 0.f, 0.f, 0.f}; }
        const char* nbf = smem + SC_NBF + par * 256;
#pragma unroll
        for (int ks = 0; ks < 4; ++ks) {
            u32x4 c0, c1;
            c0[0] = pk_bf16(C[2 * ks][0][0], C[2 * ks][0][1]); c0[1] = pk_bf16(C[2 * ks][0][2], C[2 * ks][0][3]);
            c0[2] = pk_bf16(C[2 * ks + 1][0][0], C[2 * ks + 1][0][1]); c0[3] = pk_bf16(C[2 * ks + 1][0][2], C[2 * ks + 1][0][3]);
            c1[0] = pk_bf16(C[2 * ks][1][0], C[2 * ks][1][1]); c1[1] = pk_bf16(C[2 * ks][1][2], C[2 * ks][1][3]);
            c1[2] = pk_bf16(C[2 * ks + 1][1][0], C[2 * ks + 1][1][1]); c1[3] = pk_bf16(C[2 * ks + 1][1][2], C[2 * ks + 1][1][3]);
            const bf16x8 cf0 = __builtin_bit_cast(bf16x8, c0), cf1 = __builtin_bit_cast(bf16x8, c1);
            const u32x2 nlo = *(const u32x2*)(nbf + (32 * ks + 4 * fq) * 2), nhi = *(const u32x2*)(nbf + (32 * ks + 16 + 4 * fq) * 2);
            u32x4 nv; nv[0] = nlo[0]; nv[1] = nlo[1]; nv[2] = nhi[0]; nv[3] = nhi[1];
            const bf16x8 nb = __builtin_bit_cast(bf16x8, nv);
#pragma unroll
            for (int tt = 0; tt < 4; ++tt) {
                const int row = tt * 16 + fr;
                const u32x2 lo = *(const u32x2*)(buf + offQK(row, 4 * ks + (fq >> 1)) + (fq & 1) * 8);
                const u32x2 hi = *(const u32x2*)(buf + offQK(row, 4 * ks + 2 + (fq >> 1)) + (fq & 1) * 8);
                u32x4 av; av[0] = lo[0]; av[1] = lo[1]; av[2] = hi[0]; av[3] = hi[1];
                const bf16x8 af = __builtin_bit_cast(bf16x8, av);
                Y[tt][0] = __builtin_amdgcn_mfma_f32_16x16x32_bf16(af, cf0, Y[tt][0], 0, 0, 0);
                Y[tt][1] = __builtin_amdgcn_mfma_f32_16x16x32_bf16(af, cf1, Y[tt][1], 0, 0, 0);
                DN[tt] = __builtin_amdgcn_mfma_f32_16x16x32_bf16(af, nb, DN[tt], 0, 0, 0);
            }
        }
        const char* vb = smem + SC_V + par * 32768;
        bf16x8 vf[2][2];
#pragma unroll
        for (int ks = 0; ks < 2; ++ks)
#pragma unroll
            for (int et = 0; et < 2; ++et) {
                const int cidx = 2 * wid + et, ch = 2 * cidx + ((fr & 3) >> 1);
                const int r0 = 32 * ks + 8 * fq + (fr >> 2);
                vf[ks][et] = tr_read2(vb + offV(r0, ch) + 8 * (fr & 1), vb + offV(r0 + 4, ch) + 8 * (fr & 1));
            }
#pragma unroll
        for (int ks = 0; ks < 2; ++ks)
#pragma unroll
            for (int tt = 0; tt < 4; ++tt) {
                const bf16x8 sf = *(const bf16x8*)(buf + 32768 + offSw(tt * 16 + fr, 4 * ks + fq));
                Y[tt][0] = __builtin_amdgcn_mfma_f32_16x16x32_bf16(sf, vf[ks][0], Y[tt][0], 0, 0, 0);
                Y[tt][1] = __builtin_amdgcn_mfma_f32_16x16x32_bf16(sf, vf[ks][1], Y[tt][1], 0, 0, 0);
            }
        const float* recf = (const float*)(buf + 40960);
        float* sq_out = ssqp + ((size_t)(bh * 64 + c) * 8 + wid) * 64;
#pragma unroll
        for (int tt = 0; tt < 4; ++tt) {
            const float4 rsv = *(const float4*)(recf + tt * 16 + fq * 4);
            const float dd[4] = {rsv.x + DN[tt][0], rsv.y + DN[tt][1], rsv.z + DN[tt][2], rsv.w + DN[tt][3]};
            float sq[4];
#pragma unroll
            for (int j = 0; j < 4; ++j) {
                const float inv = __builtin_amdgcn_rcpf(fmaxf(fabsf(dd[j]), 1.0f));
                Y[tt][0][j] *= inv; Y[tt][1][j] *= inv;
                sq[j] = row16_sum(Y[tt][0][j] * Y[tt][0][j] + Y[tt][1][j] * Y[tt][1][j]);
            }
            if (!(mode & 4)) {
                if (fr == 0) *(float4*)(sq_out + tt * 16 + fq * 4) = make_float4(sq[0], sq[1], sq[2], sq[3]);
#pragma unroll
                for (int et = 0; et < 2; ++et) {
                    const int e = wid * 32 + et * 16 + fr;
                    store_bf16x4(hm + (tok0 + (e >> 2)) * 1024 + h * 256 + (e & 3) * 64 + tt * 16 + fq * 4, Y[tt][et]);
                }
            } else asm volatile("" :: "v"(Y[tt][0]), "v"(Y[tt][1]), "v"(sq[0]), "v"(sq[1]), "v"(sq[2]), "v"(sq[3]));
        }
#pragma unroll
        for (int dt = 0; dt < 8; ++dt)
#pragma unroll
            for (int ks = 0; ks < 2; ++ks) {
                const int ch = 2 * dt + ((fr & 3) >> 1);
                const int r0 = 32 * ks + 8 * fq + (fr >> 2);
                const bf16x8 kf = tr_read2(buf + 16384 + offQK(r0, ch) + 8 * (fr & 1), buf + 16384 + offQK(r0 + 4, ch) + 8 * (fr & 1));
                C[dt][0] = __builtin_amdgcn_mfma_f32_16x16x32_bf16(kf, vf[ks][0], C[dt][0], 0, 0, 0);
                C[dt][1] = __builtin_amdgcn_mfma_f32_16x16x32_bf16(kf, vf[ks][1], C[dt][1], 0, 0, 0);
                if (ks == 1 && (dt & 1)) __builtin_amdgcn_sched_barrier(0);
            }
        const float g = recf[192];
#pragma unroll
        for (int dt = 0; dt < 8; ++dt) { C[dt][0] *= g; C[dt][1] *= g; }
        if (tid < 128) {
            nreg = g * (nreg + recf[64 + (tid & 127)]);
            ((bf16_t*)(smem + SC_NBF + (par ^ 1) * 256))[tid] = (bf16_t)(pk_bf16(nreg, nreg) & 0xffffu);
        }
    }
    asm volatile("s_waitcnt vmcnt(0) lgkmcnt(0)" ::: "memory");
    __syncthreads();
#undef SC_STAGE
}

__device__ __forceinline__ void ml_finish_item(const Params& p, char* smem, int item) {
    const int tid = opaque_tid(), lane = tid & 63, wid = tid >> 6;
    const int c = item & 63, bh = item >> 6, b = bh >> 2, h = bh & 3;
    char* ws = uni(p.ws);
    bf16_t* hm = (bf16_t*)uni(p.out);
    const bf16_t* mo = (const bf16_t*)(ws + OFF_MO);
    const float* ssqp = (const float*)(ws + OFF_SSQP) + (size_t)item * 512;
    const float* gain = uni(p.ml_g) + h * 256;
    const long tok0 = (long)b * 4096 + c * 64;
    float* rs = (float*)(smem + 32768);
#pragma unroll
    for (int i = 0; i < 4; ++i) {
        const int q = i * 512 + tid;
        glds16(hm + (tok0 + (q >> 5)) * 1024 + h * 256 + (q & 31) * 8, smem + q * 16);
    }
    if (tid < 64) {
        float sacc = 0.f;
#pragma unroll
        for (int w = 0; w < 8; ++w) sacc += ssqp[w * 64 + tid];
        rs[tid] = rsqrtf(sacc * (1.0f / 256.0f) + 1e-6f);
    }
    asm volatile("s_waitcnt vmcnt(0)" ::: "memory");
    __syncthreads();
    const int i16 = lane & 15, g4 = lane >> 4, q4 = i16 >> 2, p4 = i16 & 3;
#pragma unroll
    for (int it = 0; it < 4; ++it) {
        const int combo = wid * 4 + it, tb = combo & 3, eoct = (combo >> 2) * 4 + g4;
        const int t = tb * 16 + i16, e = eoct * 8;
        const char* a0 = smem + (e + q4) * 128 + (tb * 16 + 4 * p4) * 2;
        const bf16x8 hv = tr_read2(a0, a0 + 4 * 128);
        const u32x4 hw = __builtin_bit_cast(u32x4, hv);
        const u32x4 mw = *(const u32x4*)(mo + (tok0 + t) * 1024 + h * 256 + e);
        const float4 ga = *(const float4*)(gain + e), gb = *(const float4*)(gain + e + 4);
        const float r = rs[t];
        u32x4 o;
        o[0] = pk_bf16(bf_lo(hw[0]) * r * ga.x * bf_lo(mw[0]), bf_hi(hw[0]) * r * ga.y * bf_hi(mw[0]));
        o[1] = pk_bf16(bf_lo(hw[1]) * r * ga.z * bf_lo(mw[1]), bf_hi(hw[1]) * r * ga.w * bf_hi(mw[1]));
        o[2] = pk_bf16(bf_lo(hw[2]) * r * gb.x * bf_lo(mw[2]), bf_hi(hw[2]) * r * gb.y * bf_hi(mw[2]));
        o[3] = pk_bf16(bf_lo(hw[3]) * r * gb.z * bf_lo(mw[3]), bf_hi(hw[3]) * r * gb.w * bf_hi(mw[3]));
        *(u32x4*)(hm + (tok0 + t) * 1024 + h * 256 + e) = o;
    }
    __syncthreads();
}

__device__ __forceinline__ void swa_stage(const bf16_t* ak, const bf16_t* avT, int item, char* kbuf, int tid) {
    const int kvh = item & 1, n = (item >> 1) & 31, b = item >> 6;
    const long tokbase = (long)b * 4096 + n * 128 - 128;
    const int rk = tid >> 3, pck = tid & 7, lck = pck ^ ((rk >> 1) & 7);
    const bf16_t* srck = ak + (tokbase + rk) * 128 + kvh * 64 + lck * 8;
#pragma unroll
    for (int i = 0; i < 4; ++i) glds16(srck + (long)i * 64 * 128, kbuf + (i * 512 + tid) * 16);
    const int rv = tid >> 5, pcv = tid & 31, lcv = pcv ^ (rv & 15);
    const bf16_t* srcv = avT + (long)(kvh * 64 + rv) * T_ + tokbase + lcv * 8;
#pragma unroll
    for (int i = 0; i < 4; ++i) glds16(srcv + (long)i * 16 * T_, kbuf + 32768 + (i * 512 + tid) * 16);
}
__device__ __forceinline__ const bf16_t* swa_qptr(const bf16_t* aq, int item, int u, int wid, int fr, int fq) {
    const int kvh = item & 1, n = (item >> 1) & 31, b = item >> 6;
    return aq + ((long)b * 4096 + n * 128 + u * 32 + fr) * 1024 + (kvh * 8 + wid) * 64 + fq * 8;
}
__device__ __forceinline__ void swa_items(const Params& p, char* smem, int first, int stride, int hi) {
    const int tid = opaque_tid(), lane = tid & 63, wid = tid >> 6, fr = lane & 15, fq = lane >> 4;
    char* ws = uni(p.ws);
    const bf16_t* aq = (const bf16_t*)(ws + OFF_R1);
    const bf16_t* ak = (const bf16_t*)(ws + OFF_AK);
    const bf16_t* avT = (const bf16_t*)(ws + OFF_AV);
    bf16_t* ao = (bf16_t*)(ws + OFF_R0);
    if (first >= hi) return;
    __syncthreads();
    swa_stage(ak, avT, first, smem, tid);
    bf16x8 qc[4];
    {
        const bf16_t* qp = swa_qptr(aq, first, 0, wid, fr, fq);
        qc[0] = *(const bf16x8*)(qp); qc[1] = *(const bf16x8*)(qp + 32); qc[2] = *(const bf16x8*)(qp + 16 * 1024); qc[3] = *(const bf16x8*)(qp + 16 * 1024 + 32);
    }
    int pb = 0;
    for (int item = first; item < hi; item += stride, pb ^= 1) {
        const int kvh = item & 1, n = (item >> 1) & 31, b = item >> 6;
        const int hq = kvh * 8 + wid;
        char* kbuf = smem + pb * 65536; char* vbuf = kbuf + 32768;
        const float sink = uni(p.sinks)[hq];
        asm volatile("s_waitcnt vmcnt(0)" ::: "memory");
        __syncthreads();
        const bool has_next = item + stride < hi;
        if (has_next) swa_stage(ak, avT, item + stride, smem + (pb ^ 1) * 65536, tid);
        const int kswz = (fr >> 1) & 7;
#pragma unroll 1
        for (int u = 0; u < 4; ++u) {
            const long tq = (long)b * 4096 + n * 128 + u * 32 + fr;
            bf16x8 qn[4];
            {
                const bool nx = (u < 3) || has_next;
                const bf16_t* qp = nx ? (u < 3 ? swa_qptr(aq, item, u + 1, wid, fr, fq) : swa_qptr(aq, item + stride, 0, wid, fr, fq)) : swa_qptr(aq, item, u, wid, fr, fq);
                qn[0] = *(const bf16x8*)(qp); qn[1] = *(const bf16x8*)(qp + 32); qn[2] = *(const bf16x8*)(qp + 16 * 1024); qn[3] = *(const bf16x8*)(qp + 16 * 1024 + 32);
            }
            f32x4 sc[10][2];
#pragma unroll
            for (int r = 0; r < 10; ++r) {
                sc[r][0] = (f32x4){0.f, 0.f, 0.f, 0.f}; sc[r][1] = (f32x4){0.f, 0.f, 0.f, 0.f};
                if (!(n == 0 && (2 * u + r) < 8)) {
                    const char* rowp = kbuf + ((2 * u + r) * 16 + fr) * 128;
                    const bf16x8 k0 = *(const bf16x8*)(rowp + ((fq ^ kswz) * 16)), k1 = *(const bf16x8*)(rowp + (((4 + fq) ^ kswz) * 16));
                    sc[r][0] = __builtin_amdgcn_mfma_f32_16x16x32_bf16(k0, qc[0], sc[r][0], 0, 0, 0);
                    sc[r][0] = __builtin_amdgcn_mfma_f32_16x16x32_bf16(k1, qc[1], sc[r][0], 0, 0, 0);
                    sc[r][1] = __builtin_amdgcn_mfma_f32_16x16x32_bf16(k0, qc[2], sc[r][1], 0, 0, 0);
                    sc[r][1] = __builtin_amdgcn_mfma_f32_16x16x32_bf16(k1, qc[3], sc[r][1], 0, 0, 0);
                }
            }
            u32x4 pf[2][5]; float linv[2];
#pragma unroll
            for (int nt = 0; nt < 2; ++nt) {
                float m = sink;
#pragma unroll
                for (int r = 0; r < 10; ++r) {
                    const bool tile_ok = !(n == 0 && (2 * u + r) < 8);
#pragma unroll
                    for (int j = 0; j < 4; ++j) {
                        const int delta = (r - nt) * 16 + fq * 4 + j - fr;
                        const bool ok = tile_ok && delta >= 1 && delta <= 128;
                        sc[r][nt][j] = ok ? sc[r][nt][j] : -INFINITY;
                        m = fmaxf(m, sc[r][nt][j]);
                    }
                }
                m = fmaxf(m, __shfl_xor(m, 16)); m = fmaxf(m, __shfl_xor(m, 32));
                float l = 0.f;
#pragma unroll
                for (int s2 = 0; s2 < 5; ++s2) {
                    float e[8];
#pragma unroll
                    for (int j = 0; j < 4; ++j) { e[j] = __expf(sc[2 * s2][nt][j] - m); e[4 + j] = __expf(sc[2 * s2 + 1][nt][j] - m); }
                    l += ((e[0] + e[1]) + (e[2] + e[3])) + ((e[4] + e[5]) + (e[6] + e[7]));
                    u32x4 w; w[0] = pk_bf16(e[0], e[1]); w[1] = pk_bf16(e[2], e[3]); w[2] = pk_bf16(e[4], e[5]); w[3] = pk_bf16(e[6], e[7]);
                    pf[nt][s2] = w;
                }
                l += __shfl_xor(l, 16); l += __shfl_xor(l, 32);
                linv[nt] = __builtin_amdgcn_rcpf(l + __expf(sink - m));
            }
            f32x4 o[4][2];
#pragma unroll
            for (int dt = 0; dt < 4; ++dt) { o[dt][0] = (f32x4){0.f, 0.f, 0.f, 0.f}; o[dt][1] = (f32x4){0.f, 0.f, 0.f, 0.f}; }
#pragma unroll
            for (int s2 = 0; s2 < 5; ++s2) {
                if (!(n == 0 && (2 * u + 2 * s2) < 8)) {
                    const int ca = ((((2 * u + 2 * s2) * 2 + (fq >> 1)) ^ fr) * 16) + (fq & 1) * 8;
                    const int cb = ((((2 * u + 2 * s2 + 1) * 2 + (fq >> 1)) ^ fr) * 16) + (fq & 1) * 8;
                    const bf16x8 p0 = __builtin_bit_cast(bf16x8, pf[0][s2]), p1 = __builtin_bit_cast(bf16x8, pf[1][s2]);
#pragma unroll
                    for (int dt = 0; dt < 4; ++dt) {
                        const char* rowp = vbuf + (dt * 16 + fr) * 512;
                        const u32x2 va = *(const u32x2*)(rowp + ca), vb = *(const u32x2*)(rowp + cb);
                        u32x4 vv; vv[0] = va[0]; vv[1] = va[1]; vv[2] = vb[0]; vv[3] = vb[1];
                        const bf16x8 vf = __builtin_bit_cast(bf16x8, vv);
                        o[dt][0] = __builtin_amdgcn_mfma_f32_16x16x32_bf16(vf, p0, o[dt][0], 0, 0, 0);
                        o[dt][1] = __builtin_amdgcn_mfma_f32_16x16x32_bf16(vf, p1, o[dt][1], 0, 0, 0);
                    }
                }
            }
#pragma unroll
            for (int nt = 0; nt < 2; ++nt) {
                bf16_t* rp = ao + (size_t)(tq + nt * 16) * 1024 + hq * 64 + fq * 4;
#pragma unroll
                for (int dt = 0; dt < 4; ++dt) store_bf16x4(rp + dt * 16, o[dt][nt] * linv[nt]);
            }
#pragma unroll
            for (int k = 0; k < 4; ++k) qc[k] = qn[k];
        }
    }
    asm volatile("s_waitcnt vmcnt(0)" ::: "memory");
    __syncthreads();
}

constexpr int SWA_A = 0;
__device__ __forceinline__ void phase2a(const Params& p, char* smem, int which = 3) {
    const int G = gridDim.x;
    if (which & 1) for (int it = blockIdx.x; it < 4096; it += G) ml_prepass_item(p, smem, it);
    if (which & 2) swa_items(p, smem, blockIdx.x, G, SWA_A);
}
__device__ __forceinline__ void phase2c(const Params& p, char* smem) {
    for (int it = blockIdx.x; it < 4096; it += gridDim.x) ml_finish_item(p, smem, it);
}
__device__ __forceinline__ void phase2b(const Params& p, char* smem, int which = 3, const int mode = 0) {
    const int G = gridDim.x;
    if (G > 64) {
        if (blockIdx.x < 64) { if (which & 1) ml_scan(p, smem, blockIdx.x, mode); }
        else { if (which & 2) { swa_items(p, smem, SWA_A + blockIdx.x - 64, G - 64, 1024); moe_weight_prep(p, smem, blockIdx.x - 64, G - 64); } }
    } else {
        for (int it = blockIdx.x; it < 64; it += G) ml_scan(p, smem, it);
        swa_items(p, smem, SWA_A + blockIdx.x, G, 1024);
        moe_weight_prep(p, smem, blockIdx.x, G);
    }
}

struct EpiP3 {
    const bf16_t* gg; bf16_t* y;
    __device__ __forceinline__ void operator()(f32x4 (&acc)[2][2][4][2], const pg8::Unit& u, int wr, int wc, int fr, int fq) const {
        const int row0 = u.pm * 256 + wr * 64 + fr, col0 = u.pn * 256 + wc * 32 + fq * 8;
        const bool first = (u.aux & 1) == 0;
#pragma unroll
        for (int ai = 0; ai < 2; ++ai)
#pragma unroll
            for (int m = 0; m < 4; ++m) {
                const size_t tok = row0 + ai * 128 + m * 16;
#pragma unroll
                for (int bj = 0; bj < 2; ++bj) {
                    const int col = col0 + bj * 128;
                    const u32x4 gm = *(const u32x4*)(gg + tok * 2048 + 1024 + col);
                    float gmf[8] = {bf_lo(gm[0]), bf_hi(gm[0]), bf_lo(gm[1]), bf_hi(gm[1]), bf_lo(gm[2]), bf_hi(gm[2]), bf_lo(gm[3]), bf_hi(gm[3])};
                    if (first) {
                        const u32x4 ga = *(const u32x4*)(gg + tok * 2048 + col);
                        const float gaf[8] = {bf_lo(ga[0]), bf_hi(ga[0]), bf_lo(ga[1]), bf_hi(ga[1]), bf_lo(ga[2]), bf_hi(ga[2]), bf_lo(ga[3]), bf_hi(ga[3])};
#pragma unroll
                        for (int k = 0; k < 4; ++k) {
                            acc[ai][bj][m][0][k] *= gaf[k] * __builtin_amdgcn_rcpf(fmaxf(gmf[k], 1e-30f));
                            acc[ai][bj][m][1][k] *= gaf[4 + k] * __builtin_amdgcn_rcpf(fmaxf(gmf[4 + k], 1e-30f));
                        }
                    } else {
                        f32x4 v0, v1;
#pragma unroll
                        for (int k = 0; k < 4; ++k) { v0[k] = acc[ai][bj][m][0][k] * gmf[k]; v1[k] = acc[ai][bj][m][1][k] * gmf[4 + k]; }
                        store_bf16x8(y + tok * 1024 + col, v0, v1);
                    }
                }
                if (m & 1) __builtin_amdgcn_sched_barrier(0);
            }
    }
};
__device__ __forceinline__ void phase3(const Params& p, char* smem) {
    char* ws = uni(p.ws);
    SchedN1024<2> S{(int)gridDim.x, (int)blockIdx.x, ws + OFF_R0, ws + OFF_WATT, (const char*)uni(p.out), ws + OFF_WML};
    EpiP3 E{(const bf16_t*)(ws + OFF_GG), (bf16_t*)(ws + OFF_R1)};
    pg8::gemm_phase<EpiP3, SchedN1024<2>>((LDS_AS unsigned char*)smem, 1024, S, E);
}

struct EpiBf16 {
    bf16_t* outb; float scale;
    __device__ __forceinline__ void operator()(f32x4 (&acc)[2][2][4][2], const pg8::Unit& u, int wr, int wc, int fr, int fq) const {
        const int row0 = u.pm * 256 + wr * 64 + fr, col0 = u.pn * 256 + wc * 32 + fq * 8;
#pragma unroll
        for (int ai = 0; ai < 2; ++ai)
#pragma unroll
            for (int m = 0; m < 4; ++m) {
                const size_t tok = row0 + ai * 128 + m * 16;
#pragma unroll
                for (int bj = 0; bj < 2; ++bj) store_bf16x8(outb + tok * 1024 + col0 + bj * 128, acc[ai][bj][m][0] * scale, acc[ai][bj][m][1] * scale);
            }
    }
};
__device__ __forceinline__ void phase_gemm_bf16(const Params& p, char* smem, const bf16_t* A, const bf16_t* Bt, bf16_t* outb, float scale) {
    SchedN1024<1> S{(int)gridDim.x, (int)blockIdx.x, (const char*)A, (const char*)Bt, (const char*)A, (const char*)Bt};
    EpiBf16 E{outb, scale};
    pg8::gemm_phase<EpiBf16, SchedN1024<1>>((LDS_AS unsigned char*)smem, 1024, S, E);
}

__device__ __forceinline__ void ln_row(float4 (&v)[4], const float* g, const float* bta, int lane) {
    float s = 0.f;
#pragma unroll
    for (int i = 0; i < 4; ++i) s += (v[i].x + v[i].y) + (v[i].z + v[i].w);
    const float mu = wsum(s) * (1.0f / 1024.0f);
    float q = 0.f;
#pragma unroll
    for (int i = 0; i < 4; ++i) { const float a = v[i].x - mu, b = v[i].y - mu, c = v[i].z - mu, d = v[i].w - mu; q += (a * a + b * b) + (c * c + d * d); }
    const float rstd = rsqrtf(wsum(q) * (1.0f / 1024.0f) + 1e-5f);
#pragma unroll
    for (int i = 0; i < 4; ++i) {
        const float4 gg = *(const float4*)(g + i * 256 + lane * 4), bb = *(const float4*)(bta + i * 256 + lane * 4);
        v[i].x = (v[i].x - mu) * rstd * gg.x + bb.x; v[i].y = (v[i].y - mu) * rstd * gg.y + bb.y;
        v[i].z = (v[i].z - mu) * rstd * gg.z + bb.z; v[i].w = (v[i].w - mu) * rstd * gg.w + bb.w;
    }
}

__device__ __forceinline__ void phase_ln1(const Params& p) {
    const int tid_ = opaque_tid(); const int lane = tid_ & 63, wid = tid_ >> 6;
    float* z = uni(p.out); bf16_t* hb = (bf16_t*)(uni(p.ws) + OFF_R0);
    for (int row = blockIdx.x * 8 + wid; row < T_; row += gridDim.x * 8) {
        float4 v[4];
#pragma unroll
        for (int i = 0; i < 4; ++i) {
            const float4 xx = *(const float4*)(uni(p.x) + (size_t)row * 1024 + i * 256 + lane * 4);
            const uint2 mm = *(const uint2*)(hb + (size_t)row * 1024 + i * 256 + lane * 4);
            v[i].x = ALPHA * xx.x + bf_lo(mm.x); v[i].y = ALPHA * xx.y + bf_hi(mm.x); v[i].z = ALPHA * xx.z + bf_lo(mm.y); v[i].w = ALPHA * xx.w + bf_hi(mm.y);
        }
        ln_row(v, uni(p.ln1g), uni(p.ln1b), lane);
#pragma unroll
        for (int i = 0; i < 4; ++i) {
            uint2 w; w.x = pk_bf16(v[i].x, v[i].y); w.y = pk_bf16(v[i].z, v[i].w);
            *(uint2*)(hb + (size_t)row * 1024 + i * 256 + lane * 4) = w;
        }
    }
}

__device__ __forceinline__ void xa_stage_k(const bf16_t* kmat, int b, int h, int kh, char* buf, int tid) {
    const int rl = tid >> 5, pc = tid & 31, lc = pc ^ (rl & 15);
    const bf16_t* src = kmat + (size_t)(b * 256 + kh * 128 + rl) * 1024 + h * 256 + lc * 8;
#pragma unroll
    for (int i = 0; i < 8; ++i) glds16(src + (size_t)i * 16 * 1024, buf + (i * 512 + tid) * 16);
}
__device__ __forceinline__ void xa_stage_v(const bf16_t* vT, int b, int h, int vh, char* buf, int tid) {
    const int rl = tid >> 4, pc = tid & 15, lc = pc ^ (rl & 15);
    const bf16_t* src = vT + (size_t)(h * 256 + rl) * 4096 + b * 256 + vh * 128 + lc * 8;
#pragma unroll
    for (int i = 0; i < 8; ++i) glds16(src + (size_t)i * 32 * 4096, buf + (i * 512 + tid) * 16);
}

template <int KH>
__device__ __forceinline__ void xa_scores(f32x4 (&acc)[16][2], const char* buf, const bf16x8 (&qf)[2][8], int fr, int fq) {
#pragma unroll
    for (int ks = 0; ks < 8; ++ks) {
        const int ch = ((ks * 4 + fq) ^ fr) * 16;
#pragma unroll
        for (int mt = 0; mt < 8; ++mt) {
            const bf16x8 kf = *(const bf16x8*)(buf + (mt * 16 + fr) * 512 + ch);
            acc[KH * 8 + mt][0] = __builtin_amdgcn_mfma_f32_16x16x32_bf16(kf, qf[0][ks], acc[KH * 8 + mt][0], 0, 0, 0);
            acc[KH * 8 + mt][1] = __builtin_amdgcn_mfma_f32_16x16x32_bf16(kf, qf[1][ks], acc[KH * 8 + mt][1], 0, 0, 0);
        }
        if (ks & 1) __builtin_amdgcn_sched_barrier(0);
    }
}

template <int VH, int DH>
__device__ __forceinline__ void xa_pv(f32x4 (&o)[8][2], const u32x4 (&pf)[2][8], const char* buf, int fr, int fq) {
#pragma unroll
    for (int ks = 0; ks < 4; ++ks) {
        const int ca = ((ks * 4 + (fq >> 1)) ^ fr) * 16 + (fq & 1) * 8, cb = ((ks * 4 + 2 + (fq >> 1)) ^ fr) * 16 + (fq & 1) * 8;
        const bf16x8 p0 = __builtin_bit_cast(bf16x8, pf[0][VH * 4 + ks]), p1 = __builtin_bit_cast(bf16x8, pf[1][VH * 4 + ks]);
#pragma unroll
        for (int dt = 0; dt < 8; ++dt) {
            const char* rowp = buf + ((DH * 8 + dt) * 16 + fr) * 256;
            const u32x2 va = *(const u32x2*)(rowp + ca), vb = *(const u32x2*)(rowp + cb);
            u32x4 vv; vv[0] = va[0]; vv[1] = va[1]; vv[2] = vb[0]; vv[3] = vb[1];
            const bf16x8 vf = __builtin_bit_cast(bf16x8, vv);
            o[dt][0] = __builtin_amdgcn_mfma_f32_16x16x32_bf16(vf, p0, o[dt][0], 0, 0, 0);
            o[dt][1] = __builtin_amdgcn_mfma_f32_16x16x32_bf16(vf, p1, o[dt][1], 0, 0, 0);
        }
    }
}

__device__ __forceinline__ void phase6(const Params& p, char* smem) {
    const int tid = opaque_tid(), lane = tid & 63, wid = tid >> 6, fr = lane & 15, fq = lane >> 4;
    char* ws = uni(p.ws);
    const bf16_t* xq = (const bf16_t*)(ws + OFF_XQ);
    const bf16_t* kmat = (const bf16_t*)(ws + OFF_KMAT);
    const bf16_t* vT = (const bf16_t*)(ws + OFF_VT);
    bf16_t* og = (bf16_t*)(ws + OFF_O);
    char* bufA = smem; char* bufB = smem + 65536;
    const int G = gridDim.x;
    for (int idx = blockIdx.x; idx < 1024; idx += G) {
        int pair, qt;
        if (G == 256) { const int i = idx >> 8, blk = idx & 255, xcd = blk & 7, jj = blk >> 3; pair = (i * 8 + xcd) * 2 + (jj >> 4); qt = jj & 15; }
        else { pair = idx >> 4; qt = idx & 15; }
        const int b = pair >> 2, h = pair & 3;
        const int tok0 = b * 4096 + qt * 256 + wid * 32;
        xa_stage_k(kmat, b, h, 0, bufA, tid);
        xa_stage_k(kmat, b, h, 1, bufB, tid);
        const bf16_t* q0p = xq + (size_t)(tok0 + fr) * 1024 + h * 256 + fq * 8;
        const bf16_t* q1p = q0p + (size_t)16 * 1024;
        bf16x8 qf[2][8];
#pragma unroll
        for (int ks = 0; ks < 8; ++ks) { qf[0][ks] = *(const bf16x8*)(q0p + ks * 32); qf[1][ks] = *(const bf16x8*)(q1p + ks * 32); }
        f32x4 acc[16][2];
#pragma unroll
        for (int mt = 0; mt < 16; ++mt) { acc[mt][0] = (f32x4){0.f, 0.f, 0.f, 0.f}; acc[mt][1] = (f32x4){0.f, 0.f, 0.f, 0.f}; }
        asm volatile("s_waitcnt vmcnt(0)" ::: "memory");
        __syncthreads();
        xa_scores<0>(acc, bufA, qf, fr, fq);
        xa_scores<1>(acc, bufB, qf, fr, fq);
        __syncthreads();
        xa_stage_v(vT, b, h, 0, bufA, tid);
        xa_stage_v(vT, b, h, 1, bufB, tid);
        u32x4 pf[2][8]; float linv[2];
#pragma unroll
        for (int nt = 0; nt < 2; ++nt) {
            float m = -INFINITY;
#pragma unroll
            for (int mt = 0; mt < 16; ++mt) m = fmaxf(m, fmaxf(fmaxf(acc[mt][nt][0], acc[mt][nt][1]), fmaxf(acc[mt][nt][2], acc[mt][nt][3])));
            m = fmaxf(m, __shfl_xor(m, 16)); m = fmaxf(m, __shfl_xor(m, 32));
            float l = 0.f;
#pragma unroll
            for (int s2 = 0; s2 < 8; ++s2) {
                float e[8];
#pragma unroll
                for (int j = 0; j < 4; ++j) { e[j] = __expf(acc[2 * s2][nt][j] - m); e[4 + j] = __expf(acc[2 * s2 + 1][nt][j] - m); }
                l += ((e[0] + e[1]) + (e[2] + e[3])) + ((e[4] + e[5]) + (e[6] + e[7]));
                u32x4 w; w[0] = pk_bf16(e[0], e[1]); w[1] = pk_bf16(e[2], e[3]); w[2] = pk_bf16(e[4], e[5]); w[3] = pk_bf16(e[6], e[7]);
                pf[nt][s2] = w;
            }
            l += __shfl_xor(l, 16); l += __shfl_xor(l, 32);
            linv[nt] = 1.0f / l;
        }
        asm volatile("s_waitcnt vmcnt(0)" ::: "memory");
        __syncthreads();
        {
            f32x4 o[8][2];
#pragma unroll
            for (int dt = 0; dt < 8; ++dt) { o[dt][0] = (f32x4){0.f, 0.f, 0.f, 0.f}; o[dt][1] = (f32x4){0.f, 0.f, 0.f, 0.f}; }
            xa_pv<0, 0>(o, pf, bufA, fr, fq);
            xa_pv<1, 0>(o, pf, bufB, fr, fq);
#pragma unroll
            for (int nt = 0; nt < 2; ++nt) {
                bf16_t* rp = og + (size_t)(tok0 + nt * 16 + fr) * 1024 + h * 256 + fq * 4;
#pragma unroll
                for (int dt = 0; dt < 8; ++dt) store_bf16x4(rp + dt * 16, o[dt][nt] * linv[nt]);
            }
        }
        {
            f32x4 o[8][2];
#pragma unroll
            for (int dt = 0; dt < 8; ++dt) { o[dt][0] = (f32x4){0.f, 0.f, 0.f, 0.f}; o[dt][1] = (f32x4){0.f, 0.f, 0.f, 0.f}; }
            xa_pv<0, 1>(o, pf, bufA, fr, fq);
            xa_pv<1, 1>(o, pf, bufB, fr, fq);
#pragma unroll
            for (int nt = 0; nt < 2; ++nt) {
                bf16_t* rp = og + (size_t)(tok0 + nt * 16 + fr) * 1024 + h * 256 + 128 + fq * 4;
#pragma unroll
                for (int dt = 0; dt < 8; ++dt) store_bf16x4(rp + dt * 16, o[dt][nt] * linv[nt]);
            }
        }
        __syncthreads();
    }
}

__device__ __forceinline__ bool rt_better(float va, int ia, float vb, int ib) { return va > vb || (va == vb && ia < ib); }
__device__ __forceinline__ void phase_ln2_router(const Params& p, char* smem, const int mode = 0) {
    const int tid = opaque_tid(), lane = tid & 63, wid = tid >> 6;
    char* ws = uni(p.ws);
    float* z = (float*)(ws + OFF_Z2); bf16_t* hb = (bf16_t*)(ws + OFF_R0); const bf16_t* xa = (const bf16_t*)(ws + OFF_XQ);
    const float* h1 = uni(p.out);
    int2* toke = (int2*)(ws + OFF_TOKE); float2* tokw = (float2*)(ws + OFF_TOKW);
    int* histg = (int*)(ws + OFF_HIST);
    float* hs = (float*)(smem + wid * 16512);
    int* hist = (int*)(smem + 132096);
    const float* w_rg = uni(p.w_rg); const float* w_re = uni(p.w_re); const float* b_rg = uni(p.b_rg); const float* b_re = uni(p.b_re);
    const float* ln2g = uni(p.ln2g); const float* ln2b = uni(p.ln2b);
    const int chalf = lane & 1, kk = (lane >> 1) & 7, r = lane >> 4;
    for (int c = blockIdx.x; c < 256; c += gridDim.x) {
        if (tid < 64) hist[tid] = 0;
        __syncthreads();
#pragma unroll 1
        for (int rg = 0; rg < 8; ++rg) {
            const int rowbase = c * 256 + wid * 32 + rg * 4;
#pragma unroll
            for (int rr = 0; rr < 4; ++rr) {
                const int row = rowbase + rr;
                float4 v[4];
#pragma unroll
                for (int i = 0; i < 4; ++i) {
                    const uint2 hh = *(const uint2*)(hb + (size_t)row * 1024 + i * 256 + lane * 4);
                    const uint2 mm = *(const uint2*)(xa + (size_t)row * 1024 + i * 256 + lane * 4);
                    v[i].x = ALPHA * bf_lo(hh.x) + bf_lo(mm.x); v[i].y = ALPHA * bf_hi(hh.x) + bf_hi(mm.x); v[i].z = ALPHA * bf_lo(hh.y) + bf_lo(mm.y); v[i].w = ALPHA * bf_hi(hh.y) + bf_hi(mm.y);
                }
                ln_row(v, ln2g, ln2b, lane);
#pragma unroll
                for (int i = 0; i < 4; ++i) {
                    uint2 w; w.x = pk_bf16(v[i].x, v[i].y); w.y = pk_bf16(v[i].z, v[i].w);
                    if (!(mode & 2)) *(uint2*)(hb + (size_t)row * 1024 + i * 256 + lane * 4) = w;
                    *(float4*)(hs + rr * 1032 + i * 256 + lane * 4) = v[i];
                }
            }
            __builtin_amdgcn_wave_barrier();
            asm volatile("s_waitcnt lgkmcnt(0)" ::: "memory");
            if (mode & 1) continue;
            float g0 = 0.f, g1 = 0.f, g2 = 0.f, g3 = 0.f;
#pragma unroll 16
            for (int s8 = 0; s8 < 128; ++s8) {
                const int k = s8 * 8 + kk;
                const float4 w = *(const float4*)(w_rg + (size_t)k * 8 + chalf * 4);
                const float hv = hs[r * 1032 + k];
                g0 += hv * w.x; g1 += hv * w.y; g2 += hv * w.z; g3 += hv * w.w;
            }
#pragma unroll
            for (int o = 2; o < 16; o <<= 1) { g0 += __shfl_xor(g0, o); g1 += __shfl_xor(g1, o); g2 += __shfl_xor(g2, o); g3 += __shfl_xor(g3, o); }
            {
                const float4 bb = *(const float4*)(b_rg + chalf * 4);
                g0 += bb.x; g1 += bb.y; g2 += bb.z; g3 += bb.w;
            }
            float mv = g0; int mi = chalf * 4;
            if (g1 > mv) { mv = g1; mi = chalf * 4 + 1; }
            if (g2 > mv) { mv = g2; mi = chalf * 4 + 2; }
            if (g3 > mv) { mv = g3; mi = chalf * 4 + 3; }
            { const float ov = __shfl_xor(mv, 1); const int oi = __shfl_xor(mi, 1); if (rt_better(ov, oi, mv, mi)) { mv = ov; mi = oi; } }
            float es = (__expf(g0 - mv) + __expf(g1 - mv)) + (__expf(g2 - mv) + __expf(g3 - mv));
            es += __shfl_xor(es, 1);
            const float pgroup = 1.0f / es;
            const int gsel = mi;
            float e0 = 0.f, e1 = 0.f, e2 = 0.f, e3 = 0.f;
            {
                const float* we = w_re + gsel * 8 + chalf * 4;
#pragma unroll 32
                for (int s8 = 0; s8 < 128; ++s8) {
                    const int k = s8 * 8 + kk;
                    const float4 w = *(const float4*)(we + (size_t)k * 64);
                    const float hv = hs[r * 1032 + k];
                    e0 += hv * w.x; e1 += hv * w.y; e2 += hv * w.z; e3 += hv * w.w;
                }
            }
#pragma unroll
            for (int o = 2; o < 16; o <<= 1) { e0 += __shfl_xor(e0, o); e1 += __shfl_xor(e1, o); e2 += __shfl_xor(e2, o); e3 += __shfl_xor(e3, o); }
            {
                const float4 bb = *(const float4*)(b_re + gsel * 8 + chalf * 4);
                e0 += bb.x; e1 += bb.y; e2 += bb.z; e3 += bb.w;
            }
            float v0 = e0, v1 = -INFINITY; int i0 = chalf * 4, i1 = 99;
            {
                const float ev[3] = {e1, e2, e3};
#pragma unroll
                for (int q = 0; q < 3; ++q) {
                    const float x = ev[q]; const int xi = chalf * 4 + q + 1;
                    if (x > v0) { v1 = v0; i1 = i0; v0 = x; i0 = xi; } else if (x > v1) { v1 = x; i1 = xi; }
                }
            }
            {
                const float b0 = __shfl_xor(v0, 1), b1 = __shfl_xor(v1, 1); const int k0 = __shfl_xor(i0, 1), k1 = __shfl_xor(i1, 1);
                float n0, n1; int m0, m1;
                if (rt_better(v0, i0, b0, k0)) { n0 = v0; m0 = i0; if (rt_better(v1, i1, b0, k0)) { n1 = v1; m1 = i1; } else { n1 = b0; m1 = k0; } }
                else { n0 = b0; m0 = k0; if (rt_better(b1, k1, v0, i0)) { n1 = b1; m1 = k1; } else { n1 = v0; m1 = i0; } }
                v0 = n0; i0 = m0; v1 = n1; i1 = m1;
            }
            if (kk == 0 && chalf == 0) {
                const float x1 = __expf(v1 - v0), den = 1.0f + x1;
                const int ea = gsel * 8 + i0, eb2 = gsel * 8 + i1;
                toke[rowbase + r] = make_int2(ea, eb2); tokw[rowbase + r] = make_float2(pgroup / den, pgroup * x1 / den);
                atomicAdd(&hist[ea], 1); atomicAdd(&hist[eb2], 1);
            }
            __builtin_amdgcn_wave_barrier();
        }
        __syncthreads();
        if (tid < 64 && !(mode & 1)) histg[c * 64 + tid] = hist[tid];
        __syncthreads();
    }
}

__device__ __forceinline__ void compute_segments(const int* histg, int* seg, int tid) {
    if (tid < 64) {
        int s = 0;
        for (int c = 0; c < 256; ++c) s += histg[c * 64 + tid];
        seg[tid] = s;
    }
    __syncthreads();
    if (tid == 0) {
        int acc = 0;
        for (int e = 0; e < 64; ++e) { seg[64 + e] = acc; acc += (seg[e] + 255) >> 8; }
        seg[128] = acc;
    }
    __syncthreads();
}

__device__ __forceinline__ void phase8(const Params& p, char* smem) {
    const int tid = opaque_tid();
    char* ws = uni(p.ws);
    const int* histg = (const int*)(ws + OFF_HIST);
    const int2* toke = (const int2*)(ws + OFF_TOKE); const float2* tokw = (const float2*)(ws + OFF_TOKW);
    int* slot_tok = (int*)(ws + OFF_SLOTTOK); float* slot_w = (float*)(ws + OFF_SLOTW);
    int* seg = (int*)smem;
    int* cursor = seg + 192;
    compute_segments(histg, seg, tid);
    for (int e = blockIdx.x; e < 64; e += gridDim.x) {
        const int start = seg[64 + e] * 256 + seg[e], end = seg[64 + e + 1] * 256;
        for (int s = start + tid; s < end; s += NTHR) { slot_tok[s] = -1; slot_w[s] = 0.f; }
    }
    for (int c = blockIdx.x; c < 256; c += gridDim.x) {
        __syncthreads();
        if (tid < 64) {
            int base = 0;
            for (int cc = 0; cc < c; ++cc) base += histg[cc * 64 + tid];
            cursor[tid] = seg[64 + tid] * 256 + base;
        }
        __syncthreads();
        if (tid < 256) {
            const int tok = c * 256 + tid;
            const int2 ee = toke[tok]; const float2 ww = tokw[tok];
            const int s0 = atomicAdd(&cursor[ee.x], 1);
            const int s1 = atomicAdd(&cursor[ee.y], 1);
            slot_tok[s0] = tok * 2; slot_w[s0] = ww.x;
            slot_tok[s1] = tok * 2 + 1; slot_w[s1] = ww.y;
        }
    }
}

__device__ __forceinline__ void phase9a(const Params& p, char* smem) {
    const int tid = opaque_tid(), lane = tid & 63, wid = tid >> 6, wr = wid >> 1, wc = wid & 1, fr = lane & 15, fq = lane >> 4;
    char* ws = uni(p.ws);
    int* seg = (int*)(smem + LDS_GEMM);
    compute_segments((const int*)(ws + OFF_HIST), seg, tid);
    const int nrt = seg[128];
    const int* slot_tok = (const int*)(ws + OFF_SLOTTOK);
    const bf16_t* h2b = (const bf16_t*)(ws + OFF_R0);
    bf16_t* hbuf = (bf16_t*)(ws + OFF_R1);
    for (int it = 0;; ++it) {
        int t;
        if (!xcd_item(it, nrt * 4, t)) break;
        const int rtile = t >> 2, nt = t & 3;
        int e = 0;
        for (int k = 1; k < 64; ++k) if (seg[64 + k] <= rtile) e = k;
        GemmSrc s;
        {
            const int r = tid >> 3, lc = (tid & 7) ^ ((r >> 1) & 7);
#pragma unroll
            for (int i = 0; i < 4; ++i) {
                const int tk = slot_tok[rtile * 256 + i * 64 + r];
                const int tok = tk < 0 ? 0 : (tk >> 1);
                s.a[i] = h2b + (size_t)tok * 1024 + lc * 8;
            }
#pragma unroll
            for (int i = 0; i < 2; ++i) s.b[i] = (const bf16_t*)(ws + OFF_WGU) + (size_t)e * 512 * 1024 + (size_t)(nt * 128 + i * 64 + r) * 1024 + lc * 8;
        }
        f32x4 acc[4][4]; zero_acc(acc);
        gemm_loop(acc, s, 16, smem, tid);
        const int row0 = rtile * 256 + wr * 64 + fr;
        const int colb = (nt * 2 + wc) * 32 + fq * 4;
#pragma unroll
        for (int m = 0; m < 4; ++m) {
            const size_t slot = row0 + m * 16;
#pragma unroll
            for (int n = 0; n < 2; ++n) {
                const f32x4 g = acc[m][n], u = acc[m][n + 2];
                f32x4 v;
#pragma unroll
                for (int j = 0; j < 4; ++j) v[j] = g[j] * sigmoidf_(g[j]) * u[j];
                store_bf16x4(hbuf + slot * 256 + colb + n * 16, v);
            }
        }
    }
}

struct Sched9b {
    int G, c, nrt; const int* seg; const char* hbuf; const char* wd;
    __device__ __forceinline__ bool next(int i, pg8::Unit& u) const {
        int rtile, pn;
        if ((G & 7) == 0) { const int x = c & 7, j = c >> 3, nj = G >> 3, per = (nrt + 7) >> 3; const int uidx = i * nj + j; if (uidx >= per * 4) return false; rtile = x * per + (uidx >> 2); pn = uidx & 3; if (rtile >= nrt) return false; }
        else { const int uidx = i * G + c; if (uidx >= nrt * 4) return false; rtile = uidx >> 2; pn = uidx & 3; }
        int e = 0;
        for (int k = 1; k < 64; ++k) if (seg[64 + k] <= rtile) e = k;
        e = __builtin_amdgcn_readfirstlane(e);
        u.pm = rtile; u.pn = pn; u.aux = e; u.A = hbuf; u.Bt = wd + (size_t)e * 1024 * 256 * 2;
        return true;
    }
};
struct Epi9b {
    const int* slot_tok; const float* slot_w; bf16_t* yb;
    __device__ __forceinline__ void operator()(f32x4 (&acc)[2][2][4][2], const pg8::Unit& u, int wr, int wc, int fr, int fq) const {
        const int row0 = u.pm * 256 + wr * 64 + fr, col0 = u.pn * 256 + wc * 32 + fq * 8;
#pragma unroll
        for (int ai = 0; ai < 2; ++ai)
#pragma unroll
            for (int m = 0; m < 4; ++m) {
                const int slot = row0 + ai * 128 + m * 16;
                const int tk = slot_tok[slot]; const float w = slot_w[slot];
                if (tk >= 0) {
#pragma unroll
                    for (int bj = 0; bj < 2; ++bj) store_bf16x8(yb + (size_t)tk * 1024 + col0 + bj * 128, acc[ai][bj][m][0] * w, acc[ai][bj][m][1] * w);
                }
            }
    }
};
__device__ __forceinline__ void phase9b(const Params& p, char* smem) {
    const int tid = opaque_tid();
    char* ws = uni(p.ws);
    int* seg = (int*)(smem + LDS_GEMM);
    compute_segments((const int*)(ws + OFF_HIST), seg, tid);
    Sched9b S{(int)gridDim.x, (int)blockIdx.x, __builtin_amdgcn_readfirstlane(seg[128]), seg, ws + OFF_R1, ws + OFF_WD};
    Epi9b E{(const int*)(ws + OFF_SLOTTOK), (const float*)(ws + OFF_SLOTW), (bf16_t*)(ws + OFF_YB)};
    pg8::gemm_phase<Epi9b, Sched9b>((LDS_AS unsigned char*)smem, 256, S, E);
}

__device__ __forceinline__ void phase10(const Params& p) {
    const int tid_ = opaque_tid(); const int lane = tid_ & 63, wid = tid_ >> 6;
    const bf16_t* h2 = (const bf16_t*)(uni(p.ws) + OFF_R0); const bf16_t* yb = (const bf16_t*)(uni(p.ws) + OFF_YB);
    for (int row = blockIdx.x * 8 + wid; row < T_; row += gridDim.x * 8) {
        float4 v[4];
#pragma unroll
        for (int i = 0; i < 4; ++i) {
            const uint2 hh = *(const uint2*)(h2 + (size_t)row * 1024 + i * 256 + lane * 4);
            const uint2 a = *(const uint2*)(yb + (size_t)(row * 2) * 1024 + i * 256 + lane * 4), b = *(const uint2*)(yb + (size_t)(row * 2 + 1) * 1024 + i * 256 + lane * 4);
            v[i].x = ALPHA * bf_lo(hh.x) + bf_lo(a.x) + bf_lo(b.x); v[i].y = ALPHA * bf_hi(hh.x) + bf_hi(a.x) + bf_hi(b.x);
            v[i].z = ALPHA * bf_lo(hh.y) + bf_lo(a.y) + bf_lo(b.y); v[i].w = ALPHA * bf_hi(hh.y) + bf_hi(a.y) + bf_hi(b.y);
        }
        ln_row(v, uni(p.ln3g), uni(p.ln3b), lane);
#pragma unroll
        for (int i = 0; i < 4; ++i) *(float4*)(uni(p.out) + (size_t)row * 1024 + i * 256 + lane * 4) = v[i];
    }
}

#define XB_TMO      128
#define XB_XCNT(j)  (256  + 64 * (j))
#define XB_XSUB(j)  (1280 + 64 * (j))
#define XB_XGEN(j)  (2304 + 64 * (j))
#define XB_TOP      3328
#define XB_TOPGEN   3392
#define XCD_BAR_WORDS 3456
#define XB_SPIN_CAP (1u << 18)
#define LAS LDS_AS

__device__ __forceinline__ unsigned xb_ld(unsigned* p)              { return __hip_atomic_load(p, __ATOMIC_RELAXED, __HIP_MEMORY_SCOPE_AGENT); }
__device__ __forceinline__ unsigned xb_add(unsigned* p, unsigned v) { return __hip_atomic_fetch_add(p, v, __ATOMIC_RELAXED, __HIP_MEMORY_SCOPE_AGENT); }
__device__ __forceinline__ unsigned xb_xcc_id() { return (unsigned)__builtin_amdgcn_s_getreg((3 << 11) | 20) & 0xFu; }
#define XB_SPIN(cond, bar) do { unsigned _sp = 0; while (cond) { __builtin_amdgcn_s_sleep(1); \
    if ((++_sp & 255u) == 0u) { if (xb_ld(&(bar)[XB_TMO])) break; if (_sp > XB_SPIN_CAP) { atomicAdd(&(bar)[XB_TMO], 1u); break; } } } } while (0)

struct XcdBarrier {
    unsigned* bar; unsigned x;
    volatile LAS unsigned* st;
};

__device__ __forceinline__ XcdBarrier xcd_barrier_post(unsigned* bar, volatile LAS unsigned* st) {
    XcdBarrier b; b.bar = bar; b.x = xb_xcc_id(); b.st = st;
    if (threadIdx.x == 0) (void)xb_add(&bar[XB_XCNT(b.x)], 1u);
    return b;
}
__device__ __forceinline__ void xcd_barrier_complete(unsigned* bar, unsigned x, unsigned& nloc, unsigned& nx) {
    const unsigned G = gridDim.x * gridDim.y * gridDim.z;
    unsigned sum, cnt, mine, sp = 0u;
    for (;;) {
        sum = 0u; cnt = 0u; mine = 0u;
#pragma unroll
        for (unsigned j = 0; j < 16; ++j) { const unsigned c = xb_ld(&bar[XB_XCNT(j)]); sum += c; cnt += (c > 0u) ? 1u : 0u; mine = (j == x) ? c : mine; }
        if (sum == G) break;
        __builtin_amdgcn_s_sleep(1);
        if ((++sp & 255u) == 0u) { if (xb_ld(&bar[XB_TMO])) break; if (sp > XB_SPIN_CAP) { atomicAdd(&bar[XB_TMO], 1u); break; } }
    }
    nloc = mine > 0u ? mine : 1u; nx = cnt > 0u ? cnt : 1u;
}

__device__ __forceinline__ void xcd_barrier(const XcdBarrier& b) {
    asm volatile("s_waitcnt vmcnt(0)" ::: "memory");
    __syncthreads();
    if (threadIdx.x == 0) {
        unsigned* bar = b.bar;
        __builtin_amdgcn_s_waitcnt(0);
        unsigned nloc = b.st[0], nx = b.st[1];
        if (nloc == 0u) { xcd_barrier_complete(bar, b.x, nloc, nx); b.st[0] = nloc; b.st[1] = nx; }
        const unsigned old = xb_add(&bar[XB_XSUB(b.x)], 1u);
        const unsigned gen = old / nloc;
        if (old + 1u == (gen + 1u) * nloc) {
            __builtin_amdgcn_fence(__ATOMIC_RELEASE, "agent");
            asm volatile("s_waitcnt vmcnt(0)" ::: "memory");
            const unsigned og = xb_add(&bar[XB_TOP], 1u);
            const unsigned tg = og / nx;
            if (og + 1u == (tg + 1u) * nx) xb_add(&bar[XB_TOPGEN], 1u);
            else XB_SPIN(xb_ld(&bar[XB_TOPGEN]) == tg, bar);
            __builtin_amdgcn_fence(__ATOMIC_ACQUIRE, "agent");
            xb_add(&bar[XB_XGEN(b.x)], 1u);
            asm volatile("s_waitcnt vmcnt(0)" ::: "memory");
        } else {
            XB_SPIN(xb_ld(&bar[XB_XGEN(b.x)]) == gen, bar);
            __builtin_amdgcn_fence(__ATOMIC_ACQUIRE, "agent");
            asm volatile("s_waitcnt vmcnt(0)" ::: "memory");
        }
    }
    __syncthreads();
}


#ifndef DUP
#define DUP (-1)
#endif
#define RUN(id, call) do { call; if (DUP == (id)) { GRID_SYNC(); call; } } while (0)
__global__ void __launch_bounds__(NTHR) mega(Params pk) {
    extern __shared__ __attribute__((aligned(16))) char smem[];
    cg::grid_group grid = cg::this_grid();
    if (threadIdx.x == 0) *(Params*)(smem + LDS_PARAMS) = pk;
    __syncthreads();
    const Params& p = *(const Params*)(smem + LDS_PARAMS);
    char* ws = uni(p.ws);
    volatile LDS_AS unsigned* xst = (volatile LDS_AS unsigned*)(LDS_AS char*)smem + (LDS_XB / 4);
    if (threadIdx.x < 4) xst[threadIdx.x] = 0u;
    __syncthreads();
    (void)xcd_barrier_post((unsigned*)(ws + OFF_BAR), xst);
#define GRID_SYNC() do { XcdBarrier xb_; xb_.bar = (unsigned*)(uni(p.ws) + OFF_BAR); xb_.x = xb_xcc_id(); xb_.st = (volatile LDS_AS unsigned*)(LDS_AS char*)smem + (LDS_XB / 4); xcd_barrier(xb_); } while (0)
    RUN(0, phase0(p, smem));
    if (DUP == 61) { GRID_SYNC(); phase0(p, smem, 1); }
    if (DUP == 62) { GRID_SYNC(); phase0(p, smem, 2); }
    if (DUP == 64) { GRID_SYNC(); phase0(p, smem, 4); }
    grid.sync();
    RUN(1, phase1(p, smem));
    if (DUP == 30) { GRID_SYNC(); phase1(p, smem, 1); }
    if (DUP == 31) { GRID_SYNC(); phase1(p, smem, 2); }
    GRID_SYNC();
    RUN(2, phase2a(p, smem));
    if (DUP == 20) { GRID_SYNC(); phase2a(p, smem, 1); }
    if (DUP == 21) { GRID_SYNC(); phase2a(p, smem, 2); }
    GRID_SYNC();
    RUN(12, phase2b(p, smem));
    if (DUP == 22) { GRID_SYNC(); phase2b(p, smem, 1); }
    if (DUP == 23) { GRID_SYNC(); phase2b(p, smem, 2); }
    if (DUP == 24) { GRID_SYNC(); phase2b(p, smem, 1, 4); }
    if (DUP == 25) { GRID_SYNC(); phase2b(p, smem, 1, 5); }
    if (DUP == 26) { GRID_SYNC(); phase2b(p, smem, 1, 13); }
    GRID_SYNC();
    phase2c(p, smem);
    GRID_SYNC();
    RUN(3, phase3(p, smem));
    GRID_SYNC();
    RUN(4, phase_gemm_bf16(p, smem, (const bf16_t*)(ws + OFF_R1), (const bf16_t*)(ws + OFF_WMIX), (bf16_t*)(ws + OFF_R0), 1.0f));
    GRID_SYNC();
    phase_ln1(p);
    GRID_SYNC();
    RUN(6, phase_gemm_bf16(p, smem, (const bf16_t*)(ws + OFF_R0), (const bf16_t*)(ws + OFF_WXQ), (bf16_t*)(ws + OFF_XQ), 0.0625f));
    GRID_SYNC();
    RUN(7, phase6(p, smem));
    GRID_SYNC();
    RUN(8, phase_gemm_bf16(p, smem, (const bf16_t*)(ws + OFF_O), (const bf16_t*)(ws + OFF_WXO), (bf16_t*)(ws + OFF_XQ), 1.0f));
    GRID_SYNC();
    RUN(13, phase_ln2_router(p, smem));
    if (DUP == 51) { GRID_SYNC(); phase_ln2_router(p, smem, 1); }
    if (DUP == 53) { GRID_SYNC(); phase_ln2_router(p, smem, 3); }
    GRID_SYNC();
    RUN(9, phase8(p, smem));
    GRID_SYNC();
    RUN(10, phase9a(p, smem));
    GRID_SYNC();
    RUN(11, phase9b(p, smem));
    GRID_SYNC();
    RUN(14, phase10(p));
}

extern "C" void kernel_launch(void* const* d_in, const int* in_sizes, int n_in, void* d_out, int out_size,
                              void* d_ws, size_t ws_size, hipStream_t stream) {
    static int grid_blocks = 0;
    if (!grid_blocks) {
        int dev = 0, cus = 0, per_cu = 0;
        (void)hipGetDevice(&dev);
        (void)hipDeviceGetAttribute(&cus, hipDeviceAttributeMultiprocessorCount, dev);
        (void)hipFuncSetAttribute((const void*)mega, hipFuncAttributeMaxDynamicSharedMemorySize, LDS_BYTES);
        (void)hipOccupancyMaxActiveBlocksPerMultiprocessor(&per_cu, mega, NTHR, LDS_BYTES);
        if (per_cu > 1) per_cu = 1;
        grid_blocks = cus * per_cu;
        if (ws_size < WS_NEED) fprintf(stderr, "workspace too small: %zu\n", ws_size);
    }
    Params p{};
    const float* const* f = (const float* const*)d_in;
    p.x = f[0]; p.mem = f[1]; p.pos = (const int*)d_in[2];
    p.w_in = f[3]; p.sinks = f[4]; p.conv_w = f[5]; p.conv_b = f[6]; p.b_ig = f[7]; p.b_fg = f[8]; p.ml_g = f[9];
    p.w_att = f[10]; p.w_ml = f[11]; p.w_mix = f[12]; p.ln1g = f[13]; p.ln1b = f[14];
    p.w_xq = f[15]; p.w_xkv = f[16]; p.w_xo = f[17]; p.ln2g = f[18]; p.ln2b = f[19];
    p.w_rg = f[20]; p.b_rg = f[21]; p.w_re = f[22]; p.b_re = f[23]; p.w_gate = f[24]; p.w_up = f[25]; p.w_down = f[26];
    p.ln3g = f[27]; p.ln3b = f[28];
    p.out = (float*)d_out; p.ws = (char*)d_ws;
    (void)hipMemsetAsync((char*)d_ws + OFF_BAR, 0, XCD_BAR_WORDS * sizeof(unsigned), stream);
    void* args[] = {&p};
    hipError_t e = hipLaunchCooperativeKernel((void*)mega, dim3(grid_blocks), dim3(NTHR), args, LDS_BYTES, stream);
    if (e != hipSuccess) fprintf(stderr, "cooperative launch failed: %s (grid %d)\n", hipGetErrorString(e), grid_blocks);
}
```

```cpp
#include <hip/hip_runtime.h>
#include <hip/hip_cooperative_groups.h>
#include <cstdio>
#include <cstdint>
namespace cg = cooperative_groups;

typedef unsigned short bf16_t;
typedef short bf16x8 __attribute__((ext_vector_type(8)));
typedef float f32x4 __attribute__((ext_vector_type(4)));
typedef unsigned u32x2 __attribute__((ext_vector_type(2)));
typedef unsigned u32x4 __attribute__((ext_vector_type(4)));
#define LDS_AS __attribute__((address_space(3)))
#define GLB_AS __attribute__((address_space(1)))

constexpr int T_ = 65536;
constexpr int NTHR = 512;
constexpr size_t MiB = 1ull << 20;
constexpr float ALPHA = 1.189207115002721f;
constexpr size_t OFF_R0 = 0;
constexpr size_t OFF_R1 = 128 * MiB;
constexpr size_t OFF_AK = 256 * MiB;
constexpr size_t OFF_AV = 272 * MiB;
constexpr size_t OFF_MQK = 288 * MiB;
constexpr size_t OFF_MV = 416 * MiB;
constexpr size_t OFF_MO = 544 * MiB;
constexpr size_t OFF_GG = 672 * MiB;
constexpr size_t OFF_WGU = 288 * MiB;
constexpr size_t OFF_WD = 352 * MiB;
constexpr size_t OFF_XQ = 416 * MiB;
constexpr size_t OFF_O = 544 * MiB;
constexpr size_t OFF_Z2 = 672 * MiB;
constexpr size_t OFF_YB = 416 * MiB;
constexpr size_t OFF_MISC = 928 * MiB;
constexpr size_t OFF_WIN = OFF_MISC;
constexpr size_t OFF_MEMB = OFF_MISC + 13 * MiB;
constexpr size_t OFF_CS = OFF_MISC + 21 * MiB;
constexpr size_t OFF_WXKV = OFF_MISC + 37 * MiB;
constexpr size_t OFF_WATT = OFF_MISC + 41 * MiB;
constexpr size_t OFF_WML = OFF_MISC + 43 * MiB;
constexpr size_t OFF_WMIX = OFF_MISC + 45 * MiB;
constexpr size_t OFF_WXQ = OFF_MISC + 47 * MiB;
constexpr size_t OFF_WXO = OFF_MISC + 49 * MiB;
constexpr size_t OFF_KMAT = OFF_MISC + 51 * MiB;
constexpr size_t OFF_VT = OFF_MISC + 59 * MiB;
constexpr size_t OFF_GATES = OFF_MISC + 67 * MiB;
constexpr size_t OFF_TOKE = OFF_MISC + 69 * MiB;
constexpr size_t OFF_TOKW = OFF_MISC + 70 * MiB;
constexpr size_t OFF_SLOTTOK = OFF_MISC + 71 * MiB;
constexpr size_t OFF_SLOTW = OFF_MISC + 72 * MiB;
constexpr size_t OFF_HIST = OFF_MISC + 73 * MiB;
constexpr size_t OFF_BAR = OFF_MISC + 74 * MiB;
constexpr size_t OFF_SSQP = OFF_MISC + 76 * MiB;
constexpr size_t OFF_SP = OFF_MISC;
constexpr size_t OFF_REC = OFF_MISC + 32 * MiB;
constexpr size_t OUT_QP = 128 * MiB;
constexpr size_t OUT_KP = 192 * MiB;
constexpr size_t WS_NEED = 1024 * MiB;
constexpr int LDS_GEMM = 147456;
constexpr int LDS_PARAMS = 163520;
constexpr int LDS_XB = 163776;
constexpr int LDS_BYTES = 163840;

struct Params {
    const float *x, *mem; const int* pos;
    const float *w_in, *sinks, *conv_w, *conv_b, *b_ig, *b_fg, *ml_g, *w_att, *w_ml, *w_mix, *ln1g, *ln1b;
    const float *w_xq, *w_xkv, *w_xo, *ln2g, *ln2b, *w_rg, *b_rg, *w_re, *b_re, *w_gate, *w_up, *w_down, *ln3g, *ln3b;
    float* out; char* ws;
};

__device__ const double INV_FREQ[32] = {1.0, 0.7498942093324559, 0.5623413251903491, 0.4216965034285822, 0.31622776601683794, 0.23713737056616552, 0.1778279410038923, 0.1333521432163324, 0.1, 0.07498942093324558, 0.05623413251903491, 0.042169650342858224, 0.03162277660168379, 0.023713737056616554, 0.01778279410038923, 0.01333521432163324, 0.01, 0.007498942093324558, 0.005623413251903491, 0.004216965034285823, 0.0031622776601683794, 0.0023713737056616554, 0.0017782794100389228, 0.001333521432163324, 0.001, 0.0007498942093324559, 0.0005623413251903491, 0.00042169650342858224, 0.00031622776601683794, 0.00023713737056616554, 0.00017782794100389227, 0.0001333521432163324};

template <class T> __device__ __forceinline__ T* uni(T* q) {
    const unsigned long long v = (unsigned long long)q;
    const unsigned lo = __builtin_amdgcn_readfirstlane((unsigned)v), hi = __builtin_amdgcn_readfirstlane((unsigned)(v >> 32));
    return (T*)(((unsigned long long)hi << 32) | lo);
}
__device__ __forceinline__ int opaque_tid() { int t = threadIdx.x; asm volatile("" : "+v"(t)); return t; }
__device__ __forceinline__ unsigned pk_bf16(float lo, float hi) { unsigned r; asm("v_cvt_pk_bf16_f32 %0, %1, %2" : "=v"(r) : "v"(lo), "v"(hi)); return r; }
__device__ __forceinline__ float bf_lo(unsigned u) { return __uint_as_float(u << 16); }
__device__ __forceinline__ float bf_hi(unsigned u) { return __uint_as_float(u & 0xffff0000u); }
__device__ __forceinline__ float bf2f(bf16_t h) { return __uint_as_float(((unsigned)h) << 16); }
__device__ __forceinline__ float wsum(float v) {
#pragma unroll
    for (int o = 32; o; o >>= 1) v += __shfl_xor(v, o);
    return v;
}
__device__ __forceinline__ float wmaxf(float v) {
#pragma unroll
    for (int o = 32; o; o >>= 1) v = fmaxf(v, __shfl_xor(v, o));
    return v;
}
__device__ __forceinline__ float sigmoidf_(float x) { return __builtin_amdgcn_rcpf(1.0f + __builtin_amdgcn_exp2f(x * -1.4426950408889634f)); }
__device__ __forceinline__ void glds16(const bf16_t* g, char* l) {
    __builtin_amdgcn_global_load_lds((const GLB_AS void*)g, (LDS_AS void*)l, 16, 0, 0);
}

__device__ __forceinline__ bool xcd_item(int i, int n, int& item) {
    const int G = gridDim.x;
    if ((G & 7) == 0) {
        const int x = blockIdx.x & 7, j = blockIdx.x >> 3, nj = G >> 3;
        const int per = (n + 7) >> 3;
        const int u = i * nj + j;
        if (u >= per) return false;
        item = x * per + u;
        return item < n;
    }
    item = blockIdx.x + i * G;
    return item < n;
}

struct GemmSrc { const bf16_t* a[4]; const bf16_t* b[2]; };

__device__ __forceinline__ void stage_tile(const GemmSrc& s, int koff, char* buf, int tid) {
#pragma unroll
    for (int i = 0; i < 4; ++i) glds16(s.a[i] + koff, buf + (i * 512 + tid) * 16);
#pragma unroll
    for (int i = 0; i < 2; ++i) glds16(s.b[i] + koff, buf + 32768 + (i * 512 + tid) * 16);
}

constexpr int GEMM_STAGE = 49152;
__device__ __forceinline__ void gemm_loop(f32x4 (&acc)[4][4], const GemmSrc& s, int nk, char* smem, int tid) {
    const int lane = tid & 63, wid = tid >> 6, wr = wid >> 1, wc = wid & 1, fr = lane & 15, fq = lane >> 4;
    const int swz = (fr >> 1) & 7;
    const int aoff = (wr * 64 + fr) * 128;
    const int boff = 32768 + (wc * 64 + fr) * 128;
    stage_tile(s, 0, smem, tid);
    if (nk > 1) stage_tile(s, 64, smem + GEMM_STAGE, tid);
    int cur = 0, nxt = 2;
#pragma unroll 1
    for (int t = 0; t < nk; ++t) {
        if (t + 1 < nk) asm volatile("s_waitcnt vmcnt(6)" ::: "memory"); else asm volatile("s_waitcnt vmcnt(0)" ::: "memory");
        __builtin_amdgcn_s_barrier();
        if (t + 2 < nk) stage_tile(s, (t + 2) * 64, smem + nxt * GEMM_STAGE, tid);
        const char* cb = smem + cur * GEMM_STAGE;
#pragma unroll
        for (int ks = 0; ks < 2; ++ks) {
            const int ch = ((ks * 4 + fq) ^ swz) * 16;
            bf16x8 xa[4], wb[4];
#pragma unroll
            for (int m = 0; m < 4; ++m) xa[m] = *(const bf16x8*)(cb + aoff + m * 2048 + ch);
#pragma unroll
            for (int n = 0; n < 4; ++n) wb[n] = *(const bf16x8*)(cb + boff + n * 2048 + ch);
#pragma unroll
            for (int m = 0; m < 4; ++m)
#pragma unroll
                for (int n = 0; n < 4; ++n) acc[m][n] = __builtin_amdgcn_mfma_f32_16x16x32_bf16(wb[n], xa[m], acc[m][n], 0, 0, 0);
        }
        cur = cur == 2 ? 0 : cur + 1; nxt = nxt == 2 ? 0 : nxt + 1;
    }
    __syncthreads();
}

__device__ __forceinline__ void zero_acc(f32x4 (&acc)[4][4]) {
#pragma unroll
    for (int m = 0; m < 4; ++m)
#pragma unroll
        for (int n = 0; n < 4; ++n) acc[m][n] = (f32x4){0.f, 0.f, 0.f, 0.f};
}

__device__ __forceinline__ void make_src(GemmSrc& s, const bf16_t* A, size_t lda, int rowA0, const bf16_t* Bt, size_t ldb, int rowB0, int tid) {
    const int r = tid >> 3, lc = (tid & 7) ^ ((r >> 1) & 7);
#pragma unroll
    for (int i = 0; i < 4; ++i) s.a[i] = A + (size_t)(rowA0 + i * 64 + r) * lda + lc * 8;
#pragma unroll
    for (int i = 0; i < 2; ++i) s.b[i] = Bt + (size_t)(rowB0 + i * 64 + r) * ldb + lc * 8;
}

__device__ __forceinline__ void store_bf16x8(bf16_t* p, f32x4 a, f32x4 b) {
    u32x4 w; w[0] = pk_bf16(a[0], a[1]); w[1] = pk_bf16(a[2], a[3]); w[2] = pk_bf16(b[0], b[1]); w[3] = pk_bf16(b[2], b[3]); *(u32x4*)p = w;
}
__device__ __forceinline__ void store_bf16x4(bf16_t* p, f32x4 v) {
    uint2 w; w.x = pk_bf16(v[0], v[1]); w.y = pk_bf16(v[2], v[3]); *(uint2*)p = w;
}

namespace pg8 {
constexpr int BM = 256, BK = 64, HALF = 128, HTB = HALF * BK * 2;
__device__ __forceinline__ int lds_byte(int r, int c) { const int st = (r >> 4) * 2 + (c >> 5), rr = r & 15, cc = c & 31, ob = rr * 64 + cc * 2; return st * 1024 + (ob ^ (((ob >> 9) & 1) << 5)); }
__device__ __forceinline__ void stage_rc(int b, int& R, int& C) { const int st = b / 1024, sb = b % 1024, swz = sb ^ (((sb >> 9) & 1) << 5); R = (st >> 1) * 16 + swz / 64; C = (st & 1) * 32 + (swz % 64) / 2; }
struct Unit { int pm, pn, aux; const char* A; const char* Bt; };

template <class Epi, class Sched, bool GATHER = false>
__device__ __forceinline__ void gemm_phase(LDS_AS unsigned char* lds, const int K, const Sched& S, const Epi& E, const int stagger_cycles = 0) {
    const int tid = opaque_tid(), wid = __builtin_amdgcn_readfirstlane(tid >> 6), lane = tid & 63, wr = wid >> 2, wc = wid & 3, fr = lane & 15, fq = lane >> 4;
    const int nt = K / BK;
    unsigned voff[2];
#pragma unroll
    for (int i = 0; i < 2; ++i) { int R, C; stage_rc(tid * 16 + i * 8192, R, C); voff[i] = (unsigned)(R * K + C) * 2u; }
    const size_t kstep = (size_t)(BK * 2);
    const size_t hstep = (size_t)HALF * K * 2;
    const size_t tstep = 2 * hstep;
    const unsigned ldsw = (unsigned)wid * 1024u;
    const int aoff = lds_byte(wr * 64 + fr, fq * 8), boff = lds_byte(wc * 32 + fr, fq * 8);
#define PG8_SA(b, h) (((b) * 2 + (h)) * HTB)
#define PG8_SB(b, h) ((4 + (b) * 2 + (h)) * HTB)
#define PG8_STAGE(bufoff, gbase) do { _Pragma("unroll") for (int _i = 0; _i < 2; ++_i) \
        __builtin_amdgcn_global_load_lds((const GLB_AS void*)((const char*)(gbase) + voff[_i]), (LDS_AS void*)(lds + (bufoff) + ldsw + _i * 8192), 16, 0, 0); } while (0)
#define PG8_LDA(dst, b, h) do { _Pragma("unroll") for (int m = 0; m < 4; ++m) _Pragma("unroll") for (int k = 0; k < 2; ++k) dst[m][k] = *(const LDS_AS bf16x8*)(lds + PG8_SA(b, h) + aoff + m * 2048 + k * 1024); } while (0)
#define PG8_LDB(dst, b, h) do { _Pragma("unroll") for (int n = 0; n < 2; ++n) _Pragma("unroll") for (int k = 0; k < 2; ++k) dst[n][k] = *(const LDS_AS bf16x8*)(lds + PG8_SB(b, h) + boff + n * 2048 + k * 1024); } while (0)
#define PG8_MMA(ai, bj, At, Bt) do { __builtin_amdgcn_s_setprio(1); _Pragma("unroll") for (int m = 0; m < 4; ++m) _Pragma("unroll") for (int n = 0; n < 2; ++n) _Pragma("unroll") for (int k = 0; k < 2; ++k) \
        acc[ai][bj][m][n] = __builtin_amdgcn_mfma_f32_16x16x32_bf16(Bt[n][k], At[m][k], acc[ai][bj][m][n], 0, 0, 0); __builtin_amdgcn_s_setprio(0); } while (0)
#define PG8_WAIT_V(n) asm volatile("s_waitcnt vmcnt(" #n ")" ::: "memory")
#define PG8_WAIT_L(n) asm volatile("s_waitcnt lgkmcnt(" #n ")" ::: "memory")
#define PG8_BAR __builtin_amdgcn_s_barrier()
#define PG8_SCHED __builtin_amdgcn_sched_barrier(0)
#define PG8_STAGE_A(bufoff, gbase, VA) do { _Pragma("unroll") for (int _i = 0; _i < 2; ++_i) \
        __builtin_amdgcn_global_load_lds((const GLB_AS void*)((const char*)(gbase) + (VA)[_i]), (LDS_AS void*)(lds + (bufoff) + ldsw + _i * 8192), 16, 0, 0); } while (0)
    int Rr[2], Cc[2];
#pragma unroll
    for (int i = 0; i < 2; ++i) stage_rc(tid * 16 + i * 8192, Rr[i], Cc[i]);
    unsigned va0[2], va1[2], vn0[2], vn1[2];
    Unit cur, nxt; int ui = 0;
    if (!S.next(0, cur)) return;
    if constexpr (GATHER) {
#pragma unroll
        for (int i = 0; i < 2; ++i) { va0[i] = S.arow(cur, Rr[i]) + (unsigned)Cc[i] * 2u; va1[i] = S.arow(cur, 128 + Rr[i]) + (unsigned)Cc[i] * 2u; }
    } else {
#pragma unroll
        for (int i = 0; i < 2; ++i) { va0[i] = voff[i]; va1[i] = voff[i] + (unsigned)hstep; }
    }
#pragma unroll
    for (int i = 0; i < 2; ++i) { vn0[i] = va0[i]; vn1[i] = va1[i]; }
    if (stagger_cycles > 0) {
        const int lvl = (blockIdx.x >> 3) & 31;
        for (int q = 0; q < lvl * stagger_cycles; ++q) __builtin_amdgcn_s_sleep(15);
    }
    f32x4 acc[2][2][4][2];
#pragma unroll
    for (int a = 0; a < 2; ++a)
#pragma unroll
        for (int b = 0; b < 2; ++b)
#pragma unroll
            for (int m = 0; m < 4; ++m)
#pragma unroll
                for (int n = 0; n < 2; ++n) acc[a][b][m][n] = (f32x4){0.f, 0.f, 0.f, 0.f};
    bf16x8 At[4][2], B0[2][2], B1[2][2];
    const char* cA = GATHER ? cur.A : cur.A + (size_t)cur.pm * tstep; const char* cB = cur.Bt + (size_t)cur.pn * tstep;
    PG8_STAGE(PG8_SB(0, 0), cB); PG8_STAGE(PG8_SB(0, 1), cB + hstep); PG8_STAGE_A(PG8_SA(0, 0), cA, va0); PG8_STAGE_A(PG8_SA(0, 1), cA, va1);
    if (wr == 1) PG8_BAR;
    PG8_WAIT_V(2); PG8_BAR;
    PG8_STAGE(PG8_SB(1, 0), cB + kstep); PG8_STAGE_A(PG8_SA(1, 0), cA + kstep, va0); PG8_STAGE(PG8_SB(1, 1), cB + hstep + kstep);
    PG8_WAIT_V(6); PG8_BAR;
    for (;;) {
        const bool has_next = S.next(ui + 1, nxt);
        const char* nA = has_next ? (GATHER ? nxt.A : nxt.A + (size_t)nxt.pm * tstep) : cA; const char* nB = has_next ? nxt.Bt + (size_t)nxt.pn * tstep : cB;
        if constexpr (GATHER) {
            if (has_next) {
#pragma unroll
                for (int i = 0; i < 2; ++i) { vn0[i] = S.arow(nxt, Rr[i]) + (unsigned)Cc[i] * 2u; vn1[i] = S.arow(nxt, 128 + Rr[i]) + (unsigned)Cc[i] * 2u; }
            }
        }
        for (int t = 0; t < nt; t += 2) {
            const bool last = (t == nt - 2);
            const char* a1 = cA + (size_t)(t + 1) * kstep;
            const char* a2 = last ? nA : cA + (size_t)(t + 2) * kstep; const char* b2 = last ? nB : cB + (size_t)(t + 2) * kstep;
            const char* a3 = a2 + kstep; const char* b3 = b2 + kstep;
            unsigned w0[2], w1[2];
#pragma unroll
            for (int i = 0; i < 2; ++i) { w0[i] = last ? vn0[i] : va0[i]; w1[i] = last ? vn1[i] : va1[i]; }
            PG8_LDB(B0, 0, 0); PG8_LDB(B1, 0, 1); PG8_SCHED; PG8_LDA(At, 0, 0); PG8_STAGE_A(PG8_SA(1, 1), a1, va1);
            PG8_WAIT_V(8); PG8_WAIT_L(0); PG8_BAR; PG8_MMA(0, 0, At, B0); PG8_MMA(0, 1, At, B1); PG8_BAR; PG8_SCHED;
            PG8_LDA(At, 0, 1); PG8_STAGE(PG8_SB(0, 0), b2); PG8_STAGE(PG8_SB(0, 1), b2 + hstep); PG8_STAGE_A(PG8_SA(0, 0), a2, w0);
            PG8_WAIT_V(8); PG8_WAIT_L(0); PG8_BAR; PG8_MMA(1, 0, At, B0); PG8_MMA(1, 1, At, B1); PG8_BAR; PG8_SCHED;
            PG8_LDB(B0, 1, 0); PG8_LDB(B1, 1, 1); PG8_SCHED; PG8_LDA(At, 1, 0); PG8_STAGE_A(PG8_SA(0, 1), a2, w1);
            PG8_WAIT_V(8); PG8_WAIT_L(0); PG8_BAR; PG8_MMA(0, 0, At, B0); PG8_MMA(0, 1, At, B1); PG8_BAR; PG8_SCHED;
            PG8_LDA(At, 1, 1); PG8_STAGE(PG8_SB(1, 0), b3); PG8_STAGE(PG8_SB(1, 1), b3 + hstep); PG8_STAGE_A(PG8_SA(1, 0), a3, w0);
            PG8_WAIT_V(8); PG8_WAIT_L(0); PG8_BAR; PG8_MMA(1, 0, At, B0); PG8_MMA(1, 1, At, B1); PG8_BAR; PG8_SCHED;
        }
        if (wr == 0) PG8_BAR;
        E(acc, cur, wr, wc, fr, fq);
        if (!has_next) break;
        if (!(cur.aux & 0x100)) {
#pragma unroll
        for (int a = 0; a < 2; ++a)
#pragma unroll
            for (int b = 0; b < 2; ++b)
#pragma unroll
                for (int m = 0; m < 4; ++m)
#pragma unroll
                    for (int n = 0; n < 2; ++n) acc[a][b][m][n] = (f32x4){0.f, 0.f, 0.f, 0.f};
        }
        cur = nxt; cA = nA; cB = nB; ++ui;
#pragma unroll
        for (int i = 0; i < 2; ++i) { va0[i] = vn0[i]; va1[i] = vn1[i]; }
        if (wr == 1) PG8_BAR;
    }
    PG8_WAIT_V(0);
    PG8_BAR;
#undef PG8_SA
#undef PG8_SB
#undef PG8_STAGE
#undef PG8_STAGE_A
#undef PG8_LDA
#undef PG8_LDB
#undef PG8_MMA
#undef PG8_WAIT_V
#undef PG8_WAIT_L
#undef PG8_BAR
#undef PG8_SCHED
}
}

__device__ __forceinline__ int perm32(int rho) { const int n = rho >> 4, i = rho & 15; return 8 * (i >> 2) + 4 * n + (i & 3); }
template <bool PERM>
__device__ __forceinline__ void tr_tile_t(const float* src, size_t ld_src, int k0, int c0, bf16_t* dst, size_t ld_dst, int r0, float* tile, int tid) {
    {
        const int r = tid >> 3, c4 = (tid & 7) * 4;
        const float4 v = *(const float4*)(src + (size_t)(k0 + r) * ld_src + c0 + c4);
        float* tp = tile + r * 33 + c4; tp[0] = v.x; tp[1] = v.y; tp[2] = v.z; tp[3] = v.w;
    }
    __syncthreads();
    {
        const int c = tid >> 4, rc = (tid & 15) * 4, sc = PERM ? perm32(c) : c;
        const float a0 = tile[(rc + 0) * 33 + sc], a1 = tile[(rc + 1) * 33 + sc], a2 = tile[(rc + 2) * 33 + sc], a3 = tile[(rc + 3) * 33 + sc];
        uint2 w; w.x = pk_bf16(a0, a1); w.y = pk_bf16(a2, a3);
        *(uint2*)(dst + (size_t)(r0 + c) * ld_dst + k0 + rc) = w;
    }
    __syncthreads();
}
template <bool PERM>
__device__ __forceinline__ void tr_tile4(const float* const (&src)[4], const int (&c0)[4], size_t ld_src, int k0, bf16_t* dst, size_t ld_dst, int r0, float* tile, int tid) {
    {
        const int r = tid >> 3, c4 = (tid & 7) * 4;
        float4 v[4];
#pragma unroll
        for (int g = 0; g < 4; ++g) v[g] = *(const float4*)(src[g] + (size_t)(k0 + r) * ld_src + c0[g] + c4);
#pragma unroll
        for (int g = 0; g < 4; ++g) { float* tp = tile + r * 129 + g * 32 + c4; tp[0] = v[g].x; tp[1] = v[g].y; tp[2] = v[g].z; tp[3] = v[g].w; }
    }
    __syncthreads();
    {
        const int c = tid >> 4, rc = (tid & 15) * 4, sc = PERM ? perm32(c) : c;
#pragma unroll
        for (int g = 0; g < 4; ++g) {
            const float a0 = tile[(rc + 0) * 129 + g * 32 + sc], a1 = tile[(rc + 1) * 129 + g * 32 + sc], a2 = tile[(rc + 2) * 129 + g * 32 + sc], a3 = tile[(rc + 3) * 129 + g * 32 + sc];
            uint2 w; w.x = pk_bf16(a0, a1); w.y = pk_bf16(a2, a3);
            *(uint2*)(dst + (size_t)(r0 + g * 32 + c) * ld_dst + k0 + rc) = w;
        }
    }
    __syncthreads();
}
__device__ __forceinline__ void tr_tile2(const float* srca, int c0a, const float* srcb, int c0b, size_t ld_src, int k0, bf16_t* dst, size_t ld_dst, int r0, float* tile, int tid) {
    {
        const int r = tid >> 3, c4 = (tid & 7) * 4;
        const float* sp = c4 < 16 ? srca + (size_t)(k0 + r) * ld_src + c0a + c4 : srcb + (size_t)(k0 + r) * ld_src + c0b + (c4 - 16);
        const float4 v = *(const float4*)sp;
        float* tp = tile + r * 33 + c4; tp[0] = v.x; tp[1] = v.y; tp[2] = v.z; tp[3] = v.w;
    }
    __syncthreads();
    {
        const int c = tid >> 4, rc = (tid & 15) * 4;
        const float a0 = tile[(rc + 0) * 33 + c], a1 = tile[(rc + 1) * 33 + c], a2 = tile[(rc + 2) * 33 + c], a3 = tile[(rc + 3) * 33 + c];
        uint2 w; w.x = pk_bf16(a0, a1); w.y = pk_bf16(a2, a3);
        *(uint2*)(dst + (size_t)(r0 + c) * ld_dst + k0 + rc) = w;
    }
    __syncthreads();
}

__device__ __forceinline__ void phase0(const Params& p, char* smem, const int parts = 7) {
    const int tid = opaque_tid(), lane = tid & 63, wid = tid >> 6;
    const int gw = blockIdx.x * 8 + wid, nw = gridDim.x * 8;
    char* ws = uni(p.ws);
    bf16_t* xb = (bf16_t*)(ws + OFF_R0);
    if (parts & 1) {
        const float* xg = uni(p.x);
        for (int row = gw * 2; row < T_; row += nw * 2) {
            float4 v[8];
#pragma unroll
            for (int i = 0; i < 8; ++i) v[i] = ((const float4*)(xg + (size_t)(row + (i >> 2)) * 1024))[(i & 3) * 64 + lane];
#pragma unroll
            for (int i = 0; i < 8; ++i) {
                uint2 w; w.x = pk_bf16(v[i].x, v[i].y); w.y = pk_bf16(v[i].z, v[i].w);
                *(uint2*)(xb + (size_t)(row + (i >> 2)) * 1024 + (i & 3) * 256 + lane * 4) = w;
            }
        }
    }
    if (parts & 2) {
        float2* cs = (float2*)(ws + OFF_CS);
        const int gt = blockIdx.x * NTHR + tid, nt = gridDim.x * NTHR;
        for (int idx = gt; idx < T_ * 32; idx += nt) {
            const int tok = idx >> 5, i = idx & 31;
            const double ang = (double)uni(p.pos)[tok] * INV_FREQ[i];
            const double turns = ang * 0.15915494309189535;
            const float f = (float)(turns - rint(turns));
            cs[idx] = make_float2(__builtin_amdgcn_cosf(f), __builtin_amdgcn_sinf(f));
        }
        bf16_t* memb = (bf16_t*)(ws + OFF_MEMB);
        for (int idx = gt; idx < 4096 * 1024 / 4; idx += nt) {
            const float4 v = ((const float4*)uni(p.mem))[idx];
            uint2 w; w.x = pk_bf16(v.x, v.y); w.y = pk_bf16(v.z, v.w);
            ((uint2*)memb)[idx] = w;
        }
    }
    if (parts & 4) {
        float* tile = (float*)smem;
        const int NQ_WIN = 16 * 50, NQ_SQ = 16 * 8, NQ_XKV = 16 * 16;
        const int total = NQ_WIN + 5 * NQ_SQ + NQ_XKV + 16;
        const float* win = uni(p.w_in);
        for (int t = blockIdx.x; t < total; t += gridDim.x) {
            if (t < NQ_WIN) {
                const int kt = t & 15, qd = t >> 4;
                const float* srcs[4] = {win, win, win, win}; int c0[4];
#pragma unroll
                for (int g = 0; g < 4; ++g) {
                    const int n0 = (qd * 4 + g) * 32;
                    if (n0 < 1280) { const int pn = n0 >> 8, bj = (n0 >> 7) & 1, wc = (n0 >> 5) & 3; c0[g] = (4 * pn + wc) * 64 + 32 * bj; }
                    else c0[g] = n0 < 4352 ? n0 : n0 + 8;
                }
                tr_tile4<true>(srcs, c0, 6408, kt * 64, (bf16_t*)(ws + OFF_WIN), 1024, qd * 128, tile, tid);
            } else if (t < NQ_WIN + 5 * NQ_SQ) {
                const int u = t - NQ_WIN, which = u / NQ_SQ, v = u % NQ_SQ, kt = v & 15, qd = v >> 4;
                const float* src = which == 0 ? uni(p.w_att) : which == 1 ? uni(p.w_ml) : which == 2 ? uni(p.w_mix) : which == 3 ? uni(p.w_xq) : uni(p.w_xo);
                const float* srcs[4] = {src, src, src, src}; const int c0[4] = {qd * 128, qd * 128 + 32, qd * 128 + 64, qd * 128 + 96};
                tr_tile4<true>(srcs, c0, 1024, kt * 64, (bf16_t*)(ws + OFF_WATT + (size_t)which * 2 * MiB), 1024, qd * 128, tile, tid);
            } else if (t < NQ_WIN + 5 * NQ_SQ + NQ_XKV) {
                const int v = t - NQ_WIN - 5 * NQ_SQ, kt = v & 15, qd = v >> 4;
                const float* src = uni(p.w_xkv);
                const float* srcs[4] = {src, src, src, src}; const int c0[4] = {qd * 128, qd * 128 + 32, qd * 128 + 64, qd * 128 + 96};
                if (qd < 8) tr_tile4<true>(srcs, c0, 2048, kt * 64, (bf16_t*)(ws + OFF_WXKV), 1024, qd * 128, tile, tid);
                else tr_tile4<false>(srcs, c0, 2048, kt * 64, (bf16_t*)(ws + OFF_WXKV), 1024, qd * 128, tile, tid);
            } else {
                const int kt = t - (NQ_WIN + 5 * NQ_SQ + NQ_XKV);
                tr_tile_t<true>(win, 6408, kt * 64, 4352, (bf16_t*)(ws + OFF_WIN), 1024, 6400, tile, tid);
            }
        }
    }
}

__device__ __forceinline__ void moe_weight_prep(const Params& p, char* smem, int first, int stride) {
    const int tid = opaque_tid();
    float* tile = (float*)smem;
    char* ws = uni(p.ws);
    const int per_e = 96, total = 64 * per_e;
    __syncthreads();
    for (int t = first; t < total; t += stride) {
        const int e = t / per_e, u = t % per_e;
        if (u < 64) {
            const int kt = u & 15, qd = u >> 4, pn = qd >> 1, bj = qd & 1;
            const float* src = (bj ? uni(p.w_up) : uni(p.w_gate)) + (size_t)e * 1024 * 256;
            const float* srcs[4] = {src, src, src, src}; const int c0[4] = {pn * 128, pn * 128 + 32, pn * 128 + 64, pn * 128 + 96};
            tr_tile4<true>(srcs, c0, 256, kt * 64, (bf16_t*)(ws + OFF_WGU) + (size_t)e * 512 * 1024, 1024, qd * 128, tile, tid);
        } else {
            const int v = u - 64, kt = v & 3, qd = v >> 2;
            const float* dsrc = uni(p.w_down) + (size_t)e * 256 * 1024;
            const float* srcs[4] = {dsrc, dsrc, dsrc, dsrc}; const int c0[4] = {qd * 128, qd * 128 + 32, qd * 128 + 64, qd * 128 + 96};
            tr_tile4<true>(srcs, c0, 1024, kt * 64, (bf16_t*)(ws + OFF_WD) + (size_t)e * 1024 * 256, 256, qd * 128, tile, tid);
        }
    }
}

struct SchedP1 {
    int G, c; const char *xb, *win, *memb, *wxkv;
    __device__ __forceinline__ bool next(int i, pg8::Unit& u) const {
        int nmain, uidx;
        if (G == 256) { nmain = 26; const int x = c & 7, j = c >> 3; uidx = i * 32 + j; if (i < 26) { const int g = uidx / 104, v = uidx % 104; u.pm = 32 * x + 4 * g + (v & 3); u.pn = v >> 2; } }
        else { nmain = c < 6656 ? (6656 - 1 - c) / G + 1 : 0; uidx = i * G + c; if (i < nmain) { u.pm = uidx / 26; u.pn = uidx % 26; } }
        if (i < nmain) { u.aux = 0; u.A = xb; u.Bt = win; return true; }
        const int kv = c + (i - nmain) * G;
        if (kv >= 128) return false;
        if (kv < 64) { u.aux = 1; u.pm = kv >> 2; u.pn = kv & 3; u.A = memb; u.Bt = wxkv; }
        else { const int k2 = kv - 64; u.aux = 2; u.pm = k2 >> 4; u.pn = k2 & 15; u.A = wxkv + (size_t)1024 * 1024 * 2; u.Bt = memb; }
        return true;
    }
};

struct EpiP1 {
    char* ws; int skip;
    __device__ __forceinline__ void operator()(f32x4 (&acc)[2][2][4][2], const pg8::Unit& u, int wr, int wc, int fr, int fq) const {
        if (skip == 1) {
#pragma unroll
            for (int a = 0; a < 2; ++a)
#pragma unroll
                for (int b = 0; b < 2; ++b)
#pragma unroll
                    for (int m = 0; m < 4; ++m) { asm volatile("" :: "v"(acc[a][b][m][0]), "v"(acc[a][b][m][1])); }
            return;
        }
        const int row0 = u.pm * 256 + wr * 64 + fr;
        if (u.aux == 0 && u.pn < 5) {
            const int hidx = 4 * u.pn + wc;
            if (hidx < 18) {
                bf16_t* dst; int ld, cb; float sc;
                if (hidx < 16) { dst = (bf16_t*)(ws + OFF_R1); ld = 1024; cb = hidx * 64; sc = 0.125f; }
                else { dst = (bf16_t*)(ws + OFF_AK); ld = 128; cb = (hidx - 16) * 64; sc = 1.0f; }
                const float* cs = (const float*)(ws + OFF_CS);
                const int d1 = 8 * fq;
#pragma unroll
                for (int ai = 0; ai < 2; ++ai)
#pragma unroll
                    for (int m = 0; m < 4; ++m) {
                        const int tok = row0 + ai * 128 + m * 16;
                        const float4* cp = (const float4*)(cs + (size_t)tok * 64 + d1 * 2);
                        const float4 c0 = cp[0], c1 = cp[1], c2 = cp[2], c3 = cp[3];
                        const f32x4 x1a = acc[ai][0][m][0], x1b = acc[ai][0][m][1], x2a = acc[ai][1][m][0], x2b = acc[ai][1][m][1];
                        f32x4 o1a, o1b, o2a, o2b;
                        o1a[0] = (x1a[0] * c0.x - x2a[0] * c0.y) * sc; o2a[0] = (x2a[0] * c0.x + x1a[0] * c0.y) * sc;
                        o1a[1] = (x1a[1] * c0.z - x2a[1] * c0.w) * sc; o2a[1] = (x2a[1] * c0.z + x1a[1] * c0.w) * sc;
                        o1a[2] = (x1a[2] * c1.x - x2a[2] * c1.y) * sc; o2a[2] = (x2a[2] * c1.x + x1a[2] * c1.y) * sc;
                        o1a[3] = (x1a[3] * c1.z - x2a[3] * c1.w) * sc; o2a[3] = (x2a[3] * c1.z + x1a[3] * c1.w) * sc;
                        o1b[0] = (x1b[0] * c2.x - x2b[0] * c2.y) * sc; o2b[0] = (x2b[0] * c2.x + x1b[0] * c2.y) * sc;
                        o1b[1] = (x1b[1] * c2.z - x2b[1] * c2.w) * sc; o2b[1] = (x2b[1] * c2.z + x1b[1] * c2.w) * sc;
                        o1b[2] = (x1b[2] * c3.x - x2b[2] * c3.y) * sc; o2b[2] = (x2b[2] * c3.x + x1b[2] * c3.y) * sc;
                        o1b[3] = (x1b[3] * c3.z - x2b[3] * c3.w) * sc; o2b[3] = (x2b[3] * c3.z + x1b[3] * c3.w) * sc;
                        bf16_t* rp = dst + (size_t)tok * ld + cb + d1;
                        if (skip == 2) { asm volatile("" :: "v"(o1a), "v"(o1b), "v"(o2a), "v"(o2b)); } else { store_bf16x8(rp, o1a, o1b); store_bf16x8(rp + 32, o2a, o2b); }
                    }
            } else {
                bf16_t* avT = (bf16_t*)(ws + OFF_AV);
#pragma unroll
                for (int bj = 0; bj < 2; ++bj)
#pragma unroll
                    for (int ai = 0; ai < 2; ++ai)
#pragma unroll
                        for (int m = 0; m < 4; ++m)
#pragma unroll
                            for (int n = 0; n < 2; ++n)
#pragma unroll
                                for (int j = 0; j < 4; ++j)
                                    avT[(size_t)((hidx - 18) * 64 + 32 * bj + 8 * fq + 4 * n + j) * T_ + row0 + ai * 128 + m * 16] = (bf16_t)(pk_bf16(acc[ai][bj][m][n][j], acc[ai][bj][m][n][j]) & 0xffffu);
            }
            return;
        }
#pragma unroll
        for (int bj = 0; bj < 2; ++bj) {
            const int c32 = u.pn * 256 + bj * 128 + wc * 32;
            if (u.aux == 0 && c32 >= 6400) {
                if (c32 == 6400 && fq == 0) {
                    float* gates = (float*)(ws + OFF_GATES);
#pragma unroll
                    for (int ai = 0; ai < 2; ++ai)
#pragma unroll
                        for (int m = 0; m < 4; ++m) {
                            const f32x4 v0 = acc[ai][bj][m][0], v1 = acc[ai][bj][m][1];
                            float4* gp = (float4*)(gates + (size_t)(row0 + ai * 128 + m * 16) * 8);
                            gp[0] = make_float4(v0[0], v0[1], v0[2], v0[3]); gp[1] = make_float4(v1[0], v1[1], v1[2], v1[3]);
                        }
                }
            } else if (u.aux == 2) {
                bf16_t* dst = (bf16_t*)(ws + OFF_VT);
#pragma unroll
                for (int ai = 0; ai < 2; ++ai)
#pragma unroll
                    for (int m = 0; m < 4; ++m) {
                        bf16_t* rp = dst + (size_t)(row0 + ai * 128 + m * 16) * 4096 + c32 + fq * 4;
                        store_bf16x4(rp, acc[ai][bj][m][0]); store_bf16x4(rp + 16, acc[ai][bj][m][1]);
                    }
            } else {
                bf16_t* dst; int ld, cb; bool sig = false;
                if (u.aux == 1) { dst = (bf16_t*)(ws + OFF_KMAT); ld = 1024; cb = c32; }
                else if (c32 < 2304) { dst = (bf16_t*)(ws + OFF_MQK); ld = 1024; cb = c32 - 1280; }
                else if (c32 < 3328) { dst = (bf16_t*)(ws + OFF_MV); ld = 1024; cb = c32 - 2304; }
                else if (c32 < 4352) { dst = (bf16_t*)(ws + OFF_MO); ld = 1024; cb = c32 - 3328; sig = true; }
                else { dst = (bf16_t*)(ws + OFF_GG); ld = 2048; cb = c32 - 4352; sig = true; }
#pragma unroll
                for (int ai = 0; ai < 2; ++ai)
#pragma unroll
                    for (int m = 0; m < 4; ++m) {
                        f32x4 v0 = acc[ai][bj][m][0], v1 = acc[ai][bj][m][1];
                        if (sig) {
                            v0[0] = sigmoidf_(v0[0]); v0[1] = sigmoidf_(v0[1]); v0[2] = sigmoidf_(v0[2]); v0[3] = sigmoidf_(v0[3]);
                            v1[0] = sigmoidf_(v1[0]); v1[1] = sigmoidf_(v1[1]); v1[2] = sigmoidf_(v1[2]); v1[3] = sigmoidf_(v1[3]);
                        }
                        if (skip == 2) { asm volatile("" :: "v"(v0), "v"(v1)); } else store_bf16x8(dst + (size_t)(row0 + ai * 128 + m * 16) * ld + cb + fq * 8, v0, v1);
                    }
            }
        }
    }
};

__device__ __forceinline__ void phase1(const Params& p, char* smem, int skip_epi = 0) {
    char* ws = uni(p.ws);
    SchedP1 S{(int)gridDim.x, (int)blockIdx.x, ws + OFF_R0, ws + OFF_WIN, ws + OFF_MEMB, ws + OFF_WXKV};
    EpiP1 E{ws, skip_epi};
    pg8::gemm_phase<EpiP1, SchedP1>((LDS_AS unsigned char*)smem, 1024, S, E, 0);
}

template <int NPASS>
struct SchedN1024 {
    int G, c; const char* A0; const char* B0; const char* A1; const char* B1;
    __device__ __forceinline__ bool next(int i, pg8::Unit& u) const {
        const int ti = i / NPASS, pass = i % NPASS;
        int uidx;
        if (G == 256) { if (ti >= 4) return false; const int x = c & 7, j = c >> 3; uidx = ti * 32 + j; u.pm = 32 * x + (uidx >> 2); u.pn = uidx & 3; }
        else { uidx = ti * G + c; if (uidx >= 1024) return false; u.pm = uidx >> 2; u.pn = uidx & 3; }
        u.aux = pass | ((NPASS == 2 && pass == 0) ? 0x100 : 0); u.A = pass ? A1 : A0; u.Bt = pass ? B1 : B0;
        return true;
    }
};

typedef short v4i16_t __attribute__((ext_vector_type(4)));
__device__ __forceinline__ int offQK(int row, int ch) { return row * 256 + ((ch ^ (((row & 3) << 2) | ((row >> 2) & 3))) << 4); }
__device__ __forceinline__ int offV(int row, int ch) { return row * 512 + ((ch ^ (((row & 3) | (((row >> 3) & 1) << 2)) << 1)) << 4); }
__device__ __forceinline__ int offSw(int row, int ch) { return row * 128 + ((ch ^ ((row >> 1) & 7)) << 4); }
__device__ __forceinline__ bf16x8 tr_read2(const char* p0, const char* p1) {
    const v4i16_t a = __builtin_amdgcn_ds_read_tr16_b64_v4i16((LDS_AS v4i16_t*)p0);
    const v4i16_t b = __builtin_amdgcn_ds_read_tr16_b64_v4i16((LDS_AS v4i16_t*)p1);
    return __builtin_shufflevector(a, b, 0, 1, 2, 3, 4, 5, 6, 7);
}
__device__ __forceinline__ float row16_sum(float v) {
    v += __builtin_bit_cast(float, __builtin_amdgcn_update_dpp(0, __builtin_bit_cast(int, v), 0xB1, 0xf, 0xf, true));
    v += __builtin_bit_cast(float, __builtin_amdgcn_update_dpp(0, __builtin_bit_cast(int, v), 0x4E, 0xf, 0xf, true));
    v += __builtin_bit_cast(float, __builtin_amdgcn_update_dpp(0, __builtin_bit_cast(int, v), 0x141, 0xf, 0xf, true));
    v += __builtin_bit_cast(float, __builtin_amdgcn_update_dpp(0, __builtin_bit_cast(int, v), 0x140, 0xf, 0xf, true));
    return v;
}

constexpr int PP_Q = 0, PP_K = 16384, PP_S = 32768, PP_REC = 40960, PP_EB = 41984, PP_EK = 42240, PP_CSP = 42496  , PP_RSP = 44544  , PP_END = 45056;
__device__ __forceinline__ void ml_prepass_item(const Params& p, char* smem, int item) {
    const int tid = opaque_tid(), lane = tid & 63, wid = tid >> 6, fr = lane & 15, fq = lane >> 4;
    const int c = item & 63, bh = item >> 6, b = bh >> 2, h = bh & 3;
    char* ws = uni(p.ws);
    const bf16_t* mqk = (const bf16_t*)(ws + OFF_MQK);
    const float* gates = (const float*)(ws + OFF_GATES);
    float* rec = (float*)(smem + PP_REC); float* eb = (float*)(smem + PP_EB); float* ek = (float*)(smem + PP_EK);
    float* csp = (float*)(smem + PP_CSP); float* rsp = (float*)(smem + PP_RSP);
    const long tok0 = (long)b * 4096 + c * 64;
    const int cp = tid & 127, tg = tid >> 7;
    const bool isk = cp >= 64;
    const int dch = isk ? 2 * (cp - 64) : 2 * cp;
    const int ccol = isk ? (512 + h * 128 + dch) : (h * 128 + dch);
    unsigned r[19];
#pragma unroll
    for (int i = 0; i < 19; ++i) {
        const int tl = tg * 16 - 3 + i;
        r[i] = (c == 0 && tl < 0) ? 0u : *(const unsigned*)(mqk + (tok0 + tl) * 1024 + ccol);
    }
    float cw0[4], cw1[4];
#pragma unroll
    for (int j = 0; j < 4; ++j) { cw0[j] = uni(p.conv_w)[j * 1024 + ccol]; cw1[j] = uni(p.conv_w)[j * 1024 + ccol + 1]; }
    const float cb0 = uni(p.conv_b)[ccol], cb1 = uni(p.conv_b)[ccol + 1];
    if (wid == 0) {
        const float mi0 = gates[(tok0 + lane) * 8 + h] + uni(p.b_ig)[h], x = gates[(tok0 + lane) * 8 + 4 + h] + uni(p.b_fg)[h];
        float bs = fminf(x, 0.f) - log1pf(__expf(-fabsf(x)));
#pragma unroll
        for (int o = 1; o < 64; o <<= 1) { const float y = __shfl_up(bs, o); if (lane >= o) bs += y; }
        eb[lane] = __expf(bs); ek[lane] = __expf(mi0 - bs);
        if (lane == 63) rec[192] = __expf(bs);
    }
    __syncthreads();
    {
        const int tt0 = tg * 16;
        float cs0 = 0.f, cs1 = 0.f;
        const float* scp = (isk ? ek : eb) + tt0;
        char* dstb = smem + (isk ? PP_K : PP_Q) + (dch & 7) * 2;
        const float kmul = isk ? 0.08838834764831845f : 1.0f;
#pragma unroll
        for (int tt = 0; tt < 16; ++tt) {
            float v0 = cb0 + cw0[0] * bf_lo(r[tt]) + cw0[1] * bf_lo(r[tt + 1]) + cw0[2] * bf_lo(r[tt + 2]) + cw0[3] * bf_lo(r[tt + 3]);
            float v1 = cb1 + cw1[0] * bf_hi(r[tt]) + cw1[1] * bf_hi(r[tt + 1]) + cw1[2] * bf_hi(r[tt + 2]) + cw1[3] * bf_hi(r[tt + 3]);
            v0 = v0 * sigmoidf_(v0); v1 = v1 * sigmoidf_(v1);
            const float sc = scp[tt] * kmul;
            const float a0 = v0 * sc, a1 = v1 * sc;
            *(unsigned*)(dstb + offQK(tt0 + tt, dch >> 3)) = pk_bf16(a0, a1);
            cs0 += a0; cs1 += a1;
        }
        if (isk) { csp[tg * 128 + dch] = cs0; csp[tg * 128 + dch + 1] = cs1; }
    }
    __syncthreads();
    {
        const int tt = wid >> 1;
        bf16x8 qf[4];
#pragma unroll
        for (int ks = 0; ks < 4; ++ks) qf[ks] = *(const bf16x8*)(smem + PP_Q + offQK(tt * 16 + fr, 4 * ks + fq));
        float rs = 0.f;
#pragma unroll
        for (int x = 0; x < 2; ++x) {
            const int st = (wid & 1) * 2 + x;
            f32x4 a = (f32x4){0.f, 0.f, 0.f, 0.f};
#pragma unroll
            for (int ks = 0; ks < 4; ++ks) {
                const bf16x8 kf = *(const bf16x8*)(smem + PP_K + offQK(st * 16 + fr, 4 * ks + fq));
                a = __builtin_amdgcn_mfma_f32_16x16x32_bf16(kf, qf[ks], a, 0, 0, 0);
            }
#pragma unroll
            for (int j = 0; j < 4; ++j) a[j] = (st * 16 + fq * 4 + j) <= (tt * 16 + fr) ? a[j] : 0.f;
            rs += (a[0] + a[1]) + (a[2] + a[3]);
            uint2 w; w.x = pk_bf16(a[0], a[1]); w.y = pk_bf16(a[2], a[3]);
            *(uint2*)(smem + PP_S + offSw(tt * 16 + fr, st * 2 + (fq >> 1)) + (fq & 1) * 8) = w;
        }
        rs += __shfl_xor(rs, 16); rs += __shfl_xor(rs, 32);
        if (fq == 0) rsp[(wid & 1) * 64 + tt * 16 + fr] = rs;
        if (tid < 128) rec[64 + tid] = (csp[tid] + csp[128 + tid]) + (csp[256 + tid] + csp[384 + tid]);
    }
    __syncthreads();
    if (tid < 64) rec[tid] = rsp[tid] + rsp[64 + tid];
    __syncthreads();
    {
        char* qp = (char*)uni(p.out) + OUT_QP + (size_t)item * 16384;
        char* kp = (char*)uni(p.out) + OUT_KP + (size_t)item * 16384;
        char* sp = ws + OFF_SP + (size_t)item * 8192;
        char* rp = ws + OFF_REC + (size_t)item * 1024;
#pragma unroll
        for (int i = 0; i < 2; ++i) {
            *(u32x4*)(qp + (i * 512 + tid) * 16) = *(const u32x4*)(smem + PP_Q + (i * 512 + tid) * 16);
            *(u32x4*)(kp + (i * 512 + tid) * 16) = *(const u32x4*)(smem + PP_K + (i * 512 + tid) * 16);
        }
        *(u32x4*)(sp + tid * 16) = *(const u32x4*)(smem + PP_S + tid * 16);
        if (tid < 64) *(u32x4*)(rp + tid * 16) = *(const u32x4*)(smem + PP_REC + tid * 16);
    }
    __syncthreads();
}

constexpr int SC_BUF = 41984;
constexpr int SC_V = 2 * SC_BUF;
constexpr int SC_NBF = SC_V + 65536;
constexpr int SC_END = SC_NBF + 512;
__device__ __forceinline__ void ml_scan(const Params& p, char* smem, int bh, const int mode = 0) {
    const int tid = opaque_tid(), lane = tid & 63, wid = tid >> 6, fr0 = lane & 15, fq0 = lane >> 4;
    const int b = bh >> 2, h = bh & 3;
    char* ws = uni(p.ws);
    const bf16_t* mv = (const bf16_t*)(ws + OFF_MV);
    bf16_t* hm = (bf16_t*)uni(p.out);
    float* ssqp = (float*)(ws + OFF_SSQP);
    const long tokb = (long)b * 4096;
    f32x4 C[8][2];
#pragma unroll
    for (int dt = 0; dt < 8; ++dt) { C[dt][0] = (f32x4){0.f, 0.f, 0.f, 0.f}; C[dt][1] = (f32x4){0.f, 0.f, 0.f, 0.f}; }
    const int vrl = tid >> 5, vpc = tid & 31, vlc = vpc ^ ((((vrl & 3) | (((vrl >> 3) & 1) << 2))) << 1);
    const bf16_t* vsrc = mv + (tokb + vrl) * 1024 + h * 256 + vlc * 8;
    const char* qp = (const char*)uni(p.out) + OUT_QP + (size_t)bh * 64 * 16384;
    const char* kp = (const char*)uni(p.out) + OUT_KP + (size_t)bh * 64 * 16384;
    const char* sp = ws + OFF_SP + (size_t)bh * 64 * 8192;
    const char* rp = ws + OFF_REC + (size_t)bh * 64 * 1024;
#define SC_STAGE(cc, bufoff) do { \
        _Pragma("unroll") for (int _i = 0; _i < 2; ++_i) { \
            glds16((const bf16_t*)(qp + (size_t)(cc) * 16384 + (_i * 512 + tid) * 16), smem + (bufoff) + (_i * 512 + tid) * 16); \
            glds16((const bf16_t*)(kp + (size_t)(cc) * 16384 + (_i * 512 + tid) * 16), smem + (bufoff) + 16384 + (_i * 512 + tid) * 16); } \
        glds16((const bf16_t*)(sp + (size_t)(cc) * 8192 + tid * 16), smem + (bufoff) + 32768 + tid * 16); \
        if (tid < 64) glds16((const bf16_t*)(rp + (size_t)(cc) * 1024 + tid * 16), smem + (bufoff) + 40960 + tid * 16); \
        _Pragma("unroll") for (int _i = 0; _i < 4; ++_i) glds16(vsrc + (long)(cc) * 64 * 1024 + (long)_i * 16 * 1024, smem + SC_V + ((cc) & 1) * 32768 + (_i * 512 + tid) * 16); } while (0)
    __syncthreads();
    if (tid < 256) ((bf16_t*)(smem + SC_NBF))[tid] = 0;
    float nreg = 0.f;
    SC_STAGE(0, 0);
    asm volatile("s_waitcnt vmcnt(0)" ::: "memory");
#pragma unroll 1
    for (int c = 0; c < 64; ++c) {
        const int par = c & 1;
        const long tok0 = tokb + c * 64;
        int fr = fr0, fq = fq0;
        asm volatile("" : "+v"(fr), "+v"(fq));
        const char* buf = smem + par * SC_BUF;
        asm volatile("s_waitcnt vmcnt(10) lgkmcnt(0)" ::: "memory");
        __builtin_amdgcn_s_barrier();
        if (c + 1 < 64 && !(mode & 1)) SC_STAGE(c + 1, (par ^ 1) * SC_BUF);
        f32x4 Y[4][2], DN[4];
#pragma unroll
        for (int tt = 0; tt < 4; ++tt) { Y[tt][0] = (f32x4){0.f, 0.f, 0.f, 0.f}; Y[tt][1] = (f32x4){0.f, 0.f, 0.f, 0.f}; DN[tt] = (f32x4){0.f, 0.f, 0.f, 0.f}; }
        const char* nbf = smem + SC_NBF + par * 256;
#pragma unroll
        for (int ks = 0; ks < 4; ++ks) {
            u32x4 c0, c1;
            c0[0] = pk_bf16(C[2 * ks][0][0], C[2 * ks][0][1]); c0[1] = pk_bf16(C[2 * ks][0][2], C[2 * ks][0][3]);
            c0[2] = pk_bf16(C[2 * ks + 1][0][0], C[2 * ks + 1][0][1]); c0[3] = pk_bf16(C[2 * ks + 1][0][2], C[2 * ks + 1][0][3]);
            c1[0] = pk_bf16(C[2 * ks][1][0], C[2 * ks][1][1]); c1[1] = pk_bf16(C[2 * ks][1][2], C[2 * ks][1][3]);
            c1[2] = pk_bf16(C[2 * ks + 1][1][0], C[2 * ks + 1][1][1]); c1[3] = pk_bf16(C[2 * ks + 1][1][2], C[2 * ks + 1][1][3]);
            const bf16x8 cf0 = __builtin_bit_cast(bf16x8, c0), cf1 = __builtin_bit_cast(bf16x8, c1);
            const u32x2 nlo = *(const u32x2*)(nbf + (32 * ks + 4 * fq) * 2), nhi = *(const u32x2*)(nbf + (32 * ks + 16 + 4 * fq) * 2);
            u32x4 nv; nv[0] = nlo[0]; nv[1] = nlo[1]; nv[2] = nhi[0]; nv[3] = nhi[1];
            const bf16x8 nb = __builtin_bit_cast(bf16x8, nv);
#pragma unroll
            for (int tt = 0; tt < 4; ++tt) {
                const int row = tt * 16 + fr;
                const u32x2 lo = *(const u32x2*)(buf + offQK(row, 4 * ks + (fq >> 1)) + (fq & 1) * 8);
                const u32x2 hi = *(const u32x2*)(buf + offQK(row, 4 * ks + 2 + (fq >> 1)) + (fq & 1) * 8);
                u32x4 av; av[0] = lo[0]; av[1] = lo[1]; av[2] = hi[0]; av[3] = hi[1];
                const bf16x8 af = __builtin_bit_cast(bf16x8, av);
                Y[tt][0] = __builtin_amdgcn_mfma_f32_16x16x32_bf16(af, cf0, Y[tt][0], 0, 0, 0);
                Y[tt][1] = __builtin_amdgcn_mfma_f32_16x16x32_bf16(af, cf1, Y[tt][1], 0, 0, 0);
                DN[tt] = __builtin_amdgcn_mfma_f32_16x16x32_bf16(af, nb, DN[tt], 0, 0, 0);
            }
        }
        const char* vb = smem + SC_V + par * 32768;
        bf16x8 vf[2][2];
#pragma unroll
        for (int ks = 0; ks < 2; ++ks)
#pragma unroll
            for (int et = 0; et < 2; ++et) {
                const int cidx = 2 * wid + et, ch = 2 * cidx + ((fr & 3) >> 1);
                const int r0 = 32 * ks + 8 * fq + (fr >> 2);
                vf[ks][et] = tr_read2(vb + offV(r0, ch) + 8 * (fr & 1), vb + offV(r0 + 4, ch) + 8 * (fr & 1));
            }
#pragma unroll
        for (int ks = 0; ks < 2; ++ks)
#pragma unroll
            for (int tt = 0; tt < 4; ++tt) {
                const bf16x8 sf = *(const bf16x8*)(buf + 32768 + offSw(tt * 16 + fr, 4 * ks + fq));
                Y[tt][0] = __builtin_amdgcn_mfma_f32_16x16x32_bf16(sf, vf[ks][0], Y[tt][0], 0, 0, 0);
                Y[tt][1] = __builtin_amdgcn_mfma_f32_16x16x32_bf16(sf, vf[ks][1], Y[tt][1], 0, 0, 0);
            }
        const float* recf = (const float*)(buf + 40960);
        float* sq_out = ssqp + ((size_t)(bh * 64 + c) * 8 + wid) * 64;
#pragma unroll
        for (int tt = 0; tt < 4; ++tt) {
            const float4 rsv = *(const float4*)(recf + tt * 16 + fq * 4);
            const float dd[4] = {rsv.x + DN[tt][0], rsv.y + DN[tt][1], rsv.z + DN[tt][2], rsv.w + DN[tt][3]};
            float sq[4];
#pragma unroll
            for (int j = 0; j < 4; ++j) {
                const float inv = __builtin_amdgcn_rcpf(fmaxf(fabsf(dd[j]), 1.0f));
                Y[tt][0][j] *= inv; Y[tt][1][j] *= inv;
                sq[j] = row16_sum(Y[tt][0][j] * Y[tt][0][j] + Y[tt][1][j] * Y[tt][1][j]);
            }
            if (!(mode & 4)) {
                if (fr == 0) *(float4*)(sq_out + tt * 16 + fq * 4) = make_float4(sq[0], sq[1], sq[2], sq[3]);
#pragma unroll
                for (int et = 0; et < 2; ++et) {
                    const int e = wid * 32 + et * 16 + fr;
                    store_bf16x4(hm + (tok0 + (e >> 2)) * 1024 + h * 256 + (e & 3) * 64 + tt * 16 + fq * 4, Y[tt][et]);
                }
            } else asm volatile("" :: "v"(Y[tt][0]), "v"(Y[tt][1]), "v"(sq[0]), "v"(sq[1]), "v"(sq[2]), "v"(sq[3]));
        }
#pragma unroll
        for (int dt = 0; dt < 8; ++dt)
#pragma unroll
            for (int ks = 0; ks < 2; ++ks) {
                const int ch = 2 * dt + ((fr & 3) >> 1);
                const int r0 = 32 * ks + 8 * fq + (fr >> 2);
                const bf16x8 kf = tr_read2(buf + 16384 + offQK(r0, ch) + 8 * (fr & 1), buf + 16384 + offQK(r0 + 4, ch) + 8 * (fr & 1));
                C[dt][0] = __builtin_amdgcn_mfma_f32_16x16x32_bf16(kf, vf[ks][0], C[dt][0], 0, 0, 0);
                C[dt][1] = __builtin_amdgcn_mfma_f32_16x16x32_bf16(kf, vf[ks][1], C[dt][1], 0, 0, 0);
                if (ks == 1 && (dt & 1)) __builtin_amdgcn_sched_barrier(0);
            }
        const float g = recf[192];
#pragma unroll
        for (int dt = 0; dt < 8; ++dt) { C[dt][0] *= g; C[dt][1] *= g; }
        if (tid < 128) {
            nreg = g * (nreg + recf[64 + (tid & 127)]);
            ((bf16_t*)(smem + SC_NBF + (par ^ 1) * 256))[tid] = (bf16_t)(pk_bf16(nreg, nreg) & 0xffffu);
        }
    }
    asm volatile("s_waitcnt vmcnt(0) lgkmcnt(0)" ::: "memory");
    __syncthreads();
#undef SC_STAGE
}

__device__ __forceinline__ void ml_finish_item(const Params& p, char* smem, int item) {
    const int tid = opaque_tid(), lane = tid & 63, wid = tid >> 6;
    const int c = item & 63, bh = item >> 6, b = bh >> 2, h = bh & 3;
    char* ws = uni(p.ws);
    bf16_t* hm = (bf16_t*)uni(p.out);
    const bf16_t* mo = (const bf16_t*)(ws + OFF_MO);
    const float* ssqp = (const float*)(ws + OFF_SSQP) + (size_t)item * 512;
    const float* gain = uni(p.ml_g) + h * 256;
    const long tok0 = (long)b * 4096 + c * 64;
    float* rs = (float*)(smem + 32768);
#pragma unroll
    for (int i = 0; i < 4; ++i) {
        const int q = i * 512 + tid;
        glds16(hm + (tok0 + (q >> 5)) * 1024 + h * 256 + (q & 31) * 8, smem + q * 16);
    }
    if (tid < 64) {
        float sacc = 0.f;
#pragma unroll
        for (int w = 0; w < 8; ++w) sacc += ssqp[w * 64 + tid];
        rs[tid] = rsqrtf(sacc * (1.0f / 256.0f) + 1e-6f);
    }
    asm volatile("s_waitcnt vmcnt(0)" ::: "memory");
    __syncthreads();
    const int i16 = lane & 15, g4 = lane >> 4, q4 = i16 >> 2, p4 = i16 & 3;
#pragma unroll
    for (int it = 0; it < 4; ++it) {
        const int combo = wid * 4 + it, tb = combo & 3, eoct = (combo >> 2) * 4 + g4;
        const int t = tb * 16 + i16, e = eoct * 8;
        const char* a0 = smem + (e + q4) * 128 + (tb * 16 + 4 * p4) * 2;
        const bf16x8 hv = tr_read2(a0, a0 + 4 * 128);
        const u32x4 hw = __builtin_bit_cast(u32x4, hv);
        const u32x4 mw = *(const u32x4*)(mo + (tok0 + t) * 1024 + h * 256 + e);
        const float4 ga = *(const float4*)(gain + e), gb = *(const float4*)(gain + e + 4);
        const float r = rs[t];
        u32x4 o;
        o[0] = pk_bf16(bf_lo(hw[0]) * r * ga.x * bf_lo(mw[0]), bf_hi(hw[0]) * r * ga.y * bf_hi(mw[0]));
        o[1] = pk_bf16(bf_lo(hw[1]) * r * ga.z * bf_lo(mw[1]), bf_hi(hw[1]) * r * ga.w * bf_hi(mw[1]));
        o[2] = pk_bf16(bf_lo(hw[2]) * r * gb.x * bf_lo(mw[2]), bf_hi(hw[2]) * r * gb.y * bf_hi(mw[2]));
        o[3] = pk_bf16(bf_lo(hw[3]) * r * gb.z * bf_lo(mw[3]), bf_hi(hw[3]) * r * gb.w * bf_hi(mw[3]));
        *(u32x4*)(hm + (tok0 + t) * 1024 + h * 256 + e) = o;
    }
    __syncthreads();
}

__device__ __forceinline__ void swa_stage(const bf16_t* ak, const bf16_t* avT, int item, char* kbuf, int tid) {
    const int kvh = item & 1, n = (item >> 1) & 31, b = item >> 6;
    const long tokbase = (long)b * 4096 + n * 128 - 128;
    const int rk = tid >> 3, pck = tid & 7, lck = pck ^ ((rk >> 1) & 7);
    const bf16_t* srck = ak + (tokbase + rk) * 128 + kvh * 64 + lck * 8;
#pragma unroll
    for (int i = 0; i < 4; ++i) glds16(srck + (long)i * 64 * 128, kbuf + (i * 512 + tid) * 16);
    const int rv = tid >> 5, pcv = tid & 31, lcv = pcv ^ (rv & 15);
    const bf16_t* srcv = avT + (long)(kvh * 64 + rv) * T_ + tokbase + lcv * 8;
#pragma unroll
    for (int i = 0; i < 4; ++i) glds16(srcv + (long)i * 16 * T_, kbuf + 32768 + (i * 512 + tid) * 16);
}
__device__ __forceinline__ const bf16_t* swa_qptr(const bf16_t* aq, int item, int u, int wid, int fr, int fq) {
    const int kvh = item & 1, n = (item >> 1) & 31, b = item >> 6;
    return aq + ((long)b * 4096 + n * 128 + u * 32 + fr) * 1024 + (kvh * 8 + wid) * 64 + fq * 8;
}
__device__ __forceinline__ void swa_items(const Params& p, char* smem, int first, int stride, int hi) {
    const int tid = opaque_tid(), lane = tid & 63, wid = tid >> 6, fr = lane & 15, fq = lane >> 4;
    char* ws = uni(p.ws);
    const bf16_t* aq = (const bf16_t*)(ws + OFF_R1);
    const bf16_t* ak = (const bf16_t*)(ws + OFF_AK);
    const bf16_t* avT = (const bf16_t*)(ws + OFF_AV);
    bf16_t* ao = (bf16_t*)(ws + OFF_R0);
    if (first >= hi) return;
    __syncthreads();
    swa_stage(ak, avT, first, smem, tid);
    bf16x8 qc[4];
    {
        const bf16_t* qp = swa_qptr(aq, first, 0, wid, fr, fq);
        qc[0] = *(const bf16x8*)(qp); qc[1] = *(const bf16x8*)(qp + 32); qc[2] = *(const bf16x8*)(qp + 16 * 1024); qc[3] = *(const bf16x8*)(qp + 16 * 1024 + 32);
    }
    int pb = 0;
    for (int item = first; item < hi; item += stride, pb ^= 1) {
        const int kvh = item & 1, n = (item >> 1) & 31, b = item >> 6;
        const int hq = kvh * 8 + wid;
        char* kbuf = smem + pb * 65536; char* vbuf = kbuf + 32768;
        const float sink = uni(p.sinks)[hq];
        asm volatile("s_waitcnt vmcnt(0)" ::: "memory");
        __syncthreads();
        const bool has_next = item + stride < hi;
        if (has_next) swa_stage(ak, avT, item + stride, smem + (pb ^ 1) * 65536, tid);
        const int kswz = (fr >> 1) & 7;
#pragma unroll 1
        for (int u = 0; u < 4; ++u) {
            const long tq = (long)b * 4096 + n * 128 + u * 32 + fr;
            bf16x8 qn[4];
            {
                const bool nx = (u < 3) || has_next;
                const bf16_t* qp = nx ? (u < 3 ? swa_qptr(aq, item, u + 1, wid, fr, fq) : swa_qptr(aq, item + stride, 0, wid, fr, fq)) : swa_qptr(aq, item, u, wid, fr, fq);
                qn[0] = *(const bf16x8*)(qp); qn[1] = *(const bf16x8*)(qp + 32); qn[2] = *(const bf16x8*)(qp + 16 * 1024); qn[3] = *(const bf16x8*)(qp + 16 * 1024 + 32);
            }
            f32x4 sc[10][2];
#pragma unroll
            for (int r = 0; r < 10; ++r) {
                sc[r][0] = (f32x4){0.f, 0.f, 0.f, 0.f}; sc[r][1] = (f32x4){0.f, 0.f, 0.f, 0.f};
                if (!(n == 0 && (2 * u + r) < 8)) {
                    const char* rowp = kbuf + ((2 * u + r) * 16 + fr) * 128;
                    const bf16x8 k0 = *(const bf16x8*)(rowp + ((fq ^ kswz) * 16)), k1 = *(const bf16x8*)(rowp + (((4 + fq) ^ kswz) * 16));
                    sc[r][0] = __builtin_amdgcn_mfma_f32_16x16x32_bf16(k0, qc[0], sc[r][0], 0, 0, 0);
                    sc[r][0] = __builtin_amdgcn_mfma_f32_16x16x32_bf16(k1, qc[1], sc[r][0], 0, 0, 0);
                    sc[r][1] = __builtin_amdgcn_mfma_f32_16x16x32_bf16(k0, qc[2], sc[r][1], 0, 0, 0);
                    sc[r][1] = __builtin_amdgcn_mfma_f32_16x16x32_bf16(k1, qc[3], sc[r][1], 0, 0, 0);
                }
            }
            u32x4 pf[2][5]; float linv[2];
#pragma unroll
            for (int nt = 0; nt < 2; ++nt) {
                float m = sink;
#pragma unroll
                for (int r = 0; r < 10; ++r) {
                    const bool tile_ok = !(n == 0 && (2 * u + r) < 8);
#pragma unroll
                    for (int j = 0; j < 4; ++j) {
                        const int delta = (r - nt) * 16 + fq * 4 + j - fr;
                        const bool ok = tile_ok && delta >= 1 && delta <= 128;
                        sc[r][nt][j] = ok ? sc[r][nt][j] : -INFINITY;
                        m = fmaxf(m, sc[r][nt][j]);
                    }
                }
                m = fmaxf(m, __shfl_xor(m, 16)); m = fmaxf(m, __shfl_xor(m, 32));
                float l = 0.f;
#pragma unroll
                for (int s2 = 0; s2 < 5; ++s2) {
                    float e[8];
#pragma unroll
                    for (int j = 0; j < 4; ++j) { e[j] = __expf(sc[2 * s2][nt][j] - m); e[4 + j] = __expf(sc[2 * s2 + 1][nt][j] - m); }
                    l += ((e[0] + e[1]) + (e[2] + e[3])) + ((e[4] + e[5]) + (e[6] + e[7]));
                    u32x4 w; w[0] = pk_bf16(e[0], e[1]); w[1] = pk_bf16(e[2], e[3]); w[2] = pk_bf16(e[4], e[5]); w[3] = pk_bf16(e[6], e[7]);
                    pf[nt][s2] = w;
                }
                l += __shfl_xor(l, 16); l += __shfl_xor(l, 32);
                linv[nt] = __builtin_amdgcn_rcpf(l + __expf(sink - m));
            }
            f32x4 o[4][2];
#pragma unroll
            for (int dt = 0; dt < 4; ++dt) { o[dt][0] = (f32x4){0.f, 0.f, 0.f, 0.f}; o[dt][1] = (f32x4){0.f, 0.f, 0.f, 0.f}; }
#pragma unroll
            for (int s2 = 0; s2 < 5; ++s2) {
                if (!(n == 0 && (2 * u + 2 * s2) < 8)) {
                    const int ca = ((((2 * u + 2 * s2) * 2 + (fq >> 1)) ^ fr) * 16) + (fq & 1) * 8;
                    const int cb = ((((2 * u + 2 * s2 + 1) * 2 + (fq >> 1)) ^ fr) * 16) + (fq & 1) * 8;
                    const bf16x8 p0 = __builtin_bit_cast(bf16x8, pf[0][s2]), p1 = __builtin_bit_cast(bf16x8, pf[1][s2]);
#pragma unroll
                    for (int dt = 0; dt < 4; ++dt) {
                        const char* rowp = vbuf + (dt * 16 + fr) * 512;
                        const u32x2 va = *(const u32x2*)(rowp + ca), vb = *(const u32x2*)(rowp + cb);
                        u32x4 vv; vv[0] = va[0]; vv[1] = va[1]; vv[2] = vb[0]; vv[3] = vb[1];
                        const bf16x8 vf = __builtin_bit_cast(bf16x8, vv);
                        o[dt][0] = __builtin_amdgcn_mfma_f32_16x16x32_bf16(vf, p0, o[dt][0], 0, 0, 0);
                        o[dt][1] = __builtin_amdgcn_mfma_f32_16x16x32_bf16(vf, p1, o[dt][1], 0, 0, 0);
                    }
                }
            }
#pragma unroll
            for (int nt = 0; nt < 2; ++nt) {
                bf16_t* rp = ao + (size_t)(tq + nt * 16) * 1024 + hq * 64 + fq * 4;
#pragma unroll
                for (int dt = 0; dt < 4; ++dt) store_bf16x4(rp + dt * 16, o[dt][nt] * linv[nt]);
            }
#pragma unroll
            for (int k = 0; k < 4; ++k) qc[k] = qn[k];
        }
    }
    asm volatile("s_waitcnt vmcnt(0)" ::: "memory");
    __syncthreads();
}

constexpr int SWA_A = 0;
__device__ __forceinline__ void phase2a(const Params& p, char* smem, int which = 3) {
    const int G = gridDim.x;
    if (which & 1) for (int it = blockIdx.x; it < 4096; it += G) ml_prepass_item(p, smem, it);
    if (which & 2) swa_items(p, smem, blockIdx.x, G, SWA_A);
}
__device__ __forceinline__ void phase2c(const Params& p, char* smem) {
    for (int it = blockIdx.x; it < 4096; it += gridDim.x) ml_finish_item(p, smem, it);
}
__device__ __forceinline__ void phase2b(const Params& p, char* smem, int which = 3, const int mode = 0) {
    const int G = gridDim.x;
    if (G > 64) {
        if (blockIdx.x < 64) { if (which & 1) ml_scan(p, smem, blockIdx.x, mode); }
        else { if (which & 2) { swa_items(p, smem, SWA_A + blockIdx.x - 64, G - 64, 1024); moe_weight_prep(p, smem, blockIdx.x - 64, G - 64); } }
    } else {
        for (int it = blockIdx.x; it < 64; it += G) ml_scan(p, smem, it);
        swa_items(p, smem, SWA_A + blockIdx.x, G, 1024);
        moe_weight_prep(p, smem, blockIdx.x, G);
    }
}

struct EpiP3 {
    const bf16_t* gg; bf16_t* y;
    __device__ __forceinline__ void operator()(f32x4 (&acc)[2][2][4][2], const pg8::Unit& u, int wr, int wc, int fr, int fq) const {
        const int row0 = u.pm * 256 + wr * 64 + fr, col0 = u.pn * 256 + wc * 32 + fq * 8;
        const bool first = (u.aux & 1) == 0;
#pragma unroll
        for (int ai = 0; ai < 2; ++ai)
#pragma unroll
            for (int m = 0; m < 4; ++m) {
                const size_t tok = row0 + ai * 128 + m * 16;
#pragma unroll
                for (int bj = 0; bj < 2; ++bj) {
                    const int col = col0 + bj * 128;
                    const u32x4 gm = *(const u32x4*)(gg + tok * 2048 + 1024 + col);
                    float gmf[8] = {bf_lo(gm[0]), bf_hi(gm[0]), bf_lo(gm[1]), bf_hi(gm[1]), bf_lo(gm[2]), bf_hi(gm[2]), bf_lo(gm[3]), bf_hi(gm[3])};
                    if (first) {
                        const u32x4 ga = *(const u32x4*)(gg + tok * 2048 + col);
                        const float gaf[8] = {bf_lo(ga[0]), bf_hi(ga[0]), bf_lo(ga[1]), bf_hi(ga[1]), bf_lo(ga[2]), bf_hi(ga[2]), bf_lo(ga[3]), bf_hi(ga[3])};
#pragma unroll
                        for (int k = 0; k < 4; ++k) {
                            acc[ai][bj][m][0][k] *= gaf[k] * __builtin_amdgcn_rcpf(fmaxf(gmf[k], 1e-30f));
                            acc[ai][bj][m][1][k] *= gaf[4 + k] * __builtin_amdgcn_rcpf(fmaxf(gmf[4 + k], 1e-30f));
                        }
                    } else {
                        f32x4 v0, v1;
#pragma unroll
                        for (int k = 0; k < 4; ++k) { v0[k] = acc[ai][bj][m][0][k] * gmf[k]; v1[k] = acc[ai][bj][m][1][k] * gmf[4 + k]; }
                        store_bf16x8(y + tok * 1024 + col, v0, v1);
                    }
                }
                if (m & 1) __builtin_amdgcn_sched_barrier(0);
            }
    }
};
__device__ __forceinline__ void phase3(const Params& p, char* smem) {
    char* ws = uni(p.ws);
    SchedN1024<2> S{(int)gridDim.x, (int)blockIdx.x, ws + OFF_R0, ws + OFF_WATT, (const char*)uni(p.out), ws + OFF_WML};
    EpiP3 E{(const bf16_t*)(ws + OFF_GG), (bf16_t*)(ws + OFF_R1)};
    pg8::gemm_phase<EpiP3, SchedN1024<2>>((LDS_AS unsigned char*)smem, 1024, S, E);
}

struct EpiBf16 {
    bf16_t* outb; float scale;
    __device__ __forceinline__ void operator()(f32x4 (&acc)[2][2][4][2], const pg8::Unit& u, int wr, int wc, int fr, int fq) const {
        const int row0 = u.pm * 256 + wr * 64 + fr, col0 = u.pn * 256 + wc * 32 + fq * 8;
#pragma unroll
        for (int ai = 0; ai < 2; ++ai)
#pragma unroll
            for (int m = 0; m < 4; ++m) {
                const size_t tok = row0 + ai * 128 + m * 16;
#pragma unroll
                for (int bj = 0; bj < 2; ++bj) store_bf16x8(outb + tok * 1024 + col0 + bj * 128, acc[ai][bj][m][0] * scale, acc[ai][bj][m][1] * scale);
            }
    }
};
__device__ __forceinline__ void phase_gemm_bf16(const Params& p, char* smem, const bf16_t* A, const bf16_t* Bt, bf16_t* outb, float scale) {
    SchedN1024<1> S{(int)gridDim.x, (int)blockIdx.x, (const char*)A, (const char*)Bt, (const char*)A, (const char*)Bt};
    EpiBf16 E{outb, scale};
    pg8::gemm_phase<EpiBf16, SchedN1024<1>>((LDS_AS unsigned char*)smem, 1024, S, E);
}

__device__ __forceinline__ void ln_row(float4 (&v)[4], const float* g, const float* bta, int lane) {
    float s = 0.f;
#pragma unroll
    for (int i = 0; i < 4; ++i) s += (v[i].x + v[i].y) + (v[i].z + v[i].w);
    const float mu = wsum(s) * (1.0f / 1024.0f);
    float q = 0.f;
#pragma unroll
    for (int i = 0; i < 4; ++i) { const float a = v[i].x - mu, b = v[i].y - mu, c = v[i].z - mu, d = v[i].w - mu; q += (a * a + b * b) + (c * c + d * d); }
    const float rstd = rsqrtf(wsum(q) * (1.0f / 1024.0f) + 1e-5f);
#pragma unroll
    for (int i = 0; i < 4; ++i) {
        const float4 gg = *(const float4*)(g + i * 256 + lane * 4), bb = *(const float4*)(bta + i * 256 + lane * 4);
        v[i].x = (v[i].x - mu) * rstd * gg.x + bb.x; v[i].y = (v[i].y - mu) * rstd * gg.y + bb.y;
        v[i].z = (v[i].z - mu) * rstd * gg.z + bb.z; v[i].w = (v[i].w - mu) * rstd * gg.w + bb.w;
    }
}

__device__ __forceinline__ void phase_ln1(const Params& p) {
    const int tid_ = opaque_tid(); const int lane = tid_ & 63, wid = tid_ >> 6;
    float* z = uni(p.out); bf16_t* hb = (bf16_t*)(uni(p.ws) + OFF_R0);
    for (int row = blockIdx.x * 8 + wid; row < T_; row += gridDim.x * 8) {
        float4 v[4];
#pragma unroll
        for (int i = 0; i < 4; ++i) {
            const float4 xx = *(const float4*)(uni(p.x) + (size_t)row * 1024 + i * 256 + lane * 4);
            const uint2 mm = *(const uint2*)(hb + (size_t)row * 1024 + i * 256 + lane * 4);
            v[i].x = ALPHA * xx.x + bf_lo(mm.x); v[i].y = ALPHA * xx.y + bf_hi(mm.x); v[i].z = ALPHA * xx.z + bf_lo(mm.y); v[i].w = ALPHA * xx.w + bf_hi(mm.y);
        }
        ln_row(v, uni(p.ln1g), uni(p.ln1b), lane);
#pragma unroll
        for (int i = 0; i < 4; ++i) {
            uint2 w; w.x = pk_bf16(v[i].x, v[i].y); w.y = pk_bf16(v[i].z, v[i].w);
            *(uint2*)(hb + (size_t)row * 1024 + i * 256 + lane * 4) = w;
        }
    }
}

__device__ __forceinline__ void xa_stage_k(const bf16_t* kmat, int b, int h, int kh, char* buf, int tid) {
    const int rl = tid >> 5, pc = tid & 31, lc = pc ^ (rl & 15);
    const bf16_t* src = kmat + (size_t)(b * 256 + kh * 128 + rl) * 1024 + h * 256 + lc * 8;
#pragma unroll
    for (int i = 0; i < 8; ++i) glds16(src + (size_t)i * 16 * 1024, buf + (i * 512 + tid) * 16);
}
__device__ __forceinline__ void xa_stage_v(const bf16_t* vT, int b, int h, int vh, char* buf, int tid) {
    const int rl = tid >> 4, pc = tid & 15, lc = pc ^ (rl & 15);
    const bf16_t* src = vT + (size_t)(h * 256 + rl) * 4096 + b * 256 + vh * 128 + lc * 8;
#pragma unroll
    for (int i = 0; i < 8; ++i) glds16(src + (size_t)i * 32 * 4096, buf + (i * 512 + tid) * 16);
}

template <int KH>
__device__ __forceinline__ void xa_scores(f32x4 (&acc)[16][2], const char* buf, const bf16x8 (&qf)[2][8], int fr, int fq) {
#pragma unroll
    for (int ks = 0; ks < 8; ++ks) {
        const int ch = ((ks * 4 + fq) ^ fr) * 16;
#pragma unroll
        for (int mt = 0; mt < 8; ++mt) {
            const bf16x8 kf = *(const bf16x8*)(buf + (mt * 16 + fr) * 512 + ch);
            acc[KH * 8 + mt][0] = __builtin_amdgcn_mfma_f32_16x16x32_bf16(kf, qf[0][ks], acc[KH * 8 + mt][0], 0, 0, 0);
            acc[KH * 8 + mt][1] = __builtin_amdgcn_mfma_f32_16x16x32_bf16(kf, qf[1][ks], acc[KH * 8 + mt][1], 0, 0, 0);
        }
        if (ks & 1) __builtin_amdgcn_sched_barrier(0);
    }
}

template <int VH, int DH>
__device__ __forceinline__ void xa_pv(f32x4 (&o)[8][2], const u32x4 (&pf)[2][8], const char* buf, int fr, int fq) {
#pragma unroll
    for (int ks = 0; ks < 4; ++ks) {
        const int ca = ((ks * 4 + (fq >> 1)) ^ fr) * 16 + (fq & 1) * 8, cb = ((ks * 4 + 2 + (fq >> 1)) ^ fr) * 16 + (fq & 1) * 8;
        const bf16x8 p0 = __builtin_bit_cast(bf16x8, pf[0][VH * 4 + ks]), p1 = __builtin_bit_cast(bf16x8, pf[1][VH * 4 + ks]);
#pragma unroll
        for (int dt = 0; dt < 8; ++dt) {
            const char* rowp = buf + ((DH * 8 + dt) * 16 + fr) * 256;
            const u32x2 va = *(const u32x2*)(rowp + ca), vb = *(const u32x2*)(rowp + cb);
            u32x4 vv; vv[0] = va[0]; vv[1] = va[1]; vv[2] = vb[0]; vv[3] = vb[1];
            const bf16x8 vf = __builtin_bit_cast(bf16x8, vv);
            o[dt][0] = __builtin_amdgcn_mfma_f32_16x16x32_bf16(vf, p0, o[dt][0], 0, 0, 0);
            o[dt][1] = __builtin_amdgcn_mfma_f32_16x16x32_bf16(vf, p1, o[dt][1], 0, 0, 0);
        }
    }
}

__device__ __forceinline__ void phase6(const Params& p, char* smem) {
    const int tid = opaque_tid(), lane = tid & 63, wid = tid >> 6, fr = lane & 15, fq = lane >> 4;
    char* ws = uni(p.ws);
    const bf16_t* xq = (const bf16_t*)(ws + OFF_XQ);
    const bf16_t* kmat = (const bf16_t*)(ws + OFF_KMAT);
    const bf16_t* vT = (const bf16_t*)(ws + OFF_VT);
    bf16_t* og = (bf16_t*)(ws + OFF_O);
    char* bufA = smem; char* bufB = smem + 65536;
    const int G = gridDim.x;
    for (int idx = blockIdx.x; idx < 1024; idx += G) {
        int pair, qt;
        if (G == 256) { const int i = idx >> 8, blk = idx & 255, xcd = blk & 7, jj = blk >> 3; pair = (i * 8 + xcd) * 2 + (jj >> 4); qt = jj & 15; }
        else { pair = idx >> 4; qt = idx & 15; }
        const int b = pair >> 2, h = pair & 3;
        const int tok0 = b * 4096 + qt * 256 + wid * 32;
        xa_stage_k(kmat, b, h, 0, bufA, tid);
        xa_stage_k(kmat, b, h, 1, bufB, tid);
        const bf16_t* q0p = xq + (size_t)(tok0 + fr) * 1024 + h * 256 + fq * 8;
        const bf16_t* q1p = q0p + (size_t)16 * 1024;
        bf16x8 qf[2][8];
#pragma unroll
        for (int ks = 0; ks < 8; ++ks) { qf[0][ks] = *(const bf16x8*)(q0p + ks * 32); qf[1][ks] = *(const bf16x8*)(q1p + ks * 32); }
        f32x4 acc[16][2];
#pragma unroll
        for (int mt = 0; mt < 16; ++mt) { acc[mt][0] = (f32x4){0.f, 0.f, 0.f, 0.f}; acc[mt][1] = (f32x4){0.f, 0.f, 0.f, 0.f}; }
        asm volatile("s_waitcnt vmcnt(0)" ::: "memory");
        __syncthreads();
        xa_scores<0>(acc, bufA, qf, fr, fq);
        xa_scores<1>(acc, bufB, qf, fr, fq);
        __syncthreads();
        xa_stage_v(vT, b, h, 0, bufA, tid);
        xa_stage_v(vT, b, h, 1, bufB, tid);
        u32x4 pf[2][8]; float linv[2];
#pragma unroll
        for (int nt = 0; nt < 2; ++nt) {
            float m = -INFINITY;
#pragma unroll
            for (int mt = 0; mt < 16; ++mt) m = fmaxf(m, fmaxf(fmaxf(acc[mt][nt][0], acc[mt][nt][1]), fmaxf(acc[mt][nt][2], acc[mt][nt][3])));
            m = fmaxf(m, __shfl_xor(m, 16)); m = fmaxf(m, __shfl_xor(m, 32));
            float l = 0.f;
#pragma unroll
            for (int s2 = 0; s2 < 8; ++s2) {
                float e[8];
#pragma unroll
                for (int j = 0; j < 4; ++j) { e[j] = __expf(acc[2 * s2][nt][j] - m); e[4 + j] = __expf(acc[2 * s2 + 1][nt][j] - m); }
                l += ((e[0] + e[1]) + (e[2] + e[3])) + ((e[4] + e[5]) + (e[6] + e[7]));
                u32x4 w; w[0] = pk_bf16(e[0], e[1]); w[1] = pk_bf16(e[2], e[3]); w[2] = pk_bf16(e[4], e[5]); w[3] = pk_bf16(e[6], e[7]);
                pf[nt][s2] = w;
            }
            l += __shfl_xor(l, 16); l += __shfl_xor(l, 32);
            linv[nt] = 1.0f / l;
        }
        asm volatile("s_waitcnt vmcnt(0)" ::: "memory");
        __syncthreads();
        {
            f32x4 o[8][2];
#pragma unroll
            for (int dt = 0; dt < 8; ++dt) { o[dt][0] = (f32x4){0.f, 0.f, 0.f, 0.f}; o[dt][1] = (f32x4){0.f, 0.f, 0.f, 0.f}; }
            xa_pv<0, 0>(o, pf, bufA, fr, fq);
            xa_pv<1, 0>(o, pf, bufB, fr, fq);
#pragma unroll
            for (int nt = 0; nt < 2; ++nt) {
                bf16_t* rp = og + (size_t)(tok0 + nt * 16 + fr) * 1024 + h * 256 + fq * 4;
#pragma unroll
                for (int dt = 0; dt < 8; ++dt) store_bf16x4(rp + dt * 16, o[dt][nt] * linv[nt]);
            }
        }
        {
            f32x4 o[8][2];
#pragma unroll
            for (int dt = 0; dt < 8; ++dt) { o[dt][0] = (f32x4){0.f, 0.f, 0.f, 0.f}; o[dt][1] = (f32x4){0.f, 0.f, 0.f, 0.f}; }
            xa_pv<0, 1>(o, pf, bufA, fr, fq);
            xa_pv<1, 1>(o, pf, bufB, fr, fq);
#pragma unroll
            for (int nt = 0; nt < 2; ++nt) {
                bf16_t* rp = og + (size_t)(tok0 + nt * 16 + fr) * 1024 + h * 256 + 128 + fq * 4;
#pragma unroll
                for (int dt = 0; dt < 8; ++dt) store_bf16x4(rp + dt * 16, o[dt][nt] * linv[nt]);
            }
        }
        __syncthreads();
    }
}

__device__ __forceinline__ bool rt_better(float va, int ia, float vb, int ib) { return va > vb || (va == vb && ia < ib); }
__device__ __forceinline__ void phase_ln2_router(const Params& p, char* smem, const int mode = 0) {
    const int tid = opaque_tid(), lane = tid & 63, wid = tid >> 6;
    char* ws = uni(p.ws);
    float* z = (float*)(ws + OFF_Z2); bf16_t* hb = (bf16_t*)(ws + OFF_R0); const bf16_t* xa = (const bf16_t*)(ws + OFF_XQ);
    const float* h1 = uni(p.out);
    int2* toke = (int2*)(ws + OFF_TOKE); float2* tokw = (float2*)(ws + OFF_TOKW);
    int* histg = (int*)(ws + OFF_HIST);
    float* hs = (float*)(smem + wid * 16512);
    int* hist = (int*)(smem + 132096);
    const float* w_rg = uni(p.w_rg); const float* w_re = uni(p.w_re); const float* b_rg = uni(p.b_rg); const float* b_re = uni(p.b_re);
    const float* ln2g = uni(p.ln2g); const float* ln2b = uni(p.ln2b);
    const int chalf = lane & 1, kk = (lane >> 1) & 7, r = lane >> 4;
    for (int c = blockIdx.x; c < 256; c += gridDim.x) {
        if (tid < 64) hist[tid] = 0;
        __syncthreads();
#pragma unroll 1
        for (int rg = 0; rg < 8; ++rg) {
            const int rowbase = c * 256 + wid * 32 + rg * 4;
#pragma unroll
            for (int rr = 0; rr < 4; ++rr) {
                const int row = rowbase + rr;
                float4 v[4];
#pragma unroll
                for (int i = 0; i < 4; ++i) {
                    const uint2 hh = *(const uint2*)(hb + (size_t)row * 1024 + i * 256 + lane * 4);
                    const uint2 mm = *(const uint2*)(xa + (size_t)row * 1024 + i * 256 + lane * 4);
                    v[i].x = ALPHA * bf_lo(hh.x) + bf_lo(mm.x); v[i].y = ALPHA * bf_hi(hh.x) + bf_hi(mm.x); v[i].z = ALPHA * bf_lo(hh.y) + bf_lo(mm.y); v[i].w = ALPHA * bf_hi(hh.y) + bf_hi(mm.y);
                }
                ln_row(v, ln2g, ln2b, lane);
#pragma unroll
                for (int i = 0; i < 4; ++i) {
                    uint2 w; w.x = pk_bf16(v[i].x, v[i].y); w.y = pk_bf16(v[i].z, v[i].w);
                    if (!(mode & 2)) *(uint2*)(hb + (size_t)row * 1024 + i * 256 + lane * 4) = w;
                    *(float4*)(hs + rr * 1032 + i * 256 + lane * 4) = v[i];
                }
            }
            __builtin_amdgcn_wave_barrier();
            asm volatile("s_waitcnt lgkmcnt(0)" ::: "memory");
            if (mode & 1) continue;
            float g0, g1, g2, g3;
            {
                const int kq = lane >> 1;
                float ga[4][4];
#pragma unroll
                for (int rr = 0; rr < 4; ++rr) { ga[rr][0] = 0.f; ga[rr][1] = 0.f; ga[rr][2] = 0.f; ga[rr][3] = 0.f; }
#pragma unroll 8
                for (int s32 = 0; s32 < 32; ++s32) {
                    const int k = s32 * 32 + kq;
                    const float4 w = *(const float4*)(w_rg + (size_t)k * 8 + chalf * 4);
#pragma unroll
                    for (int rr = 0; rr < 4; ++rr) {
                        const float hv = hs[rr * 1032 + k];
                        ga[rr][0] += hv * w.x; ga[rr][1] += hv * w.y; ga[rr][2] += hv * w.z; ga[rr][3] += hv * w.w;
                    }
                }
#pragma unroll
                for (int rr = 0; rr < 4; ++rr)
#pragma unroll
                    for (int q = 0; q < 4; ++q) {
                        float v = ga[rr][q];
                        v += __builtin_bit_cast(float, __builtin_amdgcn_update_dpp(0, __builtin_bit_cast(int, v), 0x4E, 0xf, 0xf, true));
                        v += __builtin_bit_cast(float, __builtin_amdgcn_update_dpp(0, __builtin_bit_cast(int, v), 0x124, 0xf, 0xf, true));
                        v += __builtin_bit_cast(float, __builtin_amdgcn_update_dpp(0, __builtin_bit_cast(int, v), 0x128, 0xf, 0xf, true));
                        v += __shfl_xor(v, 16); v += __shfl_xor(v, 32);
                        ga[rr][q] = v;
                    }
                g0 = r == 0 ? ga[0][0] : r == 1 ? ga[1][0] : r == 2 ? ga[2][0] : ga[3][0];
                g1 = r == 0 ? ga[0][1] : r == 1 ? ga[1][1] : r == 2 ? ga[2][1] : ga[3][1];
                g2 = r == 0 ? ga[0][2] : r == 1 ? ga[1][2] : r == 2 ? ga[2][2] : ga[3][2];
                g3 = r == 0 ? ga[0][3] : r == 1 ? ga[1][3] : r == 2 ? ga[2][3] : ga[3][3];
            }
            {
                const float4 bb = *(const float4*)(b_rg + chalf * 4);
                g0 += bb.x; g1 += bb.y; g2 += bb.z; g3 += bb.w;
            }
            float mv = g0; int mi = chalf * 4;
            if (g1 > mv) { mv = g1; mi = chalf * 4 + 1; }
            if (g2 > mv) { mv = g2; mi = chalf * 4 + 2; }
            if (g3 > mv) { mv = g3; mi = chalf * 4 + 3; }
            { const float ov = __shfl_xor(mv, 1); const int oi = __shfl_xor(mi, 1); if (rt_better(ov, oi, mv, mi)) { mv = ov; mi = oi; } }
            float es = (__expf(g0 - mv) + __expf(g1 - mv)) + (__expf(g2 - mv) + __expf(g3 - mv));
            es += __shfl_xor(es, 1);
            const float pgroup = 1.0f / es;
            const int gsel = mi;
            float e0 = 0.f, e1 = 0.f, e2 = 0.f, e3 = 0.f;
            {
                const float* we = w_re + gsel * 8 + chalf * 4;
#pragma unroll 32
                for (int s8 = 0; s8 < 128; ++s8) {
                    const int k = s8 * 8 + kk;
                    const float4 w = *(const float4*)(we + (size_t)k * 64);
                    const float hv = hs[r * 1032 + k];
                    e0 += hv * w.x; e1 += hv * w.y; e2 += hv * w.z; e3 += hv * w.w;
                }
            }
#pragma unroll
            for (int o = 2; o < 16; o <<= 1) { e0 += __shfl_xor(e0, o); e1 += __shfl_xor(e1, o); e2 += __shfl_xor(e2, o); e3 += __shfl_xor(e3, o); }
            {
                const float4 bb = *(const float4*)(b_re + gsel * 8 + chalf * 4);
                e0 += bb.x; e1 += bb.y; e2 += bb.z; e3 += bb.w;
            }
            float v0 = e0, v1 = -INFINITY; int i0 = chalf * 4, i1 = 99;
            {
                const float ev[3] = {e1, e2, e3};
#pragma unroll
                for (int q = 0; q < 3; ++q) {
                    const float x = ev[q]; const int xi = chalf * 4 + q + 1;
                    if (x > v0) { v1 = v0; i1 = i0; v0 = x; i0 = xi; } else if (x > v1) { v1 = x; i1 = xi; }
                }
            }
            {
                const float b0 = __shfl_xor(v0, 1), b1 = __shfl_xor(v1, 1); const int k0 = __shfl_xor(i0, 1), k1 = __shfl_xor(i1, 1);
                float n0, n1; int m0, m1;
                if (rt_better(v0, i0, b0, k0)) { n0 = v0; m0 = i0; if (rt_better(v1, i1, b0, k0)) { n1 = v1; m1 = i1; } else { n1 = b0; m1 = k0; } }
                else { n0 = b0; m0 = k0; if (rt_better(b1, k1, v0, i0)) { n1 = b1; m1 = k1; } else { n1 = v0; m1 = i0; } }
                v0 = n0; i0 = m0; v1 = n1; i1 = m1;
            }
            if (kk == 0 && chalf == 0) {
                const float x1 = __expf(v1 - v0), den = 1.0f + x1;
                const int ea = gsel * 8 + i0, eb2 = gsel * 8 + i1;
                toke[rowbase + r] = make_int2(ea, eb2); tokw[rowbase + r] = make_float2(pgroup / den, pgroup * x1 / den);
                atomicAdd(&hist[ea], 1); atomicAdd(&hist[eb2], 1);
            }
            __builtin_amdgcn_wave_barrier();
        }
        __syncthreads();
        if (tid < 64 && !(mode & 1)) histg[c * 64 + tid] = hist[tid];
        __syncthreads();
    }
}

__device__ __forceinline__ void compute_segments(const int* histg, int* seg, int tid) {
    if (tid < 64) {
        int s = 0;
        for (int c = 0; c < 256; ++c) s += histg[c * 64 + tid];
        seg[tid] = s;
    }
    __syncthreads();
    if (tid == 0) {
        int acc = 0;
        for (int e = 0; e < 64; ++e) { seg[64 + e] = acc; acc += (seg[e] + 255) >> 8; }
        seg[128] = acc;
    }
    __syncthreads();
}

__device__ __forceinline__ void phase8(const Params& p, char* smem) {
    const int tid = opaque_tid();
    char* ws = uni(p.ws);
    const int* histg = (const int*)(ws + OFF_HIST);
    const int2* toke = (const int2*)(ws + OFF_TOKE); const float2* tokw = (const float2*)(ws + OFF_TOKW);
    int* slot_tok = (int*)(ws + OFF_SLOTTOK); float* slot_w = (float*)(ws + OFF_SLOTW);
    int* seg = (int*)smem;
    int* cursor = seg + 192;
    compute_segments(histg, seg, tid);
    for (int e = blockIdx.x; e < 64; e += gridDim.x) {
        const int start = seg[64 + e] * 256 + seg[e], end = seg[64 + e + 1] * 256;
        for (int s = start + tid; s < end; s += NTHR) { slot_tok[s] = -1; slot_w[s] = 0.f; }
    }
    for (int c = blockIdx.x; c < 256; c += gridDim.x) {
        __syncthreads();
        if (tid < 64) {
            int base = 0;
            for (int cc = 0; cc < c; ++cc) base += histg[cc * 64 + tid];
            cursor[tid] = seg[64 + tid] * 256 + base;
        }
        __syncthreads();
        if (tid < 256) {
            const int tok = c * 256 + tid;
            const int2 ee = toke[tok]; const float2 ww = tokw[tok];
            const int s0 = atomicAdd(&cursor[ee.x], 1);
            const int s1 = atomicAdd(&cursor[ee.y], 1);
            slot_tok[s0] = tok * 2; slot_w[s0] = ww.x;
            slot_tok[s1] = tok * 2 + 1; slot_w[s1] = ww.y;
        }
    }
}

struct Sched9a {
    int G, c, nrt; const int* seg; const int* slot_tok; const char* h2b; const char* wgu;
    __device__ __forceinline__ bool next(int i, pg8::Unit& u) const {
        int rtile, pn;
        if ((G & 7) == 0) { const int x = c & 7, j = c >> 3, nj = G >> 3, per = (nrt + 7) >> 3; const int uidx = i * nj + j; if (uidx >= per * 2) return false; rtile = x * per + (uidx >> 1); pn = uidx & 1; if (rtile >= nrt) return false; }
        else { const int uidx = i * G + c; if (uidx >= nrt * 2) return false; rtile = uidx >> 1; pn = uidx & 1; }
        int e = 0;
        for (int k = 1; k < 64; ++k) if (seg[64 + k] <= rtile) e = k;
        e = __builtin_amdgcn_readfirstlane(e);
        u.pm = rtile; u.pn = pn; u.aux = e; u.A = h2b; u.Bt = wgu + (size_t)e * 512 * 1024 * 2;
        return true;
    }
    __device__ __forceinline__ unsigned arow(const pg8::Unit& u, int r) const {
        const int tk = slot_tok[u.pm * 256 + r];
        return (unsigned)(tk < 0 ? 0 : (tk >> 1)) * 2048u;
    }
};
struct Epi9a {
    bf16_t* hbuf;
    __device__ __forceinline__ void operator()(f32x4 (&acc)[2][2][4][2], const pg8::Unit& u, int wr, int wc, int fr, int fq) const {
        const int row0 = u.pm * 256 + wr * 64 + fr, col0 = u.pn * 128 + wc * 32 + fq * 8;
#pragma unroll
        for (int ai = 0; ai < 2; ++ai)
#pragma unroll
            for (int m = 0; m < 4; ++m) {
                const size_t slot = row0 + ai * 128 + m * 16;
                f32x4 v0, v1;
#pragma unroll
                for (int j = 0; j < 4; ++j) {
                    const float g0 = acc[ai][0][m][0][j], g1 = acc[ai][0][m][1][j];
                    v0[j] = g0 * sigmoidf_(g0) * acc[ai][1][m][0][j]; v1[j] = g1 * sigmoidf_(g1) * acc[ai][1][m][1][j];
                }
                store_bf16x8(hbuf + slot * 256 + col0, v0, v1);
            }
    }
};
__device__ __forceinline__ void phase9a(const Params& p, char* smem) {
    const int tid = opaque_tid();
    char* ws = uni(p.ws);
    int* seg = (int*)(smem + LDS_GEMM);
    compute_segments((const int*)(ws + OFF_HIST), seg, tid);
    Sched9a S{(int)gridDim.x, (int)blockIdx.x, __builtin_amdgcn_readfirstlane(seg[128]), seg, (const int*)(ws + OFF_SLOTTOK), ws + OFF_R0, ws + OFF_WGU};
    Epi9a E{(bf16_t*)(ws + OFF_R1)};
    pg8::gemm_phase<Epi9a, Sched9a, true>((LDS_AS unsigned char*)smem, 1024, S, E);
}

struct Sched9b {
    int G, c, nrt; const int* seg; const char* hbuf; const char* wd;
    __device__ __forceinline__ bool next(int i, pg8::Unit& u) const {
        int rtile, pn;
        if ((G & 7) == 0) { const int x = c & 7, j = c >> 3, nj = G >> 3, per = (nrt + 7) >> 3; const int uidx = i * nj + j; if (uidx >= per * 4) return false; rtile = x * per + (uidx >> 2); pn = uidx & 3; if (rtile >= nrt) return false; }
        else { const int uidx = i * G + c; if (uidx >= nrt * 4) return false; rtile = uidx >> 2; pn = uidx & 3; }
        int e = 0;
        for (int k = 1; k < 64; ++k) if (seg[64 + k] <= rtile) e = k;
        e = __builtin_amdgcn_readfirstlane(e);
        u.pm = rtile; u.pn = pn; u.aux = e; u.A = hbuf; u.Bt = wd + (size_t)e * 1024 * 256 * 2;
        return true;
    }
};
struct Epi9b {
    const int* slot_tok; const float* slot_w; bf16_t* yb;
    __device__ __forceinline__ void operator()(f32x4 (&acc)[2][2][4][2], const pg8::Unit& u, int wr, int wc, int fr, int fq) const {
        const int row0 = u.pm * 256 + wr * 64 + fr, col0 = u.pn * 256 + wc * 32 + fq * 8;
#pragma unroll
        for (int ai = 0; ai < 2; ++ai)
#pragma unroll
            for (int m = 0; m < 4; ++m) {
                const int slot = row0 + ai * 128 + m * 16;
                const int tk = slot_tok[slot]; const float w = slot_w[slot];
                if (tk >= 0) {
#pragma unroll
                    for (int bj = 0; bj < 2; ++bj) store_bf16x8(yb + (size_t)tk * 1024 + col0 + bj * 128, acc[ai][bj][m][0] * w, acc[ai][bj][m][1] * w);
                }
            }
    }
};
__device__ __forceinline__ void phase9b(const Params& p, char* smem) {
    const int tid = opaque_tid();
    char* ws = uni(p.ws);
    int* seg = (int*)(smem + LDS_GEMM);
    compute_segments((const int*)(ws + OFF_HIST), seg, tid);
    Sched9b S{(int)gridDim.x, (int)blockIdx.x, __builtin_amdgcn_readfirstlane(seg[128]), seg, ws + OFF_R1, ws + OFF_WD};
    Epi9b E{(const int*)(ws + OFF_SLOTTOK), (const float*)(ws + OFF_SLOTW), (bf16_t*)(ws + OFF_YB)};
    pg8::gemm_phase<Epi9b, Sched9b>((LDS_AS unsigned char*)smem, 256, S, E);
}

__device__ __forceinline__ void phase10(const Params& p) {
    const int tid_ = opaque_tid(); const int lane = tid_ & 63, wid = tid_ >> 6;
    const bf16_t* h2 = (const bf16_t*)(uni(p.ws) + OFF_R0); const bf16_t* yb = (const bf16_t*)(uni(p.ws) + OFF_YB);
    for (int row = blockIdx.x * 8 + wid; row < T_; row += gridDim.x * 8) {
        float4 v[4];
#pragma unroll
        for (int i = 0; i < 4; ++i) {
            const uint2 hh = *(const uint2*)(h2 + (size_t)row * 1024 + i * 256 + lane * 4);
            const uint2 a = *(const uint2*)(yb + (size_t)(row * 2) * 1024 + i * 256 + lane * 4), b = *(const uint2*)(yb + (size_t)(row * 2 + 1) * 1024 + i * 256 + lane * 4);
            v[i].x = ALPHA * bf_lo(hh.x) + bf_lo(a.x) + bf_lo(b.x); v[i].y = ALPHA * bf_hi(hh.x) + bf_hi(a.x) + bf_hi(b.x);
            v[i].z = ALPHA * bf_lo(hh.y) + bf_lo(a.y) + bf_lo(b.y); v[i].w = ALPHA * bf_hi(hh.y) + bf_hi(a.y) + bf_hi(b.y);
        }
        ln_row(v, uni(p.ln3g), uni(p.ln3b), lane);
#pragma unroll
        for (int i = 0; i < 4; ++i) *(float4*)(uni(p.out) + (size_t)row * 1024 + i * 256 + lane * 4) = v[i];
    }
}

#define XB_TMO      128
#define XB_XCNT(j)  (256  + 64 * (j))
#define XB_XSUB(j)  (1280 + 64 * (j))
#define XB_XGEN(j)  (2304 + 64 * (j))
#define XB_TOP      3328
#define XB_TOPGEN   3392
#define XCD_BAR_WORDS 3456
#define XB_SPIN_CAP (1u << 18)
#define LAS LDS_AS

__device__ __forceinline__ unsigned xb_ld(unsigned* p)              { return __hip_atomic_load(p, __ATOMIC_RELAXED, __HIP_MEMORY_SCOPE_AGENT); }
__device__ __forceinline__ unsigned xb_add(unsigned* p, unsigned v) { return __hip_atomic_fetch_add(p, v, __ATOMIC_RELAXED, __HIP_MEMORY_SCOPE_AGENT); }
__device__ __forceinline__ unsigned xb_xcc_id() { return (unsigned)__builtin_amdgcn_s_getreg((3 << 11) | 20) & 0xFu; }
#define XB_SPIN(cond, bar) do { unsigned _sp = 0; while (cond) { __builtin_amdgcn_s_sleep(1); \
    if ((++_sp & 255u) == 0u) { if (xb_ld(&(bar)[XB_TMO])) break; if (_sp > XB_SPIN_CAP) { atomicAdd(&(bar)[XB_TMO], 1u); break; } } } } while (0)

struct XcdBarrier {
    unsigned* bar; unsigned x;
    volatile LAS unsigned* st;
};

__device__ __forceinline__ XcdBarrier xcd_barrier_post(unsigned* bar, volatile LAS unsigned* st) {
    XcdBarrier b; b.bar = bar; b.x = xb_xcc_id(); b.st = st;
    if (threadIdx.x == 0) (void)xb_add(&bar[XB_XCNT(b.x)], 1u);
    return b;
}
__device__ __forceinline__ void xcd_barrier_complete(unsigned* bar, unsigned x, unsigned& nloc, unsigned& nx) {
    const unsigned G = gridDim.x * gridDim.y * gridDim.z;
    unsigned sum, cnt, mine, sp = 0u;
    for (;;) {
        sum = 0u; cnt = 0u; mine = 0u;
#pragma unroll
        for (unsigned j = 0; j < 16; ++j) { const unsigned c = xb_ld(&bar[XB_XCNT(j)]); sum += c; cnt += (c > 0u) ? 1u : 0u; mine = (j == x) ? c : mine; }
        if (sum == G) break;
        __builtin_amdgcn_s_sleep(1);
        if ((++sp & 255u) == 0u) { if (xb_ld(&bar[XB_TMO])) break; if (sp > XB_SPIN_CAP) { atomicAdd(&bar[XB_TMO], 1u); break; } }
    }
    nloc = mine > 0u ? mine : 1u; nx = cnt > 0u ? cnt : 1u;
}

__device__ __forceinline__ void xcd_barrier(const XcdBarrier& b) {
    asm volatile("s_waitcnt vmcnt(0)" ::: "memory");
    __syncthreads();
    if (threadIdx.x == 0) {
        unsigned* bar = b.bar;
        __builtin_amdgcn_s_waitcnt(0);
        unsigned nloc = b.st[0], nx = b.st[1];
        if (nloc == 0u) { xcd_barrier_complete(bar, b.x, nloc, nx); b.st[0] = nloc; b.st[1] = nx; }
        const unsigned old = xb_add(&bar[XB_XSUB(b.x)], 1u);
        const unsigned gen = old / nloc;
        if (old + 1u == (gen + 1u) * nloc) {
            __builtin_amdgcn_fence(__ATOMIC_RELEASE, "agent");
            asm volatile("s_waitcnt vmcnt(0)" ::: "memory");
            const unsigned og = xb_add(&bar[XB_TOP], 1u);
            const unsigned tg = og / nx;
            if (og + 1u == (tg + 1u) * nx) xb_add(&bar[XB_TOPGEN], 1u);
            else XB_SPIN(xb_ld(&bar[XB_TOPGEN]) == tg, bar);
            __builtin_amdgcn_fence(__ATOMIC_ACQUIRE, "agent");
            xb_add(&bar[XB_XGEN(b.x)], 1u);
            asm volatile("s_waitcnt vmcnt(0)" ::: "memory");
        } else {
            XB_SPIN(xb_ld(&bar[XB_XGEN(b.x)]) == gen, bar);
            __builtin_amdgcn_fence(__ATOMIC_ACQUIRE, "agent");
            asm volatile("s_waitcnt vmcnt(0)" ::: "memory");
        }
    }
    __syncthreads();
}


#ifndef DUP
#define DUP (-1)
#endif
#define RUN(id, call) do { call; if (DUP == (id)) { GRID_SYNC(); call; } } while (0)
__global__ void __launch_bounds__(NTHR) mega(Params pk) {
    extern __shared__ __attribute__((aligned(16))) char smem[];
    cg::grid_group grid = cg::this_grid();
    if (threadIdx.x == 0) *(Params*)(smem + LDS_PARAMS) = pk;
    __syncthreads();
    const Params& p = *(const Params*)(smem + LDS_PARAMS);
    char* ws = uni(p.ws);
    volatile LDS_AS unsigned* xst = (volatile LDS_AS unsigned*)(LDS_AS char*)smem + (LDS_XB / 4);
    if (threadIdx.x < 4) xst[threadIdx.x] = 0u;
    __syncthreads();
    (void)xcd_barrier_post((unsigned*)(ws + OFF_BAR), xst);
#define GRID_SYNC() do { XcdBarrier xb_; xb_.bar = (unsigned*)(uni(p.ws) + OFF_BAR); xb_.x = xb_xcc_id(); xb_.st = (volatile LDS_AS unsigned*)(LDS_AS char*)smem + (LDS_XB / 4); xcd_barrier(xb_); } while (0)
    RUN(0, phase0(p, smem));
    if (DUP == 61) { GRID_SYNC(); phase0(p, smem, 1); }
    if (DUP == 62) { GRID_SYNC(); phase0(p, smem, 2); }
    if (DUP == 64) { GRID_SYNC(); phase0(p, smem, 4); }
    grid.sync();
    RUN(1, phase1(p, smem));
    if (DUP == 30) { GRID_SYNC(); phase1(p, smem, 1); }
    if (DUP == 31) { GRID_SYNC(); phase1(p, smem, 2); }
    GRID_SYNC();
    RUN(2, phase2a(p, smem));
    if (DUP == 20) { GRID_SYNC(); phase2a(p, smem, 1); }
    if (DUP == 21) { GRID_SYNC(); phase2a(p, smem, 2); }
    GRID_SYNC();
    RUN(12, phase2b(p, smem));
    if (DUP == 22) { GRID_SYNC(); phase2b(p, smem, 1); }
    if (DUP == 23) { GRID_SYNC(); phase2b(p, smem, 2); }
    if (DUP == 24) { GRID_SYNC(); phase2b(p, smem, 1, 4); }
    if (DUP == 25) { GRID_SYNC(); phase2b(p, smem, 1, 5); }
    if (DUP == 26) { GRID_SYNC(); phase2b(p, smem, 1, 13); }
    GRID_SYNC();
    phase2c(p, smem);
    GRID_SYNC();
    RUN(3, phase3(p, smem));
    GRID_SYNC();
    RUN(4, phase_gemm_bf16(p, smem, (const bf16_t*)(ws + OFF_R1), (const bf16_t*)(ws + OFF_WMIX), (bf16_t*)(ws + OFF_R0), 1.0f));
    GRID_SYNC();
    phase_ln1(p);
    GRID_SYNC();
    RUN(6, phase_gemm_bf16(p, smem, (const bf16_t*)(ws + OFF_R0), (const bf16_t*)(ws + OFF_WXQ), (bf16_t*)(ws + OFF_XQ), 0.0625f));
    GRID_SYNC();
    RUN(7, phase6(p, smem));
    GRID_SYNC();
    RUN(8, phase_gemm_bf16(p, smem, (const bf16_t*)(ws + OFF_O), (const bf16_t*)(ws + OFF_WXO), (bf16_t*)(ws + OFF_XQ), 1.0f));
    GRID_SYNC();
    RUN(13, phase_ln2_router(p, smem));
    if (DUP == 51) { GRID_SYNC(); phase_ln2_router(p, smem, 1); }
    if (DUP == 53) { GRID_SYNC(); phase_ln2_router(p, smem, 3); }
    GRID_SYNC();
    RUN(9, phase8(p, smem));
    GRID_SYNC();
    RUN(10, phase9a(p, smem));
    GRID_SYNC();
    RUN(11, phase9b(p, smem));
    GRID_SYNC();
    RUN(14, phase10(p));
}

extern "C" void kernel_launch(void* const* d_in, const int* in_sizes, int n_in, void* d_out, int out_size,
                              void* d_ws, size_t ws_size, hipStream_t stream) {
    static int grid_blocks = 0;
    if (!grid_blocks) {
        int dev = 0, cus = 0, per_cu = 0;
        (void)hipGetDevice(&dev);
        (void)hipDeviceGetAttribute(&cus, hipDeviceAttributeMultiprocessorCount, dev);
        (void)hipFuncSetAttribute((const void*)mega, hipFuncAttributeMaxDynamicSharedMemorySize, LDS_BYTES);
        (void)hipOccupancyMaxActiveBlocksPerMultiprocessor(&per_cu, mega, NTHR, LDS_BYTES);
        if (per_cu > 1) per_cu = 1;
        grid_blocks = cus * per_cu;
        if (ws_size < WS_NEED) fprintf(stderr, "workspace too small: %zu\n", ws_size);
    }
    Params p{};
    const float* const* f = (const float* const*)d_in;
    p.x = f[0]; p.mem = f[1]; p.pos = (const int*)d_in[2];
    p.w_in = f[3]; p.sinks = f[4]; p.conv_w = f[5]; p.conv_b = f[6]; p.b_ig = f[7]; p.b_fg = f[8]; p.ml_g = f[9];
    p.w_att = f[10]; p.w_ml = f[11]; p.w_mix = f[12]; p.ln1g = f[13]; p.ln1b = f[14];
    p.w_xq = f[15]; p.w_xkv = f[16]; p.w_xo = f[17]; p.ln2g = f[18]; p.ln2b = f[19];
    p.w_rg = f[20]; p.b_rg = f[21]; p.w_re = f[22]; p.b_re = f[23]; p.w_gate = f[24]; p.w_up = f[25]; p.w_down = f[26];
    p.ln3g = f[27]; p.ln3b = f[28];
    p.out = (float*)d_out; p.ws = (char*)d_ws;
    (void)hipMemsetAsync((char*)d_ws + OFF_BAR, 0, XCD_BAR_WORDS * sizeof(unsigned), stream);
    void* args[] = {&p};
    hipError_t e = hipLaunchCooperativeKernel((void*)mega, dim3(grid_blocks), dim3(NTHR), args, LDS_BYTES, stream);
    if (e != hipSuccess) fprintf(stderr, "cooperative launch failed: %s (grid %d)\n", hipGetErrorString(e), grid_blocks);
}
```

```cpp
#include <hip/hip_runtime.h>
#include <hip/hip_cooperative_groups.h>
#include <cstdio>
#include <cstdint>
namespace cg = cooperative_groups;

typedef unsigned short bf16_t;
typedef short bf16x8 __attribute__((ext_vector_type(8)));
typedef float f32x4 __attribute__((ext_vector_type(4)));
typedef unsigned u32x2 __attribute__((ext_vector_type(2)));
typedef unsigned u32x4 __attribute__((ext_vector_type(4)));
#define LDS_AS __attribute__((address_space(3)))
#define GLB_AS __attribute__((address_space(1)))

constexpr int T_ = 65536;
constexpr int NTHR = 512;
constexpr size_t MiB = 1ull << 20;
constexpr float ALPHA = 1.189207115002721f;
constexpr size_t OFF_R0 = 0;
constexpr size_t OFF_R1 = 128 * MiB;
constexpr size_t OFF_AK = 256 * MiB;
constexpr size_t OFF_AV = 272 * MiB;
constexpr size_t OFF_MQK = 288 * MiB;
constexpr size_t OFF_MV = 416 * MiB;
constexpr size_t OFF_MO = 544 * MiB;
constexpr size_t OFF_GG = 672 * MiB;
constexpr size_t OFF_WGU = 288 * MiB;
constexpr size_t OFF_WD = 352 * MiB;
constexpr size_t OFF_XQ = 416 * MiB;
constexpr size_t OFF_O = 544 * MiB;
constexpr size_t OFF_Z2 = 672 * MiB;
constexpr size_t OFF_YB = 416 * MiB;
constexpr size_t OFF_MISC = 928 * MiB;
constexpr size_t OFF_WIN = OFF_MISC;
constexpr size_t OFF_MEMB = OFF_MISC + 13 * MiB;
constexpr size_t OFF_CS = OFF_MISC + 21 * MiB;
constexpr size_t OFF_WXKV = OFF_MISC + 37 * MiB;
constexpr size_t OFF_WATT = OFF_MISC + 41 * MiB;
constexpr size_t OFF_WML = OFF_MISC + 43 * MiB;
constexpr size_t OFF_WMIX = OFF_MISC + 45 * MiB;
constexpr size_t OFF_WXQ = OFF_MISC + 47 * MiB;
constexpr size_t OFF_WXO = OFF_MISC + 49 * MiB;
constexpr size_t OFF_KMAT = OFF_MISC + 51 * MiB;
constexpr size_t OFF_VT = OFF_MISC + 59 * MiB;
constexpr size_t OFF_GATES = OFF_MISC + 67 * MiB;
constexpr size_t OFF_TOKE = OFF_MISC + 69 * MiB;
constexpr size_t OFF_TOKW = OFF_MISC + 70 * MiB;
constexpr size_t OFF_SLOTTOK = OFF_MISC + 71 * MiB;
constexpr size_t OFF_SLOTW = OFF_MISC + 72 * MiB;
constexpr size_t OFF_HIST = OFF_MISC + 73 * MiB;
constexpr size_t OFF_BAR = OFF_MISC + 74 * MiB;
constexpr size_t OFF_SSQP = OFF_MISC + 76 * MiB;
constexpr size_t OFF_SP = OFF_MISC;
constexpr size_t OFF_REC = OFF_MISC + 32 * MiB;
constexpr size_t OUT_QP = 128 * MiB;
constexpr size_t OUT_KP = 192 * MiB;
constexpr size_t WS_NEED = 1024 * MiB;
constexpr int LDS_GEMM = 147456;
constexpr int LDS_PARAMS = 163520;
constexpr int LDS_XB = 163776;
constexpr int LDS_BYTES = 163840;

struct Params {
    const float *x, *mem; const int* pos;
    const float *w_in, *sinks, *conv_w, *conv_b, *b_ig, *b_fg, *ml_g, *w_att, *w_ml, *w_mix, *ln1g, *ln1b;
    const float *w_xq, *w_xkv, *w_xo, *ln2g, *ln2b, *w_rg, *b_rg, *w_re, *b_re, *w_gate, *w_up, *w_down, *ln3g, *ln3b;
    float* out; char* ws;
};

__device__ const double INV_FREQ[32] = {1.0, 0.7498942093324559, 0.5623413251903491, 0.4216965034285822, 0.31622776601683794, 0.23713737056616552, 0.1778279410038923, 0.1333521432163324, 0.1, 0.07498942093324558, 0.05623413251903491, 0.042169650342858224, 0.03162277660168379, 0.023713737056616554, 0.01778279410038923, 0.01333521432163324, 0.01, 0.007498942093324558, 0.005623413251903491, 0.004216965034285823, 0.0031622776601683794, 0.0023713737056616554, 0.0017782794100389228, 0.001333521432163324, 0.001, 0.0007498942093324559, 0.0005623413251903491, 0.00042169650342858224, 0.00031622776601683794, 0.00023713737056616554, 0.00017782794100389227, 0.0001333521432163324};

template <class T> __device__ __forceinline__ T* uni(T* q) {
    const unsigned long long v = (unsigned long long)q;
    const unsigned lo = __builtin_amdgcn_readfirstlane((unsigned)v), hi = __builtin_amdgcn_readfirstlane((unsigned)(v >> 32));
    return (T*)(((unsigned long long)hi << 32) | lo);
}
__device__ __forceinline__ int opaque_tid() { int t = threadIdx.x; asm volatile("" : "+v"(t)); return t; }
__device__ __forceinline__ unsigned pk_bf16(float lo, float hi) { unsigned r; asm("v_cvt_pk_bf16_f32 %0, %1, %2" : "=v"(r) : "v"(lo), "v"(hi)); return r; }
__device__ __forceinline__ float bf_lo(unsigned u) { return __uint_as_float(u << 16); }
__device__ __forceinline__ float bf_hi(unsigned u) { return __uint_as_float(u & 0xffff0000u); }
__device__ __forceinline__ float bf2f(bf16_t h) { return __uint_as_float(((unsigned)h) << 16); }
__device__ __forceinline__ float wsum(float v) {
#pragma unroll
    for (int o = 32; o; o >>= 1) v += __shfl_xor(v, o);
    return v;
}
__device__ __forceinline__ float wmaxf(float v) {
#pragma unroll
    for (int o = 32; o; o >>= 1) v = fmaxf(v, __shfl_xor(v, o));
    return v;
}
__device__ __forceinline__ float sigmoidf_(float x) { return __builtin_amdgcn_rcpf(1.0f + __builtin_amdgcn_exp2f(x * -1.4426950408889634f)); }
__device__ __forceinline__ void glds16(const bf16_t* g, char* l) {
    __builtin_amdgcn_global_load_lds((const GLB_AS void*)g, (LDS_AS void*)l, 16, 0, 0);
}

__device__ __forceinline__ bool xcd_item(int i, int n, int& item) {
    const int G = gridDim.x;
    if ((G & 7) == 0) {
        const int x = blockIdx.x & 7, j = blockIdx.x >> 3, nj = G >> 3;
        const int per = (n + 7) >> 3;
        const int u = i * nj + j;
        if (u >= per) return false;
        item = x * per + u;
        return item < n;
    }
    item = blockIdx.x + i * G;
    return item < n;
}

struct GemmSrc { const bf16_t* a[4]; const bf16_t* b[2]; };

__device__ __forceinline__ void stage_tile(const GemmSrc& s, int koff, char* buf, int tid) {
#pragma unroll
    for (int i = 0; i < 4; ++i) glds16(s.a[i] + koff, buf + (i * 512 + tid) * 16);
#pragma unroll
    for (int i = 0; i < 2; ++i) glds16(s.b[i] + koff, buf + 32768 + (i * 512 + tid) * 16);
}

constexpr int GEMM_STAGE = 49152;
__device__ __forceinline__ void gemm_loop(f32x4 (&acc)[4][4], const GemmSrc& s, int nk, char* smem, int tid) {
    const int lane = tid & 63, wid = tid >> 6, wr = wid >> 1, wc = wid & 1, fr = lane & 15, fq = lane >> 4;
    const int swz = (fr >> 1) & 7;
    const int aoff = (wr * 64 + fr) * 128;
    const int boff = 32768 + (wc * 64 + fr) * 128;
    stage_tile(s, 0, smem, tid);
    if (nk > 1) stage_tile(s, 64, smem + GEMM_STAGE, tid);
    int cur = 0, nxt = 2;
#pragma unroll 1
    for (int t = 0; t < nk; ++t) {
        if (t + 1 < nk) asm volatile("s_waitcnt vmcnt(6)" ::: "memory"); else asm volatile("s_waitcnt vmcnt(0)" ::: "memory");
        __builtin_amdgcn_s_barrier();
        if (t + 2 < nk) stage_tile(s, (t + 2) * 64, smem + nxt * GEMM_STAGE, tid);
        const char* cb = smem + cur * GEMM_STAGE;
#pragma unroll
        for (int ks = 0; ks < 2; ++ks) {
            const int ch = ((ks * 4 + fq) ^ swz) * 16;
            bf16x8 xa[4], wb[4];
#pragma unroll
            for (int m = 0; m < 4; ++m) xa[m] = *(const bf16x8*)(cb + aoff + m * 2048 + ch);
#pragma unroll
            for (int n = 0; n < 4; ++n) wb[n] = *(const bf16x8*)(cb + boff + n * 2048 + ch);
#pragma unroll
            for (int m = 0; m < 4; ++m)
#pragma unroll
                for (int n = 0; n < 4; ++n) acc[m][n] = __builtin_amdgcn_mfma_f32_16x16x32_bf16(wb[n], xa[m], acc[m][n], 0, 0, 0);
        }
        cur = cur == 2 ? 0 : cur + 1; nxt = nxt == 2 ? 0 : nxt + 1;
    }
    __syncthreads();
}

__device__ __forceinline__ void zero_acc(f32x4 (&acc)[4][4]) {
#pragma unroll
    for (int m = 0; m < 4; ++m)
#pragma unroll
        for (int n = 0; n < 4; ++n) acc[m][n] = (f32x4){0.f, 0.f, 0.f, 0.f};
}

__device__ __forceinline__ void make_src(GemmSrc& s, const bf16_t* A, size_t lda, int rowA0, const bf16_t* Bt, size_t ldb, int rowB0, int tid) {
    const int r = tid >> 3, lc = (tid & 7) ^ ((r >> 1) & 7);
#pragma unroll
    for (int i = 0; i < 4; ++i) s.a[i] = A + (size_t)(rowA0 + i * 64 + r) * lda + lc * 8;
#pragma unroll
    for (int i = 0; i < 2; ++i) s.b[i] = Bt + (size_t)(rowB0 + i * 64 + r) * ldb + lc * 8;
}

__device__ __forceinline__ void store_bf16x8(bf16_t* p, f32x4 a, f32x4 b) {
    u32x4 w; w[0] = pk_bf16(a[0], a[1]); w[1] = pk_bf16(a[2], a[3]); w[2] = pk_bf16(b[0], b[1]); w[3] = pk_bf16(b[2], b[3]); *(u32x4*)p = w;
}
__device__ __forceinline__ void store_bf16x4(bf16_t* p, f32x4 v) {
    uint2 w; w.x = pk_bf16(v[0], v[1]); w.y = pk_bf16(v[2], v[3]); *(uint2*)p = w;
}

namespace pg8 {
constexpr int BM = 256, BK = 64, HALF = 128, HTB = HALF * BK * 2;
__device__ __forceinline__ int lds_byte(int r, int c) { const int st = (r >> 4) * 2 + (c >> 5), rr = r & 15, cc = c & 31, ob = rr * 64 + cc * 2; return st * 1024 + (ob ^ (((ob >> 9) & 1) << 5)); }
__device__ __forceinline__ void stage_rc(int b, int& R, int& C) { const int st = b / 1024, sb = b % 1024, swz = sb ^ (((sb >> 9) & 1) << 5); R = (st >> 1) * 16 + swz / 64; C = (st & 1) * 32 + (swz % 64) / 2; }
struct Unit { int pm, pn, aux; const char* A; const char* Bt; };

template <class Epi, class Sched, bool GATHER = false>
__device__ __forceinline__ void gemm_phase(LDS_AS unsigned char* lds, const int K, const Sched& S, const Epi& E, const int stagger_cycles = 0) {
    const int tid = opaque_tid(), wid = __builtin_amdgcn_readfirstlane(tid >> 6), lane = tid & 63, wr = wid >> 2, wc = wid & 3, fr = lane & 15, fq = lane >> 4;
    const int nt = K / BK;
    unsigned voff[2];
#pragma unroll
    for (int i = 0; i < 2; ++i) { int R, C; stage_rc(tid * 16 + i * 8192, R, C); voff[i] = (unsigned)(R * K + C) * 2u; }
    const size_t kstep = (size_t)(BK * 2);
    const size_t hstep = (size_t)HALF * K * 2;
    const size_t tstep = 2 * hstep;
    const unsigned ldsw = (unsigned)wid * 1024u;
    const int aoff = lds_byte(wr * 64 + fr, fq * 8), boff = lds_byte(wc * 32 + fr, fq * 8);
#define PG8_SA(b, h) (((b) * 2 + (h)) * HTB)
#define PG8_SB(b, h) ((4 + (b) * 2 + (h)) * HTB)
#define PG8_STAGE(bufoff, gbase) do { _Pragma("unroll") for (int _i = 0; _i < 2; ++_i) \
        __builtin_amdgcn_global_load_lds((const GLB_AS void*)((const char*)(gbase) + voff[_i]), (LDS_AS void*)(lds + (bufoff) + ldsw + _i * 8192), 16, 0, 0); } while (0)
#define PG8_LDA(dst, b, h) do { _Pragma("unroll") for (int m = 0; m < 4; ++m) _Pragma("unroll") for (int k = 0; k < 2; ++k) dst[m][k] = *(const LDS_AS bf16x8*)(lds + PG8_SA(b, h) + aoff + m * 2048 + k * 1024); } while (0)
#define PG8_LDB(dst, b, h) do { _Pragma("unroll") for (int n = 0; n < 2; ++n) _Pragma("unroll") for (int k = 0; k < 2; ++k) dst[n][k] = *(const LDS_AS bf16x8*)(lds + PG8_SB(b, h) + boff + n * 2048 + k * 1024); } while (0)
#define PG8_MMA(ai, bj, At, Bt) do { __builtin_amdgcn_s_setprio(1); _Pragma("unroll") for (int m = 0; m < 4; ++m) _Pragma("unroll") for (int n = 0; n < 2; ++n) _Pragma("unroll") for (int k = 0; k < 2; ++k) \
        acc[ai][bj][m][n] = __builtin_amdgcn_mfma_f32_16x16x32_bf16(Bt[n][k], At[m][k], acc[ai][bj][m][n], 0, 0, 0); __builtin_amdgcn_s_setprio(0); } while (0)
#define PG8_WAIT_V(n) asm volatile("s_waitcnt vmcnt(" #n ")" ::: "memory")
#define PG8_WAIT_L(n) asm volatile("s_waitcnt lgkmcnt(" #n ")" ::: "memory")
#define PG8_BAR __builtin_amdgcn_s_barrier()
#define PG8_SCHED __builtin_amdgcn_sched_barrier(0)
#define PG8_STAGE_A(bufoff, gbase, VA) do { _Pragma("unroll") for (int _i = 0; _i < 2; ++_i) \
        __builtin_amdgcn_global_load_lds((const GLB_AS void*)((const char*)(gbase) + (VA)[_i]), (LDS_AS void*)(lds + (bufoff) + ldsw + _i * 8192), 16, 0, 0); } while (0)
    int Rr[2], Cc[2];
#pragma unroll
    for (int i = 0; i < 2; ++i) stage_rc(tid * 16 + i * 8192, Rr[i], Cc[i]);
    unsigned va0[2], va1[2], vn0[2], vn1[2];
    Unit cur, nxt; int ui = 0;
    if (!S.next(0, cur)) return;
    if constexpr (GATHER) {
#pragma unroll
        for (int i = 0; i < 2; ++i) { va0[i] = S.arow(cur, Rr[i]) + (unsigned)Cc[i] * 2u; va1[i] = S.arow(cur, 128 + Rr[i]) + (unsigned)Cc[i] * 2u; }
    } else {
#pragma unroll
        for (int i = 0; i < 2; ++i) { va0[i] = voff[i]; va1[i] = voff[i] + (unsigned)hstep; }
    }
#pragma unroll
    for (int i = 0; i < 2; ++i) { vn0[i] = va0[i]; vn1[i] = va1[i]; }
    if (stagger_cycles > 0) {
        const int lvl = (blockIdx.x >> 3) & 31;
        for (int q = 0; q < lvl * stagger_cycles; ++q) __builtin_amdgcn_s_sleep(15);
    }
    f32x4 acc[2][2][4][2];
#pragma unroll
    for (int a = 0; a < 2; ++a)
#pragma unroll
        for (int b = 0; b < 2; ++b)
#pragma unroll
            for (int m = 0; m < 4; ++m)
#pragma unroll
                for (int n = 0; n < 2; ++n) acc[a][b][m][n] = (f32x4){0.f, 0.f, 0.f, 0.f};
    bf16x8 At[4][2], B0[2][2], B1[2][2];
    const char* cA = GATHER ? cur.A : cur.A + (size_t)cur.pm * tstep; const char* cB = cur.Bt + (size_t)cur.pn * tstep;
    PG8_STAGE(PG8_SB(0, 0), cB); PG8_STAGE(PG8_SB(0, 1), cB + hstep); PG8_STAGE_A(PG8_SA(0, 0), cA, va0); PG8_STAGE_A(PG8_SA(0, 1), cA, va1);
    if (wr == 1) PG8_BAR;
    PG8_WAIT_V(2); PG8_BAR;
    PG8_STAGE(PG8_SB(1, 0), cB + kstep); PG8_STAGE_A(PG8_SA(1, 0), cA + kstep, va0); PG8_STAGE(PG8_SB(1, 1), cB + hstep + kstep);
    PG8_WAIT_V(6); PG8_BAR;
    for (;;) {
        const bool has_next = S.next(ui + 1, nxt);
        const char* nA = has_next ? (GATHER ? nxt.A : nxt.A + (size_t)nxt.pm * tstep) : cA; const char* nB = has_next ? nxt.Bt + (size_t)nxt.pn * tstep : cB;
        if constexpr (GATHER) {
            if (has_next) {
#pragma unroll
                for (int i = 0; i < 2; ++i) { vn0[i] = S.arow(nxt, Rr[i]) + (unsigned)Cc[i] * 2u; vn1[i] = S.arow(nxt, 128 + Rr[i]) + (unsigned)Cc[i] * 2u; }
            }
        }
        for (int t = 0; t < nt; t += 2) {
            const bool last = (t == nt - 2);
            const char* a1 = cA + (size_t)(t + 1) * kstep;
            const char* a2 = last ? nA : cA + (size_t)(t + 2) * kstep; const char* b2 = last ? nB : cB + (size_t)(t + 2) * kstep;
            const char* a3 = a2 + kstep; const char* b3 = b2 + kstep;
            unsigned w0[2], w1[2];
#pragma unroll
            for (int i = 0; i < 2; ++i) { w0[i] = last ? vn0[i] : va0[i]; w1[i] = last ? vn1[i] : va1[i]; }
            PG8_LDB(B0, 0, 0); PG8_LDB(B1, 0, 1); PG8_SCHED; PG8_LDA(At, 0, 0); PG8_STAGE_A(PG8_SA(1, 1), a1, va1);
            PG8_WAIT_V(8); PG8_WAIT_L(0); PG8_BAR; PG8_MMA(0, 0, At, B0); PG8_MMA(0, 1, At, B1); PG8_BAR; PG8_SCHED;
            PG8_LDA(At, 0, 1); PG8_STAGE(PG8_SB(0, 0), b2); PG8_STAGE(PG8_SB(0, 1), b2 + hstep); PG8_STAGE_A(PG8_SA(0, 0), a2, w0);
            PG8_WAIT_V(8); PG8_WAIT_L(0); PG8_BAR; PG8_MMA(1, 0, At, B0); PG8_MMA(1, 1, At, B1); PG8_BAR; PG8_SCHED;
            PG8_LDB(B0, 1, 0); PG8_LDB(B1, 1, 1); PG8_SCHED; PG8_LDA(At, 1, 0); PG8_STAGE_A(PG8_SA(0, 1), a2, w1);
            PG8_WAIT_V(8); PG8_WAIT_L(0); PG8_BAR; PG8_MMA(0, 0, At, B0); PG8_MMA(0, 1, At, B1); PG8_BAR; PG8_SCHED;
            PG8_LDA(At, 1, 1); PG8_STAGE(PG8_SB(1, 0), b3); PG8_STAGE(PG8_SB(1, 1), b3 + hstep); PG8_STAGE_A(PG8_SA(1, 0), a3, w0);
            PG8_WAIT_V(8); PG8_WAIT_L(0); PG8_BAR; PG8_MMA(1, 0, At, B0); PG8_MMA(1, 1, At, B1); PG8_BAR; PG8_SCHED;
        }
        if (wr == 0) PG8_BAR;
        E(acc, cur, wr, wc, fr, fq);
        if (!has_next) break;
        if (!(cur.aux & 0x100)) {
#pragma unroll
        for (int a = 0; a < 2; ++a)
#pragma unroll
            for (int b = 0; b < 2; ++b)
#pragma unroll
                for (int m = 0; m < 4; ++m)
#pragma unroll
                    for (int n = 0; n < 2; ++n) acc[a][b][m][n] = (f32x4){0.f, 0.f, 0.f, 0.f};
        }
        cur = nxt; cA = nA; cB = nB; ++ui;
#pragma unroll
        for (int i = 0; i < 2; ++i) { va0[i] = vn0[i]; va1[i] = vn1[i]; }
        if (wr == 1) PG8_BAR;
    }
    PG8_WAIT_V(0);
    PG8_BAR;
#undef PG8_SA
#undef PG8_SB
#undef PG8_STAGE
#undef PG8_STAGE_A
#undef PG8_LDA
#undef PG8_LDB
#undef PG8_MMA
#undef PG8_WAIT_V
#undef PG8_WAIT_L
#undef PG8_BAR
#undef PG8_SCHED
}
}

__device__ __forceinline__ int perm32(int rho) { const int n = rho >> 4, i = rho & 15; return 8 * (i >> 2) + 4 * n + (i & 3); }
template <bool PERM>
__device__ __forceinline__ void tr_tile_t(const float* src, size_t ld_src, int k0, int c0, bf16_t* dst, size_t ld_dst, int r0, float* tile, int tid) {
    {
        const int r = tid >> 3, c4 = (tid & 7) * 4;
        const float4 v = *(const float4*)(src + (size_t)(k0 + r) * ld_src + c0 + c4);
        float* tp = tile + r * 33 + c4; tp[0] = v.x; tp[1] = v.y; tp[2] = v.z; tp[3] = v.w;
    }
    __syncthreads();
    {
        const int c = tid >> 4, rc = (tid & 15) * 4, sc = PERM ? perm32(c) : c;
        const float a0 = tile[(rc + 0) * 33 + sc], a1 = tile[(rc + 1) * 33 + sc], a2 = tile[(rc + 2) * 33 + sc], a3 = tile[(rc + 3) * 33 + sc];
        uint2 w; w.x = pk_bf16(a0, a1); w.y = pk_bf16(a2, a3);
        *(uint2*)(dst + (size_t)(r0 + c) * ld_dst + k0 + rc) = w;
    }
    __syncthreads();
}
template <bool PERM>
__device__ __forceinline__ void tr_tile4(const float* const (&src)[4], const int (&c0)[4], size_t ld_src, int k0, bf16_t* dst, size_t ld_dst, int r0, float* tile, int tid) {
    {
        const int r = tid >> 3, c4 = (tid & 7) * 4;
        float4 v[4];
#pragma unroll
        for (int g = 0; g < 4; ++g) v[g] = *(const float4*)(src[g] + (size_t)(k0 + r) * ld_src + c0[g] + c4);
#pragma unroll
        for (int g = 0; g < 4; ++g) { float* tp = tile + r * 129 + g * 32 + c4; tp[0] = v[g].x; tp[1] = v[g].y; tp[2] = v[g].z; tp[3] = v[g].w; }
    }
    __syncthreads();
    {
        const int c = tid >> 4, rc = (tid & 15) * 4, sc = PERM ? perm32(c) : c;
#pragma unroll
        for (int g = 0; g < 4; ++g) {
            const float a0 = tile[(rc + 0) * 129 + g * 32 + sc], a1 = tile[(rc + 1) * 129 + g * 32 + sc], a2 = tile[(rc + 2) * 129 + g * 32 + sc], a3 = tile[(rc + 3) * 129 + g * 32 + sc];
            uint2 w; w.x = pk_bf16(a0, a1); w.y = pk_bf16(a2, a3);
            *(uint2*)(dst + (size_t)(r0 + g * 32 + c) * ld_dst + k0 + rc) = w;
        }
    }
    __syncthreads();
}
__device__ __forceinline__ void tr_tile2(const float* srca, int c0a, const float* srcb, int c0b, size_t ld_src, int k0, bf16_t* dst, size_t ld_dst, int r0, float* tile, int tid) {
    {
        const int r = tid >> 3, c4 = (tid & 7) * 4;
        const float* sp = c4 < 16 ? srca + (size_t)(k0 + r) * ld_src + c0a + c4 : srcb + (size_t)(k0 + r) * ld_src + c0b + (c4 - 16);
        const float4 v = *(const float4*)sp;
        float* tp = tile + r * 33 + c4; tp[0] = v.x; tp[1] = v.y; tp[2] = v.z; tp[3] = v.w;
    }
    __syncthreads();
    {
        const int c = tid >> 4, rc = (tid & 15) * 4;
        const float a0 = tile[(rc + 0) * 33 + c], a1 = tile[(rc + 1) * 33 + c], a2 = tile[(rc + 2) * 33 + c], a3 = tile[(rc + 3) * 33 + c];
        uint2 w; w.x = pk_bf16(a0, a1); w.y = pk_bf16(a2, a3);
        *(uint2*)(dst + (size_t)(r0 + c) * ld_dst + k0 + rc) = w;
    }
    __syncthreads();
}

__device__ __forceinline__ void phase0(const Params& p, char* smem, const int parts = 7) {
    const int tid = opaque_tid(), lane = tid & 63, wid = tid >> 6;
    const int gw = blockIdx.x * 8 + wid, nw = gridDim.x * 8;
    char* ws = uni(p.ws);
    bf16_t* xb = (bf16_t*)(ws + OFF_R0);
    if (parts & 1) {
        const float* xg = uni(p.x);
        for (int row = gw * 2; row < T_; row += nw * 2) {
            float4 v[8];
#pragma unroll
            for (int i = 0; i < 8; ++i) v[i] = ((const float4*)(xg + (size_t)(row + (i >> 2)) * 1024))[(i & 3) * 64 + lane];
#pragma unroll
            for (int i = 0; i < 8; ++i) {
                uint2 w; w.x = pk_bf16(v[i].x, v[i].y); w.y = pk_bf16(v[i].z, v[i].w);
                *(uint2*)(xb + (size_t)(row + (i >> 2)) * 1024 + (i & 3) * 256 + lane * 4) = w;
            }
        }
    }
    if (parts & 2) {
        float2* cs = (float2*)(ws + OFF_CS);
        const int gt = blockIdx.x * NTHR + tid, nt = gridDim.x * NTHR;
        for (int idx = gt; idx < T_ * 32; idx += nt) {
            const int tok = idx >> 5, i = idx & 31;
            const double ang = (double)uni(p.pos)[tok] * INV_FREQ[i];
            const double turns = ang * 0.15915494309189535;
            const float f = (float)(turns - rint(turns));
            cs[idx] = make_float2(__builtin_amdgcn_cosf(f), __builtin_amdgcn_sinf(f));
        }
        bf16_t* memb = (bf16_t*)(ws + OFF_MEMB);
        for (int idx = gt; idx < 4096 * 1024 / 4; idx += nt) {
            const float4 v = ((const float4*)uni(p.mem))[idx];
            uint2 w; w.x = pk_bf16(v.x, v.y); w.y = pk_bf16(v.z, v.w);
            ((uint2*)memb)[idx] = w;
        }
    }
    if (parts & 4) {
        float* tile = (float*)smem;
        const int NQ_WIN = 16 * 50, NQ_SQ = 16 * 8, NQ_XKV = 16 * 16;
        const int total = NQ_WIN + 5 * NQ_SQ + NQ_XKV + 16;
        const float* win = uni(p.w_in);
        for (int t = blockIdx.x; t < total; t += gridDim.x) {
            if (t < NQ_WIN) {
                const int kt = t & 15, qd = t >> 4;
                const float* srcs[4] = {win, win, win, win}; int c0[4];
#pragma unroll
                for (int g = 0; g < 4; ++g) {
                    const int n0 = (qd * 4 + g) * 32;
                    if (n0 < 1280) { const int pn = n0 >> 8, bj = (n0 >> 7) & 1, wc = (n0 >> 5) & 3; c0[g] = (4 * pn + wc) * 64 + 32 * bj; }
                    else c0[g] = n0 < 4352 ? n0 : n0 + 8;
                }
                tr_tile4<true>(srcs, c0, 6408, kt * 64, (bf16_t*)(ws + OFF_WIN), 1024, qd * 128, tile, tid);
            } else if (t < NQ_WIN + 5 * NQ_SQ) {
                const int u = t - NQ_WIN, which = u / NQ_SQ, v = u % NQ_SQ, kt = v & 15, qd = v >> 4;
                const float* src = which == 0 ? uni(p.w_att) : which == 1 ? uni(p.w_ml) : which == 2 ? uni(p.w_mix) : which == 3 ? uni(p.w_xq) : uni(p.w_xo);
                const float* srcs[4] = {src, src, src, src}; const int c0[4] = {qd * 128, qd * 128 + 32, qd * 128 + 64, qd * 128 + 96};
                tr_tile4<true>(srcs, c0, 1024, kt * 64, (bf16_t*)(ws + OFF_WATT + (size_t)which * 2 * MiB), 1024, qd * 128, tile, tid);
            } else if (t < NQ_WIN + 5 * NQ_SQ + NQ_XKV) {
                const int v = t - NQ_WIN - 5 * NQ_SQ, kt = v & 15, qd = v >> 4;
                const float* src = uni(p.w_xkv);
                const float* srcs[4] = {src, src, src, src}; const int c0[4] = {qd * 128, qd * 128 + 32, qd * 128 + 64, qd * 128 + 96};
                if (qd < 8) tr_tile4<true>(srcs, c0, 2048, kt * 64, (bf16_t*)(ws + OFF_WXKV), 1024, qd * 128, tile, tid);
                else tr_tile4<false>(srcs, c0, 2048, kt * 64, (bf16_t*)(ws + OFF_WXKV), 1024, qd * 128, tile, tid);
            } else {
                const int kt = t - (NQ_WIN + 5 * NQ_SQ + NQ_XKV);
                tr_tile_t<true>(win, 6408, kt * 64, 4352, (bf16_t*)(ws + OFF_WIN), 1024, 6400, tile, tid);
            }
        }
    }
}

__device__ __forceinline__ void moe_weight_prep(const Params& p, char* smem, int first, int stride) {
    const int tid = opaque_tid();
    float* tile = (float*)smem;
    char* ws = uni(p.ws);
    const int per_e = 96, total = 64 * per_e;
    __syncthreads();
    for (int t = first; t < total; t += stride) {
        const int e = t / per_e, u = t % per_e;
        if (u < 64) {
            const int kt = u & 15, qd = u >> 4, pn = qd >> 1, bj = qd & 1;
            const float* src = (bj ? uni(p.w_up) : uni(p.w_gate)) + (size_t)e * 1024 * 256;
            const float* srcs[4] = {src, src, src, src}; const int c0[4] = {pn * 128, pn * 128 + 32, pn * 128 + 64, pn * 128 + 96};
            tr_tile4<true>(srcs, c0, 256, kt * 64, (bf16_t*)(ws + OFF_WGU) + (size_t)e * 512 * 1024, 1024, qd * 128, tile, tid);
        } else {
            const int v = u - 64, kt = v & 3, qd = v >> 2;
            const float* dsrc = uni(p.w_down) + (size_t)e * 256 * 1024;
            const float* srcs[4] = {dsrc, dsrc, dsrc, dsrc}; const int c0[4] = {qd * 128, qd * 128 + 32, qd * 128 + 64, qd * 128 + 96};
            tr_tile4<true>(srcs, c0, 1024, kt * 64, (bf16_t*)(ws + OFF_WD) + (size_t)e * 1024 * 256, 256, qd * 128, tile, tid);
        }
    }
}

struct SchedP1 {
    int G, c; const char *xb, *win, *memb, *wxkv;
    __device__ __forceinline__ bool next(int i, pg8::Unit& u) const {
        int nmain, uidx;
        if (G == 256) { nmain = 26; const int x = c & 7, j = c >> 3; uidx = i * 32 + j; if (i < 26) { const int g = uidx / 104, v = uidx % 104; u.pm = 32 * x + 4 * g + (v & 3); u.pn = v >> 2; } }
        else { nmain = c < 6656 ? (6656 - 1 - c) / G + 1 : 0; uidx = i * G + c; if (i < nmain) { u.pm = uidx / 26; u.pn = uidx % 26; } }
        if (i < nmain) { u.aux = 0; u.A = xb; u.Bt = win; return true; }
        const int kv = c + (i - nmain) * G;
        if (kv >= 128) return false;
        if (kv < 64) { u.aux = 1; u.pm = kv >> 2; u.pn = kv & 3; u.A = memb; u.Bt = wxkv; }
        else { const int k2 = kv - 64; u.aux = 2; u.pm = k2 >> 4; u.pn = k2 & 15; u.A = wxkv + (size_t)1024 * 1024 * 2; u.Bt = memb; }
        return true;
    }
};

struct EpiP1 {
    char* ws; int skip;
    __device__ __forceinline__ void operator()(f32x4 (&acc)[2][2][4][2], const pg8::Unit& u, int wr, int wc, int fr, int fq) const {
        if (skip == 1) {
#pragma unroll
            for (int a = 0; a < 2; ++a)
#pragma unroll
                for (int b = 0; b < 2; ++b)
#pragma unroll
                    for (int m = 0; m < 4; ++m) { asm volatile("" :: "v"(acc[a][b][m][0]), "v"(acc[a][b][m][1])); }
            return;
        }
        const int row0 = u.pm * 256 + wr * 64 + fr;
        if (u.aux == 0 && u.pn < 5) {
            const int hidx = 4 * u.pn + wc;
            if (hidx < 18) {
                bf16_t* dst; int ld, cb; float sc;
                if (hidx < 16) { dst = (bf16_t*)(ws + OFF_R1); ld = 1024; cb = hidx * 64; sc = 0.125f; }
                else { dst = (bf16_t*)(ws + OFF_AK); ld = 128; cb = (hidx - 16) * 64; sc = 1.0f; }
                const float* cs = (const float*)(ws + OFF_CS);
                const int d1 = 8 * fq;
#pragma unroll
                for (int ai = 0; ai < 2; ++ai)
#pragma unroll
                    for (int m = 0; m < 4; ++m) {
                        const int tok = row0 + ai * 128 + m * 16;
                        const float4* cp = (const float4*)(cs + (size_t)tok * 64 + d1 * 2);
                        const float4 c0 = cp[0], c1 = cp[1], c2 = cp[2], c3 = cp[3];
                        const f32x4 x1a = acc[ai][0][m][0], x1b = acc[ai][0][m][1], x2a = acc[ai][1][m][0], x2b = acc[ai][1][m][1];
                        f32x4 o1a, o1b, o2a, o2b;
                        o1a[0] = (x1a[0] * c0.x - x2a[0] * c0.y) * sc; o2a[0] = (x2a[0] * c0.x + x1a[0] * c0.y) * sc;
                        o1a[1] = (x1a[1] * c0.z - x2a[1] * c0.w) * sc; o2a[1] = (x2a[1] * c0.z + x1a[1] * c0.w) * sc;
                        o1a[2] = (x1a[2] * c1.x - x2a[2] * c1.y) * sc; o2a[2] = (x2a[2] * c1.x + x1a[2] * c1.y) * sc;
                        o1a[3] = (x1a[3] * c1.z - x2a[3] * c1.w) * sc; o2a[3] = (x2a[3] * c1.z + x1a[3] * c1.w) * sc;
                        o1b[0] = (x1b[0] * c2.x - x2b[0] * c2.y) * sc; o2b[0] = (x2b[0] * c2.x + x1b[0] * c2.y) * sc;
                        o1b[1] = (x1b[1] * c2.z - x2b[1] * c2.w) * sc; o2b[1] = (x2b[1] * c2.z + x1b[1] * c2.w) * sc;
                        o1b[2] = (x1b[2] * c3.x - x2b[2] * c3.y) * sc; o2b[2] = (x2b[2] * c3.x + x1b[2] * c3.y) * sc;
                        o1b[3] = (x1b[3] * c3.z - x2b[3] * c3.w) * sc; o2b[3] = (x2b[3] * c3.z + x1b[3] * c3.w) * sc;
                        bf16_t* rp = dst + (size_t)tok * ld + cb + d1;
                        if (skip == 2) { asm volatile("" :: "v"(o1a), "v"(o1b), "v"(o2a), "v"(o2b)); } else { store_bf16x8(rp, o1a, o1b); store_bf16x8(rp + 32, o2a, o2b); }
                    }
            } else {
                bf16_t* avT = (bf16_t*)(ws + OFF_AV);
#pragma unroll
                for (int bj = 0; bj < 2; ++bj)
#pragma unroll
                    for (int ai = 0; ai < 2; ++ai)
#pragma unroll
                        for (int m = 0; m < 4; ++m)
#pragma unroll
                            for (int n = 0; n < 2; ++n)
#pragma unroll
                                for (int j = 0; j < 4; ++j)
                                    avT[(size_t)((hidx - 18) * 64 + 32 * bj + 8 * fq + 4 * n + j) * T_ + row0 + ai * 128 + m * 16] = (bf16_t)(pk_bf16(acc[ai][bj][m][n][j], acc[ai][bj][m][n][j]) & 0xffffu);
            }
            return;
        }
#pragma unroll
        for (int bj = 0; bj < 2; ++bj) {
            const int c32 = u.pn * 256 + bj * 128 + wc * 32;
            if (u.aux == 0 && c32 >= 6400) {
                if (c32 == 6400 && fq == 0) {
                    float* gates = (float*)(ws + OFF_GATES);
#pragma unroll
                    for (int ai = 0; ai < 2; ++ai)
#pragma unroll
                        for (int m = 0; m < 4; ++m) {
                            const f32x4 v0 = acc[ai][bj][m][0], v1 = acc[ai][bj][m][1];
                            float4* gp = (float4*)(gates + (size_t)(row0 + ai * 128 + m * 16) * 8);
                            gp[0] = make_float4(v0[0], v0[1], v0[2], v0[3]); gp[1] = make_float4(v1[0], v1[1], v1[2], v1[3]);
                        }
                }
            } else if (u.aux == 2) {
                bf16_t* dst = (bf16_t*)(ws + OFF_VT);
#pragma unroll
                for (int ai = 0; ai < 2; ++ai)
#pragma unroll
                    for (int m = 0; m < 4; ++m) {
                        bf16_t* rp = dst + (size_t)(row0 + ai * 128 + m * 16) * 4096 + c32 + fq * 4;
                        store_bf16x4(rp, acc[ai][bj][m][0]); store_bf16x4(rp + 16, acc[ai][bj][m][1]);
                    }
            } else {
                bf16_t* dst; int ld, cb; bool sig = false;
                if (u.aux == 1) { dst = (bf16_t*)(ws + OFF_KMAT); ld = 1024; cb = c32; }
                else if (c32 < 2304) { dst = (bf16_t*)(ws + OFF_MQK); ld = 1024; cb = c32 - 1280; }
                else if (c32 < 3328) { dst = (bf16_t*)(ws + OFF_MV); ld = 1024; cb = c32 - 2304; }
                else if (c32 < 4352) { dst = (bf16_t*)(ws + OFF_MO); ld = 1024; cb = c32 - 3328; sig = true; }
                else { dst = (bf16_t*)(ws + OFF_GG); ld = 2048; cb = c32 - 4352; sig = true; }
#pragma unroll
                for (int ai = 0; ai < 2; ++ai)
#pragma unroll
                    for (int m = 0; m < 4; ++m) {
                        f32x4 v0 = acc[ai][bj][m][0], v1 = acc[ai][bj][m][1];
                        if (sig) {
                            v0[0] = sigmoidf_(v0[0]); v0[1] = sigmoidf_(v0[1]); v0[2] = sigmoidf_(v0[2]); v0[3] = sigmoidf_(v0[3]);
                            v1[0] = sigmoidf_(v1[0]); v1[1] = sigmoidf_(v1[1]); v1[2] = sigmoidf_(v1[2]); v1[3] = sigmoidf_(v1[3]);
                        }
                        if (skip == 2) { asm volatile("" :: "v"(v0), "v"(v1)); } else store_bf16x8(dst + (size_t)(row0 + ai * 128 + m * 16) * ld + cb + fq * 8, v0, v1);
                    }
            }
        }
    }
};

__device__ __forceinline__ void phase1(const Params& p, char* smem, int skip_epi = 0) {
    char* ws = uni(p.ws);
    SchedP1 S{(int)gridDim.x, (int)blockIdx.x, ws + OFF_R0, ws + OFF_WIN, ws + OFF_MEMB, ws + OFF_WXKV};
    EpiP1 E{ws, skip_epi};
    pg8::gemm_phase<EpiP1, SchedP1>((LDS_AS unsigned char*)smem, 1024, S, E, 0);
}

template <int NPASS>
struct SchedN1024 {
    int G, c; const char* A0; const char* B0; const char* A1; const char* B1;
    __device__ __forceinline__ bool next(int i, pg8::Unit& u) const {
        const int ti = i / NPASS, pass = i % NPASS;
        int uidx;
        if (G == 256) { if (ti >= 4) return false; const int x = c & 7, j = c >> 3; uidx = ti * 32 + j; u.pm = 32 * x + (uidx >> 2); u.pn = uidx & 3; }
        else { uidx = ti * G + c; if (uidx >= 1024) return false; u.pm = uidx >> 2; u.pn = uidx & 3; }
        u.aux = pass | ((NPASS == 2 && pass == 0) ? 0x100 : 0); u.A = pass ? A1 : A0; u.Bt = pass ? B1 : B0;
        return true;
    }
};

typedef short v4i16_t __attribute__((ext_vector_type(4)));
__device__ __forceinline__ int offQK(int row, int ch) { return row * 256 + ((ch ^ (((row & 3) << 2) | ((row >> 2) & 3))) << 4); }
__device__ __forceinline__ int offV(int row, int ch) { return row * 512 + ((ch ^ (((row & 3) | (((row >> 3) & 1) << 2)) << 1)) << 4); }
__device__ __forceinline__ int offSw(int row, int ch) { return row * 128 + ((ch ^ ((row >> 1) & 7)) << 4); }
__device__ __forceinline__ bf16x8 tr_read2(const char* p0, const char* p1) {
    const v4i16_t a = __builtin_amdgcn_ds_read_tr16_b64_v4i16((LDS_AS v4i16_t*)p0);
    const v4i16_t b = __builtin_amdgcn_ds_read_tr16_b64_v4i16((LDS_AS v4i16_t*)p1);
    return __builtin_shufflevector(a, b, 0, 1, 2, 3, 4, 5, 6, 7);
}
__device__ __forceinline__ float row16_sum(float v) {
    v += __builtin_bit_cast(float, __builtin_amdgcn_update_dpp(0, __builtin_bit_cast(int, v), 0xB1, 0xf, 0xf, true));
    v += __builtin_bit_cast(float, __builtin_amdgcn_update_dpp(0, __builtin_bit_cast(int, v), 0x4E, 0xf, 0xf, true));
    v += __builtin_bit_cast(float, __builtin_amdgcn_update_dpp(0, __builtin_bit_cast(int, v), 0x141, 0xf, 0xf, true));
    v += __builtin_bit_cast(float, __builtin_amdgcn_update_dpp(0, __builtin_bit_cast(int, v), 0x140, 0xf, 0xf, true));
    return v;
}

constexpr int PP_Q = 0, PP_K = 16384, PP_S = 32768, PP_REC = 40960, PP_EB = 41984, PP_EK = 42240, PP_CSP = 42496  , PP_RSP = 44544  , PP_END = 45056;
__device__ __forceinline__ void ml_prepass_item(const Params& p, char* smem, int item) {
    const int tid = opaque_tid(), lane = tid & 63, wid = tid >> 6, fr = lane & 15, fq = lane >> 4;
    const int c = item & 63, bh = item >> 6, b = bh >> 2, h = bh & 3;
    char* ws = uni(p.ws);
    const bf16_t* mqk = (const bf16_t*)(ws + OFF_MQK);
    const float* gates = (const float*)(ws + OFF_GATES);
    float* rec = (float*)(smem + PP_REC); float* eb = (float*)(smem + PP_EB); float* ek = (float*)(smem + PP_EK);
    float* csp = (float*)(smem + PP_CSP); float* rsp = (float*)(smem + PP_RSP);
    const long tok0 = (long)b * 4096 + c * 64;
    const int cp = tid & 127, tg = tid >> 7;
    const bool isk = cp >= 64;
    const int dch = isk ? 2 * (cp - 64) : 2 * cp;
    const int ccol = isk ? (512 + h * 128 + dch) : (h * 128 + dch);
    unsigned r[19];
#pragma unroll
    for (int i = 0; i < 19; ++i) {
        const int tl = tg * 16 - 3 + i;
        r[i] = (c == 0 && tl < 0) ? 0u : *(const unsigned*)(mqk + (tok0 + tl) * 1024 + ccol);
    }
    float cw0[4], cw1[4];
#pragma unroll
    for (int j = 0; j < 4; ++j) { cw0[j] = uni(p.conv_w)[j * 1024 + ccol]; cw1[j] = uni(p.conv_w)[j * 1024 + ccol + 1]; }
    const float cb0 = uni(p.conv_b)[ccol], cb1 = uni(p.conv_b)[ccol + 1];
    if (wid == 0) {
        const float mi0 = gates[(tok0 + lane) * 8 + h] + uni(p.b_ig)[h], x = gates[(tok0 + lane) * 8 + 4 + h] + uni(p.b_fg)[h];
        float bs = fminf(x, 0.f) - log1pf(__expf(-fabsf(x)));
#pragma unroll
        for (int o = 1; o < 64; o <<= 1) { const float y = __shfl_up(bs, o); if (lane >= o) bs += y; }
        eb[lane] = __expf(bs); ek[lane] = __expf(mi0 - bs);
        if (lane == 63) rec[192] = __expf(bs);
    }
    __syncthreads();
    {
        const int tt0 = tg * 16;
        float cs0 = 0.f, cs1 = 0.f;
        const float* scp = (isk ? ek : eb) + tt0;
        char* dstb = smem + (isk ? PP_K : PP_Q) + (dch & 7) * 2;
        const float kmul = isk ? 0.08838834764831845f : 1.0f;
#pragma unroll
        for (int tt = 0; tt < 16; ++tt) {
            float v0 = cb0 + cw0[0] * bf_lo(r[tt]) + cw0[1] * bf_lo(r[tt + 1]) + cw0[2] * bf_lo(r[tt + 2]) + cw0[3] * bf_lo(r[tt + 3]);
            float v1 = cb1 + cw1[0] * bf_hi(r[tt]) + cw1[1] * bf_hi(r[tt + 1]) + cw1[2] * bf_hi(r[tt + 2]) + cw1[3] * bf_hi(r[tt + 3]);
            v0 = v0 * sigmoidf_(v0); v1 = v1 * sigmoidf_(v1);
            const float sc = scp[tt] * kmul;
            const float a0 = v0 * sc, a1 = v1 * sc;
            *(unsigned*)(dstb + offQK(tt0 + tt, dch >> 3)) = pk_bf16(a0, a1);
            cs0 += a0; cs1 += a1;
        }
        if (isk) { csp[tg * 128 + dch] = cs0; csp[tg * 128 + dch + 1] = cs1; }
    }
    __syncthreads();
    {
        const int tt = wid >> 1;
        bf16x8 qf[4];
#pragma unroll
        for (int ks = 0; ks < 4; ++ks) qf[ks] = *(const bf16x8*)(smem + PP_Q + offQK(tt * 16 + fr, 4 * ks + fq));
        float rs = 0.f;
#pragma unroll
        for (int x = 0; x < 2; ++x) {
            const int st = (wid & 1) * 2 + x;
            f32x4 a = (f32x4){0.f, 0.f, 0.f, 0.f};
#pragma unroll
            for (int ks = 0; ks < 4; ++ks) {
                const bf16x8 kf = *(const bf16x8*)(smem + PP_K + offQK(st * 16 + fr, 4 * ks + fq));
                a = __builtin_amdgcn_mfma_f32_16x16x32_bf16(kf, qf[ks], a, 0, 0, 0);
            }
#pragma unroll
            for (int j = 0; j < 4; ++j) a[j] = (st * 16 + fq * 4 + j) <= (tt * 16 + fr) ? a[j] : 0.f;
            rs += (a[0] + a[1]) + (a[2] + a[3]);
            uint2 w; w.x = pk_bf16(a[0], a[1]); w.y = pk_bf16(a[2], a[3]);
            *(uint2*)(smem + PP_S + offSw(tt * 16 + fr, st * 2 + (fq >> 1)) + (fq & 1) * 8) = w;
        }
        rs += __shfl_xor(rs, 16); rs += __shfl_xor(rs, 32);
        if (fq == 0) rsp[(wid & 1) * 64 + tt * 16 + fr] = rs;
        if (tid < 128) rec[64 + tid] = (csp[tid] + csp[128 + tid]) + (csp[256 + tid] + csp[384 + tid]);
    }
    __syncthreads();
    if (tid < 64) rec[tid] = rsp[tid] + rsp[64 + tid];
    __syncthreads();
    {
        char* qp = (char*)uni(p.out) + OUT_QP + (size_t)item * 16384;
        char* kp = (char*)uni(p.out) + OUT_KP + (size_t)item * 16384;
        char* sp = ws + OFF_SP + (size_t)item * 8192;
        char* rp = ws + OFF_REC + (size_t)item * 1024;
#pragma unroll
        for (int i = 0; i < 2; ++i) {
            *(u32x4*)(qp + (i * 512 + tid) * 16) = *(const u32x4*)(smem + PP_Q + (i * 512 + tid) * 16);
            *(u32x4*)(kp + (i * 512 + tid) * 16) = *(const u32x4*)(smem + PP_K + (i * 512 + tid) * 16);
        }
        *(u32x4*)(sp + tid * 16) = *(const u32x4*)(smem + PP_S + tid * 16);
        if (tid < 64) *(u32x4*)(rp + tid * 16) = *(const u32x4*)(smem + PP_REC + tid * 16);
    }
    __syncthreads();
}

constexpr int SC_BUF = 41984;
constexpr int SC_V = 2 * SC_BUF;
constexpr int SC_NBF = SC_V + 65536;
constexpr int SC_END = SC_NBF + 512;
__device__ __forceinline__ void ml_scan(const Params& p, char* smem, int bh, const int mode = 0) {
    const int tid = opaque_tid(), lane = tid & 63, wid = tid >> 6, fr0 = lane & 15, fq0 = lane >> 4;
    const int b = bh >> 2, h = bh & 3;
    char* ws = uni(p.ws);
    const bf16_t* mv = (const bf16_t*)(ws + OFF_MV);
    bf16_t* hm = (bf16_t*)uni(p.out);
    float* ssqp = (float*)(ws + OFF_SSQP);
    const long tokb = (long)b * 4096;
    f32x4 C[8][2];
#pragma unroll
    for (int dt = 0; dt < 8; ++dt) { C[dt][0] = (f32x4){0.f, 0.f, 0.f, 0.f}; C[dt][1] = (f32x4){0.f, 0.f, 0.f, 0.f}; }
    const int vrl = tid >> 5, vpc = tid & 31, vlc = vpc ^ ((((vrl & 3) | (((vrl >> 3) & 1) << 2))) << 1);
    const bf16_t* vsrc = mv + (tokb + vrl) * 1024 + h * 256 + vlc * 8;
    const char* qp = (const char*)uni(p.out) + OUT_QP + (size_t)bh * 64 * 16384;
    const char* kp = (const char*)uni(p.out) + OUT_KP + (size_t)bh * 64 * 16384;
    const char* sp = ws + OFF_SP + (size_t)bh * 64 * 8192;
    const char* rp = ws + OFF_REC + (size_t)bh * 64 * 1024;
#define SC_STAGE(cc, bufoff) do { \
        _Pragma("unroll") for (int _i = 0; _i < 2; ++_i) { \
            glds16((const bf16_t*)(qp + (size_t)(cc) * 16384 + (_i * 512 + tid) * 16), smem + (bufoff) + (_i * 512 + tid) * 16); \
            glds16((const bf16_t*)(kp + (size_t)(cc) * 16384 + (_i * 512 + tid) * 16), smem + (bufoff) + 16384 + (_i * 512 + tid) * 16); } \
        glds16((const bf16_t*)(sp + (size_t)(cc) * 8192 + tid * 16), smem + (bufoff) + 32768 + tid * 16); \
        if (tid < 64) glds16((const bf16_t*)(rp + (size_t)(cc) * 1024 + tid * 16), smem + (bufoff) + 40960 + tid * 16); \
        _Pragma("unroll") for (int _i = 0; _i < 4; ++_i) glds16(vsrc + (long)(cc) * 64 * 1024 + (long)_i * 16 * 1024, smem + SC_V + ((cc) & 1) * 32768 + (_i * 512 + tid) * 16); } while (0)
    __syncthreads();
    if (tid < 256) ((bf16_t*)(smem + SC_NBF))[tid] = 0;
    float nreg = 0.f;
    SC_STAGE(0, 0);
    asm volatile("s_waitcnt vmcnt(0)" ::: "memory");
#pragma unroll 1
    for (int c = 0; c < 64; ++c) {
        const int par = c & 1;
        const long tok0 = tokb + c * 64;
        int fr = fr0, fq = fq0;
        asm volatile("" : "+v"(fr), "+v"(fq));
        const char* buf = smem + par * SC_BUF;
        asm volatile("s_waitcnt vmcnt(10) lgkmcnt(0)" ::: "memory");
        __builtin_amdgcn_s_barrier();
        if (c + 1 < 64 && !(mode & 1)) SC_STAGE(c + 1, (par ^ 1) * SC_BUF);
        f32x4 Y[4][2], DN[4];
#pragma unroll
        for (int tt = 0; tt < 4; ++tt) { Y[tt][0] = (f32x4){0.f, 0.f, 0.f, 0.f}; Y[tt][1] = (f32x4){0.f, 0.f, 0.f, 0.f}; DN[tt] = (f32x4){0.f, 0.f, 0.f, 0.f}; }
        const char* nbf = smem + SC_NBF + par * 256;
        const char* vb = smem + SC_V + par * 32768;
#define SC_LDC(ks, A, NB) do { \
            const u32x2 nlo_ = *(const u32x2*)(nbf + (32 * (ks) + 4 * fq) * 2), nhi_ = *(const u32x2*)(nbf + (32 * (ks) + 16 + 4 * fq) * 2); \
            u32x4 nv_; nv_[0] = nlo_[0]; nv_[1] = nlo_[1]; nv_[2] = nhi_[0]; nv_[3] = nhi_[1]; NB = __builtin_bit_cast(bf16x8, nv_); \
            _Pragma("unroll") for (int tt_ = 0; tt_ < 4; ++tt_) { \
                const u32x2 lo_ = *(const u32x2*)(buf + offQK(tt_ * 16 + fr, 4 * (ks) + (fq >> 1)) + (fq & 1) * 8); \
                const u32x2 hi_ = *(const u32x2*)(buf + offQK(tt_ * 16 + fr, 4 * (ks) + 2 + (fq >> 1)) + (fq & 1) * 8); \
                u32x4 av_; av_[0] = lo_[0]; av_[1] = lo_[1]; av_[2] = hi_[0]; av_[3] = hi_[1]; A[tt_] = __builtin_bit_cast(bf16x8, av_); } } while (0)
#define SC_MMC(ks, A, NB) do { \
            u32x4 c0_, c1_; \
            c0_[0] = pk_bf16(C[2 * (ks)][0][0], C[2 * (ks)][0][1]); c0_[1] = pk_bf16(C[2 * (ks)][0][2], C[2 * (ks)][0][3]); \
            c0_[2] = pk_bf16(C[2 * (ks) + 1][0][0], C[2 * (ks) + 1][0][1]); c0_[3] = pk_bf16(C[2 * (ks) + 1][0][2], C[2 * (ks) + 1][0][3]); \
            c1_[0] = pk_bf16(C[2 * (ks)][1][0], C[2 * (ks)][1][1]); c1_[1] = pk_bf16(C[2 * (ks)][1][2], C[2 * (ks)][1][3]); \
            c1_[2] = pk_bf16(C[2 * (ks) + 1][1][0], C[2 * (ks) + 1][1][1]); c1_[3] = pk_bf16(C[2 * (ks) + 1][1][2], C[2 * (ks) + 1][1][3]); \
            const bf16x8 cf0_ = __builtin_bit_cast(bf16x8, c0_), cf1_ = __builtin_bit_cast(bf16x8, c1_); \
            _Pragma("unroll") for (int tt_ = 0; tt_ < 4; ++tt_) { \
                Y[tt_][0] = __builtin_amdgcn_mfma_f32_16x16x32_bf16(A[tt_], cf0_, Y[tt_][0], 0, 0, 0); \
                Y[tt_][1] = __builtin_amdgcn_mfma_f32_16x16x32_bf16(A[tt_], cf1_, Y[tt_][1], 0, 0, 0); \
                DN[tt_] = __builtin_amdgcn_mfma_f32_16x16x32_bf16(A[tt_], NB, DN[tt_], 0, 0, 0); } } while (0)
#define SC_SCHED __builtin_amdgcn_sched_barrier(0)
        bf16x8 A0[4], A1[4], nb0, nb1;
        SC_LDC(0, A0, nb0);
        SC_LDC(1, A1, nb1); SC_SCHED; SC_MMC(0, A0, nb0); SC_SCHED;
        SC_LDC(2, A0, nb0); SC_SCHED; SC_MMC(1, A1, nb1); SC_SCHED;
        SC_LDC(3, A1, nb1); SC_SCHED; SC_MMC(2, A0, nb0); SC_SCHED;
        bf16x8 vf[2][2], sf[2][4];
#pragma unroll
        for (int ks = 0; ks < 2; ++ks)
#pragma unroll
            for (int et = 0; et < 2; ++et) {
                const int cidx = 2 * wid + et, ch = 2 * cidx + ((fr & 3) >> 1);
                const int r0 = 32 * ks + 8 * fq + (fr >> 2);
                vf[ks][et] = tr_read2(vb + offV(r0, ch) + 8 * (fr & 1), vb + offV(r0 + 4, ch) + 8 * (fr & 1));
            }
#pragma unroll
        for (int ks = 0; ks < 2; ++ks)
#pragma unroll
            for (int tt = 0; tt < 4; ++tt) sf[ks][tt] = *(const bf16x8*)(buf + 32768 + offSw(tt * 16 + fr, 4 * ks + fq));
        SC_SCHED; SC_MMC(3, A1, nb1); SC_SCHED;
#define SC_LDK(dt, ks, KF) do { const int ch_ = 2 * (dt) + ((fr & 3) >> 1); const int r0_ = 32 * (ks) + 8 * fq + (fr >> 2); \
            KF = tr_read2(buf + 16384 + offQK(r0_, ch_) + 8 * (fr & 1), buf + 16384 + offQK(r0_ + 4, ch_) + 8 * (fr & 1)); } while (0)
        bf16x8 kfa[4], kfb[4];
        SC_LDK(0, 0, kfa[0]); SC_LDK(0, 1, kfa[1]); SC_LDK(1, 0, kfa[2]); SC_LDK(1, 1, kfa[3]);
        SC_SCHED;
#pragma unroll
        for (int ks = 0; ks < 2; ++ks)
#pragma unroll
            for (int tt = 0; tt < 4; ++tt) {
                Y[tt][0] = __builtin_amdgcn_mfma_f32_16x16x32_bf16(sf[ks][tt], vf[ks][0], Y[tt][0], 0, 0, 0);
                Y[tt][1] = __builtin_amdgcn_mfma_f32_16x16x32_bf16(sf[ks][tt], vf[ks][1], Y[tt][1], 0, 0, 0);
            }
        SC_SCHED;
#define SC_MMK(dt0, KF) do { \
            C[dt0][0] = __builtin_amdgcn_mfma_f32_16x16x32_bf16(KF[0], vf[0][0], C[dt0][0], 0, 0, 0); C[dt0][1] = __builtin_amdgcn_mfma_f32_16x16x32_bf16(KF[0], vf[0][1], C[dt0][1], 0, 0, 0); \
            C[dt0][0] = __builtin_amdgcn_mfma_f32_16x16x32_bf16(KF[1], vf[1][0], C[dt0][0], 0, 0, 0); C[dt0][1] = __builtin_amdgcn_mfma_f32_16x16x32_bf16(KF[1], vf[1][1], C[dt0][1], 0, 0, 0); \
            C[dt0 + 1][0] = __builtin_amdgcn_mfma_f32_16x16x32_bf16(KF[2], vf[0][0], C[dt0 + 1][0], 0, 0, 0); C[dt0 + 1][1] = __builtin_amdgcn_mfma_f32_16x16x32_bf16(KF[2], vf[0][1], C[dt0 + 1][1], 0, 0, 0); \
            C[dt0 + 1][0] = __builtin_amdgcn_mfma_f32_16x16x32_bf16(KF[3], vf[1][0], C[dt0 + 1][0], 0, 0, 0); C[dt0 + 1][1] = __builtin_amdgcn_mfma_f32_16x16x32_bf16(KF[3], vf[1][1], C[dt0 + 1][1], 0, 0, 0); } while (0)
        SC_LDK(2, 0, kfb[0]); SC_LDK(2, 1, kfb[1]); SC_LDK(3, 0, kfb[2]); SC_LDK(3, 1, kfb[3]); SC_SCHED; SC_MMK(0, kfa); SC_SCHED;
        SC_LDK(4, 0, kfa[0]); SC_LDK(4, 1, kfa[1]); SC_LDK(5, 0, kfa[2]); SC_LDK(5, 1, kfa[3]); SC_SCHED; SC_MMK(2, kfb); SC_SCHED;
        SC_LDK(6, 0, kfb[0]); SC_LDK(6, 1, kfb[1]); SC_LDK(7, 0, kfb[2]); SC_LDK(7, 1, kfb[3]); SC_SCHED; SC_MMK(4, kfa); SC_SCHED;
        SC_MMK(6, kfb); SC_SCHED;
#undef SC_LDC
#undef SC_MMC
#undef SC_LDK
#undef SC_MMK
#undef SC_SCHED
        const float* recf = (const float*)(buf + 40960);
        float* sq_out = ssqp + ((size_t)(bh * 64 + c) * 8 + wid) * 64;
#pragma unroll
        for (int tt = 0; tt < 4; ++tt) {
            const float4 rsv = *(const float4*)(recf + tt * 16 + fq * 4);
            const float dd[4] = {rsv.x + DN[tt][0], rsv.y + DN[tt][1], rsv.z + DN[tt][2], rsv.w + DN[tt][3]};
            float sq[4];
#pragma unroll
            for (int j = 0; j < 4; ++j) {
                const float inv = __builtin_amdgcn_rcpf(fmaxf(fabsf(dd[j]), 1.0f));
                Y[tt][0][j] *= inv; Y[tt][1][j] *= inv;
                sq[j] = row16_sum(Y[tt][0][j] * Y[tt][0][j] + Y[tt][1][j] * Y[tt][1][j]);
            }
            if (!(mode & 4)) {
                if (fr == 0) *(float4*)(sq_out + tt * 16 + fq * 4) = make_float4(sq[0], sq[1], sq[2], sq[3]);
#pragma unroll
                for (int et = 0; et < 2; ++et) {
                    const int e = wid * 32 + et * 16 + fr;
                    store_bf16x4(hm + (tok0 + (e >> 2)) * 1024 + h * 256 + (e & 3) * 64 + tt * 16 + fq * 4, Y[tt][et]);
                }
            } else asm volatile("" :: "v"(Y[tt][0]), "v"(Y[tt][1]), "v"(sq[0]), "v"(sq[1]), "v"(sq[2]), "v"(sq[3]));
        }
        const float g = recf[192];
#pragma unroll
        for (int dt = 0; dt < 8; ++dt) { C[dt][0] *= g; C[dt][1] *= g; }
        if (tid < 128) {
            nreg = g * (nreg + recf[64 + (tid & 127)]);
            ((bf16_t*)(smem + SC_NBF + (par ^ 1) * 256))[tid] = (bf16_t)(pk_bf16(nreg, nreg) & 0xffffu);
        }
    }
    asm volatile("s_waitcnt vmcnt(0) lgkmcnt(0)" ::: "memory");
    __syncthreads();
#undef SC_STAGE
}

__device__ __forceinline__ void ml_finish_item(const Params& p, char* smem, int item) {
    const int tid = opaque_tid(), lane = tid & 63, wid = tid >> 6;
    const int c = item & 63, bh = item >> 6, b = bh >> 2, h = bh & 3;
    char* ws = uni(p.ws);
    bf16_t* hm = (bf16_t*)uni(p.out);
    const bf16_t* mo = (const bf16_t*)(ws + OFF_MO);
    const float* ssqp = (const float*)(ws + OFF_SSQP) + (size_t)item * 512;
    const float* gain = uni(p.ml_g) + h * 256;
    const long tok0 = (long)b * 4096 + c * 64;
    float* rs = (float*)(smem + 32768);
#pragma unroll
    for (int i = 0; i < 4; ++i) {
        const int q = i * 512 + tid;
        glds16(hm + (tok0 + (q >> 5)) * 1024 + h * 256 + (q & 31) * 8, smem + q * 16);
    }
    if (tid < 64) {
        float sacc = 0.f;
#pragma unroll
        for (int w = 0; w < 8; ++w) sacc += ssqp[w * 64 + tid];
        rs[tid] = rsqrtf(sacc * (1.0f / 256.0f) + 1e-6f);
    }
    asm volatile("s_waitcnt vmcnt(0)" ::: "memory");
    __syncthreads();
    const int i16 = lane & 15, g4 = lane >> 4, q4 = i16 >> 2, p4 = i16 & 3;
#pragma unroll
    for (int it = 0; it < 4; ++it) {
        const int combo = wid * 4 + it, tb = combo & 3, eoct = (combo >> 2) * 4 + g4;
        const int t = tb * 16 + i16, e = eoct * 8;
        const char* a0 = smem + (e + q4) * 128 + (tb * 16 + 4 * p4) * 2;
        const bf16x8 hv = tr_read2(a0, a0 + 4 * 128);
        const u32x4 hw = __builtin_bit_cast(u32x4, hv);
        const u32x4 mw = *(const u32x4*)(mo + (tok0 + t) * 1024 + h * 256 + e);
        const float4 ga = *(const float4*)(gain + e), gb = *(const float4*)(gain + e + 4);
        const float r = rs[t];
        u32x4 o;
        o[0] = pk_bf16(bf_lo(hw[0]) * r * ga.x * bf_lo(mw[0]), bf_hi(hw[0]) * r * ga.y * bf_hi(mw[0]));
        o[1] = pk_bf16(bf_lo(hw[1]) * r * ga.z * bf_lo(mw[1]), bf_hi(hw[1]) * r * ga.w * bf_hi(mw[1]));
        o[2] = pk_bf16(bf_lo(hw[2]) * r * gb.x * bf_lo(mw[2]), bf_hi(hw[2]) * r * gb.y * bf_hi(mw[2]));
        o[3] = pk_bf16(bf_lo(hw[3]) * r * gb.z * bf_lo(mw[3]), bf_hi(hw[3]) * r * gb.w * bf_hi(mw[3]));
        *(u32x4*)(hm + (tok0 + t) * 1024 + h * 256 + e) = o;
    }
    __syncthreads();
}

__device__ __forceinline__ void swa_stage(const bf16_t* ak, const bf16_t* avT, int item, char* kbuf, int tid) {
    const int kvh = item & 1, n = (item >> 1) & 31, b = item >> 6;
    const long tokbase = (long)b * 4096 + n * 128 - 128;
    const int rk = tid >> 3, pck = tid & 7, lck = pck ^ ((rk >> 1) & 7);
    const bf16_t* srck = ak + (tokbase + rk) * 128 + kvh * 64 + lck * 8;
#pragma unroll
    for (int i = 0; i < 4; ++i) glds16(srck + (long)i * 64 * 128, kbuf + (i * 512 + tid) * 16);
    const int rv = tid >> 5, pcv = tid & 31, lcv = pcv ^ (rv & 15);
    const bf16_t* srcv = avT + (long)(kvh * 64 + rv) * T_ + tokbase + lcv * 8;
#pragma unroll
    for (int i = 0; i < 4; ++i) glds16(srcv + (long)i * 16 * T_, kbuf + 32768 + (i * 512 + tid) * 16);
}
__device__ __forceinline__ const bf16_t* swa_qptr(const bf16_t* aq, int item, int u, int wid, int fr, int fq) {
    const int kvh = item & 1, n = (item >> 1) & 31, b = item >> 6;
    return aq + ((long)b * 4096 + n * 128 + u * 32 + fr) * 1024 + (kvh * 8 + wid) * 64 + fq * 8;
}
__device__ __forceinline__ void swa_items(const Params& p, char* smem, int first, int stride, int hi) {
    const int tid = opaque_tid(), lane = tid & 63, wid = tid >> 6, fr = lane & 15, fq = lane >> 4;
    char* ws = uni(p.ws);
    const bf16_t* aq = (const bf16_t*)(ws + OFF_R1);
    const bf16_t* ak = (const bf16_t*)(ws + OFF_AK);
    const bf16_t* avT = (const bf16_t*)(ws + OFF_AV);
    bf16_t* ao = (bf16_t*)(ws + OFF_R0);
    if (first >= hi) return;
    __syncthreads();
    swa_stage(ak, avT, first, smem, tid);
    bf16x8 qc[4];
    {
        const bf16_t* qp = swa_qptr(aq, first, 0, wid, fr, fq);
        qc[0] = *(const bf16x8*)(qp); qc[1] = *(const bf16x8*)(qp + 32); qc[2] = *(const bf16x8*)(qp + 16 * 1024); qc[3] = *(const bf16x8*)(qp + 16 * 1024 + 32);
    }
    int pb = 0;
    for (int item = first; item < hi; item += stride, pb ^= 1) {
        const int kvh = item & 1, n = (item >> 1) & 31, b = item >> 6;
        const int hq = kvh * 8 + wid;
        char* kbuf = smem + pb * 65536; char* vbuf = kbuf + 32768;
        const float sink = uni(p.sinks)[hq];
        asm volatile("s_waitcnt vmcnt(0)" ::: "memory");
        __syncthreads();
        const bool has_next = item + stride < hi;
        if (has_next) swa_stage(ak, avT, item + stride, smem + (pb ^ 1) * 65536, tid);
        const int kswz = (fr >> 1) & 7;
#pragma unroll 1
        for (int u = 0; u < 4; ++u) {
            const long tq = (long)b * 4096 + n * 128 + u * 32 + fr;
            bf16x8 qn[4];
            {
                const bool nx = (u < 3) || has_next;
                const bf16_t* qp = nx ? (u < 3 ? swa_qptr(aq, item, u + 1, wid, fr, fq) : swa_qptr(aq, item + stride, 0, wid, fr, fq)) : swa_qptr(aq, item, u, wid, fr, fq);
                qn[0] = *(const bf16x8*)(qp); qn[1] = *(const bf16x8*)(qp + 32); qn[2] = *(const bf16x8*)(qp + 16 * 1024); qn[3] = *(const bf16x8*)(qp + 16 * 1024 + 32);
            }
            f32x4 sc[10][2];
#pragma unroll
            for (int r = 0; r < 10; ++r) {
                sc[r][0] = (f32x4){0.f, 0.f, 0.f, 0.f}; sc[r][1] = (f32x4){0.f, 0.f, 0.f, 0.f};
                if (!(n == 0 && (2 * u + r) < 8)) {
                    const char* rowp = kbuf + ((2 * u + r) * 16 + fr) * 128;
                    const bf16x8 k0 = *(const bf16x8*)(rowp + ((fq ^ kswz) * 16)), k1 = *(const bf16x8*)(rowp + (((4 + fq) ^ kswz) * 16));
                    sc[r][0] = __builtin_amdgcn_mfma_f32_16x16x32_bf16(k0, qc[0], sc[r][0], 0, 0, 0);
                    sc[r][0] = __builtin_amdgcn_mfma_f32_16x16x32_bf16(k1, qc[1], sc[r][0], 0, 0, 0);
                    sc[r][1] = __builtin_amdgcn_mfma_f32_16x16x32_bf16(k0, qc[2], sc[r][1], 0, 0, 0);
                    sc[r][1] = __builtin_amdgcn_mfma_f32_16x16x32_bf16(k1, qc[3], sc[r][1], 0, 0, 0);
                }
            }
            u32x4 pf[2][5]; float linv[2];
#pragma unroll
            for (int nt = 0; nt < 2; ++nt) {
                float m = sink;
#pragma unroll
                for (int r = 0; r < 10; ++r) {
                    const bool tile_ok = !(n == 0 && (2 * u + r) < 8);
#pragma unroll
                    for (int j = 0; j < 4; ++j) {
                        const int delta = (r - nt) * 16 + fq * 4 + j - fr;
                        const bool ok = tile_ok && delta >= 1 && delta <= 128;
                        sc[r][nt][j] = ok ? sc[r][nt][j] : -INFINITY;
                        m = fmaxf(m, sc[r][nt][j]);
                    }
                }
                m = fmaxf(m, __shfl_xor(m, 16)); m = fmaxf(m, __shfl_xor(m, 32));
                float l = 0.f;
#pragma unroll
                for (int s2 = 0; s2 < 5; ++s2) {
                    float e[8];
#pragma unroll
                    for (int j = 0; j < 4; ++j) { e[j] = __expf(sc[2 * s2][nt][j] - m); e[4 + j] = __expf(sc[2 * s2 + 1][nt][j] - m); }
                    l += ((e[0] + e[1]) + (e[2] + e[3])) + ((e[4] + e[5]) + (e[6] + e[7]));
                    u32x4 w; w[0] = pk_bf16(e[0], e[1]); w[1] = pk_bf16(e[2], e[3]); w[2] = pk_bf16(e[4], e[5]); w[3] = pk_bf16(e[6], e[7]);
                    pf[nt][s2] = w;
                }
                l += __shfl_xor(l, 16); l += __shfl_xor(l, 32);
                linv[nt] = __builtin_amdgcn_rcpf(l + __expf(sink - m));
            }
            f32x4 o[4][2];
#pragma unroll
            for (int dt = 0; dt < 4; ++dt) { o[dt][0] = (f32x4){0.f, 0.f, 0.f, 0.f}; o[dt][1] = (f32x4){0.f, 0.f, 0.f, 0.f}; }
#pragma unroll
            for (int s2 = 0; s2 < 5; ++s2) {
                if (!(n == 0 && (2 * u + 2 * s2) < 8)) {
                    const int ca = ((((2 * u + 2 * s2) * 2 + (fq >> 1)) ^ fr) * 16) + (fq & 1) * 8;
                    const int cb = ((((2 * u + 2 * s2 + 1) * 2 + (fq >> 1)) ^ fr) * 16) + (fq & 1) * 8;
                    const bf16x8 p0 = __builtin_bit_cast(bf16x8, pf[0][s2]), p1 = __builtin_bit_cast(bf16x8, pf[1][s2]);
#pragma unroll
                    for (int dt = 0; dt < 4; ++dt) {
                        const char* rowp = vbuf + (dt * 16 + fr) * 512;
                        const u32x2 va = *(const u32x2*)(rowp + ca), vb = *(const u32x2*)(rowp + cb);
                        u32x4 vv; vv[0] = va[0]; vv[1] = va[1]; vv[2] = vb[0]; vv[3] = vb[1];
                        const bf16x8 vf = __builtin_bit_cast(bf16x8, vv);
                        o[dt][0] = __builtin_amdgcn_mfma_f32_16x16x32_bf16(vf, p0, o[dt][0], 0, 0, 0);
                        o[dt][1] = __builtin_amdgcn_mfma_f32_16x16x32_bf16(vf, p1, o[dt][1], 0, 0, 0);
                    }
                }
            }
#pragma unroll
            for (int nt = 0; nt < 2; ++nt) {
                bf16_t* rp = ao + (size_t)(tq + nt * 16) * 1024 + hq * 64 + fq * 4;
#pragma unroll
                for (int dt = 0; dt < 4; ++dt) store_bf16x4(rp + dt * 16, o[dt][nt] * linv[nt]);
            }
#pragma unroll
            for (int k = 0; k < 4; ++k) qc[k] = qn[k];
        }
    }
    asm volatile("s_waitcnt vmcnt(0)" ::: "memory");
    __syncthreads();
}

constexpr int SWA_A = 0;
__device__ __forceinline__ void phase2a(const Params& p, char* smem, int which = 3) {
    const int G = gridDim.x;
    if (which & 1) for (int it = blockIdx.x; it < 4096; it += G) ml_prepass_item(p, smem, it);
    if (which & 2) swa_items(p, smem, blockIdx.x, G, SWA_A);
}
__device__ __forceinline__ void phase2c(const Params& p, char* smem) {
    for (int it = blockIdx.x; it < 4096; it += gridDim.x) ml_finish_item(p, smem, it);
}
__device__ __forceinline__ void phase2b(const Params& p, char* smem, int which = 3, const int mode = 0) {
    const int G = gridDim.x;
    if (G > 64) {
        if (blockIdx.x < 64) { if (which & 1) ml_scan(p, smem, blockIdx.x, mode); }
        else { if (which & 2) { swa_items(p, smem, SWA_A + blockIdx.x - 64, G - 64, 1024); moe_weight_prep(p, smem, blockIdx.x - 64, G - 64); } }
    } else {
        for (int it = blockIdx.x; it < 64; it += G) ml_scan(p, smem, it);
        swa_items(p, smem, SWA_A + blockIdx.x, G, 1024);
        moe_weight_prep(p, smem, blockIdx.x, G);
    }
}

struct EpiP3 {
    const bf16_t* gg; bf16_t* y;
    __device__ __forceinline__ void operator()(f32x4 (&acc)[2][2][4][2], const pg8::Unit& u, int wr, int wc, int fr, int fq) const {
        const int row0 = u.pm * 256 + wr * 64 + fr, col0 = u.pn * 256 + wc * 32 + fq * 8;
        const bool first = (u.aux & 1) == 0;
#pragma unroll
        for (int ai = 0; ai < 2; ++ai)
#pragma unroll
            for (int m = 0; m < 4; ++m) {
                const size_t tok = row0 + ai * 128 + m * 16;
#pragma unroll
                for (int bj = 0; bj < 2; ++bj) {
                    const int col = col0 + bj * 128;
                    const u32x4 gm = *(const u32x4*)(gg + tok * 2048 + 1024 + col);
                    float gmf[8] = {bf_lo(gm[0]), bf_hi(gm[0]), bf_lo(gm[1]), bf_hi(gm[1]), bf_lo(gm[2]), bf_hi(gm[2]), bf_lo(gm[3]), bf_hi(gm[3])};
                    if (first) {
                        const u32x4 ga = *(const u32x4*)(gg + tok * 2048 + col);
                        const float gaf[8] = {bf_lo(ga[0]), bf_hi(ga[0]), bf_lo(ga[1]), bf_hi(ga[1]), bf_lo(ga[2]), bf_hi(ga[2]), bf_lo(ga[3]), bf_hi(ga[3])};
#pragma unroll
                        for (int k = 0; k < 4; ++k) {
                            acc[ai][bj][m][0][k] *= gaf[k] * __builtin_amdgcn_rcpf(fmaxf(gmf[k], 1e-30f));
                            acc[ai][bj][m][1][k] *= gaf[4 + k] * __builtin_amdgcn_rcpf(fmaxf(gmf[4 + k], 1e-30f));
                        }
                    } else {
                        f32x4 v0, v1;
#pragma unroll
                        for (int k = 0; k < 4; ++k) { v0[k] = acc[ai][bj][m][0][k] * gmf[k]; v1[k] = acc[ai][bj][m][1][k] * gmf[4 + k]; }
                        store_bf16x8(y + tok * 1024 + col, v0, v1);
                    }
                }
                if (m & 1) __builtin_amdgcn_sched_barrier(0);
            }
    }
};
__device__ __forceinline__ void phase3(const Params& p, char* smem) {
    char* ws = uni(p.ws);
    SchedN1024<2> S{(int)gridDim.x, (int)blockIdx.x, ws + OFF_R0, ws + OFF_WATT, (const char*)uni(p.out), ws + OFF_WML};
    EpiP3 E{(const bf16_t*)(ws + OFF_GG), (bf16_t*)(ws + OFF_R1)};
    pg8::gemm_phase<EpiP3, SchedN1024<2>>((LDS_AS unsigned char*)smem, 1024, S, E);
}

struct EpiBf16 {
    bf16_t* outb; float scale;
    __device__ __forceinline__ void operator()(f32x4 (&acc)[2][2][4][2], const pg8::Unit& u, int wr, int wc, int fr, int fq) const {
        const int row0 = u.pm * 256 + wr * 64 + fr, col0 = u.pn * 256 + wc * 32 + fq * 8;
#pragma unroll
        for (int ai = 0; ai < 2; ++ai)
#pragma unroll
            for (int m = 0; m < 4; ++m) {
                const size_t tok = row0 + ai * 128 + m * 16;
#pragma unroll
                for (int bj = 0; bj < 2; ++bj) store_bf16x8(outb + tok * 1024 + col0 + bj * 128, acc[ai][bj][m][0] * scale, acc[ai][bj][m][1] * scale);
            }
    }
};
__device__ __forceinline__ void phase_gemm_bf16(const Params& p, char* smem, const bf16_t* A, const bf16_t* Bt, bf16_t* outb, float scale) {
    SchedN1024<1> S{(int)gridDim.x, (int)blockIdx.x, (const char*)A, (const char*)Bt, (const char*)A, (const char*)Bt};
    EpiBf16 E{outb, scale};
    pg8::gemm_phase<EpiBf16, SchedN1024<1>>((LDS_AS unsigned char*)smem, 1024, S, E);
}

__device__ __forceinline__ void ln_row(float4 (&v)[4], const float* g, const float* bta, int lane) {
    float s = 0.f;
#pragma unroll
    for (int i = 0; i < 4; ++i) s += (v[i].x + v[i].y) + (v[i].z + v[i].w);
    const float mu = wsum(s) * (1.0f / 1024.0f);
    float q = 0.f;
#pragma unroll
    for (int i = 0; i < 4; ++i) { const float a = v[i].x - mu, b = v[i].y - mu, c = v[i].z - mu, d = v[i].w - mu; q += (a * a + b * b) + (c * c + d * d); }
    const float rstd = rsqrtf(wsum(q) * (1.0f / 1024.0f) + 1e-5f);
#pragma unroll
    for (int i = 0; i < 4; ++i) {
        const float4 gg = *(const float4*)(g + i * 256 + lane * 4), bb = *(const float4*)(bta + i * 256 + lane * 4);
        v[i].x = (v[i].x - mu) * rstd * gg.x + bb.x; v[i].y = (v[i].y - mu) * rstd * gg.y + bb.y;
        v[i].z = (v[i].z - mu) * rstd * gg.z + bb.z; v[i].w = (v[i].w - mu) * rstd * gg.w + bb.w;
    }
}

__device__ __forceinline__ void phase_ln1(const Params& p) {
    const int tid_ = opaque_tid(); const int lane = tid_ & 63, wid = tid_ >> 6;
    float* z = uni(p.out); bf16_t* hb = (bf16_t*)(uni(p.ws) + OFF_R0);
    for (int row = blockIdx.x * 8 + wid; row < T_; row += gridDim.x * 8) {
        float4 v[4];
#pragma unroll
        for (int i = 0; i < 4; ++i) {
            const float4 xx = *(const float4*)(uni(p.x) + (size_t)row * 1024 + i * 256 + lane * 4);
            const uint2 mm = *(const uint2*)(hb + (size_t)row * 1024 + i * 256 + lane * 4);
            v[i].x = ALPHA * xx.x + bf_lo(mm.x); v[i].y = ALPHA * xx.y + bf_hi(mm.x); v[i].z = ALPHA * xx.z + bf_lo(mm.y); v[i].w = ALPHA * xx.w + bf_hi(mm.y);
        }
        ln_row(v, uni(p.ln1g), uni(p.ln1b), lane);
#pragma unroll
        for (int i = 0; i < 4; ++i) {
            uint2 w; w.x = pk_bf16(v[i].x, v[i].y); w.y = pk_bf16(v[i].z, v[i].w);
            *(uint2*)(hb + (size_t)row * 1024 + i * 256 + lane * 4) = w;
        }
    }
}

__device__ __forceinline__ void xa_stage_k(const bf16_t* kmat, int b, int h, int kh, char* buf, int tid) {
    const int rl = tid >> 5, pc = tid & 31, lc = pc ^ (rl & 15);
    const bf16_t* src = kmat + (size_t)(b * 256 + kh * 128 + rl) * 1024 + h * 256 + lc * 8;
#pragma unroll
    for (int i = 0; i < 8; ++i) glds16(src + (size_t)i * 16 * 1024, buf + (i * 512 + tid) * 16);
}
__device__ __forceinline__ void xa_stage_v(const bf16_t* vT, int b, int h, int vh, char* buf, int tid) {
    const int rl = tid >> 4, pc = tid & 15, lc = pc ^ (rl & 15);
    const bf16_t* src = vT + (size_t)(h * 256 + rl) * 4096 + b * 256 + vh * 128 + lc * 8;
#pragma unroll
    for (int i = 0; i < 8; ++i) glds16(src + (size_t)i * 32 * 4096, buf + (i * 512 + tid) * 16);
}

template <int KH>
__device__ __forceinline__ void xa_scores(f32x4 (&acc)[16][2], const char* buf, const bf16x8 (&qf)[2][8], int fr, int fq) {
#pragma unroll
    for (int ks = 0; ks < 8; ++ks) {
        const int ch = ((ks * 4 + fq) ^ fr) * 16;
#pragma unroll
        for (int mt = 0; mt < 8; ++mt) {
            const bf16x8 kf = *(const bf16x8*)(buf + (mt * 16 + fr) * 512 + ch);
            acc[KH * 8 + mt][0] = __builtin_amdgcn_mfma_f32_16x16x32_bf16(kf, qf[0][ks], acc[KH * 8 + mt][0], 0, 0, 0);
            acc[KH * 8 + mt][1] = __builtin_amdgcn_mfma_f32_16x16x32_bf16(kf, qf[1][ks], acc[KH * 8 + mt][1], 0, 0, 0);
        }
        if (ks & 1) __builtin_amdgcn_sched_barrier(0);
    }
}

template <int VH, int DH>
__device__ __forceinline__ void xa_pv(f32x4 (&o)[8][2], const u32x4 (&pf)[2][8], const char* buf, int fr, int fq) {
#pragma unroll
    for (int ks = 0; ks < 4; ++ks) {
        const int ca = ((ks * 4 + (fq >> 1)) ^ fr) * 16 + (fq & 1) * 8, cb = ((ks * 4 + 2 + (fq >> 1)) ^ fr) * 16 + (fq & 1) * 8;
        const bf16x8 p0 = __builtin_bit_cast(bf16x8, pf[0][VH * 4 + ks]), p1 = __builtin_bit_cast(bf16x8, pf[1][VH * 4 + ks]);
#pragma unroll
        for (int dt = 0; dt < 8; ++dt) {
            const char* rowp = buf + ((DH * 8 + dt) * 16 + fr) * 256;
            const u32x2 va = *(const u32x2*)(rowp + ca), vb = *(const u32x2*)(rowp + cb);
            u32x4 vv; vv[0] = va[0]; vv[1] = va[1]; vv[2] = vb[0]; vv[3] = vb[1];
            const bf16x8 vf = __builtin_bit_cast(bf16x8, vv);
            o[dt][0] = __builtin_amdgcn_mfma_f32_16x16x32_bf16(vf, p0, o[dt][0], 0, 0, 0);
            o[dt][1] = __builtin_amdgcn_mfma_f32_16x16x32_bf16(vf, p1, o[dt][1], 0, 0, 0);
        }
    }
}

__device__ __forceinline__ void phase6(const Params& p, char* smem) {
    const int tid = opaque_tid(), lane = tid & 63, wid = tid >> 6, fr = lane & 15, fq = lane >> 4;
    char* ws = uni(p.ws);
    const bf16_t* xq = (const bf16_t*)(ws + OFF_XQ);
    const bf16_t* kmat = (const bf16_t*)(ws + OFF_KMAT);
    const bf16_t* vT = (const bf16_t*)(ws + OFF_VT);
    bf16_t* og = (bf16_t*)(ws + OFF_O);
    char* bufA = smem; char* bufB = smem + 65536;
    const int G = gridDim.x;
    for (int idx = blockIdx.x; idx < 1024; idx += G) {
        int pair, qt;
        if (G == 256) { const int i = idx >> 8, blk = idx & 255, xcd = blk & 7, jj = blk >> 3; pair = (i * 8 + xcd) * 2 + (jj >> 4); qt = jj & 15; }
        else { pair = idx >> 4; qt = idx & 15; }
        const int b = pair >> 2, h = pair & 3;
        const int tok0 = b * 4096 + qt * 256 + wid * 32;
        xa_stage_k(kmat, b, h, 0, bufA, tid);
        xa_stage_k(kmat, b, h, 1, bufB, tid);
        const bf16_t* q0p = xq + (size_t)(tok0 + fr) * 1024 + h * 256 + fq * 8;
        const bf16_t* q1p = q0p + (size_t)16 * 1024;
        bf16x8 qf[2][8];
#pragma unroll
        for (int ks = 0; ks < 8; ++ks) { qf[0][ks] = *(const bf16x8*)(q0p + ks * 32); qf[1][ks] = *(const bf16x8*)(q1p + ks * 32); }
        f32x4 acc[16][2];
#pragma unroll
        for (int mt = 0; mt < 16; ++mt) { acc[mt][0] = (f32x4){0.f, 0.f, 0.f, 0.f}; acc[mt][1] = (f32x4){0.f, 0.f, 0.f, 0.f}; }
        asm volatile("s_waitcnt vmcnt(0)" ::: "memory");
        __syncthreads();
        xa_scores<0>(acc, bufA, qf, fr, fq);
        xa_scores<1>(acc, bufB, qf, fr, fq);
        __syncthreads();
        xa_stage_v(vT, b, h, 0, bufA, tid);
        xa_stage_v(vT, b, h, 1, bufB, tid);
        u32x4 pf[2][8]; float linv[2];
#pragma unroll
        for (int nt = 0; nt < 2; ++nt) {
            float m = -INFINITY;
#pragma unroll
            for (int mt = 0; mt < 16; ++mt) m = fmaxf(m, fmaxf(fmaxf(acc[mt][nt][0], acc[mt][nt][1]), fmaxf(acc[mt][nt][2], acc[mt][nt][3])));
            m = fmaxf(m, __shfl_xor(m, 16)); m = fmaxf(m, __shfl_xor(m, 32));
            float l = 0.f;
#pragma unroll
            for (int s2 = 0; s2 < 8; ++s2) {
                float e[8];
#pragma unroll
                for (int j = 0; j < 4; ++j) { e[j] = __expf(acc[2 * s2][nt][j] - m); e[4 + j] = __expf(acc[2 * s2 + 1][nt][j] - m); }
                l += ((e[0] + e[1]) + (e[2] + e[3])) + ((e[4] + e[5]) + (e[6] + e[7]));
                u32x4 w; w[0] = pk_bf16(e[0], e[1]); w[1] = pk_bf16(e[2], e[3]); w[2] = pk_bf16(e[4], e[5]); w[3] = pk_bf16(e[6], e[7]);
                pf[nt][s2] = w;
            }
            l += __shfl_xor(l, 16); l += __shfl_xor(l, 32);
            linv[nt] = 1.0f / l;
        }
        asm volatile("s_waitcnt vmcnt(0)" ::: "memory");
        __syncthreads();
        {
            f32x4 o[8][2];
#pragma unroll
            for (int dt = 0; dt < 8; ++dt) { o[dt][0] = (f32x4){0.f, 0.f, 0.f, 0.f}; o[dt][1] = (f32x4){0.f, 0.f, 0.f, 0.f}; }
            xa_pv<0, 0>(o, pf, bufA, fr, fq);
            xa_pv<1, 0>(o, pf, bufB, fr, fq);
#pragma unroll
            for (int nt = 0; nt < 2; ++nt) {
                bf16_t* rp = og + (size_t)(tok0 + nt * 16 + fr) * 1024 + h * 256 + fq * 4;
#pragma unroll
                for (int dt = 0; dt < 8; ++dt) store_bf16x4(rp + dt * 16, o[dt][nt] * linv[nt]);
            }
        }
        {
            f32x4 o[8][2];
#pragma unroll
            for (int dt = 0; dt < 8; ++dt) { o[dt][0] = (f32x4){0.f, 0.f, 0.f, 0.f}; o[dt][1] = (f32x4){0.f, 0.f, 0.f, 0.f}; }
            xa_pv<0, 1>(o, pf, bufA, fr, fq);
            xa_pv<1, 1>(o, pf, bufB, fr, fq);
#pragma unroll
            for (int nt = 0; nt < 2; ++nt) {
                bf16_t* rp = og + (size_t)(tok0 + nt * 16 + fr) * 1024 + h * 256 + 128 + fq * 4;
#pragma unroll
                for (int dt = 0; dt < 8; ++dt) store_bf16x4(rp + dt * 16, o[dt][nt] * linv[nt]);
            }
        }
        __syncthreads();
    }
}

__device__ __forceinline__ bool rt_better(float va, int ia, float vb, int ib) { return va > vb || (va == vb && ia < ib); }
__device__ __forceinline__ void phase_ln2_router(const Params& p, char* smem, const int mode = 0) {
    const int tid = opaque_tid(), lane = tid & 63, wid = tid >> 6;
    char* ws = uni(p.ws);
    float* z = (float*)(ws + OFF_Z2); bf16_t* hb = (bf16_t*)(ws + OFF_R0); const bf16_t* xa = (const bf16_t*)(ws + OFF_XQ);
    const float* h1 = uni(p.out);
    int2* toke = (int2*)(ws + OFF_TOKE); float2* tokw = (float2*)(ws + OFF_TOKW);
    int* histg = (int*)(ws + OFF_HIST);
    float* hs = (float*)(smem + wid * 16512);
    int* hist = (int*)(smem + 132096);
    const float* w_rg = uni(p.w_rg); const float* w_re = uni(p.w_re); const float* b_rg = uni(p.b_rg); const float* b_re = uni(p.b_re);
    const float* ln2g = uni(p.ln2g); const float* ln2b = uni(p.ln2b);
    const int chalf = lane & 1, kk = (lane >> 1) & 7, r = lane >> 4;
    for (int c = blockIdx.x; c < 256; c += gridDim.x) {
        if (tid < 64) hist[tid] = 0;
        __syncthreads();
#pragma unroll 1
        for (int rg = 0; rg < 8; ++rg) {
            const int rowbase = c * 256 + wid * 32 + rg * 4;
#pragma unroll
            for (int rr = 0; rr < 4; ++rr) {
                const int row = rowbase + rr;
                float4 v[4];
#pragma unroll
                for (int i = 0; i < 4; ++i) {
                    const uint2 hh = *(const uint2*)(hb + (size_t)row * 1024 + i * 256 + lane * 4);
                    const uint2 mm = *(const uint2*)(xa + (size_t)row * 1024 + i * 256 + lane * 4);
                    v[i].x = ALPHA * bf_lo(hh.x) + bf_lo(mm.x); v[i].y = ALPHA * bf_hi(hh.x) + bf_hi(mm.x); v[i].z = ALPHA * bf_lo(hh.y) + bf_lo(mm.y); v[i].w = ALPHA * bf_hi(hh.y) + bf_hi(mm.y);
                }
                ln_row(v, ln2g, ln2b, lane);
#pragma unroll
                for (int i = 0; i < 4; ++i) {
                    uint2 w; w.x = pk_bf16(v[i].x, v[i].y); w.y = pk_bf16(v[i].z, v[i].w);
                    if (!(mode & 2)) *(uint2*)(hb + (size_t)row * 1024 + i * 256 + lane * 4) = w;
                    *(float4*)(hs + rr * 1032 + i * 256 + lane * 4) = v[i];
                }
            }
            __builtin_amdgcn_wave_barrier();
            asm volatile("s_waitcnt lgkmcnt(0)" ::: "memory");
            if (mode & 1) continue;
            float g0, g1, g2, g3;
            {
                const int kq = lane >> 1;
                float ga[4][4];
#pragma unroll
                for (int rr = 0; rr < 4; ++rr) { ga[rr][0] = 0.f; ga[rr][1] = 0.f; ga[rr][2] = 0.f; ga[rr][3] = 0.f; }
#pragma unroll 8
                for (int s32 = 0; s32 < 32; ++s32) {
                    const int k = s32 * 32 + kq;
                    const float4 w = *(const float4*)(w_rg + (size_t)k * 8 + chalf * 4);
#pragma unroll
                    for (int rr = 0; rr < 4; ++rr) {
                        const float hv = hs[rr * 1032 + k];
                        ga[rr][0] += hv * w.x; ga[rr][1] += hv * w.y; ga[rr][2] += hv * w.z; ga[rr][3] += hv * w.w;
                    }
                }
#pragma unroll
                for (int rr = 0; rr < 4; ++rr)
#pragma unroll
                    for (int q = 0; q < 4; ++q) {
                        float v = ga[rr][q];
                        v += __builtin_bit_cast(float, __builtin_amdgcn_update_dpp(0, __builtin_bit_cast(int, v), 0x4E, 0xf, 0xf, true));
                        v += __builtin_bit_cast(float, __builtin_amdgcn_update_dpp(0, __builtin_bit_cast(int, v), 0x124, 0xf, 0xf, true));
                        v += __builtin_bit_cast(float, __builtin_amdgcn_update_dpp(0, __builtin_bit_cast(int, v), 0x128, 0xf, 0xf, true));
                        v += __shfl_xor(v, 16); v += __shfl_xor(v, 32);
                        ga[rr][q] = v;
                    }
                g0 = r == 0 ? ga[0][0] : r == 1 ? ga[1][0] : r == 2 ? ga[2][0] : ga[3][0];
                g1 = r == 0 ? ga[0][1] : r == 1 ? ga[1][1] : r == 2 ? ga[2][1] : ga[3][1];
                g2 = r == 0 ? ga[0][2] : r == 1 ? ga[1][2] : r == 2 ? ga[2][2] : ga[3][2];
                g3 = r == 0 ? ga[0][3] : r == 1 ? ga[1][3] : r == 2 ? ga[2][3] : ga[3][3];
            }
            {
                const float4 bb = *(const float4*)(b_rg + chalf * 4);
                g0 += bb.x; g1 += bb.y; g2 += bb.z; g3 += bb.w;
            }
            float mv = g0; int mi = chalf * 4;
            if (g1 > mv) { mv = g1; mi = chalf * 4 + 1; }
            if (g2 > mv) { mv = g2; mi = chalf * 4 + 2; }
            if (g3 > mv) { mv = g3; mi = chalf * 4 + 3; }
            { const float ov = __shfl_xor(mv, 1); const int oi = __shfl_xor(mi, 1); if (rt_better(ov, oi, mv, mi)) { mv = ov; mi = oi; } }
            float es = (__expf(g0 - mv) + __expf(g1 - mv)) + (__expf(g2 - mv) + __expf(g3 - mv));
            es += __shfl_xor(es, 1);
            const float pgroup = 1.0f / es;
            const int gsel = mi;
            float e0 = 0.f, e1 = 0.f, e2 = 0.f, e3 = 0.f;
            {
                const float* we = w_re + gsel * 8 + chalf * 4;
#pragma unroll 32
                for (int s8 = 0; s8 < 128; ++s8) {
                    const int k = s8 * 8 + kk;
                    const float4 w = *(const float4*)(we + (size_t)k * 64);
                    const float hv = hs[r * 1032 + k];
                    e0 += hv * w.x; e1 += hv * w.y; e2 += hv * w.z; e3 += hv * w.w;
                }
            }
#pragma unroll
            for (int o = 2; o < 16; o <<= 1) { e0 += __shfl_xor(e0, o); e1 += __shfl_xor(e1, o); e2 += __shfl_xor(e2, o); e3 += __shfl_xor(e3, o); }
            {
                const float4 bb = *(const float4*)(b_re + gsel * 8 + chalf * 4);
                e0 += bb.x; e1 += bb.y; e2 += bb.z; e3 += bb.w;
            }
            float v0 = e0, v1 = -INFINITY; int i0 = chalf * 4, i1 = 99;
            {
                const float ev[3] = {e1, e2, e3};
#pragma unroll
                for (int q = 0; q < 3; ++q) {
                    const float x = ev[q]; const int xi = chalf * 4 + q + 1;
                    if (x > v0) { v1 = v0; i1 = i0; v0 = x; i0 = xi; } else if (x > v1) { v1 = x; i1 = xi; }
                }
            }
            {
                const float b0 = __shfl_xor(v0, 1), b1 = __shfl_xor(v1, 1); const int k0 = __shfl_xor(i0, 1), k1 = __shfl_xor(i1, 1);
                float n0, n1; int m0, m1;
                if (rt_better(v0, i0, b0, k0)) { n0 = v0; m0 = i0; if (rt_better(v1, i1, b0, k0)) { n1 = v1; m1 = i1; } else { n1 = b0; m1 = k0; } }
                else { n0 = b0; m0 = k0; if (rt_better(b1, k1, v0, i0)) { n1 = b1; m1 = k1; } else { n1 = v0; m1 = i0; } }
                v0 = n0; i0 = m0; v1 = n1; i1 = m1;
            }
            if (kk == 0 && chalf == 0) {
                const float x1 = __expf(v1 - v0), den = 1.0f + x1;
                const int ea = gsel * 8 + i0, eb2 = gsel * 8 + i1;
                toke[rowbase + r] = make_int2(ea, eb2); tokw[rowbase + r] = make_float2(pgroup / den, pgroup * x1 / den);
                atomicAdd(&hist[ea], 1); atomicAdd(&hist[eb2], 1);
            }
            __builtin_amdgcn_wave_barrier();
        }
        __syncthreads();
        if (tid < 64 && !(mode & 1)) histg[c * 64 + tid] = hist[tid];
        __syncthreads();
    }
}

__device__ __forceinline__ void compute_segments(const int* histg, int* seg, int tid) {
    if (tid < 64) {
        int s = 0;
        for (int c = 0; c < 256; ++c) s += histg[c * 64 + tid];
        seg[tid] = s;
    }
    __syncthreads();
    if (tid == 0) {
        int acc = 0;
        for (int e = 0; e < 64; ++e) { seg[64 + e] = acc; acc += (seg[e] + 255) >> 8; }
        seg[128] = acc;
    }
    __syncthreads();
}

__device__ __forceinline__ void phase8(const Params& p, char* smem) {
    const int tid = opaque_tid();
    char* ws = uni(p.ws);
    const int* histg = (const int*)(ws + OFF_HIST);
    const int2* toke = (const int2*)(ws + OFF_TOKE); const float2* tokw = (const float2*)(ws + OFF_TOKW);
    int* slot_tok = (int*)(ws + OFF_SLOTTOK); float* slot_w = (float*)(ws + OFF_SLOTW);
    int* seg = (int*)smem;
    int* cursor = seg + 192;
    compute_segments(histg, seg, tid);
    for (int e = blockIdx.x; e < 64; e += gridDim.x) {
        const int start = seg[64 + e] * 256 + seg[e], end = seg[64 + e + 1] * 256;
        for (int s = start + tid; s < end; s += NTHR) { slot_tok[s] = -1; slot_w[s] = 0.f; }
    }
    for (int c = blockIdx.x; c < 256; c += gridDim.x) {
        __syncthreads();
        if (tid < 64) {
            int base = 0;
            for (int cc = 0; cc < c; ++cc) base += histg[cc * 64 + tid];
            cursor[tid] = seg[64 + tid] * 256 + base;
        }
        __syncthreads();
        if (tid < 256) {
            const int tok = c * 256 + tid;
            const int2 ee = toke[tok]; const float2 ww = tokw[tok];
            const int s0 = atomicAdd(&cursor[ee.x], 1);
            const int s1 = atomicAdd(&cursor[ee.y], 1);
            slot_tok[s0] = tok * 2; slot_w[s0] = ww.x;
            slot_tok[s1] = tok * 2 + 1; slot_w[s1] = ww.y;
        }
    }
}

struct Sched9a {
    int G, c, nrt; const int* seg; const int* slot_tok; const char* h2b; const char* wgu;
    __device__ __forceinline__ bool next(int i, pg8::Unit& u) const {
        int rtile, pn;
        if ((G & 7) == 0) { const int x = c & 7, j = c >> 3, nj = G >> 3, per = (nrt + 7) >> 3; const int uidx = i * nj + j; if (uidx >= per * 2) return false; rtile = x * per + (uidx >> 1); pn = uidx & 1; if (rtile >= nrt) return false; }
        else { const int uidx = i * G + c; if (uidx >= nrt * 2) return false; rtile = uidx >> 1; pn = uidx & 1; }
        int e = 0;
        for (int k = 1; k < 64; ++k) if (seg[64 + k] <= rtile) e = k;
        e = __builtin_amdgcn_readfirstlane(e);
        u.pm = rtile; u.pn = pn; u.aux = e; u.A = h2b; u.Bt = wgu + (size_t)e * 512 * 1024 * 2;
        return true;
    }
    __device__ __forceinline__ unsigned arow(const pg8::Unit& u, int r) const {
        const int tk = slot_tok[u.pm * 256 + r];
        return (unsigned)(tk < 0 ? 0 : (tk >> 1)) * 2048u;
    }
};
struct Epi9a {
    bf16_t* hbuf;
    __device__ __forceinline__ void operator()(f32x4 (&acc)[2][2][4][2], const pg8::Unit& u, int wr, int wc, int fr, int fq) const {
        const int row0 = u.pm * 256 + wr * 64 + fr, col0 = u.pn * 128 + wc * 32 + fq * 8;
#pragma unroll
        for (int ai = 0; ai < 2; ++ai)
#pragma unroll
            for (int m = 0; m < 4; ++m) {
                const size_t slot = row0 + ai * 128 + m * 16;
                f32x4 v0, v1;
#pragma unroll
                for (int j = 0; j < 4; ++j) {
                    const float g0 = acc[ai][0][m][0][j], g1 = acc[ai][0][m][1][j];
                    v0[j] = g0 * sigmoidf_(g0) * acc[ai][1][m][0][j]; v1[j] = g1 * sigmoidf_(g1) * acc[ai][1][m][1][j];
                }
                store_bf16x8(hbuf + slot * 256 + col0, v0, v1);
            }
    }
};
__device__ __forceinline__ void phase9a(const Params& p, char* smem) {
    const int tid = opaque_tid();
    char* ws = uni(p.ws);
    int* seg = (int*)(smem + LDS_GEMM);
    compute_segments((const int*)(ws + OFF_HIST), seg, tid);
    Sched9a S{(int)gridDim.x, (int)blockIdx.x, __builtin_amdgcn_readfirstlane(seg[128]), seg, (const int*)(ws + OFF_SLOTTOK), ws + OFF_R0, ws + OFF_WGU};
    Epi9a E{(bf16_t*)(ws + OFF_R1)};
    pg8::gemm_phase<Epi9a, Sched9a, true>((LDS_AS unsigned char*)smem, 1024, S, E);
}

struct Sched9b {
    int G, c, nrt; const int* seg; const char* hbuf; const char* wd;
    __device__ __forceinline__ bool next(int i, pg8::Unit& u) const {
        int rtile, pn;
        if ((G & 7) == 0) { const int x = c & 7, j = c >> 3, nj = G >> 3, per = (nrt + 7) >> 3; const int uidx = i * nj + j; if (uidx >= per * 4) return false; rtile = x * per + (uidx >> 2); pn = uidx & 3; if (rtile >= nrt) return false; }
        else { const int uidx = i * G + c; if (uidx >= nrt * 4) return false; rtile = uidx >> 2; pn = uidx & 3; }
        int e = 0;
        for (int k = 1; k < 64; ++k) if (seg[64 + k] <= rtile) e = k;
        e = __builtin_amdgcn_readfirstlane(e);
        u.pm = rtile; u.pn = pn; u.aux = e; u.A = hbuf; u.Bt = wd + (size_t)e * 1024 * 256 * 2;
        return true;
    }
};
struct Epi9b {
    const int* slot_tok; const float* slot_w; bf16_t* yb;
    __device__ __forceinline__ void operator()(f32x4 (&acc)[2][2][4][2], const pg8::Unit& u, int wr, int wc, int fr, int fq) const {
        const int row0 = u.pm * 256 + wr * 64 + fr, col0 = u.pn * 256 + wc * 32 + fq * 8;
#pragma unroll
        for (int ai = 0; ai < 2; ++ai)
#pragma unroll
            for (int m = 0; m < 4; ++m) {
                const int slot = row0 + ai * 128 + m * 16;
                const int tk = slot_tok[slot]; const float w = slot_w[slot];
                if (tk >= 0) {
#pragma unroll
                    for (int bj = 0; bj < 2; ++bj) store_bf16x8(yb + (size_t)tk * 1024 + col0 + bj * 128, acc[ai][bj][m][0] * w, acc[ai][bj][m][1] * w);
                }
            }
    }
};
__device__ __forceinline__ void phase9b(const Params& p, char* smem) {
    const int tid = opaque_tid();
    char* ws = uni(p.ws);
    int* seg = (int*)(smem + LDS_GEMM);
    compute_segments((const int*)(ws + OFF_HIST), seg, tid);
    Sched9b S{(int)gridDim.x, (int)blockIdx.x, __builtin_amdgcn_readfirstlane(seg[128]), seg, ws + OFF_R1, ws + OFF_WD};
    Epi9b E{(const int*)(ws + OFF_SLOTTOK), (const float*)(ws + OFF_SLOTW), (bf16_t*)(ws + OFF_YB)};
    pg8::gemm_phase<Epi9b, Sched9b>((LDS_AS unsigned char*)smem, 256, S, E);
}

__device__ __forceinline__ void phase10(const Params& p) {
    const int tid_ = opaque_tid(); const int lane = tid_ & 63, wid = tid_ >> 6;
    const bf16_t* h2 = (const bf16_t*)(uni(p.ws) + OFF_R0); const bf16_t* yb = (const bf16_t*)(uni(p.ws) + OFF_YB);
    for (int row = blockIdx.x * 8 + wid; row < T_; row += gridDim.x * 8) {
        float4 v[4];
#pragma unroll
        for (int i = 0; i < 4; ++i) {
            const uint2 hh = *(const uint2*)(h2 + (size_t)row * 1024 + i * 256 + lane * 4);
            const uint2 a = *(const uint2*)(yb + (size_t)(row * 2) * 1024 + i * 256 + lane * 4), b = *(const uint2*)(yb + (size_t)(row * 2 + 1) * 1024 + i * 256 + lane * 4);
            v[i].x = ALPHA * bf_lo(hh.x) + bf_lo(a.x) + bf_lo(b.x); v[i].y = ALPHA * bf_hi(hh.x) + bf_hi(a.x) + bf_hi(b.x);
            v[i].z = ALPHA * bf_lo(hh.y) + bf_lo(a.y) + bf_lo(b.y); v[i].w = ALPHA * bf_hi(hh.y) + bf_hi(a.y) + bf_hi(b.y);
        }
        ln_row(v, uni(p.ln3g), uni(p.ln3b), lane);
#pragma unroll
        for (int i = 0; i < 4; ++i) *(float4*)(uni(p.out) + (size_t)row * 1024 + i * 256 + lane * 4) = v[i];
    }
}

#define XB_TMO      128
#define XB_XCNT(j)  (256  + 64 * (j))
#define XB_XSUB(j)  (1280 + 64 * (j))
#define XB_XGEN(j)  (2304 + 64 * (j))
#define XB_TOP      3328
#define XB_TOPGEN   3392
#define XCD_BAR_WORDS 3456
#define XB_SPIN_CAP (1u << 18)
#define LAS LDS_AS

__device__ __forceinline__ unsigned xb_ld(unsigned* p)              { return __hip_atomic_load(p, __ATOMIC_RELAXED, __HIP_MEMORY_SCOPE_AGENT); }
__device__ __forceinline__ unsigned xb_add(unsigned* p, unsigned v) { return __hip_atomic_fetch_add(p, v, __ATOMIC_RELAXED, __HIP_MEMORY_SCOPE_AGENT); }
__device__ __forceinline__ unsigned xb_xcc_id() { return (unsigned)__builtin_amdgcn_s_getreg((3 << 11) | 20) & 0xFu; }
#define XB_SPIN(cond, bar) do { unsigned _sp = 0; while (cond) { __builtin_amdgcn_s_sleep(1); \
    if ((++_sp & 255u) == 0u) { if (xb_ld(&(bar)[XB_TMO])) break; if (_sp > XB_SPIN_CAP) { atomicAdd(&(bar)[XB_TMO], 1u); break; } } } } while (0)

struct XcdBarrier {
    unsigned* bar; unsigned x;
    volatile LAS unsigned* st;
};

__device__ __forceinline__ XcdBarrier xcd_barrier_post(unsigned* bar, volatile LAS unsigned* st) {
    XcdBarrier b; b.bar = bar; b.x = xb_xcc_id(); b.st = st;
    if (threadIdx.x == 0) (void)xb_add(&bar[XB_XCNT(b.x)], 1u);
    return b;
}
__device__ __forceinline__ void xcd_barrier_complete(unsigned* bar, unsigned x, unsigned& nloc, unsigned& nx) {
    const unsigned G = gridDim.x * gridDim.y * gridDim.z;
    unsigned sum, cnt, mine, sp = 0u;
    for (;;) {
        sum = 0u; cnt = 0u; mine = 0u;
#pragma unroll
        for (unsigned j = 0; j < 16; ++j) { const unsigned c = xb_ld(&bar[XB_XCNT(j)]); sum += c; cnt += (c > 0u) ? 1u : 0u; mine = (j == x) ? c : mine; }
        if (sum == G) break;
        __builtin_amdgcn_s_sleep(1);
        if ((++sp & 255u) == 0u) { if (xb_ld(&bar[XB_TMO])) break; if (sp > XB_SPIN_CAP) { atomicAdd(&bar[XB_TMO], 1u); break; } }
    }
    nloc = mine > 0u ? mine : 1u; nx = cnt > 0u ? cnt : 1u;
}

__device__ __forceinline__ void xcd_barrier(const XcdBarrier& b) {
    asm volatile("s_waitcnt vmcnt(0)" ::: "memory");
    __syncthreads();
    if (threadIdx.x == 0) {
        unsigned* bar = b.bar;
        __builtin_amdgcn_s_waitcnt(0);
        unsigned nloc = b.st[0], nx = b.st[1];
        if (nloc == 0u) { xcd_barrier_complete(bar, b.x, nloc, nx); b.st[0] = nloc; b.st[1] = nx; }
        const unsigned old = xb_add(&bar[XB_XSUB(b.x)], 1u);
        const unsigned gen = old / nloc;
        if (old + 1u == (gen + 1u) * nloc) {
            __builtin_amdgcn_fence(__ATOMIC_RELEASE, "agent");
            asm volatile("s_waitcnt vmcnt(0)" ::: "memory");
            const unsigned og = xb_add(&bar[XB_TOP], 1u);
            const unsigned tg = og / nx;
            if (og + 1u == (tg + 1u) * nx) xb_add(&bar[XB_TOPGEN], 1u);
            else XB_SPIN(xb_ld(&bar[XB_TOPGEN]) == tg, bar);
            __builtin_amdgcn_fence(__ATOMIC_ACQUIRE, "agent");
            xb_add(&bar[XB_XGEN(b.x)], 1u);
            asm volatile("s_waitcnt vmcnt(0)" ::: "memory");
        } else {
            XB_SPIN(xb_ld(&bar[XB_XGEN(b.x)]) == gen, bar);
            __builtin_amdgcn_fence(__ATOMIC_ACQUIRE, "agent");
            asm volatile("s_waitcnt vmcnt(0)" ::: "memory");
        }
    }
    __syncthreads();
}


#ifndef DUP
#define DUP (-1)
#endif
#define RUN(id, call) do { call; if (DUP == (id)) { GRID_SYNC(); call; } } while (0)
__global__ void __launch_bounds__(NTHR) mega(Params pk) {
    extern __shared__ __attribute__((aligned(16))) char smem[];
    cg::grid_group grid = cg::this_grid();
    if (threadIdx.x == 0) *(Params*)(smem + LDS_PARAMS) = pk;
    __syncthreads();
    const Params& p = *(const Params*)(smem + LDS_PARAMS);
    char* ws = uni(p.ws);
    volatile LDS_AS unsigned* xst = (volatile LDS_AS unsigned*)(LDS_AS char*)smem + (LDS_XB / 4);
    if (threadIdx.x < 4) xst[threadIdx.x] = 0u;
    __syncthreads();
    (void)xcd_barrier_post((unsigned*)(ws + OFF_BAR), xst);
#define GRID_SYNC() do { XcdBarrier xb_; xb_.bar = (unsigned*)(uni(p.ws) + OFF_BAR); xb_.x = xb_xcc_id(); xb_.st = (volatile LDS_AS unsigned*)(LDS_AS char*)smem + (LDS_XB / 4); xcd_barrier(xb_); } while (0)
    RUN(0, phase0(p, smem));
    if (DUP == 61) { GRID_SYNC(); phase0(p, smem, 1); }
    if (DUP == 62) { GRID_SYNC(); phase0(p, smem, 2); }
    if (DUP == 64) { GRID_SYNC(); phase0(p, smem, 4); }
    grid.sync();
    RUN(1, phase1(p, smem));
    if (DUP == 30) { GRID_SYNC(); phase1(p, smem, 1); }
    if (DUP == 31) { GRID_SYNC(); phase1(p, smem, 2); }
    GRID_SYNC();
    RUN(2, phase2a(p, smem));
    if (DUP == 20) { GRID_SYNC(); phase2a(p, smem, 1); }
    if (DUP == 21) { GRID_SYNC(); phase2a(p, smem, 2); }
    GRID_SYNC();
    RUN(12, phase2b(p, smem));
    if (DUP == 22) { GRID_SYNC(); phase2b(p, smem, 1); }
    if (DUP == 23) { GRID_SYNC(); phase2b(p, smem, 2); }
    if (DUP == 24) { GRID_SYNC(); phase2b(p, smem, 1, 4); }
    if (DUP == 25) { GRID_SYNC(); phase2b(p, smem, 1, 5); }
    if (DUP == 26) { GRID_SYNC(); phase2b(p, smem, 1, 13); }
    GRID_SYNC();
    phase2c(p, smem);
    GRID_SYNC();
    RUN(3, phase3(p, smem));
    GRID_SYNC();
    RUN(4, phase_gemm_bf16(p, smem, (const bf16_t*)(ws + OFF_R1), (const bf16_t*)(ws + OFF_WMIX), (bf16_t*)(ws + OFF_R0), 1.0f));
    GRID_SYNC();
    phase_ln1(p);
    GRID_SYNC();
    RUN(6, phase_gemm_bf16(p, smem, (const bf16_t*)(ws + OFF_R0), (const bf16_t*)(ws + OFF_WXQ), (bf16_t*)(ws + OFF_XQ), 0.0625f));
    GRID_SYNC();
    RUN(7, phase6(p, smem));
    GRID_SYNC();
    RUN(8, phase_gemm_bf16(p, smem, (const bf16_t*)(ws + OFF_O), (const bf16_t*)(ws + OFF_WXO), (bf16_t*)(ws + OFF_XQ), 1.0f));
    GRID_SYNC();
    RUN(13, phase_ln2_router(p, smem));
    if (DUP == 51) { GRID_SYNC(); phase_ln2_router(p, smem, 1); }
    if (DUP == 53) { GRID_SYNC(); phase_ln2_router(p, smem, 3); }
    GRID_SYNC();
    RUN(9, phase8(p, smem));
    GRID_SYNC();
    RUN(10, phase9a(p, smem));
    GRID_SYNC();
    RUN(11, phase9b(p, smem));
    GRID_SYNC();
    RUN(14, phase10(p));
}

extern "C" void kernel_launch(void* const* d_in, const int* in_sizes, int n_in, void* d_out, int out_size,
                              void* d_ws, size_t ws_size, hipStream_t stream) {
    static int grid_blocks = 0;
    if (!grid_blocks) {
        int dev = 0, cus = 0, per_cu = 0;
        (void)hipGetDevice(&dev);
        (void)hipDeviceGetAttribute(&cus, hipDeviceAttributeMultiprocessorCount, dev);
        (void)hipFuncSetAttribute((const void*)mega, hipFuncAttributeMaxDynamicSharedMemorySize, LDS_BYTES);
        (void)hipOccupancyMaxActiveBlocksPerMultiprocessor(&per_cu, mega, NTHR, LDS_BYTES);
        if (per_cu > 1) per_cu = 1;
        grid_blocks = cus * per_cu;
        if (ws_size < WS_NEED) fprintf(stderr, "workspace too small: %zu\n", ws_size);
    }
    Params p{};
    const float* const* f = (const float* const*)d_in;
    p.x = f[0]; p.mem = f[1]; p.pos = (const int*)d_in[2];
    p.w_in = f[3]; p.sinks = f[4]; p.conv_w = f[5]; p.conv_b = f[6]; p.b_ig = f[7]; p.b_fg = f[8]; p.ml_g = f[9];
    p.w_att = f[10]; p.w_ml = f[11]; p.w_mix = f[12]; p.ln1g = f[13]; p.ln1b = f[14];
    p.w_xq = f[15]; p.w_xkv = f[16]; p.w_xo = f[17]; p.ln2g = f[18]; p.ln2b = f[19];
    p.w_rg = f[20]; p.b_rg = f[21]; p.w_re = f[22]; p.b_re = f[23]; p.w_gate = f[24]; p.w_up = f[25]; p.w_down = f[26];
    p.ln3g = f[27]; p.ln3b = f[28];
    p.out = (float*)d_out; p.ws = (char*)d_ws;
    (void)hipMemsetAsync((char*)d_ws + OFF_BAR, 0, XCD_BAR_WORDS * sizeof(unsigned), stream);
    void* args[] = {&p};
    hipError_t e = hipLaunchCooperativeKernel((void*)mega, dim3(grid_blocks), dim3(NTHR), args, LDS_BYTES, stream);
    if (e != hipSuccess) fprintf(stderr, "cooperative launch failed: %s (grid %d)\n", hipGetErrorString(e), grid_blocks);
}
```

```cpp
#include <hip/hip_runtime.h>
#include <hip/hip_cooperative_groups.h>
#include <cstdio>
#include <cstdint>
namespace cg = cooperative_groups;

typedef unsigned short bf16_t;
typedef short bf16x8 __attribute__((ext_vector_type(8)));
typedef float f32x4 __attribute__((ext_vector_type(4)));
typedef unsigned u32x2 __attribute__((ext_vector_type(2)));
typedef unsigned u32x4 __attribute__((ext_vector_type(4)));
#define LDS_AS __attribute__((address_space(3)))
#define GLB_AS __attribute__((address_space(1)))

constexpr int T_ = 65536;
constexpr int NTHR = 512;
constexpr size_t MiB = 1ull << 20;
constexpr float ALPHA = 1.189207115002721f;
constexpr size_t OFF_R0 = 0;
constexpr size_t OFF_R1 = 128 * MiB;
constexpr size_t OFF_AK = 256 * MiB;
constexpr size_t OFF_AV = 272 * MiB;
constexpr size_t OFF_MQK = 288 * MiB;
constexpr size_t OFF_MV = 416 * MiB;
constexpr size_t OFF_MO = 544 * MiB;
constexpr size_t OFF_GG = 672 * MiB;
constexpr size_t OFF_WGU = 288 * MiB;
constexpr size_t OFF_WD = 352 * MiB;
constexpr size_t OFF_XQ = 416 * MiB;
constexpr size_t OFF_O = 544 * MiB;
constexpr size_t OFF_Z2 = 672 * MiB;
constexpr size_t OFF_YB = 416 * MiB;
constexpr size_t OFF_MISC = 928 * MiB;
constexpr size_t OFF_WIN = OFF_MISC;
constexpr size_t OFF_MEMB = OFF_MISC + 84 * MiB;
constexpr size_t OFF_CS = OFF_MISC + 21 * MiB;
constexpr size_t OFF_WXKV = OFF_MISC + 37 * MiB;
constexpr size_t OFF_WATT = OFF_MISC + 41 * MiB;
constexpr size_t OFF_WML = OFF_MISC + 43 * MiB;
constexpr size_t OFF_WMIX = OFF_MISC + 45 * MiB;
constexpr size_t OFF_WXQ = OFF_MISC + 47 * MiB;
constexpr size_t OFF_WXO = OFF_MISC + 49 * MiB;
constexpr size_t OFF_KMAT = OFF_MISC + 51 * MiB;
constexpr size_t OFF_VT = OFF_MISC + 59 * MiB;
constexpr size_t OFF_GATES = OFF_MISC + 67 * MiB;
constexpr size_t OFF_TOKE = OFF_MISC + 69 * MiB;
constexpr size_t OFF_TOKW = OFF_MISC + 70 * MiB;
constexpr size_t OFF_SLOTTOK = OFF_MISC + 71 * MiB;
constexpr size_t OFF_SLOTW = OFF_MISC + 72 * MiB;
constexpr size_t OFF_HIST = OFF_MISC + 73 * MiB;
constexpr size_t OFF_TOKSLOT = OFF_MISC + 75 * MiB;
constexpr size_t OFF_BAR = OFF_MISC + 74 * MiB;
constexpr size_t OFF_SSQP = OFF_MISC + 76 * MiB;
constexpr size_t OFF_SP = OFF_MISC;
constexpr size_t OFF_REC = OFF_MISC + 32 * MiB;
constexpr size_t OUT_QP = 128 * MiB;
constexpr size_t OUT_KP = 192 * MiB;
constexpr size_t WS_NEED = 1024 * MiB;
constexpr int LDS_GEMM = 147456;
constexpr int LDS_PARAMS = 163520;
constexpr int LDS_XB = 163776;
constexpr int LDS_BYTES = 163840;

struct Params {
    const float *x, *mem; const int* pos;
    const float *w_in, *sinks, *conv_w, *conv_b, *b_ig, *b_fg, *ml_g, *w_att, *w_ml, *w_mix, *ln1g, *ln1b;
    const float *w_xq, *w_xkv, *w_xo, *ln2g, *ln2b, *w_rg, *b_rg, *w_re, *b_re, *w_gate, *w_up, *w_down, *ln3g, *ln3b;
    float* out; char* ws;
};

__device__ const double INV_FREQ[32] = {1.0, 0.7498942093324559, 0.5623413251903491, 0.4216965034285822, 0.31622776601683794, 0.23713737056616552, 0.1778279410038923, 0.1333521432163324, 0.1, 0.07498942093324558, 0.05623413251903491, 0.042169650342858224, 0.03162277660168379, 0.023713737056616554, 0.01778279410038923, 0.01333521432163324, 0.01, 0.007498942093324558, 0.005623413251903491, 0.004216965034285823, 0.0031622776601683794, 0.0023713737056616554, 0.0017782794100389228, 0.001333521432163324, 0.001, 0.0007498942093324559, 0.0005623413251903491, 0.00042169650342858224, 0.00031622776601683794, 0.00023713737056616554, 0.00017782794100389227, 0.0001333521432163324};

template <class T> __device__ __forceinline__ T* uni(T* q) {
    const unsigned long long v = (unsigned long long)q;
    const unsigned lo = __builtin_amdgcn_readfirstlane((unsigned)v), hi = __builtin_amdgcn_readfirstlane((unsigned)(v >> 32));
    return (T*)(((unsigned long long)hi << 32) | lo);
}
__device__ __forceinline__ int opaque_tid() { int t = threadIdx.x; asm volatile("" : "+v"(t)); return t; }
__device__ __forceinline__ unsigned pk_bf16(float lo, float hi) { unsigned r; asm("v_cvt_pk_bf16_f32 %0, %1, %2" : "=v"(r) : "v"(lo), "v"(hi)); return r; }
__device__ __forceinline__ float bf_lo(unsigned u) { return __uint_as_float(u << 16); }
__device__ __forceinline__ float bf_hi(unsigned u) { return __uint_as_float(u & 0xffff0000u); }
__device__ __forceinline__ float bf2f(bf16_t h) { return __uint_as_float(((unsigned)h) << 16); }
__device__ __forceinline__ float wsum(float v) {
#pragma unroll
    for (int o = 32; o; o >>= 1) v += __shfl_xor(v, o);
    return v;
}
__device__ __forceinline__ float wmaxf(float v) {
#pragma unroll
    for (int o = 32; o; o >>= 1) v = fmaxf(v, __shfl_xor(v, o));
    return v;
}
__device__ __forceinline__ float sigmoidf_(float x) { return __builtin_amdgcn_rcpf(1.0f + __builtin_amdgcn_exp2f(x * -1.4426950408889634f)); }
__device__ __forceinline__ void glds16(const bf16_t* g, char* l) {
    __builtin_amdgcn_global_load_lds((const GLB_AS void*)g, (LDS_AS void*)l, 16, 0, 0);
}

__device__ __forceinline__ bool xcd_item(int i, int n, int& item) {
    const int G = gridDim.x;
    if ((G & 7) == 0) {
        const int x = blockIdx.x & 7, j = blockIdx.x >> 3, nj = G >> 3;
        const int per = (n + 7) >> 3;
        const int u = i * nj + j;
        if (u >= per) return false;
        item = x * per + u;
        return item < n;
    }
    item = blockIdx.x + i * G;
    return item < n;
}

struct GemmSrc { const bf16_t* a[4]; const bf16_t* b[2]; };

__device__ __forceinline__ void stage_tile(const GemmSrc& s, int koff, char* buf, int tid) {
#pragma unroll
    for (int i = 0; i < 4; ++i) glds16(s.a[i] + koff, buf + (i * 512 + tid) * 16);
#pragma unroll
    for (int i = 0; i < 2; ++i) glds16(s.b[i] + koff, buf + 32768 + (i * 512 + tid) * 16);
}

constexpr int GEMM_STAGE = 49152;
__device__ __forceinline__ void gemm_loop(f32x4 (&acc)[4][4], const GemmSrc& s, int nk, char* smem, int tid) {
    const int lane = tid & 63, wid = tid >> 6, wr = wid >> 1, wc = wid & 1, fr = lane & 15, fq = lane >> 4;
    const int swz = (fr >> 1) & 7;
    const int aoff = (wr * 64 + fr) * 128;
    const int boff = 32768 + (wc * 64 + fr) * 128;
    stage_tile(s, 0, smem, tid);
    if (nk > 1) stage_tile(s, 64, smem + GEMM_STAGE, tid);
    int cur = 0, nxt = 2;
#pragma unroll 1
    for (int t = 0; t < nk; ++t) {
        if (t + 1 < nk) asm volatile("s_waitcnt vmcnt(6)" ::: "memory"); else asm volatile("s_waitcnt vmcnt(0)" ::: "memory");
        __builtin_amdgcn_s_barrier();
        if (t + 2 < nk) stage_tile(s, (t + 2) * 64, smem + nxt * GEMM_STAGE, tid);
        const char* cb = smem + cur * GEMM_STAGE;
#pragma unroll
        for (int ks = 0; ks < 2; ++ks) {
            const int ch = ((ks * 4 + fq) ^ swz) * 16;
            bf16x8 xa[4], wb[4];
#pragma unroll
            for (int m = 0; m < 4; ++m) xa[m] = *(const bf16x8*)(cb + aoff + m * 2048 + ch);
#pragma unroll
            for (int n = 0; n < 4; ++n) wb[n] = *(const bf16x8*)(cb + boff + n * 2048 + ch);
#pragma unroll
            for (int m = 0; m < 4; ++m)
#pragma unroll
                for (int n = 0; n < 4; ++n) acc[m][n] = __builtin_amdgcn_mfma_f32_16x16x32_bf16(wb[n], xa[m], acc[m][n], 0, 0, 0);
        }
        cur = cur == 2 ? 0 : cur + 1; nxt = nxt == 2 ? 0 : nxt + 1;
    }
    __syncthreads();
}

__device__ __forceinline__ void zero_acc(f32x4 (&acc)[4][4]) {
#pragma unroll
    for (int m = 0; m < 4; ++m)
#pragma unroll
        for (int n = 0; n < 4; ++n) acc[m][n] = (f32x4){0.f, 0.f, 0.f, 0.f};
}

__device__ __forceinline__ void make_src(GemmSrc& s, const bf16_t* A, size_t lda, int rowA0, const bf16_t* Bt, size_t ldb, int rowB0, int tid) {
    const int r = tid >> 3, lc = (tid & 7) ^ ((r >> 1) & 7);
#pragma unroll
    for (int i = 0; i < 4; ++i) s.a[i] = A + (size_t)(rowA0 + i * 64 + r) * lda + lc * 8;
#pragma unroll
    for (int i = 0; i < 2; ++i) s.b[i] = Bt + (size_t)(rowB0 + i * 64 + r) * ldb + lc * 8;
}

__device__ __forceinline__ void store_bf16x8(bf16_t* p, f32x4 a, f32x4 b) {
    u32x4 w; w[0] = pk_bf16(a[0], a[1]); w[1] = pk_bf16(a[2], a[3]); w[2] = pk_bf16(b[0], b[1]); w[3] = pk_bf16(b[2], b[3]); *(u32x4*)p = w;
}
__device__ __forceinline__ void store_bf16x4(bf16_t* p, f32x4 v) {
    uint2 w; w.x = pk_bf16(v[0], v[1]); w.y = pk_bf16(v[2], v[3]); *(uint2*)p = w;
}

namespace pg8 {
constexpr int BM = 256, BK = 64, HALF = 128, HTB = HALF * BK * 2;
__device__ __forceinline__ int lds_byte(int r, int c) { const int st = (r >> 4) * 2 + (c >> 5), rr = r & 15, cc = c & 31, ob = rr * 64 + cc * 2; return st * 1024 + (ob ^ (((ob >> 9) & 1) << 5)); }
__device__ __forceinline__ void stage_rc(int b, int& R, int& C) { const int st = b / 1024, sb = b % 1024, swz = sb ^ (((sb >> 9) & 1) << 5); R = (st >> 1) * 16 + swz / 64; C = (st & 1) * 32 + (swz % 64) / 2; }
struct Unit { int pm, pn, aux; const char* A; const char* Bt; };

template <class Epi, class Sched, bool GATHER = false>
__device__ __forceinline__ void gemm_phase(LDS_AS unsigned char* lds, const int K, const Sched& S, const Epi& E, const int stagger_cycles = 0) {
    const int tid = opaque_tid(), wid = __builtin_amdgcn_readfirstlane(tid >> 6), lane = tid & 63, wr = wid >> 2, wc = wid & 3, fr = lane & 15, fq = lane >> 4;
    const int nt = K / BK;
    unsigned voff[2];
#pragma unroll
    for (int i = 0; i < 2; ++i) { int R, C; stage_rc(tid * 16 + i * 8192, R, C); voff[i] = (unsigned)(R * K + C) * 2u; }
    const size_t kstep = (size_t)(BK * 2);
    const size_t hstep = (size_t)HALF * K * 2;
    const size_t tstep = 2 * hstep;
    const unsigned ldsw = (unsigned)wid * 1024u;
    const int aoff = lds_byte(wr * 64 + fr, fq * 8), boff = lds_byte(wc * 32 + fr, fq * 8);
#define PG8_SA(b, h) (((b) * 2 + (h)) * HTB)
#define PG8_SB(b, h) ((4 + (b) * 2 + (h)) * HTB)
#define PG8_STAGE(bufoff, gbase) do { _Pragma("unroll") for (int _i = 0; _i < 2; ++_i) \
        __builtin_amdgcn_global_load_lds((const GLB_AS void*)((const char*)(gbase) + voff[_i]), (LDS_AS void*)(lds + (bufoff) + ldsw + _i * 8192), 16, 0, 0); } while (0)
#define PG8_LDA(dst, b, h) do { _Pragma("unroll") for (int m = 0; m < 4; ++m) _Pragma("unroll") for (int k = 0; k < 2; ++k) dst[m][k] = *(const LDS_AS bf16x8*)(lds + PG8_SA(b, h) + aoff + m * 2048 + k * 1024); } while (0)
#define PG8_LDB(dst, b, h) do { _Pragma("unroll") for (int n = 0; n < 2; ++n) _Pragma("unroll") for (int k = 0; k < 2; ++k) dst[n][k] = *(const LDS_AS bf16x8*)(lds + PG8_SB(b, h) + boff + n * 2048 + k * 1024); } while (0)
#define PG8_MMA(ai, bj, At, Bt) do { __builtin_amdgcn_s_setprio(1); _Pragma("unroll") for (int m = 0; m < 4; ++m) _Pragma("unroll") for (int n = 0; n < 2; ++n) _Pragma("unroll") for (int k = 0; k < 2; ++k) \
        acc[ai][bj][m][n] = __builtin_amdgcn_mfma_f32_16x16x32_bf16(Bt[n][k], At[m][k], acc[ai][bj][m][n], 0, 0, 0); __builtin_amdgcn_s_setprio(0); } while (0)
#define PG8_WAIT_V(n) asm volatile("s_waitcnt vmcnt(" #n ")" ::: "memory")
#define PG8_WAIT_L(n) asm volatile("s_waitcnt lgkmcnt(" #n ")" ::: "memory")
#define PG8_BAR __builtin_amdgcn_s_barrier()
#define PG8_SCHED __builtin_amdgcn_sched_barrier(0)
#define PG8_STAGE_A(bufoff, gbase, VA) do { _Pragma("unroll") for (int _i = 0; _i < 2; ++_i) \
        __builtin_amdgcn_global_load_lds((const GLB_AS void*)((const char*)(gbase) + (VA)[_i]), (LDS_AS void*)(lds + (bufoff) + ldsw + _i * 8192), 16, 0, 0); } while (0)
    int Rr[2], Cc[2];
#pragma unroll
    for (int i = 0; i < 2; ++i) stage_rc(tid * 16 + i * 8192, Rr[i], Cc[i]);
    unsigned va0[2], va1[2], vn0[2], vn1[2];
    Unit cur, nxt; int ui = 0;
    if (!S.next(0, cur)) return;
    if constexpr (GATHER) {
#pragma unroll
        for (int i = 0; i < 2; ++i) { va0[i] = S.arow(cur, Rr[i]) + (unsigned)Cc[i] * 2u; va1[i] = S.arow(cur, 128 + Rr[i]) + (unsigned)Cc[i] * 2u; }
    } else {
#pragma unroll
        for (int i = 0; i < 2; ++i) { va0[i] = voff[i]; va1[i] = voff[i] + (unsigned)hstep; }
    }
#pragma unroll
    for (int i = 0; i < 2; ++i) { vn0[i] = va0[i]; vn1[i] = va1[i]; }
    if (stagger_cycles > 0) {
        const int lvl = (blockIdx.x >> 3) & 31;
        for (int q = 0; q < lvl * stagger_cycles; ++q) __builtin_amdgcn_s_sleep(15);
    }
    f32x4 acc[2][2][4][2];
#pragma unroll
    for (int a = 0; a < 2; ++a)
#pragma unroll
        for (int b = 0; b < 2; ++b)
#pragma unroll
            for (int m = 0; m < 4; ++m)
#pragma unroll
                for (int n = 0; n < 2; ++n) acc[a][b][m][n] = (f32x4){0.f, 0.f, 0.f, 0.f};
    bf16x8 At[4][2], B0[2][2], B1[2][2];
    const char* cA = GATHER ? cur.A : cur.A + (size_t)cur.pm * tstep; const char* cB = cur.Bt + (size_t)cur.pn * tstep;
    PG8_STAGE(PG8_SB(0, 0), cB); PG8_STAGE(PG8_SB(0, 1), cB + hstep); PG8_STAGE_A(PG8_SA(0, 0), cA, va0); PG8_STAGE_A(PG8_SA(0, 1), cA, va1);
    if (wr == 1) PG8_BAR;
    PG8_WAIT_V(2); PG8_BAR;
    PG8_STAGE(PG8_SB(1, 0), cB + kstep); PG8_STAGE_A(PG8_SA(1, 0), cA + kstep, va0); PG8_STAGE(PG8_SB(1, 1), cB + hstep + kstep);
    PG8_WAIT_V(6); PG8_BAR;
    for (;;) {
        const bool has_next = S.next(ui + 1, nxt);
        const char* nA = has_next ? (GATHER ? nxt.A : nxt.A + (size_t)nxt.pm * tstep) : cA; const char* nB = has_next ? nxt.Bt + (size_t)nxt.pn * tstep : cB;
        if constexpr (GATHER) {
            if (has_next) {
#pragma unroll
                for (int i = 0; i < 2; ++i) { vn0[i] = S.arow(nxt, Rr[i]) + (unsigned)Cc[i] * 2u; vn1[i] = S.arow(nxt, 128 + Rr[i]) + (unsigned)Cc[i] * 2u; }
            }
        }
        for (int t = 0; t < nt; t += 2) {
            const bool last = (t == nt - 2);
            const char* a1 = cA + (size_t)(t + 1) * kstep;
            const char* a2 = last ? nA : cA + (size_t)(t + 2) * kstep; const char* b2 = last ? nB : cB + (size_t)(t + 2) * kstep;
            const char* a3 = a2 + kstep; const char* b3 = b2 + kstep;
            unsigned w0[2], w1[2];
#pragma unroll
            for (int i = 0; i < 2; ++i) { w0[i] = last ? vn0[i] : va0[i]; w1[i] = last ? vn1[i] : va1[i]; }
            PG8_LDB(B0, 0, 0); PG8_LDB(B1, 0, 1); PG8_SCHED; PG8_LDA(At, 0, 0); PG8_STAGE_A(PG8_SA(1, 1), a1, va1);
            PG8_WAIT_V(8); PG8_WAIT_L(0); PG8_BAR; PG8_MMA(0, 0, At, B0); PG8_MMA(0, 1, At, B1); PG8_BAR; PG8_SCHED;
            PG8_LDA(At, 0, 1); PG8_STAGE(PG8_SB(0, 0), b2); PG8_STAGE(PG8_SB(0, 1), b2 + hstep); PG8_STAGE_A(PG8_SA(0, 0), a2, w0);
            PG8_WAIT_V(8); PG8_WAIT_L(0); PG8_BAR; PG8_MMA(1, 0, At, B0); PG8_MMA(1, 1, At, B1); PG8_BAR; PG8_SCHED;
            PG8_LDB(B0, 1, 0); PG8_LDB(B1, 1, 1); PG8_SCHED; PG8_LDA(At, 1, 0); PG8_STAGE_A(PG8_SA(0, 1), a2, w1);
            PG8_WAIT_V(8); PG8_WAIT_L(0); PG8_BAR; PG8_MMA(0, 0, At, B0); PG8_MMA(0, 1, At, B1); PG8_BAR; PG8_SCHED;
            PG8_LDA(At, 1, 1); PG8_STAGE(PG8_SB(1, 0), b3); PG8_STAGE(PG8_SB(1, 1), b3 + hstep); PG8_STAGE_A(PG8_SA(1, 0), a3, w0);
            PG8_WAIT_V(8); PG8_WAIT_L(0); PG8_BAR; PG8_MMA(1, 0, At, B0); PG8_MMA(1, 1, At, B1); PG8_BAR; PG8_SCHED;
        }
        if (wr == 0) PG8_BAR;
        E(acc, cur, wr, wc, fr, fq);
        if (!has_next) break;
        if (!(cur.aux & 0x100)) {
#pragma unroll
        for (int a = 0; a < 2; ++a)
#pragma unroll
            for (int b = 0; b < 2; ++b)
#pragma unroll
                for (int m = 0; m < 4; ++m)
#pragma unroll
                    for (int n = 0; n < 2; ++n) acc[a][b][m][n] = (f32x4){0.f, 0.f, 0.f, 0.f};
        }
        cur = nxt; cA = nA; cB = nB; ++ui;
#pragma unroll
        for (int i = 0; i < 2; ++i) { va0[i] = vn0[i]; va1[i] = vn1[i]; }
        if (wr == 1) PG8_BAR;
    }
    PG8_WAIT_V(0);
    PG8_BAR;
#undef PG8_SA
#undef PG8_SB
#undef PG8_STAGE
#undef PG8_STAGE_A
#undef PG8_LDA
#undef PG8_LDB
#undef PG8_MMA
#undef PG8_WAIT_V
#undef PG8_WAIT_L
#undef PG8_BAR
#undef PG8_SCHED
}
}

__device__ __forceinline__ int perm32(int rho) { const int n = rho >> 4, i = rho & 15; return 8 * (i >> 2) + 4 * n + (i & 3); }
template <bool PERM>
__device__ __forceinline__ void tr_tile_t(const float* src, size_t ld_src, int k0, int c0, bf16_t* dst, size_t ld_dst, int r0, float* tile, int tid) {
    {
        const int r = tid >> 3, c4 = (tid & 7) * 4;
        const float4 v = *(const float4*)(src + (size_t)(k0 + r) * ld_src + c0 + c4);
        float* tp = tile + r * 33 + c4; tp[0] = v.x; tp[1] = v.y; tp[2] = v.z; tp[3] = v.w;
    }
    __syncthreads();
    {
        const int c = tid >> 4, rc = (tid & 15) * 4, sc = PERM ? perm32(c) : c;
        const float a0 = tile[(rc + 0) * 33 + sc], a1 = tile[(rc + 1) * 33 + sc], a2 = tile[(rc + 2) * 33 + sc], a3 = tile[(rc + 3) * 33 + sc];
        uint2 w; w.x = pk_bf16(a0, a1); w.y = pk_bf16(a2, a3);
        *(uint2*)(dst + (size_t)(r0 + c) * ld_dst + k0 + rc) = w;
    }
    __syncthreads();
}
template <bool PERM>
__device__ __forceinline__ void tr_tile4(const float* const (&src)[4], const int (&c0)[4], size_t ld_src, int k0, bf16_t* dst, size_t ld_dst, int r0, float* tile, int tid) {
    {
        const int r = tid >> 3, c4 = (tid & 7) * 4;
        float4 v[4];
#pragma unroll
        for (int g = 0; g < 4; ++g) v[g] = *(const float4*)(src[g] + (size_t)(k0 + r) * ld_src + c0[g] + c4);
#pragma unroll
        for (int g = 0; g < 4; ++g) { float* tp = tile + r * 129 + g * 32 + c4; tp[0] = v[g].x; tp[1] = v[g].y; tp[2] = v[g].z; tp[3] = v[g].w; }
    }
    __syncthreads();
    {
        const int c = tid >> 4, rc = (tid & 15) * 4, sc = PERM ? perm32(c) : c;
#pragma unroll
        for (int g = 0; g < 4; ++g) {
            const float a0 = tile[(rc + 0) * 129 + g * 32 + sc], a1 = tile[(rc + 1) * 129 + g * 32 + sc], a2 = tile[(rc + 2) * 129 + g * 32 + sc], a3 = tile[(rc + 3) * 129 + g * 32 + sc];
            uint2 w; w.x = pk_bf16(a0, a1); w.y = pk_bf16(a2, a3);
            *(uint2*)(dst + (size_t)(r0 + g * 32 + c) * ld_dst + k0 + rc) = w;
        }
    }
    __syncthreads();
}
__device__ __forceinline__ void tr_tile2(const float* srca, int c0a, const float* srcb, int c0b, size_t ld_src, int k0, bf16_t* dst, size_t ld_dst, int r0, float* tile, int tid) {
    {
        const int r = tid >> 3, c4 = (tid & 7) * 4;
        const float* sp = c4 < 16 ? srca + (size_t)(k0 + r) * ld_src + c0a + c4 : srcb + (size_t)(k0 + r) * ld_src + c0b + (c4 - 16);
        const float4 v = *(const float4*)sp;
        float* tp = tile + r * 33 + c4; tp[0] = v.x; tp[1] = v.y; tp[2] = v.z; tp[3] = v.w;
    }
    __syncthreads();
    {
        const int c = tid >> 4, rc = (tid & 15) * 4;
        const float a0 = tile[(rc + 0) * 33 + c], a1 = tile[(rc + 1) * 33 + c], a2 = tile[(rc + 2) * 33 + c], a3 = tile[(rc + 3) * 33 + c];
        uint2 w; w.x = pk_bf16(a0, a1); w.y = pk_bf16(a2, a3);
        *(uint2*)(dst + (size_t)(r0 + c) * ld_dst + k0 + rc) = w;
    }
    __syncthreads();
}

__device__ __forceinline__ void phase0(const Params& p, char* smem, const int parts = 7) {
    const int tid = opaque_tid(), lane = tid & 63, wid = tid >> 6;
    const int gw = blockIdx.x * 8 + wid, nw = gridDim.x * 8;
    char* ws = uni(p.ws);
    bf16_t* xb = (bf16_t*)(ws + OFF_R0);
    if (parts & 1) {
        const float* xg = uni(p.x);
        for (int row = gw * 2; row < T_; row += nw * 2) {
            float4 v[8];
#pragma unroll
            for (int i = 0; i < 8; ++i) v[i] = ((const float4*)(xg + (size_t)(row + (i >> 2)) * 1024))[(i & 3) * 64 + lane];
#pragma unroll
            for (int i = 0; i < 8; ++i) {
                uint2 w; w.x = pk_bf16(v[i].x, v[i].y); w.y = pk_bf16(v[i].z, v[i].w);
                *(uint2*)(xb + (size_t)(row + (i >> 2)) * 1024 + (i & 3) * 256 + lane * 4) = w;
            }
        }
    }
    if (parts & 2) {
        float2* cs = (float2*)(ws + OFF_CS);
        const int gt = blockIdx.x * NTHR + tid, nt = gridDim.x * NTHR;
        for (int idx = gt; idx < T_ * 32; idx += nt) {
            const int tok = idx >> 5, i = idx & 31;
            const double ang = (double)uni(p.pos)[tok] * INV_FREQ[i];
            const double turns = ang * 0.15915494309189535;
            const float f = (float)(turns - rint(turns));
            cs[idx] = make_float2(__builtin_amdgcn_cosf(f), __builtin_amdgcn_sinf(f));
        }
        bf16_t* memb = (bf16_t*)(ws + OFF_MEMB);
        for (int idx = gt; idx < 4096 * 1024 / 4; idx += nt) {
            const float4 v = ((const float4*)uni(p.mem))[idx];
            uint2 w; w.x = pk_bf16(v.x, v.y); w.y = pk_bf16(v.z, v.w);
            ((uint2*)memb)[idx] = w;
        }
    }
    if (parts & 4) {
        float* tile = (float*)smem;
        const int NQ_WIN = 16 * 50, NQ_SQ = 16 * 8, NQ_XKV = 16 * 16;
        const int total = NQ_WIN + 5 * NQ_SQ + NQ_XKV + 16;
        const float* win = uni(p.w_in);
        for (int t = blockIdx.x; t < total; t += gridDim.x) {
            if (t < NQ_WIN) {
                const int kt = t & 15, qd = t >> 4;
                const float* srcs[4] = {win, win, win, win}; int c0[4];
#pragma unroll
                for (int g = 0; g < 4; ++g) {
                    const int n0 = (qd * 4 + g) * 32;
                    if (n0 < 1280) { const int pn = n0 >> 8, bj = (n0 >> 7) & 1, wc = (n0 >> 5) & 3; c0[g] = (4 * pn + wc) * 64 + 32 * bj; }
                    else c0[g] = n0 < 4352 ? n0 : n0 + 8;
                }
                tr_tile4<true>(srcs, c0, 6408, kt * 64, (bf16_t*)(ws + OFF_WIN), 1024, qd * 128, tile, tid);
            } else if (t < NQ_WIN + 5 * NQ_SQ) {
                const int u = t - NQ_WIN, which = u / NQ_SQ, v = u % NQ_SQ, kt = v & 15, qd = v >> 4;
                const float* src = which == 0 ? uni(p.w_att) : which == 1 ? uni(p.w_ml) : which == 2 ? uni(p.w_mix) : which == 3 ? uni(p.w_xq) : uni(p.w_xo);
                const float* srcs[4] = {src, src, src, src}; const int c0[4] = {qd * 128, qd * 128 + 32, qd * 128 + 64, qd * 128 + 96};
                tr_tile4<true>(srcs, c0, 1024, kt * 64, (bf16_t*)(ws + OFF_WATT + (size_t)which * 2 * MiB), 1024, qd * 128, tile, tid);
            } else if (t < NQ_WIN + 5 * NQ_SQ + NQ_XKV) {
                const int v = t - NQ_WIN - 5 * NQ_SQ, kt = v & 15, qd = v >> 4;
                const float* src = uni(p.w_xkv);
                const float* srcs[4] = {src, src, src, src}; const int c0[4] = {qd * 128, qd * 128 + 32, qd * 128 + 64, qd * 128 + 96};
                if (qd < 8) tr_tile4<true>(srcs, c0, 2048, kt * 64, (bf16_t*)(ws + OFF_WXKV), 1024, qd * 128, tile, tid);
                else tr_tile4<false>(srcs, c0, 2048, kt * 64, (bf16_t*)(ws + OFF_WXKV), 1024, qd * 128, tile, tid);
            } else {
                const int kt = t - (NQ_WIN + 5 * NQ_SQ + NQ_XKV);
                tr_tile_t<true>(win, 6408, kt * 64, 4352, (bf16_t*)(ws + OFF_WIN), 1024, 6400, tile, tid);
            }
        }
    }
}

__device__ __forceinline__ void moe_weight_prep(const Params& p, char* smem, int first, int stride) {
    const int tid = opaque_tid();
    float* tile = (float*)smem;
    char* ws = uni(p.ws);
    const int per_e = 96, total = 64 * per_e;
    __syncthreads();
    for (int t = first; t < total; t += stride) {
        const int e = t / per_e, u = t % per_e;
        if (u < 64) {
            const int kt = u & 15, qd = u >> 4, pn = qd >> 1, bj = qd & 1;
            const float* src = (bj ? uni(p.w_up) : uni(p.w_gate)) + (size_t)e * 1024 * 256;
            const float* srcs[4] = {src, src, src, src}; const int c0[4] = {pn * 128, pn * 128 + 32, pn * 128 + 64, pn * 128 + 96};
            tr_tile4<true>(srcs, c0, 256, kt * 64, (bf16_t*)(ws + OFF_WGU) + (size_t)e * 512 * 1024, 1024, qd * 128, tile, tid);
        } else {
            const int v = u - 64, kt = v & 3, qd = v >> 2;
            const float* dsrc = uni(p.w_down) + (size_t)e * 256 * 1024;
            const float* srcs[4] = {dsrc, dsrc, dsrc, dsrc}; const int c0[4] = {qd * 128, qd * 128 + 32, qd * 128 + 64, qd * 128 + 96};
            tr_tile4<true>(srcs, c0, 1024, kt * 64, (bf16_t*)(ws + OFF_WD) + (size_t)e * 1024 * 256, 256, qd * 128, tile, tid);
        }
    }
}

struct SchedP1 {
    int G, c; const char *xb, *win, *memb, *wxkv;
    __device__ __forceinline__ bool next(int i, pg8::Unit& u) const {
        int nmain, uidx;
        if (G == 256) { nmain = 26; const int x = c & 7, j = c >> 3; uidx = i * 32 + j; if (i < 26) { const int g = uidx / 104, v = uidx % 104; u.pm = 32 * x + 4 * g + (v & 3); u.pn = v >> 2; } }
        else { nmain = c < 6656 ? (6656 - 1 - c) / G + 1 : 0; uidx = i * G + c; if (i < nmain) { u.pm = uidx / 26; u.pn = uidx % 26; } }
        if (i < nmain) { u.aux = 0; u.A = xb; u.Bt = win; return true; }
        return false;
    }
};

struct SchedKV {
    int first, stride; const char *memb, *wxkv;
    __device__ __forceinline__ bool next(int i, pg8::Unit& u) const {
        const int kv = first + i * stride;
        if (kv >= 128) return false;
        if (kv < 64) { u.aux = 1; u.pm = kv >> 2; u.pn = kv & 3; u.A = memb; u.Bt = wxkv; }
        else { const int k2 = kv - 64; u.aux = 2; u.pm = k2 >> 4; u.pn = k2 & 15; u.A = wxkv + (size_t)1024 * 1024 * 2; u.Bt = memb; }
        return true;
    }
};
struct EpiP1 {
    char* ws; int skip;
    __device__ __forceinline__ void operator()(f32x4 (&acc)[2][2][4][2], const pg8::Unit& u, int wr, int wc, int fr, int fq) const {
        if (skip == 1) {
#pragma unroll
            for (int a = 0; a < 2; ++a)
#pragma unroll
                for (int b = 0; b < 2; ++b)
#pragma unroll
                    for (int m = 0; m < 4; ++m) { asm volatile("" :: "v"(acc[a][b][m][0]), "v"(acc[a][b][m][1])); }
            return;
        }
        const int row0 = u.pm * 256 + wr * 64 + fr;
        if (u.aux == 0 && u.pn < 5) {
            const int hidx = 4 * u.pn + wc;
            if (hidx < 18) {
                bf16_t* dst; int ld, cb; float sc;
                if (hidx < 16) { dst = (bf16_t*)(ws + OFF_R1); ld = 1024; cb = hidx * 64; sc = 0.125f; }
                else { dst = (bf16_t*)(ws + OFF_AK); ld = 128; cb = (hidx - 16) * 64; sc = 1.0f; }
                const float* cs = (const float*)(ws + OFF_CS);
                const int d1 = 8 * fq;
#pragma unroll
                for (int ai = 0; ai < 2; ++ai)
#pragma unroll
                    for (int m = 0; m < 4; ++m) {
                        const int tok = row0 + ai * 128 + m * 16;
                        const float4* cp = (const float4*)(cs + (size_t)tok * 64 + d1 * 2);
                        const float4 c0 = cp[0], c1 = cp[1], c2 = cp[2], c3 = cp[3];
                        const f32x4 x1a = acc[ai][0][m][0], x1b = acc[ai][0][m][1], x2a = acc[ai][1][m][0], x2b = acc[ai][1][m][1];
                        f32x4 o1a, o1b, o2a, o2b;
                        o1a[0] = (x1a[0] * c0.x - x2a[0] * c0.y) * sc; o2a[0] = (x2a[0] * c0.x + x1a[0] * c0.y) * sc;
                        o1a[1] = (x1a[1] * c0.z - x2a[1] * c0.w) * sc; o2a[1] = (x2a[1] * c0.z + x1a[1] * c0.w) * sc;
                        o1a[2] = (x1a[2] * c1.x - x2a[2] * c1.y) * sc; o2a[2] = (x2a[2] * c1.x + x1a[2] * c1.y) * sc;
                        o1a[3] = (x1a[3] * c1.z - x2a[3] * c1.w) * sc; o2a[3] = (x2a[3] * c1.z + x1a[3] * c1.w) * sc;
                        o1b[0] = (x1b[0] * c2.x - x2b[0] * c2.y) * sc; o2b[0] = (x2b[0] * c2.x + x1b[0] * c2.y) * sc;
                        o1b[1] = (x1b[1] * c2.z - x2b[1] * c2.w) * sc; o2b[1] = (x2b[1] * c2.z + x1b[1] * c2.w) * sc;
                        o1b[2] = (x1b[2] * c3.x - x2b[2] * c3.y) * sc; o2b[2] = (x2b[2] * c3.x + x1b[2] * c3.y) * sc;
                        o1b[3] = (x1b[3] * c3.z - x2b[3] * c3.w) * sc; o2b[3] = (x2b[3] * c3.z + x1b[3] * c3.w) * sc;
                        bf16_t* rp = dst + (size_t)tok * ld + cb + d1;
                        if (skip == 2) { asm volatile("" :: "v"(o1a), "v"(o1b), "v"(o2a), "v"(o2b)); } else { store_bf16x8(rp, o1a, o1b); store_bf16x8(rp + 32, o2a, o2b); }
                    }
            } else {
                bf16_t* avT = (bf16_t*)(ws + OFF_AV);
#pragma unroll
                for (int bj = 0; bj < 2; ++bj)
#pragma unroll
                    for (int ai = 0; ai < 2; ++ai)
#pragma unroll
                        for (int m = 0; m < 4; ++m)
#pragma unroll
                            for (int n = 0; n < 2; ++n)
#pragma unroll
                                for (int j = 0; j < 4; ++j)
                                    avT[(size_t)((hidx - 18) * 64 + 32 * bj + 8 * fq + 4 * n + j) * T_ + row0 + ai * 128 + m * 16] = (bf16_t)(pk_bf16(acc[ai][bj][m][n][j], acc[ai][bj][m][n][j]) & 0xffffu);
            }
            return;
        }
#pragma unroll
        for (int bj = 0; bj < 2; ++bj) {
            const int c32 = u.pn * 256 + bj * 128 + wc * 32;
            if (u.aux == 0 && c32 >= 6400) {
                if (c32 == 6400 && fq == 0) {
                    float* gates = (float*)(ws + OFF_GATES);
#pragma unroll
                    for (int ai = 0; ai < 2; ++ai)
#pragma unroll
                        for (int m = 0; m < 4; ++m) {
                            const f32x4 v0 = acc[ai][bj][m][0], v1 = acc[ai][bj][m][1];
                            float4* gp = (float4*)(gates + (size_t)(row0 + ai * 128 + m * 16) * 8);
                            gp[0] = make_float4(v0[0], v0[1], v0[2], v0[3]); gp[1] = make_float4(v1[0], v1[1], v1[2], v1[3]);
                        }
                }
            } else if (u.aux == 2) {
                bf16_t* dst = (bf16_t*)(ws + OFF_VT);
#pragma unroll
                for (int ai = 0; ai < 2; ++ai)
#pragma unroll
                    for (int m = 0; m < 4; ++m) {
                        bf16_t* rp = dst + (size_t)(row0 + ai * 128 + m * 16) * 4096 + c32 + fq * 4;
                        store_bf16x4(rp, acc[ai][bj][m][0]); store_bf16x4(rp + 16, acc[ai][bj][m][1]);
                    }
            } else {
                bf16_t* dst; int ld, cb; bool sig = false;
                if (u.aux == 1) { dst = (bf16_t*)(ws + OFF_KMAT); ld = 1024; cb = c32; }
                else if (c32 < 2304) { dst = (bf16_t*)(ws + OFF_MQK); ld = 1024; cb = c32 - 1280; }
                else if (c32 < 3328) { dst = (bf16_t*)(ws + OFF_MV); ld = 1024; cb = c32 - 2304; }
                else if (c32 < 4352) { dst = (bf16_t*)(ws + OFF_MO); ld = 1024; cb = c32 - 3328; sig = true; }
                else { dst = (bf16_t*)(ws + OFF_GG); ld = 2048; cb = c32 - 4352; sig = true; }
#pragma unroll
                for (int ai = 0; ai < 2; ++ai)
#pragma unroll
                    for (int m = 0; m < 4; ++m) {
                        f32x4 v0 = acc[ai][bj][m][0], v1 = acc[ai][bj][m][1];
                        if (sig) {
                            v0[0] = sigmoidf_(v0[0]); v0[1] = sigmoidf_(v0[1]); v0[2] = sigmoidf_(v0[2]); v0[3] = sigmoidf_(v0[3]);
                            v1[0] = sigmoidf_(v1[0]); v1[1] = sigmoidf_(v1[1]); v1[2] = sigmoidf_(v1[2]); v1[3] = sigmoidf_(v1[3]);
                        }
                        if (skip == 2) { asm volatile("" :: "v"(v0), "v"(v1)); } else store_bf16x8(dst + (size_t)(row0 + ai * 128 + m * 16) * ld + cb + fq * 8, v0, v1);
                    }
            }
        }
    }
};

__device__ __forceinline__ void phase1(const Params& p, char* smem, int skip_epi = 0) {
    char* ws = uni(p.ws);
    SchedP1 S{(int)gridDim.x, (int)blockIdx.x, ws + OFF_R0, ws + OFF_WIN, ws + OFF_MEMB, ws + OFF_WXKV};
    EpiP1 E{ws, skip_epi};
    pg8::gemm_phase<EpiP1, SchedP1>((LDS_AS unsigned char*)smem, 1024, S, E, 0);
}

__device__ __forceinline__ void kv_projection(const Params& p, char* smem, int first, int stride) {
    char* ws = uni(p.ws);
    __syncthreads();
    SchedKV S{first, stride, ws + OFF_MEMB, ws + OFF_WXKV};
    EpiP1 E{ws, 0};
    pg8::gemm_phase<EpiP1, SchedKV>((LDS_AS unsigned char*)smem, 1024, S, E);
}

template <int NPASS>
struct SchedN1024 {
    int G, c; const char* A0; const char* B0; const char* A1; const char* B1;
    __device__ __forceinline__ bool next(int i, pg8::Unit& u) const {
        const int ti = i / NPASS, pass = i % NPASS;
        int uidx;
        if (G == 256) { if (ti >= 4) return false; const int x = c & 7, j = c >> 3; uidx = ti * 32 + j; u.pm = 32 * x + (uidx >> 2); u.pn = uidx & 3; }
        else { uidx = ti * G + c; if (uidx >= 1024) return false; u.pm = uidx >> 2; u.pn = uidx & 3; }
        u.aux = pass | ((NPASS == 2 && pass == 0) ? 0x100 : 0); u.A = pass ? A1 : A0; u.Bt = pass ? B1 : B0;
        return true;
    }
};

typedef short v4i16_t __attribute__((ext_vector_type(4)));
__device__ __forceinline__ int offQK(int row, int ch) { return row * 256 + ((ch ^ (((row & 3) << 2) | ((row >> 2) & 3))) << 4); }
__device__ __forceinline__ int offV(int row, int ch) { return row * 512 + ((ch ^ (((row & 3) | (((row >> 3) & 1) << 2)) << 1)) << 4); }
__device__ __forceinline__ int offSw(int row, int ch) { return row * 128 + ((ch ^ ((row >> 1) & 7)) << 4); }
__device__ __forceinline__ bf16x8 tr_read2(const char* p0, const char* p1) {
    const v4i16_t a = __builtin_amdgcn_ds_read_tr16_b64_v4i16((LDS_AS v4i16_t*)p0);
    const v4i16_t b = __builtin_amdgcn_ds_read_tr16_b64_v4i16((LDS_AS v4i16_t*)p1);
    return __builtin_shufflevector(a, b, 0, 1, 2, 3, 4, 5, 6, 7);
}
__device__ __forceinline__ float row16_sum(float v) {
    v += __builtin_bit_cast(float, __builtin_amdgcn_update_dpp(0, __builtin_bit_cast(int, v), 0xB1, 0xf, 0xf, true));
    v += __builtin_bit_cast(float, __builtin_amdgcn_update_dpp(0, __builtin_bit_cast(int, v), 0x4E, 0xf, 0xf, true));
    v += __builtin_bit_cast(float, __builtin_amdgcn_update_dpp(0, __builtin_bit_cast(int, v), 0x141, 0xf, 0xf, true));
    v += __builtin_bit_cast(float, __builtin_amdgcn_update_dpp(0, __builtin_bit_cast(int, v), 0x140, 0xf, 0xf, true));
    return v;
}

constexpr int PP_Q = 0, PP_K = 16384, PP_S = 32768, PP_REC = 40960, PP_EB = 41984, PP_EK = 42240, PP_CSP = 42496  , PP_RSP = 44544  , PP_END = 45056;
__device__ __forceinline__ void ml_prepass_item(const Params& p, char* smem, int item) {
    const int tid = opaque_tid(), lane = tid & 63, wid = tid >> 6, fr = lane & 15, fq = lane >> 4;
    const int c = item & 63, bh = item >> 6, b = bh >> 2, h = bh & 3;
    char* ws = uni(p.ws);
    const bf16_t* mqk = (const bf16_t*)(ws + OFF_MQK);
    const float* gates = (const float*)(ws + OFF_GATES);
    float* rec = (float*)(smem + PP_REC); float* eb = (float*)(smem + PP_EB); float* ek = (float*)(smem + PP_EK);
    float* csp = (float*)(smem + PP_CSP); float* rsp = (float*)(smem + PP_RSP);
    const long tok0 = (long)b * 4096 + c * 64;
    const int cp = tid & 127, tg = tid >> 7;
    const bool isk = cp >= 64;
    const int dch = isk ? 2 * (cp - 64) : 2 * cp;
    const int ccol = isk ? (512 + h * 128 + dch) : (h * 128 + dch);
    unsigned r[19];
#pragma unroll
    for (int i = 0; i < 19; ++i) {
        const int tl = tg * 16 - 3 + i;
        r[i] = (c == 0 && tl < 0) ? 0u : *(const unsigned*)(mqk + (tok0 + tl) * 1024 + ccol);
    }
    float cw0[4], cw1[4];
#pragma unroll
    for (int j = 0; j < 4; ++j) { cw0[j] = uni(p.conv_w)[j * 1024 + ccol]; cw1[j] = uni(p.conv_w)[j * 1024 + ccol + 1]; }
    const float cb0 = uni(p.conv_b)[ccol], cb1 = uni(p.conv_b)[ccol + 1];
    if (wid == 0) {
        const float mi0 = gates[(tok0 + lane) * 8 + h] + uni(p.b_ig)[h], x = gates[(tok0 + lane) * 8 + 4 + h] + uni(p.b_fg)[h];
        float bs = fminf(x, 0.f) - log1pf(__expf(-fabsf(x)));
#pragma unroll
        for (int o = 1; o < 64; o <<= 1) { const float y = __shfl_up(bs, o); if (lane >= o) bs += y; }
        eb[lane] = __expf(bs); ek[lane] = __expf(mi0 - bs);
        if (lane == 63) rec[192] = __expf(bs);
    }
    __syncthreads();
    {
        const int tt0 = tg * 16;
        float cs0 = 0.f, cs1 = 0.f;
        const float* scp = (isk ? ek : eb) + tt0;
        char* dstb = smem + (isk ? PP_K : PP_Q) + (dch & 7) * 2;
        const float kmul = isk ? 0.08838834764831845f : 1.0f;
#pragma unroll
        for (int tt = 0; tt < 16; ++tt) {
            float v0 = cb0 + cw0[0] * bf_lo(r[tt]) + cw0[1] * bf_lo(r[tt + 1]) + cw0[2] * bf_lo(r[tt + 2]) + cw0[3] * bf_lo(r[tt + 3]);
            float v1 = cb1 + cw1[0] * bf_hi(r[tt]) + cw1[1] * bf_hi(r[tt + 1]) + cw1[2] * bf_hi(r[tt + 2]) + cw1[3] * bf_hi(r[tt + 3]);
            v0 = v0 * sigmoidf_(v0); v1 = v1 * sigmoidf_(v1);
            const float sc = scp[tt] * kmul;
            const float a0 = v0 * sc, a1 = v1 * sc;
            *(unsigned*)(dstb + offQK(tt0 + tt, dch >> 3)) = pk_bf16(a0, a1);
            cs0 += a0; cs1 += a1;
        }
        if (isk) { csp[tg * 128 + dch] = cs0; csp[tg * 128 + dch + 1] = cs1; }
    }
    __syncthreads();
    {
        const int tt = wid >> 1;
        bf16x8 qf[4];
#pragma unroll
        for (int ks = 0; ks < 4; ++ks) qf[ks] = *(const bf16x8*)(smem + PP_Q + offQK(tt * 16 + fr, 4 * ks + fq));
        float rs = 0.f;
#pragma unroll
        for (int x = 0; x < 2; ++x) {
            const int st = (wid & 1) * 2 + x;
            f32x4 a = (f32x4){0.f, 0.f, 0.f, 0.f};
#pragma unroll
            for (int ks = 0; ks < 4; ++ks) {
                const bf16x8 kf = *(const bf16x8*)(smem + PP_K + offQK(st * 16 + fr, 4 * ks + fq));
                a = __builtin_amdgcn_mfma_f32_16x16x32_bf16(kf, qf[ks], a, 0, 0, 0);
            }
#pragma unroll
            for (int j = 0; j < 4; ++j) a[j] = (st * 16 + fq * 4 + j) <= (tt * 16 + fr) ? a[j] : 0.f;
            rs += (a[0] + a[1]) + (a[2] + a[3]);
            uint2 w; w.x = pk_bf16(a[0], a[1]); w.y = pk_bf16(a[2], a[3]);
            *(uint2*)(smem + PP_S + offSw(tt * 16 + fr, st * 2 + (fq >> 1)) + (fq & 1) * 8) = w;
        }
        rs += __shfl_xor(rs, 16); rs += __shfl_xor(rs, 32);
        if (fq == 0) rsp[(wid & 1) * 64 + tt * 16 + fr] = rs;
        if (tid < 128) rec[64 + tid] = (csp[tid] + csp[128 + tid]) + (csp[256 + tid] + csp[384 + tid]);
    }
    __syncthreads();
    if (tid < 64) rec[tid] = rsp[tid] + rsp[64 + tid];
    __syncthreads();
    {
        char* qp = (char*)uni(p.out) + OUT_QP + (size_t)item * 16384;
        char* kp = (char*)uni(p.out) + OUT_KP + (size_t)item * 16384;
        char* sp = ws + OFF_SP + (size_t)item * 8192;
        char* rp = ws + OFF_REC + (size_t)item * 1024;
#pragma unroll
        for (int i = 0; i < 2; ++i) {
            *(u32x4*)(qp + (i * 512 + tid) * 16) = *(const u32x4*)(smem + PP_Q + (i * 512 + tid) * 16);
            *(u32x4*)(kp + (i * 512 + tid) * 16) = *(const u32x4*)(smem + PP_K + (i * 512 + tid) * 16);
        }
        *(u32x4*)(sp + tid * 16) = *(const u32x4*)(smem + PP_S + tid * 16);
        if (tid < 64) *(u32x4*)(rp + tid * 16) = *(const u32x4*)(smem + PP_REC + tid * 16);
    }
    __syncthreads();
}

constexpr int SC_BUF = 41984;
constexpr int SC_V = 2 * SC_BUF;
constexpr int SC_NBF = SC_V + 65536;
constexpr int SC_END = SC_NBF + 512;
__device__ __forceinline__ void ml_scan(const Params& p, char* smem, int bh, const int mode = 0) {
    const int tid = opaque_tid(), lane = tid & 63, wid = tid >> 6, fr0 = lane & 15, fq0 = lane >> 4;
    const int b = bh >> 2, h = bh & 3;
    char* ws = uni(p.ws);
    const bf16_t* mv = (const bf16_t*)(ws + OFF_MV);
    bf16_t* hm = (bf16_t*)uni(p.out);
    float* ssqp = (float*)(ws + OFF_SSQP);
    const long tokb = (long)b * 4096;
    f32x4 C[8][2];
#pragma unroll
    for (int dt = 0; dt < 8; ++dt) { C[dt][0] = (f32x4){0.f, 0.f, 0.f, 0.f}; C[dt][1] = (f32x4){0.f, 0.f, 0.f, 0.f}; }
    const int vrl = tid >> 5, vpc = tid & 31, vlc = vpc ^ ((((vrl & 3) | (((vrl >> 3) & 1) << 2))) << 1);
    const bf16_t* vsrc = mv + (tokb + vrl) * 1024 + h * 256 + vlc * 8;
    const char* qp = (const char*)uni(p.out) + OUT_QP + (size_t)bh * 64 * 16384;
    const char* kp = (const char*)uni(p.out) + OUT_KP + (size_t)bh * 64 * 16384;
    const char* sp = ws + OFF_SP + (size_t)bh * 64 * 8192;
    const char* rp = ws + OFF_REC + (size_t)bh * 64 * 1024;
#define SC_STAGE(cc, bufoff) do { \
        _Pragma("unroll") for (int _i = 0; _i < 2; ++_i) { \
            glds16((const bf16_t*)(qp + (size_t)(cc) * 16384 + (_i * 512 + tid) * 16), smem + (bufoff) + (_i * 512 + tid) * 16); \
            glds16((const bf16_t*)(kp + (size_t)(cc) * 16384 + (_i * 512 + tid) * 16), smem + (bufoff) + 16384 + (_i * 512 + tid) * 16); } \
        glds16((const bf16_t*)(sp + (size_t)(cc) * 8192 + tid * 16), smem + (bufoff) + 32768 + tid * 16); \
        if (tid < 64) glds16((const bf16_t*)(rp + (size_t)(cc) * 1024 + tid * 16), smem + (bufoff) + 40960 + tid * 16); \
        _Pragma("unroll") for (int _i = 0; _i < 4; ++_i) glds16(vsrc + (long)(cc) * 64 * 1024 + (long)_i * 16 * 1024, smem + SC_V + ((cc) & 1) * 32768 + (_i * 512 + tid) * 16); } while (0)
    __syncthreads();
    if (tid < 256) ((bf16_t*)(smem + SC_NBF))[tid] = 0;
    float nreg = 0.f;
    SC_STAGE(0, 0);
    asm volatile("s_waitcnt vmcnt(0)" ::: "memory");
#pragma unroll 1
    for (int c = 0; c < 64; ++c) {
        const int par = c & 1;
        const long tok0 = tokb + c * 64;
        int fr = fr0, fq = fq0;
        asm volatile("" : "+v"(fr), "+v"(fq));
        const char* buf = smem + par * SC_BUF;
        asm volatile("s_waitcnt vmcnt(10) lgkmcnt(0)" ::: "memory");
        __builtin_amdgcn_s_barrier();
        if (c + 1 < 64 && !(mode & 1)) SC_STAGE(c + 1, (par ^ 1) * SC_BUF);
        f32x4 Y[4][2], DN[4];
#pragma unroll
        for (int tt = 0; tt < 4; ++tt) { Y[tt][0] = (f32x4){0.f, 0.f, 0.f, 0.f}; Y[tt][1] = (f32x4){0.f, 0.f, 0.f, 0.f}; DN[tt] = (f32x4){0.f, 0.f, 0.f, 0.f}; }
        const char* nbf = smem + SC_NBF + par * 256;
        const char* vb = smem + SC_V + par * 32768;
#define SC_LDC(ks, A, NB) do { \
            const u32x2 nlo_ = *(const u32x2*)(nbf + (32 * (ks) + 4 * fq) * 2), nhi_ = *(const u32x2*)(nbf + (32 * (ks) + 16 + 4 * fq) * 2); \
            u32x4 nv_; nv_[0] = nlo_[0]; nv_[1] = nlo_[1]; nv_[2] = nhi_[0]; nv_[3] = nhi_[1]; NB = __builtin_bit_cast(bf16x8, nv_); \
            _Pragma("unroll") for (int tt_ = 0; tt_ < 4; ++tt_) { \
                const u32x2 lo_ = *(const u32x2*)(buf + offQK(tt_ * 16 + fr, 4 * (ks) + (fq >> 1)) + (fq & 1) * 8); \
                const u32x2 hi_ = *(const u32x2*)(buf + offQK(tt_ * 16 + fr, 4 * (ks) + 2 + (fq >> 1)) + (fq & 1) * 8); \
                u32x4 av_; av_[0] = lo_[0]; av_[1] = lo_[1]; av_[2] = hi_[0]; av_[3] = hi_[1]; A[tt_] = __builtin_bit_cast(bf16x8, av_); } } while (0)
#define SC_MMC(ks, A, NB) do { \
            u32x4 c0_, c1_; \
            c0_[0] = pk_bf16(C[2 * (ks)][0][0], C[2 * (ks)][0][1]); c0_[1] = pk_bf16(C[2 * (ks)][0][2], C[2 * (ks)][0][3]); \
            c0_[2] = pk_bf16(C[2 * (ks) + 1][0][0], C[2 * (ks) + 1][0][1]); c0_[3] = pk_bf16(C[2 * (ks) + 1][0][2], C[2 * (ks) + 1][0][3]); \
            c1_[0] = pk_bf16(C[2 * (ks)][1][0], C[2 * (ks)][1][1]); c1_[1] = pk_bf16(C[2 * (ks)][1][2], C[2 * (ks)][1][3]); \
            c1_[2] = pk_bf16(C[2 * (ks) + 1][1][0], C[2 * (ks) + 1][1][1]); c1_[3] = pk_bf16(C[2 * (ks) + 1][1][2], C[2 * (ks) + 1][1][3]); \
            const bf16x8 cf0_ = __builtin_bit_cast(bf16x8, c0_), cf1_ = __builtin_bit_cast(bf16x8, c1_); \
            _Pragma("unroll") for (int tt_ = 0; tt_ < 4; ++tt_) { \
                Y[tt_][0] = __builtin_amdgcn_mfma_f32_16x16x32_bf16(A[tt_], cf0_, Y[tt_][0], 0, 0, 0); \
                Y[tt_][1] = __builtin_amdgcn_mfma_f32_16x16x32_bf16(A[tt_], cf1_, Y[tt_][1], 0, 0, 0); \
                DN[tt_] = __builtin_amdgcn_mfma_f32_16x16x32_bf16(A[tt_], NB, DN[tt_], 0, 0, 0); } } while (0)
#define SC_SCHED __builtin_amdgcn_sched_barrier(0)
        bf16x8 A0[4], A1[4], nb0, nb1;
        SC_LDC(0, A0, nb0);
        SC_LDC(1, A1, nb1); SC_SCHED; SC_MMC(0, A0, nb0); SC_SCHED;
        SC_LDC(2, A0, nb0); SC_SCHED; SC_MMC(1, A1, nb1); SC_SCHED;
        SC_LDC(3, A1, nb1); SC_SCHED; SC_MMC(2, A0, nb0); SC_SCHED;
        bf16x8 vf[2][2], sf[2][4];
#pragma unroll
        for (int ks = 0; ks < 2; ++ks)
#pragma unroll
            for (int et = 0; et < 2; ++et) {
                const int cidx = 2 * wid + et, ch = 2 * cidx + ((fr & 3) >> 1);
                const int r0 = 32 * ks + 8 * fq + (fr >> 2);
                vf[ks][et] = tr_read2(vb + offV(r0, ch) + 8 * (fr & 1), vb + offV(r0 + 4, ch) + 8 * (fr & 1));
            }
#pragma unroll
        for (int ks = 0; ks < 2; ++ks)
#pragma unroll
            for (int tt = 0; tt < 4; ++tt) sf[ks][tt] = *(const bf16x8*)(buf + 32768 + offSw(tt * 16 + fr, 4 * ks + fq));
        SC_SCHED; SC_MMC(3, A1, nb1); SC_SCHED;
#define SC_LDK(dt, ks, KF) do { const int ch_ = 2 * (dt) + ((fr & 3) >> 1); const int r0_ = 32 * (ks) + 8 * fq + (fr >> 2); \
            KF = tr_read2(buf + 16384 + offQK(r0_, ch_) + 8 * (fr & 1), buf + 16384 + offQK(r0_ + 4, ch_) + 8 * (fr & 1)); } while (0)
        bf16x8 kfa[4], kfb[4];
        SC_LDK(0, 0, kfa[0]); SC_LDK(0, 1, kfa[1]); SC_LDK(1, 0, kfa[2]); SC_LDK(1, 1, kfa[3]);
        SC_SCHED;
#pragma unroll
        for (int ks = 0; ks < 2; ++ks)
#pragma unroll
            for (int tt = 0; tt < 4; ++tt) {
                Y[tt][0] = __builtin_amdgcn_mfma_f32_16x16x32_bf16(sf[ks][tt], vf[ks][0], Y[tt][0], 0, 0, 0);
                Y[tt][1] = __builtin_amdgcn_mfma_f32_16x16x32_bf16(sf[ks][tt], vf[ks][1], Y[tt][1], 0, 0, 0);
            }
        SC_SCHED;
#define SC_MMK(dt0, KF) do { \
            C[dt0][0] = __builtin_amdgcn_mfma_f32_16x16x32_bf16(KF[0], vf[0][0], C[dt0][0], 0, 0, 0); C[dt0][1] = __builtin_amdgcn_mfma_f32_16x16x32_bf16(KF[0], vf[0][1], C[dt0][1], 0, 0, 0); \
            C[dt0][0] = __builtin_amdgcn_mfma_f32_16x16x32_bf16(KF[1], vf[1][0], C[dt0][0], 0, 0, 0); C[dt0][1] = __builtin_amdgcn_mfma_f32_16x16x32_bf16(KF[1], vf[1][1], C[dt0][1], 0, 0, 0); \
            C[dt0 + 1][0] = __builtin_amdgcn_mfma_f32_16x16x32_bf16(KF[2], vf[0][0], C[dt0 + 1][0], 0, 0, 0); C[dt0 + 1][1] = __builtin_amdgcn_mfma_f32_16x16x32_bf16(KF[2], vf[0][1], C[dt0 + 1][1], 0, 0, 0); \
            C[dt0 + 1][0] = __builtin_amdgcn_mfma_f32_16x16x32_bf16(KF[3], vf[1][0], C[dt0 + 1][0], 0, 0, 0); C[dt0 + 1][1] = __builtin_amdgcn_mfma_f32_16x16x32_bf16(KF[3], vf[1][1], C[dt0 + 1][1], 0, 0, 0); } while (0)
        SC_LDK(2, 0, kfb[0]); SC_LDK(2, 1, kfb[1]); SC_LDK(3, 0, kfb[2]); SC_LDK(3, 1, kfb[3]); SC_SCHED; SC_MMK(0, kfa); SC_SCHED;
        SC_LDK(4, 0, kfa[0]); SC_LDK(4, 1, kfa[1]); SC_LDK(5, 0, kfa[2]); SC_LDK(5, 1, kfa[3]); SC_SCHED; SC_MMK(2, kfb); SC_SCHED;
        SC_LDK(6, 0, kfb[0]); SC_LDK(6, 1, kfb[1]); SC_LDK(7, 0, kfb[2]); SC_LDK(7, 1, kfb[3]); SC_SCHED; SC_MMK(4, kfa); SC_SCHED;
        SC_MMK(6, kfb); SC_SCHED;
#undef SC_LDC
#undef SC_MMC
#undef SC_LDK
#undef SC_MMK
#undef SC_SCHED
        const float* recf = (const float*)(buf + 40960);
        float* sq_out = ssqp + ((size_t)(bh * 64 + c) * 8 + wid) * 64;
#pragma unroll
        for (int tt = 0; tt < 4; ++tt) {
            const float4 rsv = *(const float4*)(recf + tt * 16 + fq * 4);
            const float dd[4] = {rsv.x + DN[tt][0], rsv.y + DN[tt][1], rsv.z + DN[tt][2], rsv.w + DN[tt][3]};
            float sq[4];
#pragma unroll
            for (int j = 0; j < 4; ++j) {
                const float inv = __builtin_amdgcn_rcpf(fmaxf(fabsf(dd[j]), 1.0f));
                Y[tt][0][j] *= inv; Y[tt][1][j] *= inv;
                sq[j] = row16_sum(Y[tt][0][j] * Y[tt][0][j] + Y[tt][1][j] * Y[tt][1][j]);
            }
            if (!(mode & 4)) {
                if (fr == 0) *(float4*)(sq_out + tt * 16 + fq * 4) = make_float4(sq[0], sq[1], sq[2], sq[3]);
#pragma unroll
                for (int et = 0; et < 2; ++et) {
                    const int e = wid * 32 + et * 16 + fr;
                    store_bf16x4(hm + (tok0 + (e >> 2)) * 1024 + h * 256 + (e & 3) * 64 + tt * 16 + fq * 4, Y[tt][et]);
                }
            } else asm volatile("" :: "v"(Y[tt][0]), "v"(Y[tt][1]), "v"(sq[0]), "v"(sq[1]), "v"(sq[2]), "v"(sq[3]));
        }
        const float g = recf[192];
#pragma unroll
        for (int dt = 0; dt < 8; ++dt) { C[dt][0] *= g; C[dt][1] *= g; }
        if (tid < 128) {
            nreg = g * (nreg + recf[64 + (tid & 127)]);
            ((bf16_t*)(smem + SC_NBF + (par ^ 1) * 256))[tid] = (bf16_t)(pk_bf16(nreg, nreg) & 0xffffu);
        }
    }
    asm volatile("s_waitcnt vmcnt(0) lgkmcnt(0)" ::: "memory");
    __syncthreads();
#undef SC_STAGE
}

__device__ __forceinline__ void ml_finish_item(const Params& p, char* smem, int item) {
    const int tid = opaque_tid(), lane = tid & 63, wid = tid >> 6;
    const int c = item & 63, bh = item >> 6, b = bh >> 2, h = bh & 3;
    char* ws = uni(p.ws);
    bf16_t* hm = (bf16_t*)uni(p.out);
    const bf16_t* mo = (const bf16_t*)(ws + OFF_MO);
    const float* ssqp = (const float*)(ws + OFF_SSQP) + (size_t)item * 512;
    const float* gain = uni(p.ml_g) + h * 256;
    const long tok0 = (long)b * 4096 + c * 64;
    float* rs = (float*)(smem + 32768);
#pragma unroll
    for (int i = 0; i < 4; ++i) {
        const int q = i * 512 + tid;
        glds16(hm + (tok0 + (q >> 5)) * 1024 + h * 256 + (q & 31) * 8, smem + q * 16);
    }
    if (tid < 64) {
        float sacc = 0.f;
#pragma unroll
        for (int w = 0; w < 8; ++w) sacc += ssqp[w * 64 + tid];
        rs[tid] = rsqrtf(sacc * (1.0f / 256.0f) + 1e-6f);
    }
    asm volatile("s_waitcnt vmcnt(0)" ::: "memory");
    __syncthreads();
    const int i16 = lane & 15, g4 = lane >> 4, q4 = i16 >> 2, p4 = i16 & 3;
#pragma unroll
    for (int it = 0; it < 4; ++it) {
        const int combo = wid * 4 + it, tb = combo & 3, eoct = (combo >> 2) * 4 + g4;
        const int t = tb * 16 + i16, e = eoct * 8;
        const char* a0 = smem + (e + q4) * 128 + (tb * 16 + 4 * p4) * 2;
        const bf16x8 hv = tr_read2(a0, a0 + 4 * 128);
        const u32x4 hw = __builtin_bit_cast(u32x4, hv);
        const u32x4 mw = *(const u32x4*)(mo + (tok0 + t) * 1024 + h * 256 + e);
        const float4 ga = *(const float4*)(gain + e), gb = *(const float4*)(gain + e + 4);
        const float r = rs[t];
        u32x4 o;
        o[0] = pk_bf16(bf_lo(hw[0]) * r * ga.x * bf_lo(mw[0]), bf_hi(hw[0]) * r * ga.y * bf_hi(mw[0]));
        o[1] = pk_bf16(bf_lo(hw[1]) * r * ga.z * bf_lo(mw[1]), bf_hi(hw[1]) * r * ga.w * bf_hi(mw[1]));
        o[2] = pk_bf16(bf_lo(hw[2]) * r * gb.x * bf_lo(mw[2]), bf_hi(hw[2]) * r * gb.y * bf_hi(mw[2]));
        o[3] = pk_bf16(bf_lo(hw[3]) * r * gb.z * bf_lo(mw[3]), bf_hi(hw[3]) * r * gb.w * bf_hi(mw[3]));
        *(u32x4*)(hm + (tok0 + t) * 1024 + h * 256 + e) = o;
    }
    __syncthreads();
}

__device__ __forceinline__ void swa_stage(const bf16_t* ak, const bf16_t* avT, int item, char* kbuf, int tid) {
    const int kvh = item & 1, n = (item >> 1) & 31, b = item >> 6;
    const long tokbase = (long)b * 4096 + n * 128 - 128;
    const int rk = tid >> 3, pck = tid & 7, lck = pck ^ ((rk >> 1) & 7);
    const bf16_t* srck = ak + (tokbase + rk) * 128 + kvh * 64 + lck * 8;
#pragma unroll
    for (int i = 0; i < 4; ++i) glds16(srck + (long)i * 64 * 128, kbuf + (i * 512 + tid) * 16);
    const int rv = tid >> 5, pcv = tid & 31, lcv = pcv ^ (rv & 15);
    const bf16_t* srcv = avT + (long)(kvh * 64 + rv) * T_ + tokbase + lcv * 8;
#pragma unroll
    for (int i = 0; i < 4; ++i) glds16(srcv + (long)i * 16 * T_, kbuf + 32768 + (i * 512 + tid) * 16);
}
__device__ __forceinline__ const bf16_t* swa_qptr(const bf16_t* aq, int item, int u, int wid, int fr, int fq) {
    const int kvh = item & 1, n = (item >> 1) & 31, b = item >> 6;
    return aq + ((long)b * 4096 + n * 128 + u * 32 + fr) * 1024 + (kvh * 8 + wid) * 64 + fq * 8;
}
__device__ __forceinline__ void swa_items(const Params& p, char* smem, int first, int stride, int hi) {
    const int tid = opaque_tid(), lane = tid & 63, wid = tid >> 6, fr = lane & 15, fq = lane >> 4;
    char* ws = uni(p.ws);
    const bf16_t* aq = (const bf16_t*)(ws + OFF_R1);
    const bf16_t* ak = (const bf16_t*)(ws + OFF_AK);
    const bf16_t* avT = (const bf16_t*)(ws + OFF_AV);
    bf16_t* ao = (bf16_t*)(ws + OFF_R0);
    if (first >= hi) return;
    __syncthreads();
    swa_stage(ak, avT, first, smem, tid);
    bf16x8 qc[4];
    {
        const bf16_t* qp = swa_qptr(aq, first, 0, wid, fr, fq);
        qc[0] = *(const bf16x8*)(qp); qc[1] = *(const bf16x8*)(qp + 32); qc[2] = *(const bf16x8*)(qp + 16 * 1024); qc[3] = *(const bf16x8*)(qp + 16 * 1024 + 32);
    }
    int pb = 0;
    for (int item = first; item < hi; item += stride, pb ^= 1) {
        const int kvh = item & 1, n = (item >> 1) & 31, b = item >> 6;
        const int hq = kvh * 8 + wid;
        char* kbuf = smem + pb * 65536; char* vbuf = kbuf + 32768;
        const float sink = uni(p.sinks)[hq];
        asm volatile("s_waitcnt vmcnt(0)" ::: "memory");
        __syncthreads();
        const bool has_next = item + stride < hi;
        if (has_next) swa_stage(ak, avT, item + stride, smem + (pb ^ 1) * 65536, tid);
        const int kswz = (fr >> 1) & 7;
#pragma unroll 1
        for (int u = 0; u < 4; ++u) {
            const long tq = (long)b * 4096 + n * 128 + u * 32 + fr;
            bf16x8 qn[4];
            {
                const bool nx = (u < 3) || has_next;
                const bf16_t* qp = nx ? (u < 3 ? swa_qptr(aq, item, u + 1, wid, fr, fq) : swa_qptr(aq, item + stride, 0, wid, fr, fq)) : swa_qptr(aq, item, u, wid, fr, fq);
                qn[0] = *(const bf16x8*)(qp); qn[1] = *(const bf16x8*)(qp + 32); qn[2] = *(const bf16x8*)(qp + 16 * 1024); qn[3] = *(const bf16x8*)(qp + 16 * 1024 + 32);
            }
            f32x4 sc[10][2];
#pragma unroll
            for (int r = 0; r < 10; ++r) {
                sc[r][0] = (f32x4){0.f, 0.f, 0.f, 0.f}; sc[r][1] = (f32x4){0.f, 0.f, 0.f, 0.f};
                if (!(n == 0 && (2 * u + r) < 8)) {
                    const char* rowp = kbuf + ((2 * u + r) * 16 + fr) * 128;
                    const bf16x8 k0 = *(const bf16x8*)(rowp + ((fq ^ kswz) * 16)), k1 = *(const bf16x8*)(rowp + (((4 + fq) ^ kswz) * 16));
                    sc[r][0] = __builtin_amdgcn_mfma_f32_16x16x32_bf16(k0, qc[0], sc[r][0], 0, 0, 0);
                    sc[r][0] = __builtin_amdgcn_mfma_f32_16x16x32_bf16(k1, qc[1], sc[r][0], 0, 0, 0);
                    sc[r][1] = __builtin_amdgcn_mfma_f32_16x16x32_bf16(k0, qc[2], sc[r][1], 0, 0, 0);
                    sc[r][1] = __builtin_amdgcn_mfma_f32_16x16x32_bf16(k1, qc[3], sc[r][1], 0, 0, 0);
                }
            }
            u32x4 pf[2][5]; float linv[2];
#pragma unroll
            for (int nt = 0; nt < 2; ++nt) {
                float m = sink;
#pragma unroll
                for (int r = 0; r < 10; ++r) {
                    const bool tile_ok = !(n == 0 && (2 * u + r) < 8);
#pragma unroll
                    for (int j = 0; j < 4; ++j) {
                        const int delta = (r - nt) * 16 + fq * 4 + j - fr;
                        const bool ok = tile_ok && delta >= 1 && delta <= 128;
                        sc[r][nt][j] = ok ? sc[r][nt][j] : -INFINITY;
                        m = fmaxf(m, sc[r][nt][j]);
                    }
                }
                m = fmaxf(m, __shfl_xor(m, 16)); m = fmaxf(m, __shfl_xor(m, 32));
                float l = 0.f;
#pragma unroll
                for (int s2 = 0; s2 < 5; ++s2) {
                    float e[8];
#pragma unroll
                    for (int j = 0; j < 4; ++j) { e[j] = __expf(sc[2 * s2][nt][j] - m); e[4 + j] = __expf(sc[2 * s2 + 1][nt][j] - m); }
                    l += ((e[0] + e[1]) + (e[2] + e[3])) + ((e[4] + e[5]) + (e[6] + e[7]));
                    u32x4 w; w[0] = pk_bf16(e[0], e[1]); w[1] = pk_bf16(e[2], e[3]); w[2] = pk_bf16(e[4], e[5]); w[3] = pk_bf16(e[6], e[7]);
                    pf[nt][s2] = w;
                }
                l += __shfl_xor(l, 16); l += __shfl_xor(l, 32);
                linv[nt] = __builtin_amdgcn_rcpf(l + __expf(sink - m));
            }
            f32x4 o[4][2];
#pragma unroll
            for (int dt = 0; dt < 4; ++dt) { o[dt][0] = (f32x4){0.f, 0.f, 0.f, 0.f}; o[dt][1] = (f32x4){0.f, 0.f, 0.f, 0.f}; }
#pragma unroll
            for (int s2 = 0; s2 < 5; ++s2) {
                if (!(n == 0 && (2 * u + 2 * s2) < 8)) {
                    const int ca = ((((2 * u + 2 * s2) * 2 + (fq >> 1)) ^ fr) * 16) + (fq & 1) * 8;
                    const int cb = ((((2 * u + 2 * s2 + 1) * 2 + (fq >> 1)) ^ fr) * 16) + (fq & 1) * 8;
                    const bf16x8 p0 = __builtin_bit_cast(bf16x8, pf[0][s2]), p1 = __builtin_bit_cast(bf16x8, pf[1][s2]);
#pragma unroll
                    for (int dt = 0; dt < 4; ++dt) {
                        const char* rowp = vbuf + (dt * 16 + fr) * 512;
                        const u32x2 va = *(const u32x2*)(rowp + ca), vb = *(const u32x2*)(rowp + cb);
                        u32x4 vv; vv[0] = va[0]; vv[1] = va[1]; vv[2] = vb[0]; vv[3] = vb[1];
                        const bf16x8 vf = __builtin_bit_cast(bf16x8, vv);
                        o[dt][0] = __builtin_amdgcn_mfma_f32_16x16x32_bf16(vf, p0, o[dt][0], 0, 0, 0);
                        o[dt][1] = __builtin_amdgcn_mfma_f32_16x16x32_bf16(vf, p1, o[dt][1], 0, 0, 0);
                    }
                }
            }
#pragma unroll
            for (int nt = 0; nt < 2; ++nt) {
                bf16_t* rp = ao + (size_t)(tq + nt * 16) * 1024 + hq * 64 + fq * 4;
#pragma unroll
                for (int dt = 0; dt < 4; ++dt) store_bf16x4(rp + dt * 16, o[dt][nt] * linv[nt]);
            }
#pragma unroll
            for (int k = 0; k < 4; ++k) qc[k] = qn[k];
        }
    }
    asm volatile("s_waitcnt vmcnt(0)" ::: "memory");
    __syncthreads();
}

constexpr int SWA_A = 0;
__device__ __forceinline__ void phase2a(const Params& p, char* smem, int which = 3) {
    const int G = gridDim.x;
    if (which & 1) for (int it = blockIdx.x; it < 4096; it += G) ml_prepass_item(p, smem, it);
    if (which & 2) swa_items(p, smem, blockIdx.x, G, SWA_A);
}
__device__ __forceinline__ void phase2c(const Params& p, char* smem) {
    for (int it = blockIdx.x; it < 4096; it += gridDim.x) ml_finish_item(p, smem, it);
}
__device__ __forceinline__ void phase2b(const Params& p, char* smem, int which = 3, const int mode = 0) {
    const int G = gridDim.x;
    if (G > 64) {
        if (blockIdx.x < 64) { if (which & 1) ml_scan(p, smem, blockIdx.x, mode); }
        else { if (which & 2) { swa_items(p, smem, SWA_A + blockIdx.x - 64, G - 64, 1024); moe_weight_prep(p, smem, blockIdx.x - 64, G - 64); kv_projection(p, smem, blockIdx.x - 64, G - 64); } }
    } else {
        for (int it = blockIdx.x; it < 64; it += G) ml_scan(p, smem, it);
        swa_items(p, smem, SWA_A + blockIdx.x, G, 1024);
        moe_weight_prep(p, smem, blockIdx.x, G);
        kv_projection(p, smem, blockIdx.x, G);
    }
}

struct EpiP3 {
    const bf16_t* gg; bf16_t* y;
    __device__ __forceinline__ void operator()(f32x4 (&acc)[2][2][4][2], const pg8::Unit& u, int wr, int wc, int fr, int fq) const {
        const int row0 = u.pm * 256 + wr * 64 + fr, col0 = u.pn * 256 + wc * 32 + fq * 8;
        const bool first = (u.aux & 1) == 0;
#pragma unroll
        for (int ai = 0; ai < 2; ++ai)
#pragma unroll
            for (int m = 0; m < 4; ++m) {
                const size_t tok = row0 + ai * 128 + m * 16;
#pragma unroll
                for (int bj = 0; bj < 2; ++bj) {
                    const int col = col0 + bj * 128;
                    const u32x4 gm = *(const u32x4*)(gg + tok * 2048 + 1024 + col);
                    float gmf[8] = {bf_lo(gm[0]), bf_hi(gm[0]), bf_lo(gm[1]), bf_hi(gm[1]), bf_lo(gm[2]), bf_hi(gm[2]), bf_lo(gm[3]), bf_hi(gm[3])};
                    if (first) {
                        const u32x4 ga = *(const u32x4*)(gg + tok * 2048 + col);
                        const float gaf[8] = {bf_lo(ga[0]), bf_hi(ga[0]), bf_lo(ga[1]), bf_hi(ga[1]), bf_lo(ga[2]), bf_hi(ga[2]), bf_lo(ga[3]), bf_hi(ga[3])};
#pragma unroll
                        for (int k = 0; k < 4; ++k) {
                            acc[ai][bj][m][0][k] *= gaf[k] * __builtin_amdgcn_rcpf(fmaxf(gmf[k], 1e-30f));
                            acc[ai][bj][m][1][k] *= gaf[4 + k] * __builtin_amdgcn_rcpf(fmaxf(gmf[4 + k], 1e-30f));
                        }
                    } else {
                        f32x4 v0, v1;
#pragma unroll
                        for (int k = 0; k < 4; ++k) { v0[k] = acc[ai][bj][m][0][k] * gmf[k]; v1[k] = acc[ai][bj][m][1][k] * gmf[4 + k]; }
                        store_bf16x8(y + tok * 1024 + col, v0, v1);
                    }
                }
                if (m & 1) __builtin_amdgcn_sched_barrier(0);
            }
    }
};
__device__ __forceinline__ void phase3(const Params& p, char* smem) {
    char* ws = uni(p.ws);
    SchedN1024<2> S{(int)gridDim.x, (int)blockIdx.x, ws + OFF_R0, ws + OFF_WATT, (const char*)uni(p.out), ws + OFF_WML};
    EpiP3 E{(const bf16_t*)(ws + OFF_GG), (bf16_t*)(ws + OFF_R1)};
    pg8::gemm_phase<EpiP3, SchedN1024<2>>((LDS_AS unsigned char*)smem, 1024, S, E);
}

struct EpiBf16 {
    bf16_t* outb; float scale;
    __device__ __forceinline__ void operator()(f32x4 (&acc)[2][2][4][2], const pg8::Unit& u, int wr, int wc, int fr, int fq) const {
        const int row0 = u.pm * 256 + wr * 64 + fr, col0 = u.pn * 256 + wc * 32 + fq * 8;
#pragma unroll
        for (int ai = 0; ai < 2; ++ai)
#pragma unroll
            for (int m = 0; m < 4; ++m) {
                const size_t tok = row0 + ai * 128 + m * 16;
#pragma unroll
                for (int bj = 0; bj < 2; ++bj) store_bf16x8(outb + tok * 1024 + col0 + bj * 128, acc[ai][bj][m][0] * scale, acc[ai][bj][m][1] * scale);
            }
    }
};
__device__ __forceinline__ void phase_gemm_bf16(const Params& p, char* smem, const bf16_t* A, const bf16_t* Bt, bf16_t* outb, float scale) {
    SchedN1024<1> S{(int)gridDim.x, (int)blockIdx.x, (const char*)A, (const char*)Bt, (const char*)A, (const char*)Bt};
    EpiBf16 E{outb, scale};
    pg8::gemm_phase<EpiBf16, SchedN1024<1>>((LDS_AS unsigned char*)smem, 1024, S, E);
}

__device__ __forceinline__ void ln_row(float4 (&v)[4], const float* g, const float* bta, int lane) {
    float s = 0.f;
#pragma unroll
    for (int i = 0; i < 4; ++i) s += (v[i].x + v[i].y) + (v[i].z + v[i].w);
    const float mu = wsum(s) * (1.0f / 1024.0f);
    float q = 0.f;
#pragma unroll
    for (int i = 0; i < 4; ++i) { const float a = v[i].x - mu, b = v[i].y - mu, c = v[i].z - mu, d = v[i].w - mu; q += (a * a + b * b) + (c * c + d * d); }
    const float rstd = rsqrtf(wsum(q) * (1.0f / 1024.0f) + 1e-5f);
#pragma unroll
    for (int i = 0; i < 4; ++i) {
        const float4 gg = *(const float4*)(g + i * 256 + lane * 4), bb = *(const float4*)(bta + i * 256 + lane * 4);
        v[i].x = (v[i].x - mu) * rstd * gg.x + bb.x; v[i].y = (v[i].y - mu) * rstd * gg.y + bb.y;
        v[i].z = (v[i].z - mu) * rstd * gg.z + bb.z; v[i].w = (v[i].w - mu) * rstd * gg.w + bb.w;
    }
}

__device__ __forceinline__ void phase_ln1(const Params& p) {
    const int tid_ = opaque_tid(); const int lane = tid_ & 63, wid = tid_ >> 6;
    float* z = uni(p.out); bf16_t* hb = (bf16_t*)(uni(p.ws) + OFF_R0);
    for (int row = blockIdx.x * 8 + wid; row < T_; row += gridDim.x * 8) {
        float4 v[4];
#pragma unroll
        for (int i = 0; i < 4; ++i) {
            const float4 xx = *(const float4*)(uni(p.x) + (size_t)row * 1024 + i * 256 + lane * 4);
            const uint2 mm = *(const uint2*)(hb + (size_t)row * 1024 + i * 256 + lane * 4);
            v[i].x = ALPHA * xx.x + bf_lo(mm.x); v[i].y = ALPHA * xx.y + bf_hi(mm.x); v[i].z = ALPHA * xx.z + bf_lo(mm.y); v[i].w = ALPHA * xx.w + bf_hi(mm.y);
        }
        ln_row(v, uni(p.ln1g), uni(p.ln1b), lane);
#pragma unroll
        for (int i = 0; i < 4; ++i) {
            uint2 w; w.x = pk_bf16(v[i].x, v[i].y); w.y = pk_bf16(v[i].z, v[i].w);
            *(uint2*)(hb + (size_t)row * 1024 + i * 256 + lane * 4) = w;
        }
    }
}

__device__ __forceinline__ void xa_stage_k(const bf16_t* kmat, int b, int h, int kh, char* buf, int tid) {
    const int rl = tid >> 5, pc = tid & 31, lc = pc ^ (rl & 15);
    const bf16_t* src = kmat + (size_t)(b * 256 + kh * 128 + rl) * 1024 + h * 256 + lc * 8;
#pragma unroll
    for (int i = 0; i < 8; ++i) glds16(src + (size_t)i * 16 * 1024, buf + (i * 512 + tid) * 16);
}
__device__ __forceinline__ void xa_stage_v(const bf16_t* vT, int b, int h, int vh, char* buf, int tid) {
    const int rl = tid >> 4, pc = tid & 15, lc = pc ^ (rl & 15);
    const bf16_t* src = vT + (size_t)(h * 256 + rl) * 4096 + b * 256 + vh * 128 + lc * 8;
#pragma unroll
    for (int i = 0; i < 8; ++i) glds16(src + (size_t)i * 32 * 4096, buf + (i * 512 + tid) * 16);
}

template <int KH>
__device__ __forceinline__ void xa_scores(f32x4 (&acc)[16][2], const char* buf, const bf16x8 (&qf)[2][8], int fr, int fq) {
#pragma unroll
    for (int ks = 0; ks < 8; ++ks) {
        const int ch = ((ks * 4 + fq) ^ fr) * 16;
#pragma unroll
        for (int mt = 0; mt < 8; ++mt) {
            const bf16x8 kf = *(const bf16x8*)(buf + (mt * 16 + fr) * 512 + ch);
            acc[KH * 8 + mt][0] = __builtin_amdgcn_mfma_f32_16x16x32_bf16(kf, qf[0][ks], acc[KH * 8 + mt][0], 0, 0, 0);
            acc[KH * 8 + mt][1] = __builtin_amdgcn_mfma_f32_16x16x32_bf16(kf, qf[1][ks], acc[KH * 8 + mt][1], 0, 0, 0);
        }
        if (ks & 1) __builtin_amdgcn_sched_barrier(0);
    }
}

template <int VH, int DH>
__device__ __forceinline__ void xa_pv(f32x4 (&o)[8][2], const u32x4 (&pf)[2][8], const char* buf, int fr, int fq) {
#pragma unroll
    for (int ks = 0; ks < 4; ++ks) {
        const int ca = ((ks * 4 + (fq >> 1)) ^ fr) * 16 + (fq & 1) * 8, cb = ((ks * 4 + 2 + (fq >> 1)) ^ fr) * 16 + (fq & 1) * 8;
        const bf16x8 p0 = __builtin_bit_cast(bf16x8, pf[0][VH * 4 + ks]), p1 = __builtin_bit_cast(bf16x8, pf[1][VH * 4 + ks]);
#pragma unroll
        for (int dt = 0; dt < 8; ++dt) {
            const char* rowp = buf + ((DH * 8 + dt) * 16 + fr) * 256;
            const u32x2 va = *(const u32x2*)(rowp + ca), vb = *(const u32x2*)(rowp + cb);
            u32x4 vv; vv[0] = va[0]; vv[1] = va[1]; vv[2] = vb[0]; vv[3] = vb[1];
            const bf16x8 vf = __builtin_bit_cast(bf16x8, vv);
            o[dt][0] = __builtin_amdgcn_mfma_f32_16x16x32_bf16(vf, p0, o[dt][0], 0, 0, 0);
            o[dt][1] = __builtin_amdgcn_mfma_f32_16x16x32_bf16(vf, p1, o[dt][1], 0, 0, 0);
        }
    }
}

__device__ __forceinline__ void phase6(const Params& p, char* smem) {
    const int tid = opaque_tid(), lane = tid & 63, wid = tid >> 6, fr = lane & 15, fq = lane >> 4;
    char* ws = uni(p.ws);
    const bf16_t* xq = (const bf16_t*)(ws + OFF_XQ);
    const bf16_t* kmat = (const bf16_t*)(ws + OFF_KMAT);
    const bf16_t* vT = (const bf16_t*)(ws + OFF_VT);
    bf16_t* og = (bf16_t*)(ws + OFF_O);
    char* bufA = smem; char* bufB = smem + 65536;
    const int G = gridDim.x;
    for (int idx = blockIdx.x; idx < 1024; idx += G) {
        int pair, qt;
        if (G == 256) { const int i = idx >> 8, blk = idx & 255, xcd = blk & 7, jj = blk >> 3; pair = (i * 8 + xcd) * 2 + (jj >> 4); qt = jj & 15; }
        else { pair = idx >> 4; qt = idx & 15; }
        const int b = pair >> 2, h = pair & 3;
        const int tok0 = b * 4096 + qt * 256 + wid * 32;
        xa_stage_k(kmat, b, h, 0, bufA, tid);
        xa_stage_k(kmat, b, h, 1, bufB, tid);
        const bf16_t* q0p = xq + (size_t)(tok0 + fr) * 1024 + h * 256 + fq * 8;
        const bf16_t* q1p = q0p + (size_t)16 * 1024;
        bf16x8 qf[2][8];
#pragma unroll
        for (int ks = 0; ks < 8; ++ks) { qf[0][ks] = *(const bf16x8*)(q0p + ks * 32); qf[1][ks] = *(const bf16x8*)(q1p + ks * 32); }
        f32x4 acc[16][2];
#pragma unroll
        for (int mt = 0; mt < 16; ++mt) { acc[mt][0] = (f32x4){0.f, 0.f, 0.f, 0.f}; acc[mt][1] = (f32x4){0.f, 0.f, 0.f, 0.f}; }
        asm volatile("s_waitcnt vmcnt(0)" ::: "memory");
        __syncthreads();
        xa_scores<0>(acc, bufA, qf, fr, fq);
        xa_scores<1>(acc, bufB, qf, fr, fq);
        __syncthreads();
        xa_stage_v(vT, b, h, 0, bufA, tid);
        xa_stage_v(vT, b, h, 1, bufB, tid);
        u32x4 pf[2][8]; float linv[2];
#pragma unroll
        for (int nt = 0; nt < 2; ++nt) {
            float m = -INFINITY;
#pragma unroll
            for (int mt = 0; mt < 16; ++mt) m = fmaxf(m, fmaxf(fmaxf(acc[mt][nt][0], acc[mt][nt][1]), fmaxf(acc[mt][nt][2], acc[mt][nt][3])));
            m = fmaxf(m, __shfl_xor(m, 16)); m = fmaxf(m, __shfl_xor(m, 32));
            float l = 0.f;
#pragma unroll
            for (int s2 = 0; s2 < 8; ++s2) {
                float e[8];
#pragma unroll
                for (int j = 0; j < 4; ++j) { e[j] = __expf(acc[2 * s2][nt][j] - m); e[4 + j] = __expf(acc[2 * s2 + 1][nt][j] - m); }
                l += ((e[0] + e[1]) + (e[2] + e[3])) + ((e[4] + e[5]) + (e[6] + e[7]));
                u32x4 w; w[0] = pk_bf16(e[0], e[1]); w[1] = pk_bf16(e[2], e[3]); w[2] = pk_bf16(e[4], e[5]); w[3] = pk_bf16(e[6], e[7]);
                pf[nt][s2] = w;
            }
            l += __shfl_xor(l, 16); l += __shfl_xor(l, 32);
            linv[nt] = 1.0f / l;
        }
        asm volatile("s_waitcnt vmcnt(0)" ::: "memory");
        __syncthreads();
        {
            f32x4 o[8][2];
#pragma unroll
            for (int dt = 0; dt < 8; ++dt) { o[dt][0] = (f32x4){0.f, 0.f, 0.f, 0.f}; o[dt][1] = (f32x4){0.f, 0.f, 0.f, 0.f}; }
            xa_pv<0, 0>(o, pf, bufA, fr, fq);
            xa_pv<1, 0>(o, pf, bufB, fr, fq);
#pragma unroll
            for (int nt = 0; nt < 2; ++nt) {
                bf16_t* rp = og + (size_t)(tok0 + nt * 16 + fr) * 1024 + h * 256 + fq * 4;
#pragma unroll
                for (int dt = 0; dt < 8; ++dt) store_bf16x4(rp + dt * 16, o[dt][nt] * linv[nt]);
            }
        }
        {
            f32x4 o[8][2];
#pragma unroll
            for (int dt = 0; dt < 8; ++dt) { o[dt][0] = (f32x4){0.f, 0.f, 0.f, 0.f}; o[dt][1] = (f32x4){0.f, 0.f, 0.f, 0.f}; }
            xa_pv<0, 1>(o, pf, bufA, fr, fq);
            xa_pv<1, 1>(o, pf, bufB, fr, fq);
#pragma unroll
            for (int nt = 0; nt < 2; ++nt) {
                bf16_t* rp = og + (size_t)(tok0 + nt * 16 + fr) * 1024 + h * 256 + 128 + fq * 4;
#pragma unroll
                for (int dt = 0; dt < 8; ++dt) store_bf16x4(rp + dt * 16, o[dt][nt] * linv[nt]);
            }
        }
        __syncthreads();
    }
}

__device__ __forceinline__ bool rt_better(float va, int ia, float vb, int ib) { return va > vb || (va == vb && ia < ib); }
__device__ __forceinline__ void phase_ln2_router(const Params& p, char* smem, const int mode = 0) {
    const int tid = opaque_tid(), lane = tid & 63, wid = tid >> 6;
    char* ws = uni(p.ws);
    float* z = (float*)(ws + OFF_Z2); bf16_t* hb = (bf16_t*)(ws + OFF_R0); const bf16_t* xa = (const bf16_t*)(ws + OFF_XQ);
    const float* h1 = uni(p.out);
    int2* toke = (int2*)(ws + OFF_TOKE); float2* tokw = (float2*)(ws + OFF_TOKW);
    int* histg = (int*)(ws + OFF_HIST);
    float* hs = (float*)(smem + wid * 16512);
    int* hist = (int*)(smem + 132096);
    const float* w_rg = uni(p.w_rg); const float* w_re = uni(p.w_re); const float* b_rg = uni(p.b_rg); const float* b_re = uni(p.b_re);
    const float* ln2g = uni(p.ln2g); const float* ln2b = uni(p.ln2b);
    const int chalf = lane & 1, kk = (lane >> 1) & 7, r = lane >> 4;
    for (int c = blockIdx.x; c < 256; c += gridDim.x) {
        if (tid < 64) hist[tid] = 0;
        __syncthreads();
#pragma unroll 1
        for (int rg = 0; rg < 8; ++rg) {
            const int rowbase = c * 256 + wid * 32 + rg * 4;
#pragma unroll
            for (int rr = 0; rr < 4; ++rr) {
                const int row = rowbase + rr;
                float4 v[4];
#pragma unroll
                for (int i = 0; i < 4; ++i) {
                    const uint2 hh = *(const uint2*)(hb + (size_t)row * 1024 + i * 256 + lane * 4);
                    const uint2 mm = *(const uint2*)(xa + (size_t)row * 1024 + i * 256 + lane * 4);
                    v[i].x = ALPHA * bf_lo(hh.x) + bf_lo(mm.x); v[i].y = ALPHA * bf_hi(hh.x) + bf_hi(mm.x); v[i].z = ALPHA * bf_lo(hh.y) + bf_lo(mm.y); v[i].w = ALPHA * bf_hi(hh.y) + bf_hi(mm.y);
                }
                ln_row(v, ln2g, ln2b, lane);
#pragma unroll
                for (int i = 0; i < 4; ++i) {
                    uint2 w; w.x = pk_bf16(v[i].x, v[i].y); w.y = pk_bf16(v[i].z, v[i].w);
                    if (!(mode & 2)) *(uint2*)(hb + (size_t)row * 1024 + i * 256 + lane * 4) = w;
                    *(float4*)(hs + rr * 1032 + i * 256 + lane * 4) = v[i];
                }
            }
            __builtin_amdgcn_wave_barrier();
            asm volatile("s_waitcnt lgkmcnt(0)" ::: "memory");
            if (mode & 1) continue;
            float g0, g1, g2, g3;
            {
                const int kq = lane >> 1;
                float ga[4][4];
#pragma unroll
                for (int rr = 0; rr < 4; ++rr) { ga[rr][0] = 0.f; ga[rr][1] = 0.f; ga[rr][2] = 0.f; ga[rr][3] = 0.f; }
#pragma unroll 8
                for (int s32 = 0; s32 < 32; ++s32) {
                    const int k = s32 * 32 + kq;
                    const float4 w = *(const float4*)(w_rg + (size_t)k * 8 + chalf * 4);
#pragma unroll
                    for (int rr = 0; rr < 4; ++rr) {
                        const float hv = hs[rr * 1032 + k];
                        ga[rr][0] += hv * w.x; ga[rr][1] += hv * w.y; ga[rr][2] += hv * w.z; ga[rr][3] += hv * w.w;
                    }
                }
#pragma unroll
                for (int rr = 0; rr < 4; ++rr)
#pragma unroll
                    for (int q = 0; q < 4; ++q) {
                        float v = ga[rr][q];
                        v += __builtin_bit_cast(float, __builtin_amdgcn_update_dpp(0, __builtin_bit_cast(int, v), 0x4E, 0xf, 0xf, true));
                        v += __builtin_bit_cast(float, __builtin_amdgcn_update_dpp(0, __builtin_bit_cast(int, v), 0x124, 0xf, 0xf, true));
                        v += __builtin_bit_cast(float, __builtin_amdgcn_update_dpp(0, __builtin_bit_cast(int, v), 0x128, 0xf, 0xf, true));
                        v += __shfl_xor(v, 16); v += __shfl_xor(v, 32);
                        ga[rr][q] = v;
                    }
                g0 = r == 0 ? ga[0][0] : r == 1 ? ga[1][0] : r == 2 ? ga[2][0] : ga[3][0];
                g1 = r == 0 ? ga[0][1] : r == 1 ? ga[1][1] : r == 2 ? ga[2][1] : ga[3][1];
                g2 = r == 0 ? ga[0][2] : r == 1 ? ga[1][2] : r == 2 ? ga[2][2] : ga[3][2];
                g3 = r == 0 ? ga[0][3] : r == 1 ? ga[1][3] : r == 2 ? ga[2][3] : ga[3][3];
            }
            {
                const float4 bb = *(const float4*)(b_rg + chalf * 4);
                g0 += bb.x; g1 += bb.y; g2 += bb.z; g3 += bb.w;
            }
            float mv = g0; int mi = chalf * 4;
            if (g1 > mv) { mv = g1; mi = chalf * 4 + 1; }
            if (g2 > mv) { mv = g2; mi = chalf * 4 + 2; }
            if (g3 > mv) { mv = g3; mi = chalf * 4 + 3; }
            { const float ov = __shfl_xor(mv, 1); const int oi = __shfl_xor(mi, 1); if (rt_better(ov, oi, mv, mi)) { mv = ov; mi = oi; } }
            float es = (__expf(g0 - mv) + __expf(g1 - mv)) + (__expf(g2 - mv) + __expf(g3 - mv));
            es += __shfl_xor(es, 1);
            const float pgroup = 1.0f / es;
            const int gsel = mi;
            float e0 = 0.f, e1 = 0.f, e2 = 0.f, e3 = 0.f;
            {
                const float* we = w_re + gsel * 8 + chalf * 4;
#pragma unroll 32
                for (int s8 = 0; s8 < 128; ++s8) {
                    const int k = s8 * 8 + kk;
                    const float4 w = *(const float4*)(we + (size_t)k * 64);
                    const float hv = hs[r * 1032 + k];
                    e0 += hv * w.x; e1 += hv * w.y; e2 += hv * w.z; e3 += hv * w.w;
                }
            }
#pragma unroll
            for (int o = 2; o < 16; o <<= 1) { e0 += __shfl_xor(e0, o); e1 += __shfl_xor(e1, o); e2 += __shfl_xor(e2, o); e3 += __shfl_xor(e3, o); }
            {
                const float4 bb = *(const float4*)(b_re + gsel * 8 + chalf * 4);
                e0 += bb.x; e1 += bb.y; e2 += bb.z; e3 += bb.w;
            }
            float v0 = e0, v1 = -INFINITY; int i0 = chalf * 4, i1 = 99;
            {
                const float ev[3] = {e1, e2, e3};
#pragma unroll
                for (int q = 0; q < 3; ++q) {
                    const float x = ev[q]; const int xi = chalf * 4 + q + 1;
                    if (x > v0) { v1 = v0; i1 = i0; v0 = x; i0 = xi; } else if (x > v1) { v1 = x; i1 = xi; }
                }
            }
            {
                const float b0 = __shfl_xor(v0, 1), b1 = __shfl_xor(v1, 1); const int k0 = __shfl_xor(i0, 1), k1 = __shfl_xor(i1, 1);
                float n0, n1; int m0, m1;
                if (rt_better(v0, i0, b0, k0)) { n0 = v0; m0 = i0; if (rt_better(v1, i1, b0, k0)) { n1 = v1; m1 = i1; } else { n1 = b0; m1 = k0; } }
                else { n0 = b0; m0 = k0; if (rt_better(b1, k1, v0, i0)) { n1 = b1; m1 = k1; } else { n1 = v0; m1 = i0; } }
                v0 = n0; i0 = m0; v1 = n1; i1 = m1;
            }
            if (kk == 0 && chalf == 0) {
                const float x1 = __expf(v1 - v0), den = 1.0f + x1;
                const int ea = gsel * 8 + i0, eb2 = gsel * 8 + i1;
                toke[rowbase + r] = make_int2(ea, eb2); tokw[rowbase + r] = make_float2(pgroup / den, pgroup * x1 / den);
                atomicAdd(&hist[ea], 1); atomicAdd(&hist[eb2], 1);
            }
            __builtin_amdgcn_wave_barrier();
        }
        __syncthreads();
        if (tid < 64 && !(mode & 1)) histg[c * 64 + tid] = hist[tid];
        __syncthreads();
    }
}

__device__ __forceinline__ void compute_segments(const int* histg, int* seg, int tid) {
    if (tid < 64) {
        int s = 0;
        for (int c = 0; c < 256; ++c) s += histg[c * 64 + tid];
        seg[tid] = s;
    }
    __syncthreads();
    if (tid == 0) {
        int acc = 0;
        for (int e = 0; e < 64; ++e) { seg[64 + e] = acc; acc += (seg[e] + 255) >> 8; }
        seg[128] = acc;
    }
    __syncthreads();
}

__device__ __forceinline__ void phase8(const Params& p, char* smem) {
    const int tid = opaque_tid();
    char* ws = uni(p.ws);
    const int* histg = (const int*)(ws + OFF_HIST);
    const int2* toke = (const int2*)(ws + OFF_TOKE); const float2* tokw = (const float2*)(ws + OFF_TOKW);
    int* slot_tok = (int*)(ws + OFF_SLOTTOK); float* slot_w = (float*)(ws + OFF_SLOTW); int* tokslot = (int*)(ws + OFF_TOKSLOT);
    int* seg = (int*)smem;
    int* cursor = seg + 192;
    compute_segments(histg, seg, tid);
    for (int e = blockIdx.x; e < 64; e += gridDim.x) {
        const int start = seg[64 + e] * 256 + seg[e], end = seg[64 + e + 1] * 256;
        for (int s = start + tid; s < end; s += NTHR) { slot_tok[s] = -1; slot_w[s] = 0.f; }
    }
    for (int c = blockIdx.x; c < 256; c += gridDim.x) {
        __syncthreads();
        if (tid < 64) {
            int base = 0;
            for (int cc = 0; cc < c; ++cc) base += histg[cc * 64 + tid];
            cursor[tid] = seg[64 + tid] * 256 + base;
        }
        __syncthreads();
        if (tid < 256) {
            const int tok = c * 256 + tid;
            const int2 ee = toke[tok]; const float2 ww = tokw[tok];
            const int s0 = atomicAdd(&cursor[ee.x], 1);
            const int s1 = atomicAdd(&cursor[ee.y], 1);
            tokslot[tok * 2] = s0; tokslot[tok * 2 + 1] = s1;
            slot_tok[s0] = tok * 2; slot_w[s0] = ww.x;
            slot_tok[s1] = tok * 2 + 1; slot_w[s1] = ww.y;
        }
    }
}

struct Sched9a {
    int G, c, nrt; const int* seg; const int* slot_tok; const char* h2b; const char* wgu;
    __device__ __forceinline__ bool next(int i, pg8::Unit& u) const {
        int rtile, pn;
        if ((G & 7) == 0) { const int x = c & 7, j = c >> 3, nj = G >> 3, per = (nrt + 7) >> 3; const int uidx = i * nj + j; if (uidx >= per * 2) return false; rtile = x * per + (uidx >> 1); pn = uidx & 1; if (rtile >= nrt) return false; }
        else { const int uidx = i * G + c; if (uidx >= nrt * 2) return false; rtile = uidx >> 1; pn = uidx & 1; }
        int e = 0;
        for (int k = 1; k < 64; ++k) if (seg[64 + k] <= rtile) e = k;
        e = __builtin_amdgcn_readfirstlane(e);
        u.pm = rtile; u.pn = pn; u.aux = e; u.A = h2b; u.Bt = wgu + (size_t)e * 512 * 1024 * 2;
        return true;
    }
    __device__ __forceinline__ unsigned arow(const pg8::Unit& u, int r) const {
        const int tk = slot_tok[u.pm * 256 + r];
        return (unsigned)(tk < 0 ? 0 : (tk >> 1)) * 2048u;
    }
};
struct Epi9a {
    bf16_t* hbuf;
    __device__ __forceinline__ void operator()(f32x4 (&acc)[2][2][4][2], const pg8::Unit& u, int wr, int wc, int fr, int fq) const {
        const int row0 = u.pm * 256 + wr * 64 + fr, col0 = u.pn * 128 + wc * 32 + fq * 8;
#pragma unroll
        for (int ai = 0; ai < 2; ++ai)
#pragma unroll
            for (int m = 0; m < 4; ++m) {
                const size_t slot = row0 + ai * 128 + m * 16;
                f32x4 v0, v1;
#pragma unroll
                for (int j = 0; j < 4; ++j) {
                    const float g0 = acc[ai][0][m][0][j], g1 = acc[ai][0][m][1][j];
                    v0[j] = g0 * sigmoidf_(g0) * acc[ai][1][m][0][j]; v1[j] = g1 * sigmoidf_(g1) * acc[ai][1][m][1][j];
                }
                store_bf16x8(hbuf + slot * 256 + col0, v0, v1);
            }
    }
};
__device__ __forceinline__ void phase9a(const Params& p, char* smem) {
    const int tid = opaque_tid();
    char* ws = uni(p.ws);
    int* seg = (int*)(smem + LDS_GEMM);
    compute_segments((const int*)(ws + OFF_HIST), seg, tid);
    Sched9a S{(int)gridDim.x, (int)blockIdx.x, __builtin_amdgcn_readfirstlane(seg[128]), seg, (const int*)(ws + OFF_SLOTTOK), ws + OFF_R0, ws + OFF_WGU};
    Epi9a E{(bf16_t*)(ws + OFF_R1)};
    pg8::gemm_phase<Epi9a, Sched9a, true>((LDS_AS unsigned char*)smem, 1024, S, E);
}

struct Sched9b {
    int G, c, nrt; const int* seg; const char* hbuf; const char* wd;
    __device__ __forceinline__ bool next(int i, pg8::Unit& u) const {
        int rtile, pn;
        if ((G & 7) == 0) { const int x = c & 7, j = c >> 3, nj = G >> 3, per = (nrt + 7) >> 3; const int uidx = i * nj + j; if (uidx >= per * 4) return false; rtile = x * per + (uidx >> 2); pn = uidx & 3; if (rtile >= nrt) return false; }
        else { const int uidx = i * G + c; if (uidx >= nrt * 4) return false; rtile = uidx >> 2; pn = uidx & 3; }
        int e = 0;
        for (int k = 1; k < 64; ++k) if (seg[64 + k] <= rtile) e = k;
        e = __builtin_amdgcn_readfirstlane(e);
        u.pm = rtile; u.pn = pn; u.aux = e; u.A = hbuf; u.Bt = wd + (size_t)e * 1024 * 256 * 2;
        return true;
    }
};
struct Epi9b {
    const float* slot_w; bf16_t* yb;
    __device__ __forceinline__ void operator()(f32x4 (&acc)[2][2][4][2], const pg8::Unit& u, int wr, int wc, int fr, int fq) const {
        const int row0 = u.pm * 256 + wr * 64 + fr, col0 = u.pn * 256 + wc * 32 + fq * 8;
#pragma unroll
        for (int ai = 0; ai < 2; ++ai)
#pragma unroll
            for (int m = 0; m < 4; ++m) {
                const int slot = row0 + ai * 128 + m * 16;
                const float w = slot_w[slot];
#pragma unroll
                for (int bj = 0; bj < 2; ++bj) store_bf16x8(yb + (size_t)slot * 1024 + col0 + bj * 128, acc[ai][bj][m][0] * w, acc[ai][bj][m][1] * w);
            }
    }
};
__device__ __forceinline__ void phase9b(const Params& p, char* smem) {
    const int tid = opaque_tid();
    char* ws = uni(p.ws);
    int* seg = (int*)(smem + LDS_GEMM);
    compute_segments((const int*)(ws + OFF_HIST), seg, tid);
    Sched9b S{(int)gridDim.x, (int)blockIdx.x, __builtin_amdgcn_readfirstlane(seg[128]), seg, ws + OFF_R1, ws + OFF_WD};
    Epi9b E{(const float*)(ws + OFF_SLOTW), (bf16_t*)(ws + OFF_YB)};
    pg8::gemm_phase<Epi9b, Sched9b>((LDS_AS unsigned char*)smem, 256, S, E);
}

__device__ __forceinline__ void phase10(const Params& p) {
    const int tid_ = opaque_tid(); const int lane = tid_ & 63, wid = tid_ >> 6;
    const bf16_t* h2 = (const bf16_t*)(uni(p.ws) + OFF_R0); const bf16_t* yb = (const bf16_t*)(uni(p.ws) + OFF_YB);
    const int* tokslot = (const int*)(uni(p.ws) + OFF_TOKSLOT);
    for (int row = blockIdx.x * 8 + wid; row < T_; row += gridDim.x * 8) {
        const int sl0 = __builtin_amdgcn_readfirstlane(tokslot[row * 2]), sl1 = __builtin_amdgcn_readfirstlane(tokslot[row * 2 + 1]);
        float4 v[4];
#pragma unroll
        for (int i = 0; i < 4; ++i) {
            const uint2 hh = *(const uint2*)(h2 + (size_t)row * 1024 + i * 256 + lane * 4);
            const uint2 a = *(const uint2*)(yb + (size_t)sl0 * 1024 + i * 256 + lane * 4), b = *(const uint2*)(yb + (size_t)sl1 * 1024 + i * 256 + lane * 4);
            v[i].x = ALPHA * bf_lo(hh.x) + bf_lo(a.x) + bf_lo(b.x); v[i].y = ALPHA * bf_hi(hh.x) + bf_hi(a.x) + bf_hi(b.x);
            v[i].z = ALPHA * bf_lo(hh.y) + bf_lo(a.y) + bf_lo(b.y); v[i].w = ALPHA * bf_hi(hh.y) + bf_hi(a.y) + bf_hi(b.y);
        }
        ln_row(v, uni(p.ln3g), uni(p.ln3b), lane);
#pragma unroll
        for (int i = 0; i < 4; ++i) *(float4*)(uni(p.out) + (size_t)row * 1024 + i * 256 + lane * 4) = v[i];
    }
}

#define XB_TMO      128
#define XB_XCNT(j)  (256  + 64 * (j))
#define XB_XSUB(j)  (1280 + 64 * (j))
#define XB_XGEN(j)  (2304 + 64 * (j))
#define XB_TOP      3328
#define XB_TOPGEN   3392
#define XCD_BAR_WORDS 3456
#define XB_SPIN_CAP (1u << 18)
#define LAS LDS_AS

__device__ __forceinline__ unsigned xb_ld(unsigned* p)              { return __hip_atomic_load(p, __ATOMIC_RELAXED, __HIP_MEMORY_SCOPE_AGENT); }
__device__ __forceinline__ unsigned xb_add(unsigned* p, unsigned v) { return __hip_atomic_fetch_add(p, v, __ATOMIC_RELAXED, __HIP_MEMORY_SCOPE_AGENT); }
__device__ __forceinline__ unsigned xb_xcc_id() { return (unsigned)__builtin_amdgcn_s_getreg((3 << 11) | 20) & 0xFu; }
#define XB_SPIN(cond, bar) do { unsigned _sp = 0; while (cond) { __builtin_amdgcn_s_sleep(1); \
    if ((++_sp & 255u) == 0u) { if (xb_ld(&(bar)[XB_TMO])) break; if (_sp > XB_SPIN_CAP) { atomicAdd(&(bar)[XB_TMO], 1u); break; } } } } while (0)

struct XcdBarrier {
    unsigned* bar; unsigned x;
    volatile LAS unsigned* st;
};

__device__ __forceinline__ XcdBarrier xcd_barrier_post(unsigned* bar, volatile LAS unsigned* st) {
    XcdBarrier b; b.bar = bar; b.x = xb_xcc_id(); b.st = st;
    if (threadIdx.x == 0) (void)xb_add(&bar[XB_XCNT(b.x)], 1u);
    return b;
}
__device__ __forceinline__ void xcd_barrier_complete(unsigned* bar, unsigned x, unsigned& nloc, unsigned& nx) {
    const unsigned G = gridDim.x * gridDim.y * gridDim.z;
    unsigned sum, cnt, mine, sp = 0u;
    for (;;) {
        sum = 0u; cnt = 0u; mine = 0u;
#pragma unroll
        for (unsigned j = 0; j < 16; ++j) { const unsigned c = xb_ld(&bar[XB_XCNT(j)]); sum += c; cnt += (c > 0u) ? 1u : 0u; mine = (j == x) ? c : mine; }
        if (sum == G) break;
        __builtin_amdgcn_s_sleep(1);
        if ((++sp & 255u) == 0u) { if (xb_ld(&bar[XB_TMO])) break; if (sp > XB_SPIN_CAP) { atomicAdd(&bar[XB_TMO], 1u); break; } }
    }
    nloc = mine > 0u ? mine : 1u; nx = cnt > 0u ? cnt : 1u;
}

__device__ __forceinline__ void xcd_barrier(const XcdBarrier& b) {
    asm volatile("s_waitcnt vmcnt(0)" ::: "memory");
    __syncthreads();
    if (threadIdx.x == 0) {
        unsigned* bar = b.bar;
        __builtin_amdgcn_s_waitcnt(0);
        unsigned nloc = b.st[0], nx = b.st[1];
        if (nloc == 0u) { xcd_barrier_complete(bar, b.x, nloc, nx); b.st[0] = nloc; b.st[1] = nx; }
        const unsigned old = xb_add(&bar[XB_XSUB(b.x)], 1u);
        const unsigned gen = old / nloc;
        if (old + 1u == (gen + 1u) * nloc) {
            __builtin_amdgcn_fence(__ATOMIC_RELEASE, "agent");
            asm volatile("s_waitcnt vmcnt(0)" ::: "memory");
            const unsigned og = xb_add(&bar[XB_TOP], 1u);
            const unsigned tg = og / nx;
            if (og + 1u == (tg + 1u) * nx) xb_add(&bar[XB_TOPGEN], 1u);
            else XB_SPIN(xb_ld(&bar[XB_TOPGEN]) == tg, bar);
            __builtin_amdgcn_fence(__ATOMIC_ACQUIRE, "agent");
            xb_add(&bar[XB_XGEN(b.x)], 1u);
            asm volatile("s_waitcnt vmcnt(0)" ::: "memory");
        } else {
            XB_SPIN(xb_ld(&bar[XB_XGEN(b.x)]) == gen, bar);
            __builtin_amdgcn_fence(__ATOMIC_ACQUIRE, "agent");
            asm volatile("s_waitcnt vmcnt(0)" ::: "memory");
        }
    }
    __syncthreads();
}


#ifndef DUP
#define DUP (-1)
#endif
#define RUN(id, call) do { call; if (DUP == (id)) { GRID_SYNC(); call; } } while (0)
__global__ void __launch_bounds__(NTHR) mega(Params pk) {
    extern __shared__ __attribute__((aligned(16))) char smem[];
    cg::grid_group grid = cg::this_grid();
    if (threadIdx.x == 0) *(Params*)(smem + LDS_PARAMS) = pk;
    __syncthreads();
    const Params& p = *(const Params*)(smem + LDS_PARAMS);
    char* ws = uni(p.ws);
    volatile LDS_AS unsigned* xst = (volatile LDS_AS unsigned*)(LDS_AS char*)smem + (LDS_XB / 4);
    if (threadIdx.x < 4) xst[threadIdx.x] = 0u;
    __syncthreads();
    (void)xcd_barrier_post((unsigned*)(ws + OFF_BAR), xst);
#define GRID_SYNC() do { XcdBarrier xb_; xb_.bar = (unsigned*)(uni(p.ws) + OFF_BAR); xb_.x = xb_xcc_id(); xb_.st = (volatile LDS_AS unsigned*)(LDS_AS char*)smem + (LDS_XB / 4); xcd_barrier(xb_); } while (0)
    RUN(0, phase0(p, smem));
    if (DUP == 61) { GRID_SYNC(); phase0(p, smem, 1); }
    if (DUP == 62) { GRID_SYNC(); phase0(p, smem, 2); }
    if (DUP == 64) { GRID_SYNC(); phase0(p, smem, 4); }
    grid.sync();
    RUN(1, phase1(p, smem));
    if (DUP == 30) { GRID_SYNC(); phase1(p, smem, 1); }
    if (DUP == 31) { GRID_SYNC(); phase1(p, smem, 2); }
    GRID_SYNC();
    RUN(2, phase2a(p, smem));
    if (DUP == 20) { GRID_SYNC(); phase2a(p, smem, 1); }
    if (DUP == 21) { GRID_SYNC(); phase2a(p, smem, 2); }
    GRID_SYNC();
    RUN(12, phase2b(p, smem));
    if (DUP == 22) { GRID_SYNC(); phase2b(p, smem, 1); }
    if (DUP == 23) { GRID_SYNC(); phase2b(p, smem, 2); }
    if (DUP == 24) { GRID_SYNC(); phase2b(p, smem, 1, 4); }
    if (DUP == 25) { GRID_SYNC(); phase2b(p, smem, 1, 5); }
    if (DUP == 26) { GRID_SYNC(); phase2b(p, smem, 1, 13); }
    GRID_SYNC();
    phase2c(p, smem);
    GRID_SYNC();
    RUN(3, phase3(p, smem));
    GRID_SYNC();
    RUN(4, phase_gemm_bf16(p, smem, (const bf16_t*)(ws + OFF_R1), (const bf16_t*)(ws + OFF_WMIX), (bf16_t*)(ws + OFF_R0), 1.0f));
    GRID_SYNC();
    phase_ln1(p);
    GRID_SYNC();
    RUN(6, phase_gemm_bf16(p, smem, (const bf16_t*)(ws + OFF_R0), (const bf16_t*)(ws + OFF_WXQ), (bf16_t*)(ws + OFF_XQ), 0.0625f));
    GRID_SYNC();
    RUN(7, phase6(p, smem));
    GRID_SYNC();
    RUN(8, phase_gemm_bf16(p, smem, (const bf16_t*)(ws + OFF_O), (const bf16_t*)(ws + OFF_WXO), (bf16_t*)(ws + OFF_XQ), 1.0f));
    GRID_SYNC();
    RUN(13, phase_ln2_router(p, smem));
    if (DUP == 51) { GRID_SYNC(); phase_ln2_router(p, smem, 1); }
    if (DUP == 53) { GRID_SYNC(); phase_ln2_router(p, smem, 3); }
    GRID_SYNC();
    RUN(9, phase8(p, smem));
    GRID_SYNC();
    RUN(10, phase9a(p, smem));
    GRID_SYNC();
    RUN(11, phase9b(p, smem));
    GRID_SYNC();
    RUN(14, phase10(p));
}

extern "C" void kernel_launch(void* const* d_in, const int* in_sizes, int n_in, void* d_out, int out_size,
                              void* d_ws, size_t ws_size, hipStream_t stream) {
    static int grid_blocks = 0;
    if (!grid_blocks) {
        int dev = 0, cus = 0, per_cu = 0;
        (void)hipGetDevice(&dev);
        (void)hipDeviceGetAttribute(&cus, hipDeviceAttributeMultiprocessorCount, dev);
        (void)hipFuncSetAttribute((const void*)mega, hipFuncAttributeMaxDynamicSharedMemorySize, LDS_BYTES);
        (void)hipOccupancyMaxActiveBlocksPerMultiprocessor(&per_cu, mega, NTHR, LDS_BYTES);
        if (per_cu > 1) per_cu = 1;
        grid_blocks = cus * per_cu;
        if (ws_size < WS_NEED) fprintf(stderr, "workspace too small: %zu\n", ws_size);
    }
    Params p{};
    const float* const* f = (const float* const*)d_in;
    p.x = f[0]; p.mem = f[1]; p.pos = (const int*)d_in[2];
    p.w_in = f[3]; p.sinks = f[4]; p.conv_w = f[5]; p.conv_b = f[6]; p.b_ig = f[7]; p.b_fg = f[8]; p.ml_g = f[9];
    p.w_att = f[10]; p.w_ml = f[11]; p.w_mix = f[12]; p.ln1g = f[13]; p.ln1b = f[14];
    p.w_xq = f[15]; p.w_xkv = f[16]; p.w_xo = f[17]; p.ln2g = f[18]; p.ln2b = f[19];
    p.w_rg = f[20]; p.b_rg = f[21]; p.w_re = f[22]; p.b_re = f[23]; p.w_gate = f[24]; p.w_up = f[25]; p.w_down = f[26];
    p.ln3g = f[27]; p.ln3b = f[28];
    p.out = (float*)d_out; p.ws = (char*)d_ws;
    (void)hipMemsetAsync((char*)d_ws + OFF_BAR, 0, XCD_BAR_WORDS * sizeof(unsigned), stream);
    void* args[] = {&p};
    hipError_t e = hipLaunchCooperativeKernel((void*)mega, dim3(grid_blocks), dim3(NTHR), args, LDS_BYTES, stream);
    if (e != hipSuccess) fprintf(stderr, "cooperative launch failed: %s (grid %d)\n", hipGetErrorString(e), grid_blocks);
}
```

```cpp
#include <hip/hip_runtime.h>
#include <hip/hip_cooperative_groups.h>
#include <cstdio>
#include <cstdint>
namespace cg = cooperative_groups;

typedef unsigned short bf16_t;
typedef short bf16x8 __attribute__((ext_vector_type(8)));
typedef float f32x4 __attribute__((ext_vector_type(4)));
typedef unsigned u32x2 __attribute__((ext_vector_type(2)));
typedef unsigned u32x4 __attribute__((ext_vector_type(4)));
#define LDS_AS __attribute__((address_space(3)))
#define GLB_AS __attribute__((address_space(1)))

constexpr int T_ = 65536;
constexpr int NTHR = 512;
constexpr size_t MiB = 1ull << 20;
constexpr float ALPHA = 1.189207115002721f;
constexpr size_t OFF_R0 = 0;
constexpr size_t OFF_R1 = 128 * MiB;
constexpr size_t OFF_AK = 256 * MiB;
constexpr size_t OFF_AV = 272 * MiB;
constexpr size_t OFF_MQK = 288 * MiB;
constexpr size_t OFF_MV = 416 * MiB;
constexpr size_t OFF_MO = 544 * MiB;
constexpr size_t OFF_GG = 672 * MiB;
constexpr size_t OFF_WGU = 288 * MiB;
constexpr size_t OFF_WD = 352 * MiB;
constexpr size_t OFF_XQ = 416 * MiB;
constexpr size_t OFF_O = 544 * MiB;
constexpr size_t OFF_Z2 = 672 * MiB;
constexpr size_t OFF_YB = 384 * MiB;
constexpr size_t OFF_MISC = 928 * MiB;
constexpr size_t OFF_WIN = OFF_MISC;
constexpr size_t OFF_MEMB = OFF_MISC + 84 * MiB;
constexpr size_t OFF_CS = OFF_MISC + 21 * MiB;
constexpr size_t OFF_WXKV = OFF_MISC + 37 * MiB;
constexpr size_t OFF_WATT = OFF_MISC + 41 * MiB;
constexpr size_t OFF_WML = OFF_MISC + 43 * MiB;
constexpr size_t OFF_WMIX = OFF_MISC + 45 * MiB;
constexpr size_t OFF_WXQ = OFF_MISC + 47 * MiB;
constexpr size_t OFF_WXO = OFF_MISC + 49 * MiB;
constexpr size_t OFF_KMAT = OFF_MISC + 51 * MiB;
constexpr size_t OFF_VT = OFF_MISC + 59 * MiB;
constexpr size_t OFF_GATES = OFF_MISC + 67 * MiB;
constexpr size_t OFF_TOKE = OFF_MISC + 69 * MiB;
constexpr size_t OFF_TOKW = OFF_MISC + 70 * MiB;
constexpr size_t OFF_SLOTTOK = OFF_MISC + 71 * MiB;
constexpr size_t OFF_SLOTW = OFF_MISC + 72 * MiB;
constexpr size_t OFF_HIST = OFF_MISC + 73 * MiB;
constexpr size_t OFF_TOKSLOT = OFF_MISC + 75 * MiB;
constexpr size_t OFF_BAR = OFF_MISC + 74 * MiB;
constexpr size_t OFF_WRT = OFF_MISC + 92 * MiB;
constexpr size_t OFF_SSQP = OFF_MISC + 76 * MiB;
constexpr size_t OFF_SP = OFF_MISC;
constexpr size_t OFF_REC = OFF_MISC + 32 * MiB;
constexpr size_t OUT_QP = 128 * MiB;
constexpr size_t OUT_KP = 192 * MiB;
constexpr size_t WS_NEED = 1024 * MiB;
constexpr int LDS_GEMM = 147456;
constexpr int LDS_PARAMS = 163520;
constexpr int LDS_XB = 163776;
constexpr int LDS_BYTES = 163840;

struct Params {
    const float *x, *mem; const int* pos;
    const float *w_in, *sinks, *conv_w, *conv_b, *b_ig, *b_fg, *ml_g, *w_att, *w_ml, *w_mix, *ln1g, *ln1b;
    const float *w_xq, *w_xkv, *w_xo, *ln2g, *ln2b, *w_rg, *b_rg, *w_re, *b_re, *w_gate, *w_up, *w_down, *ln3g, *ln3b;
    float* out; char* ws;
};

typedef float f32x2 __attribute__((ext_vector_type(2)));
__device__ const double INV_FREQ[32] = {1.0, 0.7498942093324559, 0.5623413251903491, 0.4216965034285822, 0.31622776601683794, 0.23713737056616552, 0.1778279410038923, 0.1333521432163324, 0.1, 0.07498942093324558, 0.05623413251903491, 0.042169650342858224, 0.03162277660168379, 0.023713737056616554, 0.01778279410038923, 0.01333521432163324, 0.01, 0.007498942093324558, 0.005623413251903491, 0.004216965034285823, 0.0031622776601683794, 0.0023713737056616554, 0.0017782794100389228, 0.001333521432163324, 0.001, 0.0007498942093324559, 0.0005623413251903491, 0.00042169650342858224, 0.00031622776601683794, 0.00023713737056616554, 0.00017782794100389227, 0.0001333521432163324};

template <class T> __device__ __forceinline__ T* uni(T* q) {
    const unsigned long long v = (unsigned long long)q;
    const unsigned lo = __builtin_amdgcn_readfirstlane((unsigned)v), hi = __builtin_amdgcn_readfirstlane((unsigned)(v >> 32));
    typedef __attribute__((address_space(1))) T* gptr_t;
    return (T*)(gptr_t)(((unsigned long long)hi << 32) | lo);
}
__device__ __forceinline__ int opaque_tid() { int t = threadIdx.x; asm volatile("" : "+v"(t)); return t; }
__device__ __forceinline__ unsigned pk_bf16(float lo, float hi) { unsigned r; asm("v_cvt_pk_bf16_f32 %0, %1, %2" : "=v"(r) : "v"(lo), "v"(hi)); return r; }
__device__ __forceinline__ float bf_lo(unsigned u) { return __uint_as_float(u << 16); }
__device__ __forceinline__ float bf_hi(unsigned u) { return __uint_as_float(u & 0xffff0000u); }
__device__ __forceinline__ float bf2f(bf16_t h) { return __uint_as_float(((unsigned)h) << 16); }
__device__ __forceinline__ float wsum(float v) {
#pragma unroll
    for (int o = 32; o; o >>= 1) v += __shfl_xor(v, o);
    return v;
}
__device__ __forceinline__ float sigmoidf_(float x) { return __builtin_amdgcn_rcpf(1.0f + __builtin_amdgcn_exp2f(x * -1.4426950408889634f)); }
__device__ __forceinline__ void glds16(const bf16_t* g, char* l) {
    __builtin_amdgcn_global_load_lds((const GLB_AS void*)g, (LDS_AS void*)l, 16, 0, 0);
}

__device__ __forceinline__ void store_bf16x8(bf16_t* p, f32x4 a, f32x4 b) {
    u32x4 w; w[0] = pk_bf16(a[0], a[1]); w[1] = pk_bf16(a[2], a[3]); w[2] = pk_bf16(b[0], b[1]); w[3] = pk_bf16(b[2], b[3]); *(u32x4*)p = w;
}
__device__ __forceinline__ void store_bf16x4(bf16_t* p, f32x4 v) {
    uint2 w; w.x = pk_bf16(v[0], v[1]); w.y = pk_bf16(v[2], v[3]); *(uint2*)p = w;
}

namespace pg8 {
constexpr int BM = 256, BK = 64, HALF = 128, HTB = HALF * BK * 2;
__device__ __forceinline__ int lds_byte(int r, int c) { const int st = (r >> 4) * 2 + (c >> 5), rr = r & 15, cc = c & 31, ob = rr * 64 + cc * 2; return st * 1024 + (ob ^ (((ob >> 9) & 1) << 5)); }
__device__ __forceinline__ void stage_rc(int b, int& R, int& C) { const int st = b / 1024, sb = b % 1024, swz = sb ^ (((sb >> 9) & 1) << 5); R = (st >> 1) * 16 + swz / 64; C = (st & 1) * 32 + (swz % 64) / 2; }
struct Unit { int pm, pn, aux; const char* A; const char* Bt; };

template <class Epi, class Sched, bool GATHER = false>
__device__ __forceinline__ void gemm_phase(LDS_AS unsigned char* lds, const int K, const Sched& S, const Epi& E, const int stagger_cycles = 0) {
    const int tid = opaque_tid(), wid = __builtin_amdgcn_readfirstlane(tid >> 6), lane = tid & 63, wr = wid >> 2, wc = wid & 3, fr = lane & 15, fq = lane >> 4;
    const int nt = K / BK;
    unsigned voff[2];
#pragma unroll
    for (int i = 0; i < 2; ++i) { int R, C; stage_rc(tid * 16 + i * 8192, R, C); voff[i] = (unsigned)(R * K + C) * 2u; }
    const size_t kstep = (size_t)(BK * 2);
    const size_t hstep = (size_t)HALF * K * 2;
    const size_t tstep = 2 * hstep;
    const unsigned ldsw = (unsigned)wid * 1024u;
    const int aoff = lds_byte(wr * 64 + fr, fq * 8), boff = lds_byte(wc * 32 + fr, fq * 8);
#define PG8_SA(b, h) (((b) * 2 + (h)) * HTB)
#define PG8_SB(b, h) ((4 + (b) * 2 + (h)) * HTB)
#define PG8_STAGE(bufoff, gbase) do { _Pragma("unroll") for (int _i = 0; _i < 2; ++_i) \
        __builtin_amdgcn_global_load_lds((const GLB_AS void*)((const char*)(gbase) + voff[_i]), (LDS_AS void*)(lds + (bufoff) + ldsw + _i * 8192), 16, 0, 0); } while (0)
#define PG8_LDA(dst, b, h) do { _Pragma("unroll") for (int m = 0; m < 4; ++m) _Pragma("unroll") for (int k = 0; k < 2; ++k) dst[m][k] = *(const LDS_AS bf16x8*)(lds + PG8_SA(b, h) + aoff + m * 2048 + k * 1024); } while (0)
#define PG8_LDB(dst, b, h) do { _Pragma("unroll") for (int n = 0; n < 2; ++n) _Pragma("unroll") for (int k = 0; k < 2; ++k) dst[n][k] = *(const LDS_AS bf16x8*)(lds + PG8_SB(b, h) + boff + n * 2048 + k * 1024); } while (0)
#define PG8_MMA(ai, bj, At, Bt) do { __builtin_amdgcn_s_setprio(1); _Pragma("unroll") for (int m = 0; m < 4; ++m) _Pragma("unroll") for (int n = 0; n < 2; ++n) _Pragma("unroll") for (int k = 0; k < 2; ++k) \
        acc[ai][bj][m][n] = __builtin_amdgcn_mfma_f32_16x16x32_bf16(Bt[n][k], At[m][k], acc[ai][bj][m][n], 0, 0, 0); __builtin_amdgcn_s_setprio(0); } while (0)
#define PG8_WAIT_V(n) asm volatile("s_waitcnt vmcnt(" #n ")" ::: "memory")
#define PG8_WAIT_L(n) asm volatile("s_waitcnt lgkmcnt(" #n ")" ::: "memory")
#define PG8_BAR __builtin_amdgcn_s_barrier()
#define PG8_SCHED __builtin_amdgcn_sched_barrier(0)
#define PG8_STAGE_A(bufoff, gbase, VA) do { _Pragma("unroll") for (int _i = 0; _i < 2; ++_i) \
        __builtin_amdgcn_global_load_lds((const GLB_AS void*)((const char*)(gbase) + (VA)[_i]), (LDS_AS void*)(lds + (bufoff) + ldsw + _i * 8192), 16, 0, 0); } while (0)
    int Rr[2], Cc[2];
#pragma unroll
    for (int i = 0; i < 2; ++i) stage_rc(tid * 16 + i * 8192, Rr[i], Cc[i]);
    unsigned va0[2], va1[2], vn0[2], vn1[2];
    Unit cur, nxt; int ui = 0;
    if (!S.next(0, cur)) return;
    if constexpr (GATHER) {
#pragma unroll
        for (int i = 0; i < 2; ++i) { va0[i] = S.arow(cur, Rr[i]) + (unsigned)Cc[i] * 2u; va1[i] = S.arow(cur, 128 + Rr[i]) + (unsigned)Cc[i] * 2u; }
    } else {
#pragma unroll
        for (int i = 0; i < 2; ++i) { va0[i] = voff[i]; va1[i] = voff[i] + (unsigned)hstep; }
    }
#pragma unroll
    for (int i = 0; i < 2; ++i) { vn0[i] = va0[i]; vn1[i] = va1[i]; }
    if (stagger_cycles > 0) {
        const int lvl = (blockIdx.x >> 3) & 31;
        for (int q = 0; q < lvl * stagger_cycles; ++q) __builtin_amdgcn_s_sleep(15);
    }
    f32x4 acc[2][2][4][2];
#pragma unroll
    for (int a = 0; a < 2; ++a)
#pragma unroll
        for (int b = 0; b < 2; ++b)
#pragma unroll
            for (int m = 0; m < 4; ++m)
#pragma unroll
                for (int n = 0; n < 2; ++n) acc[a][b][m][n] = (f32x4){0.f, 0.f, 0.f, 0.f};
    bf16x8 At[4][2], B0[2][2], B1[2][2];
    const char* cA = GATHER ? cur.A : cur.A + (size_t)cur.pm * tstep; const char* cB = cur.Bt + (size_t)cur.pn * tstep;
    PG8_STAGE(PG8_SB(0, 0), cB); PG8_STAGE(PG8_SB(0, 1), cB + hstep); PG8_STAGE_A(PG8_SA(0, 0), cA, va0); PG8_STAGE_A(PG8_SA(0, 1), cA, va1);
    if (wr == 1) PG8_BAR;
    PG8_WAIT_V(2); PG8_BAR;
    PG8_STAGE(PG8_SB(1, 0), cB + kstep); PG8_STAGE_A(PG8_SA(1, 0), cA + kstep, va0); PG8_STAGE(PG8_SB(1, 1), cB + hstep + kstep);
    PG8_WAIT_V(6); PG8_BAR;
    for (;;) {
        const bool has_next = S.next(ui + 1, nxt);
        const char* nA = has_next ? (GATHER ? nxt.A : nxt.A + (size_t)nxt.pm * tstep) : cA; const char* nB = has_next ? nxt.Bt + (size_t)nxt.pn * tstep : cB;
        if constexpr (GATHER) {
            if (has_next) {
#pragma unroll
                for (int i = 0; i < 2; ++i) { vn0[i] = S.arow(nxt, Rr[i]) + (unsigned)Cc[i] * 2u; vn1[i] = S.arow(nxt, 128 + Rr[i]) + (unsigned)Cc[i] * 2u; }
            }
        }
        for (int t = 0; t < nt; t += 2) {
            const bool last = (t == nt - 2);
            const char* a1 = cA + (size_t)(t + 1) * kstep;
            const char* a2 = last ? nA : cA + (size_t)(t + 2) * kstep; const char* b2 = last ? nB : cB + (size_t)(t + 2) * kstep;
            const char* a3 = a2 + kstep; const char* b3 = b2 + kstep;
            unsigned w0[2], w1[2];
#pragma unroll
            for (int i = 0; i < 2; ++i) { w0[i] = last ? vn0[i] : va0[i]; w1[i] = last ? vn1[i] : va1[i]; }
            PG8_LDB(B0, 0, 0); PG8_LDB(B1, 0, 1); PG8_SCHED; PG8_LDA(At, 0, 0); PG8_STAGE_A(PG8_SA(1, 1), a1, va1);
            PG8_WAIT_V(8); PG8_WAIT_L(0); PG8_BAR; PG8_MMA(0, 0, At, B0); PG8_MMA(0, 1, At, B1); PG8_BAR; PG8_SCHED;
            PG8_LDA(At, 0, 1); PG8_STAGE(PG8_SB(0, 0), b2); PG8_STAGE(PG8_SB(0, 1), b2 + hstep); PG8_STAGE_A(PG8_SA(0, 0), a2, w0);
            PG8_WAIT_V(8); PG8_WAIT_L(0); PG8_BAR; PG8_MMA(1, 0, At, B0); PG8_MMA(1, 1, At, B1); PG8_BAR; PG8_SCHED;
            PG8_LDB(B0, 1, 0); PG8_LDB(B1, 1, 1); PG8_SCHED; PG8_LDA(At, 1, 0); PG8_STAGE_A(PG8_SA(0, 1), a2, w1);
            PG8_WAIT_V(8); PG8_WAIT_L(0); PG8_BAR; PG8_MMA(0, 0, At, B0); PG8_MMA(0, 1, At, B1); PG8_BAR; PG8_SCHED;
            PG8_LDA(At, 1, 1); PG8_STAGE(PG8_SB(1, 0), b3); PG8_STAGE(PG8_SB(1, 1), b3 + hstep); PG8_STAGE_A(PG8_SA(1, 0), a3, w0);
            PG8_WAIT_V(8); PG8_WAIT_L(0); PG8_BAR; PG8_MMA(1, 0, At, B0); PG8_MMA(1, 1, At, B1); PG8_BAR; PG8_SCHED;
        }
        if (wr == 0) PG8_BAR;
        E(acc, cur, wr, wc, fr, fq);
        if (!has_next) break;
        if (!(cur.aux & 0x100)) {
#pragma unroll
        for (int a = 0; a < 2; ++a)
#pragma unroll
            for (int b = 0; b < 2; ++b)
#pragma unroll
                for (int m = 0; m < 4; ++m)
#pragma unroll
                    for (int n = 0; n < 2; ++n) acc[a][b][m][n] = (f32x4){0.f, 0.f, 0.f, 0.f};
        }
        cur = nxt; cA = nA; cB = nB; ++ui;
#pragma unroll
        for (int i = 0; i < 2; ++i) { va0[i] = vn0[i]; va1[i] = vn1[i]; }
        if (wr == 1) PG8_BAR;
    }
    PG8_WAIT_V(0);
    PG8_BAR;
#undef PG8_SA
#undef PG8_SB
#undef PG8_STAGE
#undef PG8_STAGE_A
#undef PG8_LDA
#undef PG8_LDB
#undef PG8_MMA
#undef PG8_WAIT_V
#undef PG8_WAIT_L
#undef PG8_BAR
#undef PG8_SCHED
}
}

__device__ __forceinline__ int perm32(int rho) { const int n = rho >> 4, i = rho & 15; return 8 * (i >> 2) + 4 * n + (i & 3); }
template <bool PERM>
__device__ __forceinline__ void tr_tile_t(const float* src, size_t ld_src, int k0, int c0, bf16_t* dst, size_t ld_dst, int r0, float* tile, int tid) {
    {
        const int r = tid >> 3, c4 = (tid & 7) * 4;
        const float4 v = *(const float4*)(src + (size_t)(k0 + r) * ld_src + c0 + c4);
        float* tp = tile + r * 33 + c4; tp[0] = v.x; tp[1] = v.y; tp[2] = v.z; tp[3] = v.w;
    }
    __syncthreads();
    {
        const int c = tid >> 4, rc = (tid & 15) * 4, sc = PERM ? perm32(c) : c;
        const float a0 = tile[(rc + 0) * 33 + sc], a1 = tile[(rc + 1) * 33 + sc], a2 = tile[(rc + 2) * 33 + sc], a3 = tile[(rc + 3) * 33 + sc];
        uint2 w; w.x = pk_bf16(a0, a1); w.y = pk_bf16(a2, a3);
        *(uint2*)(dst + (size_t)(r0 + c) * ld_dst + k0 + rc) = w;
    }
    __syncthreads();
}
template <bool PERM>
__device__ __forceinline__ void tr_tile4(const float* const (&src)[4], const int (&c0)[4], size_t ld_src, int k0, bf16_t* dst, size_t ld_dst, int r0, float* tile, int tid) {
    {
        const int r = tid >> 3, c4 = (tid & 7) * 4;
        float4 v[4];
#pragma unroll
        for (int g = 0; g < 4; ++g) v[g] = *(const float4*)(src[g] + (size_t)(k0 + r) * ld_src + c0[g] + c4);
#pragma unroll
        for (int g = 0; g < 4; ++g) { float* tp = tile + r * 129 + g * 32 + c4; tp[0] = v[g].x; tp[1] = v[g].y; tp[2] = v[g].z; tp[3] = v[g].w; }
    }
    __syncthreads();
    {
        const int c = tid >> 4, rc = (tid & 15) * 4, sc = PERM ? perm32(c) : c;
#pragma unroll
        for (int g = 0; g < 4; ++g) {
            const float a0 = tile[(rc + 0) * 129 + g * 32 + sc], a1 = tile[(rc + 1) * 129 + g * 32 + sc], a2 = tile[(rc + 2) * 129 + g * 32 + sc], a3 = tile[(rc + 3) * 129 + g * 32 + sc];
            uint2 w; w.x = pk_bf16(a0, a1); w.y = pk_bf16(a2, a3);
            *(uint2*)(dst + (size_t)(r0 + g * 32 + c) * ld_dst + k0 + rc) = w;
        }
    }
    __syncthreads();
}
__device__ __forceinline__ void phase0(const Params& p, char* smem, const int parts = 7) {
    const int tid = opaque_tid(), lane = tid & 63, wid = tid >> 6;
    const int gw = blockIdx.x * 8 + wid, nw = gridDim.x * 8;
    char* ws = uni(p.ws);
    bf16_t* xb = (bf16_t*)(ws + OFF_R0);
    if (parts & 1) {
        const float* xg = uni(p.x);
        float* gates = (float*)(ws + OFF_GATES);
        float4 wg[4][4][2];
        {
            float4* wl = (float4*)smem;
            for (int k = tid; k < 1024; k += NTHR) {
                const float4* wp = (const float4*)(uni(p.w_in) + (size_t)k * 6408 + 4352);
                const int slot = ((k & 3) * 4 + (k >> 8)) * 64 + ((k >> 2) & 63);
                wl[slot * 2] = wp[0]; wl[slot * 2 + 1] = wp[1];
            }
            __syncthreads();
#pragma unroll
            for (int blk = 0; blk < 4; ++blk)
#pragma unroll
                for (int e = 0; e < 4; ++e) { wg[blk][e][0] = wl[((e * 4 + blk) * 64 + lane) * 2]; wg[blk][e][1] = wl[((e * 4 + blk) * 64 + lane) * 2 + 1]; }
            __syncthreads();
        }
        int row = gw * 2;
        float4 v[8];
        if (row < T_) {
#pragma unroll
            for (int i = 0; i < 8; ++i) v[i] = ((const float4*)(xg + (size_t)(row + (i >> 2)) * 1024))[(i & 3) * 64 + lane];
        }
#pragma unroll 1
        for (; row < T_; row += nw * 2) {
            float4 vn[8];
            const int rn = row + nw * 2 < T_ ? row + nw * 2 : row;
#pragma unroll
            for (int i = 0; i < 8; ++i) vn[i] = ((const float4*)(xg + (size_t)(rn + (i >> 2)) * 1024))[(i & 3) * 64 + lane];
#pragma unroll
            for (int i = 0; i < 8; ++i) {
                uint2 w; w.x = pk_bf16(v[i].x, v[i].y); w.y = pk_bf16(v[i].z, v[i].w);
                *(uint2*)(xb + (size_t)(row + (i >> 2)) * 1024 + (i & 3) * 256 + lane * 4) = w;
            }
            float g[16];
#pragma unroll
            for (int r = 0; r < 2; ++r) {
                f32x2 a0 = (f32x2){0.f, 0.f}, a1 = a0, b0 = a0, b1 = a0;
#pragma unroll
                for (int blk = 0; blk < 4; ++blk) {
                    const float xe[4] = {v[r * 4 + blk].x, v[r * 4 + blk].y, v[r * 4 + blk].z, v[r * 4 + blk].w};
#pragma unroll
                    for (int e = 0; e < 4; ++e) {
                        const f32x2 xx = (f32x2){xe[e], xe[e]};
                        a0 = __builtin_elementwise_fma(xx, (f32x2){wg[blk][e][0].x, wg[blk][e][0].y}, a0);
                        a1 = __builtin_elementwise_fma(xx, (f32x2){wg[blk][e][0].z, wg[blk][e][0].w}, a1);
                        b0 = __builtin_elementwise_fma(xx, (f32x2){wg[blk][e][1].x, wg[blk][e][1].y}, b0);
                        b1 = __builtin_elementwise_fma(xx, (f32x2){wg[blk][e][1].z, wg[blk][e][1].w}, b1);
                    }
                }
                g[r * 8 + 0] = a0[0]; g[r * 8 + 1] = a0[1]; g[r * 8 + 2] = a1[0]; g[r * 8 + 3] = a1[1];
                g[r * 8 + 4] = b0[0]; g[r * 8 + 5] = b0[1]; g[r * 8 + 6] = b1[0]; g[r * 8 + 7] = b1[1];
            }
#pragma unroll
            for (int st = 0; st < 4; ++st) {
                const int o = 32 >> st, n = 8 >> st;
                const bool up = (lane & o) != 0;
#pragma unroll
                for (int i = 0; i < n; ++i) {
                    const float keep = up ? g[i + n] : g[i], send = up ? g[i] : g[i + n];
                    g[i] = keep + __shfl_xor(send, o);
                }
            }
            g[0] += __shfl_xor(g[0], 2); g[0] += __shfl_xor(g[0], 1);
            if ((lane & 3) == 0) gates[(size_t)row * 8 + (lane >> 2)] = g[0];
#pragma unroll
            for (int i = 0; i < 8; ++i) v[i] = vn[i];
        }
    }
    if (parts & 2) {
        float2* cs = (float2*)(ws + OFF_CS);
        const int gt = blockIdx.x * NTHR + tid, nt = gridDim.x * NTHR;
        for (int idx = gt; idx < T_ * 32; idx += nt) {
            const int tok = idx >> 5, i = idx & 31;
            const double ang = (double)uni(p.pos)[tok] * INV_FREQ[i];
            const double turns = ang * 0.15915494309189535;
            const float f = (float)(turns - rint(turns));
            cs[idx] = make_float2(__builtin_amdgcn_cosf(f), __builtin_amdgcn_sinf(f));
        }
        {
            bf16_t* wrt = (bf16_t*)(ws + OFF_WRT);
            const float* wrg = uni(p.w_rg); const float* wre = uni(p.w_re);
            for (int idx = gt; idx < 256 * 1024; idx += nt) {
                const int c = idx >> 10, k = idx & 1023;
                unsigned a = 0u, b2 = 0u;
                if (c < 144) {
                    const int cc = c < 72 ? c : c - 72;
                    const float w = cc < 8 ? wrg[k * 8 + cc] : wre[k * 64 + (cc - 8)];
                    const unsigned hi = pk_bf16(w, w) & 0xffffu;
                    if (c < 72) { a = hi; b2 = hi; }
                    else { const float lo = w - bf_lo(hi); a = pk_bf16(lo, lo) & 0xffffu; }
                }
                wrt[(size_t)c * 2048 + k] = (bf16_t)a; wrt[(size_t)c * 2048 + 1024 + k] = (bf16_t)b2;
            }
        }
        bf16_t* memb = (bf16_t*)(ws + OFF_MEMB);
        for (int idx = gt; idx < 4096 * 1024 / 4; idx += nt) {
            const float4 v = ((const float4*)uni(p.mem))[idx];
            uint2 w; w.x = pk_bf16(v.x, v.y); w.y = pk_bf16(v.z, v.w);
            ((uint2*)memb)[idx] = w;
        }
    }
    if (parts & 4) {
        float* tile = (float*)smem;
        const int NQ_WIN = 16 * 50, NQ_SQ = 16 * 8, NQ_XKV = 16 * 16;
        const int total = NQ_WIN + 5 * NQ_SQ + NQ_XKV;
        const float* win = uni(p.w_in);
        for (int t = blockIdx.x; t < total; t += gridDim.x) {
            if (t < NQ_WIN) {
                const int kt = t & 15, qd = t >> 4;
                const float* srcs[4] = {win, win, win, win}; int c0[4];
#pragma unroll
                for (int g = 0; g < 4; ++g) {
                    const int n0 = (qd * 4 + g) * 32;
                    if (n0 < 1280) { const int pn = n0 >> 8, bj = (n0 >> 7) & 1, wc = (n0 >> 5) & 3; c0[g] = (4 * pn + wc) * 64 + 32 * bj; }
                    else if (n0 < 4352) c0[g] = n0;
                    else { const int pn = n0 >> 8, bj = (n0 >> 7) & 1, wc = (n0 >> 5) & 3; c0[g] = 4360 + bj * 1024 + 128 * (pn - 17) + 32 * wc; }
                }
                tr_tile4<true>(srcs, c0, 6408, kt * 64, (bf16_t*)(ws + OFF_WIN), 1024, qd * 128, tile, tid);
            } else if (t < NQ_WIN + 5 * NQ_SQ) {
                const int u = t - NQ_WIN, which = u / NQ_SQ, v = u % NQ_SQ, kt = v & 15, qd = v >> 4;
                const float* src = which == 0 ? uni(p.w_att) : which == 1 ? uni(p.w_ml) : which == 2 ? uni(p.w_mix) : which == 3 ? uni(p.w_xq) : uni(p.w_xo);
                const float* srcs[4] = {src, src, src, src}; const int c0[4] = {qd * 128, qd * 128 + 32, qd * 128 + 64, qd * 128 + 96};
                tr_tile4<true>(srcs, c0, 1024, kt * 64, (bf16_t*)(ws + OFF_WATT + (size_t)which * 2 * MiB), 1024, qd * 128, tile, tid);
            } else {
                const int v = t - NQ_WIN - 5 * NQ_SQ, kt = v & 15, qd = v >> 4;
                const float* src = uni(p.w_xkv);
                const float* srcs[4] = {src, src, src, src}; const int c0[4] = {qd * 128, qd * 128 + 32, qd * 128 + 64, qd * 128 + 96};
                if (qd < 8) tr_tile4<true>(srcs, c0, 2048, kt * 64, (bf16_t*)(ws + OFF_WXKV), 1024, qd * 128, tile, tid);
                else tr_tile4<false>(srcs, c0, 2048, kt * 64, (bf16_t*)(ws + OFF_WXKV), 1024, qd * 128, tile, tid);
            }
        }
    }
}

__device__ __forceinline__ void moe_weight_prep(const Params& p, char* smem, int first, int stride) {
    const int tid = opaque_tid();
    float* tile = (float*)smem;
    char* ws = uni(p.ws);
    const int per_e = 96, total = 64 * per_e;
    __syncthreads();
    for (int t = first; t < total; t += stride) {
        const int e = t / per_e, u = t % per_e;
        if (u < 64) {
            const int kt = u & 15, qd = u >> 4, pn = qd >> 1, bj = qd & 1;
            const float* src = (bj ? uni(p.w_up) : uni(p.w_gate)) + (size_t)e * 1024 * 256;
            const float* srcs[4] = {src, src, src, src}; const int c0[4] = {pn * 128, pn * 128 + 32, pn * 128 + 64, pn * 128 + 96};
            tr_tile4<true>(srcs, c0, 256, kt * 64, (bf16_t*)(ws + OFF_WGU) + (size_t)e * 512 * 1024, 1024, qd * 128, tile, tid);
        } else {
            const int v = u - 64, kt = v & 3, qd = v >> 2;
            const float* dsrc = uni(p.w_down) + (size_t)e * 256 * 1024;
            const float* srcs[4] = {dsrc, dsrc, dsrc, dsrc}; const int c0[4] = {qd * 128, qd * 128 + 32, qd * 128 + 64, qd * 128 + 96};
            tr_tile4<true>(srcs, c0, 1024, kt * 64, (bf16_t*)(ws + OFF_WD) + (size_t)e * 1024 * 256, 256, qd * 128, tile, tid);
        }
    }
}

struct SchedP1 {
    int G, c; const char *xb, *win, *memb, *wxkv;
    __device__ __forceinline__ bool next(int i, pg8::Unit& u) const {
        int nmain, uidx;
        if (G == 256) { nmain = 25; const int x = c & 7, j = c >> 3; uidx = i * 32 + j; if (i < 25) { const int g = uidx / 100, v = uidx % 100; u.pm = 32 * x + 4 * g + (v & 3); u.pn = v >> 2; } }
        else { nmain = c < 6400 ? (6400 - 1 - c) / G + 1 : 0; uidx = i * G + c; if (i < nmain) { u.pm = uidx / 25; u.pn = uidx % 25; } }
        if (i < nmain) { u.aux = 0; u.A = xb; u.Bt = win; return true; }
        return false;
    }
};

struct SchedKV {
    int first, stride; const char *memb, *wxkv;
    __device__ __forceinline__ bool next(int i, pg8::Unit& u) const {
        const int kv = first + i * stride;
        if (kv >= 128) return false;
        if (kv < 64) { u.aux = 1; u.pm = kv >> 2; u.pn = kv & 3; u.A = memb; u.Bt = wxkv; }
        else { const int k2 = kv - 64; u.aux = 2; u.pm = k2 >> 4; u.pn = k2 & 15; u.A = wxkv + (size_t)1024 * 1024 * 2; u.Bt = memb; }
        return true;
    }
};
struct EpiP1 {
    char* ws; int skip;
    __device__ __forceinline__ void operator()(f32x4 (&acc)[2][2][4][2], const pg8::Unit& u, int wr, int wc, int fr, int fq) const {
        if (skip == 1) {
#pragma unroll
            for (int a = 0; a < 2; ++a)
#pragma unroll
                for (int b = 0; b < 2; ++b)
#pragma unroll
                    for (int m = 0; m < 4; ++m) { asm volatile("" :: "v"(acc[a][b][m][0]), "v"(acc[a][b][m][1])); }
            return;
        }
        const int row0 = u.pm * 256 + wr * 64 + fr;
        if (u.aux == 0 && u.pn < 5) {
            const int hidx = 4 * u.pn + wc;
            if (hidx < 18) {
                bf16_t* dst; int ld, cb; float sc;
                if (hidx < 16) { dst = (bf16_t*)(ws + OFF_R1); ld = 1024; cb = hidx * 64; sc = 0.125f; }
                else { dst = (bf16_t*)(ws + OFF_AK); ld = 128; cb = (hidx - 16) * 64; sc = 1.0f; }
                const float* cs = (const float*)(ws + OFF_CS);
                const int d1 = 8 * fq;
#pragma unroll
                for (int ai = 0; ai < 2; ++ai)
#pragma unroll
                    for (int m = 0; m < 4; ++m) {
                        const int tok = row0 + ai * 128 + m * 16;
                        const float4* cp = (const float4*)(cs + (size_t)tok * 64 + d1 * 2);
                        const float4 c0 = cp[0], c1 = cp[1], c2 = cp[2], c3 = cp[3];
                        const f32x4 x1a = acc[ai][0][m][0], x1b = acc[ai][0][m][1], x2a = acc[ai][1][m][0], x2b = acc[ai][1][m][1];
                        f32x4 o1a, o1b, o2a, o2b;
                        o1a[0] = (x1a[0] * c0.x - x2a[0] * c0.y) * sc; o2a[0] = (x2a[0] * c0.x + x1a[0] * c0.y) * sc;
                        o1a[1] = (x1a[1] * c0.z - x2a[1] * c0.w) * sc; o2a[1] = (x2a[1] * c0.z + x1a[1] * c0.w) * sc;
                        o1a[2] = (x1a[2] * c1.x - x2a[2] * c1.y) * sc; o2a[2] = (x2a[2] * c1.x + x1a[2] * c1.y) * sc;
                        o1a[3] = (x1a[3] * c1.z - x2a[3] * c1.w) * sc; o2a[3] = (x2a[3] * c1.z + x1a[3] * c1.w) * sc;
                        o1b[0] = (x1b[0] * c2.x - x2b[0] * c2.y) * sc; o2b[0] = (x2b[0] * c2.x + x1b[0] * c2.y) * sc;
                        o1b[1] = (x1b[1] * c2.z - x2b[1] * c2.w) * sc; o2b[1] = (x2b[1] * c2.z + x1b[1] * c2.w) * sc;
                        o1b[2] = (x1b[2] * c3.x - x2b[2] * c3.y) * sc; o2b[2] = (x2b[2] * c3.x + x1b[2] * c3.y) * sc;
                        o1b[3] = (x1b[3] * c3.z - x2b[3] * c3.w) * sc; o2b[3] = (x2b[3] * c3.z + x1b[3] * c3.w) * sc;
                        bf16_t* rp = dst + (size_t)tok * ld + cb + d1;
                        if (skip == 2) { asm volatile("" :: "v"(o1a), "v"(o1b), "v"(o2a), "v"(o2b)); } else { store_bf16x8(rp, o1a, o1b); store_bf16x8(rp + 32, o2a, o2b); }
                    }
            } else {
                bf16_t* avT = (bf16_t*)(ws + OFF_AV);
#pragma unroll
                for (int bj = 0; bj < 2; ++bj)
#pragma unroll
                    for (int ai = 0; ai < 2; ++ai)
#pragma unroll
                        for (int m = 0; m < 4; ++m)
#pragma unroll
                            for (int n = 0; n < 2; ++n)
#pragma unroll
                                for (int j = 0; j < 4; ++j)
                                    avT[(size_t)((hidx - 18) * 64 + 32 * bj + 8 * fq + 4 * n + j) * T_ + row0 + ai * 128 + m * 16] = (bf16_t)(pk_bf16(acc[ai][bj][m][n][j], acc[ai][bj][m][n][j]) & 0xffffu);
            }
            return;
        }
        if (u.aux == 0 && u.pn >= 17 && u.pn < 25) {
            bf16_t* gg = (bf16_t*)(ws + OFF_GG);
            const int col = 128 * (u.pn - 17) + 32 * wc + 8 * fq;
#pragma unroll
            for (int ai = 0; ai < 2; ++ai)
#pragma unroll
                for (int m = 0; m < 4; ++m) {
                    f32x4 r0, r1, s0, s1;
#pragma unroll
                    for (int j = 0; j < 4; ++j) {
                        s0[j] = sigmoidf_(acc[ai][1][m][0][j]); s1[j] = sigmoidf_(acc[ai][1][m][1][j]);
                        r0[j] = sigmoidf_(acc[ai][0][m][0][j]) * __builtin_amdgcn_rcpf(fmaxf(s0[j], 1e-30f));
                        r1[j] = sigmoidf_(acc[ai][0][m][1][j]) * __builtin_amdgcn_rcpf(fmaxf(s1[j], 1e-30f));
                    }
                    bf16_t* rp = gg + (size_t)(row0 + ai * 128 + m * 16) * 2048 + col;
                    if (skip == 2) { asm volatile("" :: "v"(r0), "v"(r1), "v"(s0), "v"(s1)); } else { store_bf16x8(rp, r0, r1); store_bf16x8(rp + 1024, s0, s1); }
                }
            return;
        }
#pragma unroll
        for (int bj = 0; bj < 2; ++bj) {
            const int c32 = u.pn * 256 + bj * 128 + wc * 32;
            if (u.aux == 2) {
                bf16_t* dst = (bf16_t*)(ws + OFF_VT);
#pragma unroll
                for (int ai = 0; ai < 2; ++ai)
#pragma unroll
                    for (int m = 0; m < 4; ++m) {
                        bf16_t* rp = dst + (size_t)(row0 + ai * 128 + m * 16) * 4096 + c32 + fq * 4;
                        store_bf16x4(rp, acc[ai][bj][m][0]); store_bf16x4(rp + 16, acc[ai][bj][m][1]);
                    }
            } else {
                bf16_t* dst; int ld, cb; bool sig = false;
                if (u.aux == 1) { dst = (bf16_t*)(ws + OFF_KMAT); ld = 1024; cb = c32; }
                else if (c32 < 2304) { dst = (bf16_t*)(ws + OFF_MQK); ld = 1024; cb = c32 - 1280; }
                else if (c32 < 3328) { dst = (bf16_t*)(ws + OFF_MV); ld = 1024; cb = c32 - 2304; }
                else if (c32 < 4352) { dst = (bf16_t*)(ws + OFF_MO); ld = 1024; cb = c32 - 3328; sig = true; }
                else { dst = (bf16_t*)(ws + OFF_GG); ld = 2048; cb = c32 - 4352; sig = true; }
#pragma unroll
                for (int ai = 0; ai < 2; ++ai)
#pragma unroll
                    for (int m = 0; m < 4; ++m) {
                        f32x4 v0 = acc[ai][bj][m][0], v1 = acc[ai][bj][m][1];
                        if (sig) {
                            v0[0] = sigmoidf_(v0[0]); v0[1] = sigmoidf_(v0[1]); v0[2] = sigmoidf_(v0[2]); v0[3] = sigmoidf_(v0[3]);
                            v1[0] = sigmoidf_(v1[0]); v1[1] = sigmoidf_(v1[1]); v1[2] = sigmoidf_(v1[2]); v1[3] = sigmoidf_(v1[3]);
                        }
                        if (skip == 2) { asm volatile("" :: "v"(v0), "v"(v1)); } else store_bf16x8(dst + (size_t)(row0 + ai * 128 + m * 16) * ld + cb + fq * 8, v0, v1);
                    }
            }
        }
    }
};

__device__ __forceinline__ void phase1(const Params& p, char* smem, int skip_epi = 0) {
    char* ws = uni(p.ws);
    SchedP1 S{(int)gridDim.x, (int)blockIdx.x, ws + OFF_R0, ws + OFF_WIN, ws + OFF_MEMB, ws + OFF_WXKV};
    EpiP1 E{ws, skip_epi};
    pg8::gemm_phase<EpiP1, SchedP1>((LDS_AS unsigned char*)smem, 1024, S, E, 0);
}

__device__ __forceinline__ void kv_projection(const Params& p, char* smem, int first, int stride) {
    char* ws = uni(p.ws);
    __syncthreads();
    SchedKV S{first, stride, ws + OFF_MEMB, ws + OFF_WXKV};
    EpiP1 E{ws, 0};
    pg8::gemm_phase<EpiP1, SchedKV>((LDS_AS unsigned char*)smem, 1024, S, E);
}

template <int NPASS>
struct SchedN1024 {
    int G, c; const char* A0; const char* B0; const char* A1; const char* B1;
    __device__ __forceinline__ bool next(int i, pg8::Unit& u) const {
        const int ti = i / NPASS, pass = i % NPASS;
        int uidx;
        if (G == 256) { if (ti >= 4) return false; const int x = c & 7, j = c >> 3; uidx = ti * 32 + j; u.pm = 32 * x + (uidx >> 2); u.pn = uidx & 3; }
        else { uidx = ti * G + c; if (uidx >= 1024) return false; u.pm = uidx >> 2; u.pn = uidx & 3; }
        u.aux = pass | ((NPASS == 2 && pass == 0) ? 0x100 : 0); u.A = pass ? A1 : A0; u.Bt = pass ? B1 : B0;
        return true;
    }
};

typedef short v4i16_t __attribute__((ext_vector_type(4)));
__device__ __forceinline__ int offQK(int row, int ch) { return row * 256 + ((ch ^ (((row & 3) << 2) | ((row >> 2) & 3))) << 4); }
__device__ __forceinline__ int offV(int row, int ch) { return row * 512 + ((ch ^ (((row & 3) | (((row >> 3) & 1) << 2)) << 1)) << 4); }
__device__ __forceinline__ int offSw(int row, int ch) { return row * 128 + ((ch ^ ((row >> 1) & 7)) << 4); }
__device__ __forceinline__ bf16x8 tr_read2(const char* p0, const char* p1) {
    const v4i16_t a = __builtin_amdgcn_ds_read_tr16_b64_v4i16((LDS_AS v4i16_t*)p0);
    const v4i16_t b = __builtin_amdgcn_ds_read_tr16_b64_v4i16((LDS_AS v4i16_t*)p1);
    return __builtin_shufflevector(a, b, 0, 1, 2, 3, 4, 5, 6, 7);
}
__device__ __forceinline__ float row16_sum(float v) {
    v += __builtin_bit_cast(float, __builtin_amdgcn_update_dpp(0, __builtin_bit_cast(int, v), 0xB1, 0xf, 0xf, true));
    v += __builtin_bit_cast(float, __builtin_amdgcn_update_dpp(0, __builtin_bit_cast(int, v), 0x4E, 0xf, 0xf, true));
    v += __builtin_bit_cast(float, __builtin_amdgcn_update_dpp(0, __builtin_bit_cast(int, v), 0x141, 0xf, 0xf, true));
    v += __builtin_bit_cast(float, __builtin_amdgcn_update_dpp(0, __builtin_bit_cast(int, v), 0x140, 0xf, 0xf, true));
    return v;
}

constexpr int PP_Q = 0, PP_K = 16384, PP_S = 32768, PP_REC = 40960, PP_EB = 41984, PP_EK = 42240, PP_CSP = 42496  , PP_RSP = 44544  , PP_END = 45056;
__device__ __forceinline__ void ml_prepass_item(const Params& p, char* smem, int item) {
    const int tid = opaque_tid(), lane = tid & 63, wid = tid >> 6, fr = lane & 15, fq = lane >> 4;
    const int c = item & 63, bh = item >> 6, b = bh >> 2, h = bh & 3;
    char* ws = uni(p.ws);
    const bf16_t* mqk = (const bf16_t*)(ws + OFF_MQK);
    const float* gates = (const float*)(ws + OFF_GATES);
    float* rec = (float*)(smem + PP_REC); float* eb = (float*)(smem + PP_EB); float* ek = (float*)(smem + PP_EK);
    float* csp = (float*)(smem + PP_CSP); float* rsp = (float*)(smem + PP_RSP);
    const long tok0 = (long)b * 4096 + c * 64;
    const int cp = tid & 127, tg = tid >> 7;
    const bool isk = cp >= 64;
    const int dch = isk ? 2 * (cp - 64) : 2 * cp;
    const int ccol = isk ? (512 + h * 128 + dch) : (h * 128 + dch);
    unsigned r[19];
#pragma unroll
    for (int i = 0; i < 19; ++i) {
        const int tl = tg * 16 - 3 + i;
        r[i] = (c == 0 && tl < 0) ? 0u : *(const unsigned*)(mqk + (tok0 + tl) * 1024 + ccol);
    }
    float cw0[4], cw1[4];
#pragma unroll
    for (int j = 0; j < 4; ++j) { cw0[j] = uni(p.conv_w)[j * 1024 + ccol]; cw1[j] = uni(p.conv_w)[j * 1024 + ccol + 1]; }
    const float cb0 = uni(p.conv_b)[ccol], cb1 = uni(p.conv_b)[ccol + 1];
    if (wid == 0) {
        const float mi0 = gates[(tok0 + lane) * 8 + h] + uni(p.b_ig)[h], x = gates[(tok0 + lane) * 8 + 4 + h] + uni(p.b_fg)[h];
        float bs = fminf(x, 0.f) - log1pf(__expf(-fabsf(x)));
#pragma unroll
        for (int o = 1; o < 64; o <<= 1) { const float y = __shfl_up(bs, o); if (lane >= o) bs += y; }
        eb[lane] = __expf(bs); ek[lane] = __expf(mi0 - bs);
        if (lane == 63) rec[192] = __expf(bs);
    }
    __syncthreads();
    {
        const int tt0 = tg * 16;
        float cs0 = 0.f, cs1 = 0.f;
        const float* scp = (isk ? ek : eb) + tt0;
        char* dstb = smem + (isk ? PP_K : PP_Q) + (dch & 7) * 2;
        const float kmul = isk ? 0.08838834764831845f : 1.0f;
#pragma unroll
        for (int tt = 0; tt < 16; ++tt) {
            float v0 = cb0 + cw0[0] * bf_lo(r[tt]) + cw0[1] * bf_lo(r[tt + 1]) + cw0[2] * bf_lo(r[tt + 2]) + cw0[3] * bf_lo(r[tt + 3]);
            float v1 = cb1 + cw1[0] * bf_hi(r[tt]) + cw1[1] * bf_hi(r[tt + 1]) + cw1[2] * bf_hi(r[tt + 2]) + cw1[3] * bf_hi(r[tt + 3]);
            v0 = v0 * sigmoidf_(v0); v1 = v1 * sigmoidf_(v1);
            const float sc = scp[tt] * kmul;
            const float a0 = v0 * sc, a1 = v1 * sc;
            *(unsigned*)(dstb + offQK(tt0 + tt, dch >> 3)) = pk_bf16(a0, a1);
            cs0 += a0; cs1 += a1;
        }
        if (isk) { csp[tg * 128 + dch] = cs0; csp[tg * 128 + dch + 1] = cs1; }
    }
    __syncthreads();
    {
        const int tt = wid >> 1;
        bf16x8 qf[4];
#pragma unroll
        for (int ks = 0; ks < 4; ++ks) qf[ks] = *(const bf16x8*)(smem + PP_Q + offQK(tt * 16 + fr, 4 * ks + fq));
        float rs = 0.f;
#pragma unroll
        for (int x = 0; x < 2; ++x) {
            const int st = (wid & 1) * 2 + x;
            f32x4 a = (f32x4){0.f, 0.f, 0.f, 0.f};
#pragma unroll
            for (int ks = 0; ks < 4; ++ks) {
                const bf16x8 kf = *(const bf16x8*)(smem + PP_K + offQK(st * 16 + fr, 4 * ks + fq));
                a = __builtin_amdgcn_mfma_f32_16x16x32_bf16(kf, qf[ks], a, 0, 0, 0);
            }
#pragma unroll
            for (int j = 0; j < 4; ++j) a[j] = (st * 16 + fq * 4 + j) <= (tt * 16 + fr) ? a[j] : 0.f;
            rs += (a[0] + a[1]) + (a[2] + a[3]);
            uint2 w; w.x = pk_bf16(a[0], a[1]); w.y = pk_bf16(a[2], a[3]);
            *(uint2*)(smem + PP_S + offSw(tt * 16 + fr, st * 2 + (fq >> 1)) + (fq & 1) * 8) = w;
        }
        rs += __shfl_xor(rs, 16); rs += __shfl_xor(rs, 32);
        if (fq == 0) rsp[(wid & 1) * 64 + tt * 16 + fr] = rs;
        if (tid < 128) rec[64 + tid] = (csp[tid] + csp[128 + tid]) + (csp[256 + tid] + csp[384 + tid]);
    }
    __syncthreads();
    if (tid < 64) rec[tid] = rsp[tid] + rsp[64 + tid];
    __syncthreads();
    {
        char* qp = (char*)uni(p.out) + OUT_QP + (size_t)item * 16384;
        char* kp = (char*)uni(p.out) + OUT_KP + (size_t)item * 16384;
        char* sp = ws + OFF_SP + (size_t)item * 8192;
        char* rp = ws + OFF_REC + (size_t)item * 1024;
#pragma unroll
        for (int i = 0; i < 2; ++i) {
            *(u32x4*)(qp + (i * 512 + tid) * 16) = *(const u32x4*)(smem + PP_Q + (i * 512 + tid) * 16);
            *(u32x4*)(kp + (i * 512 + tid) * 16) = *(const u32x4*)(smem + PP_K + (i * 512 + tid) * 16);
        }
        *(u32x4*)(sp + tid * 16) = *(const u32x4*)(smem + PP_S + tid * 16);
        if (tid < 64) *(u32x4*)(rp + tid * 16) = *(const u32x4*)(smem + PP_REC + tid * 16);
    }
    __syncthreads();
}

constexpr int SC_BUF = 41984;
constexpr int SC_V = 2 * SC_BUF;
constexpr int SC_NBF = SC_V + 65536;
constexpr int SC_END = SC_NBF + 512;
__device__ __forceinline__ void ml_scan(const Params& p, char* smem, int bh, const int mode = 0) {
    const int tid = opaque_tid(), lane = tid & 63, wid = tid >> 6, fr0 = lane & 15, fq0 = lane >> 4;
    const int b = bh >> 2, h = bh & 3;
    char* ws = uni(p.ws);
    const bf16_t* mv = (const bf16_t*)(ws + OFF_MV);
    bf16_t* hm = (bf16_t*)uni(p.out);
    float* ssqp = (float*)(ws + OFF_SSQP);
    const long tokb = (long)b * 4096;
    f32x4 C[8][2];
#pragma unroll
    for (int dt = 0; dt < 8; ++dt) { C[dt][0] = (f32x4){0.f, 0.f, 0.f, 0.f}; C[dt][1] = (f32x4){0.f, 0.f, 0.f, 0.f}; }
    const int vrl = tid >> 5, vpc = tid & 31, vlc = vpc ^ ((((vrl & 3) | (((vrl >> 3) & 1) << 2))) << 1);
    const bf16_t* vsrc = mv + (tokb + vrl) * 1024 + h * 256 + vlc * 8;
    const char* qp = (const char*)uni(p.out) + OUT_QP + (size_t)bh * 64 * 16384;
    const char* kp = (const char*)uni(p.out) + OUT_KP + (size_t)bh * 64 * 16384;
    const char* sp = ws + OFF_SP + (size_t)bh * 64 * 8192;
    const char* rp = ws + OFF_REC + (size_t)bh * 64 * 1024;
#define SC_STAGE(cc, bufoff) do { \
        _Pragma("unroll") for (int _i = 0; _i < 2; ++_i) { \
            glds16((const bf16_t*)(qp + (size_t)(cc) * 16384 + (_i * 512 + tid) * 16), smem + (bufoff) + (_i * 512 + tid) * 16); \
            glds16((const bf16_t*)(kp + (size_t)(cc) * 16384 + (_i * 512 + tid) * 16), smem + (bufoff) + 16384 + (_i * 512 + tid) * 16); } \
        glds16((const bf16_t*)(sp + (size_t)(cc) * 8192 + tid * 16), smem + (bufoff) + 32768 + tid * 16); \
        if (tid < 64) glds16((const bf16_t*)(rp + (size_t)(cc) * 1024 + tid * 16), smem + (bufoff) + 40960 + tid * 16); \
        _Pragma("unroll") for (int _i = 0; _i < 4; ++_i) glds16(vsrc + (long)(cc) * 64 * 1024 + (long)_i * 16 * 1024, smem + SC_V + ((cc) & 1) * 32768 + (_i * 512 + tid) * 16); } while (0)
    __syncthreads();
    if (tid < 256) ((bf16_t*)(smem + SC_NBF))[tid] = 0;
    float nreg = 0.f;
    SC_STAGE(0, 0);
    asm volatile("s_waitcnt vmcnt(0)" ::: "memory");
#pragma unroll 1
    for (int c = 0; c < 64; ++c) {
        const int par = c & 1;
        const long tok0 = tokb + c * 64;
        int fr = fr0, fq = fq0;
        asm volatile("" : "+v"(fr), "+v"(fq));
        const char* buf = smem + par * SC_BUF;
        asm volatile("s_waitcnt vmcnt(10) lgkmcnt(0)" ::: "memory");
        __builtin_amdgcn_s_barrier();
        if (c + 1 < 64 && !(mode & 1)) SC_STAGE(c + 1, (par ^ 1) * SC_BUF);
        f32x4 Y[4][2], DN[4];
#pragma unroll
        for (int tt = 0; tt < 4; ++tt) { Y[tt][0] = (f32x4){0.f, 0.f, 0.f, 0.f}; Y[tt][1] = (f32x4){0.f, 0.f, 0.f, 0.f}; DN[tt] = (f32x4){0.f, 0.f, 0.f, 0.f}; }
        const char* nbf = smem + SC_NBF + par * 256;
        const char* vb = smem + SC_V + par * 32768;
#define SC_LDC(ks, A, NB) do { \
            const u32x2 nlo_ = *(const u32x2*)(nbf + (32 * (ks) + 4 * fq) * 2), nhi_ = *(const u32x2*)(nbf + (32 * (ks) + 16 + 4 * fq) * 2); \
            u32x4 nv_; nv_[0] = nlo_[0]; nv_[1] = nlo_[1]; nv_[2] = nhi_[0]; nv_[3] = nhi_[1]; NB = __builtin_bit_cast(bf16x8, nv_); \
            _Pragma("unroll") for (int tt_ = 0; tt_ < 4; ++tt_) { \
                const u32x2 lo_ = *(const u32x2*)(buf + offQK(tt_ * 16 + fr, 4 * (ks) + (fq >> 1)) + (fq & 1) * 8); \
                const u32x2 hi_ = *(const u32x2*)(buf + offQK(tt_ * 16 + fr, 4 * (ks) + 2 + (fq >> 1)) + (fq & 1) * 8); \
                u32x4 av_; av_[0] = lo_[0]; av_[1] = lo_[1]; av_[2] = hi_[0]; av_[3] = hi_[1]; A[tt_] = __builtin_bit_cast(bf16x8, av_); } } while (0)
#define SC_MMC(ks, A, NB) do { \
            u32x4 c0_, c1_; \
            c0_[0] = pk_bf16(C[2 * (ks)][0][0], C[2 * (ks)][0][1]); c0_[1] = pk_bf16(C[2 * (ks)][0][2], C[2 * (ks)][0][3]); \
            c0_[2] = pk_bf16(C[2 * (ks) + 1][0][0], C[2 * (ks) + 1][0][1]); c0_[3] = pk_bf16(C[2 * (ks) + 1][0][2], C[2 * (ks) + 1][0][3]); \
            c1_[0] = pk_bf16(C[2 * (ks)][1][0], C[2 * (ks)][1][1]); c1_[1] = pk_bf16(C[2 * (ks)][1][2], C[2 * (ks)][1][3]); \
            c1_[2] = pk_bf16(C[2 * (ks) + 1][1][0], C[2 * (ks) + 1][1][1]); c1_[3] = pk_bf16(C[2 * (ks) + 1][1][2], C[2 * (ks) + 1][1][3]); \
            const bf16x8 cf0_ = __builtin_bit_cast(bf16x8, c0_), cf1_ = __builtin_bit_cast(bf16x8, c1_); \
            _Pragma("unroll") for (int tt_ = 0; tt_ < 4; ++tt_) { \
                Y[tt_][0] = __builtin_amdgcn_mfma_f32_16x16x32_bf16(A[tt_], cf0_, Y[tt_][0], 0, 0, 0); \
                Y[tt_][1] = __builtin_amdgcn_mfma_f32_16x16x32_bf16(A[tt_], cf1_, Y[tt_][1], 0, 0, 0); \
                DN[tt_] = __builtin_amdgcn_mfma_f32_16x16x32_bf16(A[tt_], NB, DN[tt_], 0, 0, 0); } } while (0)
#define SC_SCHED __builtin_amdgcn_sched_barrier(0)
        bf16x8 A0[4], A1[4], nb0, nb1;
        SC_LDC(0, A0, nb0);
        SC_LDC(1, A1, nb1); SC_SCHED; SC_MMC(0, A0, nb0); SC_SCHED;
        SC_LDC(2, A0, nb0); SC_SCHED; SC_MMC(1, A1, nb1); SC_SCHED;
        SC_LDC(3, A1, nb1); SC_SCHED; SC_MMC(2, A0, nb0); SC_SCHED;
        bf16x8 vf[2][2], sf[2][4];
#pragma unroll
        for (int ks = 0; ks < 2; ++ks)
#pragma unroll
            for (int et = 0; et < 2; ++et) {
                const int cidx = 2 * wid + et, ch = 2 * cidx + ((fr & 3) >> 1);
                const int r0 = 32 * ks + 8 * fq + (fr >> 2);
                vf[ks][et] = tr_read2(vb + offV(r0, ch) + 8 * (fr & 1), vb + offV(r0 + 4, ch) + 8 * (fr & 1));
            }
#pragma unroll
        for (int ks = 0; ks < 2; ++ks)
#pragma unroll
            for (int tt = 0; tt < 4; ++tt) sf[ks][tt] = *(const bf16x8*)(buf + 32768 + offSw(tt * 16 + fr, 4 * ks + fq));
        SC_SCHED; SC_MMC(3, A1, nb1); SC_SCHED;
#define SC_LDK(dt, ks, KF) do { const int ch_ = 2 * (dt) + ((fr & 3) >> 1); const int r0_ = 32 * (ks) + 8 * fq + (fr >> 2); \
            KF = tr_read2(buf + 16384 + offQK(r0_, ch_) + 8 * (fr & 1), buf + 16384 + offQK(r0_ + 4, ch_) + 8 * (fr & 1)); } while (0)
        bf16x8 kfa[4], kfb[4];
        SC_LDK(0, 0, kfa[0]); SC_LDK(0, 1, kfa[1]); SC_LDK(1, 0, kfa[2]); SC_LDK(1, 1, kfa[3]);
        SC_SCHED;
#pragma unroll
        for (int ks = 0; ks < 2; ++ks)
#pragma unroll
            for (int tt = 0; tt < 4; ++tt) {
                Y[tt][0] = __builtin_amdgcn_mfma_f32_16x16x32_bf16(sf[ks][tt], vf[ks][0], Y[tt][0], 0, 0, 0);
                Y[tt][1] = __builtin_amdgcn_mfma_f32_16x16x32_bf16(sf[ks][tt], vf[ks][1], Y[tt][1], 0, 0, 0);
            }
        SC_SCHED;
#define SC_MMK(dt0, KF) do { \
            C[dt0][0] = __builtin_amdgcn_mfma_f32_16x16x32_bf16(KF[0], vf[0][0], C[dt0][0], 0, 0, 0); C[dt0][1] = __builtin_amdgcn_mfma_f32_16x16x32_bf16(KF[0], vf[0][1], C[dt0][1], 0, 0, 0); \
            C[dt0][0] = __builtin_amdgcn_mfma_f32_16x16x32_bf16(KF[1], vf[1][0], C[dt0][0], 0, 0, 0); C[dt0][1] = __builtin_amdgcn_mfma_f32_16x16x32_bf16(KF[1], vf[1][1], C[dt0][1], 0, 0, 0); \
            C[dt0 + 1][0] = __builtin_amdgcn_mfma_f32_16x16x32_bf16(KF[2], vf[0][0], C[dt0 + 1][0], 0, 0, 0); C[dt0 + 1][1] = __builtin_amdgcn_mfma_f32_16x16x32_bf16(KF[2], vf[0][1], C[dt0 + 1][1], 0, 0, 0); \
            C[dt0 + 1][0] = __builtin_amdgcn_mfma_f32_16x16x32_bf16(KF[3], vf[1][0], C[dt0 + 1][0], 0, 0, 0); C[dt0 + 1][1] = __builtin_amdgcn_mfma_f32_16x16x32_bf16(KF[3], vf[1][1], C[dt0 + 1][1], 0, 0, 0); } while (0)
        SC_LDK(2, 0, kfb[0]); SC_LDK(2, 1, kfb[1]); SC_LDK(3, 0, kfb[2]); SC_LDK(3, 1, kfb[3]); SC_SCHED; SC_MMK(0, kfa); SC_SCHED;
        SC_LDK(4, 0, kfa[0]); SC_LDK(4, 1, kfa[1]); SC_LDK(5, 0, kfa[2]); SC_LDK(5, 1, kfa[3]); SC_SCHED; SC_MMK(2, kfb); SC_SCHED;
        SC_LDK(6, 0, kfb[0]); SC_LDK(6, 1, kfb[1]); SC_LDK(7, 0, kfb[2]); SC_LDK(7, 1, kfb[3]); SC_SCHED; SC_MMK(4, kfa); SC_SCHED;
        SC_MMK(6, kfb); SC_SCHED;
#undef SC_LDC
#undef SC_MMC
#undef SC_LDK
#undef SC_MMK
#undef SC_SCHED
        const float* recf = (const float*)(buf + 40960);
        float* sq_out = ssqp + ((size_t)(bh * 64 + c) * 8 + wid) * 64;
#pragma unroll
        for (int tt = 0; tt < 4; ++tt) {
            const float4 rsv = *(const float4*)(recf + tt * 16 + fq * 4);
            const float dd[4] = {rsv.x + DN[tt][0], rsv.y + DN[tt][1], rsv.z + DN[tt][2], rsv.w + DN[tt][3]};
            float sq[4];
#pragma unroll
            for (int j = 0; j < 4; ++j) {
                const float inv = __builtin_amdgcn_rcpf(fmaxf(fabsf(dd[j]), 1.0f));
                Y[tt][0][j] *= inv; Y[tt][1][j] *= inv;
                sq[j] = row16_sum(Y[tt][0][j] * Y[tt][0][j] + Y[tt][1][j] * Y[tt][1][j]);
            }
            if (!(mode & 4)) {
                if (fr == 0) *(float4*)(sq_out + tt * 16 + fq * 4) = make_float4(sq[0], sq[1], sq[2], sq[3]);
#pragma unroll
                for (int et = 0; et < 2; ++et) {
                    const int e = wid * 32 + et * 16 + fr;
                    store_bf16x4(hm + (tok0 + (e >> 2)) * 1024 + h * 256 + (e & 3) * 64 + tt * 16 + fq * 4, Y[tt][et]);
                }
            } else asm volatile("" :: "v"(Y[tt][0]), "v"(Y[tt][1]), "v"(sq[0]), "v"(sq[1]), "v"(sq[2]), "v"(sq[3]));
        }
        const float g = recf[192];
#pragma unroll
        for (int dt = 0; dt < 8; ++dt) { C[dt][0] *= g; C[dt][1] *= g; }
        if (tid < 128) {
            nreg = g * (nreg + recf[64 + (tid & 127)]);
            ((bf16_t*)(smem + SC_NBF + (par ^ 1) * 256))[tid] = (bf16_t)(pk_bf16(nreg, nreg) & 0xffffu);
        }
    }
    asm volatile("s_waitcnt vmcnt(0) lgkmcnt(0)" ::: "memory");
    __syncthreads();
#undef SC_STAGE
}

__device__ __forceinline__ void ml_finish_item(const Params& p, char* smem, int item) {
    const int tid = opaque_tid(), lane = tid & 63, wid = tid >> 6;
    const int c = item & 63, bh = item >> 6, b = bh >> 2, h = bh & 3;
    char* ws = uni(p.ws);
    bf16_t* hm = (bf16_t*)uni(p.out);
    const bf16_t* mo = (const bf16_t*)(ws + OFF_MO);
    const float* ssqp = (const float*)(ws + OFF_SSQP) + (size_t)item * 512;
    const float* gain = uni(p.ml_g) + h * 256;
    const long tok0 = (long)b * 4096 + c * 64;
    float* rs = (float*)(smem + 32768);
#pragma unroll
    for (int i = 0; i < 4; ++i) {
        const int q = i * 512 + tid;
        glds16(hm + (tok0 + (q >> 5)) * 1024 + h * 256 + (q & 31) * 8, smem + q * 16);
    }
    if (tid < 64) {
        float sacc = 0.f;
#pragma unroll
        for (int w = 0; w < 8; ++w) sacc += ssqp[w * 64 + tid];
        rs[tid] = rsqrtf(sacc * (1.0f / 256.0f) + 1e-6f);
    }
    asm volatile("s_waitcnt vmcnt(0)" ::: "memory");
    __syncthreads();
    const int i16 = lane & 15, g4 = lane >> 4, q4 = i16 >> 2, p4 = i16 & 3;
#pragma unroll
    for (int it = 0; it < 4; ++it) {
        const int combo = wid * 4 + it, tb = combo & 3, eoct = (combo >> 2) * 4 + g4;
        const int t = tb * 16 + i16, e = eoct * 8;
        const char* a0 = smem + (e + q4) * 128 + (tb * 16 + 4 * p4) * 2;
        const bf16x8 hv = tr_read2(a0, a0 + 4 * 128);
        const u32x4 hw = __builtin_bit_cast(u32x4, hv);
        const u32x4 mw = *(const u32x4*)(mo + (tok0 + t) * 1024 + h * 256 + e);
        const float4 ga = *(const float4*)(gain + e), gb = *(const float4*)(gain + e + 4);
        const float r = rs[t];
        u32x4 o;
        o[0] = pk_bf16(bf_lo(hw[0]) * r * ga.x * bf_lo(mw[0]), bf_hi(hw[0]) * r * ga.y * bf_hi(mw[0]));
        o[1] = pk_bf16(bf_lo(hw[1]) * r * ga.z * bf_lo(mw[1]), bf_hi(hw[1]) * r * ga.w * bf_hi(mw[1]));
        o[2] = pk_bf16(bf_lo(hw[2]) * r * gb.x * bf_lo(mw[2]), bf_hi(hw[2]) * r * gb.y * bf_hi(mw[2]));
        o[3] = pk_bf16(bf_lo(hw[3]) * r * gb.z * bf_lo(mw[3]), bf_hi(hw[3]) * r * gb.w * bf_hi(mw[3]));
        *(u32x4*)(hm + (tok0 + t) * 1024 + h * 256 + e) = o;
    }
    __syncthreads();
}

__device__ __forceinline__ void swa_stage(const bf16_t* ak, const bf16_t* avT, int item, char* kbuf, int tid) {
    const int kvh = item & 1, n = (item >> 1) & 31, b = item >> 6;
    const long tokbase = (long)b * 4096 + n * 128 - 128;
    const int rk = tid >> 3, pck = tid & 7, lck = pck ^ ((rk >> 1) & 7);
    const bf16_t* srck = ak + (tokbase + rk) * 128 + kvh * 64 + lck * 8;
#pragma unroll
    for (int i = 0; i < 4; ++i) glds16(srck + (long)i * 64 * 128, kbuf + (i * 512 + tid) * 16);
    const int rv = tid >> 5, pcv = tid & 31, lcv = pcv ^ (rv & 15);
    const bf16_t* srcv = avT + (long)(kvh * 64 + rv) * T_ + tokbase + lcv * 8;
#pragma unroll
    for (int i = 0; i < 4; ++i) glds16(srcv + (long)i * 16 * T_, kbuf + 32768 + (i * 512 + tid) * 16);
}
__device__ __forceinline__ const bf16_t* swa_qptr(const bf16_t* aq, int item, int u, int wid, int fr, int fq) {
    const int kvh = item & 1, n = (item >> 1) & 31, b = item >> 6;
    return aq + ((long)b * 4096 + n * 128 + u * 32 + fr) * 1024 + (kvh * 8 + wid) * 64 + fq * 8;
}
__device__ __forceinline__ void swa_items(const Params& p, char* smem, int first, int stride, int hi) {
    const int tid = opaque_tid(), lane = tid & 63, wid = tid >> 6, fr = lane & 15, fq = lane >> 4;
    char* ws = uni(p.ws);
    const bf16_t* aq = (const bf16_t*)(ws + OFF_R1);
    const bf16_t* ak = (const bf16_t*)(ws + OFF_AK);
    const bf16_t* avT = (const bf16_t*)(ws + OFF_AV);
    bf16_t* ao = (bf16_t*)(ws + OFF_R0);
    if (first >= hi) return;
    __syncthreads();
    swa_stage(ak, avT, first, smem, tid);
    bf16x8 qc[4];
    {
        const bf16_t* qp = swa_qptr(aq, first, 0, wid, fr, fq);
        qc[0] = *(const bf16x8*)(qp); qc[1] = *(const bf16x8*)(qp + 32); qc[2] = *(const bf16x8*)(qp + 16 * 1024); qc[3] = *(const bf16x8*)(qp + 16 * 1024 + 32);
    }
    int pb = 0;
    for (int item = first; item < hi; item += stride, pb ^= 1) {
        const int kvh = item & 1, n = (item >> 1) & 31, b = item >> 6;
        const int hq = kvh * 8 + wid;
        char* kbuf = smem + pb * 65536; char* vbuf = kbuf + 32768;
        const float sink = uni(p.sinks)[hq];
        asm volatile("s_waitcnt vmcnt(0)" ::: "memory");
        __syncthreads();
        const bool has_next = item + stride < hi;
        if (has_next) swa_stage(ak, avT, item + stride, smem + (pb ^ 1) * 65536, tid);
        const int kswz = (fr >> 1) & 7;
#pragma unroll 1
        for (int u = 0; u < 4; ++u) {
            const long tq = (long)b * 4096 + n * 128 + u * 32 + fr;
            bf16x8 qn[4];
            {
                const bool nx = (u < 3) || has_next;
                const bf16_t* qp = nx ? (u < 3 ? swa_qptr(aq, item, u + 1, wid, fr, fq) : swa_qptr(aq, item + stride, 0, wid, fr, fq)) : swa_qptr(aq, item, u, wid, fr, fq);
                qn[0] = *(const bf16x8*)(qp); qn[1] = *(const bf16x8*)(qp + 32); qn[2] = *(const bf16x8*)(qp + 16 * 1024); qn[3] = *(const bf16x8*)(qp + 16 * 1024 + 32);
            }
            f32x4 sc[10][2];
#pragma unroll
            for (int r = 0; r < 10; ++r) {
                sc[r][0] = (f32x4){0.f, 0.f, 0.f, 0.f}; sc[r][1] = (f32x4){0.f, 0.f, 0.f, 0.f};
                if (!(n == 0 && (2 * u + r) < 8)) {
                    const char* rowp = kbuf + ((2 * u + r) * 16 + fr) * 128;
                    const bf16x8 k0 = *(const bf16x8*)(rowp + ((fq ^ kswz) * 16)), k1 = *(const bf16x8*)(rowp + (((4 + fq) ^ kswz) * 16));
                    sc[r][0] = __builtin_amdgcn_mfma_f32_16x16x32_bf16(k0, qc[0], sc[r][0], 0, 0, 0);
                    sc[r][0] = __builtin_amdgcn_mfma_f32_16x16x32_bf16(k1, qc[1], sc[r][0], 0, 0, 0);
                    sc[r][1] = __builtin_amdgcn_mfma_f32_16x16x32_bf16(k0, qc[2], sc[r][1], 0, 0, 0);
                    sc[r][1] = __builtin_amdgcn_mfma_f32_16x16x32_bf16(k1, qc[3], sc[r][1], 0, 0, 0);
                }
            }
            u32x4 pf[2][5]; float linv[2];
#pragma unroll
            for (int nt = 0; nt < 2; ++nt) {
                float m = sink;
#pragma unroll
                for (int r = 0; r < 10; ++r) {
                    const bool tile_ok = !(n == 0 && (2 * u + r) < 8);
#pragma unroll
                    for (int j = 0; j < 4; ++j) {
                        const int delta = (r - nt) * 16 + fq * 4 + j - fr;
                        const bool ok = tile_ok && delta >= 1 && delta <= 128;
                        sc[r][nt][j] = ok ? sc[r][nt][j] : -INFINITY;
                        m = fmaxf(m, sc[r][nt][j]);
                    }
                }
                m = fmaxf(m, __shfl_xor(m, 16)); m = fmaxf(m, __shfl_xor(m, 32));
                float l = 0.f;
#pragma unroll
                for (int s2 = 0; s2 < 5; ++s2) {
                    float e[8];
#pragma unroll
                    for (int j = 0; j < 4; ++j) { e[j] = __expf(sc[2 * s2][nt][j] - m); e[4 + j] = __expf(sc[2 * s2 + 1][nt][j] - m); }
                    l += ((e[0] + e[1]) + (e[2] + e[3])) + ((e[4] + e[5]) + (e[6] + e[7]));
                    u32x4 w; w[0] = pk_bf16(e[0], e[1]); w[1] = pk_bf16(e[2], e[3]); w[2] = pk_bf16(e[4], e[5]); w[3] = pk_bf16(e[6], e[7]);
                    pf[nt][s2] = w;
                }
                l += __shfl_xor(l, 16); l += __shfl_xor(l, 32);
                linv[nt] = __builtin_amdgcn_rcpf(l + __expf(sink - m));
            }
            f32x4 o[4][2];
#pragma unroll
            for (int dt = 0; dt < 4; ++dt) { o[dt][0] = (f32x4){0.f, 0.f, 0.f, 0.f}; o[dt][1] = (f32x4){0.f, 0.f, 0.f, 0.f}; }
#pragma unroll
            for (int s2 = 0; s2 < 5; ++s2) {
                if (!(n == 0 && (2 * u + 2 * s2) < 8)) {
                    const int ca = ((((2 * u + 2 * s2) * 2 + (fq >> 1)) ^ fr) * 16) + (fq & 1) * 8;
                    const int cb = ((((2 * u + 2 * s2 + 1) * 2 + (fq >> 1)) ^ fr) * 16) + (fq & 1) * 8;
                    const bf16x8 p0 = __builtin_bit_cast(bf16x8, pf[0][s2]), p1 = __builtin_bit_cast(bf16x8, pf[1][s2]);
#pragma unroll
                    for (int dt = 0; dt < 4; ++dt) {
                        const char* rowp = vbuf + (dt * 16 + fr) * 512;
                        const u32x2 va = *(const u32x2*)(rowp + ca), vb = *(const u32x2*)(rowp + cb);
                        u32x4 vv; vv[0] = va[0]; vv[1] = va[1]; vv[2] = vb[0]; vv[3] = vb[1];
                        const bf16x8 vf = __builtin_bit_cast(bf16x8, vv);
                        o[dt][0] = __builtin_amdgcn_mfma_f32_16x16x32_bf16(vf, p0, o[dt][0], 0, 0, 0);
                        o[dt][1] = __builtin_amdgcn_mfma_f32_16x16x32_bf16(vf, p1, o[dt][1], 0, 0, 0);
                    }
                }
            }
#pragma unroll
            for (int nt = 0; nt < 2; ++nt) {
                bf16_t* rp = ao + (size_t)(tq + nt * 16) * 1024 + hq * 64 + fq * 4;
#pragma unroll
                for (int dt = 0; dt < 4; ++dt) store_bf16x4(rp + dt * 16, o[dt][nt] * linv[nt]);
            }
#pragma unroll
            for (int k = 0; k < 4; ++k) qc[k] = qn[k];
        }
    }
    asm volatile("s_waitcnt vmcnt(0)" ::: "memory");
    __syncthreads();
}

constexpr int SWA_A = 0;
__device__ __forceinline__ void phase2a(const Params& p, char* smem, int which = 3) {
    const int G = gridDim.x;
    if (which & 1) for (int it = blockIdx.x; it < 4096; it += G) ml_prepass_item(p, smem, it);
    if (which & 2) swa_items(p, smem, blockIdx.x, G, SWA_A);
}
__device__ __forceinline__ void phase2c(const Params& p, char* smem) {
    for (int it = blockIdx.x; it < 4096; it += gridDim.x) ml_finish_item(p, smem, it);
}
__device__ __forceinline__ void phase2b(const Params& p, char* smem, int which = 3, const int mode = 0) {
    const int G = gridDim.x;
    if (G > 64) {
        if (blockIdx.x < 64) { if (which & 1) ml_scan(p, smem, blockIdx.x, mode); }
        else { if (which & 2) { swa_items(p, smem, SWA_A + blockIdx.x - 64, G - 64, 1024); moe_weight_prep(p, smem, blockIdx.x - 64, G - 64); kv_projection(p, smem, blockIdx.x - 64, G - 64); } }
    } else {
        for (int it = blockIdx.x; it < 64; it += G) ml_scan(p, smem, it);
        swa_items(p, smem, SWA_A + blockIdx.x, G, 1024);
        moe_weight_prep(p, smem, blockIdx.x, G);
        kv_projection(p, smem, blockIdx.x, G);
    }
}

struct EpiP3 {
    const bf16_t* gg; bf16_t* y;
    __device__ __forceinline__ void operator()(f32x4 (&acc)[2][2][4][2], const pg8::Unit& u, int wr, int wc, int fr, int fq) const {
        const int row0 = u.pm * 256 + wr * 64 + fr, col0 = u.pn * 256 + wc * 32 + fq * 8;
        const bool first = (u.aux & 1) == 0;
#pragma unroll
        for (int ai = 0; ai < 2; ++ai)
#pragma unroll
            for (int m = 0; m < 4; ++m) {
                const size_t tok = row0 + ai * 128 + m * 16;
#pragma unroll
                for (int bj = 0; bj < 2; ++bj) {
                    const int col = col0 + bj * 128;
                    const u32x4 gv = *(const u32x4*)(gg + tok * 2048 + (first ? 0 : 1024) + col);
                    const float gf[8] = {bf_lo(gv[0]), bf_hi(gv[0]), bf_lo(gv[1]), bf_hi(gv[1]), bf_lo(gv[2]), bf_hi(gv[2]), bf_lo(gv[3]), bf_hi(gv[3])};
                    if (first) {
#pragma unroll
                        for (int k = 0; k < 4; ++k) { acc[ai][bj][m][0][k] *= gf[k]; acc[ai][bj][m][1][k] *= gf[4 + k]; }
                    } else {
                        f32x4 v0, v1;
#pragma unroll
                        for (int k = 0; k < 4; ++k) { v0[k] = acc[ai][bj][m][0][k] * gf[k]; v1[k] = acc[ai][bj][m][1][k] * gf[4 + k]; }
                        store_bf16x8(y + tok * 1024 + col, v0, v1);
                    }
                }
            }
    }
};
__device__ __forceinline__ void phase3(const Params& p, char* smem) {
    char* ws = uni(p.ws);
    SchedN1024<2> S{(int)gridDim.x, (int)blockIdx.x, ws + OFF_R0, ws + OFF_WATT, (const char*)uni(p.out), ws + OFF_WML};
    EpiP3 E{(const bf16_t*)(ws + OFF_GG), (bf16_t*)(ws + OFF_R1)};
    pg8::gemm_phase<EpiP3, SchedN1024<2>>((LDS_AS unsigned char*)smem, 1024, S, E);
}

struct EpiBf16 {
    bf16_t* outb; float scale;
    __device__ __forceinline__ void operator()(f32x4 (&acc)[2][2][4][2], const pg8::Unit& u, int wr, int wc, int fr, int fq) const {
        const int row0 = u.pm * 256 + wr * 64 + fr, col0 = u.pn * 256 + wc * 32 + fq * 8;
#pragma unroll
        for (int ai = 0; ai < 2; ++ai)
#pragma unroll
            for (int m = 0; m < 4; ++m) {
                const size_t tok = row0 + ai * 128 + m * 16;
#pragma unroll
                for (int bj = 0; bj < 2; ++bj) store_bf16x8(outb + tok * 1024 + col0 + bj * 128, acc[ai][bj][m][0] * scale, acc[ai][bj][m][1] * scale);
            }
    }
};
__device__ __forceinline__ void phase_gemm_bf16(const Params& p, char* smem, const bf16_t* A, const bf16_t* Bt, bf16_t* outb, float scale) {
    SchedN1024<1> S{(int)gridDim.x, (int)blockIdx.x, (const char*)A, (const char*)Bt, (const char*)A, (const char*)Bt};
    EpiBf16 E{outb, scale};
    pg8::gemm_phase<EpiBf16, SchedN1024<1>>((LDS_AS unsigned char*)smem, 1024, S, E);
}

__device__ __forceinline__ void ln_row(float4 (&v)[4], const float* g, const float* bta, int lane) {
    float s = 0.f;
#pragma unroll
    for (int i = 0; i < 4; ++i) s += (v[i].x + v[i].y) + (v[i].z + v[i].w);
    const float mu = wsum(s) * (1.0f / 1024.0f);
    float q = 0.f;
#pragma unroll
    for (int i = 0; i < 4; ++i) { const float a = v[i].x - mu, b = v[i].y - mu, c = v[i].z - mu, d = v[i].w - mu; q += (a * a + b * b) + (c * c + d * d); }
    const float rstd = rsqrtf(wsum(q) * (1.0f / 1024.0f) + 1e-5f);
#pragma unroll
    for (int i = 0; i < 4; ++i) {
        const float4 gg = *(const float4*)(g + i * 256 + lane * 4), bb = *(const float4*)(bta + i * 256 + lane * 4);
        v[i].x = (v[i].x - mu) * rstd * gg.x + bb.x; v[i].y = (v[i].y - mu) * rstd * gg.y + bb.y;
        v[i].z = (v[i].z - mu) * rstd * gg.z + bb.z; v[i].w = (v[i].w - mu) * rstd * gg.w + bb.w;
    }
}

__device__ __forceinline__ void phase_ln1(const Params& p) {
    const int tid_ = opaque_tid(); const int lane = tid_ & 63, wid = tid_ >> 6;
    bf16_t* hb = (bf16_t*)(uni(p.ws) + OFF_R0);
    for (int row = blockIdx.x * 8 + wid; row < T_; row += gridDim.x * 8) {
        float4 v[4];
#pragma unroll
        for (int i = 0; i < 4; ++i) {
            const float4 xx = *(const float4*)(uni(p.x) + (size_t)row * 1024 + i * 256 + lane * 4);
            const uint2 mm = *(const uint2*)(hb + (size_t)row * 1024 + i * 256 + lane * 4);
            v[i].x = ALPHA * xx.x + bf_lo(mm.x); v[i].y = ALPHA * xx.y + bf_hi(mm.x); v[i].z = ALPHA * xx.z + bf_lo(mm.y); v[i].w = ALPHA * xx.w + bf_hi(mm.y);
        }
        ln_row(v, uni(p.ln1g), uni(p.ln1b), lane);
#pragma unroll
        for (int i = 0; i < 4; ++i) {
            uint2 w; w.x = pk_bf16(v[i].x, v[i].y); w.y = pk_bf16(v[i].z, v[i].w);
            *(uint2*)(hb + (size_t)row * 1024 + i * 256 + lane * 4) = w;
        }
    }
}

__device__ __forceinline__ void xa_stage_k(const bf16_t* kmat, int b, int h, int kh, char* buf, int tid) {
    const int rl = tid >> 5, pc = tid & 31, lc = pc ^ (rl & 15);
    const bf16_t* src = kmat + (size_t)(b * 256 + kh * 128 + rl) * 1024 + h * 256 + lc * 8;
#pragma unroll
    for (int i = 0; i < 8; ++i) glds16(src + (size_t)i * 16 * 1024, buf + (i * 512 + tid) * 16);
}
__device__ __forceinline__ void xa_stage_v(const bf16_t* vT, int b, int h, int vh, char* buf, int tid) {
    const int rl = tid >> 4, pc = tid & 15, lc = pc ^ (rl & 15);
    const bf16_t* src = vT + (size_t)(h * 256 + rl) * 4096 + b * 256 + vh * 128 + lc * 8;
#pragma unroll
    for (int i = 0; i < 8; ++i) glds16(src + (size_t)i * 32 * 4096, buf + (i * 512 + tid) * 16);
}

template <int KH>
__device__ __forceinline__ void xa_scores(f32x4 (&acc)[16][2], const char* buf, const bf16x8 (&qf)[2][8], int fr, int fq) {
#pragma unroll
    for (int ks = 0; ks < 8; ++ks) {
        const int ch = ((ks * 4 + fq) ^ fr) * 16;
#pragma unroll
        for (int mt = 0; mt < 8; ++mt) {
            const bf16x8 kf = *(const bf16x8*)(buf + (mt * 16 + fr) * 512 + ch);
            acc[KH * 8 + mt][0] = __builtin_amdgcn_mfma_f32_16x16x32_bf16(kf, qf[0][ks], acc[KH * 8 + mt][0], 0, 0, 0);
            acc[KH * 8 + mt][1] = __builtin_amdgcn_mfma_f32_16x16x32_bf16(kf, qf[1][ks], acc[KH * 8 + mt][1], 0, 0, 0);
        }
        if (ks & 1) __builtin_amdgcn_sched_barrier(0);
    }
}

template <int VH, int DH>
__device__ __forceinline__ void xa_pv(f32x4 (&o)[8][2], const u32x4 (&pf)[2][8], const char* buf, int fr, int fq) {
#pragma unroll
    for (int ks = 0; ks < 4; ++ks) {
        const int ca = ((ks * 4 + (fq >> 1)) ^ fr) * 16 + (fq & 1) * 8, cb = ((ks * 4 + 2 + (fq >> 1)) ^ fr) * 16 + (fq & 1) * 8;
        const bf16x8 p0 = __builtin_bit_cast(bf16x8, pf[0][VH * 4 + ks]), p1 = __builtin_bit_cast(bf16x8, pf[1][VH * 4 + ks]);
#pragma unroll
        for (int dt = 0; dt < 8; ++dt) {
            const char* rowp = buf + ((DH * 8 + dt) * 16 + fr) * 256;
            const u32x2 va = *(const u32x2*)(rowp + ca), vb = *(const u32x2*)(rowp + cb);
            u32x4 vv; vv[0] = va[0]; vv[1] = va[1]; vv[2] = vb[0]; vv[3] = vb[1];
            const bf16x8 vf = __builtin_bit_cast(bf16x8, vv);
            o[dt][0] = __builtin_amdgcn_mfma_f32_16x16x32_bf16(vf, p0, o[dt][0], 0, 0, 0);
            o[dt][1] = __builtin_amdgcn_mfma_f32_16x16x32_bf16(vf, p1, o[dt][1], 0, 0, 0);
        }
    }
}

__device__ __forceinline__ void phase6(const Params& p, char* smem) {
    const int tid = opaque_tid(), lane = tid & 63, wid = tid >> 6, fr = lane & 15, fq = lane >> 4;
    char* ws = uni(p.ws);
    const bf16_t* xq = (const bf16_t*)(ws + OFF_XQ);
    const bf16_t* kmat = (const bf16_t*)(ws + OFF_KMAT);
    const bf16_t* vT = (const bf16_t*)(ws + OFF_VT);
    bf16_t* og = (bf16_t*)(ws + OFF_O);
    char* bufA = smem; char* bufB = smem + 65536;
    const int G = gridDim.x;
    for (int idx = blockIdx.x; idx < 1024; idx += G) {
        int pair, qt;
        if (G == 256) { const int i = idx >> 8, blk = idx & 255, xcd = blk & 7, jj = blk >> 3; pair = (i * 8 + xcd) * 2 + (jj >> 4); qt = jj & 15; }
        else { pair = idx >> 4; qt = idx & 15; }
        const int b = pair >> 2, h = pair & 3;
        const int tok0 = b * 4096 + qt * 256 + wid * 32;
        xa_stage_k(kmat, b, h, 0, bufA, tid);
        xa_stage_k(kmat, b, h, 1, bufB, tid);
        const bf16_t* q0p = xq + (size_t)(tok0 + fr) * 1024 + h * 256 + fq * 8;
        const bf16_t* q1p = q0p + (size_t)16 * 1024;
        bf16x8 qf[2][8];
#pragma unroll
        for (int ks = 0; ks < 8; ++ks) { qf[0][ks] = *(const bf16x8*)(q0p + ks * 32); qf[1][ks] = *(const bf16x8*)(q1p + ks * 32); }
        f32x4 acc[16][2];
#pragma unroll
        for (int mt = 0; mt < 16; ++mt) { acc[mt][0] = (f32x4){0.f, 0.f, 0.f, 0.f}; acc[mt][1] = (f32x4){0.f, 0.f, 0.f, 0.f}; }
        asm volatile("s_waitcnt vmcnt(0)" ::: "memory");
        __syncthreads();
        xa_scores<0>(acc, bufA, qf, fr, fq);
        xa_scores<1>(acc, bufB, qf, fr, fq);
        __syncthreads();
        xa_stage_v(vT, b, h, 0, bufA, tid);
        xa_stage_v(vT, b, h, 1, bufB, tid);
        u32x4 pf[2][8]; float linv[2];
#pragma unroll
        for (int nt = 0; nt < 2; ++nt) {
            float m = -INFINITY;
#pragma unroll
            for (int mt = 0; mt < 16; ++mt) m = fmaxf(m, fmaxf(fmaxf(acc[mt][nt][0], acc[mt][nt][1]), fmaxf(acc[mt][nt][2], acc[mt][nt][3])));
            m = fmaxf(m, __shfl_xor(m, 16)); m = fmaxf(m, __shfl_xor(m, 32));
            float l = 0.f;
#pragma unroll
            for (int s2 = 0; s2 < 8; ++s2) {
                float e[8];
#pragma unroll
                for (int j = 0; j < 4; ++j) { e[j] = __expf(acc[2 * s2][nt][j] - m); e[4 + j] = __expf(acc[2 * s2 + 1][nt][j] - m); }
                l += ((e[0] + e[1]) + (e[2] + e[3])) + ((e[4] + e[5]) + (e[6] + e[7]));
                u32x4 w; w[0] = pk_bf16(e[0], e[1]); w[1] = pk_bf16(e[2], e[3]); w[2] = pk_bf16(e[4], e[5]); w[3] = pk_bf16(e[6], e[7]);
                pf[nt][s2] = w;
            }
            l += __shfl_xor(l, 16); l += __shfl_xor(l, 32);
            linv[nt] = 1.0f / l;
        }
        asm volatile("s_waitcnt vmcnt(0)" ::: "memory");
        __syncthreads();
        {
            f32x4 o[8][2];
#pragma unroll
            for (int dt = 0; dt < 8; ++dt) { o[dt][0] = (f32x4){0.f, 0.f, 0.f, 0.f}; o[dt][1] = (f32x4){0.f, 0.f, 0.f, 0.f}; }
            xa_pv<0, 0>(o, pf, bufA, fr, fq);
            xa_pv<1, 0>(o, pf, bufB, fr, fq);
#pragma unroll
            for (int nt = 0; nt < 2; ++nt) {
                bf16_t* rp = og + (size_t)(tok0 + nt * 16 + fr) * 1024 + h * 256 + fq * 4;
#pragma unroll
                for (int dt = 0; dt < 8; ++dt) store_bf16x4(rp + dt * 16, o[dt][nt] * linv[nt]);
            }
        }
        {
            f32x4 o[8][2];
#pragma unroll
            for (int dt = 0; dt < 8; ++dt) { o[dt][0] = (f32x4){0.f, 0.f, 0.f, 0.f}; o[dt][1] = (f32x4){0.f, 0.f, 0.f, 0.f}; }
            xa_pv<0, 1>(o, pf, bufA, fr, fq);
            xa_pv<1, 1>(o, pf, bufB, fr, fq);
#pragma unroll
            for (int nt = 0; nt < 2; ++nt) {
                bf16_t* rp = og + (size_t)(tok0 + nt * 16 + fr) * 1024 + h * 256 + 128 + fq * 4;
#pragma unroll
                for (int dt = 0; dt < 8; ++dt) store_bf16x4(rp + dt * 16, o[dt][nt] * linv[nt]);
            }
        }
        __syncthreads();
    }
}

__device__ __forceinline__ void phase_ln2(const Params& p) {
    const int tid_ = opaque_tid(); const int lane = tid_ & 63, wid = tid_ >> 6;
    char* ws = uni(p.ws);
    const bf16_t* hb = (const bf16_t*)(ws + OFF_R0); const bf16_t* xa = (const bf16_t*)(ws + OFF_XQ);
    bf16_t* hc = (bf16_t*)(ws + OFF_Z2);
    const float* lg = uni(p.ln2g); const float* lb = uni(p.ln2b);
    for (int row = blockIdx.x * 8 + wid; row < T_; row += gridDim.x * 8) {
        float4 v[4];
#pragma unroll
        for (int i = 0; i < 4; ++i) {
            const uint2 hh = *(const uint2*)(hb + (size_t)row * 1024 + i * 256 + lane * 4);
            const uint2 mm = *(const uint2*)(xa + (size_t)row * 1024 + i * 256 + lane * 4);
            v[i].x = ALPHA * bf_lo(hh.x) + bf_lo(mm.x); v[i].y = ALPHA * bf_hi(hh.x) + bf_hi(mm.x); v[i].z = ALPHA * bf_lo(hh.y) + bf_lo(mm.y); v[i].w = ALPHA * bf_hi(hh.y) + bf_hi(mm.y);
        }
        ln_row(v, lg, lb, lane);
#pragma unroll
        for (int i = 0; i < 4; ++i) {
            uint2 hi; hi.x = pk_bf16(v[i].x, v[i].y); hi.y = pk_bf16(v[i].z, v[i].w);
            uint2 lo; lo.x = pk_bf16(v[i].x - bf_lo(hi.x), v[i].y - bf_hi(hi.x)); lo.y = pk_bf16(v[i].z - bf_lo(hi.y), v[i].w - bf_hi(hi.y));
            *(uint2*)(hc + (size_t)row * 2048 + i * 256 + lane * 4) = hi;
            *(uint2*)(hc + (size_t)row * 2048 + 1024 + i * 256 + lane * 4) = lo;
        }
    }
}

struct SchedRouter {
    int G, c; const char* A; const char* Bt;
    __device__ __forceinline__ bool next(int i, pg8::Unit& u) const {
        const int uidx = c + i * G;
        if (uidx >= 256) return false;
        u.pm = uidx; u.pn = 0; u.aux = 0; u.A = A; u.Bt = Bt;
        return true;
    }
};
struct EpiRouter {
    float* logits;
    __device__ __forceinline__ void operator()(f32x4 (&acc)[2][2][4][2], const pg8::Unit& u, int wr, int wc, int fr, int fq) const {
        const int row0 = u.pm * 256 + wr * 64 + fr;
#pragma unroll
        for (int ai = 0; ai < 2; ++ai)
#pragma unroll
            for (int m = 0; m < 4; ++m) {
                float* rp = logits + (size_t)(row0 + ai * 128 + m * 16) * 160;
#pragma unroll
                for (int n = 0; n < 2; ++n) { const f32x4 v = acc[ai][0][m][n]; *(float4*)(rp + wc * 32 + n * 16 + fq * 4) = make_float4(v[0], v[1], v[2], v[3]); }
                if (wc == 0) { const f32x4 v = acc[ai][1][m][0]; *(float4*)(rp + 128 + fq * 4) = make_float4(v[0], v[1], v[2], v[3]); }
            }
    }
};
__device__ __forceinline__ void phase_router_gemm(const Params& p, char* smem) {
    char* ws = uni(p.ws);
    SchedRouter S{(int)gridDim.x, (int)blockIdx.x, ws + OFF_Z2, ws + OFF_WRT};
    EpiRouter E{(float*)(ws + OFF_R1)};
    pg8::gemm_phase<EpiRouter, SchedRouter>((LDS_AS unsigned char*)smem, 2048, S, E);
}

__device__ __forceinline__ void phase_select(const Params& p, char* smem) {
    const int tid = opaque_tid();
    char* ws = uni(p.ws);
    const float* logits = (const float*)(ws + OFF_R1);
    int2* toke = (int2*)(ws + OFF_TOKE); float2* tokw = (float2*)(ws + OFF_TOKW);
    int* histg = (int*)(ws + OFF_HIST);
    int* hist = (int*)smem;
    const float* b_rg = uni(p.b_rg); const float* b_re = uni(p.b_re);
    for (int c = blockIdx.x; c < 256; c += gridDim.x) {
        __syncthreads();
        if (tid < 64) hist[tid] = 0;
        __syncthreads();
        if (tid < 256) {
            const int tok = c * 256 + tid;
            const float* L = logits + (size_t)tok * 160;
            const float4 ga = *(const float4*)(L), gb = *(const float4*)(L + 4), gc = *(const float4*)(L + 72), gd = *(const float4*)(L + 76);
            const float g[8] = {ga.x + gc.x + b_rg[0], ga.y + gc.y + b_rg[1], ga.z + gc.z + b_rg[2], ga.w + gc.w + b_rg[3],
                                gb.x + gd.x + b_rg[4], gb.y + gd.y + b_rg[5], gb.z + gd.z + b_rg[6], gb.w + gd.w + b_rg[7]};
            float gmax = g[0]; int gsel = 0;
#pragma unroll
            for (int k = 1; k < 8; ++k) if (g[k] > gmax) { gmax = g[k]; gsel = k; }
            float gs = 0.f;
#pragma unroll
            for (int k = 0; k < 8; ++k) gs += __expf(g[k] - gmax);
            const float pgroup = 1.0f / gs;
            const float4 ea = *(const float4*)(L + 8 + gsel * 8), eb = *(const float4*)(L + 12 + gsel * 8), ec = *(const float4*)(L + 80 + gsel * 8), ed = *(const float4*)(L + 84 + gsel * 8);
            const float4 ba = *(const float4*)(b_re + gsel * 8), bb = *(const float4*)(b_re + gsel * 8 + 4);
            const float e[8] = {ea.x + ec.x + ba.x, ea.y + ec.y + ba.y, ea.z + ec.z + ba.z, ea.w + ec.w + ba.w, eb.x + ed.x + bb.x, eb.y + ed.y + bb.y, eb.z + ed.z + bb.z, eb.w + ed.w + bb.w};
            float v0 = e[0], v1 = -INFINITY; int i0 = 0, i1 = 0;
#pragma unroll
            for (int k = 1; k < 8; ++k) { if (e[k] > v0) { v1 = v0; i1 = i0; v0 = e[k]; i0 = k; } else if (e[k] > v1) { v1 = e[k]; i1 = k; } }
            const float x1 = __expf(v1 - v0), den = 1.0f + x1;
            const int e0i = gsel * 8 + i0, e1i = gsel * 8 + i1;
            toke[tok] = make_int2(e0i, e1i); tokw[tok] = make_float2(pgroup / den, pgroup * x1 / den);
            atomicAdd(&hist[e0i], 1); atomicAdd(&hist[e1i], 1);
        }
        __syncthreads();
        if (tid < 64) histg[c * 64 + tid] = hist[tid];
    }
}

__device__ __forceinline__ void compute_segments(const int* histg, int* seg, int tid) {
    if (tid < 64) {
        int s = 0;
        for (int c = 0; c < 256; ++c) s += histg[c * 64 + tid];
        seg[tid] = s;
    }
    __syncthreads();
    if (tid == 0) {
        int acc = 0;
        for (int e = 0; e < 64; ++e) { seg[64 + e] = acc; acc += (seg[e] + 255) >> 8; }
        seg[128] = acc;
    }
    __syncthreads();
}

__device__ __forceinline__ void phase8(const Params& p, char* smem) {
    const int tid = opaque_tid();
    char* ws = uni(p.ws);
    const int* histg = (const int*)(ws + OFF_HIST);
    const int2* toke = (const int2*)(ws + OFF_TOKE); const float2* tokw = (const float2*)(ws + OFF_TOKW);
    int* slot_tok = (int*)(ws + OFF_SLOTTOK); float* slot_w = (float*)(ws + OFF_SLOTW); int* tokslot = (int*)(ws + OFF_TOKSLOT);
    int* seg = (int*)smem;
    int* cursor = seg + 192;
    compute_segments(histg, seg, tid);
    for (int e = blockIdx.x; e < 64; e += gridDim.x) {
        const int start = seg[64 + e] * 256 + seg[e], end = seg[64 + e + 1] * 256;
        for (int s = start + tid; s < end; s += NTHR) { slot_tok[s] = -1; slot_w[s] = 0.f; }
    }
    for (int c = blockIdx.x; c < 256; c += gridDim.x) {
        __syncthreads();
        if (tid < 64) {
            int base = 0;
            for (int cc = 0; cc < c; ++cc) base += histg[cc * 64 + tid];
            cursor[tid] = seg[64 + tid] * 256 + base;
        }
        __syncthreads();
        if (tid < 256) {
            const int tok = c * 256 + tid;
            const int2 ee = toke[tok]; const float2 ww = tokw[tok];
            const int s0 = atomicAdd(&cursor[ee.x], 1);
            const int s1 = atomicAdd(&cursor[ee.y], 1);
            tokslot[tok * 2] = s0; tokslot[tok * 2 + 1] = s1;
            slot_tok[s0] = tok * 2; slot_w[s0] = ww.x;
            slot_tok[s1] = tok * 2 + 1; slot_w[s1] = ww.y;
        }
    }
}

struct Sched9a {
    int G, c, nrt; const int* seg; const int* slot_tok; const char* h2b; const char* wgu;
    __device__ __forceinline__ bool next(int i, pg8::Unit& u) const {
        int rtile, pn;
        if ((G & 7) == 0) { const int x = c & 7, j = c >> 3, nj = G >> 3, per = (nrt + 7) >> 3; const int uidx = i * nj + j; if (uidx >= per * 2) return false; rtile = x * per + (uidx >> 1); pn = uidx & 1; if (rtile >= nrt) return false; }
        else { const int uidx = i * G + c; if (uidx >= nrt * 2) return false; rtile = uidx >> 1; pn = uidx & 1; }
        int e = 0;
        for (int k = 1; k < 64; ++k) if (seg[64 + k] <= rtile) e = k;
        e = __builtin_amdgcn_readfirstlane(e);
        u.pm = rtile; u.pn = pn; u.aux = e; u.A = h2b; u.Bt = wgu + (size_t)e * 512 * 1024 * 2;
        return true;
    }
    __device__ __forceinline__ unsigned arow(const pg8::Unit& u, int r) const {
        const int tk = slot_tok[u.pm * 256 + r];
        return (unsigned)(tk < 0 ? 0 : (tk >> 1)) * 4096u;
    }
};
struct Epi9a {
    bf16_t* hbuf;
    __device__ __forceinline__ void operator()(f32x4 (&acc)[2][2][4][2], const pg8::Unit& u, int wr, int wc, int fr, int fq) const {
        const int row0 = u.pm * 256 + wr * 64 + fr, col0 = u.pn * 128 + wc * 32 + fq * 8;
#pragma unroll
        for (int ai = 0; ai < 2; ++ai)
#pragma unroll
            for (int m = 0; m < 4; ++m) {
                const size_t slot = row0 + ai * 128 + m * 16;
                f32x4 v0, v1;
#pragma unroll
                for (int j = 0; j < 4; ++j) {
                    const float g0 = acc[ai][0][m][0][j], g1 = acc[ai][0][m][1][j];
                    v0[j] = g0 * sigmoidf_(g0) * acc[ai][1][m][0][j]; v1[j] = g1 * sigmoidf_(g1) * acc[ai][1][m][1][j];
                }
                store_bf16x8(hbuf + slot * 256 + col0, v0, v1);
            }
    }
};
__device__ __forceinline__ void phase9a(const Params& p, char* smem) {
    const int tid = opaque_tid();
    char* ws = uni(p.ws);
    int* seg = (int*)(smem + LDS_GEMM);
    compute_segments((const int*)(ws + OFF_HIST), seg, tid);
    Sched9a S{(int)gridDim.x, (int)blockIdx.x, __builtin_amdgcn_readfirstlane(seg[128]), seg, (const int*)(ws + OFF_SLOTTOK), ws + OFF_Z2, ws + OFF_WGU};
    Epi9a E{(bf16_t*)(ws + OFF_R1)};
    pg8::gemm_phase<Epi9a, Sched9a, true>((LDS_AS unsigned char*)smem, 1024, S, E);
}

struct Sched9b {
    int G, c, nrt; const int* seg; const char* hbuf; const char* wd;
    __device__ __forceinline__ bool next(int i, pg8::Unit& u) const {
        int rtile, pn;
        if ((G & 7) == 0) { const int x = c & 7, j = c >> 3, nj = G >> 3, per = (nrt + 7) >> 3; const int uidx = i * nj + j; if (uidx >= per * 4) return false; rtile = x * per + (uidx >> 2); pn = uidx & 3; if (rtile >= nrt) return false; }
        else { const int uidx = i * G + c; if (uidx >= nrt * 4) return false; rtile = uidx >> 2; pn = uidx & 3; }
        int e = 0;
        for (int k = 1; k < 64; ++k) if (seg[64 + k] <= rtile) e = k;
        e = __builtin_amdgcn_readfirstlane(e);
        u.pm = rtile; u.pn = pn; u.aux = e; u.A = hbuf; u.Bt = wd + (size_t)e * 1024 * 256 * 2;
        return true;
    }
};
struct Epi9b {
    const float* slot_w; bf16_t* yb;
    __device__ __forceinline__ void operator()(f32x4 (&acc)[2][2][4][2], const pg8::Unit& u, int wr, int wc, int fr, int fq) const {
        const int row0 = u.pm * 256 + wr * 64 + fr, col0 = u.pn * 256 + wc * 32 + fq * 8;
#pragma unroll
        for (int ai = 0; ai < 2; ++ai)
#pragma unroll
            for (int m = 0; m < 4; ++m) {
                const int slot = row0 + ai * 128 + m * 16;
                const float w = slot_w[slot];
#pragma unroll
                for (int bj = 0; bj < 2; ++bj) store_bf16x8(yb + (size_t)slot * 1024 + col0 + bj * 128, acc[ai][bj][m][0] * w, acc[ai][bj][m][1] * w);
            }
    }
};
__device__ __forceinline__ void phase9b(const Params& p, char* smem) {
    const int tid = opaque_tid();
    char* ws = uni(p.ws);
    int* seg = (int*)(smem + LDS_GEMM);
    compute_segments((const int*)(ws + OFF_HIST), seg, tid);
    Sched9b S{(int)gridDim.x, (int)blockIdx.x, __builtin_amdgcn_readfirstlane(seg[128]), seg, ws + OFF_R1, ws + OFF_WD};
    Epi9b E{(const float*)(ws + OFF_SLOTW), (bf16_t*)(ws + OFF_YB)};
    pg8::gemm_phase<Epi9b, Sched9b>((LDS_AS unsigned char*)smem, 256, S, E);
}

__device__ __forceinline__ void phase10(const Params& p) {
    const int tid_ = opaque_tid(); const int lane = tid_ & 63, wid = tid_ >> 6;
    const bf16_t* h2 = (const bf16_t*)(uni(p.ws) + OFF_Z2); const bf16_t* yb = (const bf16_t*)(uni(p.ws) + OFF_YB);
    const int* tokslot = (const int*)(uni(p.ws) + OFF_TOKSLOT);
    for (int row = blockIdx.x * 8 + wid; row < T_; row += gridDim.x * 8) {
        const int sl0 = __builtin_amdgcn_readfirstlane(tokslot[row * 2]), sl1 = __builtin_amdgcn_readfirstlane(tokslot[row * 2 + 1]);
        float4 v[4];
#pragma unroll
        for (int i = 0; i < 4; ++i) {
            const uint2 hh = *(const uint2*)(h2 + (size_t)row * 2048 + i * 256 + lane * 4);
            const uint2 a = *(const uint2*)(yb + (size_t)sl0 * 1024 + i * 256 + lane * 4), b = *(const uint2*)(yb + (size_t)sl1 * 1024 + i * 256 + lane * 4);
            v[i].x = ALPHA * bf_lo(hh.x) + bf_lo(a.x) + bf_lo(b.x); v[i].y = ALPHA * bf_hi(hh.x) + bf_hi(a.x) + bf_hi(b.x);
            v[i].z = ALPHA * bf_lo(hh.y) + bf_lo(a.y) + bf_lo(b.y); v[i].w = ALPHA * bf_hi(hh.y) + bf_hi(a.y) + bf_hi(b.y);
        }
        ln_row(v, uni(p.ln3g), uni(p.ln3b), lane);
#pragma unroll
        for (int i = 0; i < 4; ++i) *(float4*)(uni(p.out) + (size_t)row * 1024 + i * 256 + lane * 4) = v[i];
    }
}

#define XB_TMO      128
#define XB_XCNT(j)  (256  + 64 * (j))
#define XB_XSUB(j)  (1280 + 64 * (j))
#define XB_XGEN(j)  (2304 + 64 * (j))
#define XB_TOP      3328
#define XB_TOPGEN   3392
#define XCD_BAR_WORDS 3456
#define XB_SPIN_CAP (1u << 18)
#define LAS LDS_AS

__device__ __forceinline__ unsigned xb_ld(unsigned* p)              { return __hip_atomic_load(p, __ATOMIC_RELAXED, __HIP_MEMORY_SCOPE_AGENT); }
__device__ __forceinline__ unsigned xb_add(unsigned* p, unsigned v) { return __hip_atomic_fetch_add(p, v, __ATOMIC_RELAXED, __HIP_MEMORY_SCOPE_AGENT); }
__device__ __forceinline__ unsigned xb_xcc_id() { return (unsigned)__builtin_amdgcn_s_getreg((3 << 11) | 20) & 0xFu; }
#define XB_SPIN(cond, bar) do { unsigned _sp = 0; while (cond) { __builtin_amdgcn_s_sleep(1); \
    if ((++_sp & 255u) == 0u) { if (xb_ld(&(bar)[XB_TMO])) break; if (_sp > XB_SPIN_CAP) { atomicAdd(&(bar)[XB_TMO], 1u); break; } } } } while (0)

struct XcdBarrier {
    unsigned* bar; unsigned x;
    volatile LAS unsigned* st;
};

__device__ __forceinline__ XcdBarrier xcd_barrier_post(unsigned* bar, volatile LAS unsigned* st) {
    XcdBarrier b; b.bar = bar; b.x = xb_xcc_id(); b.st = st;
    if (threadIdx.x == 0) (void)xb_add(&bar[XB_XCNT(b.x)], 1u);
    return b;
}
__device__ __forceinline__ void xcd_barrier_complete(unsigned* bar, unsigned x, unsigned& nloc, unsigned& nx) {
    const unsigned G = gridDim.x * gridDim.y * gridDim.z;
    unsigned sum, cnt, mine, sp = 0u;
    for (;;) {
        sum = 0u; cnt = 0u; mine = 0u;
#pragma unroll
        for (unsigned j = 0; j < 16; ++j) { const unsigned c = xb_ld(&bar[XB_XCNT(j)]); sum += c; cnt += (c > 0u) ? 1u : 0u; mine = (j == x) ? c : mine; }
        if (sum == G) break;
        __builtin_amdgcn_s_sleep(1);
        if ((++sp & 255u) == 0u) { if (xb_ld(&bar[XB_TMO])) break; if (sp > XB_SPIN_CAP) { atomicAdd(&bar[XB_TMO], 1u); break; } }
    }
    nloc = mine > 0u ? mine : 1u; nx = cnt > 0u ? cnt : 1u;
}

__device__ __forceinline__ void xcd_barrier(const XcdBarrier& b) {
    asm volatile("s_waitcnt vmcnt(0)" ::: "memory");
    __syncthreads();
    if (threadIdx.x == 0) {
        unsigned* bar = b.bar;
        __builtin_amdgcn_s_waitcnt(0);
        unsigned nloc = b.st[0], nx = b.st[1];
        if (nloc == 0u) { xcd_barrier_complete(bar, b.x, nloc, nx); b.st[0] = nloc; b.st[1] = nx; }
        const unsigned old = xb_add(&bar[XB_XSUB(b.x)], 1u);
        const unsigned gen = old / nloc;
        if (old + 1u == (gen + 1u) * nloc) {
            __builtin_amdgcn_fence(__ATOMIC_RELEASE, "agent");
            asm volatile("s_waitcnt vmcnt(0)" ::: "memory");
            const unsigned og = xb_add(&bar[XB_TOP], 1u);
            const unsigned tg = og / nx;
            if (og + 1u == (tg + 1u) * nx) xb_add(&bar[XB_TOPGEN], 1u);
            else XB_SPIN(xb_ld(&bar[XB_TOPGEN]) == tg, bar);
            __builtin_amdgcn_fence(__ATOMIC_ACQUIRE, "agent");
            xb_add(&bar[XB_XGEN(b.x)], 1u);
            asm volatile("s_waitcnt vmcnt(0)" ::: "memory");
        } else {
            XB_SPIN(xb_ld(&bar[XB_XGEN(b.x)]) == gen, bar);
            __builtin_amdgcn_fence(__ATOMIC_ACQUIRE, "agent");
            asm volatile("s_waitcnt vmcnt(0)" ::: "memory");
        }
    }
    __syncthreads();
}


#ifndef DUP
#define DUP (-1)
#endif
#define RUN(id, call) do { call; if (DUP == (id)) { GRID_SYNC(); call; } } while (0)
__global__ void __launch_bounds__(NTHR) mega(Params pk) {
    extern __shared__ __attribute__((aligned(16))) char smem[];
    cg::grid_group grid = cg::this_grid();
    if (threadIdx.x == 0) *(Params*)(smem + LDS_PARAMS) = pk;
    __syncthreads();
    const Params& p = *(const Params*)(smem + LDS_PARAMS);
    char* ws = uni(p.ws);
    volatile LDS_AS unsigned* xst = (volatile LDS_AS unsigned*)(LDS_AS char*)smem + (LDS_XB / 4);
    if (threadIdx.x < 4) xst[threadIdx.x] = 0u;
    __syncthreads();
    (void)xcd_barrier_post((unsigned*)(ws + OFF_BAR), xst);
#define GRID_SYNC() do { XcdBarrier xb_; xb_.bar = (unsigned*)(uni(p.ws) + OFF_BAR); xb_.x = xb_xcc_id(); xb_.st = (volatile LDS_AS unsigned*)(LDS_AS char*)smem + (LDS_XB / 4); xcd_barrier(xb_); } while (0)
    RUN(0, phase0(p, smem));
    if (DUP == 61) { GRID_SYNC(); phase0(p, smem, 1); }
    if (DUP == 62) { GRID_SYNC(); phase0(p, smem, 2); }
    if (DUP == 64) { GRID_SYNC(); phase0(p, smem, 4); }
    grid.sync();
    RUN(1, phase1(p, smem));
    if (DUP == 30) { GRID_SYNC(); phase1(p, smem, 1); }
    if (DUP == 31) { GRID_SYNC(); phase1(p, smem, 2); }
    GRID_SYNC();
    RUN(2, phase2a(p, smem));
    if (DUP == 20) { GRID_SYNC(); phase2a(p, smem, 1); }
    if (DUP == 21) { GRID_SYNC(); phase2a(p, smem, 2); }
    GRID_SYNC();
    RUN(12, phase2b(p, smem));
    if (DUP == 22) { GRID_SYNC(); phase2b(p, smem, 1); }
    if (DUP == 23) { GRID_SYNC(); phase2b(p, smem, 2); }
    if (DUP == 24) { GRID_SYNC(); phase2b(p, smem, 1, 4); }
    if (DUP == 25) { GRID_SYNC(); phase2b(p, smem, 1, 5); }
    if (DUP == 26) { GRID_SYNC(); phase2b(p, smem, 1, 13); }
    GRID_SYNC();
    phase2c(p, smem);
    GRID_SYNC();
    RUN(3, phase3(p, smem));
    GRID_SYNC();
    RUN(4, phase_gemm_bf16(p, smem, (const bf16_t*)(ws + OFF_R1), (const bf16_t*)(ws + OFF_WMIX), (bf16_t*)(ws + OFF_R0), 1.0f));
    GRID_SYNC();
    phase_ln1(p);
    GRID_SYNC();
    RUN(6, phase_gemm_bf16(p, smem, (const bf16_t*)(ws + OFF_R0), (const bf16_t*)(ws + OFF_WXQ), (bf16_t*)(ws + OFF_XQ), 0.0625f));
    GRID_SYNC();
    RUN(7, phase6(p, smem));
    GRID_SYNC();
    RUN(8, phase_gemm_bf16(p, smem, (const bf16_t*)(ws + OFF_O), (const bf16_t*)(ws + OFF_WXO), (bf16_t*)(ws + OFF_XQ), 1.0f));
    GRID_SYNC();
    RUN(13, phase_ln2(p));
    GRID_SYNC();
    RUN(15, phase_router_gemm(p, smem));
    GRID_SYNC();
    RUN(16, phase_select(p, smem));
    GRID_SYNC();
    RUN(9, phase8(p, smem));
    GRID_SYNC();
    RUN(10, phase9a(p, smem));
    GRID_SYNC();
    RUN(11, phase9b(p, smem));
    GRID_SYNC();
    RUN(14, phase10(p));
}

extern "C" void kernel_launch(void* const* d_in, const int* in_sizes, int n_in, void* d_out, int out_size,
                              void* d_ws, size_t ws_size, hipStream_t stream) {
    static int grid_blocks = 0;
    if (!grid_blocks) {
        int dev = 0, cus = 0, per_cu = 0;
        (void)hipGetDevice(&dev);
        (void)hipDeviceGetAttribute(&cus, hipDeviceAttributeMultiprocessorCount, dev);
        (void)hipFuncSetAttribute((const void*)mega, hipFuncAttributeMaxDynamicSharedMemorySize, LDS_BYTES);
        (void)hipOccupancyMaxActiveBlocksPerMultiprocessor(&per_cu, mega, NTHR, LDS_BYTES);
        if (per_cu > 1) per_cu = 1;
        grid_blocks = cus * per_cu;
        if (ws_size < WS_NEED) fprintf(stderr, "workspace too small: %zu\n", ws_size);
    }
    Params p{};
    const float* const* f = (const float* const*)d_in;
    p.x = f[0]; p.mem = f[1]; p.pos = (const int*)d_in[2];
    p.w_in = f[3]; p.sinks = f[4]; p.conv_w = f[5]; p.conv_b = f[6]; p.b_ig = f[7]; p.b_fg = f[8]; p.ml_g = f[9];
    p.w_att = f[10]; p.w_ml = f[11]; p.w_mix = f[12]; p.ln1g = f[13]; p.ln1b = f[14];
    p.w_xq = f[15]; p.w_xkv = f[16]; p.w_xo = f[17]; p.ln2g = f[18]; p.ln2b = f[19];
    p.w_rg = f[20]; p.b_rg = f[21]; p.w_re = f[22]; p.b_re = f[23]; p.w_gate = f[24]; p.w_up = f[25]; p.w_down = f[26];
    p.ln3g = f[27]; p.ln3b = f[28];
    p.out = (float*)d_out; p.ws = (char*)d_ws;
    (void)hipMemsetAsync((char*)d_ws + OFF_BAR, 0, XCD_BAR_WORDS * sizeof(unsigned), stream);
    void* args[] = {&p};
    hipError_t e = hipLaunchCooperativeKernel((void*)mega, dim3(grid_blocks), dim3(NTHR), args, LDS_BYTES, stream);
    if (e != hipSuccess) fprintf(stderr, "cooperative launch failed: %s (grid %d)\n", hipGetErrorString(e), grid_blocks);
}
```

```cpp
#include <hip/hip_runtime.h>
#include <hip/hip_cooperative_groups.h>
#include <cstdio>
#include <cstdint>
namespace cg = cooperative_groups;

typedef unsigned short bf16_t;
typedef short bf16x8 __attribute__((ext_vector_type(8)));
typedef float f32x4 __attribute__((ext_vector_type(4)));
typedef unsigned u32x2 __attribute__((ext_vector_type(2)));
typedef unsigned u32x4 __attribute__((ext_vector_type(4)));
#define LDS_AS __attribute__((address_space(3)))
#define GLB_AS __attribute__((address_space(1)))

constexpr int T_ = 65536;
constexpr int NTHR = 512;
constexpr size_t MiB = 1ull << 20;
constexpr float ALPHA = 1.189207115002721f;
constexpr size_t OFF_R0 = 0;
constexpr size_t OFF_R1 = 128 * MiB;
constexpr size_t OFF_AK = 256 * MiB;
constexpr size_t OFF_AV = 272 * MiB;
constexpr size_t OFF_MQK = 288 * MiB;
constexpr size_t OFF_MV = 416 * MiB;
constexpr size_t OFF_MO = 544 * MiB;
constexpr size_t OFF_GG = 672 * MiB;
constexpr size_t OFF_WGU = 288 * MiB;
constexpr size_t OFF_WD = 352 * MiB;
constexpr size_t OFF_XQ = 416 * MiB;
constexpr size_t OFF_O = 544 * MiB;
constexpr size_t OFF_Z2 = 672 * MiB;
constexpr size_t OFF_YB = 384 * MiB;
constexpr size_t OFF_MISC = 928 * MiB;
constexpr size_t OFF_WIN = OFF_MISC;
constexpr size_t OFF_MEMB = OFF_MISC + 84 * MiB;
constexpr size_t OFF_CS = OFF_MISC + 21 * MiB;
constexpr size_t OFF_WXKV = OFF_MISC + 37 * MiB;
constexpr size_t OFF_WATT = OFF_MISC + 41 * MiB;
constexpr size_t OFF_WML = OFF_MISC + 43 * MiB;
constexpr size_t OFF_WMIX = OFF_MISC + 45 * MiB;
constexpr size_t OFF_WXQ = OFF_MISC + 47 * MiB;
constexpr size_t OFF_WXO = OFF_MISC + 49 * MiB;
constexpr size_t OFF_KMAT = OFF_MISC + 51 * MiB;
constexpr size_t OFF_VT = OFF_MISC + 59 * MiB;
constexpr size_t OFF_GATES = OFF_MISC + 67 * MiB;
constexpr size_t OFF_TOKE = OFF_MISC + 69 * MiB;
constexpr size_t OFF_TOKW = OFF_MISC + 70 * MiB;
constexpr size_t OFF_SLOTTOK = OFF_MISC + 71 * MiB;
constexpr size_t OFF_SLOTW = OFF_MISC + 72 * MiB;
constexpr size_t OFF_HIST = OFF_MISC + 73 * MiB;
constexpr size_t OFF_TOKSLOT = OFF_MISC + 75 * MiB;
constexpr size_t OFF_BAR = OFF_MISC + 74 * MiB;
constexpr size_t OFF_WRT = OFF_MISC + 92 * MiB;
constexpr size_t OFF_SSQP = OFF_MISC + 76 * MiB;
constexpr size_t OFF_SP = OFF_MISC;
constexpr size_t OFF_REC = OFF_MISC + 32 * MiB;
constexpr size_t OUT_QP = 128 * MiB;
constexpr size_t OUT_KP = 192 * MiB;
constexpr size_t WS_NEED = 1024 * MiB;
constexpr int LDS_GEMM = 147456;
constexpr int LDS_PARAMS = 163520;
constexpr int LDS_XB = 163776;
constexpr int LDS_BYTES = 163840;

struct Params {
    const float *x, *mem; const int* pos;
    const float *w_in, *sinks, *conv_w, *conv_b, *b_ig, *b_fg, *ml_g, *w_att, *w_ml, *w_mix, *ln1g, *ln1b;
    const float *w_xq, *w_xkv, *w_xo, *ln2g, *ln2b, *w_rg, *b_rg, *w_re, *b_re, *w_gate, *w_up, *w_down, *ln3g, *ln3b;
    float* out; char* ws;
};

typedef float f32x2 __attribute__((ext_vector_type(2)));
__device__ const double INV_FREQ[32] = {1.0, 0.7498942093324559, 0.5623413251903491, 0.4216965034285822, 0.31622776601683794, 0.23713737056616552, 0.1778279410038923, 0.1333521432163324, 0.1, 0.07498942093324558, 0.05623413251903491, 0.042169650342858224, 0.03162277660168379, 0.023713737056616554, 0.01778279410038923, 0.01333521432163324, 0.01, 0.007498942093324558, 0.005623413251903491, 0.004216965034285823, 0.0031622776601683794, 0.0023713737056616554, 0.0017782794100389228, 0.001333521432163324, 0.001, 0.0007498942093324559, 0.0005623413251903491, 0.00042169650342858224, 0.00031622776601683794, 0.00023713737056616554, 0.00017782794100389227, 0.0001333521432163324};

template <class T> __device__ __forceinline__ T* uni(T* q) {
    const unsigned long long v = (unsigned long long)q;
    const unsigned lo = __builtin_amdgcn_readfirstlane((unsigned)v), hi = __builtin_amdgcn_readfirstlane((unsigned)(v >> 32));
    typedef __attribute__((address_space(1))) T* gptr_t;
    return (T*)(gptr_t)(((unsigned long long)hi << 32) | lo);
}
__device__ __forceinline__ int opaque_tid() { int t = threadIdx.x; asm volatile("" : "+v"(t)); return t; }
__device__ __forceinline__ unsigned pk_bf16(float lo, float hi) { unsigned r; asm("v_cvt_pk_bf16_f32 %0, %1, %2" : "=v"(r) : "v"(lo), "v"(hi)); return r; }
__device__ __forceinline__ float bf_lo(unsigned u) { return __uint_as_float(u << 16); }
__device__ __forceinline__ float bf_hi(unsigned u) { return __uint_as_float(u & 0xffff0000u); }
__device__ __forceinline__ float bf2f(bf16_t h) { return __uint_as_float(((unsigned)h) << 16); }
template <int CTRL> __device__ __forceinline__ float dppf(float v) { return __builtin_bit_cast(float, __builtin_amdgcn_update_dpp(0, __builtin_bit_cast(int, v), CTRL, 0xf, 0xf, true)); }
__device__ __forceinline__ float wsum(float v) {
#pragma unroll
    for (int o = 32; o; o >>= 1) v += __shfl_xor(v, o);
    return v;
}
__device__ __forceinline__ float sigmoidf_(float x) { return __builtin_amdgcn_rcpf(1.0f + __builtin_amdgcn_exp2f(x * -1.4426950408889634f)); }
__device__ __forceinline__ void glds16(const bf16_t* g, char* l) {
    __builtin_amdgcn_global_load_lds((const GLB_AS void*)g, (LDS_AS void*)l, 16, 0, 0);
}

__device__ __forceinline__ void store_bf16x8(bf16_t* p, f32x4 a, f32x4 b) {
    u32x4 w; w[0] = pk_bf16(a[0], a[1]); w[1] = pk_bf16(a[2], a[3]); w[2] = pk_bf16(b[0], b[1]); w[3] = pk_bf16(b[2], b[3]); *(u32x4*)p = w;
}
__device__ __forceinline__ void store_bf16x4(bf16_t* p, f32x4 v) {
    uint2 w; w.x = pk_bf16(v[0], v[1]); w.y = pk_bf16(v[2], v[3]); *(uint2*)p = w;
}

namespace pg8 {
constexpr int BM = 256, BK = 64, HALF = 128, HTB = HALF * BK * 2;
__device__ __forceinline__ int lds_byte(int r, int c) { const int st = (r >> 4) * 2 + (c >> 5), rr = r & 15, cc = c & 31, ob = rr * 64 + cc * 2; return st * 1024 + (ob ^ (((ob >> 9) & 1) << 5)); }
__device__ __forceinline__ void stage_rc(int b, int& R, int& C) { const int st = b / 1024, sb = b % 1024, swz = sb ^ (((sb >> 9) & 1) << 5); R = (st >> 1) * 16 + swz / 64; C = (st & 1) * 32 + (swz % 64) / 2; }
struct Unit { int pm, pn, aux; const char* A; const char* Bt; };

template <class Epi, class Sched, bool GATHER = false>
__device__ __forceinline__ void gemm_phase(LDS_AS unsigned char* lds, const int K, const Sched& S, const Epi& E, const int stagger_cycles = 0) {
    const int tid = opaque_tid(), wid = __builtin_amdgcn_readfirstlane(tid >> 6), lane = tid & 63, wr = wid >> 2, wc = wid & 3, fr = lane & 15, fq = lane >> 4;
    const int nt = K / BK;
    unsigned voff[2];
#pragma unroll
    for (int i = 0; i < 2; ++i) { int R, C; stage_rc(tid * 16 + i * 8192, R, C); voff[i] = (unsigned)(R * K + C) * 2u; }
    const size_t kstep = (size_t)(BK * 2);
    const size_t hstep = (size_t)HALF * K * 2;
    const size_t tstep = 2 * hstep;
    const unsigned ldsw = (unsigned)wid * 1024u;
    const int aoff = lds_byte(wr * 64 + fr, fq * 8), boff = lds_byte(wc * 32 + fr, fq * 8);
#define PG8_SA(b, h) (((b) * 2 + (h)) * HTB)
#define PG8_SB(b, h) ((4 + (b) * 2 + (h)) * HTB)
#define PG8_STAGE(bufoff, gbase) do { _Pragma("unroll") for (int _i = 0; _i < 2; ++_i) \
        __builtin_amdgcn_global_load_lds((const GLB_AS void*)((const char*)(gbase) + voff[_i]), (LDS_AS void*)(lds + (bufoff) + ldsw + _i * 8192), 16, 0, 0); } while (0)
#define PG8_LDA(dst, b, h) do { _Pragma("unroll") for (int m = 0; m < 4; ++m) _Pragma("unroll") for (int k = 0; k < 2; ++k) dst[m][k] = *(const LDS_AS bf16x8*)(lds + PG8_SA(b, h) + aoff + m * 2048 + k * 1024); } while (0)
#define PG8_LDB(dst, b, h) do { _Pragma("unroll") for (int n = 0; n < 2; ++n) _Pragma("unroll") for (int k = 0; k < 2; ++k) dst[n][k] = *(const LDS_AS bf16x8*)(lds + PG8_SB(b, h) + boff + n * 2048 + k * 1024); } while (0)
#define PG8_MMA(ai, bj, At, Bt) do { __builtin_amdgcn_s_setprio(1); _Pragma("unroll") for (int m = 0; m < 4; ++m) _Pragma("unroll") for (int n = 0; n < 2; ++n) _Pragma("unroll") for (int k = 0; k < 2; ++k) \
        acc[ai][bj][m][n] = __builtin_amdgcn_mfma_f32_16x16x32_bf16(Bt[n][k], At[m][k], acc[ai][bj][m][n], 0, 0, 0); __builtin_amdgcn_s_setprio(0); } while (0)
#define PG8_WAIT_V(n) asm volatile("s_waitcnt vmcnt(" #n ")" ::: "memory")
#define PG8_WAIT_L(n) asm volatile("s_waitcnt lgkmcnt(" #n ")" ::: "memory")
#define PG8_BAR __builtin_amdgcn_s_barrier()
#define PG8_SCHED __builtin_amdgcn_sched_barrier(0)
#define PG8_STAGE_A(bufoff, gbase, VA) do { _Pragma("unroll") for (int _i = 0; _i < 2; ++_i) \
        __builtin_amdgcn_global_load_lds((const GLB_AS void*)((const char*)(gbase) + (VA)[_i]), (LDS_AS void*)(lds + (bufoff) + ldsw + _i * 8192), 16, 0, 0); } while (0)
    int Rr[2], Cc[2];
#pragma unroll
    for (int i = 0; i < 2; ++i) stage_rc(tid * 16 + i * 8192, Rr[i], Cc[i]);
    unsigned va0[2], va1[2], vn0[2], vn1[2];
    Unit cur, nxt; int ui = 0;
    if (!S.next(0, cur)) return;
    if constexpr (GATHER) {
#pragma unroll
        for (int i = 0; i < 2; ++i) { va0[i] = S.arow(cur, Rr[i]) + (unsigned)Cc[i] * 2u; va1[i] = S.arow(cur, 128 + Rr[i]) + (unsigned)Cc[i] * 2u; }
    } else {
#pragma unroll
        for (int i = 0; i < 2; ++i) { va0[i] = voff[i]; va1[i] = voff[i] + (unsigned)hstep; }
    }
#pragma unroll
    for (int i = 0; i < 2; ++i) { vn0[i] = va0[i]; vn1[i] = va1[i]; }
    if (stagger_cycles > 0) {
        const int lvl = (blockIdx.x >> 3) & 31;
        for (int q = 0; q < lvl * stagger_cycles; ++q) __builtin_amdgcn_s_sleep(15);
    }
    f32x4 acc[2][2][4][2];
#pragma unroll
    for (int a = 0; a < 2; ++a)
#pragma unroll
        for (int b = 0; b < 2; ++b)
#pragma unroll
            for (int m = 0; m < 4; ++m)
#pragma unroll
                for (int n = 0; n < 2; ++n) acc[a][b][m][n] = (f32x4){0.f, 0.f, 0.f, 0.f};
    bf16x8 At[4][2], B0[2][2], B1[2][2];
    const char* cA = GATHER ? cur.A : cur.A + (size_t)cur.pm * tstep; const char* cB = cur.Bt + (size_t)cur.pn * tstep;
    PG8_STAGE(PG8_SB(0, 0), cB); PG8_STAGE(PG8_SB(0, 1), cB + hstep); PG8_STAGE_A(PG8_SA(0, 0), cA, va0); PG8_STAGE_A(PG8_SA(0, 1), cA, va1);
    if (wr == 1) PG8_BAR;
    PG8_WAIT_V(2); PG8_BAR;
    PG8_STAGE(PG8_SB(1, 0), cB + kstep); PG8_STAGE_A(PG8_SA(1, 0), cA + kstep, va0); PG8_STAGE(PG8_SB(1, 1), cB + hstep + kstep);
    PG8_WAIT_V(6); PG8_BAR;
    for (;;) {
        const bool has_next = S.next(ui + 1, nxt);
        const char* nA = has_next ? (GATHER ? nxt.A : nxt.A + (size_t)nxt.pm * tstep) : cA; const char* nB = has_next ? nxt.Bt + (size_t)nxt.pn * tstep : cB;
        if constexpr (GATHER) {
            if (has_next) {
#pragma unroll
                for (int i = 0; i < 2; ++i) { vn0[i] = S.arow(nxt, Rr[i]) + (unsigned)Cc[i] * 2u; vn1[i] = S.arow(nxt, 128 + Rr[i]) + (unsigned)Cc[i] * 2u; }
            }
        }
        for (int t = 0; t < nt; t += 2) {
            const bool last = (t == nt - 2);
            const char* a1 = cA + (size_t)(t + 1) * kstep;
            const char* a2 = last ? nA : cA + (size_t)(t + 2) * kstep; const char* b2 = last ? nB : cB + (size_t)(t + 2) * kstep;
            const char* a3 = a2 + kstep; const char* b3 = b2 + kstep;
            unsigned w0[2], w1[2];
#pragma unroll
            for (int i = 0; i < 2; ++i) { w0[i] = last ? vn0[i] : va0[i]; w1[i] = last ? vn1[i] : va1[i]; }
            PG8_LDB(B0, 0, 0); PG8_LDB(B1, 0, 1); PG8_SCHED; PG8_LDA(At, 0, 0); PG8_STAGE_A(PG8_SA(1, 1), a1, va1);
            PG8_WAIT_V(8); PG8_WAIT_L(0); PG8_BAR; PG8_MMA(0, 0, At, B0); PG8_MMA(0, 1, At, B1); PG8_BAR; PG8_SCHED;
            PG8_LDA(At, 0, 1); PG8_STAGE(PG8_SB(0, 0), b2); PG8_STAGE(PG8_SB(0, 1), b2 + hstep); PG8_STAGE_A(PG8_SA(0, 0), a2, w0);
            PG8_WAIT_V(8); PG8_WAIT_L(0); PG8_BAR; PG8_MMA(1, 0, At, B0); PG8_MMA(1, 1, At, B1); PG8_BAR; PG8_SCHED;
            PG8_LDB(B0, 1, 0); PG8_LDB(B1, 1, 1); PG8_SCHED; PG8_LDA(At, 1, 0); PG8_STAGE_A(PG8_SA(0, 1), a2, w1);
            PG8_WAIT_V(8); PG8_WAIT_L(0); PG8_BAR; PG8_MMA(0, 0, At, B0); PG8_MMA(0, 1, At, B1); PG8_BAR; PG8_SCHED;
            PG8_LDA(At, 1, 1); PG8_STAGE(PG8_SB(1, 0), b3); PG8_STAGE(PG8_SB(1, 1), b3 + hstep); PG8_STAGE_A(PG8_SA(1, 0), a3, w0);
            PG8_WAIT_V(8); PG8_WAIT_L(0); PG8_BAR; PG8_MMA(1, 0, At, B0); PG8_MMA(1, 1, At, B1); PG8_BAR; PG8_SCHED;
        }
        if (wr == 0) PG8_BAR;
        E(acc, cur, wr, wc, fr, fq);
        if (!has_next) break;
        if (!(cur.aux & 0x100)) {
#pragma unroll
        for (int a = 0; a < 2; ++a)
#pragma unroll
            for (int b = 0; b < 2; ++b)
#pragma unroll
                for (int m = 0; m < 4; ++m)
#pragma unroll
                    for (int n = 0; n < 2; ++n) acc[a][b][m][n] = (f32x4){0.f, 0.f, 0.f, 0.f};
        }
        cur = nxt; cA = nA; cB = nB; ++ui;
#pragma unroll
        for (int i = 0; i < 2; ++i) { va0[i] = vn0[i]; va1[i] = vn1[i]; }
        if (wr == 1) PG8_BAR;
    }
    PG8_WAIT_V(0);
    PG8_BAR;
#undef PG8_SA
#undef PG8_SB
#undef PG8_STAGE
#undef PG8_STAGE_A
#undef PG8_LDA
#undef PG8_LDB
#undef PG8_MMA
#undef PG8_WAIT_V
#undef PG8_WAIT_L
#undef PG8_BAR
#undef PG8_SCHED
}
}

__device__ __forceinline__ int perm32(int rho) { const int n = rho >> 4, i = rho & 15; return 8 * (i >> 2) + 4 * n + (i & 3); }
template <bool PERM>
__device__ __forceinline__ void tr_tile_t(const float* src, size_t ld_src, int k0, int c0, bf16_t* dst, size_t ld_dst, int r0, float* tile, int tid) {
    {
        const int r = tid >> 3, c4 = (tid & 7) * 4;
        const float4 v = *(const float4*)(src + (size_t)(k0 + r) * ld_src + c0 + c4);
        float* tp = tile + r * 33 + c4; tp[0] = v.x; tp[1] = v.y; tp[2] = v.z; tp[3] = v.w;
    }
    __syncthreads();
    {
        const int c = tid >> 4, rc = (tid & 15) * 4, sc = PERM ? perm32(c) : c;
        const float a0 = tile[(rc + 0) * 33 + sc], a1 = tile[(rc + 1) * 33 + sc], a2 = tile[(rc + 2) * 33 + sc], a3 = tile[(rc + 3) * 33 + sc];
        uint2 w; w.x = pk_bf16(a0, a1); w.y = pk_bf16(a2, a3);
        *(uint2*)(dst + (size_t)(r0 + c) * ld_dst + k0 + rc) = w;
    }
    __syncthreads();
}
template <bool PERM>
__device__ __forceinline__ void tr_tile4(const float* const (&src)[4], const int (&c0)[4], size_t ld_src, int k0, bf16_t* dst, size_t ld_dst, int r0, float* tile, int tid) {
    {
        const int r = tid >> 3, c4 = (tid & 7) * 4;
        float4 v[4];
#pragma unroll
        for (int g = 0; g < 4; ++g) v[g] = *(const float4*)(src[g] + (size_t)(k0 + r) * ld_src + c0[g] + c4);
#pragma unroll
        for (int g = 0; g < 4; ++g) { float* tp = tile + r * 129 + g * 32 + c4; tp[0] = v[g].x; tp[1] = v[g].y; tp[2] = v[g].z; tp[3] = v[g].w; }
    }
    __syncthreads();
    {
        const int c = tid >> 4, rc = (tid & 15) * 4, sc = PERM ? perm32(c) : c;
#pragma unroll
        for (int g = 0; g < 4; ++g) {
            const float a0 = tile[(rc + 0) * 129 + g * 32 + sc], a1 = tile[(rc + 1) * 129 + g * 32 + sc], a2 = tile[(rc + 2) * 129 + g * 32 + sc], a3 = tile[(rc + 3) * 129 + g * 32 + sc];
            uint2 w; w.x = pk_bf16(a0, a1); w.y = pk_bf16(a2, a3);
            *(uint2*)(dst + (size_t)(r0 + g * 32 + c) * ld_dst + k0 + rc) = w;
        }
    }
    __syncthreads();
}
__device__ __forceinline__ void phase0(const Params& p, char* smem, const int parts = 7) {
    const int tid = opaque_tid(), lane = tid & 63, wid = tid >> 6;
    const int gw = blockIdx.x * 8 + wid, nw = gridDim.x * 8;
    char* ws = uni(p.ws);
    bf16_t* xb = (bf16_t*)(ws + OFF_R0);
    if (parts & 1) {
        const float* xg = uni(p.x);
        float* gates = (float*)(ws + OFF_GATES);
        float4 wg[4][4][2];
        {
            float4* wl = (float4*)smem;
            for (int k = tid; k < 1024; k += NTHR) {
                const float4* wp = (const float4*)(uni(p.w_in) + (size_t)k * 6408 + 4352);
                const int slot = ((k & 3) * 4 + (k >> 8)) * 64 + ((k >> 2) & 63);
                wl[slot * 2] = wp[0]; wl[slot * 2 + 1] = wp[1];
            }
            __syncthreads();
#pragma unroll
            for (int blk = 0; blk < 4; ++blk)
#pragma unroll
                for (int e = 0; e < 4; ++e) { wg[blk][e][0] = wl[((e * 4 + blk) * 64 + lane) * 2]; wg[blk][e][1] = wl[((e * 4 + blk) * 64 + lane) * 2 + 1]; }
            __syncthreads();
        }
        int row = gw * 2;
        float4 v[8];
        if (row < T_) {
#pragma unroll
            for (int i = 0; i < 8; ++i) v[i] = ((const float4*)(xg + (size_t)(row + (i >> 2)) * 1024))[(i & 3) * 64 + lane];
        }
#pragma unroll 1
        for (; row < T_; row += nw * 2) {
            float4 vn[8];
            const int rn = row + nw * 2 < T_ ? row + nw * 2 : row;
#pragma unroll
            for (int i = 0; i < 8; ++i) vn[i] = ((const float4*)(xg + (size_t)(rn + (i >> 2)) * 1024))[(i & 3) * 64 + lane];
#pragma unroll
            for (int i = 0; i < 8; ++i) {
                uint2 w; w.x = pk_bf16(v[i].x, v[i].y); w.y = pk_bf16(v[i].z, v[i].w);
                *(uint2*)(xb + (size_t)(row + (i >> 2)) * 1024 + (i & 3) * 256 + lane * 4) = w;
            }
            if (!(parts & 8)) {
            float g[16];
#pragma unroll
            for (int r = 0; r < 2; ++r) {
                f32x2 a0 = (f32x2){0.f, 0.f}, a1 = a0, b0 = a0, b1 = a0;
#pragma unroll
                for (int blk = 0; blk < 4; ++blk) {
                    const float xe[4] = {v[r * 4 + blk].x, v[r * 4 + blk].y, v[r * 4 + blk].z, v[r * 4 + blk].w};
#pragma unroll
                    for (int e = 0; e < 4; ++e) {
                        const f32x2 xx = (f32x2){xe[e], xe[e]};
                        a0 = __builtin_elementwise_fma(xx, (f32x2){wg[blk][e][0].x, wg[blk][e][0].y}, a0);
                        a1 = __builtin_elementwise_fma(xx, (f32x2){wg[blk][e][0].z, wg[blk][e][0].w}, a1);
                        b0 = __builtin_elementwise_fma(xx, (f32x2){wg[blk][e][1].x, wg[blk][e][1].y}, b0);
                        b1 = __builtin_elementwise_fma(xx, (f32x2){wg[blk][e][1].z, wg[blk][e][1].w}, b1);
                    }
                }
                g[r * 8 + 0] = a0[0]; g[r * 8 + 1] = a0[1]; g[r * 8 + 2] = a1[0]; g[r * 8 + 3] = a1[1];
                g[r * 8 + 4] = b0[0]; g[r * 8 + 5] = b0[1]; g[r * 8 + 6] = b1[0]; g[r * 8 + 7] = b1[1];
            }
#pragma unroll
            for (int i = 0; i < 8; ++i) {
                float a = g[i], b = g[i + 8];
                asm("s_nop 1\n\tv_permlane32_swap_b32 %0, %1" : "+v"(a), "+v"(b));
                g[i] = a + b;
            }
#pragma unroll
            for (int i = 0; i < 4; ++i) {
                float a = g[i], b = g[i + 4];
                asm("s_nop 1\n\tv_permlane16_swap_b32 %0, %1" : "+v"(a), "+v"(b));
                g[i] = a + b;
            }
            {
                const bool up = (lane & 8) != 0;
#pragma unroll
                for (int i = 0; i < 2; ++i) {
                    const float keep = up ? g[i + 2] : g[i], send = up ? g[i] : g[i + 2];
                    g[i] = keep + dppf<0x128>(send);
                }
            }
            {
                const bool up = (lane & 4) != 0;
                const float keep = up ? g[1] : g[0], send = up ? g[0] : g[1];
                g[0] = keep + dppf<0x141>(send);
            }
            g[0] += dppf<0x4E>(g[0]); g[0] += dppf<0xB1>(g[0]);
            if ((lane & 3) == 0) gates[(size_t)row * 8 + (lane >> 2)] = g[0];
            }
#pragma unroll
            for (int i = 0; i < 8; ++i) v[i] = vn[i];
        }
    }
    if (parts & 2) {
        float2* cs = (float2*)(ws + OFF_CS);
        const int gt = blockIdx.x * NTHR + tid, nt = gridDim.x * NTHR;
        for (int idx = gt; idx < T_ * 32; idx += nt) {
            const int tok = idx >> 5, i = idx & 31;
            const double ang = (double)uni(p.pos)[tok] * INV_FREQ[i];
            const double turns = ang * 0.15915494309189535;
            const float f = (float)(turns - rint(turns));
            cs[idx] = make_float2(__builtin_amdgcn_cosf(f), __builtin_amdgcn_sinf(f));
        }
        {
            bf16_t* wrt = (bf16_t*)(ws + OFF_WRT);
            const float* wrg = uni(p.w_rg); const float* wre = uni(p.w_re);
            for (int idx = gt; idx < 256 * 1024; idx += nt) {
                const int c = idx >> 10, k = idx & 1023;
                unsigned a = 0u, b2 = 0u;
                if (c < 144) {
                    const int cc = c < 72 ? c : c - 72;
                    const float w = cc < 8 ? wrg[k * 8 + cc] : wre[k * 64 + (cc - 8)];
                    const unsigned hi = pk_bf16(w, w) & 0xffffu;
                    if (c < 72) { a = hi; b2 = hi; }
                    else { const float lo = w - bf_lo(hi); a = pk_bf16(lo, lo) & 0xffffu; }
                }
                wrt[(size_t)c * 2048 + k] = (bf16_t)a; wrt[(size_t)c * 2048 + 1024 + k] = (bf16_t)b2;
            }
        }
        bf16_t* memb = (bf16_t*)(ws + OFF_MEMB);
        for (int idx = gt; idx < 4096 * 1024 / 4; idx += nt) {
            const float4 v = ((const float4*)uni(p.mem))[idx];
            uint2 w; w.x = pk_bf16(v.x, v.y); w.y = pk_bf16(v.z, v.w);
            ((uint2*)memb)[idx] = w;
        }
    }
    if (parts & 4) {
        float* tile = (float*)smem;
        const int NQ_WIN = 16 * 50, NQ_SQ = 16 * 8, NQ_XKV = 16 * 16;
        const int total = NQ_WIN + 5 * NQ_SQ + NQ_XKV;
        const float* win = uni(p.w_in);
        for (int t = blockIdx.x; t < total; t += gridDim.x) {
            if (t < NQ_WIN) {
                const int kt = t & 15, qd = t >> 4;
                const float* srcs[4] = {win, win, win, win}; int c0[4];
#pragma unroll
                for (int g = 0; g < 4; ++g) {
                    const int n0 = (qd * 4 + g) * 32;
                    if (n0 < 1280) { const int pn = n0 >> 8, bj = (n0 >> 7) & 1, wc = (n0 >> 5) & 3; c0[g] = (4 * pn + wc) * 64 + 32 * bj; }
                    else if (n0 < 4352) c0[g] = n0;
                    else { const int pn = n0 >> 8, bj = (n0 >> 7) & 1, wc = (n0 >> 5) & 3; c0[g] = 4360 + bj * 1024 + 128 * (pn - 17) + 32 * wc; }
                }
                tr_tile4<true>(srcs, c0, 6408, kt * 64, (bf16_t*)(ws + OFF_WIN), 1024, qd * 128, tile, tid);
            } else if (t < NQ_WIN + 5 * NQ_SQ) {
                const int u = t - NQ_WIN, which = u / NQ_SQ, v = u % NQ_SQ, kt = v & 15, qd = v >> 4;
                const float* src = which == 0 ? uni(p.w_att) : which == 1 ? uni(p.w_ml) : which == 2 ? uni(p.w_mix) : which == 3 ? uni(p.w_xq) : uni(p.w_xo);
                const float* srcs[4] = {src, src, src, src}; const int c0[4] = {qd * 128, qd * 128 + 32, qd * 128 + 64, qd * 128 + 96};
                tr_tile4<true>(srcs, c0, 1024, kt * 64, (bf16_t*)(ws + OFF_WATT + (size_t)which * 2 * MiB), 1024, qd * 128, tile, tid);
            } else {
                const int v = t - NQ_WIN - 5 * NQ_SQ, kt = v & 15, qd = v >> 4;
                const float* src = uni(p.w_xkv);
                const float* srcs[4] = {src, src, src, src}; const int c0[4] = {qd * 128, qd * 128 + 32, qd * 128 + 64, qd * 128 + 96};
                if (qd < 8) tr_tile4<true>(srcs, c0, 2048, kt * 64, (bf16_t*)(ws + OFF_WXKV), 1024, qd * 128, tile, tid);
                else tr_tile4<false>(srcs, c0, 2048, kt * 64, (bf16_t*)(ws + OFF_WXKV), 1024, qd * 128, tile, tid);
            }
        }
    }
}

__device__ __forceinline__ void moe_weight_prep(const Params& p, char* smem, int first, int stride) {
    const int tid = opaque_tid();
    float* tile = (float*)smem;
    char* ws = uni(p.ws);
    const int per_e = 96, total = 64 * per_e;
    __syncthreads();
    for (int t = first; t < total; t += stride) {
        const int e = t / per_e, u = t % per_e;
        if (u < 64) {
            const int kt = u & 15, qd = u >> 4, pn = qd >> 1, bj = qd & 1;
            const float* src = (bj ? uni(p.w_up) : uni(p.w_gate)) + (size_t)e * 1024 * 256;
            const float* srcs[4] = {src, src, src, src}; const int c0[4] = {pn * 128, pn * 128 + 32, pn * 128 + 64, pn * 128 + 96};
            tr_tile4<true>(srcs, c0, 256, kt * 64, (bf16_t*)(ws + OFF_WGU) + (size_t)e * 512 * 1024, 1024, qd * 128, tile, tid);
        } else {
            const int v = u - 64, kt = v & 3, qd = v >> 2;
            const float* dsrc = uni(p.w_down) + (size_t)e * 256 * 1024;
            const float* srcs[4] = {dsrc, dsrc, dsrc, dsrc}; const int c0[4] = {qd * 128, qd * 128 + 32, qd * 128 + 64, qd * 128 + 96};
            tr_tile4<true>(srcs, c0, 1024, kt * 64, (bf16_t*)(ws + OFF_WD) + (size_t)e * 1024 * 256, 256, qd * 128, tile, tid);
        }
    }
}

struct SchedP1 {
    int G, c; const char *xb, *win, *memb, *wxkv;
    __device__ __forceinline__ bool next(int i, pg8::Unit& u) const {
        int nmain, uidx;
        if (G == 256) { nmain = 25; const int x = c & 7, j = c >> 3; uidx = i * 32 + j; if (i < 25) { const int g = uidx / 100, v = uidx % 100; u.pm = 32 * x + 4 * g + (v & 3); u.pn = v >> 2; } }
        else { nmain = c < 6400 ? (6400 - 1 - c) / G + 1 : 0; uidx = i * G + c; if (i < nmain) { u.pm = uidx / 25; u.pn = uidx % 25; } }
        if (i < nmain) { u.aux = 0; u.A = xb; u.Bt = win; return true; }
        return false;
    }
};

struct SchedKV {
    int first, stride; const char *memb, *wxkv;
    __device__ __forceinline__ bool next(int i, pg8::Unit& u) const {
        const int kv = first + i * stride;
        if (kv >= 128) return false;
        if (kv < 64) { u.aux = 1; u.pm = kv >> 2; u.pn = kv & 3; u.A = memb; u.Bt = wxkv; }
        else { const int k2 = kv - 64; u.aux = 2; u.pm = k2 >> 4; u.pn = k2 & 15; u.A = wxkv + (size_t)1024 * 1024 * 2; u.Bt = memb; }
        return true;
    }
};
struct EpiP1 {
    char* ws; int skip;
    __device__ __forceinline__ void operator()(f32x4 (&acc)[2][2][4][2], const pg8::Unit& u, int wr, int wc, int fr, int fq) const {
        if (skip == 1) {
#pragma unroll
            for (int a = 0; a < 2; ++a)
#pragma unroll
                for (int b = 0; b < 2; ++b)
#pragma unroll
                    for (int m = 0; m < 4; ++m) { asm volatile("" :: "v"(acc[a][b][m][0]), "v"(acc[a][b][m][1])); }
            return;
        }
        const int row0 = u.pm * 256 + wr * 64 + fr;
        if (u.aux == 0 && u.pn < 5) {
            const int hidx = 4 * u.pn + wc;
            if (hidx < 18) {
                bf16_t* dst; int ld, cb; float sc;
                if (hidx < 16) { dst = (bf16_t*)(ws + OFF_R1); ld = 1024; cb = hidx * 64; sc = 0.125f; }
                else { dst = (bf16_t*)(ws + OFF_AK); ld = 128; cb = (hidx - 16) * 64; sc = 1.0f; }
                const float* cs = (const float*)(ws + OFF_CS);
                const int d1 = 8 * fq;
#pragma unroll
                for (int ai = 0; ai < 2; ++ai)
#pragma unroll
                    for (int m = 0; m < 4; ++m) {
                        const int tok = row0 + ai * 128 + m * 16;
                        const float4* cp = (const float4*)(cs + (size_t)tok * 64 + d1 * 2);
                        const float4 c0 = cp[0], c1 = cp[1], c2 = cp[2], c3 = cp[3];
                        const f32x4 x1a = acc[ai][0][m][0], x1b = acc[ai][0][m][1], x2a = acc[ai][1][m][0], x2b = acc[ai][1][m][1];
                        f32x4 o1a, o1b, o2a, o2b;
                        o1a[0] = (x1a[0] * c0.x - x2a[0] * c0.y) * sc; o2a[0] = (x2a[0] * c0.x + x1a[0] * c0.y) * sc;
                        o1a[1] = (x1a[1] * c0.z - x2a[1] * c0.w) * sc; o2a[1] = (x2a[1] * c0.z + x1a[1] * c0.w) * sc;
                        o1a[2] = (x1a[2] * c1.x - x2a[2] * c1.y) * sc; o2a[2] = (x2a[2] * c1.x + x1a[2] * c1.y) * sc;
                        o1a[3] = (x1a[3] * c1.z - x2a[3] * c1.w) * sc; o2a[3] = (x2a[3] * c1.z + x1a[3] * c1.w) * sc;
                        o1b[0] = (x1b[0] * c2.x - x2b[0] * c2.y) * sc; o2b[0] = (x2b[0] * c2.x + x1b[0] * c2.y) * sc;
                        o1b[1] = (x1b[1] * c2.z - x2b[1] * c2.w) * sc; o2b[1] = (x2b[1] * c2.z + x1b[1] * c2.w) * sc;
                        o1b[2] = (x1b[2] * c3.x - x2b[2] * c3.y) * sc; o2b[2] = (x2b[2] * c3.x + x1b[2] * c3.y) * sc;
                        o1b[3] = (x1b[3] * c3.z - x2b[3] * c3.w) * sc; o2b[3] = (x2b[3] * c3.z + x1b[3] * c3.w) * sc;
                        bf16_t* rp = dst + (size_t)tok * ld + cb + d1;
                        if (skip == 2) { asm volatile("" :: "v"(o1a), "v"(o1b), "v"(o2a), "v"(o2b)); } else { store_bf16x8(rp, o1a, o1b); store_bf16x8(rp + 32, o2a, o2b); }
                    }
            } else {
                bf16_t* avT = (bf16_t*)(ws + OFF_AV);
#pragma unroll
                for (int bj = 0; bj < 2; ++bj)
#pragma unroll
                    for (int ai = 0; ai < 2; ++ai)
#pragma unroll
                        for (int m = 0; m < 4; ++m)
#pragma unroll
                            for (int n = 0; n < 2; ++n)
#pragma unroll
                                for (int j = 0; j < 4; ++j)
                                    avT[(size_t)((hidx - 18) * 64 + 32 * bj + 8 * fq + 4 * n + j) * T_ + row0 + ai * 128 + m * 16] = (bf16_t)(pk_bf16(acc[ai][bj][m][n][j], acc[ai][bj][m][n][j]) & 0xffffu);
            }
            return;
        }
        if (u.aux == 0 && u.pn >= 17 && u.pn < 25) {
            bf16_t* gg = (bf16_t*)(ws + OFF_GG);
            const int col = 128 * (u.pn - 17) + 32 * wc + 8 * fq;
#pragma unroll
            for (int ai = 0; ai < 2; ++ai)
#pragma unroll
                for (int m = 0; m < 4; ++m) {
                    f32x4 r0, r1, s0, s1;
#pragma unroll
                    for (int j = 0; j < 4; ++j) {
                        s0[j] = sigmoidf_(acc[ai][1][m][0][j]); s1[j] = sigmoidf_(acc[ai][1][m][1][j]);
                        r0[j] = sigmoidf_(acc[ai][0][m][0][j]) * __builtin_amdgcn_rcpf(fmaxf(s0[j], 1e-30f));
                        r1[j] = sigmoidf_(acc[ai][0][m][1][j]) * __builtin_amdgcn_rcpf(fmaxf(s1[j], 1e-30f));
                    }
                    bf16_t* rp = gg + (size_t)(row0 + ai * 128 + m * 16) * 2048 + col;
                    if (skip == 2) { asm volatile("" :: "v"(r0), "v"(r1), "v"(s0), "v"(s1)); } else { store_bf16x8(rp, r0, r1); store_bf16x8(rp + 1024, s0, s1); }
                }
            return;
        }
#pragma unroll
        for (int bj = 0; bj < 2; ++bj) {
            const int c32 = u.pn * 256 + bj * 128 + wc * 32;
            if (u.aux == 2) {
                bf16_t* dst = (bf16_t*)(ws + OFF_VT);
#pragma unroll
                for (int ai = 0; ai < 2; ++ai)
#pragma unroll
                    for (int m = 0; m < 4; ++m) {
                        bf16_t* rp = dst + (size_t)(row0 + ai * 128 + m * 16) * 4096 + c32 + fq * 4;
                        store_bf16x4(rp, acc[ai][bj][m][0]); store_bf16x4(rp + 16, acc[ai][bj][m][1]);
                    }
            } else {
                bf16_t* dst; int ld, cb; bool sig = false;
                if (u.aux == 1) { dst = (bf16_t*)(ws + OFF_KMAT); ld = 1024; cb = c32; }
                else if (c32 < 2304) { dst = (bf16_t*)(ws + OFF_MQK); ld = 1024; cb = c32 - 1280; }
                else if (c32 < 3328) { dst = (bf16_t*)(ws + OFF_MV); ld = 1024; cb = c32 - 2304; }
                else if (c32 < 4352) { dst = (bf16_t*)(ws + OFF_MO); ld = 1024; cb = c32 - 3328; sig = true; }
                else { dst = (bf16_t*)(ws + OFF_GG); ld = 2048; cb = c32 - 4352; sig = true; }
#pragma unroll
                for (int ai = 0; ai < 2; ++ai)
#pragma unroll
                    for (int m = 0; m < 4; ++m) {
                        f32x4 v0 = acc[ai][bj][m][0], v1 = acc[ai][bj][m][1];
                        if (sig) {
                            v0[0] = sigmoidf_(v0[0]); v0[1] = sigmoidf_(v0[1]); v0[2] = sigmoidf_(v0[2]); v0[3] = sigmoidf_(v0[3]);
                            v1[0] = sigmoidf_(v1[0]); v1[1] = sigmoidf_(v1[1]); v1[2] = sigmoidf_(v1[2]); v1[3] = sigmoidf_(v1[3]);
                        }
                        if (skip == 2) { asm volatile("" :: "v"(v0), "v"(v1)); } else store_bf16x8(dst + (size_t)(row0 + ai * 128 + m * 16) * ld + cb + fq * 8, v0, v1);
                    }
            }
        }
    }
};

__device__ __forceinline__ void phase1(const Params& p, char* smem, int skip_epi = 0) {
    char* ws = uni(p.ws);
    SchedP1 S{(int)gridDim.x, (int)blockIdx.x, ws + OFF_R0, ws + OFF_WIN, ws + OFF_MEMB, ws + OFF_WXKV};
    EpiP1 E{ws, skip_epi};
    pg8::gemm_phase<EpiP1, SchedP1>((LDS_AS unsigned char*)smem, 1024, S, E, 0);
}

__device__ __forceinline__ void kv_projection(const Params& p, char* smem, int first, int stride) {
    char* ws = uni(p.ws);
    __syncthreads();
    SchedKV S{first, stride, ws + OFF_MEMB, ws + OFF_WXKV};
    EpiP1 E{ws, 0};
    pg8::gemm_phase<EpiP1, SchedKV>((LDS_AS unsigned char*)smem, 1024, S, E);
}

template <int NPASS>
struct SchedN1024 {
    int G, c; const char* A0; const char* B0; const char* A1; const char* B1;
    __device__ __forceinline__ bool next(int i, pg8::Unit& u) const {
        const int ti = i / NPASS, pass = i % NPASS;
        int uidx;
        if (G == 256) { if (ti >= 4) return false; const int x = c & 7, j = c >> 3; uidx = ti * 32 + j; u.pm = 32 * x + (uidx >> 2); u.pn = uidx & 3; }
        else { uidx = ti * G + c; if (uidx >= 1024) return false; u.pm = uidx >> 2; u.pn = uidx & 3; }
        u.aux = pass | ((NPASS == 2 && pass == 0) ? 0x100 : 0); u.A = pass ? A1 : A0; u.Bt = pass ? B1 : B0;
        return true;
    }
};

typedef short v4i16_t __attribute__((ext_vector_type(4)));
__device__ __forceinline__ int offQK(int row, int ch) { return row * 256 + ((ch ^ (((row & 3) << 2) | ((row >> 2) & 3))) << 4); }
__device__ __forceinline__ int offV(int row, int ch) { return row * 512 + ((ch ^ (((row & 3) | (((row >> 3) & 1) << 2)) << 1)) << 4); }
__device__ __forceinline__ int offSw(int row, int ch) { return row * 128 + ((ch ^ ((row >> 1) & 7)) << 4); }
__device__ __forceinline__ bf16x8 tr_read2(const char* p0, const char* p1) {
    const v4i16_t a = __builtin_amdgcn_ds_read_tr16_b64_v4i16((LDS_AS v4i16_t*)p0);
    const v4i16_t b = __builtin_amdgcn_ds_read_tr16_b64_v4i16((LDS_AS v4i16_t*)p1);
    return __builtin_shufflevector(a, b, 0, 1, 2, 3, 4, 5, 6, 7);
}
__device__ __forceinline__ float row16_sum(float v) {
    v += __builtin_bit_cast(float, __builtin_amdgcn_update_dpp(0, __builtin_bit_cast(int, v), 0xB1, 0xf, 0xf, true));
    v += __builtin_bit_cast(float, __builtin_amdgcn_update_dpp(0, __builtin_bit_cast(int, v), 0x4E, 0xf, 0xf, true));
    v += __builtin_bit_cast(float, __builtin_amdgcn_update_dpp(0, __builtin_bit_cast(int, v), 0x141, 0xf, 0xf, true));
    v += __builtin_bit_cast(float, __builtin_amdgcn_update_dpp(0, __builtin_bit_cast(int, v), 0x140, 0xf, 0xf, true));
    return v;
}

constexpr int PP_Q = 0, PP_K = 16384, PP_S = 32768, PP_REC = 40960, PP_EB = 41984, PP_EK = 42240, PP_CSP = 42496  , PP_RSP = 44544  , PP_END = 45056;
__device__ __forceinline__ void ml_prepass_item(const Params& p, char* smem, int item) {
    const int tid = opaque_tid(), lane = tid & 63, wid = tid >> 6, fr = lane & 15, fq = lane >> 4;
    const int c = item & 63, bh = item >> 6, b = bh >> 2, h = bh & 3;
    char* ws = uni(p.ws);
    const bf16_t* mqk = (const bf16_t*)(ws + OFF_MQK);
    const float* gates = (const float*)(ws + OFF_GATES);
    float* rec = (float*)(smem + PP_REC); float* eb = (float*)(smem + PP_EB); float* ek = (float*)(smem + PP_EK);
    float* csp = (float*)(smem + PP_CSP); float* rsp = (float*)(smem + PP_RSP);
    const long tok0 = (long)b * 4096 + c * 64;
    const int cp = tid & 127, tg = tid >> 7;
    const bool isk = cp >= 64;
    const int dch = isk ? 2 * (cp - 64) : 2 * cp;
    const int ccol = isk ? (512 + h * 128 + dch) : (h * 128 + dch);
    unsigned r[19];
#pragma unroll
    for (int i = 0; i < 19; ++i) {
        const int tl = tg * 16 - 3 + i;
        r[i] = (c == 0 && tl < 0) ? 0u : *(const unsigned*)(mqk + (tok0 + tl) * 1024 + ccol);
    }
    float cw0[4], cw1[4];
#pragma unroll
    for (int j = 0; j < 4; ++j) { cw0[j] = uni(p.conv_w)[j * 1024 + ccol]; cw1[j] = uni(p.conv_w)[j * 1024 + ccol + 1]; }
    const float cb0 = uni(p.conv_b)[ccol], cb1 = uni(p.conv_b)[ccol + 1];
    if (wid == 0) {
        const float mi0 = gates[(tok0 + lane) * 8 + h] + uni(p.b_ig)[h], x = gates[(tok0 + lane) * 8 + 4 + h] + uni(p.b_fg)[h];
        float bs = fminf(x, 0.f) - log1pf(__expf(-fabsf(x)));
#pragma unroll
        for (int o = 1; o < 64; o <<= 1) { const float y = __shfl_up(bs, o); if (lane >= o) bs += y; }
        eb[lane] = __expf(bs); ek[lane] = __expf(mi0 - bs);
        if (lane == 63) rec[192] = __expf(bs);
    }
    __syncthreads();
    {
        const int tt0 = tg * 16;
        float cs0 = 0.f, cs1 = 0.f;
        const float* scp = (isk ? ek : eb) + tt0;
        char* dstb = smem + (isk ? PP_K : PP_Q) + (dch & 7) * 2;
        const float kmul = isk ? 0.08838834764831845f : 1.0f;
#pragma unroll
        for (int tt = 0; tt < 16; ++tt) {
            float v0 = cb0 + cw0[0] * bf_lo(r[tt]) + cw0[1] * bf_lo(r[tt + 1]) + cw0[2] * bf_lo(r[tt + 2]) + cw0[3] * bf_lo(r[tt + 3]);
            float v1 = cb1 + cw1[0] * bf_hi(r[tt]) + cw1[1] * bf_hi(r[tt + 1]) + cw1[2] * bf_hi(r[tt + 2]) + cw1[3] * bf_hi(r[tt + 3]);
            v0 = v0 * sigmoidf_(v0); v1 = v1 * sigmoidf_(v1);
            const float sc = scp[tt] * kmul;
            const float a0 = v0 * sc, a1 = v1 * sc;
            *(unsigned*)(dstb + offQK(tt0 + tt, dch >> 3)) = pk_bf16(a0, a1);
            cs0 += a0; cs1 += a1;
        }
        if (isk) { csp[tg * 128 + dch] = cs0; csp[tg * 128 + dch + 1] = cs1; }
    }
    __syncthreads();
    {
        const int tt = wid >> 1;
        bf16x8 qf[4];
#pragma unroll
        for (int ks = 0; ks < 4; ++ks) qf[ks] = *(const bf16x8*)(smem + PP_Q + offQK(tt * 16 + fr, 4 * ks + fq));
        float rs = 0.f;
#pragma unroll
        for (int x = 0; x < 2; ++x) {
            const int st = (wid & 1) * 2 + x;
            f32x4 a = (f32x4){0.f, 0.f, 0.f, 0.f};
#pragma unroll
            for (int ks = 0; ks < 4; ++ks) {
                const bf16x8 kf = *(const bf16x8*)(smem + PP_K + offQK(st * 16 + fr, 4 * ks + fq));
                a = __builtin_amdgcn_mfma_f32_16x16x32_bf16(kf, qf[ks], a, 0, 0, 0);
            }
#pragma unroll
            for (int j = 0; j < 4; ++j) a[j] = (st * 16 + fq * 4 + j) <= (tt * 16 + fr) ? a[j] : 0.f;
            rs += (a[0] + a[1]) + (a[2] + a[3]);
            uint2 w; w.x = pk_bf16(a[0], a[1]); w.y = pk_bf16(a[2], a[3]);
            *(uint2*)(smem + PP_S + offSw(tt * 16 + fr, st * 2 + (fq >> 1)) + (fq & 1) * 8) = w;
        }
        rs += __shfl_xor(rs, 16); rs += __shfl_xor(rs, 32);
        if (fq == 0) rsp[(wid & 1) * 64 + tt * 16 + fr] = rs;
        if (tid < 128) rec[64 + tid] = (csp[tid] + csp[128 + tid]) + (csp[256 + tid] + csp[384 + tid]);
    }
    __syncthreads();
    if (tid < 64) rec[tid] = rsp[tid] + rsp[64 + tid];
    __syncthreads();
    {
        char* qp = (char*)uni(p.out) + OUT_QP + (size_t)item * 16384;
        char* kp = (char*)uni(p.out) + OUT_KP + (size_t)item * 16384;
        char* sp = ws + OFF_SP + (size_t)item * 8192;
        char* rp = ws + OFF_REC + (size_t)item * 1024;
#pragma unroll
        for (int i = 0; i < 2; ++i) {
            *(u32x4*)(qp + (i * 512 + tid) * 16) = *(const u32x4*)(smem + PP_Q + (i * 512 + tid) * 16);
            *(u32x4*)(kp + (i * 512 + tid) * 16) = *(const u32x4*)(smem + PP_K + (i * 512 + tid) * 16);
        }
        *(u32x4*)(sp + tid * 16) = *(const u32x4*)(smem + PP_S + tid * 16);
        if (tid < 64) *(u32x4*)(rp + tid * 16) = *(const u32x4*)(smem + PP_REC + tid * 16);
    }
    __syncthreads();
}

constexpr int SC_BUF = 41984;
constexpr int SC_V = 2 * SC_BUF;
constexpr int SC_NBF = SC_V + 65536;
constexpr int SC_END = SC_NBF + 512;
__device__ __forceinline__ void ml_scan(const Params& p, char* smem, int bh, const int mode = 0) {
    const int tid = opaque_tid(), lane = tid & 63, wid = tid >> 6, fr0 = lane & 15, fq0 = lane >> 4;
    const int b = bh >> 2, h = bh & 3;
    char* ws = uni(p.ws);
    const bf16_t* mv = (const bf16_t*)(ws + OFF_MV);
    bf16_t* hm = (bf16_t*)uni(p.out);
    float* ssqp = (float*)(ws + OFF_SSQP);
    const long tokb = (long)b * 4096;
    f32x4 C[8][2];
#pragma unroll
    for (int dt = 0; dt < 8; ++dt) { C[dt][0] = (f32x4){0.f, 0.f, 0.f, 0.f}; C[dt][1] = (f32x4){0.f, 0.f, 0.f, 0.f}; }
    const int vrl = tid >> 5, vpc = tid & 31, vlc = vpc ^ ((((vrl & 3) | (((vrl >> 3) & 1) << 2))) << 1);
    const bf16_t* vsrc = mv + (tokb + vrl) * 1024 + h * 256 + vlc * 8;
    const char* qp = (const char*)uni(p.out) + OUT_QP + (size_t)bh * 64 * 16384;
    const char* kp = (const char*)uni(p.out) + OUT_KP + (size_t)bh * 64 * 16384;
    const char* sp = ws + OFF_SP + (size_t)bh * 64 * 8192;
    const char* rp = ws + OFF_REC + (size_t)bh * 64 * 1024;
#define SC_STAGE(cc, bufoff) do { \
        _Pragma("unroll") for (int _i = 0; _i < 2; ++_i) { \
            glds16((const bf16_t*)(qp + (size_t)(cc) * 16384 + (_i * 512 + tid) * 16), smem + (bufoff) + (_i * 512 + tid) * 16); \
            glds16((const bf16_t*)(kp + (size_t)(cc) * 16384 + (_i * 512 + tid) * 16), smem + (bufoff) + 16384 + (_i * 512 + tid) * 16); } \
        glds16((const bf16_t*)(sp + (size_t)(cc) * 8192 + tid * 16), smem + (bufoff) + 32768 + tid * 16); \
        if (tid < 64) glds16((const bf16_t*)(rp + (size_t)(cc) * 1024 + tid * 16), smem + (bufoff) + 40960 + tid * 16); \
        _Pragma("unroll") for (int _i = 0; _i < 4; ++_i) glds16(vsrc + (long)(cc) * 64 * 1024 + (long)_i * 16 * 1024, smem + SC_V + ((cc) & 1) * 32768 + (_i * 512 + tid) * 16); } while (0)
    __syncthreads();
    if (tid < 256) ((bf16_t*)(smem + SC_NBF))[tid] = 0;
    float nreg = 0.f;
    SC_STAGE(0, 0);
    asm volatile("s_waitcnt vmcnt(0)" ::: "memory");
#pragma unroll 1
    for (int c = 0; c < 64; ++c) {
        const int par = c & 1;
        const long tok0 = tokb + c * 64;
        int fr = fr0, fq = fq0;
        asm volatile("" : "+v"(fr), "+v"(fq));
        const char* buf = smem + par * SC_BUF;
        asm volatile("s_waitcnt vmcnt(10) lgkmcnt(0)" ::: "memory");
        __builtin_amdgcn_s_barrier();
        if (c + 1 < 64 && !(mode & 1)) SC_STAGE(c + 1, (par ^ 1) * SC_BUF);
        f32x4 Y[4][2], DN[4];
#pragma unroll
        for (int tt = 0; tt < 4; ++tt) { Y[tt][0] = (f32x4){0.f, 0.f, 0.f, 0.f}; Y[tt][1] = (f32x4){0.f, 0.f, 0.f, 0.f}; DN[tt] = (f32x4){0.f, 0.f, 0.f, 0.f}; }
        const char* nbf = smem + SC_NBF + par * 256;
        const char* vb = smem + SC_V + par * 32768;
#define SC_LDC(ks, A, NB) do { \
            const u32x2 nlo_ = *(const u32x2*)(nbf + (32 * (ks) + 4 * fq) * 2), nhi_ = *(const u32x2*)(nbf + (32 * (ks) + 16 + 4 * fq) * 2); \
            u32x4 nv_; nv_[0] = nlo_[0]; nv_[1] = nlo_[1]; nv_[2] = nhi_[0]; nv_[3] = nhi_[1]; NB = __builtin_bit_cast(bf16x8, nv_); \
            _Pragma("unroll") for (int tt_ = 0; tt_ < 4; ++tt_) { \
                const u32x2 lo_ = *(const u32x2*)(buf + offQK(tt_ * 16 + fr, 4 * (ks) + (fq >> 1)) + (fq & 1) * 8); \
                const u32x2 hi_ = *(const u32x2*)(buf + offQK(tt_ * 16 + fr, 4 * (ks) + 2 + (fq >> 1)) + (fq & 1) * 8); \
                u32x4 av_; av_[0] = lo_[0]; av_[1] = lo_[1]; av_[2] = hi_[0]; av_[3] = hi_[1]; A[tt_] = __builtin_bit_cast(bf16x8, av_); } } while (0)
#define SC_MMC(ks, A, NB) do { \
            u32x4 c0_, c1_; \
            c0_[0] = pk_bf16(C[2 * (ks)][0][0], C[2 * (ks)][0][1]); c0_[1] = pk_bf16(C[2 * (ks)][0][2], C[2 * (ks)][0][3]); \
            c0_[2] = pk_bf16(C[2 * (ks) + 1][0][0], C[2 * (ks) + 1][0][1]); c0_[3] = pk_bf16(C[2 * (ks) + 1][0][2], C[2 * (ks) + 1][0][3]); \
            c1_[0] = pk_bf16(C[2 * (ks)][1][0], C[2 * (ks)][1][1]); c1_[1] = pk_bf16(C[2 * (ks)][1][2], C[2 * (ks)][1][3]); \
            c1_[2] = pk_bf16(C[2 * (ks) + 1][1][0], C[2 * (ks) + 1][1][1]); c1_[3] = pk_bf16(C[2 * (ks) + 1][1][2], C[2 * (ks) + 1][1][3]); \
            const bf16x8 cf0_ = __builtin_bit_cast(bf16x8, c0_), cf1_ = __builtin_bit_cast(bf16x8, c1_); \
            _Pragma("unroll") for (int tt_ = 0; tt_ < 4; ++tt_) { \
                Y[tt_][0] = __builtin_amdgcn_mfma_f32_16x16x32_bf16(A[tt_], cf0_, Y[tt_][0], 0, 0, 0); \
                Y[tt_][1] = __builtin_amdgcn_mfma_f32_16x16x32_bf16(A[tt_], cf1_, Y[tt_][1], 0, 0, 0); \
                DN[tt_] = __builtin_amdgcn_mfma_f32_16x16x32_bf16(A[tt_], NB, DN[tt_], 0, 0, 0); } } while (0)
#define SC_SCHED __builtin_amdgcn_sched_barrier(0)
        bf16x8 A0[4], A1[4], nb0, nb1;
        SC_LDC(0, A0, nb0);
        SC_LDC(1, A1, nb1); SC_SCHED; SC_MMC(0, A0, nb0); SC_SCHED;
        SC_LDC(2, A0, nb0); SC_SCHED; SC_MMC(1, A1, nb1); SC_SCHED;
        SC_LDC(3, A1, nb1); SC_SCHED; SC_MMC(2, A0, nb0); SC_SCHED;
        bf16x8 vf[2][2], sf[2][4];
#pragma unroll
        for (int ks = 0; ks < 2; ++ks)
#pragma unroll
            for (int et = 0; et < 2; ++et) {
                const int cidx = 2 * wid + et, ch = 2 * cidx + ((fr & 3) >> 1);
                const int r0 = 32 * ks + 8 * fq + (fr >> 2);
                vf[ks][et] = tr_read2(vb + offV(r0, ch) + 8 * (fr & 1), vb + offV(r0 + 4, ch) + 8 * (fr & 1));
            }
#pragma unroll
        for (int ks = 0; ks < 2; ++ks)
#pragma unroll
            for (int tt = 0; tt < 4; ++tt) sf[ks][tt] = *(const bf16x8*)(buf + 32768 + offSw(tt * 16 + fr, 4 * ks + fq));
        SC_SCHED; SC_MMC(3, A1, nb1); SC_SCHED;
#define SC_LDK(dt, ks, KF) do { const int ch_ = 2 * (dt) + ((fr & 3) >> 1); const int r0_ = 32 * (ks) + 8 * fq + (fr >> 2); \
            KF = tr_read2(buf + 16384 + offQK(r0_, ch_) + 8 * (fr & 1), buf + 16384 + offQK(r0_ + 4, ch_) + 8 * (fr & 1)); } while (0)
        bf16x8 kfa[4], kfb[4];
        SC_LDK(0, 0, kfa[0]); SC_LDK(0, 1, kfa[1]); SC_LDK(1, 0, kfa[2]); SC_LDK(1, 1, kfa[3]);
        SC_SCHED;
#pragma unroll
        for (int ks = 0; ks < 2; ++ks)
#pragma unroll
            for (int tt = 0; tt < 4; ++tt) {
                Y[tt][0] = __builtin_amdgcn_mfma_f32_16x16x32_bf16(sf[ks][tt], vf[ks][0], Y[tt][0], 0, 0, 0);
                Y[tt][1] = __builtin_amdgcn_mfma_f32_16x16x32_bf16(sf[ks][tt], vf[ks][1], Y[tt][1], 0, 0, 0);
            }
        SC_SCHED;
#define SC_MMK(dt0, KF) do { \
            C[dt0][0] = __builtin_amdgcn_mfma_f32_16x16x32_bf16(KF[0], vf[0][0], C[dt0][0], 0, 0, 0); C[dt0][1] = __builtin_amdgcn_mfma_f32_16x16x32_bf16(KF[0], vf[0][1], C[dt0][1], 0, 0, 0); \
            C[dt0][0] = __builtin_amdgcn_mfma_f32_16x16x32_bf16(KF[1], vf[1][0], C[dt0][0], 0, 0, 0); C[dt0][1] = __builtin_amdgcn_mfma_f32_16x16x32_bf16(KF[1], vf[1][1], C[dt0][1], 0, 0, 0); \
            C[dt0 + 1][0] = __builtin_amdgcn_mfma_f32_16x16x32_bf16(KF[2], vf[0][0], C[dt0 + 1][0], 0, 0, 0); C[dt0 + 1][1] = __builtin_amdgcn_mfma_f32_16x16x32_bf16(KF[2], vf[0][1], C[dt0 + 1][1], 0, 0, 0); \
            C[dt0 + 1][0] = __builtin_amdgcn_mfma_f32_16x16x32_bf16(KF[3], vf[1][0], C[dt0 + 1][0], 0, 0, 0); C[dt0 + 1][1] = __builtin_amdgcn_mfma_f32_16x16x32_bf16(KF[3], vf[1][1], C[dt0 + 1][1], 0, 0, 0); } while (0)
        SC_LDK(2, 0, kfb[0]); SC_LDK(2, 1, kfb[1]); SC_LDK(3, 0, kfb[2]); SC_LDK(3, 1, kfb[3]); SC_SCHED; SC_MMK(0, kfa); SC_SCHED;
        SC_LDK(4, 0, kfa[0]); SC_LDK(4, 1, kfa[1]); SC_LDK(5, 0, kfa[2]); SC_LDK(5, 1, kfa[3]); SC_SCHED; SC_MMK(2, kfb); SC_SCHED;
        SC_LDK(6, 0, kfb[0]); SC_LDK(6, 1, kfb[1]); SC_LDK(7, 0, kfb[2]); SC_LDK(7, 1, kfb[3]); SC_SCHED; SC_MMK(4, kfa); SC_SCHED;
        SC_MMK(6, kfb); SC_SCHED;
#undef SC_LDC
#undef SC_MMC
#undef SC_LDK
#undef SC_MMK
#undef SC_SCHED
        const float* recf = (const float*)(buf + 40960);
        float* sq_out = ssqp + ((size_t)(bh * 64 + c) * 8 + wid) * 64;
#pragma unroll
        for (int tt = 0; tt < 4; ++tt) {
            const float4 rsv = *(const float4*)(recf + tt * 16 + fq * 4);
            const float dd[4] = {rsv.x + DN[tt][0], rsv.y + DN[tt][1], rsv.z + DN[tt][2], rsv.w + DN[tt][3]};
            float sq[4];
#pragma unroll
            for (int j = 0; j < 4; ++j) {
                const float inv = __builtin_amdgcn_rcpf(fmaxf(fabsf(dd[j]), 1.0f));
                Y[tt][0][j] *= inv; Y[tt][1][j] *= inv;
                sq[j] = row16_sum(Y[tt][0][j] * Y[tt][0][j] + Y[tt][1][j] * Y[tt][1][j]);
            }
            if (!(mode & 4)) {
                if (fr == 0) *(float4*)(sq_out + tt * 16 + fq * 4) = make_float4(sq[0], sq[1], sq[2], sq[3]);
#pragma unroll
                for (int et = 0; et < 2; ++et) {
                    const int e = wid * 32 + et * 16 + fr;
                    store_bf16x4(hm + (tok0 + (e >> 2)) * 1024 + h * 256 + (e & 3) * 64 + tt * 16 + fq * 4, Y[tt][et]);
                }
            } else asm volatile("" :: "v"(Y[tt][0]), "v"(Y[tt][1]), "v"(sq[0]), "v"(sq[1]), "v"(sq[2]), "v"(sq[3]));
        }
        const float g = recf[192];
#pragma unroll
        for (int dt = 0; dt < 8; ++dt) { C[dt][0] *= g; C[dt][1] *= g; }
        if (tid < 128) {
            nreg = g * (nreg + recf[64 + (tid & 127)]);
            ((bf16_t*)(smem + SC_NBF + (par ^ 1) * 256))[tid] = (bf16_t)(pk_bf16(nreg, nreg) & 0xffffu);
        }
    }
    asm volatile("s_waitcnt vmcnt(0) lgkmcnt(0)" ::: "memory");
    __syncthreads();
#undef SC_STAGE
}

__device__ __forceinline__ void ml_finish_item(const Params& p, char* smem, int item) {
    const int tid = opaque_tid(), lane = tid & 63, wid = tid >> 6;
    const int c = item & 63, bh = item >> 6, b = bh >> 2, h = bh & 3;
    char* ws = uni(p.ws);
    bf16_t* hm = (bf16_t*)uni(p.out);
    const bf16_t* mo = (const bf16_t*)(ws + OFF_MO);
    const float* ssqp = (const float*)(ws + OFF_SSQP) + (size_t)item * 512;
    const float* gain = uni(p.ml_g) + h * 256;
    const long tok0 = (long)b * 4096 + c * 64;
    float* rs = (float*)(smem + 32768);
#pragma unroll
    for (int i = 0; i < 4; ++i) {
        const int q = i * 512 + tid;
        glds16(hm + (tok0 + (q >> 5)) * 1024 + h * 256 + (q & 31) * 8, smem + q * 16);
    }
    if (tid < 64) {
        float sacc = 0.f;
#pragma unroll
        for (int w = 0; w < 8; ++w) sacc += ssqp[w * 64 + tid];
        rs[tid] = rsqrtf(sacc * (1.0f / 256.0f) + 1e-6f);
    }
    asm volatile("s_waitcnt vmcnt(0)" ::: "memory");
    __syncthreads();
    const int i16 = lane & 15, g4 = lane >> 4, q4 = i16 >> 2, p4 = i16 & 3;
#pragma unroll
    for (int it = 0; it < 4; ++it) {
        const int combo = wid * 4 + it, tb = combo & 3, eoct = (combo >> 2) * 4 + g4;
        const int t = tb * 16 + i16, e = eoct * 8;
        const char* a0 = smem + (e + q4) * 128 + (tb * 16 + 4 * p4) * 2;
        const bf16x8 hv = tr_read2(a0, a0 + 4 * 128);
        const u32x4 hw = __builtin_bit_cast(u32x4, hv);
        const u32x4 mw = *(const u32x4*)(mo + (tok0 + t) * 1024 + h * 256 + e);
        const float4 ga = *(const float4*)(gain + e), gb = *(const float4*)(gain + e + 4);
        const float r = rs[t];
        u32x4 o;
        o[0] = pk_bf16(bf_lo(hw[0]) * r * ga.x * bf_lo(mw[0]), bf_hi(hw[0]) * r * ga.y * bf_hi(mw[0]));
        o[1] = pk_bf16(bf_lo(hw[1]) * r * ga.z * bf_lo(mw[1]), bf_hi(hw[1]) * r * ga.w * bf_hi(mw[1]));
        o[2] = pk_bf16(bf_lo(hw[2]) * r * gb.x * bf_lo(mw[2]), bf_hi(hw[2]) * r * gb.y * bf_hi(mw[2]));
        o[3] = pk_bf16(bf_lo(hw[3]) * r * gb.z * bf_lo(mw[3]), bf_hi(hw[3]) * r * gb.w * bf_hi(mw[3]));
        *(u32x4*)(hm + (tok0 + t) * 1024 + h * 256 + e) = o;
    }
    __syncthreads();
}

__device__ __forceinline__ void swa_stage(const bf16_t* ak, const bf16_t* avT, int item, char* kbuf, int tid) {
    const int kvh = item & 1, n = (item >> 1) & 31, b = item >> 6;
    const long tokbase = (long)b * 4096 + n * 128 - 128;
    const int rk = tid >> 3, pck = tid & 7, lck = pck ^ ((rk >> 1) & 7);
    const bf16_t* srck = ak + (tokbase + rk) * 128 + kvh * 64 + lck * 8;
#pragma unroll
    for (int i = 0; i < 4; ++i) glds16(srck + (long)i * 64 * 128, kbuf + (i * 512 + tid) * 16);
    const int rv = tid >> 5, pcv = tid & 31, lcv = pcv ^ (rv & 15);
    const bf16_t* srcv = avT + (long)(kvh * 64 + rv) * T_ + tokbase + lcv * 8;
#pragma unroll
    for (int i = 0; i < 4; ++i) glds16(srcv + (long)i * 16 * T_, kbuf + 32768 + (i * 512 + tid) * 16);
}
__device__ __forceinline__ const bf16_t* swa_qptr(const bf16_t* aq, int item, int u, int wid, int fr, int fq) {
    const int kvh = item & 1, n = (item >> 1) & 31, b = item >> 6;
    return aq + ((long)b * 4096 + n * 128 + u * 32 + fr) * 1024 + (kvh * 8 + wid) * 64 + fq * 8;
}
__device__ __forceinline__ void swa_items(const Params& p, char* smem, int first, int stride, int hi) {
    const int tid = opaque_tid(), lane = tid & 63, wid = tid >> 6, fr = lane & 15, fq = lane >> 4;
    char* ws = uni(p.ws);
    const bf16_t* aq = (const bf16_t*)(ws + OFF_R1);
    const bf16_t* ak = (const bf16_t*)(ws + OFF_AK);
    const bf16_t* avT = (const bf16_t*)(ws + OFF_AV);
    bf16_t* ao = (bf16_t*)(ws + OFF_R0);
    if (first >= hi) return;
    __syncthreads();
    swa_stage(ak, avT, first, smem, tid);
    bf16x8 qc[4];
    {
        const bf16_t* qp = swa_qptr(aq, first, 0, wid, fr, fq);
        qc[0] = *(const bf16x8*)(qp); qc[1] = *(const bf16x8*)(qp + 32); qc[2] = *(const bf16x8*)(qp + 16 * 1024); qc[3] = *(const bf16x8*)(qp + 16 * 1024 + 32);
    }
    int pb = 0;
    for (int item = first; item < hi; item += stride, pb ^= 1) {
        const int kvh = item & 1, n = (item >> 1) & 31, b = item >> 6;
        const int hq = kvh * 8 + wid;
        char* kbuf = smem + pb * 65536; char* vbuf = kbuf + 32768;
        const float sink = uni(p.sinks)[hq];
        asm volatile("s_waitcnt vmcnt(0)" ::: "memory");
        __syncthreads();
        const bool has_next = item + stride < hi;
        if (has_next) swa_stage(ak, avT, item + stride, smem + (pb ^ 1) * 65536, tid);
        const int kswz = (fr >> 1) & 7;
#pragma unroll 1
        for (int u = 0; u < 4; ++u) {
            const long tq = (long)b * 4096 + n * 128 + u * 32 + fr;
            bf16x8 qn[4];
            {
                const bool nx = (u < 3) || has_next;
                const bf16_t* qp = nx ? (u < 3 ? swa_qptr(aq, item, u + 1, wid, fr, fq) : swa_qptr(aq, item + stride, 0, wid, fr, fq)) : swa_qptr(aq, item, u, wid, fr, fq);
                qn[0] = *(const bf16x8*)(qp); qn[1] = *(const bf16x8*)(qp + 32); qn[2] = *(const bf16x8*)(qp + 16 * 1024); qn[3] = *(const bf16x8*)(qp + 16 * 1024 + 32);
            }
            f32x4 sc[10][2];
#pragma unroll
            for (int r = 0; r < 10; ++r) {
                sc[r][0] = (f32x4){0.f, 0.f, 0.f, 0.f}; sc[r][1] = (f32x4){0.f, 0.f, 0.f, 0.f};
                if (!(n == 0 && (2 * u + r) < 8)) {
                    const char* rowp = kbuf + ((2 * u + r) * 16 + fr) * 128;
                    const bf16x8 k0 = *(const bf16x8*)(rowp + ((fq ^ kswz) * 16)), k1 = *(const bf16x8*)(rowp + (((4 + fq) ^ kswz) * 16));
                    sc[r][0] = __builtin_amdgcn_mfma_f32_16x16x32_bf16(k0, qc[0], sc[r][0], 0, 0, 0);
                    sc[r][0] = __builtin_amdgcn_mfma_f32_16x16x32_bf16(k1, qc[1], sc[r][0], 0, 0, 0);
                    sc[r][1] = __builtin_amdgcn_mfma_f32_16x16x32_bf16(k0, qc[2], sc[r][1], 0, 0, 0);
                    sc[r][1] = __builtin_amdgcn_mfma_f32_16x16x32_bf16(k1, qc[3], sc[r][1], 0, 0, 0);
                }
            }
            u32x4 pf[2][5]; float linv[2];
#pragma unroll
            for (int nt = 0; nt < 2; ++nt) {
                float m = sink;
#pragma unroll
                for (int r = 0; r < 10; ++r) {
                    const bool tile_ok = !(n == 0 && (2 * u + r) < 8);
#pragma unroll
                    for (int j = 0; j < 4; ++j) {
                        const int delta = (r - nt) * 16 + fq * 4 + j - fr;
                        const bool ok = tile_ok && delta >= 1 && delta <= 128;
                        sc[r][nt][j] = ok ? sc[r][nt][j] : -INFINITY;
                        m = fmaxf(m, sc[r][nt][j]);
                    }
                }
                m = fmaxf(m, __shfl_xor(m, 16)); m = fmaxf(m, __shfl_xor(m, 32));
                float l = 0.f;
#pragma unroll
                for (int s2 = 0; s2 < 5; ++s2) {
                    float e[8];
#pragma unroll
                    for (int j = 0; j < 4; ++j) { e[j] = __expf(sc[2 * s2][nt][j] - m); e[4 + j] = __expf(sc[2 * s2 + 1][nt][j] - m); }
                    l += ((e[0] + e[1]) + (e[2] + e[3])) + ((e[4] + e[5]) + (e[6] + e[7]));
                    u32x4 w; w[0] = pk_bf16(e[0], e[1]); w[1] = pk_bf16(e[2], e[3]); w[2] = pk_bf16(e[4], e[5]); w[3] = pk_bf16(e[6], e[7]);
                    pf[nt][s2] = w;
                }
                l += __shfl_xor(l, 16); l += __shfl_xor(l, 32);
                linv[nt] = __builtin_amdgcn_rcpf(l + __expf(sink - m));
            }
            f32x4 o[4][2];
#pragma unroll
            for (int dt = 0; dt < 4; ++dt) { o[dt][0] = (f32x4){0.f, 0.f, 0.f, 0.f}; o[dt][1] = (f32x4){0.f, 0.f, 0.f, 0.f}; }
#pragma unroll
            for (int s2 = 0; s2 < 5; ++s2) {
                if (!(n == 0 && (2 * u + 2 * s2) < 8)) {
                    const int ca = ((((2 * u + 2 * s2) * 2 + (fq >> 1)) ^ fr) * 16) + (fq & 1) * 8;
                    const int cb = ((((2 * u + 2 * s2 + 1) * 2 + (fq >> 1)) ^ fr) * 16) + (fq & 1) * 8;
                    const bf16x8 p0 = __builtin_bit_cast(bf16x8, pf[0][s2]), p1 = __builtin_bit_cast(bf16x8, pf[1][s2]);
#pragma unroll
                    for (int dt = 0; dt < 4; ++dt) {
                        const char* rowp = vbuf + (dt * 16 + fr) * 512;
                        const u32x2 va = *(const u32x2*)(rowp + ca), vb = *(const u32x2*)(rowp + cb);
                        u32x4 vv; vv[0] = va[0]; vv[1] = va[1]; vv[2] = vb[0]; vv[3] = vb[1];
                        const bf16x8 vf = __builtin_bit_cast(bf16x8, vv);
                        o[dt][0] = __builtin_amdgcn_mfma_f32_16x16x32_bf16(vf, p0, o[dt][0], 0, 0, 0);
                        o[dt][1] = __builtin_amdgcn_mfma_f32_16x16x32_bf16(vf, p1, o[dt][1], 0, 0, 0);
                    }
                }
            }
#pragma unroll
            for (int nt = 0; nt < 2; ++nt) {
                bf16_t* rp = ao + (size_t)(tq + nt * 16) * 1024 + hq * 64 + fq * 4;
#pragma unroll
                for (int dt = 0; dt < 4; ++dt) store_bf16x4(rp + dt * 16, o[dt][nt] * linv[nt]);
            }
#pragma unroll
            for (int k = 0; k < 4; ++k) qc[k] = qn[k];
        }
    }
    asm volatile("s_waitcnt vmcnt(0)" ::: "memory");
    __syncthreads();
}

constexpr int SWA_A = 0;
__device__ __forceinline__ void phase2a(const Params& p, char* smem, int which = 3) {
    const int G = gridDim.x;
    if (which & 1) for (int it = blockIdx.x; it < 4096; it += G) ml_prepass_item(p, smem, it);
    if (which & 2) swa_items(p, smem, blockIdx.x, G, SWA_A);
}
__device__ __forceinline__ void phase2c(const Params& p, char* smem) {
    for (int it = blockIdx.x; it < 4096; it += gridDim.x) ml_finish_item(p, smem, it);
}
__device__ __forceinline__ void phase2b(const Params& p, char* smem, int which = 3, const int mode = 0) {
    const int G = gridDim.x;
    if (G > 64) {
        if (blockIdx.x < 64) { if (which & 1) ml_scan(p, smem, blockIdx.x, mode); }
        else { if (which & 2) { swa_items(p, smem, SWA_A + blockIdx.x - 64, G - 64, 1024); moe_weight_prep(p, smem, blockIdx.x - 64, G - 64); kv_projection(p, smem, blockIdx.x - 64, G - 64); } }
    } else {
        for (int it = blockIdx.x; it < 64; it += G) ml_scan(p, smem, it);
        swa_items(p, smem, SWA_A + blockIdx.x, G, 1024);
        moe_weight_prep(p, smem, blockIdx.x, G);
        kv_projection(p, smem, blockIdx.x, G);
    }
}

struct EpiP3 {
    const bf16_t* gg; bf16_t* y;
    __device__ __forceinline__ void operator()(f32x4 (&acc)[2][2][4][2], const pg8::Unit& u, int wr, int wc, int fr, int fq) const {
        const int row0 = u.pm * 256 + wr * 64 + fr, col0 = u.pn * 256 + wc * 32 + fq * 8;
        const bool first = (u.aux & 1) == 0;
#pragma unroll
        for (int ai = 0; ai < 2; ++ai)
#pragma unroll
            for (int m = 0; m < 4; ++m) {
                const size_t tok = row0 + ai * 128 + m * 16;
#pragma unroll
                for (int bj = 0; bj < 2; ++bj) {
                    const int col = col0 + bj * 128;
                    const u32x4 gv = *(const u32x4*)(gg + tok * 2048 + (first ? 0 : 1024) + col);
                    const float gf[8] = {bf_lo(gv[0]), bf_hi(gv[0]), bf_lo(gv[1]), bf_hi(gv[1]), bf_lo(gv[2]), bf_hi(gv[2]), bf_lo(gv[3]), bf_hi(gv[3])};
                    if (first) {
#pragma unroll
                        for (int k = 0; k < 4; ++k) { acc[ai][bj][m][0][k] *= gf[k]; acc[ai][bj][m][1][k] *= gf[4 + k]; }
                    } else {
                        f32x4 v0, v1;
#pragma unroll
                        for (int k = 0; k < 4; ++k) { v0[k] = acc[ai][bj][m][0][k] * gf[k]; v1[k] = acc[ai][bj][m][1][k] * gf[4 + k]; }
                        store_bf16x8(y + tok * 1024 + col, v0, v1);
                    }
                }
            }
    }
};
__device__ __forceinline__ void phase3(const Params& p, char* smem) {
    char* ws = uni(p.ws);
    SchedN1024<2> S{(int)gridDim.x, (int)blockIdx.x, ws + OFF_R0, ws + OFF_WATT, (const char*)uni(p.out), ws + OFF_WML};
    EpiP3 E{(const bf16_t*)(ws + OFF_GG), (bf16_t*)(ws + OFF_R1)};
    pg8::gemm_phase<EpiP3, SchedN1024<2>>((LDS_AS unsigned char*)smem, 1024, S, E);
}

struct EpiBf16 {
    bf16_t* outb; float scale;
    __device__ __forceinline__ void operator()(f32x4 (&acc)[2][2][4][2], const pg8::Unit& u, int wr, int wc, int fr, int fq) const {
        const int row0 = u.pm * 256 + wr * 64 + fr, col0 = u.pn * 256 + wc * 32 + fq * 8;
#pragma unroll
        for (int ai = 0; ai < 2; ++ai)
#pragma unroll
            for (int m = 0; m < 4; ++m) {
                const size_t tok = row0 + ai * 128 + m * 16;
#pragma unroll
                for (int bj = 0; bj < 2; ++bj) store_bf16x8(outb + tok * 1024 + col0 + bj * 128, acc[ai][bj][m][0] * scale, acc[ai][bj][m][1] * scale);
            }
    }
};
__device__ __forceinline__ void phase_gemm_bf16(const Params& p, char* smem, const bf16_t* A, const bf16_t* Bt, bf16_t* outb, float scale) {
    SchedN1024<1> S{(int)gridDim.x, (int)blockIdx.x, (const char*)A, (const char*)Bt, (const char*)A, (const char*)Bt};
    EpiBf16 E{outb, scale};
    pg8::gemm_phase<EpiBf16, SchedN1024<1>>((LDS_AS unsigned char*)smem, 1024, S, E);
}

__device__ __forceinline__ void ln_row(float4 (&v)[4], const float* g, const float* bta, int lane) {
    float s = 0.f;
#pragma unroll
    for (int i = 0; i < 4; ++i) s += (v[i].x + v[i].y) + (v[i].z + v[i].w);
    const float mu = wsum(s) * (1.0f / 1024.0f);
    float q = 0.f;
#pragma unroll
    for (int i = 0; i < 4; ++i) { const float a = v[i].x - mu, b = v[i].y - mu, c = v[i].z - mu, d = v[i].w - mu; q += (a * a + b * b) + (c * c + d * d); }
    const float rstd = rsqrtf(wsum(q) * (1.0f / 1024.0f) + 1e-5f);
#pragma unroll
    for (int i = 0; i < 4; ++i) {
        const float4 gg = *(const float4*)(g + i * 256 + lane * 4), bb = *(const float4*)(bta + i * 256 + lane * 4);
        v[i].x = (v[i].x - mu) * rstd * gg.x + bb.x; v[i].y = (v[i].y - mu) * rstd * gg.y + bb.y;
        v[i].z = (v[i].z - mu) * rstd * gg.z + bb.z; v[i].w = (v[i].w - mu) * rstd * gg.w + bb.w;
    }
}

__device__ __forceinline__ void phase_ln1(const Params& p) {
    const int tid_ = opaque_tid(); const int lane = tid_ & 63, wid = tid_ >> 6;
    bf16_t* hb = (bf16_t*)(uni(p.ws) + OFF_R0);
    for (int row = blockIdx.x * 8 + wid; row < T_; row += gridDim.x * 8) {
        float4 v[4];
#pragma unroll
        for (int i = 0; i < 4; ++i) {
            const float4 xx = *(const float4*)(uni(p.x) + (size_t)row * 1024 + i * 256 + lane * 4);
            const uint2 mm = *(const uint2*)(hb + (size_t)row * 1024 + i * 256 + lane * 4);
            v[i].x = ALPHA * xx.x + bf_lo(mm.x); v[i].y = ALPHA * xx.y + bf_hi(mm.x); v[i].z = ALPHA * xx.z + bf_lo(mm.y); v[i].w = ALPHA * xx.w + bf_hi(mm.y);
        }
        ln_row(v, uni(p.ln1g), uni(p.ln1b), lane);
#pragma unroll
        for (int i = 0; i < 4; ++i) {
            uint2 w; w.x = pk_bf16(v[i].x, v[i].y); w.y = pk_bf16(v[i].z, v[i].w);
            *(uint2*)(hb + (size_t)row * 1024 + i * 256 + lane * 4) = w;
        }
    }
}

__device__ __forceinline__ void xa_stage_k(const bf16_t* kmat, int b, int h, int kh, char* buf, int tid) {
    const int rl = tid >> 5, pc = tid & 31, lc = pc ^ (rl & 15);
    const bf16_t* src = kmat + (size_t)(b * 256 + kh * 128 + rl) * 1024 + h * 256 + lc * 8;
#pragma unroll
    for (int i = 0; i < 8; ++i) glds16(src + (size_t)i * 16 * 1024, buf + (i * 512 + tid) * 16);
}
__device__ __forceinline__ void xa_stage_v(const bf16_t* vT, int b, int h, int vh, char* buf, int tid) {
    const int rl = tid >> 4, pc = tid & 15, lc = pc ^ (rl & 15);
    const bf16_t* src = vT + (size_t)(h * 256 + rl) * 4096 + b * 256 + vh * 128 + lc * 8;
#pragma unroll
    for (int i = 0; i < 8; ++i) glds16(src + (size_t)i * 32 * 4096, buf + (i * 512 + tid) * 16);
}

template <int KH>
__device__ __forceinline__ void xa_scores(f32x4 (&acc)[16][2], const char* buf, const bf16x8 (&qf)[2][8], int fr, int fq) {
#pragma unroll
    for (int ks = 0; ks < 8; ++ks) {
        const int ch = ((ks * 4 + fq) ^ fr) * 16;
#pragma unroll
        for (int mt = 0; mt < 8; ++mt) {
            const bf16x8 kf = *(const bf16x8*)(buf + (mt * 16 + fr) * 512 + ch);
            acc[KH * 8 + mt][0] = __builtin_amdgcn_mfma_f32_16x16x32_bf16(kf, qf[0][ks], acc[KH * 8 + mt][0], 0, 0, 0);
            acc[KH * 8 + mt][1] = __builtin_amdgcn_mfma_f32_16x16x32_bf16(kf, qf[1][ks], acc[KH * 8 + mt][1], 0, 0, 0);
        }
        if (ks & 1) __builtin_amdgcn_sched_barrier(0);
    }
}

template <int VH, int DH>
__device__ __forceinline__ void xa_pv(f32x4 (&o)[8][2], const u32x4 (&pf)[2][8], const char* buf, int fr, int fq) {
#pragma unroll
    for (int ks = 0; ks < 4; ++ks) {
        const int ca = ((ks * 4 + (fq >> 1)) ^ fr) * 16 + (fq & 1) * 8, cb = ((ks * 4 + 2 + (fq >> 1)) ^ fr) * 16 + (fq & 1) * 8;
        const bf16x8 p0 = __builtin_bit_cast(bf16x8, pf[0][VH * 4 + ks]), p1 = __builtin_bit_cast(bf16x8, pf[1][VH * 4 + ks]);
#pragma unroll
        for (int dt = 0; dt < 8; ++dt) {
            const char* rowp = buf + ((DH * 8 + dt) * 16 + fr) * 256;
            const u32x2 va = *(const u32x2*)(rowp + ca), vb = *(const u32x2*)(rowp + cb);
            u32x4 vv; vv[0] = va[0]; vv[1] = va[1]; vv[2] = vb[0]; vv[3] = vb[1];
            const bf16x8 vf = __builtin_bit_cast(bf16x8, vv);
            o[dt][0] = __builtin_amdgcn_mfma_f32_16x16x32_bf16(vf, p0, o[dt][0], 0, 0, 0);
            o[dt][1] = __builtin_amdgcn_mfma_f32_16x16x32_bf16(vf, p1, o[dt][1], 0, 0, 0);
        }
    }
}

__device__ __forceinline__ void phase6(const Params& p, char* smem) {
    const int tid = opaque_tid(), lane = tid & 63, wid = tid >> 6, fr = lane & 15, fq = lane >> 4;
    char* ws = uni(p.ws);
    const bf16_t* xq = (const bf16_t*)(ws + OFF_XQ);
    const bf16_t* kmat = (const bf16_t*)(ws + OFF_KMAT);
    const bf16_t* vT = (const bf16_t*)(ws + OFF_VT);
    bf16_t* og = (bf16_t*)(ws + OFF_O);
    char* bufA = smem; char* bufB = smem + 65536;
    const int G = gridDim.x;
    for (int idx = blockIdx.x; idx < 1024; idx += G) {
        int pair, qt;
        if (G == 256) { const int i = idx >> 8, blk = idx & 255, xcd = blk & 7, jj = blk >> 3; pair = (i * 8 + xcd) * 2 + (jj >> 4); qt = jj & 15; }
        else { pair = idx >> 4; qt = idx & 15; }
        const int b = pair >> 2, h = pair & 3;
        const int tok0 = b * 4096 + qt * 256 + wid * 32;
        xa_stage_k(kmat, b, h, 0, bufA, tid);
        xa_stage_k(kmat, b, h, 1, bufB, tid);
        const bf16_t* q0p = xq + (size_t)(tok0 + fr) * 1024 + h * 256 + fq * 8;
        const bf16_t* q1p = q0p + (size_t)16 * 1024;
        bf16x8 qf[2][8];
#pragma unroll
        for (int ks = 0; ks < 8; ++ks) { qf[0][ks] = *(const bf16x8*)(q0p + ks * 32); qf[1][ks] = *(const bf16x8*)(q1p + ks * 32); }
        f32x4 acc[16][2];
#pragma unroll
        for (int mt = 0; mt < 16; ++mt) { acc[mt][0] = (f32x4){0.f, 0.f, 0.f, 0.f}; acc[mt][1] = (f32x4){0.f, 0.f, 0.f, 0.f}; }
        asm volatile("s_waitcnt vmcnt(0)" ::: "memory");
        __syncthreads();
        xa_scores<0>(acc, bufA, qf, fr, fq);
        xa_scores<1>(acc, bufB, qf, fr, fq);
        __syncthreads();
        xa_stage_v(vT, b, h, 0, bufA, tid);
        xa_stage_v(vT, b, h, 1, bufB, tid);
        u32x4 pf[2][8]; float linv[2];
#pragma unroll
        for (int nt = 0; nt < 2; ++nt) {
            float m = -INFINITY;
#pragma unroll
            for (int mt = 0; mt < 16; ++mt) m = fmaxf(m, fmaxf(fmaxf(acc[mt][nt][0], acc[mt][nt][1]), fmaxf(acc[mt][nt][2], acc[mt][nt][3])));
            m = fmaxf(m, __shfl_xor(m, 16)); m = fmaxf(m, __shfl_xor(m, 32));
            float l = 0.f;
#pragma unroll
            for (int s2 = 0; s2 < 8; ++s2) {
                float e[8];
#pragma unroll
                for (int j = 0; j < 4; ++j) { e[j] = __expf(acc[2 * s2][nt][j] - m); e[4 + j] = __expf(acc[2 * s2 + 1][nt][j] - m); }
                l += ((e[0] + e[1]) + (e[2] + e[3])) + ((e[4] + e[5]) + (e[6] + e[7]));
                u32x4 w; w[0] = pk_bf16(e[0], e[1]); w[1] = pk_bf16(e[2], e[3]); w[2] = pk_bf16(e[4], e[5]); w[3] = pk_bf16(e[6], e[7]);
                pf[nt][s2] = w;
            }
            l += __shfl_xor(l, 16); l += __shfl_xor(l, 32);
            linv[nt] = 1.0f / l;
        }
        asm volatile("s_waitcnt vmcnt(0)" ::: "memory");
        __syncthreads();
        {
            f32x4 o[8][2];
#pragma unroll
            for (int dt = 0; dt < 8; ++dt) { o[dt][0] = (f32x4){0.f, 0.f, 0.f, 0.f}; o[dt][1] = (f32x4){0.f, 0.f, 0.f, 0.f}; }
            xa_pv<0, 0>(o, pf, bufA, fr, fq);
            xa_pv<1, 0>(o, pf, bufB, fr, fq);
#pragma unroll
            for (int nt = 0; nt < 2; ++nt) {
                bf16_t* rp = og + (size_t)(tok0 + nt * 16 + fr) * 1024 + h * 256 + fq * 4;
#pragma unroll
                for (int dt = 0; dt < 8; ++dt) store_bf16x4(rp + dt * 16, o[dt][nt] * linv[nt]);
            }
        }
        {
            f32x4 o[8][2];
#pragma unroll
            for (int dt = 0; dt < 8; ++dt) { o[dt][0] = (f32x4){0.f, 0.f, 0.f, 0.f}; o[dt][1] = (f32x4){0.f, 0.f, 0.f, 0.f}; }
            xa_pv<0, 1>(o, pf, bufA, fr, fq);
            xa_pv<1, 1>(o, pf, bufB, fr, fq);
#pragma unroll
            for (int nt = 0; nt < 2; ++nt) {
                bf16_t* rp = og + (size_t)(tok0 + nt * 16 + fr) * 1024 + h * 256 + 128 + fq * 4;
#pragma unroll
                for (int dt = 0; dt < 8; ++dt) store_bf16x4(rp + dt * 16, o[dt][nt] * linv[nt]);
            }
        }
        __syncthreads();
    }
}

__device__ __forceinline__ void phase_ln2(const Params& p) {
    const int tid_ = opaque_tid(); const int lane = tid_ & 63, wid = tid_ >> 6;
    char* ws = uni(p.ws);
    const bf16_t* hb = (const bf16_t*)(ws + OFF_R0); const bf16_t* xa = (const bf16_t*)(ws + OFF_XQ);
    bf16_t* hc = (bf16_t*)(ws + OFF_Z2);
    const float* lg = uni(p.ln2g); const float* lb = uni(p.ln2b);
    for (int row = blockIdx.x * 8 + wid; row < T_; row += gridDim.x * 8) {
        float4 v[4];
#pragma unroll
        for (int i = 0; i < 4; ++i) {
            const uint2 hh = *(const uint2*)(hb + (size_t)row * 1024 + i * 256 + lane * 4);
            const uint2 mm = *(const uint2*)(xa + (size_t)row * 1024 + i * 256 + lane * 4);
            v[i].x = ALPHA * bf_lo(hh.x) + bf_lo(mm.x); v[i].y = ALPHA * bf_hi(hh.x) + bf_hi(mm.x); v[i].z = ALPHA * bf_lo(hh.y) + bf_lo(mm.y); v[i].w = ALPHA * bf_hi(hh.y) + bf_hi(mm.y);
        }
        ln_row(v, lg, lb, lane);
#pragma unroll
        for (int i = 0; i < 4; ++i) {
            uint2 hi; hi.x = pk_bf16(v[i].x, v[i].y); hi.y = pk_bf16(v[i].z, v[i].w);
            uint2 lo; lo.x = pk_bf16(v[i].x - bf_lo(hi.x), v[i].y - bf_hi(hi.x)); lo.y = pk_bf16(v[i].z - bf_lo(hi.y), v[i].w - bf_hi(hi.y));
            *(uint2*)(hc + (size_t)row * 2048 + i * 256 + lane * 4) = hi;
            *(uint2*)(hc + (size_t)row * 2048 + 1024 + i * 256 + lane * 4) = lo;
        }
    }
}

struct SchedRouter {
    int G, c; const char* A; const char* Bt;
    __device__ __forceinline__ bool next(int i, pg8::Unit& u) const {
        const int uidx = c + i * G;
        if (uidx >= 256) return false;
        u.pm = uidx; u.pn = 0; u.aux = 0; u.A = A; u.Bt = Bt;
        return true;
    }
};
struct EpiRouter {
    float* logits;
    __device__ __forceinline__ void operator()(f32x4 (&acc)[2][2][4][2], const pg8::Unit& u, int wr, int wc, int fr, int fq) const {
        const int row0 = u.pm * 256 + wr * 64 + fr;
#pragma unroll
        for (int ai = 0; ai < 2; ++ai)
#pragma unroll
            for (int m = 0; m < 4; ++m) {
                float* rp = logits + (size_t)(row0 + ai * 128 + m * 16) * 160;
#pragma unroll
                for (int n = 0; n < 2; ++n) { const f32x4 v = acc[ai][0][m][n]; *(float4*)(rp + wc * 32 + n * 16 + fq * 4) = make_float4(v[0], v[1], v[2], v[3]); }
                if (wc == 0) { const f32x4 v = acc[ai][1][m][0]; *(float4*)(rp + 128 + fq * 4) = make_float4(v[0], v[1], v[2], v[3]); }
            }
    }
};
__device__ __forceinline__ void phase_router_gemm(const Params& p, char* smem) {
    char* ws = uni(p.ws);
    SchedRouter S{(int)gridDim.x, (int)blockIdx.x, ws + OFF_Z2, ws + OFF_WRT};
    EpiRouter E{(float*)(ws + OFF_R1)};
    pg8::gemm_phase<EpiRouter, SchedRouter>((LDS_AS unsigned char*)smem, 2048, S, E);
}

__device__ __forceinline__ void phase_select(const Params& p, char* smem) {
    const int tid = opaque_tid();
    char* ws = uni(p.ws);
    const float* logits = (const float*)(ws + OFF_R1);
    int2* toke = (int2*)(ws + OFF_TOKE); float2* tokw = (float2*)(ws + OFF_TOKW);
    int* histg = (int*)(ws + OFF_HIST);
    int* hist = (int*)smem;
    const float* b_rg = uni(p.b_rg); const float* b_re = uni(p.b_re);
    for (int c = blockIdx.x; c < 256; c += gridDim.x) {
        __syncthreads();
        if (tid < 64) hist[tid] = 0;
        __syncthreads();
        if (tid < 256) {
            const int tok = c * 256 + tid;
            const float* L = logits + (size_t)tok * 160;
            const float4 ga = *(const float4*)(L), gb = *(const float4*)(L + 4), gc = *(const float4*)(L + 72), gd = *(const float4*)(L + 76);
            const float g[8] = {ga.x + gc.x + b_rg[0], ga.y + gc.y + b_rg[1], ga.z + gc.z + b_rg[2], ga.w + gc.w + b_rg[3],
                                gb.x + gd.x + b_rg[4], gb.y + gd.y + b_rg[5], gb.z + gd.z + b_rg[6], gb.w + gd.w + b_rg[7]};
            float gmax = g[0]; int gsel = 0;
#pragma unroll
            for (int k = 1; k < 8; ++k) if (g[k] > gmax) { gmax = g[k]; gsel = k; }
            float gs = 0.f;
#pragma unroll
            for (int k = 0; k < 8; ++k) gs += __expf(g[k] - gmax);
            const float pgroup = 1.0f / gs;
            const float4 ea = *(const float4*)(L + 8 + gsel * 8), eb = *(const float4*)(L + 12 + gsel * 8), ec = *(const float4*)(L + 80 + gsel * 8), ed = *(const float4*)(L + 84 + gsel * 8);
            const float4 ba = *(const float4*)(b_re + gsel * 8), bb = *(const float4*)(b_re + gsel * 8 + 4);
            const float e[8] = {ea.x + ec.x + ba.x, ea.y + ec.y + ba.y, ea.z + ec.z + ba.z, ea.w + ec.w + ba.w, eb.x + ed.x + bb.x, eb.y + ed.y + bb.y, eb.z + ed.z + bb.z, eb.w + ed.w + bb.w};
            float v0 = e[0], v1 = -INFINITY; int i0 = 0, i1 = 0;
#pragma unroll
            for (int k = 1; k < 8; ++k) { if (e[k] > v0) { v1 = v0; i1 = i0; v0 = e[k]; i0 = k; } else if (e[k] > v1) { v1 = e[k]; i1 = k; } }
            const float x1 = __expf(v1 - v0), den = 1.0f + x1;
            const int e0i = gsel * 8 + i0, e1i = gsel * 8 + i1;
            toke[tok] = make_int2(e0i, e1i); tokw[tok] = make_float2(pgroup / den, pgroup * x1 / den);
            atomicAdd(&hist[e0i], 1); atomicAdd(&hist[e1i], 1);
        }
        __syncthreads();
        if (tid < 64) histg[c * 64 + tid] = hist[tid];
    }
}

__device__ __forceinline__ void compute_segments(const int* histg, int* seg, int tid) {
    if (tid < 64) {
        int s = 0;
        for (int c = 0; c < 256; ++c) s += histg[c * 64 + tid];
        seg[tid] = s;
    }
    __syncthreads();
    if (tid == 0) {
        int acc = 0;
        for (int e = 0; e < 64; ++e) { seg[64 + e] = acc; acc += (seg[e] + 255) >> 8; }
        seg[128] = acc;
    }
    __syncthreads();
}

__device__ __forceinline__ void phase8(const Params& p, char* smem) {
    const int tid = opaque_tid();
    char* ws = uni(p.ws);
    const int* histg = (const int*)(ws + OFF_HIST);
    const int2* toke = (const int2*)(ws + OFF_TOKE); const float2* tokw = (const float2*)(ws + OFF_TOKW);
    int* slot_tok = (int*)(ws + OFF_SLOTTOK); float* slot_w = (float*)(ws + OFF_SLOTW); int* tokslot = (int*)(ws + OFF_TOKSLOT);
    int* seg = (int*)smem;
    int* cursor = seg + 192;
    compute_segments(histg, seg, tid);
    for (int e = blockIdx.x; e < 64; e += gridDim.x) {
        const int start = seg[64 + e] * 256 + seg[e], end = seg[64 + e + 1] * 256;
        for (int s = start + tid; s < end; s += NTHR) { slot_tok[s] = -1; slot_w[s] = 0.f; }
    }
    for (int c = blockIdx.x; c < 256; c += gridDim.x) {
        __syncthreads();
        if (tid < 64) {
            int base = 0;
            for (int cc = 0; cc < c; ++cc) base += histg[cc * 64 + tid];
            cursor[tid] = seg[64 + tid] * 256 + base;
        }
        __syncthreads();
        if (tid < 256) {
            const int tok = c * 256 + tid;
            const int2 ee = toke[tok]; const float2 ww = tokw[tok];
            const int s0 = atomicAdd(&cursor[ee.x], 1);
            const int s1 = atomicAdd(&cursor[ee.y], 1);
            tokslot[tok * 2] = s0; tokslot[tok * 2 + 1] = s1;
            slot_tok[s0] = tok * 2; slot_w[s0] = ww.x;
            slot_tok[s1] = tok * 2 + 1; slot_w[s1] = ww.y;
        }
    }
}

struct Sched9a {
    int G, c, nrt; const int* seg; const int* slot_tok; const char* h2b; const char* wgu;
    __device__ __forceinline__ bool next(int i, pg8::Unit& u) const {
        int rtile, pn;
        if ((G & 7) == 0) { const int x = c & 7, j = c >> 3, nj = G >> 3, per = (nrt + 7) >> 3; const int uidx = i * nj + j; if (uidx >= per * 2) return false; rtile = x * per + (uidx >> 1); pn = uidx & 1; if (rtile >= nrt) return false; }
        else { const int uidx = i * G + c; if (uidx >= nrt * 2) return false; rtile = uidx >> 1; pn = uidx & 1; }
        int e = 0;
        for (int k = 1; k < 64; ++k) if (seg[64 + k] <= rtile) e = k;
        e = __builtin_amdgcn_readfirstlane(e);
        u.pm = rtile; u.pn = pn; u.aux = e; u.A = h2b; u.Bt = wgu + (size_t)e * 512 * 1024 * 2;
        return true;
    }
    __device__ __forceinline__ unsigned arow(const pg8::Unit& u, int r) const {
        const int tk = slot_tok[u.pm * 256 + r];
        return (unsigned)(tk < 0 ? 0 : (tk >> 1)) * 4096u;
    }
};
struct Epi9a {
    bf16_t* hbuf;
    __device__ __forceinline__ void operator()(f32x4 (&acc)[2][2][4][2], const pg8::Unit& u, int wr, int wc, int fr, int fq) const {
        const int row0 = u.pm * 256 + wr * 64 + fr, col0 = u.pn * 128 + wc * 32 + fq * 8;
#pragma unroll
        for (int ai = 0; ai < 2; ++ai)
#pragma unroll
            for (int m = 0; m < 4; ++m) {
                const size_t slot = row0 + ai * 128 + m * 16;
                f32x4 v0, v1;
#pragma unroll
                for (int j = 0; j < 4; ++j) {
                    const float g0 = acc[ai][0][m][0][j], g1 = acc[ai][0][m][1][j];
                    v0[j] = g0 * sigmoidf_(g0) * acc[ai][1][m][0][j]; v1[j] = g1 * sigmoidf_(g1) * acc[ai][1][m][1][j];
                }
                store_bf16x8(hbuf + slot * 256 + col0, v0, v1);
            }
    }
};
__device__ __forceinline__ void phase9a(const Params& p, char* smem) {
    const int tid = opaque_tid();
    char* ws = uni(p.ws);
    int* seg = (int*)(smem + LDS_GEMM);
    compute_segments((const int*)(ws + OFF_HIST), seg, tid);
    Sched9a S{(int)gridDim.x, (int)blockIdx.x, __builtin_amdgcn_readfirstlane(seg[128]), seg, (const int*)(ws + OFF_SLOTTOK), ws + OFF_Z2, ws + OFF_WGU};
    Epi9a E{(bf16_t*)(ws + OFF_R1)};
    pg8::gemm_phase<Epi9a, Sched9a, true>((LDS_AS unsigned char*)smem, 1024, S, E);
}

struct Sched9b {
    int G, c, nrt; const int* seg; const char* hbuf; const char* wd;
    __device__ __forceinline__ bool next(int i, pg8::Unit& u) const {
        int rtile, pn;
        if ((G & 7) == 0) { const int x = c & 7, j = c >> 3, nj = G >> 3, per = (nrt + 7) >> 3; const int uidx = i * nj + j; if (uidx >= per * 4) return false; rtile = x * per + (uidx >> 2); pn = uidx & 3; if (rtile >= nrt) return false; }
        else { const int uidx = i * G + c; if (uidx >= nrt * 4) return false; rtile = uidx >> 2; pn = uidx & 3; }
        int e = 0;
        for (int k = 1; k < 64; ++k) if (seg[64 + k] <= rtile) e = k;
        e = __builtin_amdgcn_readfirstlane(e);
        u.pm = rtile; u.pn = pn; u.aux = e; u.A = hbuf; u.Bt = wd + (size_t)e * 1024 * 256 * 2;
        return true;
    }
};
struct Epi9b {
    const float* slot_w; bf16_t* yb;
    __device__ __forceinline__ void operator()(f32x4 (&acc)[2][2][4][2], const pg8::Unit& u, int wr, int wc, int fr, int fq) const {
        const int row0 = u.pm * 256 + wr * 64 + fr, col0 = u.pn * 256 + wc * 32 + fq * 8;
#pragma unroll
        for (int ai = 0; ai < 2; ++ai)
#pragma unroll
            for (int m = 0; m < 4; ++m) {
                const int slot = row0 + ai * 128 + m * 16;
                const float w = slot_w[slot];
#pragma unroll
                for (int bj = 0; bj < 2; ++bj) store_bf16x8(yb + (size_t)slot * 1024 + col0 + bj * 128, acc[ai][bj][m][0] * w, acc[ai][bj][m][1] * w);
            }
    }
};
__device__ __forceinline__ void phase9b(const Params& p, char* smem) {
    const int tid = opaque_tid();
    char* ws = uni(p.ws);
    int* seg = (int*)(smem + LDS_GEMM);
    compute_segments((const int*)(ws + OFF_HIST), seg, tid);
    Sched9b S{(int)gridDim.x, (int)blockIdx.x, __builtin_amdgcn_readfirstlane(seg[128]), seg, ws + OFF_R1, ws + OFF_WD};
    Epi9b E{(const float*)(ws + OFF_SLOTW), (bf16_t*)(ws + OFF_YB)};
    pg8::gemm_phase<Epi9b, Sched9b>((LDS_AS unsigned char*)smem, 256, S, E);
}

__device__ __forceinline__ void phase10(const Params& p) {
    const int tid_ = opaque_tid(); const int lane = tid_ & 63, wid = tid_ >> 6;
    const bf16_t* h2 = (const bf16_t*)(uni(p.ws) + OFF_Z2); const bf16_t* yb = (const bf16_t*)(uni(p.ws) + OFF_YB);
    const int* tokslot = (const int*)(uni(p.ws) + OFF_TOKSLOT);
    for (int row = blockIdx.x * 8 + wid; row < T_; row += gridDim.x * 8) {
        const int sl0 = __builtin_amdgcn_readfirstlane(tokslot[row * 2]), sl1 = __builtin_amdgcn_readfirstlane(tokslot[row * 2 + 1]);
        float4 v[4];
#pragma unroll
        for (int i = 0; i < 4; ++i) {
            const uint2 hh = *(const uint2*)(h2 + (size_t)row * 2048 + i * 256 + lane * 4);
            const uint2 a = *(const uint2*)(yb + (size_t)sl0 * 1024 + i * 256 + lane * 4), b = *(const uint2*)(yb + (size_t)sl1 * 1024 + i * 256 + lane * 4);
            v[i].x = ALPHA * bf_lo(hh.x) + bf_lo(a.x) + bf_lo(b.x); v[i].y = ALPHA * bf_hi(hh.x) + bf_hi(a.x) + bf_hi(b.x);
            v[i].z = ALPHA * bf_lo(hh.y) + bf_lo(a.y) + bf_lo(b.y); v[i].w = ALPHA * bf_hi(hh.y) + bf_hi(a.y) + bf_hi(b.y);
        }
        ln_row(v, uni(p.ln3g), uni(p.ln3b), lane);
#pragma unroll
        for (int i = 0; i < 4; ++i) *(float4*)(uni(p.out) + (size_t)row * 1024 + i * 256 + lane * 4) = v[i];
    }
}

#define XB_TMO      128
#define XB_XCNT(j)  (256  + 64 * (j))
#define XB_XSUB(j)  (1280 + 64 * (j))
#define XB_XGEN(j)  (2304 + 64 * (j))
#define XB_TOP      3328
#define XB_TOPGEN   3392
#define XCD_BAR_WORDS 3456
#define XB_SPIN_CAP (1u << 18)
#define LAS LDS_AS

__device__ __forceinline__ unsigned xb_ld(unsigned* p)              { return __hip_atomic_load(p, __ATOMIC_RELAXED, __HIP_MEMORY_SCOPE_AGENT); }
__device__ __forceinline__ unsigned xb_add(unsigned* p, unsigned v) { return __hip_atomic_fetch_add(p, v, __ATOMIC_RELAXED, __HIP_MEMORY_SCOPE_AGENT); }
__device__ __forceinline__ unsigned xb_xcc_id() { return (unsigned)__builtin_amdgcn_s_getreg((3 << 11) | 20) & 0xFu; }
#define XB_SPIN(cond, bar) do { unsigned _sp = 0; while (cond) { __builtin_amdgcn_s_sleep(1); \
    if ((++_sp & 255u) == 0u) { if (xb_ld(&(bar)[XB_TMO])) break; if (_sp > XB_SPIN_CAP) { atomicAdd(&(bar)[XB_TMO], 1u); break; } } } } while (0)

struct XcdBarrier {
    unsigned* bar; unsigned x;
    volatile LAS unsigned* st;
};

__device__ __forceinline__ XcdBarrier xcd_barrier_post(unsigned* bar, volatile LAS unsigned* st) {
    XcdBarrier b; b.bar = bar; b.x = xb_xcc_id(); b.st = st;
    if (threadIdx.x == 0) (void)xb_add(&bar[XB_XCNT(b.x)], 1u);
    return b;
}
__device__ __forceinline__ void xcd_barrier_complete(unsigned* bar, unsigned x, unsigned& nloc, unsigned& nx) {
    const unsigned G = gridDim.x * gridDim.y * gridDim.z;
    unsigned sum, cnt, mine, sp = 0u;
    for (;;) {
        sum = 0u; cnt = 0u; mine = 0u;
#pragma unroll
        for (unsigned j = 0; j < 16; ++j) { const unsigned c = xb_ld(&bar[XB_XCNT(j)]); sum += c; cnt += (c > 0u) ? 1u : 0u; mine = (j == x) ? c : mine; }
        if (sum == G) break;
        __builtin_amdgcn_s_sleep(1);
        if ((++sp & 255u) == 0u) { if (xb_ld(&bar[XB_TMO])) break; if (sp > XB_SPIN_CAP) { atomicAdd(&bar[XB_TMO], 1u); break; } }
    }
    nloc = mine > 0u ? mine : 1u; nx = cnt > 0u ? cnt : 1u;
}

__device__ __forceinline__ void xcd_barrier(const XcdBarrier& b) {
    asm volatile("s_waitcnt vmcnt(0)" ::: "memory");
    __syncthreads();
    if (threadIdx.x == 0) {
        unsigned* bar = b.bar;
        __builtin_amdgcn_s_waitcnt(0);
        unsigned nloc = b.st[0], nx = b.st[1];
        if (nloc == 0u) { xcd_barrier_complete(bar, b.x, nloc, nx); b.st[0] = nloc; b.st[1] = nx; }
        const unsigned old = xb_add(&bar[XB_XSUB(b.x)], 1u);
        const unsigned gen = old / nloc;
        if (old + 1u == (gen + 1u) * nloc) {
            __builtin_amdgcn_fence(__ATOMIC_RELEASE, "agent");
            asm volatile("s_waitcnt vmcnt(0)" ::: "memory");
            const unsigned og = xb_add(&bar[XB_TOP], 1u);
            const unsigned tg = og / nx;
            if (og + 1u == (tg + 1u) * nx) xb_add(&bar[XB_TOPGEN], 1u);
            else XB_SPIN(xb_ld(&bar[XB_TOPGEN]) == tg, bar);
            __builtin_amdgcn_fence(__ATOMIC_ACQUIRE, "agent");
            xb_add(&bar[XB_XGEN(b.x)], 1u);
            asm volatile("s_waitcnt vmcnt(0)" ::: "memory");
        } else {
            XB_SPIN(xb_ld(&bar[XB_XGEN(b.x)]) == gen, bar);
            __builtin_amdgcn_fence(__ATOMIC_ACQUIRE, "agent");
            asm volatile("s_waitcnt vmcnt(0)" ::: "memory");
        }
    }
    __syncthreads();
}


#ifndef DUP
#define DUP (-1)
#endif
#define RUN(id, call) do { call; if (DUP == (id)) { GRID_SYNC(); call; } } while (0)
__global__ void __launch_bounds__(NTHR) mega(Params pk) {
    extern __shared__ __attribute__((aligned(16))) char smem[];
    cg::grid_group grid = cg::this_grid();
    if (threadIdx.x == 0) *(Params*)(smem + LDS_PARAMS) = pk;
    __syncthreads();
    const Params& p = *(const Params*)(smem + LDS_PARAMS);
    char* ws = uni(p.ws);
    volatile LDS_AS unsigned* xst = (volatile LDS_AS unsigned*)(LDS_AS char*)smem + (LDS_XB / 4);
    if (threadIdx.x < 4) xst[threadIdx.x] = 0u;
    __syncthreads();
    (void)xcd_barrier_post((unsigned*)(ws + OFF_BAR), xst);
#define GRID_SYNC() do { XcdBarrier xb_; xb_.bar = (unsigned*)(uni(p.ws) + OFF_BAR); xb_.x = xb_xcc_id(); xb_.st = (volatile LDS_AS unsigned*)(LDS_AS char*)smem + (LDS_XB / 4); xcd_barrier(xb_); } while (0)
    RUN(0, phase0(p, smem));
    if (DUP == 61) { GRID_SYNC(); phase0(p, smem, 1); }
    if (DUP == 65) { GRID_SYNC(); phase0(p, smem, 9); }
    if (DUP == 62) { GRID_SYNC(); phase0(p, smem, 2); }
    if (DUP == 64) { GRID_SYNC(); phase0(p, smem, 4); }
    grid.sync();
    RUN(1, phase1(p, smem));
    if (DUP == 30) { GRID_SYNC(); phase1(p, smem, 1); }
    if (DUP == 31) { GRID_SYNC(); phase1(p, smem, 2); }
    GRID_SYNC();
    RUN(2, phase2a(p, smem));
    if (DUP == 20) { GRID_SYNC(); phase2a(p, smem, 1); }
    if (DUP == 21) { GRID_SYNC(); phase2a(p, smem, 2); }
    GRID_SYNC();
    RUN(12, phase2b(p, smem));
    if (DUP == 22) { GRID_SYNC(); phase2b(p, smem, 1); }
    if (DUP == 23) { GRID_SYNC(); phase2b(p, smem, 2); }
    if (DUP == 24) { GRID_SYNC(); phase2b(p, smem, 1, 4); }
    if (DUP == 25) { GRID_SYNC(); phase2b(p, smem, 1, 5); }
    if (DUP == 26) { GRID_SYNC(); phase2b(p, smem, 1, 13); }
    GRID_SYNC();
    phase2c(p, smem);
    GRID_SYNC();
    RUN(3, phase3(p, smem));
    GRID_SYNC();
    RUN(4, phase_gemm_bf16(p, smem, (const bf16_t*)(ws + OFF_R1), (const bf16_t*)(ws + OFF_WMIX), (bf16_t*)(ws + OFF_R0), 1.0f));
    GRID_SYNC();
    phase_ln1(p);
    GRID_SYNC();
    RUN(6, phase_gemm_bf16(p, smem, (const bf16_t*)(ws + OFF_R0), (const bf16_t*)(ws + OFF_WXQ), (bf16_t*)(ws + OFF_XQ), 0.0625f));
    GRID_SYNC();
    RUN(7, phase6(p, smem));
    GRID_SYNC();
    RUN(8, phase_gemm_bf16(p, smem, (const bf16_t*)(ws + OFF_O), (const bf16_t*)(ws + OFF_WXO), (bf16_t*)(ws + OFF_XQ), 1.0f));
    GRID_SYNC();
    RUN(13, phase_ln2(p));
    GRID_SYNC();
    RUN(15, phase_router_gemm(p, smem));
    GRID_SYNC();
    RUN(16, phase_select(p, smem));
    GRID_SYNC();
    RUN(9, phase8(p, smem));
    GRID_SYNC();
    RUN(10, phase9a(p, smem));
    GRID_SYNC();
    RUN(11, phase9b(p, smem));
    GRID_SYNC();
    RUN(14, phase10(p));
}

extern "C" void kernel_launch(void* const* d_in, const int* in_sizes, int n_in, void* d_out, int out_size,
                              void* d_ws, size_t ws_size, hipStream_t stream) {
    static int grid_blocks = 0;
    if (!grid_blocks) {
        int dev = 0, cus = 0, per_cu = 0;
        (void)hipGetDevice(&dev);
        (void)hipDeviceGetAttribute(&cus, hipDeviceAttributeMultiprocessorCount, dev);
        (void)hipFuncSetAttribute((const void*)mega, hipFuncAttributeMaxDynamicSharedMemorySize, LDS_BYTES);
        (void)hipOccupancyMaxActiveBlocksPerMultiprocessor(&per_cu, mega, NTHR, LDS_BYTES);
        if (per_cu > 1) per_cu = 1;
        grid_blocks = cus * per_cu;
        if (ws_size < WS_NEED) fprintf(stderr, "workspace too small: %zu\n", ws_size);
    }
    Params p{};
    const float* const* f = (const float* const*)d_in;
    p.x = f[0]; p.mem = f[1]; p.pos = (const int*)d_in[2];
    p.w_in = f[3]; p.sinks = f[4]; p.conv_w = f[5]; p.conv_b = f[6]; p.b_ig = f[7]; p.b_fg = f[8]; p.ml_g = f[9];
    p.w_att = f[10]; p.w_ml = f[11]; p.w_mix = f[12]; p.ln1g = f[13]; p.ln1b = f[14];
    p.w_xq = f[15]; p.w_xkv = f[16]; p.w_xo = f[17]; p.ln2g = f[18]; p.ln2b = f[19];
    p.w_rg = f[20]; p.b_rg = f[21]; p.w_re = f[22]; p.b_re = f[23]; p.w_gate = f[24]; p.w_up = f[25]; p.w_down = f[26];
    p.ln3g = f[27]; p.ln3b = f[28];
    p.out = (float*)d_out; p.ws = (char*)d_ws;
    (void)hipMemsetAsync((char*)d_ws + OFF_BAR, 0, XCD_BAR_WORDS * sizeof(unsigned), stream);
    void* args[] = {&p};
    hipError_t e = hipLaunchCooperativeKernel((void*)mega, dim3(grid_blocks), dim3(NTHR), args, LDS_BYTES, stream);
    if (e != hipSuccess) fprintf(stderr, "cooperative launch failed: %s (grid %d)\n", hipGetErrorString(e), grid_blocks);
}
```
